# Optimizing an MI355X kernel written in HIP

```python
import math
import jax, jax.numpy as jnp
from jax import lax
import numpy as np

D_MODEL = 2048
BATCH = 2
SEQ = 4096
DEPTH = 4

N_META = 16
BLOCK = 128
WINDOW = 128
HEAD_DIM = 64
A_HEADS = 16
A_KV_HEADS = 2
A_WIDTH = 1024
A_KV_WIDTH = 128
B_HEADS = 16
B_WIDTH = 1024
B_Q_RANK = 512
B_KV_RANK = 256
IDX_HEADS = 8
IDX_DIM = 64
TOPK_MAX = 256
N_BUCKETS = 32
MAX_DISTANCE = 128
EPS = 1e-6
NEG = -1e30
INVALID_POS = 1 << 30

kernel_name = "hybrid_swa_sink_dsa_gated_trunk"

IN_SPLITS = (A_WIDTH, A_KV_WIDTH, A_KV_WIDTH, A_WIDTH,
             B_Q_RANK, B_KV_RANK, B_WIDTH, IDX_DIM, IDX_HEADS,
             D_MODEL, D_MODEL)
IN_COLS = 8264


def _split_points():
    return [int(v) for v in np.cumsum(np.array(IN_SPLITS))[:-1]]


def _rmsnorm(x, g):
    xf = x.astype(jnp.float32)
    y = xf * lax.rsqrt(jnp.mean(xf * xf, axis=-1, keepdims=True) + EPS)
    return (y * g.astype(jnp.float32)).astype(x.dtype)


def _t5_bucket(dist):
    n = jnp.maximum(dist, 0)
    max_exact = N_BUCKETS // 2
    nf = jnp.maximum(n, 1).astype(jnp.float32)
    large = max_exact + (jnp.log(nf / max_exact) / math.log(MAX_DISTANCE / max_exact)
                         * (N_BUCKETS - max_exact)).astype(jnp.int32)
    large = jnp.minimum(large, N_BUCKETS - 1)
    return jnp.where(n < max_exact, n, large)


def _sink_attention(q, k, v, qpos, kpos, sinks, bias_a):
    G, R = A_KV_HEADS, A_HEADS // A_KV_HEADS
    s = jnp.einsum('...qgrd,...kgd->...grqk', q.astype(jnp.float32),
                   k.astype(jnp.float32)) * (HEAD_DIM ** -0.5)
    d = qpos[..., :, None] - kpos[..., None, :]
    mask = (d >= 0) & ((d < WINDOW) | (kpos[..., None, :] < N_META))
    b = jnp.moveaxis(bias_a[_t5_bucket(d)], -1, -3)
    b = b.reshape(d.shape[:-2] + (G, R) + d.shape[-2:]).astype(jnp.float32)
    logits = jnp.where(mask[..., None, None, :, :], s + b, NEG)
    sk = sinks.reshape(G, R)[:, :, None, None].astype(jnp.float32)
    m = jnp.maximum(jnp.max(logits, axis=-1, keepdims=True), sk)
    p = jnp.exp(logits - m)
    p = p / (jnp.sum(p, axis=-1, keepdims=True) + jnp.exp(sk - m))
    o = jnp.einsum('...grqk,...kgd->...qgrd', p, v.astype(jnp.float32))
    return o.astype(q.dtype)


def _mixer_a(q, k, v, sinks, bias_a):
    Bn, L = q.shape[0], q.shape[1]
    S = L - N_META
    nb = S // BLOCK
    G, R = A_KV_HEADS, A_HEADS // A_KV_HEADS
    q = q.reshape(Bn, L, G, R, HEAD_DIM)
    qm, qr = q[:, :N_META], q[:, N_META:]
    km, kr = k[:, :N_META], k[:, N_META:]
    vm, vr = v[:, :N_META], v[:, N_META:]
    meta_pos = jnp.arange(N_META, dtype=jnp.int32)
    o_meta = _sink_attention(qm, km, vm, meta_pos, meta_pos, sinks, bias_a)
    qb = qr.reshape(Bn, nb, BLOCK, G, R, HEAD_DIM)
    kb = kr.reshape(Bn, nb, BLOCK, G, HEAD_DIM)
    vb = vr.reshape(Bn, nb, BLOCK, G, HEAD_DIM)
    pad = ((0, 0), (1, 0), (0, 0), (0, 0), (0, 0))
    kprev = jnp.pad(kb, pad)[:, :-1]
    vprev = jnp.pad(vb, pad)[:, :-1]
    kmb = jnp.broadcast_to(km[:, None], (Bn, nb, N_META, G, HEAD_DIM))
    vmb = jnp.broadcast_to(vm[:, None], (Bn, nb, N_META, G, HEAD_DIM))
    kcat = jnp.concatenate([kmb, kprev, kb], axis=2)
    vcat = jnp.concatenate([vmb, vprev, vb], axis=2)
    blk_pos = N_META + jnp.arange(S, dtype=jnp.int32).reshape(nb, BLOCK)
    prev_pos = jnp.concatenate([jnp.full((1, BLOCK), INVALID_POS, jnp.int32), blk_pos[:-1]], axis=0)
    kpos = jnp.concatenate([jnp.broadcast_to(meta_pos, (nb, N_META)), prev_pos, blk_pos], axis=1)
    o_real = _sink_attention(qb, kcat, vcat, blk_pos, kpos, sinks, bias_a)
    o_real = o_real.reshape(Bn, S, A_WIDTH)
    return jnp.concatenate([o_meta.reshape(Bn, N_META, A_WIDTH), o_real], axis=1)


def _mixer_b(q_lat, ckv, q_idx, k_idx, w_idx, bias_b, w_uv, topk):
    Bn, L = q_lat.shape[0], q_lat.shape[1]
    S = L - N_META
    nb = S // BLOCK
    kpos = jnp.arange(L, dtype=jnp.int32)
    k_idx32 = k_idx.astype(jnp.float32)

    def attend(ql, qi, wi, qpos):
        sc = jnp.einsum('bqhd,bkd->bqhk', qi.astype(jnp.float32), k_idx32) * (IDX_DIM ** -0.5)
        isc = jnp.einsum('bqh,bqhk->bqk', wi.astype(jnp.float32), jax.nn.relu(sc))
        isc = jnp.where(kpos[None, :] <= qpos[:, None], isc, NEG)
        _, idx = lax.top_k(isc, topk)
        valid = idx <= qpos[None, :, None]
        sel = jax.vmap(lambda c, i: c[i])(ckv, idx).astype(jnp.float32)
        s = jnp.einsum('bqhr,bqkr->bqhk', ql.astype(jnp.float32), sel) * (HEAD_DIM ** -0.5)
        b = bias_b[_t5_bucket(qpos[None, :, None] - idx)].astype(jnp.float32)
        s = jnp.where(valid[:, :, None, :], s + jnp.moveaxis(b, -1, -2), NEG)
        p = jax.nn.softmax(s, axis=-1)
        return jnp.einsum('bqhk,bqkr->bqhr', p, sel).astype(ql.dtype)

    meta_pos = jnp.arange(N_META, dtype=jnp.int32)
    o_meta = attend(q_lat[:, :N_META], q_idx[:, :N_META], w_idx[:, :N_META], meta_pos)

    def to_blocks(a):
        a = a[:, N_META:]
        a = a.reshape((Bn, nb, BLOCK) + a.shape[2:])
        return jnp.moveaxis(a, 1, 0)

    blk_pos = N_META + jnp.arange(S, dtype=jnp.int32).reshape(nb, BLOCK)
    xs = (to_blocks(q_lat), to_blocks(q_idx), to_blocks(w_idx), blk_pos)
    o_real = lax.map(lambda a: attend(a[0], a[1], a[2], a[3]), xs)
    o_real = jnp.moveaxis(o_real, 0, 1).reshape(Bn, S, B_HEADS, B_KV_RANK)
    o_lat = jnp.concatenate([o_meta, o_real], axis=1)
    o = jnp.einsum('blhr,hrd->blhd', o_lat, w_uv)
    return o.reshape(Bn, L, B_WIDTH)


def setup_inputs(seed: int = 0) -> dict:
    key = jax.random.key(seed)
    ks = jax.random.split(key, 20)
    f = jnp.float32
    nrm = lambda k, shape, scale: jax.random.normal(k, shape, f) * scale
    return {
        "x": nrm(ks[0], (BATCH, SEQ, D_MODEL), 1.0),
        "meta_tokens": nrm(ks[1], (N_META, D_MODEL), 1.0),
        "bias_table": nrm(ks[2], (N_BUCKETS, A_HEADS + B_HEADS), 0.5),
        "norm_g": 1.0 + nrm(ks[3], (DEPTH, D_MODEL), 0.02),
        "w_in": nrm(ks[4], (DEPTH, D_MODEL, IN_COLS), D_MODEL ** -0.5),
        "q_norm_g": 1.0 + nrm(ks[5], (DEPTH, B_Q_RANK), 0.02),
        "kv_norm_g": 1.0 + nrm(ks[6], (DEPTH, B_KV_RANK), 0.02),
        "w_qb": nrm(ks[7], (DEPTH, B_Q_RANK, B_WIDTH), B_Q_RANK ** -0.5),
        "w_iq": nrm(ks[8], (DEPTH, B_Q_RANK, IDX_HEADS * IDX_DIM), B_Q_RANK ** -0.5),
        "w_uk": nrm(ks[9], (DEPTH, B_HEADS, HEAD_DIM, B_KV_RANK), B_KV_RANK ** -0.5),
        "w_uv": nrm(ks[10], (DEPTH, B_HEADS, B_KV_RANK, HEAD_DIM), B_KV_RANK ** -0.5),
        "sinks": nrm(ks[11], (DEPTH, A_HEADS), 1.0),
        "w_proj_a": nrm(ks[12], (DEPTH, A_WIDTH, D_MODEL), A_WIDTH ** -0.5),
        "w_proj_b": nrm(ks[13], (DEPTH, B_WIDTH, D_MODEL), B_WIDTH ** -0.5),
        "w_out": nrm(ks[14], (DEPTH, D_MODEL, D_MODEL), D_MODEL ** -0.5),
        "final_g": 1.0 + nrm(ks[15], (D_MODEL,), 0.02),
    }


def reference(x, meta_tokens, bias_table, norm_g, w_in, q_norm_g, kv_norm_g, w_qb, w_iq,
              w_uk, w_uv, sinks, w_proj_a, w_proj_b, w_out, final_g):
    Bn, S, D = x.shape
    L = S + N_META
    topk = min(TOPK_MAX, S // 4)
    h = jnp.concatenate([jnp.broadcast_to(meta_tokens.astype(x.dtype)[None], (Bn, N_META, D)), x], axis=1)
    bias_a = bias_table[:, :A_HEADS]
    bias_b = bias_table[:, A_HEADS:]
    splits = _split_points()
    for l in range(DEPTH):
        u = _rmsnorm(h, norm_g[l])
        proj = jnp.einsum('bld,dc->blc', u, w_in[l])
        qa, ka, va, za, cq, ckv, zb, kidx, widx, ga, gb = jnp.split(proj, splits, axis=-1)
        ya = _mixer_a(qa.reshape(Bn, L, A_HEADS, HEAD_DIM),
                      ka.reshape(Bn, L, A_KV_HEADS, HEAD_DIM),
                      va.reshape(Bn, L, A_KV_HEADS, HEAD_DIM), sinks[l], bias_a)
        ya = ya * jax.nn.silu(za)
        cq = _rmsnorm(cq, q_norm_g[l])
        ckv = _rmsnorm(ckv, kv_norm_g[l])
        qb = jnp.einsum('blr,rc->blc', cq, w_qb[l]).reshape(Bn, L, B_HEADS, HEAD_DIM)
        q_lat = jnp.einsum('blhd,hdr->blhr', qb, w_uk[l])
        q_idx = jnp.einsum('blr,rc->blc', cq, w_iq[l]).reshape(Bn, L, IDX_HEADS, IDX_DIM)
        yb = _mixer_b(q_lat, ckv, q_idx, kidx, widx * (IDX_HEADS ** -0.5), bias_b, w_uv[l], topk)
        yb = yb * jax.nn.silu(zb)
        merged = (jax.nn.sigmoid(ga) * jnp.einsum('blc,cd->bld', ya, w_proj_a[l])
                  + jax.nn.sigmoid(gb) * jnp.einsum('blc,cd->bld', yb, w_proj_b[l]))
        h = h + jnp.einsum('bld,de->ble', merged, w_out[l])
    return _rmsnorm(h, final_g)[:, N_META:]
```

```cpp
#include <hip/hip_runtime.h>
#include <cstdio>
#include <cstdint>
namespace pg8 {
#define PG8_LAS __attribute__((address_space(3)))
typedef unsigned short bf16_t;
typedef short bf16x8 __attribute__((ext_vector_type(8)));
typedef float f32x4 __attribute__((ext_vector_type(4)));
typedef unsigned u32x4 __attribute__((ext_vector_type(4)));
constexpr int BM = 256, BK = 64, HALF = 128, HTB = HALF * BK * 2  , STAGE_BYTES = 8 * HTB, NXCD = 8, WGM = 8;

__host__ __device__ __forceinline__ int lds_byte(int r, int c) { const int st = (r >> 4) * 2 + (c >> 5), rr = r & 15, cc = c & 31, ob = rr * 64 + cc * 2; return st * 1024 + (ob ^ (((ob >> 9) & 1) << 5)); }
__host__ __device__ __forceinline__ void stage_rc(int b, int& R, int& C) { const int st = b / 1024, sb = b % 1024, swz = sb ^ (((sb >> 9) & 1) << 5); R = (st >> 1) * 16 + swz / 64; C = (st & 1) * 32 + (swz % 64) / 2; }
__host__ __device__ __forceinline__ int perm32(int rho) { const int n = rho >> 4, i = rho & 15; return 8 * (i >> 2) + 4 * n + (i & 3); }

struct Unit { int pm, pn; };
struct Gemm { const bf16_t* A; const bf16_t* Bt; int M, N, K; };

struct StaticOrder {
    int nM, nN, nwg, G, c;
    __host__ __device__ void init(int M, int N, int G_, int c_) { nM = M / BM; nN = N / BM; nwg = nM * nN; G = G_; c = c_; }
    __host__ __device__ bool next(int i, Unit& u) const {
        const long L = (long)i * G + c; if (L >= nwg) return false;
        int wgid = (int)L; { const int q = nwg / NXCD, r = nwg % NXCD, xcd = wgid % NXCD, off = wgid / NXCD; wgid = (xcd < r ? xcd * (q + 1) : r * (q + 1) + (xcd - r) * q) + off; }
        const int nig = WGM * nN, gid = wgid / nig, fm = gid * WGM, gsz = (nM - fm) < WGM ? (nM - fm) : WGM;
        u.pm = fm + ((wgid % nig) % gsz); u.pn = (wgid % nig) / gsz; return true;
    }
    __device__ __forceinline__ void a_ready(const Unit&) const {}
    __device__ __forceinline__ void done(const Unit&) const {}
};

__device__ __forceinline__ unsigned cvt_pk_bf16(float lo, float hi) { unsigned r; asm volatile("v_cvt_pk_bf16_f32 %0, %1, %2" : "=v"(r) : "v"(lo), "v"(hi)); return r; }
typedef float f32x2 __attribute__((ext_vector_type(2)));
__device__ __forceinline__ f32x2 gelu_pk(f32x2 v) {
    const f32x2 av = __builtin_elementwise_abs(v), d = av * 0.2316418882f + 1.0f;
    f32x2 t; t.x = __builtin_amdgcn_rcpf(d.x); t.y = __builtin_amdgcn_rcpf(d.y);
    f32x2 q = t * 0.5307027145f + (-0.7265760135f); q = q * t + 0.7107068705f; q = q * t + (-0.142248368f); q = q * t + 0.127414796f; q = q * t;
    const f32x2 s = (v * v) * (-0.72134752044f);
    f32x2 e; e.x = __builtin_amdgcn_exp2f(s.x); e.y = __builtin_amdgcn_exp2f(s.y);
    const f32x2 m = v * (q * e), r = v - m;
    f32x2 o; o.x = v.x < 0.f ? m.x : r.x; o.y = v.y < 0.f ? m.y : r.y; return o;
}

template <int ACT  > struct EpiBf16 {
    static constexpr bool PERM = true, AFTER_DRAIN = false; static_assert(ACT == 0 || ACT == 1, "EpiBf16: ACT is 0 (none) or 1 (gelu_pk)");
    bf16_t* O; int ldc; const float* bias; int split_cols; size_t split_stride; float scale0;
    __device__ __forceinline__ void operator()(const f32x4 (&acc)[2][2][4][2], const Unit& u, int ui, int wr, int wc, int fr, int fq) const {
        const int row0 = u.pm * BM + wr * 64 + fr; int colt = u.pn * BM; bf16_t* base = O;
        float sc = 1.f; if (split_cols) { const int t = colt / split_cols; base += (size_t)t * split_stride; colt -= t * split_cols; if (t == 0) sc = scale0; }
        const int col0 = colt + wc * 32 + 8 * fq, bcol0 = u.pn * BM + wc * 32 + 8 * fq;
        f32x4 bv[2][2];
#pragma unroll
        for (int bj = 0; bj < 2; ++bj)
#pragma unroll
            for (int n = 0; n < 2; ++n) bv[bj][n] = bias ? *(const f32x4*)(bias + bcol0 + bj * HALF + 4 * n) : (f32x4){0.f, 0.f, 0.f, 0.f};
#pragma unroll
        for (int ai = 0; ai < 2; ++ai)
#pragma unroll
            for (int m = 0; m < 4; ++m) { bf16_t* rowp = base + (size_t)(row0 + ai * HALF + m * 16) * ldc + col0;
#pragma unroll
                for (int bj = 0; bj < 2; ++bj) { f32x4 v0 = acc[ai][bj][m][0] + bv[bj][0], v1 = acc[ai][bj][m][1] + bv[bj][1];
                    if (ACT == 1) { f32x2 a = gelu_pk((f32x2){v0[0], v0[1]}), b = gelu_pk((f32x2){v0[2], v0[3]}), c = gelu_pk((f32x2){v1[0], v1[1]}), d = gelu_pk((f32x2){v1[2], v1[3]});
                        v0 = (f32x4){a.x, a.y, b.x, b.y}; v1 = (f32x4){c.x, c.y, d.x, d.y}; }
                    v0 = v0 * sc; v1 = v1 * sc; u32x4 w; w.x = cvt_pk_bf16(v0[0], v0[1]); w.y = cvt_pk_bf16(v0[2], v0[3]); w.z = cvt_pk_bf16(v1[0], v1[1]); w.w = cvt_pk_bf16(v1[2], v1[3]);
                    *(u32x4*)(rowp + bj * HALF) = w; } }
    }
};

template <class Epi, class Sched, bool ALIGN_EPI = false, bool SP2 = false>
__device__ __forceinline__ void gemm_phase(PG8_LAS unsigned char* lds, const Gemm g, const Sched& S, const Epi& E) {
    int tid_ = threadIdx.x; asm volatile("" : "+v"(tid_));
    const int tid = tid_, wid = __builtin_amdgcn_readfirstlane(tid >> 6), lane = tid & 63, wr = wid >> 2, wc = wid & 3, fr = lane & 15, fq = lane >> 4;
    const int K = g.K, nt = K / BK;
    unsigned voffA[2], voffB[2];
#pragma unroll
    for (int i = 0; i < 2; ++i) { int R, C; stage_rc(tid * 16 + i * 8192, R, C); const int Rb = Epi::PERM ? ((R & ~31) + perm32(R & 31)) : R;
        voffA[i] = (unsigned)(R * K + C) * 2u; voffB[i] = (unsigned)(Rb * K + C) * 2u; }
    const size_t kstep = (size_t)(BK * 2);
    const size_t hstep = (size_t)HALF * K * 2;
    const size_t tstep = 2 * hstep;
    const unsigned ldsw = (unsigned)wid * 1024u;
    const int aoff = lds_byte(wr * 64 + fr, fq * 8), boff = lds_byte(wc * 32 + fr, fq * 8);
#define PG8_SA(b, h) (((b) * 2 + (h)) * HTB)
#define PG8_SB(b, h) ((4 + (b) * 2 + (h)) * HTB)
#define PG8_STAGE(bufoff, gbase, voff) do { _Pragma("unroll") for (int _i = 0; _i < 2; ++_i) \
        __builtin_amdgcn_global_load_lds((const unsigned*)((const char*)(gbase) + (voff)[_i]), (PG8_LAS unsigned*)(lds + (bufoff) + ldsw + _i * 8192), 16, 0, 0); } while (0)
#define PG8_LDA(dst, b, h) do { _Pragma("unroll") for (int m = 0; m < 4; ++m) _Pragma("unroll") for (int k = 0; k < 2; ++k) dst[m][k] = *(const PG8_LAS bf16x8*)(lds + PG8_SA(b, h) + aoff + m * 2048 + k * 1024); } while (0)
#define PG8_LDB(dst, b, h) do { _Pragma("unroll") for (int n = 0; n < 2; ++n) _Pragma("unroll") for (int k = 0; k < 2; ++k) dst[n][k] = *(const PG8_LAS bf16x8*)(lds + PG8_SB(b, h) + boff + n * 2048 + k * 1024); } while (0)
#define PG8_MMA(ai, bj, At, Bt) do { __builtin_amdgcn_s_setprio(1); _Pragma("unroll") for (int m = 0; m < 4; ++m) _Pragma("unroll") for (int n = 0; n < 2; ++n) _Pragma("unroll") for (int k = 0; k < 2; ++k) \
        acc[ai][bj][m][n] = __builtin_amdgcn_mfma_f32_16x16x32_bf16(Bt[n][k], At[m][k], acc[ai][bj][m][n], 0, 0, 0); __builtin_amdgcn_s_setprio(0); } while (0)
#define PG8_WAIT_V(n) asm volatile("s_waitcnt vmcnt(" #n ")" ::: "memory")
#define PG8_WAIT_L(n) asm volatile("s_waitcnt lgkmcnt(" #n ")" ::: "memory")
#define PG8_BAR __builtin_amdgcn_s_barrier()
#define PG8_SCHED __builtin_amdgcn_sched_barrier(0)
    Unit cur, nxt; int ui = 0;
    if (!S.next(0, cur)) return;
    f32x4 acc[2][2][4][2];
#pragma unroll
    for (int a = 0; a < 2; ++a)
#pragma unroll
        for (int b = 0; b < 2; ++b)
#pragma unroll
            for (int m = 0; m < 4; ++m)
#pragma unroll
                for (int n = 0; n < 2; ++n) acc[a][b][m][n] = (f32x4){0.f, 0.f, 0.f, 0.f};
    bf16x8 At[4][2], B0[2][2], B1[2][2];
    const char* cA = (const char*)g.A + (size_t)cur.pm * tstep; const char* cB = (const char*)g.Bt + (size_t)cur.pn * tstep;
    S.a_ready(cur);
    if constexpr (SP2) {
        PG8_STAGE(PG8_SB(0, 0), cB, voffB); PG8_STAGE(PG8_SB(0, 1), cB + hstep, voffB); PG8_STAGE(PG8_SA(0, 0), cA, voffA); PG8_STAGE(PG8_SA(0, 1), cA + hstep, voffA);
        if (wr == 1) PG8_BAR;
        PG8_WAIT_V(2); PG8_BAR;
        PG8_STAGE(PG8_SB(1, 0), cB + kstep, voffB); PG8_STAGE(PG8_SA(1, 0), cA + kstep, voffA); PG8_STAGE(PG8_SB(1, 1), cB + hstep + kstep, voffB);
        PG8_WAIT_V(6); PG8_BAR;
    } else {
        PG8_STAGE(PG8_SB(0, 0), cB, voffB); PG8_STAGE(PG8_SA(0, 0), cA, voffA); PG8_STAGE(PG8_SB(0, 1), cB + hstep, voffB); PG8_STAGE(PG8_SA(0, 1), cA + hstep, voffA);
        if (wr == 1) PG8_BAR;
        PG8_WAIT_V(4); PG8_BAR;
        PG8_STAGE(PG8_SB(1, 0), cB + kstep, voffB); PG8_STAGE(PG8_SA(1, 0), cA + kstep, voffA); PG8_STAGE(PG8_SB(1, 1), cB + hstep + kstep, voffB);
        PG8_WAIT_V(6); PG8_BAR;
    }
    for (;;) {
        const bool has_next = S.next(ui + 1, nxt);
        const char* nA = has_next ? (const char*)g.A + (size_t)nxt.pm * tstep : cA; const char* nB = has_next ? (const char*)g.Bt + (size_t)nxt.pn * tstep : cB;
        for (int t = 0; t < nt; t += 2) {
            const bool last = (t == nt - 2);
            const char* a1 = cA + (size_t)(t + 1) * kstep;
            const char* a2 = last ? nA : cA + (size_t)(t + 2) * kstep; const char* b2 = last ? nB : cB + (size_t)(t + 2) * kstep;
            const char* a3 = a2 + kstep; const char* b3 = b2 + kstep;
            if (last && has_next) S.a_ready(nxt);
            if constexpr (SP2) {
            PG8_LDB(B0, 0, 0); PG8_LDB(B1, 0, 1); PG8_SCHED; PG8_LDA(At, 0, 0); PG8_STAGE(PG8_SA(1, 1), a1 + hstep, voffA);
            PG8_WAIT_V(8); PG8_WAIT_L(0); PG8_BAR; PG8_MMA(0, 0, At, B0); PG8_MMA(0, 1, At, B1); PG8_BAR; PG8_SCHED;
            PG8_LDA(At, 0, 1); PG8_STAGE(PG8_SB(0, 0), b2, voffB); PG8_STAGE(PG8_SB(0, 1), b2 + hstep, voffB); PG8_STAGE(PG8_SA(0, 0), a2, voffA);
            PG8_WAIT_V(8); PG8_WAIT_L(0); PG8_BAR; PG8_MMA(1, 0, At, B0); PG8_MMA(1, 1, At, B1); PG8_BAR; PG8_SCHED;
            PG8_LDB(B0, 1, 0); PG8_LDB(B1, 1, 1); PG8_SCHED; PG8_LDA(At, 1, 0); PG8_STAGE(PG8_SA(0, 1), a2 + hstep, voffA);
            PG8_WAIT_V(8); PG8_WAIT_L(0); PG8_BAR; PG8_MMA(0, 0, At, B0); PG8_MMA(0, 1, At, B1); PG8_BAR; PG8_SCHED;
            PG8_LDA(At, 1, 1); PG8_STAGE(PG8_SB(1, 0), b3, voffB); PG8_STAGE(PG8_SB(1, 1), b3 + hstep, voffB); PG8_STAGE(PG8_SA(1, 0), a3, voffA);
            PG8_WAIT_V(8); PG8_WAIT_L(0); PG8_BAR; PG8_MMA(1, 0, At, B0); PG8_MMA(1, 1, At, B1); PG8_BAR; PG8_SCHED;
            } else {
            PG8_LDB(B0, 0, 0); PG8_SCHED; PG8_LDA(At, 0, 0); PG8_STAGE(PG8_SA(1, 1), a1 + hstep, voffA);
            PG8_WAIT_L(8); PG8_BAR; PG8_WAIT_L(0); PG8_MMA(0, 0, At, B0); PG8_BAR; PG8_SCHED;
            PG8_LDB(B1, 0, 1); PG8_STAGE(PG8_SB(0, 0), b2, voffB);
            PG8_BAR; PG8_WAIT_L(0); PG8_MMA(0, 1, At, B1); PG8_BAR;
            PG8_LDA(At, 0, 1); PG8_STAGE(PG8_SA(0, 0), a2, voffA);
            PG8_BAR; PG8_WAIT_L(0); PG8_MMA(1, 0, At, B0); PG8_BAR; PG8_SCHED;
            PG8_STAGE(PG8_SB(0, 1), b2 + hstep, voffB);
            PG8_WAIT_V(6); PG8_BAR; PG8_MMA(1, 1, At, B1); PG8_BAR;
            PG8_LDB(B0, 1, 0); PG8_SCHED; PG8_LDA(At, 1, 0); PG8_STAGE(PG8_SA(0, 1), a2 + hstep, voffA);
            PG8_WAIT_L(8); PG8_BAR; PG8_WAIT_L(0); PG8_MMA(0, 0, At, B0); PG8_BAR; PG8_SCHED;
            PG8_LDB(B1, 1, 1); PG8_STAGE(PG8_SB(1, 0), b3, voffB);
            PG8_BAR; PG8_WAIT_L(0); PG8_MMA(0, 1, At, B1); PG8_BAR;
            PG8_LDA(At, 1, 1); PG8_STAGE(PG8_SA(1, 0), a3, voffA);
            PG8_BAR; PG8_WAIT_L(0); PG8_MMA(1, 0, At, B0); PG8_BAR; PG8_SCHED;
            PG8_STAGE(PG8_SB(1, 1), b3 + hstep, voffB);
            PG8_WAIT_V(6); PG8_BAR; PG8_MMA(1, 1, At, B1); PG8_BAR;
            }
        }
        if constexpr (ALIGN_EPI) { if (wr == 0) PG8_BAR; }
        if constexpr (!Epi::AFTER_DRAIN) { E(acc, cur, ui, wr, wc, fr, fq); S.done(cur); }
        if (!has_next) break;
#pragma unroll
        for (int a = 0; a < 2; ++a)
#pragma unroll
            for (int b = 0; b < 2; ++b)
#pragma unroll
                for (int m = 0; m < 4; ++m)
#pragma unroll
                    for (int n = 0; n < 2; ++n) acc[a][b][m][n] = (f32x4){0.f, 0.f, 0.f, 0.f};
        cur = nxt; cA = nA; cB = nB; ++ui;
        if constexpr (ALIGN_EPI) { if (wr == 1) PG8_BAR; }
    }
    PG8_WAIT_V(0);
    if constexpr (!ALIGN_EPI) { if (wr == 0) PG8_BAR; }
    PG8_BAR;
    if constexpr (Epi::AFTER_DRAIN) { E.fused(acc, cur, wr, wc, fr, fq, lds, wid, lane); S.done(cur); }
#undef PG8_SA
#undef PG8_SB
#undef PG8_STAGE
#undef PG8_LDA
#undef PG8_LDB
#undef PG8_MMA
#undef PG8_WAIT_V
#undef PG8_WAIT_L
#undef PG8_BAR
#undef PG8_SCHED
}
}
namespace pg8 {
__device__ __forceinline__ float bf_lo(unsigned w) { return __uint_as_float(w << 16); }
__device__ __forceinline__ float bf_hi(unsigned w) { return __uint_as_float(w & 0xffff0000u); }
__device__ __forceinline__ float sigm(float x) { return 1.0f / (1.0f + __expf(-x)); }
typedef unsigned u32x2 __attribute__((ext_vector_type(2)));

struct EpiProj {
    static constexpr bool PERM = true, AFTER_DRAIN = false;
    bf16_t* O; int ldc; const PG8_LAS float* rstd;
    __device__ __forceinline__ void operator()(const f32x4 (&acc)[2][2][4][2], const Unit& u, int ui, int wr, int wc, int fr, int fq) const {
        const int rt0 = wr * 64 + fr, col0 = u.pn * BM + wc * 32 + 8 * fq;
#pragma unroll
        for (int ai = 0; ai < 2; ++ai)
#pragma unroll
            for (int m = 0; m < 4; ++m) { const int rt = rt0 + ai * HALF + m * 16; const float s = rstd[ui * 256 + rt]; bf16_t* rowp = O + (size_t)(u.pm * BM + rt) * ldc + col0;
#pragma unroll
                for (int bj = 0; bj < 2; ++bj) { const f32x4 v0 = acc[ai][bj][m][0] * s, v1 = acc[ai][bj][m][1] * s;
                    u32x4 w; w.x = cvt_pk_bf16(v0[0], v0[1]); w.y = cvt_pk_bf16(v0[2], v0[3]); w.z = cvt_pk_bf16(v1[0], v1[1]); w.w = cvt_pk_bf16(v1[2], v1[3]);
                    *(u32x4*)(rowp + bj * HALF) = w; } }
    }
};
struct EpiPA {
    static constexpr bool PERM = false, AFTER_DRAIN = false;
    float* P; const bf16_t* G; int ldg;
    __device__ __forceinline__ void operator()(const f32x4 (&acc)[2][2][4][2], const Unit& u, int ui, int wr, int wc, int fr, int fq) const {
        const int col0 = u.pn * BM + wc * 32 + 4 * fq;
#pragma unroll
        for (int ai = 0; ai < 2; ++ai)
#pragma unroll
            for (int m = 0; m < 4; ++m) { const int row = u.pm * BM + ai * HALF + wr * 64 + m * 16 + fr;
#pragma unroll
                for (int bj = 0; bj < 2; ++bj)
#pragma unroll
                    for (int n = 0; n < 2; ++n) { const int c = col0 + bj * HALF + n * 16; const u32x2 g = *(const u32x2*)(G + (size_t)row * ldg + c);
                        f32x4 v = acc[ai][bj][m][n]; v[0] *= sigm(bf_lo(g.x)); v[1] *= sigm(bf_hi(g.x)); v[2] *= sigm(bf_lo(g.y)); v[3] *= sigm(bf_hi(g.y));
                        *(f32x4*)(P + (size_t)row * 2048 + c) = v; } }
    }
};
struct EpiMerge {
    static constexpr bool PERM = true, AFTER_DRAIN = false;
    bf16_t* O; const float* P; const bf16_t* G; int ldg;
    __device__ __forceinline__ void operator()(const f32x4 (&acc)[2][2][4][2], const Unit& u, int ui, int wr, int wc, int fr, int fq) const {
        const int col0 = u.pn * BM + wc * 32 + 8 * fq;
#pragma unroll
        for (int ai = 0; ai < 2; ++ai)
#pragma unroll
            for (int m = 0; m < 4; ++m) { const int row = u.pm * BM + ai * HALF + wr * 64 + m * 16 + fr;
#pragma unroll
                for (int bj = 0; bj < 2; ++bj) { const int c = col0 + bj * HALF; const u32x4 g = *(const u32x4*)(G + (size_t)row * ldg + c);
                    const f32x4 p0 = *(const f32x4*)(P + (size_t)row * 2048 + c), p1 = *(const f32x4*)(P + (size_t)row * 2048 + c + 4);
                    f32x4 v0 = acc[ai][bj][m][0], v1 = acc[ai][bj][m][1];
                    v0[0] = p0[0] + sigm(bf_lo(g.x)) * v0[0]; v0[1] = p0[1] + sigm(bf_hi(g.x)) * v0[1]; v0[2] = p0[2] + sigm(bf_lo(g.y)) * v0[2]; v0[3] = p0[3] + sigm(bf_hi(g.y)) * v0[3];
                    v1[0] = p1[0] + sigm(bf_lo(g.z)) * v1[0]; v1[1] = p1[1] + sigm(bf_hi(g.z)) * v1[1]; v1[2] = p1[2] + sigm(bf_lo(g.w)) * v1[2]; v1[3] = p1[3] + sigm(bf_hi(g.w)) * v1[3];
                    u32x4 w; w.x = cvt_pk_bf16(v0[0], v0[1]); w.y = cvt_pk_bf16(v0[2], v0[3]); w.z = cvt_pk_bf16(v1[0], v1[1]); w.w = cvt_pk_bf16(v1[2], v1[3]);
                    *(u32x4*)(O + (size_t)row * 2048 + c) = w; } }
    }
};
struct EpiRes {
    static constexpr bool PERM = false, AFTER_DRAIN = false;
    float* H; bf16_t* HB; float* RS;
    __device__ __forceinline__ void operator()(const f32x4 (&acc)[2][2][4][2], const Unit& u, int ui, int wr, int wc, int fr, int fq) const {
        const int col0 = u.pn * BM + wc * 32 + 4 * fq;
#pragma unroll
        for (int ai = 0; ai < 2; ++ai)
#pragma unroll
            for (int m = 0; m < 4; ++m) { const int row = u.pm * BM + ai * HALF + wr * 64 + m * 16 + fr; float ss = 0.f;
#pragma unroll
                for (int bj = 0; bj < 2; ++bj)
#pragma unroll
                    for (int n = 0; n < 2; ++n) { const size_t off = (size_t)row * 2048 + col0 + bj * HALF + n * 16;
                        f32x4 hv = *(const f32x4*)(H + off); hv += acc[ai][bj][m][n]; *(f32x4*)(H + off) = hv;
                        u32x2 w; w.x = cvt_pk_bf16(hv[0], hv[1]); w.y = cvt_pk_bf16(hv[2], hv[3]); *(u32x2*)(HB + off) = w;
                        ss += (hv[0] * hv[0] + hv[1] * hv[1]) + (hv[2] * hv[2] + hv[3] * hv[3]); }
                ss += __shfl_xor(ss, 16); ss += __shfl_xor(ss, 32);
                if (fq == 0) RS[(size_t)row * 32 + u.pn * 4 + wc] = ss; }
    }
};
}

#define GAS __attribute__((address_space(1)))
#define LAS __attribute__((address_space(3)))
typedef unsigned short bf16;
typedef unsigned v4u __attribute__((ext_vector_type(4)));
typedef float f32x4 __attribute__((ext_vector_type(4)));
typedef short bf16x8 __attribute__((ext_vector_type(8)));
typedef GAS unsigned gu32;
typedef GAS unsigned long long gu64;
#define RLX_AGENT __ATOMIC_RELAXED, __HIP_MEMORY_SCOPE_AGENT
#define LDS_WAIT() asm volatile("s_waitcnt lgkmcnt(0)" ::: "memory")
#define VM_WAIT() asm volatile("s_waitcnt vmcnt(0)" ::: "memory")
__device__ __forceinline__ unsigned long long rt() { return __builtin_amdgcn_s_memrealtime(); }
__device__ __forceinline__ unsigned f2bf(float f) { unsigned u = __builtin_bit_cast(unsigned, f); return (u + 0x7fffu + ((u >> 16) & 1u)) >> 16; }
__device__ __forceinline__ unsigned pk2(float lo, float hi) { return f2bf(lo) | (f2bf(hi) << 16); }

#define XB_TMO      128
#define XB_XCNT(j)  (256  + 64 * (j))
#define XB_XSUB(j)  (1280 + 64 * (j))
#define XB_XGEN(j)  (2304 + 64 * (j))
#define XB_TOP      3328
#define XB_TOPGEN   3392
#define XCD_BAR_WORDS 3456
#define XB_SPIN_CAP (1u << 18)

__device__ __forceinline__ unsigned xb_ld(unsigned* p)              { return __hip_atomic_load(p, __ATOMIC_RELAXED, __HIP_MEMORY_SCOPE_AGENT); }
__device__ __forceinline__ unsigned xb_add(unsigned* p, unsigned v) { return __hip_atomic_fetch_add(p, v, __ATOMIC_RELAXED, __HIP_MEMORY_SCOPE_AGENT); }
__device__ __forceinline__ unsigned xb_xcc_id() { return (unsigned)__builtin_amdgcn_s_getreg((3 << 11) | 20) & 0xFu; }
#define XB_SPIN(cond, bar) do { unsigned _sp = 0; while (cond) { __builtin_amdgcn_s_sleep(1); \
    if ((++_sp & 255u) == 0u) { if (xb_ld(&(bar)[XB_TMO])) break; if (_sp > XB_SPIN_CAP) { atomicAdd(&(bar)[XB_TMO], 1u); break; } } } } while (0)

struct XcdBarrier {
    unsigned* bar; unsigned x;
    volatile LAS unsigned* st;
};

__device__ __forceinline__ XcdBarrier xcd_barrier_post(unsigned* bar, volatile LAS unsigned* st) {
    XcdBarrier b; b.bar = bar; b.x = xb_xcc_id(); b.st = st;
    if (threadIdx.x == 0) (void)xb_add(&bar[XB_XCNT(b.x)], 1u);
    return b;
}
__device__ __forceinline__ void xcd_barrier_complete(unsigned* bar, unsigned x, unsigned& nloc, unsigned& nx) {
    const unsigned G = gridDim.x * gridDim.y * gridDim.z;
    unsigned sum, cnt, mine, sp = 0u;
    for (;;) {
        sum = 0u; cnt = 0u; mine = 0u;
#pragma unroll
        for (unsigned j = 0; j < 16; ++j) { const unsigned c = xb_ld(&bar[XB_XCNT(j)]); sum += c; cnt += (c > 0u) ? 1u : 0u; mine = (j == x) ? c : mine; }
        if (sum == G) break;
        __builtin_amdgcn_s_sleep(1);
        if ((++sp & 255u) == 0u) { if (xb_ld(&bar[XB_TMO])) break; if (sp > XB_SPIN_CAP) { atomicAdd(&bar[XB_TMO], 1u); break; } }
    }
    nloc = mine > 0u ? mine : 1u; nx = cnt > 0u ? cnt : 1u;
}

__device__ __forceinline__ void xcd_barrier(const XcdBarrier& b) {
    asm volatile("s_waitcnt vmcnt(0)" ::: "memory");
    __syncthreads();
    if (threadIdx.x == 0) {
        unsigned* bar = b.bar;
        __builtin_amdgcn_s_waitcnt(0);
        unsigned nloc = b.st[0], nx = b.st[1];
        if (nloc == 0u) { xcd_barrier_complete(bar, b.x, nloc, nx); b.st[0] = nloc; b.st[1] = nx; }
        const unsigned old = xb_add(&bar[XB_XSUB(b.x)], 1u);
        const unsigned gen = old / nloc;
        if (old + 1u == (gen + 1u) * nloc) {
            __builtin_amdgcn_fence(__ATOMIC_RELEASE, "agent");
            asm volatile("s_waitcnt vmcnt(0)" ::: "memory");
            const unsigned og = xb_add(&bar[XB_TOP], 1u);
            const unsigned tg = og / nx;
            if (og + 1u == (tg + 1u) * nx) xb_add(&bar[XB_TOPGEN], 1u);
            else XB_SPIN(xb_ld(&bar[XB_TOPGEN]) == tg, bar);
            __builtin_amdgcn_fence(__ATOMIC_ACQUIRE, "agent");
            xb_add(&bar[XB_XGEN(b.x)], 1u);
            asm volatile("s_waitcnt vmcnt(0)" ::: "memory");
        } else {
            XB_SPIN(xb_ld(&bar[XB_XGEN(b.x)]) == gen, bar);
            __builtin_amdgcn_fence(__ATOMIC_ACQUIRE, "agent");
            asm volatile("s_waitcnt vmcnt(0)" ::: "memory");
        }
    }
    __syncthreads();
}
constexpr int NWAVES = 8;
constexpr int NLAYER = 4, DM = 2048, NBATCH = 2, SEQ = 4096, NMETA = 16, LTOK = SEQ + NMETA, NTOK = NBATCH * LTOK;
constexpr int MP = 8448;
constexpr int NP1 = 8448;
constexpr int NC_IN = 8264;
constexpr int PC_QA = 0, PC_KA = 1024, PC_VA = 1152, PC_ZA = 1280, PC_CQ = 2304, PC_CKV = 2816, PC_ZB = 3072, PC_GA = 4096, PC_GB = 6144, PC_KIDX = 8192, PC_WIDX = 8256;
constexpr int NQ2 = 4608;
constexpr int TOPK = 256;
constexpr float RMS_EPS = 1e-6f;

__device__ __forceinline__ int rowof(int b, int t) { return t < NMETA ? 8192 + b * NMETA + t : b * SEQ + (t - NMETA); }
__device__ __forceinline__ int t5_bucket(int d) {
    const int n = d < 0 ? 0 : d;
    if (n < 16) return n;
    return 16 + (n >= 19) + (n >= 21) + (n >= 24) + (n >= 27) + (n >= 31) + (n >= 35) + (n >= 40) + (n >= 46) + (n >= 52) + (n >= 59) + (n >= 67) + (n >= 77) + (n >= 87) + (n >= 99) + (n >= 113);
}
__device__ __forceinline__ float bf2f(bf16 v) { return __uint_as_float((unsigned)v << 16); }
__device__ __forceinline__ float sigmoidf_(float x) { return 1.0f / (1.0f + __expf(-x)); }
__device__ __forceinline__ float siluf_(float x) { return x / (1.0f + __expf(-x)); }
__device__ __forceinline__ float wave_sum(float v) {
#pragma unroll
    for (int o = 1; o < 64; o <<= 1) v += __shfl_xor(v, o);
    return v;
}
__device__ __forceinline__ float wave_max(float v) {
#pragma unroll
    for (int o = 1; o < 64; o <<= 1) v = fmaxf(v, __shfl_xor(v, o));
    return v;
}
__device__ __forceinline__ int wave_sum_i(int v) {
#pragma unroll
    for (int o = 1; o < 64; o <<= 1) v += __shfl_xor(v, o);
    return v;
}

constexpr size_t MiB = 1u << 20;
constexpr size_t WS_CTL = 0, CTL_ZERO_BYTES = 1 * MiB;
constexpr size_t SZ_W1 = (size_t)NLAYER * NP1 * DM * 2, SZ_W2 = (size_t)NLAYER * NQ2 * 512 * 2, SZ_WA = (size_t)NLAYER * DM * 1024 * 2, SZ_WO = (size_t)NLAYER * DM * DM * 2;
constexpr size_t al(size_t x) { return (x + 4095) / 4096 * 4096; }
constexpr size_t WS_W1 = 1 * MiB, WS_W2 = WS_W1 + al(SZ_W1), WS_WA = WS_W2 + al(SZ_W2), WS_WB = WS_WA + al(SZ_WA), WS_WO = WS_WB + al(SZ_WA);
constexpr size_t WS_H = WS_WO + al(SZ_WO), WS_HB = WS_H + al((size_t)MP * DM * 4), WS_RS = WS_HB + al((size_t)MP * DM * 2);
constexpr size_t WS_PROJ = WS_RS + al((size_t)MP * 32 * 4), WS_CQN = WS_PROJ + al((size_t)MP * NP1 * 2), WS_CKVN = WS_CQN + al((size_t)MP * 512 * 2);
constexpr size_t WS_Q2 = WS_CKVN + al((size_t)MP * 256 * 2), WS_OLAT = WS_Q2 + al((size_t)MP * NQ2 * 2), WS_YA = WS_OLAT + al((size_t)MP * 4096 * 2);
constexpr size_t WS_YB = WS_YA + al((size_t)MP * 1024 * 2), WS_PA = WS_YB + al((size_t)MP * 1024 * 2), WS_MG = WS_PA + al((size_t)MP * DM * 4), WS_END = WS_MG + al((size_t)MP * DM * 2);
constexpr int CW_TMO = 0, CW_CODE = 1, CW_BAR = 4096;

constexpr int RING_OFF = 0, RING_BYTES = 131072;
constexpr int LDSCTL_OFF = RING_BYTES, MISC_OFF = LDSCTL_OFF + 320;
constexpr int RSTD_OFF = LDSCTL_OFF + 512;
constexpr int LDS_BYTES = 147456;
static_assert(RSTD_OFF + 5 * 256 * 4 <= LDS_BYTES, "LDS map");

struct Args {
    const float* x; const float* meta; const float* bias_table; const float* norm_g; const float* w_in; const float* q_norm_g; const float* kv_norm_g; const float* w_qb; const float* w_iq;
    const float* w_uk; const float* w_uv; const float* sinks; const float* w_proj_a; const float* w_proj_b; const float* w_out; const float* final_g;
    float* out; unsigned char* ws; int ph_lo, ph_hi;
};

__device__ __forceinline__ void xpose_item(const float* __restrict__ W, int ldw, int k0, int c0, int nvalid, const float* __restrict__ scale, bf16* out, int K, LAS float* scr, int lane) {
    const int c = lane & 31;
#pragma unroll 8
    for (int i = 0; i < 32; ++i) { const int kk = 2 * i + (lane >> 5); float v = (c < nvalid) ? W[(size_t)(k0 + kk) * ldw + c0 + c] : 0.f; if (scale) v *= scale[k0 + kk]; scr[kk * 33 + c] = v; }
    LDS_WAIT(); asm volatile("" ::: "memory");
    const int cc = lane & 7;
#pragma unroll
    for (int j = 0; j < 4; ++j) { const int n = (lane >> 3) + 8 * j; const LAS float* s = scr + (8 * cc) * 33 + n;
        v4u o; o.x = pk2(s[0 * 33], s[1 * 33]); o.y = pk2(s[2 * 33], s[3 * 33]); o.z = pk2(s[4 * 33], s[5 * 33]); o.w = pk2(s[6 * 33], s[7 * 33]);
        *(GAS v4u*)(out + (size_t)n * K + k0 + 8 * cc) = o; }
    LDS_WAIT(); asm volatile("" ::: "memory");
}
__device__ __forceinline__ void fold_item(const float* __restrict__ wqb, const float* __restrict__ wuk, const float* __restrict__ gq, bf16* W2l, int h, int kb, int rb, LAS float* scr, int lane) {
    const int rr = lane & 31, r = rb * 32 + rr;
    float uk[64];
#pragma unroll
    for (int d = 0; d < 64; ++d) uk[d] = wuk[((size_t)h * 64 + d) * 256 + r];
    for (int i = 0; i < 32; ++i) { const int kk = 2 * i + (lane >> 5), k = kb * 64 + kk; const f32x4* qp = (const f32x4*)(wqb + (size_t)k * 1024 + h * 64); float a = 0.f;
#pragma unroll
        for (int d4 = 0; d4 < 16; ++d4) { const f32x4 q = qp[d4]; a = fmaf(q[0], uk[4 * d4], a); a = fmaf(q[1], uk[4 * d4 + 1], a); a = fmaf(q[2], uk[4 * d4 + 2], a); a = fmaf(q[3], uk[4 * d4 + 3], a); }
        scr[kk * 33 + rr] = a * gq[k]; }
    LDS_WAIT(); asm volatile("" ::: "memory");
    const int cc = lane & 7; bf16* out = W2l + (size_t)(h * 256 + rb * 32) * 512;
#pragma unroll
    for (int j = 0; j < 4; ++j) { const int n = (lane >> 3) + 8 * j; const LAS float* s = scr + (8 * cc) * 33 + n;
        v4u o; o.x = pk2(s[0 * 33], s[1 * 33]); o.y = pk2(s[2 * 33], s[3 * 33]); o.z = pk2(s[4 * 33], s[5 * 33]); o.w = pk2(s[6 * 33], s[7 * 33]);
        *(GAS v4u*)(out + (size_t)n * 512 + kb * 64 + 8 * cc) = o; }
    LDS_WAIT(); asm volatile("" ::: "memory");
}

struct Ctx {
    LAS unsigned char* lds; int tid, lane, wave, G, gw, NGW, bid;
    Args a;
};
__device__ __forceinline__ unsigned char* launder(unsigned char* p) { asm volatile("" : "+s"(p)); return p; }
__device__ __forceinline__ const float* launderf(const float* p) { asm volatile("" : "+s"(p)); return p; }
struct Bufs {
    bf16 *W1, *W2, *WA, *WB, *WO, *HB, *PROJ, *CQN, *CKVN, *Q2, *OLAT, *YA, *YB, *MG; float *H, *RS, *PA;
    __device__ __forceinline__ explicit Bufs(unsigned char* ws0) {
        unsigned char* ws = launder(ws0);
        W1 = (bf16*)(ws + WS_W1); W2 = (bf16*)(ws + WS_W2); WA = (bf16*)(ws + WS_WA); WB = (bf16*)(ws + WS_WB); WO = (bf16*)(ws + WS_WO);
        H = (float*)(ws + WS_H); HB = (bf16*)(ws + WS_HB); RS = (float*)(ws + WS_RS); PROJ = (bf16*)(ws + WS_PROJ); CQN = (bf16*)(ws + WS_CQN); CKVN = (bf16*)(ws + WS_CKVN);
        Q2 = (bf16*)(ws + WS_Q2); OLAT = (bf16*)(ws + WS_OLAT); YA = (bf16*)(ws + WS_YA); YB = (bf16*)(ws + WS_YB); PA = (float*)(ws + WS_PA); MG = (bf16*)(ws + WS_MG);
    }
};

__device__ __forceinline__ void p0_prologue(const Ctx& C) {
    const Bufs B(C.a.ws);
    const Args& A = C.a;
    LAS float* scr = (LAS float*)(C.lds + RING_OFF + C.wave * 16384);
    constexpr int I_T1 = (DM / 64) * (NP1 / 32), I_T2 = (512 / 64) * (512 / 32), I_T3 = (1024 / 64) * (DM / 32), I_T5 = (DM / 64) * (DM / 32), I_F = 16 * 8 * 8;
    constexpr int I_LAYER = I_T1 + I_T2 + 2 * I_T3 + I_T5 + I_F, NITEMS = NLAYER * I_LAYER;
    for (int it = C.gw; it < NITEMS; it += C.NGW) {
        const int l = it / I_LAYER; int r = it % I_LAYER;
        if (r < I_T1) { const int nblk = NP1 / 32, kb = r / nblk, nb = r % nblk, n0 = nb * 32;
            int c0, nvalid = 32;
            if (n0 < 4096) c0 = n0; else if (n0 < 8192) c0 = n0 + 72; else { c0 = n0 - 8192 + 4096; nvalid = NC_IN - 4096 - 72 - 4096 + 0; nvalid = (8264 - n0) < 0 ? 0 : ((8264 - n0) > 32 ? 32 : (8264 - n0)); }
            xpose_item(A.w_in + (size_t)l * DM * NC_IN, NC_IN, kb * 64, c0, nvalid, A.norm_g + l * DM, B.W1 + ((size_t)l * NP1 + n0) * DM, DM, scr, C.lane); continue; }
        r -= I_T1;
        if (r < I_T2) { const int nblk = 512 / 32, kb = r / nblk, nb = r % nblk;
            xpose_item(A.w_iq + (size_t)l * 512 * 512, 512, kb * 64, nb * 32, 32, A.q_norm_g + l * 512, B.W2 + ((size_t)l * NQ2 + 4096 + nb * 32) * 512, 512, scr, C.lane); continue; }
        r -= I_T2;
        if (r < I_T3) { const int nblk = DM / 32, kb = r / nblk, nb = r % nblk;
            xpose_item(A.w_proj_a + (size_t)l * 1024 * DM, DM, kb * 64, nb * 32, 32, nullptr, B.WA + ((size_t)l * DM + nb * 32) * 1024, 1024, scr, C.lane); continue; }
        r -= I_T3;
        if (r < I_T3) { const int nblk = DM / 32, kb = r / nblk, nb = r % nblk;
            xpose_item(A.w_proj_b + (size_t)l * 1024 * DM, DM, kb * 64, nb * 32, 32, nullptr, B.WB + ((size_t)l * DM + nb * 32) * 1024, 1024, scr, C.lane); continue; }
        r -= I_T3;
        if (r < I_T5) { const int nblk = DM / 32, kb = r / nblk, nb = r % nblk;
            xpose_item(A.w_out + (size_t)l * DM * DM, DM, kb * 64, nb * 32, 32, nullptr, B.WO + ((size_t)l * DM + nb * 32) * DM, DM, scr, C.lane); continue; }
        r -= I_T5;
        { const int h = r / 64, kb = (r / 8) % 8, rb = r % 8;
            fold_item(A.w_qb + (size_t)l * 512 * 1024, A.w_uk + (size_t)l * 16 * 64 * 256, A.q_norm_g + l * 512, B.W2 + (size_t)l * NQ2 * 512, h, kb, rb, scr, C.lane); }
    }
    for (int m = C.gw; m < MP; m += C.NGW) {
        const float* src = nullptr;
        if (m < 8192) src = A.x + (size_t)m * DM; else if (m < 8224) src = A.meta + (size_t)((m - 8192) % NMETA) * DM;
        float ss = 0.f;
#pragma unroll
        for (int j = 0; j < 8; ++j) { f32x4 v = src ? *(const f32x4*)(src + j * 256 + C.lane * 4) : (f32x4){0.f, 0.f, 0.f, 0.f};
            *(f32x4*)(B.H + (size_t)m * DM + j * 256 + C.lane * 4) = v;
            pg8::u32x2 w; w.x = pk2(v[0], v[1]); w.y = pk2(v[2], v[3]); *(pg8::u32x2*)(B.HB + (size_t)m * DM + j * 256 + C.lane * 4) = w;
            ss += (v[0] * v[0] + v[1] * v[1]) + (v[2] * v[2] + v[3] * v[3]); }
        ss = wave_sum(ss);
        if (C.lane < 32) B.RS[(size_t)m * 32 + C.lane] = (C.lane == 0) ? ss : 0.f;
        if (m >= NTOK) {
#pragma unroll
            for (int j = 0; j < 2; ++j) { *(v4u*)(B.YA + (size_t)m * 1024 + j * 512 + C.lane * 8) = (v4u){0u, 0u, 0u, 0u}; *(v4u*)(B.YB + (size_t)m * 1024 + j * 512 + C.lane * 8) = (v4u){0u, 0u, 0u, 0u}; }
        }
    }
}

__device__ __forceinline__ void g1_rstd_table(const Ctx& C, const pg8::StaticOrder& S) {
    const Bufs B(C.a.ws);
    LAS float* tbl = (LAS float*)(C.lds + RSTD_OFF);
    pg8::Unit u;
    for (int ui = 0; ui < 5 && S.next(ui, u); ++ui) {
        if (C.tid < 256) { const f32x4* p = (const f32x4*)(B.RS + (size_t)(u.pm * 256 + C.tid) * 32); float s = 0.f;
#pragma unroll
            for (int j = 0; j < 8; ++j) { const f32x4 v = p[j]; s += (v[0] + v[1]) + (v[2] + v[3]); }
            tbl[ui * 256 + C.tid] = rsqrtf(s * (1.0f / DM) + RMS_EPS); }
    }
    __syncthreads();
}

__device__ __forceinline__ void norm_phase(const Ctx& C, int l) {
    const Bufs B(C.a.ws);
    const Args& A = C.a;
    for (int m = C.gw; m < MP; m += C.NGW) {
        const bf16* pr = B.PROJ + (size_t)m * NP1;
        { const v4u w = *(const v4u*)(pr + PC_CQ + C.lane * 8); float v[8] = {pg8::bf_lo(w.x), pg8::bf_hi(w.x), pg8::bf_lo(w.y), pg8::bf_hi(w.y), pg8::bf_lo(w.z), pg8::bf_hi(w.z), pg8::bf_lo(w.w), pg8::bf_hi(w.w)};
          float ss = 0.f;
#pragma unroll
          for (int j = 0; j < 8; ++j) ss += v[j] * v[j];
          ss = wave_sum(ss); const float r = rsqrtf(ss * (1.0f / 512.0f) + RMS_EPS);
          v4u o; o.x = pk2(v[0] * r, v[1] * r); o.y = pk2(v[2] * r, v[3] * r); o.z = pk2(v[4] * r, v[5] * r); o.w = pk2(v[6] * r, v[7] * r);
          *(v4u*)(B.CQN + (size_t)m * 512 + C.lane * 8) = o; }
        { const pg8::u32x2 w = *(const pg8::u32x2*)(pr + PC_CKV + C.lane * 4); float v[4] = {pg8::bf_lo(w.x), pg8::bf_hi(w.x), pg8::bf_lo(w.y), pg8::bf_hi(w.y)};
          float ss = (v[0] * v[0] + v[1] * v[1]) + (v[2] * v[2] + v[3] * v[3]);
          ss = wave_sum(ss); const float r = rsqrtf(ss * (1.0f / 256.0f) + RMS_EPS);
          const f32x4 g = *(const f32x4*)(A.kv_norm_g + l * 256 + C.lane * 4);
          pg8::u32x2 o; o.x = pk2(v[0] * r * g[0], v[1] * r * g[1]); o.y = pk2(v[2] * r * g[2], v[3] * r * g[3]);
          *(pg8::u32x2*)(B.CKVN + (size_t)m * 256 + C.lane * 4) = o; }
    }
}

__device__ __forceinline__ void swa_naive(const Ctx& C, int l) {
    const Bufs B(C.a.ws);
    const Args& A = C.a;
    LAS float* ps = (LAS float*)(C.lds + RING_OFF + C.wave * 2048);
    LAS int* kp = (LAS int*)(C.lds + RING_OFF + C.wave * 2048 + 1024);
    const int lane = C.lane;
    for (int item = C.gw; item < NTOK * 16; item += C.NGW) {
        const int tok = item >> 4, head = item & 15, b = tok / LTOK, t = tok % LTOK, g = head >> 3, row = rowof(b, t);
        const int nmeta = t < NMETA ? t + 1 : NMETA;
        const int wlo = t - 127 < NMETA ? NMETA : t - 127;
        const int nwin = t < NMETA ? 0 : t - wlo + 1;
        const int ncand = nmeta + nwin;
        const bf16* q = B.PROJ + (size_t)row * NP1 + PC_QA + head * 64;
        const float sink = A.sinks[l * 16 + head];
        float mx = -3.0e38f;
        for (int c = lane; c < ncand; c += 64) {
            const int kpos = c < nmeta ? c : wlo + (c - nmeta), krow = rowof(b, kpos);
            const bf16* k = B.PROJ + (size_t)krow * NP1 + PC_KA + g * 64;
            float s = 0.f;
            for (int d = 0; d < 64; ++d) s = fmaf(bf2f(q[d]), bf2f(k[d]), s);
            s = s * 0.125f + A.bias_table[t5_bucket(t - kpos) * 32 + head];
            ps[c] = s; kp[c] = krow;
            mx = fmaxf(mx, s);
        }
        mx = fmaxf(wave_max(mx), sink);
        float sum = 0.f;
        for (int c = lane; c < ncand; c += 64) { const float p = __expf(ps[c] - mx); ps[c] = p; sum += p; }
        sum = wave_sum(sum) + __expf(sink - mx);
        LDS_WAIT(); asm volatile("" ::: "memory");
        float o = 0.f;
        for (int c = 0; c < ncand; ++c) o = fmaf(ps[c], bf2f(B.PROJ[(size_t)kp[c] * NP1 + PC_VA + g * 64 + lane]), o);
        o /= sum;
        const float z = bf2f(B.PROJ[(size_t)row * NP1 + PC_ZA + head * 64 + lane]);
        B.YA[(size_t)row * 1024 + head * 64 + lane] = (bf16)f2bf(o * siluf_(z));
        LDS_WAIT(); asm volatile("" ::: "memory");
    }
}

__device__ __forceinline__ unsigned f2key(float f) { const unsigned u = __float_as_uint(f); return (u & 0x80000000u) ? ~u : (u | 0x80000000u); }

__device__ __forceinline__ void dsa_naive(const Ctx& C, int l) {
    const Bufs B(C.a.ws);
    const Args& A = C.a;
    LAS float* s_qi = (LAS float*)(C.lds + 0);
    LAS float* s_wi = (LAS float*)(C.lds + 2048);
    LAS unsigned* s_key = (LAS unsigned*)(C.lds + 2112);
    LAS int* s_sel = (LAS int*)(C.lds + 18560);
    LAS float* s_ql = (LAS float*)(C.lds + 19584);
    LAS float* s_p = (LAS float*)(C.lds + 35968);
    LAS int* s_cnt = (LAS int*)(C.lds + 52352);
    LAS int* s_n = (LAS int*)(C.lds + 52384);
    const int tid = C.tid, lane = C.lane, wid = C.wave;
    for (int item = C.bid; item < NTOK; item += C.G) {
        const int b = item / LTOK, t = item % LTOK, row = rowof(b, t);
        __syncthreads();
        s_qi[tid] = bf2f(B.Q2[(size_t)row * NQ2 + 4096 + tid]);
        if (tid < 8) s_wi[tid] = bf2f(B.PROJ[(size_t)row * NP1 + PC_WIDX + tid]) * 0.35355339059327373f;
        for (int i = tid; i < 4096; i += 512) s_ql[i] = bf2f(B.Q2[(size_t)row * NQ2 + i]);
        __syncthreads();
        const int n = t + 1;
        for (int k = tid; k < n; k += 512) {
            const bf16* kr = B.PROJ + (size_t)rowof(b, k) * NP1 + PC_KIDX;
            float isc = 0.f;
            for (int hh = 0; hh < 8; ++hh) {
                float s = 0.f;
                for (int d = 0; d < 64; ++d) s = fmaf(s_qi[hh * 64 + d], bf2f(kr[d]), s);
                isc += s_wi[hh] * fmaxf(s * 0.125f, 0.f);
            }
            s_key[k] = f2key(isc);
        }
        __syncthreads();
        int cnt;
        if (n <= TOPK) {
            for (int i = tid; i < n; i += 512) s_sel[i] = i;
            cnt = n;
        } else {
            unsigned T = 0u;
            for (int bit = 31; bit >= 0; --bit) {
                const unsigned cand = T | (1u << bit);
                int c = 0;
                for (int k = tid; k < n; k += 512) c += (s_key[k] >= cand) ? 1 : 0;
                c = wave_sum_i(c);
                __syncthreads();
                if (lane == 0) s_cnt[wid] = c;
                __syncthreads();
                int tot = 0;
#pragma unroll
                for (int w = 0; w < 8; ++w) tot += s_cnt[w];
                if (tot >= TOPK) T = cand;
            }
            int c = 0;
            for (int k = tid; k < n; k += 512) c += (s_key[k] > T) ? 1 : 0;
            c = wave_sum_i(c);
            __syncthreads();
            if (lane == 0) s_cnt[wid] = c;
            __syncthreads();
            int ngt = 0;
#pragma unroll
            for (int w = 0; w < 8; ++w) ngt += s_cnt[w];
            const int need = TOPK - ngt;
            if (wid == 0) {
                int base = 0, eqbase = 0;
                for (int k0 = 0; k0 < n; k0 += 64) {
                    const int k = k0 + lane;
                    const unsigned key = k < n ? s_key[k] : 0u;
                    const bool gt = (k < n) && key > T, eq = (k < n) && key == T;
                    const unsigned long long meq = __ballot(eq);
                    const unsigned long long lt = (1ull << lane) - 1ull;
                    const int eqrank = eqbase + __popcll(meq & lt);
                    const bool sel = gt || (eq && eqrank < need);
                    const unsigned long long ms = __ballot(sel);
                    if (sel) s_sel[base + __popcll(ms & lt)] = k;
                    base += __popcll(ms); eqbase += __popcll(meq);
                }
                if (lane == 0) s_n[0] = base;
            }
            __syncthreads();
            cnt = s_n[0];
        }
        __syncthreads();
        {
            const int j = tid & 255, hb = (tid >> 8) * 8;
            float sc[8];
#pragma unroll
            for (int hh = 0; hh < 8; ++hh) sc[hh] = 0.f;
            if (j < cnt) {
                const int idx = s_sel[j];
                const bf16* kr = B.CKVN + (size_t)rowof(b, idx) * 256;
                for (int r = 0; r < 256; ++r) {
                    const float v = bf2f(kr[r]);
#pragma unroll
                    for (int hh = 0; hh < 8; ++hh) sc[hh] = fmaf(s_ql[(hb + hh) * 256 + r], v, sc[hh]);
                }
                const int bk = t5_bucket(t - idx);
#pragma unroll
                for (int hh = 0; hh < 8; ++hh) s_p[(hb + hh) * 256 + j] = sc[hh] * 0.125f + A.bias_table[bk * 32 + 16 + hb + hh];
            } else {
#pragma unroll
                for (int hh = 0; hh < 8; ++hh) s_p[(hb + hh) * 256 + j] = -3.0e38f;
            }
        }
        __syncthreads();
        for (int hh = wid * 2; hh < wid * 2 + 2; ++hh) {
            float v[4]; float mx = -3.0e38f;
#pragma unroll
            for (int i = 0; i < 4; ++i) { v[i] = s_p[hh * 256 + lane + 64 * i]; mx = fmaxf(mx, v[i]); }
            mx = wave_max(mx);
            float sum = 0.f;
#pragma unroll
            for (int i = 0; i < 4; ++i) { v[i] = (lane + 64 * i < cnt) ? __expf(v[i] - mx) : 0.f; sum += v[i]; }
            sum = wave_sum(sum);
            const float inv = 1.0f / sum;
#pragma unroll
            for (int i = 0; i < 4; ++i) s_p[hh * 256 + lane + 64 * i] = bf2f((bf16)f2bf(v[i] * inv));
        }
        __syncthreads();
        {
            const int r = tid & 255, hb = (tid >> 8) * 8;
            float acc[8];
#pragma unroll
            for (int hh = 0; hh < 8; ++hh) acc[hh] = 0.f;
            for (int j = 0; j < cnt; ++j) {
                const float v = bf2f(B.CKVN[(size_t)rowof(b, s_sel[j]) * 256 + r]);
#pragma unroll
                for (int hh = 0; hh < 8; ++hh) acc[hh] = fmaf(s_p[(hb + hh) * 256 + j], v, acc[hh]);
            }
#pragma unroll
            for (int hh = 0; hh < 8; ++hh) B.OLAT[(size_t)row * 4096 + (hb + hh) * 256 + r] = (bf16)f2bf(acc[hh]);
        }
    }
    __syncthreads();
}
__device__ __forceinline__ void wuv_naive(const Ctx& C, int l) {
    const Bufs B(C.a.ws);
    const Args& A = C.a;
    const float* wuv = A.w_uv + (size_t)l * 16 * 256 * 64;
    for (int item = C.bid; item < NTOK; item += C.G) {
        const int b = item / LTOK, t = item % LTOK, row = rowof(b, t);
        for (int c = C.tid; c < 1024; c += 512) {
            const int h = c >> 6, d = c & 63;
            const bf16* o = B.OLAT + (size_t)row * 4096 + h * 256;
            float a = 0.f;
            for (int r = 0; r < 256; ++r) a = fmaf(bf2f(__builtin_nontemporal_load(o + r)), bf2f((bf16)f2bf(wuv[((size_t)h * 256 + r) * 64 + d])), a);
            const float z = bf2f(B.PROJ[(size_t)row * NP1 + PC_ZB + c]);
            B.YB[(size_t)row * 1024 + c] = (bf16)f2bf(a * siluf_(z));
        }
    }
}
__device__ __forceinline__ void final_phase(const Ctx& C) {
    const Bufs B(C.a.ws);
    const Args& A = C.a;
    for (int m = C.gw; m < 8192; m += C.NGW) {
        float s = (C.lane < 32) ? B.RS[(size_t)m * 32 + C.lane] : 0.f;
        s = wave_sum(s);
        const float r = rsqrtf(s * (1.0f / DM) + RMS_EPS);
#pragma unroll
        for (int j = 0; j < 8; ++j) { const f32x4 v = *(const f32x4*)(B.H + (size_t)m * DM + j * 256 + C.lane * 4); const f32x4 g = *(const f32x4*)(A.final_g + j * 256 + C.lane * 4);
            *(f32x4*)(A.out + (size_t)m * DM + j * 256 + C.lane * 4) = v * r * g; }
    }
}

constexpr int PH_PER_LAYER = 7, N_PHASES = 1 + NLAYER * PH_PER_LAYER + 1;
#ifndef MK_ONE_LAUNCH
#define MK_ONE_LAUNCH 1
#endif

__global__ void __launch_bounds__(NWAVES * 64, 2) fwd_kernel(Args args) {
    extern __shared__ __attribute__((aligned(16))) unsigned char lds[];
    Ctx C;
    C.lds = (LAS unsigned char*)lds; C.tid = threadIdx.x; C.lane = C.tid & 63; C.wave = __builtin_amdgcn_readfirstlane(C.tid >> 6);
    C.G = gridDim.x; C.bid = blockIdx.x; C.gw = blockIdx.x * NWAVES + C.wave; C.NGW = C.G * NWAVES; C.a = args;
    unsigned char* ws = args.ws;
    gu32* ctl = (gu32*)(ws + WS_CTL);
    for (int u = C.tid; u < (LDS_BYTES - LDSCTL_OFF) / 4; u += NWAVES * 64) ((LAS unsigned*)(C.lds + LDSCTL_OFF))[u] = 0u;
    __syncthreads();
    volatile LAS unsigned* MISC = (volatile LAS unsigned*)(C.lds + MISC_OFF);
    XcdBarrier bar; bar.bar = (unsigned*)(ctl + CW_BAR); bar.x = 0; bar.st = nullptr;
    const int lo = args.ph_lo, hi = args.ph_hi;
    const bool one = (hi - lo) > 1;
    if (one) bar = xcd_barrier_post((unsigned*)(ctl + CW_BAR), MISC + 8);
#define IN(k) (lo <= (k) && (k) < hi)
#define PHASE_BEGIN() do { int t_ = threadIdx.x; asm volatile("" : "+v"(t_)); int b_ = blockIdx.x; asm volatile("" : "+s"(b_)); C.tid = t_; C.lane = t_ & 63; C.wave = __builtin_amdgcn_readfirstlane(t_ >> 6); C.bid = b_; C.gw = b_ * NWAVES + C.wave; } while (0)
#define SEAM(k) do { if (IN((k) + 1)) xcd_barrier(bar); } while (0)
    LAS unsigned char* ring = C.lds + RING_OFF;

    if (IN(0)) { PHASE_BEGIN(); p0_prologue(C); SEAM(0); }
    for (int l = 0; l < NLAYER; ++l) {
        const int p = 1 + l * PH_PER_LAYER;
        if (IN(p)) {
            PHASE_BEGIN(); const Bufs B(ws);
            pg8::Gemm g{B.HB, B.W1 + (size_t)l * NP1 * DM, MP, NP1, DM}; pg8::StaticOrder S; S.init(MP, NP1, C.G, C.bid);
            g1_rstd_table(C, S);
            pg8::EpiProj E{B.PROJ, NP1, (const LAS float*)(C.lds + RSTD_OFF)};
            pg8::gemm_phase<pg8::EpiProj, pg8::StaticOrder, true, true>(ring, g, S, E);
            SEAM(p);
        }
        if (IN(p + 1)) { PHASE_BEGIN(); norm_phase(C, l); SEAM(p + 1); }
        if (IN(p + 2)) {
            PHASE_BEGIN(); const Bufs B(ws);
            pg8::Gemm g{B.CQN, B.W2 + (size_t)l * NQ2 * 512, MP, NQ2, 512}; pg8::StaticOrder S; S.init(MP, NQ2, C.G, C.bid);
            pg8::EpiBf16<0> E{B.Q2, NQ2, nullptr, 0, 0, 1.f};
            pg8::gemm_phase<pg8::EpiBf16<0>, pg8::StaticOrder, true, true>(ring, g, S, E);
            SEAM(p + 2);
        }
        if (IN(p + 3)) {
            PHASE_BEGIN(); swa_naive(C, l);
            PHASE_BEGIN(); dsa_naive(C, l);
            VM_WAIT(); __syncthreads();
            PHASE_BEGIN(); wuv_naive(C, l);
            SEAM(p + 3);
        }
        if (IN(p + 4)) {
            PHASE_BEGIN(); const Bufs B(ws);
            pg8::Gemm g{B.YA, B.WA + (size_t)l * DM * 1024, MP, DM, 1024}; pg8::StaticOrder S; S.init(MP, DM, C.G, C.bid);
            pg8::EpiPA E{B.PA, B.PROJ + PC_GA, NP1};
            pg8::gemm_phase<pg8::EpiPA, pg8::StaticOrder, true, true>(ring, g, S, E);
            SEAM(p + 4);
        }
        if (IN(p + 5)) {
            PHASE_BEGIN(); const Bufs B(ws);
            pg8::Gemm g{B.YB, B.WB + (size_t)l * DM * 1024, MP, DM, 1024}; pg8::StaticOrder S; S.init(MP, DM, C.G, C.bid);
            pg8::EpiMerge E{B.MG, B.PA, B.PROJ + PC_GB, NP1};
            pg8::gemm_phase<pg8::EpiMerge, pg8::StaticOrder, true, true>(ring, g, S, E);
            SEAM(p + 5);
        }
        if (IN(p + 6)) {
            PHASE_BEGIN(); const Bufs B(ws);
            pg8::Gemm g{B.MG, B.WO + (size_t)l * DM * DM, MP, DM, DM}; pg8::StaticOrder S; S.init(MP, DM, C.G, C.bid);
            pg8::EpiRes E{B.H, B.HB, B.RS};
            pg8::gemm_phase<pg8::EpiRes, pg8::StaticOrder, true, true>(ring, g, S, E);
            SEAM(p + 6);
        }
    }
    if (IN(N_PHASES - 1)) { PHASE_BEGIN(); final_phase(C); }
#undef IN
#undef SEAM
}

extern "C" void kernel_launch(void* const* d_in, const int* in_sizes, int n_in, void* d_out, int out_size, void* d_ws, size_t ws_size, hipStream_t stream) {
    static int grid = 0;
    if (grid == 0) {
        if (n_in != 16 || ws_size < WS_END) { fprintf(stderr, "kernel_launch: unexpected inputs (n_in %d, ws %zu, need %zu)\n", n_in, ws_size, (size_t)WS_END); grid = -1; return; }
        int dev = 0, cus = 0;
        if (hipGetDevice(&dev) != hipSuccess || hipDeviceGetAttribute(&cus, hipDeviceAttributeMultiprocessorCount, dev) != hipSuccess) { grid = -1; return; }
        if (hipFuncSetAttribute((const void*)fwd_kernel, hipFuncAttributeMaxDynamicSharedMemorySize, LDS_BYTES) != hipSuccess) { fprintf(stderr, "kernel_launch: hipFuncSetAttribute failed\n"); grid = -1; return; }
        int per_cu = 0;
        if (hipOccupancyMaxActiveBlocksPerMultiprocessor(&per_cu, (const void*)fwd_kernel, NWAVES * 64, LDS_BYTES) != hipSuccess || per_cu < 1) fprintf(stderr, "kernel_launch: occupancy query says %d\n", per_cu);
        (void)hipGetLastError();
        grid = cus;
    }
    if (grid < 0) return;
    if (hipMemsetAsync((char*)d_ws + WS_CTL, 0, CTL_ZERO_BYTES, stream) != hipSuccess) return;
    Args a{};
    a.x = (const float*)d_in[0]; a.meta = (const float*)d_in[1]; a.bias_table = (const float*)d_in[2]; a.norm_g = (const float*)d_in[3]; a.w_in = (const float*)d_in[4];
    a.q_norm_g = (const float*)d_in[5]; a.kv_norm_g = (const float*)d_in[6]; a.w_qb = (const float*)d_in[7]; a.w_iq = (const float*)d_in[8]; a.w_uk = (const float*)d_in[9];
    a.w_uv = (const float*)d_in[10]; a.sinks = (const float*)d_in[11]; a.w_proj_a = (const float*)d_in[12]; a.w_proj_b = (const float*)d_in[13]; a.w_out = (const float*)d_in[14];
    a.final_g = (const float*)d_in[15]; a.out = (float*)d_out; a.ws = (unsigned char*)d_ws;
#if MK_ONE_LAUNCH
    a.ph_lo = 0; a.ph_hi = N_PHASES;
    hipLaunchKernelGGL(fwd_kernel, dim3(grid), dim3(NWAVES * 64), LDS_BYTES, stream, a);
#else
    for (int p = 0; p < N_PHASES; ++p) { a.ph_lo = p; a.ph_hi = p + 1; hipLaunchKernelGGL(fwd_kernel, dim3(grid), dim3(NWAVES * 64), LDS_BYTES, stream, a); }
#endif
}
```

```cpp
#include <hip/hip_runtime.h>
#include <cstdio>
#include <cstdint>
namespace pg8 {
#define PG8_LAS __attribute__((address_space(3)))
typedef unsigned short bf16_t;
typedef short bf16x8 __attribute__((ext_vector_type(8)));
typedef float f32x4 __attribute__((ext_vector_type(4)));
typedef unsigned u32x4 __attribute__((ext_vector_type(4)));
constexpr int BM = 256, BK = 64, HALF = 128, HTB = HALF * BK * 2  , STAGE_BYTES = 8 * HTB, NXCD = 8, WGM = 8;

__host__ __device__ __forceinline__ int lds_byte(int r, int c) { const int st = (r >> 4) * 2 + (c >> 5), rr = r & 15, cc = c & 31, ob = rr * 64 + cc * 2; return st * 1024 + (ob ^ (((ob >> 9) & 1) << 5)); }
__host__ __device__ __forceinline__ void stage_rc(int b, int& R, int& C) { const int st = b / 1024, sb = b % 1024, swz = sb ^ (((sb >> 9) & 1) << 5); R = (st >> 1) * 16 + swz / 64; C = (st & 1) * 32 + (swz % 64) / 2; }
__host__ __device__ __forceinline__ int perm32(int rho) { const int n = rho >> 4, i = rho & 15; return 8 * (i >> 2) + 4 * n + (i & 3); }

struct Unit { int pm, pn; };
struct Gemm { const bf16_t* A; const bf16_t* Bt; int M, N, K; };

struct StaticOrder {
    int nM, nN, nwg, G, c;
    __host__ __device__ void init(int M, int N, int G_, int c_) { nM = M / BM; nN = N / BM; nwg = nM * nN; G = G_; c = c_; }
    __host__ __device__ bool next(int i, Unit& u) const {
        const long L = (long)i * G + c; if (L >= nwg) return false;
        int wgid = (int)L; { const int q = nwg / NXCD, r = nwg % NXCD, xcd = wgid % NXCD, off = wgid / NXCD; wgid = (xcd < r ? xcd * (q + 1) : r * (q + 1) + (xcd - r) * q) + off; }
        const int nig = WGM * nN, gid = wgid / nig, fm = gid * WGM, gsz = (nM - fm) < WGM ? (nM - fm) : WGM;
        u.pm = fm + ((wgid % nig) % gsz); u.pn = (wgid % nig) / gsz; return true;
    }
    __device__ __forceinline__ void a_ready(const Unit&) const {}
    __device__ __forceinline__ void done(const Unit&) const {}
};

__device__ __forceinline__ unsigned cvt_pk_bf16(float lo, float hi) { unsigned r; asm volatile("v_cvt_pk_bf16_f32 %0, %1, %2" : "=v"(r) : "v"(lo), "v"(hi)); return r; }
typedef float f32x2 __attribute__((ext_vector_type(2)));
__device__ __forceinline__ f32x2 gelu_pk(f32x2 v) {
    const f32x2 av = __builtin_elementwise_abs(v), d = av * 0.2316418882f + 1.0f;
    f32x2 t; t.x = __builtin_amdgcn_rcpf(d.x); t.y = __builtin_amdgcn_rcpf(d.y);
    f32x2 q = t * 0.5307027145f + (-0.7265760135f); q = q * t + 0.7107068705f; q = q * t + (-0.142248368f); q = q * t + 0.127414796f; q = q * t;
    const f32x2 s = (v * v) * (-0.72134752044f);
    f32x2 e; e.x = __builtin_amdgcn_exp2f(s.x); e.y = __builtin_amdgcn_exp2f(s.y);
    const f32x2 m = v * (q * e), r = v - m;
    f32x2 o; o.x = v.x < 0.f ? m.x : r.x; o.y = v.y < 0.f ? m.y : r.y; return o;
}

template <int ACT  > struct EpiBf16 {
    static constexpr bool PERM = true, AFTER_DRAIN = false; static_assert(ACT == 0 || ACT == 1, "EpiBf16: ACT is 0 (none) or 1 (gelu_pk)");
    bf16_t* O; int ldc; const float* bias; int split_cols; size_t split_stride; float scale0;
    __device__ __forceinline__ void operator()(const f32x4 (&acc)[2][2][4][2], const Unit& u, int ui, int wr, int wc, int fr, int fq) const {
        const int row0 = u.pm * BM + wr * 64 + fr; int colt = u.pn * BM; bf16_t* base = O;
        float sc = 1.f; if (split_cols) { const int t = colt / split_cols; base += (size_t)t * split_stride; colt -= t * split_cols; if (t == 0) sc = scale0; }
        const int col0 = colt + wc * 32 + 8 * fq, bcol0 = u.pn * BM + wc * 32 + 8 * fq;
        f32x4 bv[2][2];
#pragma unroll
        for (int bj = 0; bj < 2; ++bj)
#pragma unroll
            for (int n = 0; n < 2; ++n) bv[bj][n] = bias ? *(const f32x4*)(bias + bcol0 + bj * HALF + 4 * n) : (f32x4){0.f, 0.f, 0.f, 0.f};
#pragma unroll
        for (int ai = 0; ai < 2; ++ai)
#pragma unroll
            for (int m = 0; m < 4; ++m) { bf16_t* rowp = base + (size_t)(row0 + ai * HALF + m * 16) * ldc + col0;
#pragma unroll
                for (int bj = 0; bj < 2; ++bj) { f32x4 v0 = acc[ai][bj][m][0] + bv[bj][0], v1 = acc[ai][bj][m][1] + bv[bj][1];
                    if (ACT == 1) { f32x2 a = gelu_pk((f32x2){v0[0], v0[1]}), b = gelu_pk((f32x2){v0[2], v0[3]}), c = gelu_pk((f32x2){v1[0], v1[1]}), d = gelu_pk((f32x2){v1[2], v1[3]});
                        v0 = (f32x4){a.x, a.y, b.x, b.y}; v1 = (f32x4){c.x, c.y, d.x, d.y}; }
                    v0 = v0 * sc; v1 = v1 * sc; u32x4 w; w.x = cvt_pk_bf16(v0[0], v0[1]); w.y = cvt_pk_bf16(v0[2], v0[3]); w.z = cvt_pk_bf16(v1[0], v1[1]); w.w = cvt_pk_bf16(v1[2], v1[3]);
                    *(u32x4*)(rowp + bj * HALF) = w; } }
    }
};

template <class Epi, class Sched, bool ALIGN_EPI = false, bool SP2 = false>
__device__ __forceinline__ void gemm_phase(PG8_LAS unsigned char* lds, const Gemm g, const Sched& S, const Epi& E, int tid_in) {
    int tid_ = tid_in; asm volatile("" : "+v"(tid_));
    const int tid = tid_, wid = __builtin_amdgcn_readfirstlane(tid >> 6), lane = tid & 63, wr = wid >> 2, wc = wid & 3, fr = lane & 15, fq = lane >> 4;
    const int K = g.K, nt = K / BK;
    unsigned voffA[2], voffB[2];
#pragma unroll
    for (int i = 0; i < 2; ++i) { int R, C; stage_rc(tid * 16 + i * 8192, R, C); const int Rb = Epi::PERM ? ((R & ~31) + perm32(R & 31)) : R;
        voffA[i] = (unsigned)(R * K + C) * 2u; voffB[i] = (unsigned)(Rb * K + C) * 2u; }
    const size_t kstep = (size_t)(BK * 2);
    const size_t hstep = (size_t)HALF * K * 2;
    const size_t tstep = 2 * hstep;
    const unsigned ldsw = (unsigned)wid * 1024u;
    const int aoff = lds_byte(wr * 64 + fr, fq * 8), boff = lds_byte(wc * 32 + fr, fq * 8);
#define PG8_SA(b, h) (((b) * 2 + (h)) * HTB)
#define PG8_SB(b, h) ((4 + (b) * 2 + (h)) * HTB)
#define PG8_STAGE(bufoff, gbase, voff) do { _Pragma("unroll") for (int _i = 0; _i < 2; ++_i) \
        __builtin_amdgcn_global_load_lds((const unsigned*)((const char*)(gbase) + (voff)[_i]), (PG8_LAS unsigned*)(lds + (bufoff) + ldsw + _i * 8192), 16, 0, 0); } while (0)
#define PG8_LDA(dst, b, h) do { _Pragma("unroll") for (int m = 0; m < 4; ++m) _Pragma("unroll") for (int k = 0; k < 2; ++k) dst[m][k] = *(const PG8_LAS bf16x8*)(lds + PG8_SA(b, h) + aoff + m * 2048 + k * 1024); } while (0)
#define PG8_LDB(dst, b, h) do { _Pragma("unroll") for (int n = 0; n < 2; ++n) _Pragma("unroll") for (int k = 0; k < 2; ++k) dst[n][k] = *(const PG8_LAS bf16x8*)(lds + PG8_SB(b, h) + boff + n * 2048 + k * 1024); } while (0)
#define PG8_MMA(ai, bj, At, Bt) do { __builtin_amdgcn_s_setprio(1); _Pragma("unroll") for (int m = 0; m < 4; ++m) _Pragma("unroll") for (int n = 0; n < 2; ++n) _Pragma("unroll") for (int k = 0; k < 2; ++k) \
        acc[ai][bj][m][n] = __builtin_amdgcn_mfma_f32_16x16x32_bf16(Bt[n][k], At[m][k], acc[ai][bj][m][n], 0, 0, 0); __builtin_amdgcn_s_setprio(0); } while (0)
#define PG8_WAIT_V(n) asm volatile("s_waitcnt vmcnt(" #n ")" ::: "memory")
#define PG8_WAIT_L(n) asm volatile("s_waitcnt lgkmcnt(" #n ")" ::: "memory")
#define PG8_BAR __builtin_amdgcn_s_barrier()
#define PG8_SCHED __builtin_amdgcn_sched_barrier(0)
    Unit cur, nxt; int ui = 0;
    if (!S.next(0, cur)) return;
    f32x4 acc[2][2][4][2];
#pragma unroll
    for (int a = 0; a < 2; ++a)
#pragma unroll
        for (int b = 0; b < 2; ++b)
#pragma unroll
            for (int m = 0; m < 4; ++m)
#pragma unroll
                for (int n = 0; n < 2; ++n) acc[a][b][m][n] = (f32x4){0.f, 0.f, 0.f, 0.f};
    bf16x8 At[4][2], B0[2][2], B1[2][2];
    const char* cA = (const char*)g.A + (size_t)cur.pm * tstep; const char* cB = (const char*)g.Bt + (size_t)cur.pn * tstep;
    S.a_ready(cur);
    if constexpr (SP2) {
        PG8_STAGE(PG8_SB(0, 0), cB, voffB); PG8_STAGE(PG8_SB(0, 1), cB + hstep, voffB); PG8_STAGE(PG8_SA(0, 0), cA, voffA); PG8_STAGE(PG8_SA(0, 1), cA + hstep, voffA);
        if (wr == 1) PG8_BAR;
        PG8_WAIT_V(2); PG8_BAR;
        PG8_STAGE(PG8_SB(1, 0), cB + kstep, voffB); PG8_STAGE(PG8_SA(1, 0), cA + kstep, voffA); PG8_STAGE(PG8_SB(1, 1), cB + hstep + kstep, voffB);
        PG8_WAIT_V(6); PG8_BAR;
    } else {
        PG8_STAGE(PG8_SB(0, 0), cB, voffB); PG8_STAGE(PG8_SA(0, 0), cA, voffA); PG8_STAGE(PG8_SB(0, 1), cB + hstep, voffB); PG8_STAGE(PG8_SA(0, 1), cA + hstep, voffA);
        if (wr == 1) PG8_BAR;
        PG8_WAIT_V(4); PG8_BAR;
        PG8_STAGE(PG8_SB(1, 0), cB + kstep, voffB); PG8_STAGE(PG8_SA(1, 0), cA + kstep, voffA); PG8_STAGE(PG8_SB(1, 1), cB + hstep + kstep, voffB);
        PG8_WAIT_V(6); PG8_BAR;
    }
    for (;;) {
        const bool has_next = S.next(ui + 1, nxt);
        const char* nA = has_next ? (const char*)g.A + (size_t)nxt.pm * tstep : cA; const char* nB = has_next ? (const char*)g.Bt + (size_t)nxt.pn * tstep : cB;
        for (int t = 0; t < nt; t += 2) {
            const bool last = (t == nt - 2);
            const char* a1 = cA + (size_t)(t + 1) * kstep;
            const char* a2 = last ? nA : cA + (size_t)(t + 2) * kstep; const char* b2 = last ? nB : cB + (size_t)(t + 2) * kstep;
            const char* a3 = a2 + kstep; const char* b3 = b2 + kstep;
            if (last && has_next) S.a_ready(nxt);
            if constexpr (SP2) {
            PG8_LDB(B0, 0, 0); PG8_LDB(B1, 0, 1); PG8_SCHED; PG8_LDA(At, 0, 0); PG8_STAGE(PG8_SA(1, 1), a1 + hstep, voffA);
            PG8_WAIT_V(8); PG8_WAIT_L(0); PG8_BAR; PG8_MMA(0, 0, At, B0); PG8_MMA(0, 1, At, B1); PG8_BAR; PG8_SCHED;
            PG8_LDA(At, 0, 1); PG8_STAGE(PG8_SB(0, 0), b2, voffB); PG8_STAGE(PG8_SB(0, 1), b2 + hstep, voffB); PG8_STAGE(PG8_SA(0, 0), a2, voffA);
            PG8_WAIT_V(8); PG8_WAIT_L(0); PG8_BAR; PG8_MMA(1, 0, At, B0); PG8_MMA(1, 1, At, B1); PG8_BAR; PG8_SCHED;
            PG8_LDB(B0, 1, 0); PG8_LDB(B1, 1, 1); PG8_SCHED; PG8_LDA(At, 1, 0); PG8_STAGE(PG8_SA(0, 1), a2 + hstep, voffA);
            PG8_WAIT_V(8); PG8_WAIT_L(0); PG8_BAR; PG8_MMA(0, 0, At, B0); PG8_MMA(0, 1, At, B1); PG8_BAR; PG8_SCHED;
            PG8_LDA(At, 1, 1); PG8_STAGE(PG8_SB(1, 0), b3, voffB); PG8_STAGE(PG8_SB(1, 1), b3 + hstep, voffB); PG8_STAGE(PG8_SA(1, 0), a3, voffA);
            PG8_WAIT_V(8); PG8_WAIT_L(0); PG8_BAR; PG8_MMA(1, 0, At, B0); PG8_MMA(1, 1, At, B1); PG8_BAR; PG8_SCHED;
            } else {
            PG8_LDB(B0, 0, 0); PG8_SCHED; PG8_LDA(At, 0, 0); PG8_STAGE(PG8_SA(1, 1), a1 + hstep, voffA);
            PG8_WAIT_L(8); PG8_BAR; PG8_WAIT_L(0); PG8_MMA(0, 0, At, B0); PG8_BAR; PG8_SCHED;
            PG8_LDB(B1, 0, 1); PG8_STAGE(PG8_SB(0, 0), b2, voffB);
            PG8_BAR; PG8_WAIT_L(0); PG8_MMA(0, 1, At, B1); PG8_BAR;
            PG8_LDA(At, 0, 1); PG8_STAGE(PG8_SA(0, 0), a2, voffA);
            PG8_BAR; PG8_WAIT_L(0); PG8_MMA(1, 0, At, B0); PG8_BAR; PG8_SCHED;
            PG8_STAGE(PG8_SB(0, 1), b2 + hstep, voffB);
            PG8_WAIT_V(6); PG8_BAR; PG8_MMA(1, 1, At, B1); PG8_BAR;
            PG8_LDB(B0, 1, 0); PG8_SCHED; PG8_LDA(At, 1, 0); PG8_STAGE(PG8_SA(0, 1), a2 + hstep, voffA);
            PG8_WAIT_L(8); PG8_BAR; PG8_WAIT_L(0); PG8_MMA(0, 0, At, B0); PG8_BAR; PG8_SCHED;
            PG8_LDB(B1, 1, 1); PG8_STAGE(PG8_SB(1, 0), b3, voffB);
            PG8_BAR; PG8_WAIT_L(0); PG8_MMA(0, 1, At, B1); PG8_BAR;
            PG8_LDA(At, 1, 1); PG8_STAGE(PG8_SA(1, 0), a3, voffA);
            PG8_BAR; PG8_WAIT_L(0); PG8_MMA(1, 0, At, B0); PG8_BAR; PG8_SCHED;
            PG8_STAGE(PG8_SB(1, 1), b3 + hstep, voffB);
            PG8_WAIT_V(6); PG8_BAR; PG8_MMA(1, 1, At, B1); PG8_BAR;
            }
        }
        if constexpr (ALIGN_EPI) { if (wr == 0) PG8_BAR; }
        if constexpr (!Epi::AFTER_DRAIN) { E(acc, cur, ui, wr, wc, fr, fq); S.done(cur); }
        if (!has_next) break;
#pragma unroll
        for (int a = 0; a < 2; ++a)
#pragma unroll
            for (int b = 0; b < 2; ++b)
#pragma unroll
                for (int m = 0; m < 4; ++m)
#pragma unroll
                    for (int n = 0; n < 2; ++n) acc[a][b][m][n] = (f32x4){0.f, 0.f, 0.f, 0.f};
        cur = nxt; cA = nA; cB = nB; ++ui;
        if constexpr (ALIGN_EPI) { if (wr == 1) PG8_BAR; }
    }
    PG8_WAIT_V(0);
    if constexpr (!ALIGN_EPI) { if (wr == 0) PG8_BAR; }
    PG8_BAR;
    if constexpr (Epi::AFTER_DRAIN) { E.fused(acc, cur, wr, wc, fr, fq, lds, wid, lane); S.done(cur); }
#undef PG8_SA
#undef PG8_SB
#undef PG8_STAGE
#undef PG8_LDA
#undef PG8_LDB
#undef PG8_MMA
#undef PG8_WAIT_V
#undef PG8_WAIT_L
#undef PG8_BAR
#undef PG8_SCHED
}
}
namespace pg8 {
__device__ __forceinline__ float bf_lo(unsigned w) { return __uint_as_float(w << 16); }
__device__ __forceinline__ float bf_hi(unsigned w) { return __uint_as_float(w & 0xffff0000u); }
__device__ __forceinline__ float sigm(float x) { return 1.0f / (1.0f + __expf(-x)); }
typedef unsigned u32x2 __attribute__((ext_vector_type(2)));

struct EpiProj {
    static constexpr bool PERM = true, AFTER_DRAIN = false;
    bf16_t* O; int ldc; const PG8_LAS float* rstd;
    __device__ __forceinline__ void operator()(const f32x4 (&acc)[2][2][4][2], const Unit& u, int ui, int wr, int wc, int fr, int fq) const {
        const int rt0 = wr * 64 + fr, col0 = u.pn * BM + wc * 32 + 8 * fq;
#pragma unroll
        for (int ai = 0; ai < 2; ++ai)
#pragma unroll
            for (int m = 0; m < 4; ++m) { const int rt = rt0 + ai * HALF + m * 16; const float s = rstd[ui * 256 + rt]; bf16_t* rowp = O + (size_t)(u.pm * BM + rt) * ldc + col0;
#pragma unroll
                for (int bj = 0; bj < 2; ++bj) { const f32x4 v0 = acc[ai][bj][m][0] * s, v1 = acc[ai][bj][m][1] * s;
                    u32x4 w; w.x = cvt_pk_bf16(v0[0], v0[1]); w.y = cvt_pk_bf16(v0[2], v0[3]); w.z = cvt_pk_bf16(v1[0], v1[1]); w.w = cvt_pk_bf16(v1[2], v1[3]);
                    *(u32x4*)(rowp + bj * HALF) = w; } }
    }
};
struct EpiPA {
    static constexpr bool PERM = false, AFTER_DRAIN = false;
    float* P; const bf16_t* G; int ldg;
    __device__ __forceinline__ void operator()(const f32x4 (&acc)[2][2][4][2], const Unit& u, int ui, int wr, int wc, int fr, int fq) const {
        const int col0 = u.pn * BM + wc * 32 + 4 * fq;
#pragma unroll
        for (int ai = 0; ai < 2; ++ai)
#pragma unroll
            for (int m = 0; m < 4; ++m) { const int row = u.pm * BM + ai * HALF + wr * 64 + m * 16 + fr;
#pragma unroll
                for (int bj = 0; bj < 2; ++bj)
#pragma unroll
                    for (int n = 0; n < 2; ++n) { const int c = col0 + bj * HALF + n * 16; const u32x2 g = *(const u32x2*)(G + (size_t)row * ldg + c);
                        f32x4 v = acc[ai][bj][m][n]; v[0] *= sigm(bf_lo(g.x)); v[1] *= sigm(bf_hi(g.x)); v[2] *= sigm(bf_lo(g.y)); v[3] *= sigm(bf_hi(g.y));
                        *(f32x4*)(P + (size_t)row * 2048 + c) = v; } }
    }
};
struct EpiMerge {
    static constexpr bool PERM = true, AFTER_DRAIN = false;
    bf16_t* O; const float* P; const bf16_t* G; int ldg;
    __device__ __forceinline__ void operator()(const f32x4 (&acc)[2][2][4][2], const Unit& u, int ui, int wr, int wc, int fr, int fq) const {
        const int col0 = u.pn * BM + wc * 32 + 8 * fq;
#pragma unroll
        for (int ai = 0; ai < 2; ++ai)
#pragma unroll
            for (int m = 0; m < 4; ++m) { const int row = u.pm * BM + ai * HALF + wr * 64 + m * 16 + fr;
#pragma unroll
                for (int bj = 0; bj < 2; ++bj) { const int c = col0 + bj * HALF; const u32x4 g = *(const u32x4*)(G + (size_t)row * ldg + c);
                    const f32x4 p0 = *(const f32x4*)(P + (size_t)row * 2048 + c), p1 = *(const f32x4*)(P + (size_t)row * 2048 + c + 4);
                    f32x4 v0 = acc[ai][bj][m][0], v1 = acc[ai][bj][m][1];
                    v0[0] = p0[0] + sigm(bf_lo(g.x)) * v0[0]; v0[1] = p0[1] + sigm(bf_hi(g.x)) * v0[1]; v0[2] = p0[2] + sigm(bf_lo(g.y)) * v0[2]; v0[3] = p0[3] + sigm(bf_hi(g.y)) * v0[3];
                    v1[0] = p1[0] + sigm(bf_lo(g.z)) * v1[0]; v1[1] = p1[1] + sigm(bf_hi(g.z)) * v1[1]; v1[2] = p1[2] + sigm(bf_lo(g.w)) * v1[2]; v1[3] = p1[3] + sigm(bf_hi(g.w)) * v1[3];
                    u32x4 w; w.x = cvt_pk_bf16(v0[0], v0[1]); w.y = cvt_pk_bf16(v0[2], v0[3]); w.z = cvt_pk_bf16(v1[0], v1[1]); w.w = cvt_pk_bf16(v1[2], v1[3]);
                    *(u32x4*)(O + (size_t)row * 2048 + c) = w; } }
    }
};
struct EpiRes {
    static constexpr bool PERM = false, AFTER_DRAIN = false;
    float* H; bf16_t* HB; float* RS;
    __device__ __forceinline__ void operator()(const f32x4 (&acc)[2][2][4][2], const Unit& u, int ui, int wr, int wc, int fr, int fq) const {
        const int col0 = u.pn * BM + wc * 32 + 4 * fq;
#pragma unroll
        for (int ai = 0; ai < 2; ++ai)
#pragma unroll
            for (int m = 0; m < 4; ++m) { const int row = u.pm * BM + ai * HALF + wr * 64 + m * 16 + fr; float ss = 0.f;
#pragma unroll
                for (int bj = 0; bj < 2; ++bj)
#pragma unroll
                    for (int n = 0; n < 2; ++n) { const size_t off = (size_t)row * 2048 + col0 + bj * HALF + n * 16;
                        f32x4 hv = *(const f32x4*)(H + off); hv += acc[ai][bj][m][n]; *(f32x4*)(H + off) = hv;
                        u32x2 w; w.x = cvt_pk_bf16(hv[0], hv[1]); w.y = cvt_pk_bf16(hv[2], hv[3]); *(u32x2*)(HB + off) = w;
                        ss += (hv[0] * hv[0] + hv[1] * hv[1]) + (hv[2] * hv[2] + hv[3] * hv[3]); }
                ss += __shfl_xor(ss, 16); ss += __shfl_xor(ss, 32);
                if (fq == 0) RS[(size_t)row * 32 + u.pn * 4 + wc] = ss; }
    }
};
}

#define GAS __attribute__((address_space(1)))
#define LAS __attribute__((address_space(3)))
typedef unsigned short bf16;
typedef unsigned v4u __attribute__((ext_vector_type(4)));
typedef float f32x4 __attribute__((ext_vector_type(4)));
typedef short bf16x8 __attribute__((ext_vector_type(8)));
typedef GAS unsigned gu32;
typedef GAS unsigned long long gu64;
#define RLX_AGENT __ATOMIC_RELAXED, __HIP_MEMORY_SCOPE_AGENT
#define LDS_WAIT() asm volatile("s_waitcnt lgkmcnt(0)" ::: "memory")
#define VM_WAIT() asm volatile("s_waitcnt vmcnt(0)" ::: "memory")
__device__ __forceinline__ unsigned long long rt() { return __builtin_amdgcn_s_memrealtime(); }
__device__ __forceinline__ unsigned f2bf(float f) { unsigned u = __builtin_bit_cast(unsigned, f); return (u + 0x7fffu + ((u >> 16) & 1u)) >> 16; }
__device__ __forceinline__ unsigned pk2(float lo, float hi) { return f2bf(lo) | (f2bf(hi) << 16); }

#define XB_TMO      128
#define XB_XCNT(j)  (256  + 64 * (j))
#define XB_XSUB(j)  (1280 + 64 * (j))
#define XB_XGEN(j)  (2304 + 64 * (j))
#define XB_TOP      3328
#define XB_TOPGEN   3392
#define XCD_BAR_WORDS 3456
#define XB_SPIN_CAP (1u << 18)

__device__ __forceinline__ unsigned xb_ld(unsigned* p)              { return __hip_atomic_load(p, __ATOMIC_RELAXED, __HIP_MEMORY_SCOPE_AGENT); }
__device__ __forceinline__ unsigned xb_add(unsigned* p, unsigned v) { return __hip_atomic_fetch_add(p, v, __ATOMIC_RELAXED, __HIP_MEMORY_SCOPE_AGENT); }
__device__ __forceinline__ unsigned xb_xcc_id() { return (unsigned)__builtin_amdgcn_s_getreg((3 << 11) | 20) & 0xFu; }
#define XB_SPIN(cond, bar) do { unsigned _sp = 0; while (cond) { __builtin_amdgcn_s_sleep(1); \
    if ((++_sp & 255u) == 0u) { if (xb_ld(&(bar)[XB_TMO])) break; if (_sp > XB_SPIN_CAP) { atomicAdd(&(bar)[XB_TMO], 1u); break; } } } } while (0)

struct XcdBarrier {
    unsigned* bar; unsigned x;
    volatile LAS unsigned* st;
};

__device__ __forceinline__ XcdBarrier xcd_barrier_post(unsigned* bar, volatile LAS unsigned* st) {
    XcdBarrier b; b.bar = bar; b.x = xb_xcc_id(); b.st = st;
    if (threadIdx.x == 0) (void)xb_add(&bar[XB_XCNT(b.x)], 1u);
    return b;
}
__device__ __forceinline__ void xcd_barrier_complete(unsigned* bar, unsigned x, unsigned& nloc, unsigned& nx) {
    const unsigned G = gridDim.x * gridDim.y * gridDim.z;
    unsigned sum, cnt, mine, sp = 0u;
    for (;;) {
        sum = 0u; cnt = 0u; mine = 0u;
#pragma unroll
        for (unsigned j = 0; j < 16; ++j) { const unsigned c = xb_ld(&bar[XB_XCNT(j)]); sum += c; cnt += (c > 0u) ? 1u : 0u; mine = (j == x) ? c : mine; }
        if (sum == G) break;
        __builtin_amdgcn_s_sleep(1);
        if ((++sp & 255u) == 0u) { if (xb_ld(&bar[XB_TMO])) break; if (sp > XB_SPIN_CAP) { atomicAdd(&bar[XB_TMO], 1u); break; } }
    }
    nloc = mine > 0u ? mine : 1u; nx = cnt > 0u ? cnt : 1u;
}

__device__ __forceinline__ void xcd_barrier(const XcdBarrier& b) {
    asm volatile("s_waitcnt vmcnt(0)" ::: "memory");
    __syncthreads();
    if (threadIdx.x == 0) {
        unsigned* bar = b.bar;
        __builtin_amdgcn_s_waitcnt(0);
        unsigned nloc = b.st[0], nx = b.st[1];
        if (nloc == 0u) { xcd_barrier_complete(bar, b.x, nloc, nx); b.st[0] = nloc; b.st[1] = nx; }
        const unsigned old = xb_add(&bar[XB_XSUB(b.x)], 1u);
        const unsigned gen = old / nloc;
        if (old + 1u == (gen + 1u) * nloc) {
            __builtin_amdgcn_fence(__ATOMIC_RELEASE, "agent");
            asm volatile("s_waitcnt vmcnt(0)" ::: "memory");
            const unsigned og = xb_add(&bar[XB_TOP], 1u);
            const unsigned tg = og / nx;
            if (og + 1u == (tg + 1u) * nx) xb_add(&bar[XB_TOPGEN], 1u);
            else XB_SPIN(xb_ld(&bar[XB_TOPGEN]) == tg, bar);
            __builtin_amdgcn_fence(__ATOMIC_ACQUIRE, "agent");
            xb_add(&bar[XB_XGEN(b.x)], 1u);
            asm volatile("s_waitcnt vmcnt(0)" ::: "memory");
        } else {
            XB_SPIN(xb_ld(&bar[XB_XGEN(b.x)]) == gen, bar);
            __builtin_amdgcn_fence(__ATOMIC_ACQUIRE, "agent");
            asm volatile("s_waitcnt vmcnt(0)" ::: "memory");
        }
    }
    __syncthreads();
}
constexpr int NWAVES = 8;
constexpr int NLAYER = 4, DM = 2048, NBATCH = 2, SEQ = 4096, NMETA = 16, LTOK = SEQ + NMETA, NTOK = NBATCH * LTOK;
constexpr int MP = 8448;
constexpr int NP1 = 8448;
constexpr int NC_IN = 8264;
constexpr int PC_QA = 0, PC_KA = 1024, PC_VA = 1152, PC_ZA = 1280, PC_CQ = 2304, PC_CKV = 2816, PC_ZB = 3072, PC_GA = 4096, PC_GB = 6144, PC_KIDX = 8192, PC_WIDX = 8256;
constexpr int NQ2 = 4608;
constexpr int TOPK = 256;
constexpr float RMS_EPS = 1e-6f;

__device__ __forceinline__ int rowof(int b, int t) { return t < NMETA ? 8192 + b * NMETA + t : b * SEQ + (t - NMETA); }
__device__ __forceinline__ int t5_bucket(int d) {
    const int n = d < 0 ? 0 : d;
    if (n < 16) return n;
    return 16 + (n >= 19) + (n >= 21) + (n >= 24) + (n >= 27) + (n >= 31) + (n >= 35) + (n >= 40) + (n >= 46) + (n >= 52) + (n >= 59) + (n >= 67) + (n >= 77) + (n >= 87) + (n >= 99) + (n >= 113);
}
__device__ __forceinline__ float bf2f(bf16 v) { return __uint_as_float((unsigned)v << 16); }
__device__ __forceinline__ float sigmoidf_(float x) { return 1.0f / (1.0f + __expf(-x)); }
__device__ __forceinline__ float siluf_(float x) { return x / (1.0f + __expf(-x)); }
__device__ __forceinline__ float wave_sum(float v) {
#pragma unroll
    for (int o = 1; o < 64; o <<= 1) v += __shfl_xor(v, o);
    return v;
}
__device__ __forceinline__ float wave_max(float v) {
#pragma unroll
    for (int o = 1; o < 64; o <<= 1) v = fmaxf(v, __shfl_xor(v, o));
    return v;
}
__device__ __forceinline__ int wave_sum_i(int v) {
#pragma unroll
    for (int o = 1; o < 64; o <<= 1) v += __shfl_xor(v, o);
    return v;
}

constexpr size_t MiB = 1u << 20;
constexpr size_t WS_CTL = 0, CTL_ZERO_BYTES = 1 * MiB;
constexpr size_t SZ_W1 = (size_t)NLAYER * NP1 * DM * 2, SZ_W2 = (size_t)NLAYER * NQ2 * 512 * 2, SZ_WA = (size_t)NLAYER * DM * 1024 * 2, SZ_WO = (size_t)NLAYER * DM * DM * 2;
constexpr size_t al(size_t x) { return (x + 4095) / 4096 * 4096; }
constexpr size_t WS_W1 = 1 * MiB, WS_W2 = WS_W1 + al(SZ_W1), WS_WA = WS_W2 + al(SZ_W2), WS_WB = WS_WA + al(SZ_WA), WS_WO = WS_WB + al(SZ_WA);
constexpr size_t SZ_WUV = (size_t)NLAYER * 16 * 64 * 256 * 2;
constexpr size_t WS_WUV = WS_WO + al(SZ_WO);
constexpr size_t WS_VT = WS_WUV + al(SZ_WUV);
constexpr size_t WS_H = WS_VT + al((size_t)2 * 128 * 4128 * 2), WS_HB = WS_H + al((size_t)MP * DM * 4), WS_RS = WS_HB + al((size_t)MP * DM * 2);
constexpr size_t WS_PROJ = WS_RS + al((size_t)MP * 32 * 4), WS_CQN = WS_PROJ + al((size_t)MP * NP1 * 2), WS_CKVN = WS_CQN + al((size_t)MP * 512 * 2);
constexpr size_t WS_Q2 = WS_CKVN + al((size_t)MP * 256 * 2), WS_OLAT = WS_Q2 + al((size_t)MP * NQ2 * 2), WS_YA = WS_OLAT + al((size_t)MP * 4096 * 2);
constexpr size_t WS_YB = WS_YA + al((size_t)MP * 1024 * 2), WS_PA = WS_YB + al((size_t)MP * 1024 * 2), WS_MG = WS_PA + al((size_t)MP * DM * 4), WS_END = WS_MG + al((size_t)MP * DM * 2);
constexpr int CW_TMO = 0, CW_CODE = 1, CW_BAR = 4096;

constexpr int LDSCTL_OFF = 0, MISC_OFF = LDSCTL_OFF + 320;
constexpr int RSTD_OFF = 512;
constexpr int RING_OFF = 8192, RING_BYTES = 131072;
constexpr int LDS_BYTES = 163840;
static_assert(RSTD_OFF + 5 * 256 * 4 <= RING_OFF, "LDS map");

struct Args {
    const float* x; const float* meta; const float* bias_table; const float* norm_g; const float* w_in; const float* q_norm_g; const float* kv_norm_g; const float* w_qb; const float* w_iq;
    const float* w_uk; const float* w_uv; const float* sinks; const float* w_proj_a; const float* w_proj_b; const float* w_out; const float* final_g;
    float* out; unsigned char* ws; int ph_lo, ph_hi;
};

__device__ __forceinline__ void xpose_item(const float* __restrict__ W, int ldw, int k0, int c0, int nvalid, const float* __restrict__ scale, bf16* out, int K, LAS float* scr, int lane) {
    const int c = lane & 31;
#pragma unroll 8
    for (int i = 0; i < 32; ++i) { const int kk = 2 * i + (lane >> 5); float v = (c < nvalid) ? W[(size_t)(k0 + kk) * ldw + c0 + c] : 0.f; if (scale) v *= scale[k0 + kk]; scr[kk * 33 + c] = v; }
    LDS_WAIT(); asm volatile("" ::: "memory");
    const int cc = lane & 7;
#pragma unroll
    for (int j = 0; j < 4; ++j) { const int n = (lane >> 3) + 8 * j; const LAS float* s = scr + (8 * cc) * 33 + n;
        v4u o; o.x = pk2(s[0 * 33], s[1 * 33]); o.y = pk2(s[2 * 33], s[3 * 33]); o.z = pk2(s[4 * 33], s[5 * 33]); o.w = pk2(s[6 * 33], s[7 * 33]);
        *(GAS v4u*)(out + (size_t)n * K + k0 + 8 * cc) = o; }
    LDS_WAIT(); asm volatile("" ::: "memory");
}
__device__ __forceinline__ void fold_item(const float* __restrict__ wqb, const float* __restrict__ wuk, const float* __restrict__ gq, bf16* W2l, int h, int kb, int rb, LAS float* scr, int lane) {
    const int rr = lane & 31, r = rb * 32 + rr;
    float uk[64];
#pragma unroll
    for (int d = 0; d < 64; ++d) uk[d] = wuk[((size_t)h * 64 + d) * 256 + r];
    for (int i = 0; i < 32; ++i) { const int kk = 2 * i + (lane >> 5), k = kb * 64 + kk; const f32x4* qp = (const f32x4*)(wqb + (size_t)k * 1024 + h * 64); float a = 0.f;
#pragma unroll
        for (int d4 = 0; d4 < 16; ++d4) { const f32x4 q = qp[d4]; a = fmaf(q[0], uk[4 * d4], a); a = fmaf(q[1], uk[4 * d4 + 1], a); a = fmaf(q[2], uk[4 * d4 + 2], a); a = fmaf(q[3], uk[4 * d4 + 3], a); }
        scr[kk * 33 + rr] = a * gq[k]; }
    LDS_WAIT(); asm volatile("" ::: "memory");
    const int cc = lane & 7; bf16* out = W2l + (size_t)(h * 256 + rb * 32) * 512;
#pragma unroll
    for (int j = 0; j < 4; ++j) { const int n = (lane >> 3) + 8 * j; const LAS float* s = scr + (8 * cc) * 33 + n;
        v4u o; o.x = pk2(s[0 * 33], s[1 * 33]); o.y = pk2(s[2 * 33], s[3 * 33]); o.z = pk2(s[4 * 33], s[5 * 33]); o.w = pk2(s[6 * 33], s[7 * 33]);
        *(GAS v4u*)(out + (size_t)n * 512 + kb * 64 + 8 * cc) = o; }
    LDS_WAIT(); asm volatile("" ::: "memory");
}

struct Ctx {
    LAS unsigned char* lds; int tid, lane, wave, G, gw, NGW, bid;
    Args a;
};
__device__ __forceinline__ unsigned char* launder(unsigned char* p) { asm volatile("" : "+s"(p)); return p; }
__device__ __forceinline__ const float* launderf(const float* p) { asm volatile("" : "+s"(p)); return p; }
struct Bufs {
    bf16 *W1, *W2, *WA, *WB, *WO, *WUV, *VT, *HB, *PROJ, *CQN, *CKVN, *Q2, *OLAT, *YA, *YB, *MG; float *H, *RS, *PA;
    __device__ __forceinline__ explicit Bufs(unsigned char* ws0) {
        unsigned char* ws = launder(ws0);
        W1 = (bf16*)(ws + WS_W1); W2 = (bf16*)(ws + WS_W2); WA = (bf16*)(ws + WS_WA); WB = (bf16*)(ws + WS_WB); WO = (bf16*)(ws + WS_WO); WUV = (bf16*)(ws + WS_WUV); VT = (bf16*)(ws + WS_VT);
        H = (float*)(ws + WS_H); HB = (bf16*)(ws + WS_HB); RS = (float*)(ws + WS_RS); PROJ = (bf16*)(ws + WS_PROJ); CQN = (bf16*)(ws + WS_CQN); CKVN = (bf16*)(ws + WS_CKVN);
        Q2 = (bf16*)(ws + WS_Q2); OLAT = (bf16*)(ws + WS_OLAT); YA = (bf16*)(ws + WS_YA); YB = (bf16*)(ws + WS_YB); PA = (float*)(ws + WS_PA); MG = (bf16*)(ws + WS_MG);
    }
};

__device__ __forceinline__ void p0_prologue(const Ctx& C) {
    const Bufs B(C.a.ws);
    const Args& A = C.a;
    LAS float* scr = (LAS float*)(C.lds + RING_OFF + C.wave * 16384);
    constexpr int I_T1 = (DM / 64) * (NP1 / 32), I_T2 = (512 / 64) * (512 / 32), I_T3 = (1024 / 64) * (DM / 32), I_T5 = (DM / 64) * (DM / 32), I_F = 16 * 8 * 8, I_UV = 16 * 4 * 2;
    constexpr int I_LAYER = I_T1 + I_T2 + 2 * I_T3 + I_T5 + I_F + I_UV, NITEMS = NLAYER * I_LAYER;
    for (int it = C.gw; it < NITEMS; it += C.NGW) {
        const int l = it / I_LAYER; int r = it % I_LAYER;
        if (r < I_T1) { const int nblk = NP1 / 32, kb = r / nblk, nb = r % nblk, n0 = nb * 32;
            int c0, nvalid = 32;
            if (n0 < 4096) c0 = n0; else if (n0 < 8192) c0 = n0 + 72; else { c0 = n0 - 8192 + 4096; nvalid = NC_IN - 4096 - 72 - 4096 + 0; nvalid = (8264 - n0) < 0 ? 0 : ((8264 - n0) > 32 ? 32 : (8264 - n0)); }
            xpose_item(A.w_in + (size_t)l * DM * NC_IN, NC_IN, kb * 64, c0, nvalid, A.norm_g + l * DM, B.W1 + ((size_t)l * NP1 + n0) * DM, DM, scr, C.lane); continue; }
        r -= I_T1;
        if (r < I_T2) { const int nblk = 512 / 32, kb = r / nblk, nb = r % nblk;
            xpose_item(A.w_iq + (size_t)l * 512 * 512, 512, kb * 64, nb * 32, 32, A.q_norm_g + l * 512, B.W2 + ((size_t)l * NQ2 + 4096 + nb * 32) * 512, 512, scr, C.lane); continue; }
        r -= I_T2;
        if (r < I_T3) { const int nblk = DM / 32, kb = r / nblk, nb = r % nblk;
            xpose_item(A.w_proj_a + (size_t)l * 1024 * DM, DM, kb * 64, nb * 32, 32, nullptr, B.WA + ((size_t)l * DM + nb * 32) * 1024, 1024, scr, C.lane); continue; }
        r -= I_T3;
        if (r < I_T3) { const int nblk = DM / 32, kb = r / nblk, nb = r % nblk;
            xpose_item(A.w_proj_b + (size_t)l * 1024 * DM, DM, kb * 64, nb * 32, 32, nullptr, B.WB + ((size_t)l * DM + nb * 32) * 1024, 1024, scr, C.lane); continue; }
        r -= I_T3;
        if (r < I_T5) { const int nblk = DM / 32, kb = r / nblk, nb = r % nblk;
            xpose_item(A.w_out + (size_t)l * DM * DM, DM, kb * 64, nb * 32, 32, nullptr, B.WO + ((size_t)l * DM + nb * 32) * DM, DM, scr, C.lane); continue; }
        r -= I_T5;
        if (r >= I_F) { r -= I_F; const int h = r / 8, kb = (r / 2) % 4, nb = r % 2;
            xpose_item(A.w_uv + ((size_t)l * 16 + h) * 256 * 64, 64, kb * 64, nb * 32, 32, nullptr, B.WUV + (((size_t)l * 16 + h) * 64 + nb * 32) * 256, 256, scr, C.lane); continue; }
        { const int h = r / 64, kb = (r / 8) % 8, rb = r % 8;
            fold_item(A.w_qb + (size_t)l * 512 * 1024, A.w_uk + (size_t)l * 16 * 64 * 256, A.q_norm_g + l * 512, B.W2 + (size_t)l * NQ2 * 512, h, kb, rb, scr, C.lane); }
    }
    for (int m = C.gw; m < MP; m += C.NGW) {
        const float* src = nullptr;
        if (m < 8192) src = A.x + (size_t)m * DM; else if (m < 8224) src = A.meta + (size_t)((m - 8192) % NMETA) * DM;
        float ss = 0.f;
#pragma unroll
        for (int j = 0; j < 8; ++j) { f32x4 v = src ? *(const f32x4*)(src + j * 256 + C.lane * 4) : (f32x4){0.f, 0.f, 0.f, 0.f};
            *(f32x4*)(B.H + (size_t)m * DM + j * 256 + C.lane * 4) = v;
            pg8::u32x2 w; w.x = pk2(v[0], v[1]); w.y = pk2(v[2], v[3]); *(pg8::u32x2*)(B.HB + (size_t)m * DM + j * 256 + C.lane * 4) = w;
            ss += (v[0] * v[0] + v[1] * v[1]) + (v[2] * v[2] + v[3] * v[3]); }
        ss = wave_sum(ss);
        if (C.lane < 32) B.RS[(size_t)m * 32 + C.lane] = (C.lane == 0) ? ss : 0.f;
        if (m >= NTOK) {
#pragma unroll
            for (int j = 0; j < 2; ++j) { *(v4u*)(B.YA + (size_t)m * 1024 + j * 512 + C.lane * 8) = (v4u){0u, 0u, 0u, 0u}; *(v4u*)(B.YB + (size_t)m * 1024 + j * 512 + C.lane * 8) = (v4u){0u, 0u, 0u, 0u}; }
        }
    }
}

__device__ __forceinline__ void g1_rstd_table(const Ctx& C, const pg8::StaticOrder& S) {
    const Bufs B(C.a.ws);
    LAS float* tbl = (LAS float*)(C.lds + RSTD_OFF);
    pg8::Unit u;
    for (int ui = 0; ui < 5 && S.next(ui, u); ++ui) {
        if (C.tid < 256) { const f32x4* p = (const f32x4*)(B.RS + (size_t)(u.pm * 256 + C.tid) * 32); float s = 0.f;
#pragma unroll
            for (int j = 0; j < 8; ++j) { const f32x4 v = p[j]; s += (v[0] + v[1]) + (v[2] + v[3]); }
            tbl[ui * 256 + C.tid] = rsqrtf(s * (1.0f / DM) + RMS_EPS); }
    }
    __syncthreads();
}

__device__ __forceinline__ void norm_phase(const Ctx& C, int l) {
    const Bufs B(C.a.ws);
    const Args& A = C.a;
    for (int m = C.gw; m < MP; m += C.NGW) {
        const bf16* pr = B.PROJ + (size_t)m * NP1;
        { const v4u w = *(const v4u*)(pr + PC_CQ + C.lane * 8); float v[8] = {pg8::bf_lo(w.x), pg8::bf_hi(w.x), pg8::bf_lo(w.y), pg8::bf_hi(w.y), pg8::bf_lo(w.z), pg8::bf_hi(w.z), pg8::bf_lo(w.w), pg8::bf_hi(w.w)};
          float ss = 0.f;
#pragma unroll
          for (int j = 0; j < 8; ++j) ss += v[j] * v[j];
          ss = wave_sum(ss); const float r = rsqrtf(ss * (1.0f / 512.0f) + RMS_EPS);
          v4u o; o.x = pk2(v[0] * r, v[1] * r); o.y = pk2(v[2] * r, v[3] * r); o.z = pk2(v[4] * r, v[5] * r); o.w = pk2(v[6] * r, v[7] * r);
          *(v4u*)(B.CQN + (size_t)m * 512 + C.lane * 8) = o; }
        { const pg8::u32x2 w = *(const pg8::u32x2*)(pr + PC_CKV + C.lane * 4); float v[4] = {pg8::bf_lo(w.x), pg8::bf_hi(w.x), pg8::bf_lo(w.y), pg8::bf_hi(w.y)};
          float ss = (v[0] * v[0] + v[1] * v[1]) + (v[2] * v[2] + v[3] * v[3]);
          ss = wave_sum(ss); const float r = rsqrtf(ss * (1.0f / 256.0f) + RMS_EPS);
          const f32x4 g = *(const f32x4*)(A.kv_norm_g + l * 256 + C.lane * 4);
          pg8::u32x2 o; o.x = pk2(v[0] * r * g[0], v[1] * r * g[1]); o.y = pk2(v[2] * r * g[2], v[3] * r * g[3]);
          *(pg8::u32x2*)(B.CKVN + (size_t)m * 256 + C.lane * 4) = o; }
    }
    for (int it = C.gw; it < 2 * 65; it += C.NGW) { const int b = it / 65, pos = (it % 65) * 64 + C.lane;
        if (pos < LTOK) { const bf16* vr = B.PROJ + (size_t)rowof(b, pos) * NP1 + PC_VA;
#pragma unroll 4
            for (int c8 = 0; c8 < 16; ++c8) { const v4u w = *(const v4u*)(vr + 8 * c8); bf16* o = B.VT + ((size_t)b * 128 + 8 * c8) * 4128 + pos;
                o[0 * 4128] = (bf16)(w.x & 0xffffu); o[1 * 4128] = (bf16)(w.x >> 16); o[2 * 4128] = (bf16)(w.y & 0xffffu); o[3 * 4128] = (bf16)(w.y >> 16);
                o[4 * 4128] = (bf16)(w.z & 0xffffu); o[5 * 4128] = (bf16)(w.z >> 16); o[6 * 4128] = (bf16)(w.w & 0xffffu); o[7 * 4128] = (bf16)(w.w >> 16); } } }
}

__device__ __forceinline__ void swa_naive(const Ctx& C, int l) {
    const Bufs B(C.a.ws);
    const Args& A = C.a;
    LAS float* ps = (LAS float*)(C.lds + RING_OFF + C.wave * 2048);
    LAS int* kp = (LAS int*)(C.lds + RING_OFF + C.wave * 2048 + 1024);
    const int lane = C.lane;
    for (int item = C.gw; item < NTOK * 16; item += C.NGW) {
        const int tok = item >> 4, head = item & 15, b = tok / LTOK, t = tok % LTOK, g = head >> 3, row = rowof(b, t);
        const int nmeta = t < NMETA ? t + 1 : NMETA;
        const int wlo = t - 127 < NMETA ? NMETA : t - 127;
        const int nwin = t < NMETA ? 0 : t - wlo + 1;
        const int ncand = nmeta + nwin;
        const bf16* q = B.PROJ + (size_t)row * NP1 + PC_QA + head * 64;
        const float sink = A.sinks[l * 16 + head];
        float mx = -3.0e38f;
        for (int c = lane; c < ncand; c += 64) {
            const int kpos = c < nmeta ? c : wlo + (c - nmeta), krow = rowof(b, kpos);
            const bf16* k = B.PROJ + (size_t)krow * NP1 + PC_KA + g * 64;
            float s = 0.f;
            for (int d = 0; d < 64; ++d) s = fmaf(bf2f(q[d]), bf2f(k[d]), s);
            s = s * 0.125f + A.bias_table[t5_bucket(t - kpos) * 32 + head];
            ps[c] = s; kp[c] = krow;
            mx = fmaxf(mx, s);
        }
        mx = fmaxf(wave_max(mx), sink);
        float sum = 0.f;
        for (int c = lane; c < ncand; c += 64) { const float p = __expf(ps[c] - mx); ps[c] = p; sum += p; }
        sum = wave_sum(sum) + __expf(sink - mx);
        LDS_WAIT(); asm volatile("" ::: "memory");
        float o = 0.f;
        for (int c = 0; c < ncand; ++c) o = fmaf(ps[c], bf2f(B.PROJ[(size_t)kp[c] * NP1 + PC_VA + g * 64 + lane]), o);
        o /= sum;
        const float z = bf2f(B.PROJ[(size_t)row * NP1 + PC_ZA + head * 64 + lane]);
        B.YA[(size_t)row * 1024 + head * 64 + lane] = (bf16)f2bf(o * siluf_(z));
        LDS_WAIT(); asm volatile("" ::: "memory");
    }
}

__device__ __forceinline__ unsigned f2key(float f) { const unsigned u = __float_as_uint(f); return (u & 0x80000000u) ? ~u : (u | 0x80000000u); }

__device__ __forceinline__ void dsa_naive(const Ctx& C, int l) {
    const Bufs B(C.a.ws);
    const Args& A = C.a;
    LAS float* s_qi = (LAS float*)(C.lds + RING_OFF + 0);
    LAS float* s_wi = (LAS float*)(C.lds + RING_OFF + 2048);
    LAS unsigned* s_key = (LAS unsigned*)(C.lds + RING_OFF + 2112);
    LAS int* s_sel = (LAS int*)(C.lds + RING_OFF + 18560);
    LAS float* s_ql = (LAS float*)(C.lds + RING_OFF + 19584);
    LAS float* s_p = (LAS float*)(C.lds + RING_OFF + 35968);
    LAS int* s_cnt = (LAS int*)(C.lds + RING_OFF + 52352);
    LAS int* s_n = (LAS int*)(C.lds + RING_OFF + 52384);
    const int tid = C.tid, lane = C.lane, wid = C.wave;
    for (int item = C.bid; item < NTOK; item += C.G) {
        const int b = item / LTOK, t = item % LTOK, row = rowof(b, t);
        __syncthreads();
        s_qi[tid] = bf2f(B.Q2[(size_t)row * NQ2 + 4096 + tid]);
        if (tid < 8) s_wi[tid] = bf2f(B.PROJ[(size_t)row * NP1 + PC_WIDX + tid]) * 0.35355339059327373f;
        for (int i = tid; i < 4096; i += 512) s_ql[i] = bf2f(B.Q2[(size_t)row * NQ2 + i]);
        __syncthreads();
        const int n = t + 1;
        for (int k = tid; k < n; k += 512) {
            const bf16* kr = B.PROJ + (size_t)rowof(b, k) * NP1 + PC_KIDX;
            float isc = 0.f;
            for (int hh = 0; hh < 8; ++hh) {
                float s = 0.f;
                for (int d = 0; d < 64; ++d) s = fmaf(s_qi[hh * 64 + d], bf2f(kr[d]), s);
                isc += s_wi[hh] * fmaxf(s * 0.125f, 0.f);
            }
            s_key[k] = f2key(isc);
        }
        __syncthreads();
        int cnt;
        if (n <= TOPK) {
            for (int i = tid; i < n; i += 512) s_sel[i] = i;
            cnt = n;
        } else {
            unsigned T = 0u;
            for (int bit = 31; bit >= 0; --bit) {
                const unsigned cand = T | (1u << bit);
                int c = 0;
                for (int k = tid; k < n; k += 512) c += (s_key[k] >= cand) ? 1 : 0;
                c = wave_sum_i(c);
                __syncthreads();
                if (lane == 0) s_cnt[wid] = c;
                __syncthreads();
                int tot = 0;
#pragma unroll
                for (int w = 0; w < 8; ++w) tot += s_cnt[w];
                if (tot >= TOPK) T = cand;
            }
            int c = 0;
            for (int k = tid; k < n; k += 512) c += (s_key[k] > T) ? 1 : 0;
            c = wave_sum_i(c);
            __syncthreads();
            if (lane == 0) s_cnt[wid] = c;
            __syncthreads();
            int ngt = 0;
#pragma unroll
            for (int w = 0; w < 8; ++w) ngt += s_cnt[w];
            const int need = TOPK - ngt;
            if (wid == 0) {
                int base = 0, eqbase = 0;
                for (int k0 = 0; k0 < n; k0 += 64) {
                    const int k = k0 + lane;
                    const unsigned key = k < n ? s_key[k] : 0u;
                    const bool gt = (k < n) && key > T, eq = (k < n) && key == T;
                    const unsigned long long meq = __ballot(eq);
                    const unsigned long long lt = (1ull << lane) - 1ull;
                    const int eqrank = eqbase + __popcll(meq & lt);
                    const bool sel = gt || (eq && eqrank < need);
                    const unsigned long long ms = __ballot(sel);
                    if (sel) s_sel[base + __popcll(ms & lt)] = k;
                    base += __popcll(ms); eqbase += __popcll(meq);
                }
                if (lane == 0) s_n[0] = base;
            }
            __syncthreads();
            cnt = s_n[0];
        }
        __syncthreads();
        {
            const int j = tid & 255, hb = (tid >> 8) * 8;
            float sc[8];
#pragma unroll
            for (int hh = 0; hh < 8; ++hh) sc[hh] = 0.f;
            if (j < cnt) {
                const int idx = s_sel[j];
                const bf16* kr = B.CKVN + (size_t)rowof(b, idx) * 256;
                for (int r = 0; r < 256; ++r) {
                    const float v = bf2f(kr[r]);
#pragma unroll
                    for (int hh = 0; hh < 8; ++hh) sc[hh] = fmaf(s_ql[(hb + hh) * 256 + r], v, sc[hh]);
                }
                const int bk = t5_bucket(t - idx);
#pragma unroll
                for (int hh = 0; hh < 8; ++hh) s_p[(hb + hh) * 256 + j] = sc[hh] * 0.125f + A.bias_table[bk * 32 + 16 + hb + hh];
            } else {
#pragma unroll
                for (int hh = 0; hh < 8; ++hh) s_p[(hb + hh) * 256 + j] = -3.0e38f;
            }
        }
        __syncthreads();
        for (int hh = wid * 2; hh < wid * 2 + 2; ++hh) {
            float v[4]; float mx = -3.0e38f;
#pragma unroll
            for (int i = 0; i < 4; ++i) { v[i] = s_p[hh * 256 + lane + 64 * i]; mx = fmaxf(mx, v[i]); }
            mx = wave_max(mx);
            float sum = 0.f;
#pragma unroll
            for (int i = 0; i < 4; ++i) { v[i] = (lane + 64 * i < cnt) ? __expf(v[i] - mx) : 0.f; sum += v[i]; }
            sum = wave_sum(sum);
            const float inv = 1.0f / sum;
#pragma unroll
            for (int i = 0; i < 4; ++i) s_p[hh * 256 + lane + 64 * i] = bf2f((bf16)f2bf(v[i] * inv));
        }
        __syncthreads();
        {
            const int r = tid & 255, hb = (tid >> 8) * 8;
            float acc[8];
#pragma unroll
            for (int hh = 0; hh < 8; ++hh) acc[hh] = 0.f;
            for (int j = 0; j < cnt; ++j) {
                const float v = bf2f(B.CKVN[(size_t)rowof(b, s_sel[j]) * 256 + r]);
#pragma unroll
                for (int hh = 0; hh < 8; ++hh) acc[hh] = fmaf(s_p[(hb + hh) * 256 + j], v, acc[hh]);
            }
#pragma unroll
            for (int hh = 0; hh < 8; ++hh) B.OLAT[(size_t)row * 4096 + (hb + hh) * 256 + r] = (bf16)f2bf(acc[hh]);
        }
    }
    __syncthreads();
}
__device__ __forceinline__ void wuv_naive(const Ctx& C, int l) {
    const Bufs B(C.a.ws);
    const Args& A = C.a;
    const float* wuv = A.w_uv + (size_t)l * 16 * 256 * 64;
    for (int item = C.bid; item < NTOK; item += C.G) {
        const int b = item / LTOK, t = item % LTOK, row = rowof(b, t);
        for (int c = C.tid; c < 1024; c += 512) {
            const int h = c >> 6, d = c & 63;
            const bf16* o = B.OLAT + (size_t)row * 4096 + h * 256;
            float a = 0.f;
            for (int r = 0; r < 256; ++r) a = fmaf(bf2f(__builtin_nontemporal_load(o + r)), bf2f((bf16)f2bf(wuv[((size_t)h * 256 + r) * 64 + d])), a);
            const float z = bf2f(B.PROJ[(size_t)row * NP1 + PC_ZB + c]);
            B.YB[(size_t)row * 1024 + c] = (bf16)f2bf(a * siluf_(z));
        }
    }
}
__device__ __forceinline__ void final_phase(const Ctx& C) {
    const Bufs B(C.a.ws);
    const Args& A = C.a;
    for (int m = C.gw; m < 8192; m += C.NGW) {
        float s = (C.lane < 32) ? B.RS[(size_t)m * 32 + C.lane] : 0.f;
        s = wave_sum(s);
        const float r = rsqrtf(s * (1.0f / DM) + RMS_EPS);
#pragma unroll
        for (int j = 0; j < 8; ++j) { const f32x4 v = *(const f32x4*)(B.H + (size_t)m * DM + j * 256 + C.lane * 4); const f32x4 g = *(const f32x4*)(A.final_g + j * 256 + C.lane * 4);
            *(f32x4*)(A.out + (size_t)m * DM + j * 256 + C.lane * 4) = v * r * g; }
    }
}

typedef float f32x16 __attribute__((ext_vector_type(16)));
typedef short s16x4 __attribute__((ext_vector_type(4)));
typedef unsigned short u16x4 __attribute__((ext_vector_type(4)));
constexpr int DS_ISC = RING_OFF, DS_ISC_WORDS = 4128, DS_ISC_STRIDE = DS_ISC_WORDS * 4;
constexpr int DS_SEL = DS_ISC + 8 * DS_ISC_STRIDE;
constexpr int DS_BIAS = DS_SEL + 8 * 512;
constexpr int DS_END = DS_BIAS + 2048;
static_assert(DS_END <= LDS_BYTES, "DSA LDS map");

__device__ __forceinline__ s16x4 tr_read(LAS unsigned char* p) { typedef short v4i16_t __attribute__((ext_vector_type(4))); return __builtin_bit_cast(s16x4, __builtin_amdgcn_ds_read_tr16_b64_v4i16((LAS v4i16_t*)p)); }
__device__ __forceinline__ unsigned cvtpk(float lo, float hi) { typedef float f2_t __attribute__((ext_vector_type(2))); typedef __bf16 b2_t __attribute__((ext_vector_type(2))); f2_t v = {lo, hi}; b2_t b = __builtin_convertvector(v, b2_t); return __builtin_bit_cast(unsigned, b); }

__device__ __forceinline__ void dsa_unit(const Ctx& C, const Bufs& B, int l, int b, int t0) {
    int lane = C.lane; const int w = C.wave;
#define RELANE() do { asm volatile("" : "+v"(lane)); asm volatile("" : "+s"(t0), "+s"(b)); } while (0)
    LAS unsigned* ISC = (LAS unsigned*)(C.lds + DS_ISC);
    LAS unsigned short* sel = (LAS unsigned short*)(C.lds + DS_SEL) + w * 256;
    const LAS float* biasl = (const LAS float*)(C.lds + DS_BIAS);
    {
        const int r32 = lane & 31, hh = lane >> 5;
        bf16x8 qa[2][4]; float wq[2][2][8];
        const int qi = 2 * ((r32 >> 2) & 1) + (r32 >> 4), hA = (r32 & 3) + 4 * ((r32 >> 3) & 1);
#pragma unroll
        for (int g = 0; g < 2; ++g) { const int row = rowof(b, t0 + 4 * g + qi);
#pragma unroll
            for (int s = 0; s < 4; ++s) qa[g][s] = *(const bf16x8*)(B.Q2 + (size_t)row * NQ2 + 4096 + hA * 64 + 16 * s + 8 * hh);
#pragma unroll
            for (int j = 0; j < 2; ++j) { const int rw = rowof(b, t0 + 4 * g + 2 * hh + j); const v4u ww = *(const v4u*)(B.PROJ + (size_t)rw * NP1 + PC_WIDX);
                const float sc = 0.35355339059327373f * 0.125f;
                wq[g][j][0] = pg8::bf_lo(ww.x) * sc; wq[g][j][1] = pg8::bf_hi(ww.x) * sc; wq[g][j][2] = pg8::bf_lo(ww.y) * sc; wq[g][j][3] = pg8::bf_hi(ww.y) * sc;
                wq[g][j][4] = pg8::bf_lo(ww.z) * sc; wq[g][j][5] = pg8::bf_hi(ww.z) * sc; wq[g][j][6] = pg8::bf_lo(ww.w) * sc; wq[g][j][7] = pg8::bf_hi(ww.w) * sc; } }
        const int nkeys = t0 + 8, nkt = (nkeys + 31) >> 5;
        for (int kt = w; kt < nkt; kt += 8) {
            const int key = kt * 32 + r32, kc = key < nkeys ? key : nkeys - 1, krow = rowof(b, kc);
            bf16x8 kb[4];
#pragma unroll
            for (int s = 0; s < 4; ++s) kb[s] = *(const bf16x8*)(B.PROJ + (size_t)krow * NP1 + PC_KIDX + 16 * s + 8 * hh);
#pragma unroll
            for (int g = 0; g < 2; ++g) { f32x16 acc = {};
#pragma unroll
                for (int s = 0; s < 4; ++s) acc = __builtin_amdgcn_mfma_f32_32x32x16_bf16(qa[g][s], kb[s], acc, 0, 0, 0);
#pragma unroll
                for (int j = 0; j < 2; ++j) { float isc = 0.f;
#pragma unroll
                    for (int h = 0; h < 8; ++h) isc += wq[g][j][h] * fmaxf(acc[8 * j + h], 0.f);
                    ISC[(4 * g + 2 * hh + j) * DS_ISC_WORDS + key] = f2key(isc); } }
        }
    }
    LDS_WAIT(); __syncthreads(); RELANE();
    const int t = t0 + w, n = t + 1;
    int cnt;
    if (n <= TOPK) { for (int j = lane; j < n; j += 64) sel[j] = (unsigned short)j; cnt = n; }
    else {
        const LAS unsigned* myrow = ISC + w * DS_ISC_WORDS;
        const int nI = (n + 255) >> 8;
        unsigned v[68];
#pragma unroll
        for (int i = 0; i < 17; ++i) { pg8::u32x4 x = {0u, 0u, 0u, 0u}; if (i < nI) x = *(const LAS pg8::u32x4*)(myrow + 256 * i + 4 * lane);
#pragma unroll
            for (int e = 0; e < 4; ++e) v[4 * i + e] = (256 * i + 4 * lane + e <= t) ? x[e] : 0u; }
        unsigned T = 0u; bool exact = false;
        for (int bit = 31; bit >= 0; --bit) {
            const unsigned cand = T | (1u << bit); int c = 0;
#pragma unroll
            for (int k = 0; k < 68; ++k) c += __popcll(__ballot(v[k] >= cand));
            if (c >= TOPK) { T = cand; if (c == TOPK) { exact = true; break; } }
        }
        if (!exact) { int c = 0;
#pragma unroll
            for (int k = 0; k < 68; ++k) c += __popcll(__ballot(v[k] >= T));
            exact = (c == TOPK); }
        int base = 0;
#pragma unroll
        for (int k = 0; k < 68; ++k) { const bool p = exact ? (v[k] >= T) : (v[k] > T); const unsigned long long m = __ballot(p);
            const int pos = base + (int)__builtin_amdgcn_mbcnt_hi((unsigned)(m >> 32), __builtin_amdgcn_mbcnt_lo((unsigned)m, 0u));
            if (p) sel[pos] = (unsigned short)(256 * (k >> 2) + 4 * lane + (k & 3));
            base += __popcll(m); }
        if (!exact) {
            int last = -1;
            while (base < TOPK) { int mi = 0x7fffffff;
#pragma unroll
                for (int k = 0; k < 68; ++k) { const int idx = 256 * (k >> 2) + 4 * lane + (k & 3); if (v[k] == T && idx > last && idx < mi) mi = idx; }
#pragma unroll
                for (int o = 1; o < 64; o <<= 1) { const int oth = __shfl_xor(mi, o); mi = oth < mi ? oth : mi; }
                if (lane == 0) sel[base] = (unsigned short)mi;
                last = mi; ++base; }
        }
        cnt = TOPK;
    }
    LDS_WAIT(); asm volatile("" ::: "memory"); RELANE();
    {
        const int g = lane >> 4, c16 = lane & 15, rowq = rowof(b, t);
        bf16x8 qf[8];
#pragma unroll
        for (int s = 0; s < 8; ++s) qf[s] = *(const bf16x8*)(B.Q2 + (size_t)rowq * NQ2 + c16 * 256 + 32 * s + 8 * g);
        f32x4 O[16];
#pragma unroll
        for (int rt = 0; rt < 16; ++rt) O[rt] = (f32x4){0.f, 0.f, 0.f, 0.f};
        float m_ref = 0.f, lsum = 0.f;
        const int buf0 = DS_ISC + w * DS_ISC_STRIDE, buf1 = buf0 + 8192;
        const int npairs = (cnt + 31) >> 5;
        const int swz = (c16 & 7) << 1;
        const int trow = 4 * g + (c16 >> 2), tswz = (trow & 7) << 1, tp = c16 & 3;
        for (int kp = 0; kp < npairs; ++kp) {
#pragma unroll
            for (int p = 0; p < 16; ++p) { const int rowc = 2 * (p & 7) + (lane >> 5), j = 32 * kp + 16 * (p >> 3) + rowc; const int pos = sel[j < cnt ? j : 0];
                const int logical = (lane & 31) ^ ((rowc & 7) << 1);
                const unsigned char* src = (const unsigned char*)B.CKVN + (size_t)rowof(b, pos) * 512 + logical * 16;
                __builtin_amdgcn_global_load_lds((const unsigned*)src, (LAS unsigned*)(C.lds + ((p >> 3) ? buf1 : buf0) + (p & 7) * 1024), 16, 0, 0); }
            asm volatile("s_waitcnt vmcnt(0)" ::: "memory");
            f32x4 s0 = {0.f, 0.f, 0.f, 0.f}, s1 = {0.f, 0.f, 0.f, 0.f};
#pragma unroll
            for (int s = 0; s < 8; ++s) { const int off = c16 * 512 + (((4 * s + g) ^ swz) << 4);
                const bf16x8 a0 = *(const LAS bf16x8*)(C.lds + buf0 + off), a1 = *(const LAS bf16x8*)(C.lds + buf1 + off);
                s0 = __builtin_amdgcn_mfma_f32_16x16x32_bf16(a0, qf[s], s0, 0, 0, 0); s1 = __builtin_amdgcn_mfma_f32_16x16x32_bf16(a1, qf[s], s1, 0, 0, 0); }
            const u16x4 p0 = *(const LAS u16x4*)(sel + 32 * kp + 4 * g), p1 = *(const LAS u16x4*)(sel + 32 * kp + 16 + 4 * g);
            float x0[4], x1[4]; float mloc = -INFINITY;
#pragma unroll
            for (int i = 0; i < 4; ++i) { const int j0 = 32 * kp + 4 * g + i, j1 = j0 + 16;
                x0[i] = (j0 < cnt) ? 0.125f * s0[i] + biasl[t5_bucket(t - (int)p0[i]) * 16 + c16] : -INFINITY;
                x1[i] = (j1 < cnt) ? 0.125f * s1[i] + biasl[t5_bucket(t - (int)p1[i]) * 16 + c16] : -INFINITY;
                mloc = fmaxf(mloc, fmaxf(x0[i], x1[i])); }
            mloc = fmaxf(mloc, __shfl_xor(mloc, 16)); mloc = fmaxf(mloc, __shfl_xor(mloc, 32));
            if (kp == 0) m_ref = mloc;
            else if (__any(mloc > m_ref + 8.0f)) { const float mn = fmaxf(m_ref, mloc), al = __expf(m_ref - mn);
#pragma unroll
                for (int rt = 0; rt < 16; ++rt) O[rt] *= al;
                lsum *= al; m_ref = mn; }
            float pe0[4], pe1[4];
#pragma unroll
            for (int i = 0; i < 4; ++i) { pe0[i] = __expf(x0[i] - m_ref); pe1[i] = __expf(x1[i] - m_ref); lsum += pe0[i] + pe1[i]; }
            pg8::u32x4 pw; pw.x = cvtpk(pe0[0], pe0[1]); pw.y = cvtpk(pe0[2], pe0[3]); pw.z = cvtpk(pe1[0], pe1[1]); pw.w = cvtpk(pe1[2], pe1[3]);
            const bf16x8 pf = __builtin_bit_cast(bf16x8, pw);
#pragma unroll
            for (int rt = 0; rt < 16; ++rt) { const int off = trow * 512 + (((2 * rt + (tp >> 1)) ^ tswz) << 4) + 8 * (tp & 1);
                const s16x4 lo = tr_read(C.lds + buf0 + off), hi = tr_read(C.lds + buf1 + off);
                const bf16x8 af = {lo[0], lo[1], lo[2], lo[3], hi[0], hi[1], hi[2], hi[3]};
                O[rt] = __builtin_amdgcn_mfma_f32_16x16x32_bf16(af, pf, O[rt], 0, 0, 0); }
            LDS_WAIT(); asm volatile("" ::: "memory");
        }
        lsum += __shfl_xor(lsum, 16); lsum += __shfl_xor(lsum, 32);
        const float inv = 1.0f / lsum;
#pragma unroll
        for (int rt = 0; rt < 16; ++rt) { const f32x4 o = O[rt] * inv; pg8::u32x2 wv; wv.x = cvtpk(o[0], o[1]); wv.y = cvtpk(o[2], o[3]);
            *(pg8::u32x2*)(B.OLAT + (size_t)rowq * 4096 + c16 * 256 + 16 * rt + 4 * g) = wv; }
    }
    VM_WAIT(); LDS_WAIT(); __syncthreads(); RELANE();
    {
        const int g = lane >> 4, c16 = lane & 15, rowA = rowof(b, t0 + (c16 & 7));
#pragma unroll 1
        for (int hq = 0; hq < 2; ++hq) { const int h = 2 * w + hq;
            f32x4 Dv[4];
#pragma unroll
            for (int nt = 0; nt < 4; ++nt) Dv[nt] = (f32x4){0.f, 0.f, 0.f, 0.f};
#pragma unroll
            for (int s = 0; s < 8; ++s) { const v4u av = __builtin_nontemporal_load((const v4u*)(B.OLAT + (size_t)rowA * 4096 + h * 256 + 32 * s + 8 * g)); const bf16x8 a = __builtin_bit_cast(bf16x8, av);
#pragma unroll
                for (int nt = 0; nt < 4; ++nt) { const bf16x8 bw = *(const bf16x8*)(B.WUV + (((size_t)l * 16 + h) * 64 + 16 * nt + c16) * 256 + 32 * s + 8 * g);
                    Dv[nt] = __builtin_amdgcn_mfma_f32_16x16x32_bf16(a, bw, Dv[nt], 0, 0, 0); } }
            if (g < 2) {
#pragma unroll
                for (int i = 0; i < 4; ++i) { const int row = rowof(b, t0 + 4 * g + i);
#pragma unroll
                    for (int nt = 0; nt < 4; ++nt) { const int col = h * 64 + 16 * nt + c16; const float z = bf2f(B.PROJ[(size_t)row * NP1 + PC_ZB + col]);
                        B.YB[(size_t)row * 1024 + col] = (bf16)f2bf(Dv[nt][i] * siluf_(z)); } }
            }
        }
    }
#undef RELANE
}

__device__ __forceinline__ void dsa_phase(const Ctx& C, int l) {
    const Bufs B(C.a.ws);
    const Args& A = C.a;
    if (C.tid < 512) { const int bk = C.tid >> 4, h = C.tid & 15; ((LAS float*)(C.lds + DS_BIAS))[C.tid] = A.bias_table[bk * 32 + 16 + h]; }
    __syncthreads();
    for (int it = 0;; ++it) {
        int s;
        if (C.G == 256) { if (it < 4) s = 256 * it + ((it & 1) ? 255 - C.bid : C.bid); else if (it == 4 && C.bid < 4) s = 1024 + C.bid; else break; }
        else { s = C.bid + it * C.G; if (s >= 1028) break; }
        dsa_unit(C, B, l, s & 1, 8 * (513 - (s >> 1)));
    }
    __syncthreads();
}

constexpr int VT_PITCH = 4128;
constexpr int SW_BIAS = RING_OFF;
constexpr int SW_WS = SW_BIAS + 8192;

__device__ __forceinline__ void swa_item(const Ctx& C, const Bufs& B, const float* __restrict__ sinks, int b, int head, int p0, bool meta) {
    const int lane = C.lane, r32 = lane & 31, hh = lane >> 5, g = head >> 3;
    const LAS float* biasl = (const LAS float*)(C.lds + SW_BIAS);
    LAS float* wsf = (LAS float*)(C.lds + SW_WS) + C.wave * 32;
    const int tq = p0 + r32;
    const int tqc = meta ? (tq < NMETA ? tq : NMETA - 1) : tq;
    const int rowq = rowof(b, tqc);
    bf16x8 qf[4];
#pragma unroll
    for (int s = 0; s < 4; ++s) qf[s] = *(const bf16x8*)(B.PROJ + (size_t)rowq * NP1 + PC_QA + head * 64 + 16 * s + 8 * hh);
    const int ntile = meta ? 1 : 6;
    f32x16 S[6];
#pragma unroll
    for (int kt = 0; kt < 6; ++kt) {
        if (kt < ntile) {
            const int k0 = (kt == 0) ? 0 : p0 - 128 + 32 * (kt - 1);
            int kpos = k0 + r32; kpos = kpos < 0 ? 0 : kpos;
            const int krow = rowof(b, kpos);
            f32x16 acc = {};
#pragma unroll
            for (int s = 0; s < 4; ++s) { const bf16x8 kf = *(const bf16x8*)(B.PROJ + (size_t)krow * NP1 + PC_KA + g * 64 + 16 * s + 8 * hh);
                acc = __builtin_amdgcn_mfma_f32_32x32x16_bf16(kf, qf[s], acc, 0, 0, 0); }
#pragma unroll
            for (int i = 0; i < 16; ++i) { const int kp = k0 + (i & 3) + 8 * (i >> 2) + 4 * hh; const int d = tq - kp;
                bool ok;
                if (kt == 0) ok = kp < NMETA && d >= 0; else ok = kp >= NMETA && d >= 0 && d < 128;
                const int dc = d < 0 ? 0 : (d > 127 ? 127 : d);
                acc[i] = ok ? 0.125f * acc[i] + biasl[dc * 16 + head] : -INFINITY; }
            S[kt] = acc;
        } else S[kt] = (f32x16){-INFINITY, -INFINITY, -INFINITY, -INFINITY, -INFINITY, -INFINITY, -INFINITY, -INFINITY, -INFINITY, -INFINITY, -INFINITY, -INFINITY, -INFINITY, -INFINITY, -INFINITY, -INFINITY};
    }
    const float sink = sinks[head];
    float mx = sink;
#pragma unroll
    for (int kt = 0; kt < 6; ++kt)
#pragma unroll
        for (int i = 0; i < 16; ++i) mx = fmaxf(mx, S[kt][i]);
    mx = fmaxf(mx, __shfl_xor(mx, 32));
    float sum = 0.f;
#pragma unroll
    for (int kt = 0; kt < 6; ++kt)
#pragma unroll
        for (int i = 0; i < 16; ++i) { const float p = __expf(S[kt][i] - mx); S[kt][i] = p; sum += p; }
    sum += __shfl_xor(sum, 32);
    sum += __expf(sink - mx);
    if (hh == 0) wsf[r32] = sum;
    f32x16 O0 = {}, O1 = {};
#pragma unroll
    for (int kt = 0; kt < 6; ++kt) {
        if (kt < ntile) {
            const int k0 = (kt == 0) ? 0 : p0 - 128 + 32 * (kt - 1);
#pragma unroll
            for (int s2 = 0; s2 < 2; ++s2) {
                pg8::u32x4 pw; pw.x = cvtpk(S[kt][8 * s2 + 0], S[kt][8 * s2 + 1]); pw.y = cvtpk(S[kt][8 * s2 + 2], S[kt][8 * s2 + 3]); pw.z = cvtpk(S[kt][8 * s2 + 4], S[kt][8 * s2 + 5]); pw.w = cvtpk(S[kt][8 * s2 + 6], S[kt][8 * s2 + 7]);
                const bf16x8 pf = __builtin_bit_cast(bf16x8, pw);
                int ka = k0 + 16 * s2 + 4 * hh, kb2 = ka + 8; ka = ka < 0 ? 0 : ka; kb2 = kb2 < 0 ? 0 : kb2;
#pragma unroll
                for (int dt = 0; dt < 2; ++dt) { const bf16* vrow = B.VT + ((size_t)b * 128 + g * 64 + 32 * dt + r32) * VT_PITCH;
                    const pg8::u32x2 lo = *(const pg8::u32x2*)(vrow + ka), hi2 = *(const pg8::u32x2*)(vrow + kb2);
                    const pg8::u32x4 vw = {lo.x, lo.y, hi2.x, hi2.y}; const bf16x8 vf = __builtin_bit_cast(bf16x8, vw);
                    if (dt == 0) O0 = __builtin_amdgcn_mfma_f32_32x32x16_bf16(pf, vf, O0, 0, 0, 0); else O1 = __builtin_amdgcn_mfma_f32_32x32x16_bf16(pf, vf, O1, 0, 0, 0); }
            }
        }
    }
    LDS_WAIT(); asm volatile("" ::: "memory");
#pragma unroll
    for (int i = 0; i < 16; ++i) { const int q = (i & 3) + 8 * (i >> 2) + 4 * hh, t = p0 + q;
        if (!meta || t < NMETA) { const int row = rowof(b, t); const float inv = 1.0f / wsf[q];
#pragma unroll
            for (int dt = 0; dt < 2; ++dt) { const int col = head * 64 + 32 * dt + r32; const float z = bf2f(B.PROJ[(size_t)row * NP1 + PC_ZA + col]);
                const float o = (dt == 0 ? O0[i] : O1[i]) * inv;
                B.YA[(size_t)row * 1024 + col] = (bf16)f2bf(o * siluf_(z)); } } }
    LDS_WAIT(); asm volatile("" ::: "memory");
}

__device__ __forceinline__ void swa_phase(const Ctx& C, int l) {
    const Bufs B(C.a.ws);
    const Args& A = C.a;
    __syncthreads();
    for (int i = C.tid; i < 128 * 16; i += NWAVES * 64) { const int d = i >> 4, h = i & 15; ((LAS float*)(C.lds + SW_BIAS))[i] = A.bias_table[t5_bucket(d) * 32 + h]; }
    __syncthreads();
    const float* sinks = A.sinks + l * 16;
    for (int it = C.gw; it < 4096 + 32; it += C.NGW) {
        if (it < 4096) { const int blk = it & 127, head = (it >> 7) & 15, b = it >> 11; swa_item(C, B, sinks, b, head, NMETA + 32 * blk, false); }
        else { const int r = it - 4096, head = r & 15, b = r >> 4; swa_item(C, B, sinks, b, head, 0, true); }
    }
    __syncthreads();
}


constexpr int PH_PER_LAYER = 7, N_PHASES = 1 + NLAYER * PH_PER_LAYER + 1;
#ifndef MK_NAIVE_SWA
#define MK_NAIVE_SWA 0
#endif
#ifndef MK_NAIVE_DSA
#define MK_NAIVE_DSA 0
#endif
#ifndef MK_ONE_LAUNCH
#define MK_ONE_LAUNCH 1
#endif

__global__ void __launch_bounds__(NWAVES * 64, 2) fwd_kernel(Args args) {
    extern __shared__ __attribute__((aligned(16))) unsigned char lds[];
    Ctx C;
    C.lds = (LAS unsigned char*)lds; C.tid = threadIdx.x; C.lane = C.tid & 63; C.wave = __builtin_amdgcn_readfirstlane(C.tid >> 6);
    C.G = gridDim.x; C.bid = blockIdx.x; C.gw = blockIdx.x * NWAVES + C.wave; C.NGW = C.G * NWAVES; C.a = args;
    unsigned char* ws = args.ws;
    gu32* ctl = (gu32*)(ws + WS_CTL);
    for (int u = C.tid; u < RING_OFF / 4; u += NWAVES * 64) ((LAS unsigned*)(C.lds + LDSCTL_OFF))[u] = 0u;
    __syncthreads();
    volatile LAS unsigned* MISC = (volatile LAS unsigned*)(C.lds + MISC_OFF);
    XcdBarrier bar; bar.bar = (unsigned*)(ctl + CW_BAR); bar.x = 0; bar.st = nullptr;
    const int lo = args.ph_lo, hi = args.ph_hi;
    const bool one = (hi - lo) > 1;
    if (one) bar = xcd_barrier_post((unsigned*)(ctl + CW_BAR), MISC + 8);
#define IN(k) (lo <= (k) && (k) < hi)
#define PHASE_BEGIN() do { int l_ = (int)__builtin_amdgcn_mbcnt_hi(~0u, __builtin_amdgcn_mbcnt_lo(~0u, 0u)); asm volatile("" : "+v"(l_)); int b_ = blockIdx.x; asm volatile("" : "+s"(b_)); \
    C.lane = l_; C.tid = C.wave * 64 + l_; C.bid = b_; C.gw = b_ * NWAVES + C.wave; } while (0)
#define SEAM(k) do { if (IN((k) + 1)) xcd_barrier(bar); } while (0)
    LAS unsigned char* ring = C.lds + RING_OFF;

    if (IN(0)) { PHASE_BEGIN(); p0_prologue(C); SEAM(0); }
    for (int l = 0; l < NLAYER; ++l) {
        const int p = 1 + l * PH_PER_LAYER;
        if (IN(p)) {
            PHASE_BEGIN(); const Bufs B(ws);
            pg8::Gemm g{B.HB, B.W1 + (size_t)l * NP1 * DM, MP, NP1, DM}; pg8::StaticOrder S; S.init(MP, NP1, C.G, C.bid);
            g1_rstd_table(C, S);
            pg8::EpiProj E{B.PROJ, NP1, (const LAS float*)(C.lds + RSTD_OFF)};
            pg8::gemm_phase<pg8::EpiProj, pg8::StaticOrder, true, true>(ring, g, S, E, C.tid);
            SEAM(p);
        }
        if (IN(p + 1)) { PHASE_BEGIN(); norm_phase(C, l); SEAM(p + 1); }
        if (IN(p + 2)) {
            PHASE_BEGIN(); const Bufs B(ws);
            pg8::Gemm g{B.CQN, B.W2 + (size_t)l * NQ2 * 512, MP, NQ2, 512}; pg8::StaticOrder S; S.init(MP, NQ2, C.G, C.bid);
            pg8::EpiBf16<0> E{B.Q2, NQ2, nullptr, 0, 0, 1.f};
            pg8::gemm_phase<pg8::EpiBf16<0>, pg8::StaticOrder, true, true>(ring, g, S, E, C.tid);
            SEAM(p + 2);
        }
        if (IN(p + 3)) {
#if MK_NAIVE_SWA
            PHASE_BEGIN(); swa_naive(C, l);
#else
            PHASE_BEGIN(); swa_phase(C, l);
#endif
#if MK_NAIVE_DSA
            PHASE_BEGIN(); dsa_naive(C, l);
            VM_WAIT(); __syncthreads();
            PHASE_BEGIN(); wuv_naive(C, l);
#else
            PHASE_BEGIN(); dsa_phase(C, l);
#endif
            SEAM(p + 3);
        }
        if (IN(p + 4)) {
            PHASE_BEGIN(); const Bufs B(ws);
            pg8::Gemm g{B.YA, B.WA + (size_t)l * DM * 1024, MP, DM, 1024}; pg8::StaticOrder S; S.init(MP, DM, C.G, C.bid);
            pg8::EpiPA E{B.PA, B.PROJ + PC_GA, NP1};
            pg8::gemm_phase<pg8::EpiPA, pg8::StaticOrder, true, true>(ring, g, S, E, C.tid);
            SEAM(p + 4);
        }
        if (IN(p + 5)) {
            PHASE_BEGIN(); const Bufs B(ws);
            pg8::Gemm g{B.YB, B.WB + (size_t)l * DM * 1024, MP, DM, 1024}; pg8::StaticOrder S; S.init(MP, DM, C.G, C.bid);
            pg8::EpiMerge E{B.MG, B.PA, B.PROJ + PC_GB, NP1};
            pg8::gemm_phase<pg8::EpiMerge, pg8::StaticOrder, true, true>(ring, g, S, E, C.tid);
            SEAM(p + 5);
        }
        if (IN(p + 6)) {
            PHASE_BEGIN(); const Bufs B(ws);
            pg8::Gemm g{B.MG, B.WO + (size_t)l * DM * DM, MP, DM, DM}; pg8::StaticOrder S; S.init(MP, DM, C.G, C.bid);
            pg8::EpiRes E{B.H, B.HB, B.RS};
            pg8::gemm_phase<pg8::EpiRes, pg8::StaticOrder, true, true>(ring, g, S, E, C.tid);
            SEAM(p + 6);
        }
    }
    if (IN(N_PHASES - 1)) { PHASE_BEGIN(); final_phase(C); }
#undef IN
#undef SEAM
}

extern "C" void kernel_launch(void* const* d_in, const int* in_sizes, int n_in, void* d_out, int out_size, void* d_ws, size_t ws_size, hipStream_t stream) {
    static int grid = 0;
    if (grid == 0) {
        if (n_in != 16 || ws_size < WS_END) { fprintf(stderr, "kernel_launch: unexpected inputs (n_in %d, ws %zu, need %zu)\n", n_in, ws_size, (size_t)WS_END); grid = -1; return; }
        int dev = 0, cus = 0;
        if (hipGetDevice(&dev) != hipSuccess || hipDeviceGetAttribute(&cus, hipDeviceAttributeMultiprocessorCount, dev) != hipSuccess) { grid = -1; return; }
        if (hipFuncSetAttribute((const void*)fwd_kernel, hipFuncAttributeMaxDynamicSharedMemorySize, LDS_BYTES) != hipSuccess) { fprintf(stderr, "kernel_launch: hipFuncSetAttribute failed\n"); grid = -1; return; }
        int per_cu = 0;
        if (hipOccupancyMaxActiveBlocksPerMultiprocessor(&per_cu, (const void*)fwd_kernel, NWAVES * 64, LDS_BYTES) != hipSuccess || per_cu < 1) fprintf(stderr, "kernel_launch: occupancy query says %d\n", per_cu);
        (void)hipGetLastError();
        grid = cus;
    }
    if (grid < 0) return;
    if (hipMemsetAsync((char*)d_ws + WS_CTL, 0, CTL_ZERO_BYTES, stream) != hipSuccess) return;
    Args a{};
    a.x = (const float*)d_in[0]; a.meta = (const float*)d_in[1]; a.bias_table = (const float*)d_in[2]; a.norm_g = (const float*)d_in[3]; a.w_in = (const float*)d_in[4];
    a.q_norm_g = (const float*)d_in[5]; a.kv_norm_g = (const float*)d_in[6]; a.w_qb = (const float*)d_in[7]; a.w_iq = (const float*)d_in[8]; a.w_uk = (const float*)d_in[9];
    a.w_uv = (const float*)d_in[10]; a.sinks = (const float*)d_in[11]; a.w_proj_a = (const float*)d_in[12]; a.w_proj_b = (const float*)d_in[13]; a.w_out = (const float*)d_in[14];
    a.final_g = (const float*)d_in[15]; a.out = (float*)d_out; a.ws = (unsigned char*)d_ws;
#if MK_ONE_LAUNCH
    a.ph_lo = 0; a.ph_hi = N_PHASES;
    hipLaunchKernelGGL(fwd_kernel, dim3(grid), dim3(NWAVES * 64), LDS_BYTES, stream, a);
#else
    for (int p = 0; p < N_PHASES; ++p) { a.ph_lo = p; a.ph_hi = p + 1; hipLaunchKernelGGL(fwd_kernel, dim3(grid), dim3(NWAVES * 64), LDS_BYTES, stream, a); }
#endif
}
```

```cpp
#include <hip/hip_runtime.h>
#include <cstdio>
#include <cstdint>
namespace pg8 {
#define PG8_LAS __attribute__((address_space(3)))
typedef unsigned short bf16_t;
typedef short bf16x8 __attribute__((ext_vector_type(8)));
typedef float f32x4 __attribute__((ext_vector_type(4)));
typedef unsigned u32x4 __attribute__((ext_vector_type(4)));
constexpr int BM = 256, BK = 64, HALF = 128, HTB = HALF * BK * 2  , STAGE_BYTES = 8 * HTB, NXCD = 8, WGM = 8;

__host__ __device__ __forceinline__ int lds_byte(int r, int c) { const int st = (r >> 4) * 2 + (c >> 5), rr = r & 15, cc = c & 31, ob = rr * 64 + cc * 2; return st * 1024 + (ob ^ (((ob >> 9) & 1) << 5)); }
__host__ __device__ __forceinline__ void stage_rc(int b, int& R, int& C) { const int st = b / 1024, sb = b % 1024, swz = sb ^ (((sb >> 9) & 1) << 5); R = (st >> 1) * 16 + swz / 64; C = (st & 1) * 32 + (swz % 64) / 2; }
__host__ __device__ __forceinline__ int perm32(int rho) { const int n = rho >> 4, i = rho & 15; return 8 * (i >> 2) + 4 * n + (i & 3); }

struct Unit { int pm, pn; };
struct Gemm { const bf16_t* A; const bf16_t* Bt; int M, N, K; };

struct StaticOrder {
    int nM, nN, nwg, G, c;
    __host__ __device__ void init(int M, int N, int G_, int c_) { nM = M / BM; nN = N / BM; nwg = nM * nN; G = G_; c = c_; }
    __host__ __device__ bool next(int i, Unit& u) const {
        const long L = (long)i * G + c; if (L >= nwg) return false;
        int wgid = (int)L; { const int q = nwg / NXCD, r = nwg % NXCD, xcd = wgid % NXCD, off = wgid / NXCD; wgid = (xcd < r ? xcd * (q + 1) : r * (q + 1) + (xcd - r) * q) + off; }
        const int nig = WGM * nN, gid = wgid / nig, fm = gid * WGM, gsz = (nM - fm) < WGM ? (nM - fm) : WGM;
        u.pm = fm + ((wgid % nig) % gsz); u.pn = (wgid % nig) / gsz; return true;
    }
    __device__ __forceinline__ void a_ready(const Unit&) const {}
    __device__ __forceinline__ void done(const Unit&) const {}
};

__device__ __forceinline__ unsigned cvt_pk_bf16(float lo, float hi) { unsigned r; asm volatile("v_cvt_pk_bf16_f32 %0, %1, %2" : "=v"(r) : "v"(lo), "v"(hi)); return r; }
typedef float f32x2 __attribute__((ext_vector_type(2)));
__device__ __forceinline__ f32x2 gelu_pk(f32x2 v) {
    const f32x2 av = __builtin_elementwise_abs(v), d = av * 0.2316418882f + 1.0f;
    f32x2 t; t.x = __builtin_amdgcn_rcpf(d.x); t.y = __builtin_amdgcn_rcpf(d.y);
    f32x2 q = t * 0.5307027145f + (-0.7265760135f); q = q * t + 0.7107068705f; q = q * t + (-0.142248368f); q = q * t + 0.127414796f; q = q * t;
    const f32x2 s = (v * v) * (-0.72134752044f);
    f32x2 e; e.x = __builtin_amdgcn_exp2f(s.x); e.y = __builtin_amdgcn_exp2f(s.y);
    const f32x2 m = v * (q * e), r = v - m;
    f32x2 o; o.x = v.x < 0.f ? m.x : r.x; o.y = v.y < 0.f ? m.y : r.y; return o;
}

template <int ACT  > struct EpiBf16 {
    static constexpr bool PERM = true, AFTER_DRAIN = false; static_assert(ACT == 0 || ACT == 1, "EpiBf16: ACT is 0 (none) or 1 (gelu_pk)");
    bf16_t* O; int ldc; const float* bias; int split_cols; size_t split_stride; float scale0;
    __device__ __forceinline__ void operator()(const f32x4 (&acc)[2][2][4][2], const Unit& u, int ui, int wr, int wc, int fr, int fq) const {
        const int row0 = u.pm * BM + wr * 64 + fr; int colt = u.pn * BM; bf16_t* base = O;
        float sc = 1.f; if (split_cols) { const int t = colt / split_cols; base += (size_t)t * split_stride; colt -= t * split_cols; if (t == 0) sc = scale0; }
        const int col0 = colt + wc * 32 + 8 * fq, bcol0 = u.pn * BM + wc * 32 + 8 * fq;
        f32x4 bv[2][2];
#pragma unroll
        for (int bj = 0; bj < 2; ++bj)
#pragma unroll
            for (int n = 0; n < 2; ++n) bv[bj][n] = bias ? *(const f32x4*)(bias + bcol0 + bj * HALF + 4 * n) : (f32x4){0.f, 0.f, 0.f, 0.f};
#pragma unroll
        for (int ai = 0; ai < 2; ++ai)
#pragma unroll
            for (int m = 0; m < 4; ++m) { bf16_t* rowp = base + (size_t)(row0 + ai * HALF + m * 16) * ldc + col0;
#pragma unroll
                for (int bj = 0; bj < 2; ++bj) { f32x4 v0 = acc[ai][bj][m][0] + bv[bj][0], v1 = acc[ai][bj][m][1] + bv[bj][1];
                    if (ACT == 1) { f32x2 a = gelu_pk((f32x2){v0[0], v0[1]}), b = gelu_pk((f32x2){v0[2], v0[3]}), c = gelu_pk((f32x2){v1[0], v1[1]}), d = gelu_pk((f32x2){v1[2], v1[3]});
                        v0 = (f32x4){a.x, a.y, b.x, b.y}; v1 = (f32x4){c.x, c.y, d.x, d.y}; }
                    v0 = v0 * sc; v1 = v1 * sc; u32x4 w; w.x = cvt_pk_bf16(v0[0], v0[1]); w.y = cvt_pk_bf16(v0[2], v0[3]); w.z = cvt_pk_bf16(v1[0], v1[1]); w.w = cvt_pk_bf16(v1[2], v1[3]);
                    *(u32x4*)(rowp + bj * HALF) = w; } }
    }
};

template <class Epi, class Sched, bool ALIGN_EPI = false, bool SP2 = false>
__device__ __forceinline__ void gemm_phase(PG8_LAS unsigned char* lds, const Gemm g, const Sched& S, const Epi& E, int tid_in) {
    int tid_ = tid_in; asm volatile("" : "+v"(tid_));
    const int tid = tid_, wid = __builtin_amdgcn_readfirstlane(tid >> 6), lane = tid & 63, wr = wid >> 2, wc = wid & 3, fr = lane & 15, fq = lane >> 4;
    const int K = g.K, nt = K / BK;
    unsigned voffA[2], voffB[2];
#pragma unroll
    for (int i = 0; i < 2; ++i) { int R, C; stage_rc(tid * 16 + i * 8192, R, C); const int Rb = Epi::PERM ? ((R & ~31) + perm32(R & 31)) : R;
        voffA[i] = (unsigned)(R * K + C) * 2u; voffB[i] = (unsigned)(Rb * K + C) * 2u; }
    const size_t kstep = (size_t)(BK * 2);
    const size_t hstep = (size_t)HALF * K * 2;
    const size_t tstep = 2 * hstep;
    const unsigned ldsw = (unsigned)wid * 1024u;
    const int aoff = lds_byte(wr * 64 + fr, fq * 8), boff = lds_byte(wc * 32 + fr, fq * 8);
#define PG8_SA(b, h) (((b) * 2 + (h)) * HTB)
#define PG8_SB(b, h) ((4 + (b) * 2 + (h)) * HTB)
#define PG8_STAGE(bufoff, gbase, voff) do { _Pragma("unroll") for (int _i = 0; _i < 2; ++_i) \
        __builtin_amdgcn_global_load_lds((const unsigned*)((const char*)(gbase) + (voff)[_i]), (PG8_LAS unsigned*)(lds + (bufoff) + ldsw + _i * 8192), 16, 0, 0); } while (0)
#define PG8_LDA(dst, b, h) do { _Pragma("unroll") for (int m = 0; m < 4; ++m) _Pragma("unroll") for (int k = 0; k < 2; ++k) dst[m][k] = *(const PG8_LAS bf16x8*)(lds + PG8_SA(b, h) + aoff + m * 2048 + k * 1024); } while (0)
#define PG8_LDB(dst, b, h) do { _Pragma("unroll") for (int n = 0; n < 2; ++n) _Pragma("unroll") for (int k = 0; k < 2; ++k) dst[n][k] = *(const PG8_LAS bf16x8*)(lds + PG8_SB(b, h) + boff + n * 2048 + k * 1024); } while (0)
#define PG8_MMA(ai, bj, At, Bt) do { __builtin_amdgcn_s_setprio(1); _Pragma("unroll") for (int m = 0; m < 4; ++m) _Pragma("unroll") for (int n = 0; n < 2; ++n) _Pragma("unroll") for (int k = 0; k < 2; ++k) \
        acc[ai][bj][m][n] = __builtin_amdgcn_mfma_f32_16x16x32_bf16(Bt[n][k], At[m][k], acc[ai][bj][m][n], 0, 0, 0); __builtin_amdgcn_s_setprio(0); } while (0)
#define PG8_WAIT_V(n) asm volatile("s_waitcnt vmcnt(" #n ")" ::: "memory")
#define PG8_WAIT_L(n) asm volatile("s_waitcnt lgkmcnt(" #n ")" ::: "memory")
#define PG8_BAR __builtin_amdgcn_s_barrier()
#define PG8_SCHED __builtin_amdgcn_sched_barrier(0)
    Unit cur, nxt; int ui = 0;
    if (!S.next(0, cur)) return;
    f32x4 acc[2][2][4][2];
#pragma unroll
    for (int a = 0; a < 2; ++a)
#pragma unroll
        for (int b = 0; b < 2; ++b)
#pragma unroll
            for (int m = 0; m < 4; ++m)
#pragma unroll
                for (int n = 0; n < 2; ++n) acc[a][b][m][n] = (f32x4){0.f, 0.f, 0.f, 0.f};
    bf16x8 At[4][2], B0[2][2], B1[2][2];
    const char* cA = (const char*)g.A + (size_t)cur.pm * tstep; const char* cB = (const char*)g.Bt + (size_t)cur.pn * tstep;
    S.a_ready(cur);
    if constexpr (SP2) {
        PG8_STAGE(PG8_SB(0, 0), cB, voffB); PG8_STAGE(PG8_SB(0, 1), cB + hstep, voffB); PG8_STAGE(PG8_SA(0, 0), cA, voffA); PG8_STAGE(PG8_SA(0, 1), cA + hstep, voffA);
        if (wr == 1) PG8_BAR;
        PG8_WAIT_V(2); PG8_BAR;
        PG8_STAGE(PG8_SB(1, 0), cB + kstep, voffB); PG8_STAGE(PG8_SA(1, 0), cA + kstep, voffA); PG8_STAGE(PG8_SB(1, 1), cB + hstep + kstep, voffB);
        PG8_WAIT_V(6); PG8_BAR;
    } else {
        PG8_STAGE(PG8_SB(0, 0), cB, voffB); PG8_STAGE(PG8_SA(0, 0), cA, voffA); PG8_STAGE(PG8_SB(0, 1), cB + hstep, voffB); PG8_STAGE(PG8_SA(0, 1), cA + hstep, voffA);
        if (wr == 1) PG8_BAR;
        PG8_WAIT_V(4); PG8_BAR;
        PG8_STAGE(PG8_SB(1, 0), cB + kstep, voffB); PG8_STAGE(PG8_SA(1, 0), cA + kstep, voffA); PG8_STAGE(PG8_SB(1, 1), cB + hstep + kstep, voffB);
        PG8_WAIT_V(6); PG8_BAR;
    }
    for (;;) {
        const bool has_next = S.next(ui + 1, nxt);
        const char* nA = has_next ? (const char*)g.A + (size_t)nxt.pm * tstep : cA; const char* nB = has_next ? (const char*)g.Bt + (size_t)nxt.pn * tstep : cB;
        for (int t = 0; t < nt; t += 2) {
            const bool last = (t == nt - 2);
            const char* a1 = cA + (size_t)(t + 1) * kstep;
            const char* a2 = last ? nA : cA + (size_t)(t + 2) * kstep; const char* b2 = last ? nB : cB + (size_t)(t + 2) * kstep;
            const char* a3 = a2 + kstep; const char* b3 = b2 + kstep;
            if (last && has_next) S.a_ready(nxt);
            if constexpr (SP2) {
            PG8_LDB(B0, 0, 0); PG8_LDB(B1, 0, 1); PG8_SCHED; PG8_LDA(At, 0, 0); PG8_STAGE(PG8_SA(1, 1), a1 + hstep, voffA);
            PG8_WAIT_V(8); PG8_WAIT_L(0); PG8_BAR; PG8_MMA(0, 0, At, B0); PG8_MMA(0, 1, At, B1); PG8_BAR; PG8_SCHED;
            PG8_LDA(At, 0, 1); PG8_STAGE(PG8_SB(0, 0), b2, voffB); PG8_STAGE(PG8_SB(0, 1), b2 + hstep, voffB); PG8_STAGE(PG8_SA(0, 0), a2, voffA);
            PG8_WAIT_V(8); PG8_WAIT_L(0); PG8_BAR; PG8_MMA(1, 0, At, B0); PG8_MMA(1, 1, At, B1); PG8_BAR; PG8_SCHED;
            PG8_LDB(B0, 1, 0); PG8_LDB(B1, 1, 1); PG8_SCHED; PG8_LDA(At, 1, 0); PG8_STAGE(PG8_SA(0, 1), a2 + hstep, voffA);
            PG8_WAIT_V(8); PG8_WAIT_L(0); PG8_BAR; PG8_MMA(0, 0, At, B0); PG8_MMA(0, 1, At, B1); PG8_BAR; PG8_SCHED;
            PG8_LDA(At, 1, 1); PG8_STAGE(PG8_SB(1, 0), b3, voffB); PG8_STAGE(PG8_SB(1, 1), b3 + hstep, voffB); PG8_STAGE(PG8_SA(1, 0), a3, voffA);
            PG8_WAIT_V(8); PG8_WAIT_L(0); PG8_BAR; PG8_MMA(1, 0, At, B0); PG8_MMA(1, 1, At, B1); PG8_BAR; PG8_SCHED;
            } else {
            PG8_LDB(B0, 0, 0); PG8_SCHED; PG8_LDA(At, 0, 0); PG8_STAGE(PG8_SA(1, 1), a1 + hstep, voffA);
            PG8_WAIT_L(8); PG8_BAR; PG8_WAIT_L(0); PG8_MMA(0, 0, At, B0); PG8_BAR; PG8_SCHED;
            PG8_LDB(B1, 0, 1); PG8_STAGE(PG8_SB(0, 0), b2, voffB);
            PG8_BAR; PG8_WAIT_L(0); PG8_MMA(0, 1, At, B1); PG8_BAR;
            PG8_LDA(At, 0, 1); PG8_STAGE(PG8_SA(0, 0), a2, voffA);
            PG8_BAR; PG8_WAIT_L(0); PG8_MMA(1, 0, At, B0); PG8_BAR; PG8_SCHED;
            PG8_STAGE(PG8_SB(0, 1), b2 + hstep, voffB);
            PG8_WAIT_V(6); PG8_BAR; PG8_MMA(1, 1, At, B1); PG8_BAR;
            PG8_LDB(B0, 1, 0); PG8_SCHED; PG8_LDA(At, 1, 0); PG8_STAGE(PG8_SA(0, 1), a2 + hstep, voffA);
            PG8_WAIT_L(8); PG8_BAR; PG8_WAIT_L(0); PG8_MMA(0, 0, At, B0); PG8_BAR; PG8_SCHED;
            PG8_LDB(B1, 1, 1); PG8_STAGE(PG8_SB(1, 0), b3, voffB);
            PG8_BAR; PG8_WAIT_L(0); PG8_MMA(0, 1, At, B1); PG8_BAR;
            PG8_LDA(At, 1, 1); PG8_STAGE(PG8_SA(1, 0), a3, voffA);
            PG8_BAR; PG8_WAIT_L(0); PG8_MMA(1, 0, At, B0); PG8_BAR; PG8_SCHED;
            PG8_STAGE(PG8_SB(1, 1), b3 + hstep, voffB);
            PG8_WAIT_V(6); PG8_BAR; PG8_MMA(1, 1, At, B1); PG8_BAR;
            }
        }
        if constexpr (ALIGN_EPI) { if (wr == 0) PG8_BAR; }
        if constexpr (!Epi::AFTER_DRAIN) { E(acc, cur, ui, wr, wc, fr, fq); S.done(cur); }
        if (!has_next) break;
#pragma unroll
        for (int a = 0; a < 2; ++a)
#pragma unroll
            for (int b = 0; b < 2; ++b)
#pragma unroll
                for (int m = 0; m < 4; ++m)
#pragma unroll
                    for (int n = 0; n < 2; ++n) acc[a][b][m][n] = (f32x4){0.f, 0.f, 0.f, 0.f};
        cur = nxt; cA = nA; cB = nB; ++ui;
        if constexpr (ALIGN_EPI) { if (wr == 1) PG8_BAR; }
    }
    PG8_WAIT_V(0);
    if constexpr (!ALIGN_EPI) { if (wr == 0) PG8_BAR; }
    PG8_BAR;
    if constexpr (Epi::AFTER_DRAIN) { E.fused(acc, cur, wr, wc, fr, fq, lds, wid, lane); S.done(cur); }
#undef PG8_SA
#undef PG8_SB
#undef PG8_STAGE
#undef PG8_LDA
#undef PG8_LDB
#undef PG8_MMA
#undef PG8_WAIT_V
#undef PG8_WAIT_L
#undef PG8_BAR
#undef PG8_SCHED
}
}
namespace pg8 {
__device__ __forceinline__ float bf_lo(unsigned w) { return __uint_as_float(w << 16); }
__device__ __forceinline__ float bf_hi(unsigned w) { return __uint_as_float(w & 0xffff0000u); }
__device__ __forceinline__ float sigm(float x) { return 1.0f / (1.0f + __expf(-x)); }
typedef unsigned u32x2 __attribute__((ext_vector_type(2)));

struct EpiProj {
    static constexpr bool PERM = true, AFTER_DRAIN = false;
    bf16_t* O; int ldc; const PG8_LAS float* rstd;
    __device__ __forceinline__ void operator()(const f32x4 (&acc)[2][2][4][2], const Unit& u, int ui, int wr, int wc, int fr, int fq) const {
        const int rt0 = wr * 64 + fr, col0 = u.pn * BM + wc * 32 + 8 * fq;
#pragma unroll
        for (int ai = 0; ai < 2; ++ai)
#pragma unroll
            for (int m = 0; m < 4; ++m) { const int rt = rt0 + ai * HALF + m * 16; const float s = rstd[ui * 256 + rt]; bf16_t* rowp = O + (size_t)(u.pm * BM + rt) * ldc + col0;
#pragma unroll
                for (int bj = 0; bj < 2; ++bj) { const f32x4 v0 = acc[ai][bj][m][0] * s, v1 = acc[ai][bj][m][1] * s;
                    u32x4 w; w.x = cvt_pk_bf16(v0[0], v0[1]); w.y = cvt_pk_bf16(v0[2], v0[3]); w.z = cvt_pk_bf16(v1[0], v1[1]); w.w = cvt_pk_bf16(v1[2], v1[3]);
                    *(u32x4*)(rowp + bj * HALF) = w; } }
    }
};
struct EpiPA {
    static constexpr bool PERM = false, AFTER_DRAIN = false;
    float* P; const bf16_t* G; int ldg;
    __device__ __forceinline__ void operator()(const f32x4 (&acc)[2][2][4][2], const Unit& u, int ui, int wr, int wc, int fr, int fq) const {
        const int col0 = u.pn * BM + wc * 32 + 4 * fq;
#pragma unroll
        for (int ai = 0; ai < 2; ++ai)
#pragma unroll
            for (int m = 0; m < 4; ++m) { const int row = u.pm * BM + ai * HALF + wr * 64 + m * 16 + fr;
#pragma unroll
                for (int bj = 0; bj < 2; ++bj)
#pragma unroll
                    for (int n = 0; n < 2; ++n) { const int c = col0 + bj * HALF + n * 16; const u32x2 g = *(const u32x2*)(G + (size_t)row * ldg + c);
                        f32x4 v = acc[ai][bj][m][n]; v[0] *= sigm(bf_lo(g.x)); v[1] *= sigm(bf_hi(g.x)); v[2] *= sigm(bf_lo(g.y)); v[3] *= sigm(bf_hi(g.y));
                        *(f32x4*)(P + (size_t)row * 2048 + c) = v; } }
    }
};
struct EpiMerge {
    static constexpr bool PERM = true, AFTER_DRAIN = false;
    bf16_t* O; const float* P; const bf16_t* G; int ldg;
    __device__ __forceinline__ void operator()(const f32x4 (&acc)[2][2][4][2], const Unit& u, int ui, int wr, int wc, int fr, int fq) const {
        const int col0 = u.pn * BM + wc * 32 + 8 * fq;
#pragma unroll
        for (int ai = 0; ai < 2; ++ai)
#pragma unroll
            for (int m = 0; m < 4; ++m) { const int row = u.pm * BM + ai * HALF + wr * 64 + m * 16 + fr;
#pragma unroll
                for (int bj = 0; bj < 2; ++bj) { const int c = col0 + bj * HALF; const u32x4 g = *(const u32x4*)(G + (size_t)row * ldg + c);
                    const f32x4 p0 = *(const f32x4*)(P + (size_t)row * 2048 + c), p1 = *(const f32x4*)(P + (size_t)row * 2048 + c + 4);
                    f32x4 v0 = acc[ai][bj][m][0], v1 = acc[ai][bj][m][1];
                    v0[0] = p0[0] + sigm(bf_lo(g.x)) * v0[0]; v0[1] = p0[1] + sigm(bf_hi(g.x)) * v0[1]; v0[2] = p0[2] + sigm(bf_lo(g.y)) * v0[2]; v0[3] = p0[3] + sigm(bf_hi(g.y)) * v0[3];
                    v1[0] = p1[0] + sigm(bf_lo(g.z)) * v1[0]; v1[1] = p1[1] + sigm(bf_hi(g.z)) * v1[1]; v1[2] = p1[2] + sigm(bf_lo(g.w)) * v1[2]; v1[3] = p1[3] + sigm(bf_hi(g.w)) * v1[3];
                    u32x4 w; w.x = cvt_pk_bf16(v0[0], v0[1]); w.y = cvt_pk_bf16(v0[2], v0[3]); w.z = cvt_pk_bf16(v1[0], v1[1]); w.w = cvt_pk_bf16(v1[2], v1[3]);
                    *(u32x4*)(O + (size_t)row * 2048 + c) = w; } }
    }
};
struct EpiRes {
    static constexpr bool PERM = false, AFTER_DRAIN = false;
    float* H; bf16_t* HB; float* RS;
    __device__ __forceinline__ void operator()(const f32x4 (&acc)[2][2][4][2], const Unit& u, int ui, int wr, int wc, int fr, int fq) const {
        const int col0 = u.pn * BM + wc * 32 + 4 * fq;
#pragma unroll
        for (int ai = 0; ai < 2; ++ai)
#pragma unroll
            for (int m = 0; m < 4; ++m) { const int row = u.pm * BM + ai * HALF + wr * 64 + m * 16 + fr; float ss = 0.f;
#pragma unroll
                for (int bj = 0; bj < 2; ++bj)
#pragma unroll
                    for (int n = 0; n < 2; ++n) { const size_t off = (size_t)row * 2048 + col0 + bj * HALF + n * 16;
                        f32x4 hv = *(const f32x4*)(H + off); hv += acc[ai][bj][m][n]; *(f32x4*)(H + off) = hv;
                        u32x2 w; w.x = cvt_pk_bf16(hv[0], hv[1]); w.y = cvt_pk_bf16(hv[2], hv[3]); *(u32x2*)(HB + off) = w;
                        ss += (hv[0] * hv[0] + hv[1] * hv[1]) + (hv[2] * hv[2] + hv[3] * hv[3]); }
                ss += __shfl_xor(ss, 16); ss += __shfl_xor(ss, 32);
                if (fq == 0) RS[(size_t)row * 32 + u.pn * 4 + wc] = ss; }
    }
};
}

#define GAS __attribute__((address_space(1)))
#define LAS __attribute__((address_space(3)))
typedef unsigned short bf16;
typedef unsigned v4u __attribute__((ext_vector_type(4)));
typedef float f32x4 __attribute__((ext_vector_type(4)));
typedef short bf16x8 __attribute__((ext_vector_type(8)));
typedef GAS unsigned gu32;
typedef GAS unsigned long long gu64;
#define RLX_AGENT __ATOMIC_RELAXED, __HIP_MEMORY_SCOPE_AGENT
#define LDS_WAIT() asm volatile("s_waitcnt lgkmcnt(0)" ::: "memory")
#define VM_WAIT() asm volatile("s_waitcnt vmcnt(0)" ::: "memory")
__device__ __forceinline__ unsigned long long rt() { return __builtin_amdgcn_s_memrealtime(); }
__device__ __forceinline__ unsigned f2bf(float f) { unsigned u = __builtin_bit_cast(unsigned, f); return (u + 0x7fffu + ((u >> 16) & 1u)) >> 16; }
__device__ __forceinline__ unsigned pk2(float lo, float hi) { return f2bf(lo) | (f2bf(hi) << 16); }

#define XB_TMO      128
#define XB_XCNT(j)  (256  + 64 * (j))
#define XB_XSUB(j)  (1280 + 64 * (j))
#define XB_XGEN(j)  (2304 + 64 * (j))
#define XB_TOP      3328
#define XB_TOPGEN   3392
#define XCD_BAR_WORDS 3456
#define XB_SPIN_CAP (1u << 18)

__device__ __forceinline__ unsigned xb_ld(unsigned* p)              { return __hip_atomic_load(p, __ATOMIC_RELAXED, __HIP_MEMORY_SCOPE_AGENT); }
__device__ __forceinline__ unsigned xb_add(unsigned* p, unsigned v) { return __hip_atomic_fetch_add(p, v, __ATOMIC_RELAXED, __HIP_MEMORY_SCOPE_AGENT); }
__device__ __forceinline__ unsigned xb_xcc_id() { return (unsigned)__builtin_amdgcn_s_getreg((3 << 11) | 20) & 0xFu; }
#define XB_SPIN(cond, bar) do { unsigned _sp = 0; while (cond) { __builtin_amdgcn_s_sleep(1); \
    if ((++_sp & 255u) == 0u) { if (xb_ld(&(bar)[XB_TMO])) break; if (_sp > XB_SPIN_CAP) { atomicAdd(&(bar)[XB_TMO], 1u); break; } } } } while (0)

struct XcdBarrier {
    unsigned* bar; unsigned x;
    volatile LAS unsigned* st;
};

__device__ __forceinline__ XcdBarrier xcd_barrier_post(unsigned* bar, volatile LAS unsigned* st) {
    XcdBarrier b; b.bar = bar; b.x = xb_xcc_id(); b.st = st;
    if (threadIdx.x == 0) (void)xb_add(&bar[XB_XCNT(b.x)], 1u);
    return b;
}
__device__ __forceinline__ void xcd_barrier_complete(unsigned* bar, unsigned x, unsigned& nloc, unsigned& nx) {
    const unsigned G = gridDim.x * gridDim.y * gridDim.z;
    unsigned sum, cnt, mine, sp = 0u;
    for (;;) {
        sum = 0u; cnt = 0u; mine = 0u;
#pragma unroll
        for (unsigned j = 0; j < 16; ++j) { const unsigned c = xb_ld(&bar[XB_XCNT(j)]); sum += c; cnt += (c > 0u) ? 1u : 0u; mine = (j == x) ? c : mine; }
        if (sum == G) break;
        __builtin_amdgcn_s_sleep(1);
        if ((++sp & 255u) == 0u) { if (xb_ld(&bar[XB_TMO])) break; if (sp > XB_SPIN_CAP) { atomicAdd(&bar[XB_TMO], 1u); break; } }
    }
    nloc = mine > 0u ? mine : 1u; nx = cnt > 0u ? cnt : 1u;
}

__device__ __forceinline__ void xcd_barrier(const XcdBarrier& b) {
    asm volatile("s_waitcnt vmcnt(0)" ::: "memory");
    __syncthreads();
    if (threadIdx.x == 0) {
        unsigned* bar = b.bar;
        __builtin_amdgcn_s_waitcnt(0);
        unsigned nloc = b.st[0], nx = b.st[1];
        if (nloc == 0u) { xcd_barrier_complete(bar, b.x, nloc, nx); b.st[0] = nloc; b.st[1] = nx; }
        const unsigned old = xb_add(&bar[XB_XSUB(b.x)], 1u);
        const unsigned gen = old / nloc;
        if (old + 1u == (gen + 1u) * nloc) {
            __builtin_amdgcn_fence(__ATOMIC_RELEASE, "agent");
            asm volatile("s_waitcnt vmcnt(0)" ::: "memory");
            const unsigned og = xb_add(&bar[XB_TOP], 1u);
            const unsigned tg = og / nx;
            if (og + 1u == (tg + 1u) * nx) xb_add(&bar[XB_TOPGEN], 1u);
            else XB_SPIN(xb_ld(&bar[XB_TOPGEN]) == tg, bar);
            __builtin_amdgcn_fence(__ATOMIC_ACQUIRE, "agent");
            xb_add(&bar[XB_XGEN(b.x)], 1u);
            asm volatile("s_waitcnt vmcnt(0)" ::: "memory");
        } else {
            XB_SPIN(xb_ld(&bar[XB_XGEN(b.x)]) == gen, bar);
            __builtin_amdgcn_fence(__ATOMIC_ACQUIRE, "agent");
            asm volatile("s_waitcnt vmcnt(0)" ::: "memory");
        }
    }
    __syncthreads();
}
#ifndef MK_PROBE
#define MK_PROBE (-1)
#endif
#ifndef MK_PROBE_SCALE
#define MK_PROBE_SCALE 5e-7f
#endif
#define PROBE_T0() unsigned long long pt0_ = 0; if (MK_PROBE >= 0) { pt0_ = __builtin_amdgcn_s_memtime(); asm volatile("s_waitcnt lgkmcnt(0)" ::: "memory"); }
#define PROBE_T1(id) do { if (MK_PROBE == (id)) { const unsigned long long pt1_ = __builtin_amdgcn_s_memtime(); asm volatile("s_waitcnt lgkmcnt(0)" ::: "memory"); \
    if (C.bid == 0 && C.wave == 0 && C.lane == 0) { volatile LAS unsigned* pw_ = (volatile LAS unsigned*)(C.lds + MISC_OFF + 64); pw_[0] = pw_[0] + (unsigned)(pt1_ - pt0_); } } } while (0)
constexpr int NWAVES = 8;
constexpr int NLAYER = 4, DM = 2048, NBATCH = 2, SEQ = 4096, NMETA = 16, LTOK = SEQ + NMETA, NTOK = NBATCH * LTOK;
constexpr int MP = 8448;
constexpr int NP1 = 8448;
constexpr int NC_IN = 8264;
constexpr int PC_QA = 0, PC_KA = 1024, PC_VA = 1152, PC_ZA = 1280, PC_CQ = 2304, PC_CKV = 2816, PC_ZB = 3072, PC_GA = 4096, PC_GB = 6144, PC_KIDX = 8192, PC_WIDX = 8256;
constexpr int NQ2 = 4608;
constexpr int TOPK = 256;
constexpr float RMS_EPS = 1e-6f;

__device__ __forceinline__ int rowof(int b, int t) { return t < NMETA ? 8192 + b * NMETA + t : b * SEQ + (t - NMETA); }
__device__ __forceinline__ int t5_bucket(int d) {
    const int n = d < 0 ? 0 : d;
    if (n < 16) return n;
    return 16 + (n >= 19) + (n >= 21) + (n >= 24) + (n >= 27) + (n >= 31) + (n >= 35) + (n >= 40) + (n >= 46) + (n >= 52) + (n >= 59) + (n >= 67) + (n >= 77) + (n >= 87) + (n >= 99) + (n >= 113);
}
__device__ __forceinline__ float bf2f(bf16 v) { return __uint_as_float((unsigned)v << 16); }
__device__ __forceinline__ float sigmoidf_(float x) { return 1.0f / (1.0f + __expf(-x)); }
__device__ __forceinline__ float siluf_(float x) { return x / (1.0f + __expf(-x)); }
__device__ __forceinline__ float wave_sum(float v) {
#pragma unroll
    for (int o = 1; o < 64; o <<= 1) v += __shfl_xor(v, o);
    return v;
}
__device__ __forceinline__ float wave_max(float v) {
#pragma unroll
    for (int o = 1; o < 64; o <<= 1) v = fmaxf(v, __shfl_xor(v, o));
    return v;
}
__device__ __forceinline__ int wave_sum_i(int v) {
#pragma unroll
    for (int o = 1; o < 64; o <<= 1) v += __shfl_xor(v, o);
    return v;
}

constexpr size_t MiB = 1u << 20;
constexpr size_t WS_CTL = 0, CTL_ZERO_BYTES = 1 * MiB;
constexpr size_t SZ_W1 = (size_t)NLAYER * NP1 * DM * 2, SZ_W2 = (size_t)NLAYER * NQ2 * 512 * 2, SZ_WA = (size_t)NLAYER * DM * 1024 * 2, SZ_WO = (size_t)NLAYER * DM * DM * 2;
constexpr size_t al(size_t x) { return (x + 4095) / 4096 * 4096; }
constexpr size_t WS_W1 = 1 * MiB, WS_W2 = WS_W1 + al(SZ_W1), WS_WA = WS_W2 + al(SZ_W2), WS_WB = WS_WA + al(SZ_WA), WS_WO = WS_WB + al(SZ_WA);
constexpr size_t SZ_WUV = (size_t)NLAYER * 16 * 64 * 256 * 2;
constexpr size_t WS_WUV = WS_WO + al(SZ_WO);
constexpr size_t WS_VT = WS_WUV + al(SZ_WUV);
constexpr size_t WS_H = WS_VT + al((size_t)2 * 128 * 4128 * 2), WS_HB = WS_H + al((size_t)MP * DM * 4), WS_RS = WS_HB + al((size_t)MP * DM * 2);
constexpr size_t WS_RS2 = WS_RS + al((size_t)MP * 32 * 4);
constexpr size_t WS_PROJ = WS_RS2 + al((size_t)32 * 64 * 4), WS_CQN = WS_PROJ + al((size_t)MP * NP1 * 2), WS_CKVN = WS_CQN + al((size_t)MP * 512 * 2);
constexpr size_t WS_Q2 = WS_CKVN + al((size_t)MP * 256 * 2), WS_OLAT = WS_Q2 + al((size_t)MP * NQ2 * 2), WS_YA = WS_OLAT + al((size_t)256 * 3 * 16 * 8 * 64 * 8 * 2);
constexpr size_t WS_YB = WS_YA + al((size_t)MP * 1024 * 2), WS_PA = WS_YB + al((size_t)MP * 1024 * 2), WS_MG = WS_PA + al((size_t)MP * DM * 4), WS_END = WS_MG + al((size_t)MP * DM * 2);
constexpr int CW_TMO = 0, CW_CODE = 1, CW_BAR = 4096;

constexpr int LDSCTL_OFF = 0, MISC_OFF = LDSCTL_OFF + 320;
constexpr int RSTD_OFF = 512;
constexpr int RING_OFF = 8192, RING_BYTES = 131072;
constexpr int LDS_BYTES = 163840;
static_assert(RSTD_OFF + 5 * 256 * 4 <= RING_OFF, "LDS map");

struct Args {
    const float* x; const float* meta; const float* bias_table; const float* norm_g; const float* w_in; const float* q_norm_g; const float* kv_norm_g; const float* w_qb; const float* w_iq;
    const float* w_uk; const float* w_uv; const float* sinks; const float* w_proj_a; const float* w_proj_b; const float* w_out; const float* final_g;
    float* out; unsigned char* ws; int ph_lo, ph_hi;
};

__device__ __forceinline__ void xpose_item(const float* __restrict__ W, int ldw, int k0, int c0, int nvalid, const float* __restrict__ scale, bf16* out, int K, LAS float* scr, int lane) {
    const int c = lane & 31;
#pragma unroll 8
    for (int i = 0; i < 32; ++i) { const int kk = 2 * i + (lane >> 5); float v = (c < nvalid) ? W[(size_t)(k0 + kk) * ldw + c0 + c] : 0.f; if (scale) v *= scale[k0 + kk]; scr[kk * 33 + c] = v; }
    LDS_WAIT(); asm volatile("" ::: "memory");
    const int cc = lane & 7;
#pragma unroll
    for (int j = 0; j < 4; ++j) { const int n = (lane >> 3) + 8 * j; const LAS float* s = scr + (8 * cc) * 33 + n;
        v4u o; o.x = pk2(s[0 * 33], s[1 * 33]); o.y = pk2(s[2 * 33], s[3 * 33]); o.z = pk2(s[4 * 33], s[5 * 33]); o.w = pk2(s[6 * 33], s[7 * 33]);
        *(GAS v4u*)(out + (size_t)n * K + k0 + 8 * cc) = o; }
    LDS_WAIT(); asm volatile("" ::: "memory");
}
__device__ __forceinline__ void fold_item(const float* __restrict__ wqb, const float* __restrict__ wuk, const float* __restrict__ gq, bf16* W2l, int h, int kb, int rb, LAS float* scr, int lane) {
    const int rr = lane & 31, r = rb * 32 + rr;
    float uk[64];
#pragma unroll
    for (int d = 0; d < 64; ++d) uk[d] = wuk[((size_t)h * 64 + d) * 256 + r];
    for (int i = 0; i < 32; ++i) { const int kk = 2 * i + (lane >> 5), k = kb * 64 + kk; const f32x4* qp = (const f32x4*)(wqb + (size_t)k * 1024 + h * 64); float a = 0.f;
#pragma unroll
        for (int d4 = 0; d4 < 16; ++d4) { const f32x4 q = qp[d4]; a = fmaf(q[0], uk[4 * d4], a); a = fmaf(q[1], uk[4 * d4 + 1], a); a = fmaf(q[2], uk[4 * d4 + 2], a); a = fmaf(q[3], uk[4 * d4 + 3], a); }
        scr[kk * 33 + rr] = a * gq[k]; }
    LDS_WAIT(); asm volatile("" ::: "memory");
    const int cc = lane & 7; bf16* out = W2l + (size_t)(h * 256 + rb * 32) * 512;
#pragma unroll
    for (int j = 0; j < 4; ++j) { const int n = (lane >> 3) + 8 * j; const LAS float* s = scr + (8 * cc) * 33 + n;
        v4u o; o.x = pk2(s[0 * 33], s[1 * 33]); o.y = pk2(s[2 * 33], s[3 * 33]); o.z = pk2(s[4 * 33], s[5 * 33]); o.w = pk2(s[6 * 33], s[7 * 33]);
        *(GAS v4u*)(out + (size_t)n * 512 + kb * 64 + 8 * cc) = o; }
    LDS_WAIT(); asm volatile("" ::: "memory");
}

struct Ctx {
    LAS unsigned char* lds; int tid, lane, wave, G, gw, NGW, bid;
    Args a;
};
__device__ __forceinline__ unsigned char* launder(unsigned char* p) { asm volatile("" : "+s"(p)); return p; }
__device__ __forceinline__ const float* launderf(const float* p) { asm volatile("" : "+s"(p)); return p; }
struct Bufs {
    bf16 *W1, *W2, *WA, *WB, *WO, *WUV, *VT, *HB, *PROJ, *CQN, *CKVN, *Q2, *OLAT, *YA, *YB, *MG; float *H, *RS, *RS2, *PA;
    __device__ __forceinline__ explicit Bufs(unsigned char* ws0) {
        unsigned char* ws = launder(ws0);
        W1 = (bf16*)(ws + WS_W1); W2 = (bf16*)(ws + WS_W2); WA = (bf16*)(ws + WS_WA); WB = (bf16*)(ws + WS_WB); WO = (bf16*)(ws + WS_WO); WUV = (bf16*)(ws + WS_WUV); VT = (bf16*)(ws + WS_VT);
        H = (float*)(ws + WS_H); HB = (bf16*)(ws + WS_HB); RS = (float*)(ws + WS_RS); RS2 = (float*)(ws + WS_RS2); PROJ = (bf16*)(ws + WS_PROJ); CQN = (bf16*)(ws + WS_CQN); CKVN = (bf16*)(ws + WS_CKVN);
        Q2 = (bf16*)(ws + WS_Q2); OLAT = (bf16*)(ws + WS_OLAT); YA = (bf16*)(ws + WS_YA); YB = (bf16*)(ws + WS_YB); PA = (float*)(ws + WS_PA); MG = (bf16*)(ws + WS_MG);
    }
};

__device__ __forceinline__ void p0_prologue(const Ctx& C) {
    const Bufs B(C.a.ws);
    const Args& A = C.a;
    LAS float* scr = (LAS float*)(C.lds + RING_OFF + C.wave * 16384);
    constexpr int I_T1 = (DM / 64) * (NP1 / 32), I_T2 = (512 / 64) * (512 / 32), I_T3 = (1024 / 64) * (DM / 32), I_T5 = (DM / 64) * (DM / 32), I_F = 16 * 8 * 8, I_UV = 16 * 4 * 2;
    constexpr int I_LAYER = I_T1 + I_T2 + 2 * I_T3 + I_T5 + I_F + I_UV, NITEMS = NLAYER * I_LAYER;
    for (int it = C.gw; it < NITEMS; it += C.NGW) {
        const int l = it / I_LAYER; int r = it % I_LAYER;
        if (r < I_T1) { const int nblk = NP1 / 32, kb = r / nblk, nb = r % nblk, n0 = nb * 32;
            int c0, nvalid = 32;
            if (n0 < 4096) c0 = n0; else if (n0 < 8192) c0 = n0 + 72; else { c0 = n0 - 8192 + 4096; nvalid = NC_IN - 4096 - 72 - 4096 + 0; nvalid = (8264 - n0) < 0 ? 0 : ((8264 - n0) > 32 ? 32 : (8264 - n0)); }
            xpose_item(A.w_in + (size_t)l * DM * NC_IN, NC_IN, kb * 64, c0, nvalid, A.norm_g + l * DM, B.W1 + ((size_t)l * NP1 + n0) * DM, DM, scr, C.lane); continue; }
        r -= I_T1;
        if (r < I_T2) { const int nblk = 512 / 32, kb = r / nblk, nb = r % nblk;
            xpose_item(A.w_iq + (size_t)l * 512 * 512, 512, kb * 64, nb * 32, 32, A.q_norm_g + l * 512, B.W2 + ((size_t)l * NQ2 + 4096 + nb * 32) * 512, 512, scr, C.lane); continue; }
        r -= I_T2;
        if (r < I_T3) { const int nblk = DM / 32, kb = r / nblk, nb = r % nblk;
            xpose_item(A.w_proj_a + (size_t)l * 1024 * DM, DM, kb * 64, nb * 32, 32, nullptr, B.WA + ((size_t)l * DM + nb * 32) * 1024, 1024, scr, C.lane); continue; }
        r -= I_T3;
        if (r < I_T3) { const int nblk = DM / 32, kb = r / nblk, nb = r % nblk;
            xpose_item(A.w_proj_b + (size_t)l * 1024 * DM, DM, kb * 64, nb * 32, 32, nullptr, B.WB + ((size_t)l * DM + nb * 32) * 1024, 1024, scr, C.lane); continue; }
        r -= I_T3;
        if (r < I_T5) { const int nblk = DM / 32, kb = r / nblk, nb = r % nblk;
            xpose_item(A.w_out + (size_t)l * DM * DM, DM, kb * 64, nb * 32, 32, nullptr, B.WO + ((size_t)l * DM + nb * 32) * DM, DM, scr, C.lane); continue; }
        r -= I_T5;
        if (r >= I_F) { r -= I_F; const int h = r / 8, s = r % 8;
            const float* wsrc = A.w_uv + ((size_t)l * 16 + h) * 256 * 64; const int gg = C.lane >> 4, cc = C.lane & 15;
#pragma unroll
            for (int nt = 0; nt < 4; ++nt) { const float* p = wsrc + (size_t)(32 * s + 8 * gg) * 64 + 16 * nt + cc;
                v4u o; o.x = pk2(p[0 * 64], p[1 * 64]); o.y = pk2(p[2 * 64], p[3 * 64]); o.z = pk2(p[4 * 64], p[5 * 64]); o.w = pk2(p[6 * 64], p[7 * 64]);
                *(GAS v4u*)(B.WUV + ((((size_t)l * 16 + h) * 8 + s) * 4 + nt) * 512 + C.lane * 8) = o; }
            continue; }
        { const int h = r / 64, kb = (r / 8) % 8, rb = r % 8;
            fold_item(A.w_qb + (size_t)l * 512 * 1024, A.w_uk + (size_t)l * 16 * 64 * 256, A.q_norm_g + l * 512, B.W2 + (size_t)l * NQ2 * 512, h, kb, rb, scr, C.lane); }
    }
    for (int m = C.gw; m < MP; m += C.NGW) {
        const float* src = nullptr;
        if (m < 8192) src = A.x + (size_t)m * DM; else if (m < 8224) src = A.meta + (size_t)((m - 8192) % NMETA) * DM;
        float ss = 0.f;
#pragma unroll
        for (int j = 0; j < 8; ++j) { f32x4 v = src ? *(const f32x4*)(src + j * 256 + C.lane * 4) : (f32x4){0.f, 0.f, 0.f, 0.f};
            *(f32x4*)(B.H + (size_t)m * DM + j * 256 + C.lane * 4) = v;
            pg8::u32x2 w; w.x = pk2(v[0], v[1]); w.y = pk2(v[2], v[3]); *(pg8::u32x2*)(B.HB + (size_t)m * DM + j * 256 + C.lane * 4) = w;
            ss += (v[0] * v[0] + v[1] * v[1]) + (v[2] * v[2] + v[3] * v[3]); }
        ss = wave_sum(ss);
        if (C.lane < 32) B.RS[(size_t)m * 32 + C.lane] = (C.lane == 0) ? ss : 0.f;
        if (m >= 8192 && m < 8224) B.RS2[(size_t)(m - 8192) * 64 + C.lane] = (C.lane == 0) ? ss : 0.f;
        if (m >= NTOK) {
#pragma unroll
            for (int j = 0; j < 2; ++j) { *(v4u*)(B.YA + (size_t)m * 1024 + j * 512 + C.lane * 8) = (v4u){0u, 0u, 0u, 0u}; *(v4u*)(B.YB + (size_t)m * 1024 + j * 512 + C.lane * 8) = (v4u){0u, 0u, 0u, 0u}; }
        }
    }
}

__device__ __forceinline__ void g1_rstd_table(const Ctx& C, const pg8::StaticOrder& S) {
    const Bufs B(C.a.ws);
    LAS float* tbl = (LAS float*)(C.lds + RSTD_OFF);
    pg8::Unit u;
    for (int ui = 0; ui < 5 && S.next(ui, u); ++ui) {
        if (C.tid < 256) { const f32x4* p = (const f32x4*)(B.RS + (size_t)(u.pm * 256 + C.tid) * 32); float s = 0.f;
#pragma unroll
            for (int j = 0; j < 8; ++j) { const f32x4 v = p[j]; s += (v[0] + v[1]) + (v[2] + v[3]); }
            tbl[ui * 256 + C.tid] = rsqrtf(s * (1.0f / DM) + RMS_EPS); }
    }
    __syncthreads();
}

__device__ __forceinline__ void norm_phase(const Ctx& C, int l) {
    const Bufs B(C.a.ws);
    const Args& A = C.a;
    for (int m = C.gw; m < NTOK; m += C.NGW) {
        const bf16* pr = B.PROJ + (size_t)m * NP1;
        { const v4u w = *(const v4u*)(pr + PC_CQ + C.lane * 8); float v[8] = {pg8::bf_lo(w.x), pg8::bf_hi(w.x), pg8::bf_lo(w.y), pg8::bf_hi(w.y), pg8::bf_lo(w.z), pg8::bf_hi(w.z), pg8::bf_lo(w.w), pg8::bf_hi(w.w)};
          float ss = 0.f;
#pragma unroll
          for (int j = 0; j < 8; ++j) ss += v[j] * v[j];
          ss = wave_sum(ss); const float r = rsqrtf(ss * (1.0f / 512.0f) + RMS_EPS);
          v4u o; o.x = pk2(v[0] * r, v[1] * r); o.y = pk2(v[2] * r, v[3] * r); o.z = pk2(v[4] * r, v[5] * r); o.w = pk2(v[6] * r, v[7] * r);
          *(v4u*)(B.CQN + (size_t)m * 512 + C.lane * 8) = o; }
        { const pg8::u32x2 w = *(const pg8::u32x2*)(pr + PC_CKV + C.lane * 4); float v[4] = {pg8::bf_lo(w.x), pg8::bf_hi(w.x), pg8::bf_lo(w.y), pg8::bf_hi(w.y)};
          float ss = (v[0] * v[0] + v[1] * v[1]) + (v[2] * v[2] + v[3] * v[3]);
          ss = wave_sum(ss); const float r = rsqrtf(ss * (1.0f / 256.0f) + RMS_EPS);
          const f32x4 g = *(const f32x4*)(A.kv_norm_g + l * 256 + C.lane * 4);
          pg8::u32x2 o; o.x = pk2(v[0] * r * g[0], v[1] * r * g[1]); o.y = pk2(v[2] * r * g[2], v[3] * r * g[3]);
          *(pg8::u32x2*)(B.CKVN + (size_t)m * 256 + C.lane * 4) = o; }
    }
    for (int it = C.gw; it < 2 * 65; it += C.NGW) { const int b = it / 65, pos = (it % 65) * 64 + C.lane;
        if (pos < LTOK) { const bf16* vr = B.PROJ + (size_t)rowof(b, pos) * NP1 + PC_VA;
#pragma unroll 4
            for (int c8 = 0; c8 < 16; ++c8) { const v4u w = *(const v4u*)(vr + 8 * c8); bf16* o = B.VT + ((size_t)b * 128 + 8 * c8) * 4128 + pos;
                o[0 * 4128] = (bf16)(w.x & 0xffffu); o[1 * 4128] = (bf16)(w.x >> 16); o[2 * 4128] = (bf16)(w.y & 0xffffu); o[3 * 4128] = (bf16)(w.y >> 16);
                o[4 * 4128] = (bf16)(w.z & 0xffffu); o[5 * 4128] = (bf16)(w.z >> 16); o[6 * 4128] = (bf16)(w.w & 0xffffu); o[7 * 4128] = (bf16)(w.w >> 16); } } }
}

__device__ __forceinline__ void swa_naive(const Ctx& C, int l) {
    const Bufs B(C.a.ws);
    const Args& A = C.a;
    LAS float* ps = (LAS float*)(C.lds + RING_OFF + C.wave * 2048);
    LAS int* kp = (LAS int*)(C.lds + RING_OFF + C.wave * 2048 + 1024);
    const int lane = C.lane;
    for (int item = C.gw; item < NTOK * 16; item += C.NGW) {
        const int tok = item >> 4, head = item & 15, b = tok / LTOK, t = tok % LTOK, g = head >> 3, row = rowof(b, t);
        const int nmeta = t < NMETA ? t + 1 : NMETA;
        const int wlo = t - 127 < NMETA ? NMETA : t - 127;
        const int nwin = t < NMETA ? 0 : t - wlo + 1;
        const int ncand = nmeta + nwin;
        const bf16* q = B.PROJ + (size_t)row * NP1 + PC_QA + head * 64;
        const float sink = A.sinks[l * 16 + head];
        float mx = -3.0e38f;
        for (int c = lane; c < ncand; c += 64) {
            const int kpos = c < nmeta ? c : wlo + (c - nmeta), krow = rowof(b, kpos);
            const bf16* k = B.PROJ + (size_t)krow * NP1 + PC_KA + g * 64;
            float s = 0.f;
            for (int d = 0; d < 64; ++d) s = fmaf(bf2f(q[d]), bf2f(k[d]), s);
            s = s * 0.125f + A.bias_table[t5_bucket(t - kpos) * 32 + head];
            ps[c] = s; kp[c] = krow;
            mx = fmaxf(mx, s);
        }
        mx = fmaxf(wave_max(mx), sink);
        float sum = 0.f;
        for (int c = lane; c < ncand; c += 64) { const float p = __expf(ps[c] - mx); ps[c] = p; sum += p; }
        sum = wave_sum(sum) + __expf(sink - mx);
        LDS_WAIT(); asm volatile("" ::: "memory");
        float o = 0.f;
        for (int c = 0; c < ncand; ++c) o = fmaf(ps[c], bf2f(B.PROJ[(size_t)kp[c] * NP1 + PC_VA + g * 64 + lane]), o);
        o /= sum;
        const float z = bf2f(B.PROJ[(size_t)row * NP1 + PC_ZA + head * 64 + lane]);
        B.YA[(size_t)row * 1024 + head * 64 + lane] = (bf16)f2bf(o * siluf_(z));
        LDS_WAIT(); asm volatile("" ::: "memory");
    }
}

__device__ __forceinline__ unsigned f2key(float f) { const unsigned u = __float_as_uint(f); return (u & 0x80000000u) ? ~u : (u | 0x80000000u); }

__device__ __forceinline__ void dsa_naive(const Ctx& C, int l) {
    const Bufs B(C.a.ws);
    const Args& A = C.a;
    LAS float* s_qi = (LAS float*)(C.lds + RING_OFF + 0);
    LAS float* s_wi = (LAS float*)(C.lds + RING_OFF + 2048);
    LAS unsigned* s_key = (LAS unsigned*)(C.lds + RING_OFF + 2112);
    LAS int* s_sel = (LAS int*)(C.lds + RING_OFF + 18560);
    LAS float* s_ql = (LAS float*)(C.lds + RING_OFF + 19584);
    LAS float* s_p = (LAS float*)(C.lds + RING_OFF + 35968);
    LAS int* s_cnt = (LAS int*)(C.lds + RING_OFF + 52352);
    LAS int* s_n = (LAS int*)(C.lds + RING_OFF + 52384);
    const int tid = C.tid, lane = C.lane, wid = C.wave;
    for (int item = C.bid; item < NTOK; item += C.G) {
        const int b = item / LTOK, t = item % LTOK, row = rowof(b, t);
        __syncthreads();
        s_qi[tid] = bf2f(B.Q2[(size_t)row * NQ2 + 4096 + tid]);
        if (tid < 8) s_wi[tid] = bf2f(B.PROJ[(size_t)row * NP1 + PC_WIDX + tid]) * 0.35355339059327373f;
        for (int i = tid; i < 4096; i += 512) s_ql[i] = bf2f(B.Q2[(size_t)row * NQ2 + i]);
        __syncthreads();
        const int n = t + 1;
        for (int k = tid; k < n; k += 512) {
            const bf16* kr = B.PROJ + (size_t)rowof(b, k) * NP1 + PC_KIDX;
            float isc = 0.f;
            for (int hh = 0; hh < 8; ++hh) {
                float s = 0.f;
                for (int d = 0; d < 64; ++d) s = fmaf(s_qi[hh * 64 + d], bf2f(kr[d]), s);
                isc += s_wi[hh] * fmaxf(s * 0.125f, 0.f);
            }
            s_key[k] = f2key(isc);
        }
        __syncthreads();
        int cnt;
        if (n <= TOPK) {
            for (int i = tid; i < n; i += 512) s_sel[i] = i;
            cnt = n;
        } else {
            unsigned T = 0u;
            for (int bit = 31; bit >= 0; --bit) {
                const unsigned cand = T | (1u << bit);
                int c = 0;
                for (int k = tid; k < n; k += 512) c += (s_key[k] >= cand) ? 1 : 0;
                c = wave_sum_i(c);
                __syncthreads();
                if (lane == 0) s_cnt[wid] = c;
                __syncthreads();
                int tot = 0;
#pragma unroll
                for (int w = 0; w < 8; ++w) tot += s_cnt[w];
                if (tot >= TOPK) T = cand;
            }
            int c = 0;
            for (int k = tid; k < n; k += 512) c += (s_key[k] > T) ? 1 : 0;
            c = wave_sum_i(c);
            __syncthreads();
            if (lane == 0) s_cnt[wid] = c;
            __syncthreads();
            int ngt = 0;
#pragma unroll
            for (int w = 0; w < 8; ++w) ngt += s_cnt[w];
            const int need = TOPK - ngt;
            if (wid == 0) {
                int base = 0, eqbase = 0;
                for (int k0 = 0; k0 < n; k0 += 64) {
                    const int k = k0 + lane;
                    const unsigned key = k < n ? s_key[k] : 0u;
                    const bool gt = (k < n) && key > T, eq = (k < n) && key == T;
                    const unsigned long long meq = __ballot(eq);
                    const unsigned long long lt = (1ull << lane) - 1ull;
                    const int eqrank = eqbase + __popcll(meq & lt);
                    const bool sel = gt || (eq && eqrank < need);
                    const unsigned long long ms = __ballot(sel);
                    if (sel) s_sel[base + __popcll(ms & lt)] = k;
                    base += __popcll(ms); eqbase += __popcll(meq);
                }
                if (lane == 0) s_n[0] = base;
            }
            __syncthreads();
            cnt = s_n[0];
        }
        __syncthreads();
        {
            const int j = tid & 255, hb = (tid >> 8) * 8;
            float sc[8];
#pragma unroll
            for (int hh = 0; hh < 8; ++hh) sc[hh] = 0.f;
            if (j < cnt) {
                const int idx = s_sel[j];
                const bf16* kr = B.CKVN + (size_t)rowof(b, idx) * 256;
                for (int r = 0; r < 256; ++r) {
                    const float v = bf2f(kr[r]);
#pragma unroll
                    for (int hh = 0; hh < 8; ++hh) sc[hh] = fmaf(s_ql[(hb + hh) * 256 + r], v, sc[hh]);
                }
                const int bk = t5_bucket(t - idx);
#pragma unroll
                for (int hh = 0; hh < 8; ++hh) s_p[(hb + hh) * 256 + j] = sc[hh] * 0.125f + A.bias_table[bk * 32 + 16 + hb + hh];
            } else {
#pragma unroll
                for (int hh = 0; hh < 8; ++hh) s_p[(hb + hh) * 256 + j] = -3.0e38f;
            }
        }
        __syncthreads();
        for (int hh = wid * 2; hh < wid * 2 + 2; ++hh) {
            float v[4]; float mx = -3.0e38f;
#pragma unroll
            for (int i = 0; i < 4; ++i) { v[i] = s_p[hh * 256 + lane + 64 * i]; mx = fmaxf(mx, v[i]); }
            mx = wave_max(mx);
            float sum = 0.f;
#pragma unroll
            for (int i = 0; i < 4; ++i) { v[i] = (lane + 64 * i < cnt) ? __expf(v[i] - mx) : 0.f; sum += v[i]; }
            sum = wave_sum(sum);
            const float inv = 1.0f / sum;
#pragma unroll
            for (int i = 0; i < 4; ++i) s_p[hh * 256 + lane + 64 * i] = bf2f((bf16)f2bf(v[i] * inv));
        }
        __syncthreads();
        {
            const int r = tid & 255, hb = (tid >> 8) * 8;
            float acc[8];
#pragma unroll
            for (int hh = 0; hh < 8; ++hh) acc[hh] = 0.f;
            for (int j = 0; j < cnt; ++j) {
                const float v = bf2f(B.CKVN[(size_t)rowof(b, s_sel[j]) * 256 + r]);
#pragma unroll
                for (int hh = 0; hh < 8; ++hh) acc[hh] = fmaf(s_p[(hb + hh) * 256 + j], v, acc[hh]);
            }
#pragma unroll
            for (int hh = 0; hh < 8; ++hh) B.OLAT[(size_t)row * 4096 + (hb + hh) * 256 + r] = (bf16)f2bf(acc[hh]);
        }
    }
    __syncthreads();
}
__device__ __forceinline__ void wuv_naive(const Ctx& C, int l) {
    const Bufs B(C.a.ws);
    const Args& A = C.a;
    const float* wuv = A.w_uv + (size_t)l * 16 * 256 * 64;
    for (int item = C.bid; item < NTOK; item += C.G) {
        const int b = item / LTOK, t = item % LTOK, row = rowof(b, t);
        for (int c = C.tid; c < 1024; c += 512) {
            const int h = c >> 6, d = c & 63;
            const bf16* o = B.OLAT + (size_t)row * 4096 + h * 256;
            float a = 0.f;
            for (int r = 0; r < 256; ++r) a = fmaf(bf2f(__builtin_nontemporal_load(o + r)), bf2f((bf16)f2bf(wuv[((size_t)h * 256 + r) * 64 + d])), a);
            const float z = bf2f(B.PROJ[(size_t)row * NP1 + PC_ZB + c]);
            B.YB[(size_t)row * 1024 + c] = (bf16)f2bf(a * siluf_(z));
        }
    }
}
__device__ __forceinline__ void final_phase(const Ctx& C) {
    const Bufs B(C.a.ws);
    const Args& A = C.a;
    for (int m = C.gw; m < 8192; m += C.NGW) {
        float s = (C.lane < 32) ? B.RS[(size_t)m * 32 + C.lane] : 0.f;
        s = wave_sum(s);
        const float r = rsqrtf(s * (1.0f / DM) + RMS_EPS);
#pragma unroll
        for (int j = 0; j < 8; ++j) { const f32x4 v = *(const f32x4*)(B.H + (size_t)m * DM + j * 256 + C.lane * 4); const f32x4 g = *(const f32x4*)(A.final_g + j * 256 + C.lane * 4);
            *(f32x4*)(A.out + (size_t)m * DM + j * 256 + C.lane * 4) = v * r * g; }
    }
#if defined(MK_PROBE)
    if (MK_PROBE >= 0 && C.gw == 0) { VM_WAIT(); if (C.lane == 0) A.out[0] += (float)((volatile LAS unsigned*)(C.lds + MISC_OFF + 64))[0] * MK_PROBE_SCALE; }
#endif
}


struct SkProj { bf16* O; const LAS float* tbl; __device__ __forceinline__ float operator()(int rloc, int c, float v) const { O[(size_t)rloc * NP1 + c] = (bf16)f2bf(v * tbl[rloc]); return 0.f; } };
struct SkQ2 { bf16* O; __device__ __forceinline__ float operator()(int rloc, int c, float v) const { O[(size_t)rloc * NQ2 + c] = (bf16)f2bf(v); return 0.f; } };
struct SkPA { float* P; const bf16* G; __device__ __forceinline__ float operator()(int rloc, int c, float v) const { P[(size_t)rloc * DM + c] = sigmoidf_(bf2f(G[(size_t)rloc * NP1 + c])) * v; return 0.f; } };
struct SkMerge { bf16* O; const float* P; const bf16* G; __device__ __forceinline__ float operator()(int rloc, int c, float v) const { O[(size_t)rloc * DM + c] = (bf16)f2bf(P[(size_t)rloc * DM + c] + sigmoidf_(bf2f(G[(size_t)rloc * NP1 + c])) * v); return 0.f; } };
struct SkRes { float* H; bf16* HB; __device__ __forceinline__ float operator()(int rloc, int c, float v) const { const float h = H[(size_t)rloc * DM + c] + v; H[(size_t)rloc * DM + c] = h; HB[(size_t)rloc * DM + c] = (bf16)f2bf(h); return h; } };
constexpr int MR = 8192;
typedef float f32x16 __attribute__((ext_vector_type(16)));
template <int NT, bool WANT_SS, class F>
__device__ __forceinline__ void skinny_unit(const Ctx& C, const bf16* __restrict__ A, int lda, const bf16* __restrict__ Bt, int K, float* ss_out  , int ss_ld, int ss_col0, const F& epi) {
    const int lane = C.lane, w = C.wave, r32 = lane & 31, hh = lane >> 5;
    f32x16 acc[NT];
#pragma unroll
    for (int nt = 0; nt < NT; ++nt) acc[nt] = (f32x16){};
    const int kper = K >> 3;
    const bf16* ap = A + (size_t)r32 * lda + w * kper + 8 * hh;
    const bf16* bp = Bt + (size_t)r32 * K + w * kper + 8 * hh;
#pragma unroll 4
    for (int k = 0; k < kper; k += 16) { const bf16x8 a = *(const bf16x8*)(ap + k);
#pragma unroll
        for (int nt = 0; nt < NT; ++nt) { const bf16x8 bv = *(const bf16x8*)(bp + (size_t)nt * 32 * K + k); acc[nt] = __builtin_amdgcn_mfma_f32_32x32x16_bf16(a, bv, acc[nt], 0, 0, 0); } }
    LAS float* part = (LAS float*)(C.lds + RING_OFF);
#pragma unroll
    for (int nt = 0; nt < NT; ++nt)
#pragma unroll
        for (int i = 0; i < 16; ++i) part[(w * NT * 16 + nt * 16 + i) * 64 + lane] = acc[nt][i];
    LDS_WAIT(); __syncthreads();
#pragma unroll
    for (int j = 0; j < 2 * NT; ++j) { const int e = (w + 8 * j) * 64 + lane;
        const int nti = w + 8 * j, nt = nti >> 4, i = nti & 15;
        float v = 0.f;
#pragma unroll
        for (int ww = 0; ww < 8; ++ww) v += part[ww * NT * 1024 + e];
        const int rloc = (i & 3) + 8 * (i >> 2) + 4 * hh, c = nt * 32 + r32;
        float sv = epi(rloc, c, v);
        if (WANT_SS) { sv = sv * sv;
#pragma unroll
            for (int o = 1; o < 32; o <<= 1) sv += __shfl_xor(sv, o);
            if (r32 == 0) ss_out[(size_t)rloc * ss_ld + ss_col0 + nt] = sv; }
    }
    LDS_WAIT(); __syncthreads();
}
__device__ __forceinline__ void skinny_rstd(const Ctx& C, const float* __restrict__ rs, int np, LAS float* tbl) {
    if (C.tid < 32) { float s = 0.f; const f32x4* p = (const f32x4*)(rs + (size_t)C.tid * np);
        for (int j = 0; j < np / 4; ++j) { const f32x4 v = p[j]; s += (v[0] + v[1]) + (v[2] + v[3]); }
        tbl[C.tid] = rsqrtf(s * (1.0f / DM) + RMS_EPS); }
    LDS_WAIT(); __syncthreads();
}

typedef short s16x4 __attribute__((ext_vector_type(4)));
typedef unsigned short u16x4 __attribute__((ext_vector_type(4)));
constexpr int DS_ISC = RING_OFF, DS_ISC_WORDS = 4128, DS_ISC_STRIDE = DS_ISC_WORDS * 4;
constexpr int DS_SEL = DS_ISC + 8 * DS_ISC_STRIDE;
constexpr int DS_BIAS = DS_SEL + 8 * 512;
constexpr int DS_HIST = DS_BIAS + 2048;
constexpr int DS_QROW = DS_HIST + 8 * 272 * 4;
constexpr int DS_END = DS_QROW + 256;
constexpr size_t OL_BLOCK = (size_t)3 * 16 * 8 * 64 * 8;
static_assert(DS_END <= LDS_BYTES, "DSA LDS map");

__device__ __forceinline__ s16x4 tr_read(LAS unsigned char* p) { typedef short v4i16_t __attribute__((ext_vector_type(4))); return __builtin_bit_cast(s16x4, __builtin_amdgcn_ds_read_tr16_b64_v4i16((LAS v4i16_t*)p)); }
__device__ __forceinline__ unsigned cvtpk(float lo, float hi) { typedef float f2_t __attribute__((ext_vector_type(2))); typedef __bf16 b2_t __attribute__((ext_vector_type(2))); f2_t v = {lo, hi}; b2_t b = __builtin_convertvector(v, b2_t); return __builtin_bit_cast(unsigned, b); }

#define DSA_LOCALS() const int w = C.wave; LAS unsigned* ISC = (LAS unsigned*)(C.lds + DS_ISC); LAS unsigned short* sel = (LAS unsigned short*)(C.lds + DS_SEL) + w * 256; const LAS float* biasl = (const LAS float*)(C.lds + DS_BIAS); (void)ISC; (void)sel; (void)biasl
#define RELANE() do { asm volatile("" : "+v"(lane)); asm volatile("" : "+s"(t0), "+s"(b)); } while (0)
__device__ __forceinline__ void dsa_step1(const Ctx& C, const Bufs& B, int b, int t0) {
    int lane = C.lane; RELANE(); DSA_LOCALS();
    {
        const int r32 = lane & 31, hh = lane >> 5;
        bf16x8 qa[2][4]; float wq[2][2][8];
        const int qi = 2 * ((r32 >> 2) & 1) + (r32 >> 4), hA = (r32 & 3) + 4 * ((r32 >> 3) & 1);
#pragma unroll
        for (int g = 0; g < 2; ++g) { const int row = rowof(b, t0 + 4 * g + qi);
#pragma unroll
            for (int s = 0; s < 4; ++s) qa[g][s] = *(const bf16x8*)(B.Q2 + (size_t)row * NQ2 + 4096 + hA * 64 + 16 * s + 8 * hh);
#pragma unroll
            for (int j = 0; j < 2; ++j) { const int rw = rowof(b, t0 + 4 * g + 2 * hh + j); const v4u ww = *(const v4u*)(B.PROJ + (size_t)rw * NP1 + PC_WIDX);
                const float sc = 0.35355339059327373f * 0.125f;
                wq[g][j][0] = pg8::bf_lo(ww.x) * sc; wq[g][j][1] = pg8::bf_hi(ww.x) * sc; wq[g][j][2] = pg8::bf_lo(ww.y) * sc; wq[g][j][3] = pg8::bf_hi(ww.y) * sc;
                wq[g][j][4] = pg8::bf_lo(ww.z) * sc; wq[g][j][5] = pg8::bf_hi(ww.z) * sc; wq[g][j][6] = pg8::bf_lo(ww.w) * sc; wq[g][j][7] = pg8::bf_hi(ww.w) * sc; } }
        const int nkeys = t0 + 8, nkt = (nkeys + 31) >> 5;
        for (int kt = w; kt < nkt; kt += 8) {
            const int key = kt * 32 + r32, kc = key < nkeys ? key : nkeys - 1, krow = rowof(b, kc);
            bf16x8 kb[4];
#pragma unroll
            for (int s = 0; s < 4; ++s) kb[s] = *(const bf16x8*)(B.PROJ + (size_t)krow * NP1 + PC_KIDX + 16 * s + 8 * hh);
#pragma unroll
            for (int g = 0; g < 2; ++g) { f32x16 acc = {};
#pragma unroll
                for (int s = 0; s < 4; ++s) acc = __builtin_amdgcn_mfma_f32_32x32x16_bf16(qa[g][s], kb[s], acc, 0, 0, 0);
#pragma unroll
                for (int j = 0; j < 2; ++j) { float isc = 0.f;
#pragma unroll
                    for (int h = 0; h < 8; ++h) isc += wq[g][j][h] * fmaxf(acc[8 * j + h], 0.f);
                    ISC[(4 * g + 2 * hh + j) * DS_ISC_WORDS + key] = f2key(isc); } }
        }
    }
}
__device__ __forceinline__ int dsa_step2(const Ctx& C, int b, int t0) {
    int lane = C.lane; RELANE(); DSA_LOCALS();
    const int t = t0 + w, n = t + 1;
    int cnt;
    if (n <= TOPK) { for (int j = lane; j < n; j += 64) sel[j] = (unsigned short)j; cnt = n; }
    else {
        const LAS unsigned* myrow = ISC + w * DS_ISC_WORDS;
        const int nI = (n + 255) >> 8;
        unsigned v[68];
#pragma unroll
        for (int i = 0; i < 17; ++i) { pg8::u32x4 x = {0u, 0u, 0u, 0u}; if (i < nI) x = *(const LAS pg8::u32x4*)(myrow + 256 * i + 4 * lane);
#pragma unroll
            for (int e = 0; e < 4; ++e) v[4 * i + e] = (256 * i + 4 * lane + e <= t) ? x[e] : 0u; }
        unsigned T = 0u; bool exact = false;
#define DSA_COUNT(res, pred_expr) do { int c_ = 0; \
        _Pragma("unroll") for (int i = 0; i < 17; ++i) { if (i < nI) { _Pragma("unroll") for (int e = 0; e < 4; ++e) { const unsigned x_ = v[4 * i + e]; c_ += (pred_expr) ? 1 : 0; } } } \
        int tot_ = 0; _Pragma("unroll") for (int bt = 0; bt < 7; ++bt) tot_ += __popcll(__ballot((c_ >> bt) & 1)) << bt; res = tot_; } while (0)
#pragma unroll 1
        for (int bit = 31; bit >= 0; --bit) {
            const unsigned cand = T | (1u << bit); int c;
            DSA_COUNT(c, x_ >= cand);
            if (c >= TOPK) { T = cand; if (c == TOPK) { exact = true; break; } }
        }
        if (!exact) { int c; DSA_COUNT(c, x_ >= T); exact = (c == TOPK); }
#undef DSA_COUNT
        int base = 0;
#pragma unroll
        for (int k = 0; k < 68; ++k) { const bool p = exact ? (v[k] >= T) : (v[k] > T); const unsigned long long m = __ballot(p);
            const int pos = base + (int)__builtin_amdgcn_mbcnt_hi((unsigned)(m >> 32), __builtin_amdgcn_mbcnt_lo((unsigned)m, 0u));
            if (p) sel[pos] = (unsigned short)(256 * (k >> 2) + 4 * lane + (k & 3));
            base += __popcll(m); }
        if (!exact) {
            int last = -1;
            while (base < TOPK) { int mi = 0x7fffffff;
#pragma unroll
                for (int k = 0; k < 68; ++k) { const int idx = 256 * (k >> 2) + 4 * lane + (k & 3); if (v[k] == T && idx > last && idx < mi) mi = idx; }
#pragma unroll
                for (int o = 1; o < 64; o <<= 1) { const int oth = __shfl_xor(mi, o); mi = oth < mi ? oth : mi; }
                if (lane == 0) sel[base] = (unsigned short)mi;
                last = mi; ++base; }
        }
        cnt = TOPK;
    }
    return cnt;
}
__device__ __forceinline__ void dsa_step3(const Ctx& C, const Bufs& B, int b, int t0, int cnt, int qslot) {
    int lane = C.lane; RELANE(); DSA_LOCALS(); const int t = t0 + w;
    {
        const int g = lane >> 4, c16 = lane & 15, rowq = rowof(b, t);
        bf16x8 qf[8];
#pragma unroll
        for (int s = 0; s < 8; ++s) qf[s] = *(const bf16x8*)(B.Q2 + (size_t)rowq * NQ2 + c16 * 256 + 32 * s + 8 * g);
        f32x4 O[16];
#pragma unroll
        for (int rt = 0; rt < 16; ++rt) O[rt] = (f32x4){0.f, 0.f, 0.f, 0.f};
        float m_ref = 0.f, lsum = 0.f;
        const int buf0 = DS_ISC + w * DS_ISC_STRIDE, buf1 = buf0 + 8192;
        const int npairs = (cnt + 31) >> 5;
        const int swz = (c16 & 7) << 1;
        const int trow = 4 * g + (c16 >> 2), tswz = (trow & 7) << 1, tp = c16 & 3;
        for (int kp = 0; kp < npairs; ++kp) {
#pragma unroll
            for (int p = 0; p < 16; ++p) { const int rowc = 2 * (p & 7) + (lane >> 5), j = 32 * kp + 16 * (p >> 3) + rowc; const int pos = sel[j < cnt ? j : 0];
                const int logical = (lane & 31) ^ ((rowc & 7) << 1);
                const unsigned char* src = (const unsigned char*)B.CKVN + (size_t)rowof(b, pos) * 512 + logical * 16;
                __builtin_amdgcn_global_load_lds((const unsigned*)src, (LAS unsigned*)(C.lds + ((p >> 3) ? buf1 : buf0) + (p & 7) * 1024), 16, 0, 0); }
            asm volatile("s_waitcnt vmcnt(0)" ::: "memory");
            f32x4 s0 = {0.f, 0.f, 0.f, 0.f}, s1 = {0.f, 0.f, 0.f, 0.f};
#pragma unroll
            for (int s = 0; s < 8; ++s) { const int off = c16 * 512 + (((4 * s + g) ^ swz) << 4);
                const bf16x8 a0 = *(const LAS bf16x8*)(C.lds + buf0 + off), a1 = *(const LAS bf16x8*)(C.lds + buf1 + off);
                s0 = __builtin_amdgcn_mfma_f32_16x16x32_bf16(a0, qf[s], s0, 0, 0, 0); s1 = __builtin_amdgcn_mfma_f32_16x16x32_bf16(a1, qf[s], s1, 0, 0, 0); }
            const u16x4 p0 = *(const LAS u16x4*)(sel + 32 * kp + 4 * g), p1 = *(const LAS u16x4*)(sel + 32 * kp + 16 + 4 * g);
            float x0[4], x1[4]; float mloc = -INFINITY;
#pragma unroll
            for (int i = 0; i < 4; ++i) { const int j0 = 32 * kp + 4 * g + i, j1 = j0 + 16;
                x0[i] = (j0 < cnt) ? 0.125f * s0[i] + biasl[t5_bucket(t - (int)p0[i]) * 16 + c16] : -INFINITY;
                x1[i] = (j1 < cnt) ? 0.125f * s1[i] + biasl[t5_bucket(t - (int)p1[i]) * 16 + c16] : -INFINITY;
                mloc = fmaxf(mloc, fmaxf(x0[i], x1[i])); }
            mloc = fmaxf(mloc, __shfl_xor(mloc, 16)); mloc = fmaxf(mloc, __shfl_xor(mloc, 32));
            if (kp == 0) m_ref = mloc;
            else if (__any(mloc > m_ref + 8.0f)) { const float mn = fmaxf(m_ref, mloc), al = __expf(m_ref - mn);
#pragma unroll
                for (int rt = 0; rt < 16; ++rt) O[rt] *= al;
                lsum *= al; m_ref = mn; }
            float pe0[4], pe1[4];
#pragma unroll
            for (int i = 0; i < 4; ++i) { pe0[i] = __expf(x0[i] - m_ref); pe1[i] = __expf(x1[i] - m_ref); lsum += pe0[i] + pe1[i]; }
            pg8::u32x4 pw; pw.x = cvtpk(pe0[0], pe0[1]); pw.y = cvtpk(pe0[2], pe0[3]); pw.z = cvtpk(pe1[0], pe1[1]); pw.w = cvtpk(pe1[2], pe1[3]);
            const bf16x8 pf = __builtin_bit_cast(bf16x8, pw);
#pragma unroll
            for (int rt = 0; rt < 16; ++rt) { const int off = trow * 512 + (((2 * rt + (tp >> 1)) ^ tswz) << 4) + 8 * (tp & 1);
                const s16x4 lo = tr_read(C.lds + buf0 + off), hi = tr_read(C.lds + buf1 + off);
                const bf16x8 af = {lo[0], lo[1], lo[2], lo[3], hi[0], hi[1], hi[2], hi[3]};
                O[rt] = __builtin_amdgcn_mfma_f32_16x16x32_bf16(af, pf, O[rt], 0, 0, 0); }
            LDS_WAIT(); asm volatile("" ::: "memory");
        }
        lsum += __shfl_xor(lsum, 16); lsum += __shfl_xor(lsum, 32);
        const float inv = 1.0f / lsum;
#pragma unroll
        for (int rt = 0; rt < 16; ++rt) { const f32x4 o = O[rt] * inv; pg8::u32x2 wv; wv.x = cvtpk(o[0], o[1]); wv.y = cvtpk(o[2], o[3]);
            const int s_ = rt >> 1, gp = 2 * (rt & 1) + (g >> 1), jo = 4 * (g & 1);
            *(pg8::u32x2*)(B.OLAT + (size_t)C.bid * OL_BLOCK + ((((size_t)(qslot >> 4) * 16 + c16) * 8 + s_) * 64 + gp * 16 + (qslot & 15)) * 8 + jo) = wv; }
    }
}
__device__ __forceinline__ void dsa_wuv(const Ctx& C, const Bufs& B, int l, int nq) {
    const int lane = C.lane, w = C.wave, g = lane >> 4, c16 = lane & 15;
    const LAS int* qrow = (const LAS int*)(C.lds + DS_QROW);
    const int nmt = (nq + 15) >> 4;
#pragma unroll 1
    for (int hq = 0; hq < 2; ++hq) { const int h = 2 * w + hq;
        f32x4 Dv[3][4];
#pragma unroll
        for (int mt = 0; mt < 3; ++mt)
#pragma unroll
            for (int nt = 0; nt < 4; ++nt) Dv[mt][nt] = (f32x4){0.f, 0.f, 0.f, 0.f};
        const bf16* wb = B.WUV + (((size_t)l * 16 + h) * 32) * 512 + lane * 8;
        const bf16* ab = B.OLAT + (size_t)C.bid * OL_BLOCK + ((size_t)h * 8) * 512 + lane * 8;
#pragma unroll
        for (int s = 0; s < 8; ++s) { bf16x8 bw[4];
#pragma unroll
            for (int nt = 0; nt < 4; ++nt) bw[nt] = *(const bf16x8*)(wb + (s * 4 + nt) * 512);
#pragma unroll
            for (int mt = 0; mt < 3; ++mt) { if (mt < nmt) { const v4u av = __builtin_nontemporal_load((const v4u*)(ab + ((size_t)mt * 16 * 8 + s) * 512)); const bf16x8 a = __builtin_bit_cast(bf16x8, av);
#pragma unroll
                for (int nt = 0; nt < 4; ++nt) Dv[mt][nt] = __builtin_amdgcn_mfma_f32_16x16x32_bf16(a, bw[nt], Dv[mt][nt], 0, 0, 0); } } }
#pragma unroll
        for (int mt = 0; mt < 3; ++mt)
#pragma unroll
            for (int i = 0; i < 4; ++i) { const int q = mt * 16 + 4 * g + i;
                if (q < nq) { const int row = qrow[q];
#pragma unroll
                    for (int nt = 0; nt < 4; ++nt) { const int col = h * 64 + 16 * nt + c16; const float z = bf2f(B.PROJ[(size_t)row * NP1 + PC_ZB + col]);
                        B.YB[(size_t)row * 1024 + col] = (bf16)f2bf(Dv[mt][nt][i] * siluf_(z)); } } }
    }
}
#ifndef MK_DSUB
#define MK_DSUB 0
#endif
__device__ __forceinline__ void dsa_unit(const Ctx& C, const Bufs& B, int l, int b, int t0, int uidx) {
    { PROBE_T0(); for (int rep = 0; rep < ((MK_DSUB & 1) ? 2 : 1); ++rep) { dsa_step1(C, B, b, t0); LDS_WAIT(); PROBE_T1(10); __syncthreads(); } PROBE_T1(0); }
    int cnt = 0;
    { PROBE_T0(); for (int rep = 0; rep < ((MK_DSUB & 2) ? 2 : 1); ++rep) { cnt = dsa_step2(C, b, t0); LDS_WAIT(); asm volatile("" ::: "memory"); } PROBE_T1(1); }
    if (C.lane == 0) ((LAS int*)(C.lds + DS_QROW))[uidx * 8 + C.wave] = rowof(b, t0 + C.wave);
    { PROBE_T0(); for (int rep = 0; rep < ((MK_DSUB & 4) ? 2 : 1); ++rep) { dsa_step3(C, B, b, t0, cnt, uidx * 8 + C.wave); } PROBE_T1(2); }
    { PROBE_T0(); LDS_WAIT(); __syncthreads(); PROBE_T1(7); }
}
#undef RELANE
#undef DSA_LOCALS

__device__ __forceinline__ void dsa_phase(const Ctx& C, int l) {
    const Bufs B(C.a.ws);
    const Args& A = C.a;
    if (C.tid < 512) { const int bk = C.tid >> 4, h = C.tid & 15; ((LAS float*)(C.lds + DS_BIAS))[C.tid] = A.bias_table[bk * 32 + 16 + h]; }
    __syncthreads();
    int nu = 0;
    for (int it = 0;; ++it) {
        int s;
        if (C.G == 256) { if (it < 4) s = 256 * it + ((it & 1) ? 255 - C.bid : C.bid); else if (it == 4 && C.bid < 4) s = 1024 + C.bid; else break; }
        else { s = C.bid + it * C.G; if (s >= 1028) break; }
        dsa_unit(C, B, l, s & 1, 8 * (513 - (s >> 1)), it); nu = it + 1;
    }
    VM_WAIT(); LDS_WAIT(); __syncthreads();
    { PROBE_T0(); dsa_wuv(C, B, l, nu * 8); PROBE_T1(3); }
    __syncthreads();
}

constexpr int VT_PITCH = 4128;
constexpr int SW_BIAS = RING_OFF;
constexpr int SW_WS = SW_BIAS + 8192;

__device__ __forceinline__ void swa_item(const Ctx& C, const Bufs& B, const float* __restrict__ sinks, int b, int head, int p0, bool meta) {
    const int lane = C.lane, r32 = lane & 31, hh = lane >> 5, g = head >> 3;
    const LAS float* biasl = (const LAS float*)(C.lds + SW_BIAS);
    LAS float* wsf = (LAS float*)(C.lds + SW_WS) + C.wave * 32;
    const int tq = p0 + r32;
    const int tqc = meta ? (tq < NMETA ? tq : NMETA - 1) : tq;
    const int rowq = rowof(b, tqc);
    bf16x8 qf[4];
#pragma unroll
    for (int s = 0; s < 4; ++s) qf[s] = *(const bf16x8*)(B.PROJ + (size_t)rowq * NP1 + PC_QA + head * 64 + 16 * s + 8 * hh);
    const int ntile = meta ? 1 : 6;
    f32x16 S[6];
#pragma unroll
    for (int kt = 0; kt < 6; ++kt) {
        if (kt < ntile) {
            const int k0 = (kt == 0) ? 0 : p0 - 128 + 32 * (kt - 1);
            int kpos = k0 + r32; kpos = kpos < 0 ? 0 : kpos;
            const int krow = rowof(b, kpos);
            f32x16 acc = {};
#pragma unroll
            for (int s = 0; s < 4; ++s) { const bf16x8 kf = *(const bf16x8*)(B.PROJ + (size_t)krow * NP1 + PC_KA + g * 64 + 16 * s + 8 * hh);
                acc = __builtin_amdgcn_mfma_f32_32x32x16_bf16(kf, qf[s], acc, 0, 0, 0); }
#pragma unroll
            for (int i = 0; i < 16; ++i) { const int kp = k0 + (i & 3) + 8 * (i >> 2) + 4 * hh; const int d = tq - kp;
                bool ok;
                if (kt == 0) ok = kp < NMETA && d >= 0; else ok = kp >= NMETA && d >= 0 && d < 128;
                const int dc = d < 0 ? 0 : (d > 127 ? 127 : d);
                acc[i] = ok ? 0.125f * acc[i] + biasl[dc * 16 + head] : -INFINITY; }
            S[kt] = acc;
        } else S[kt] = (f32x16){-INFINITY, -INFINITY, -INFINITY, -INFINITY, -INFINITY, -INFINITY, -INFINITY, -INFINITY, -INFINITY, -INFINITY, -INFINITY, -INFINITY, -INFINITY, -INFINITY, -INFINITY, -INFINITY};
    }
    const float sink = sinks[head];
    float mx = sink;
#pragma unroll
    for (int kt = 0; kt < 6; ++kt)
#pragma unroll
        for (int i = 0; i < 16; ++i) mx = fmaxf(mx, S[kt][i]);
    mx = fmaxf(mx, __shfl_xor(mx, 32));
    float sum = 0.f;
#pragma unroll
    for (int kt = 0; kt < 6; ++kt)
#pragma unroll
        for (int i = 0; i < 16; ++i) { const float p = __expf(S[kt][i] - mx); S[kt][i] = p; sum += p; }
    sum += __shfl_xor(sum, 32);
    sum += __expf(sink - mx);
    if (hh == 0) wsf[r32] = sum;
    f32x16 O0 = {}, O1 = {};
#pragma unroll
    for (int kt = 0; kt < 6; ++kt) {
        if (kt < ntile) {
            const int k0 = (kt == 0) ? 0 : p0 - 128 + 32 * (kt - 1);
#pragma unroll
            for (int s2 = 0; s2 < 2; ++s2) {
                pg8::u32x4 pw; pw.x = cvtpk(S[kt][8 * s2 + 0], S[kt][8 * s2 + 1]); pw.y = cvtpk(S[kt][8 * s2 + 2], S[kt][8 * s2 + 3]); pw.z = cvtpk(S[kt][8 * s2 + 4], S[kt][8 * s2 + 5]); pw.w = cvtpk(S[kt][8 * s2 + 6], S[kt][8 * s2 + 7]);
                const bf16x8 pf = __builtin_bit_cast(bf16x8, pw);
                int ka = k0 + 16 * s2 + 4 * hh, kb2 = ka + 8; ka = ka < 0 ? 0 : ka; kb2 = kb2 < 0 ? 0 : kb2;
#pragma unroll
                for (int dt = 0; dt < 2; ++dt) { const bf16* vrow = B.VT + ((size_t)b * 128 + g * 64 + 32 * dt + r32) * VT_PITCH;
                    const pg8::u32x2 lo = *(const pg8::u32x2*)(vrow + ka), hi2 = *(const pg8::u32x2*)(vrow + kb2);
                    const pg8::u32x4 vw = {lo.x, lo.y, hi2.x, hi2.y}; const bf16x8 vf = __builtin_bit_cast(bf16x8, vw);
                    if (dt == 0) O0 = __builtin_amdgcn_mfma_f32_32x32x16_bf16(pf, vf, O0, 0, 0, 0); else O1 = __builtin_amdgcn_mfma_f32_32x32x16_bf16(pf, vf, O1, 0, 0, 0); }
            }
        }
    }
    LDS_WAIT(); asm volatile("" ::: "memory");
#pragma unroll
    for (int i = 0; i < 16; ++i) { const int q = (i & 3) + 8 * (i >> 2) + 4 * hh, t = p0 + q;
        if (!meta || t < NMETA) { const int row = rowof(b, t); const float inv = 1.0f / wsf[q];
#pragma unroll
            for (int dt = 0; dt < 2; ++dt) { const int col = head * 64 + 32 * dt + r32; const float z = bf2f(B.PROJ[(size_t)row * NP1 + PC_ZA + col]);
                const float o = (dt == 0 ? O0[i] : O1[i]) * inv;
                B.YA[(size_t)row * 1024 + col] = (bf16)f2bf(o * siluf_(z)); } } }
    LDS_WAIT(); asm volatile("" ::: "memory");
}

__device__ __forceinline__ void swa_phase(const Ctx& C, int l) {
    const Bufs B(C.a.ws);
    const Args& A = C.a;
    __syncthreads();
    for (int i = C.tid; i < 128 * 16; i += NWAVES * 64) { const int d = i >> 4, h = i & 15; ((LAS float*)(C.lds + SW_BIAS))[i] = A.bias_table[t5_bucket(d) * 32 + h]; }
    __syncthreads();
    const float* sinks = A.sinks + l * 16;
    for (int it = C.gw; it < 4096 + 32; it += C.NGW) {
        if (it < 4096) { const int blk = it & 127, head = (it >> 7) & 15, b = it >> 11; swa_item(C, B, sinks, b, head, NMETA + 32 * blk, false); }
        else { const int r = it - 4096, head = r & 15, b = r >> 4; swa_item(C, B, sinks, b, head, 0, true); }
    }
    __syncthreads();
}


constexpr int PH_PER_LAYER = 7, N_PHASES = 1 + NLAYER * PH_PER_LAYER + 1;
#ifndef MK_DUP
#define MK_DUP 0
#endif
#ifndef MK_NAIVE_SWA
#define MK_NAIVE_SWA 0
#endif
#ifndef MK_NAIVE_DSA
#define MK_NAIVE_DSA 0
#endif
#ifndef MK_ONE_LAUNCH
#define MK_ONE_LAUNCH 1
#endif

__global__ void __launch_bounds__(NWAVES * 64, 2) fwd_kernel(Args args) {
    extern __shared__ __attribute__((aligned(16))) unsigned char lds[];
    Ctx C;
    C.lds = (LAS unsigned char*)lds; C.tid = threadIdx.x; C.lane = C.tid & 63; C.wave = __builtin_amdgcn_readfirstlane(C.tid >> 6);
    C.G = gridDim.x; C.bid = blockIdx.x; C.gw = blockIdx.x * NWAVES + C.wave; C.NGW = C.G * NWAVES; C.a = args;
    unsigned char* ws = args.ws;
    gu32* ctl = (gu32*)(ws + WS_CTL);
    for (int u = C.tid; u < RING_OFF / 4; u += NWAVES * 64) ((LAS unsigned*)(C.lds + LDSCTL_OFF))[u] = 0u;
    __syncthreads();
    volatile LAS unsigned* MISC = (volatile LAS unsigned*)(C.lds + MISC_OFF);
    XcdBarrier bar; bar.bar = (unsigned*)(ctl + CW_BAR); bar.x = 0; bar.st = nullptr;
    const int lo = args.ph_lo, hi = args.ph_hi;
    const bool one = (hi - lo) > 1;
    if (one) bar = xcd_barrier_post((unsigned*)(ctl + CW_BAR), MISC + 8);
#define IN(k) (lo <= (k) && (k) < hi)
#define PHASE_BEGIN() do { int l_ = (int)__builtin_amdgcn_mbcnt_hi(~0u, __builtin_amdgcn_mbcnt_lo(~0u, 0u)); asm volatile("" : "+v"(l_)); int b_ = blockIdx.x; asm volatile("" : "+s"(b_)); \
    C.lane = l_; C.tid = C.wave * 64 + l_; C.bid = b_; C.gw = b_ * NWAVES + C.wave; } while (0)
#define SEAM(k) do { if (IN((k) + 1)) xcd_barrier(bar); } while (0)
    LAS unsigned char* ring = C.lds + RING_OFF;

    if (IN(0)) { PHASE_BEGIN(); p0_prologue(C); if (MK_DUP & 128) { PHASE_BEGIN(); p0_prologue(C); } SEAM(0); }
    for (int l = 0; l < NLAYER; ++l) {
        const int p = 1 + l * PH_PER_LAYER;
        if (IN(p)) {
            PHASE_BEGIN(); const Bufs B(ws);
            const bf16* W1l = B.W1 + (size_t)l * NP1 * DM;
            pg8::Gemm g{B.HB, W1l, MR, 8192, DM}; pg8::StaticOrder S; S.init(MR, 8192, C.G, C.bid);
            g1_rstd_table(C, S);
            pg8::EpiProj E{B.PROJ, NP1, (const LAS float*)(C.lds + RSTD_OFF)};
            pg8::gemm_phase<pg8::EpiProj, pg8::StaticOrder, true, true>(ring, g, S, E, C.tid);
            if (MK_DUP & 1) { PHASE_BEGIN(); pg8::gemm_phase<pg8::EpiProj, pg8::StaticOrder, true, true>(ring, g, S, E, C.tid); }
            PHASE_BEGIN();
            LAS float* tbl = (LAS float*)(C.lds + RSTD_OFF);
            for (int u = C.bid; u < 256 + 87; u += C.G) {
                if (u < 256) { const int row0 = 32 * u; skinny_rstd(C, B.RS + (size_t)row0 * 32, 32, tbl);
                    skinny_unit<3, false>(C, B.HB + (size_t)row0 * DM, DM, W1l + (size_t)8192 * DM, DM, nullptr, 0, 0, SkProj{B.PROJ + (size_t)row0 * NP1 + 8192, tbl}); }
                else { const int gc = u - 256; skinny_rstd(C, B.RS2, 64, tbl);
                    skinny_unit<3, false>(C, B.HB + (size_t)MR * DM, DM, W1l + (size_t)gc * 96 * DM, DM, nullptr, 0, 0, SkProj{B.PROJ + (size_t)MR * NP1 + gc * 96, tbl}); }
            }
            SEAM(p);
        }
        if (IN(p + 1)) { PHASE_BEGIN(); norm_phase(C, l); if (MK_DUP & 2) { PHASE_BEGIN(); norm_phase(C, l); } SEAM(p + 1); }
        if (IN(p + 2)) {
            PHASE_BEGIN(); const Bufs B(ws);
            const bf16* W2l = B.W2 + (size_t)l * NQ2 * 512;
            pg8::Gemm g{B.CQN, W2l, MR, NQ2, 512}; pg8::StaticOrder S; S.init(MR, NQ2, C.G, C.bid);
            pg8::EpiBf16<0> E{B.Q2, NQ2, nullptr, 0, 0, 1.f};
            pg8::gemm_phase<pg8::EpiBf16<0>, pg8::StaticOrder, true, true>(ring, g, S, E, C.tid);
            if (MK_DUP & 4) { PHASE_BEGIN(); pg8::gemm_phase<pg8::EpiBf16<0>, pg8::StaticOrder, true, true>(ring, g, S, E, C.tid); }
            PHASE_BEGIN();
            for (int u = C.bid; u < 48; u += C.G) skinny_unit<3, false>(C, B.CQN + (size_t)MR * 512, 512, W2l + (size_t)u * 96 * 512, 512, nullptr, 0, 0, SkQ2{B.Q2 + (size_t)MR * NQ2 + u * 96});
            SEAM(p + 2);
        }
        if (IN(p + 3)) {
#if MK_NAIVE_SWA
            PHASE_BEGIN(); swa_naive(C, l);
#else
            { PROBE_T0(); PHASE_BEGIN(); swa_phase(C, l); PROBE_T1(5); }
            if (MK_DUP & 8) { PHASE_BEGIN(); swa_phase(C, l); }
#endif
#if MK_NAIVE_DSA
            PHASE_BEGIN(); dsa_naive(C, l);
            VM_WAIT(); __syncthreads();
            PHASE_BEGIN(); wuv_naive(C, l);
#else
            { PROBE_T0(); PHASE_BEGIN(); dsa_phase(C, l); PROBE_T1(4); }
            if (MK_DUP & 16) { PHASE_BEGIN(); dsa_phase(C, l); }
#endif
            SEAM(p + 3);
        }
        if (IN(p + 4)) {
            PHASE_BEGIN(); const Bufs B(ws);
            const bf16* WAl = B.WA + (size_t)l * DM * 1024;
            pg8::Gemm g{B.YA, WAl, MR, DM, 1024}; pg8::StaticOrder S; S.init(MR, DM, C.G, C.bid);
            pg8::EpiPA E{B.PA, B.PROJ + PC_GA, NP1};
            pg8::gemm_phase<pg8::EpiPA, pg8::StaticOrder, true, true>(ring, g, S, E, C.tid);
            if (MK_DUP & 32) { PHASE_BEGIN(); pg8::gemm_phase<pg8::EpiPA, pg8::StaticOrder, true, true>(ring, g, S, E, C.tid); }
            PHASE_BEGIN();
            for (int u = C.bid; u < 32; u += C.G) skinny_unit<2, false>(C, B.YA + (size_t)MR * 1024, 1024, WAl + (size_t)u * 64 * 1024, 1024, nullptr, 0, 0, SkPA{B.PA + (size_t)MR * DM + u * 64, B.PROJ + (size_t)MR * NP1 + PC_GA + u * 64});
            SEAM(p + 4);
        }
        if (IN(p + 5)) {
            PHASE_BEGIN(); const Bufs B(ws);
            const bf16* WBl = B.WB + (size_t)l * DM * 1024;
            pg8::Gemm g{B.YB, WBl, MR, DM, 1024}; pg8::StaticOrder S; S.init(MR, DM, C.G, C.bid);
            pg8::EpiMerge E{B.MG, B.PA, B.PROJ + PC_GB, NP1};
            pg8::gemm_phase<pg8::EpiMerge, pg8::StaticOrder, true, true>(ring, g, S, E, C.tid);
            PHASE_BEGIN();
            for (int u = C.bid; u < 32; u += C.G) skinny_unit<2, false>(C, B.YB + (size_t)MR * 1024, 1024, WBl + (size_t)u * 64 * 1024, 1024, nullptr, 0, 0, SkMerge{B.MG + (size_t)MR * DM + u * 64, B.PA + (size_t)MR * DM + u * 64, B.PROJ + (size_t)MR * NP1 + PC_GB + u * 64});
            SEAM(p + 5);
        }
        if (IN(p + 6)) {
            PHASE_BEGIN(); const Bufs B(ws);
            const bf16* WOl = B.WO + (size_t)l * DM * DM;
            pg8::Gemm g{B.MG, WOl, MR, DM, DM}; pg8::StaticOrder S; S.init(MR, DM, C.G, C.bid);
            pg8::EpiRes E{B.H, B.HB, B.RS};
            pg8::gemm_phase<pg8::EpiRes, pg8::StaticOrder, true, true>(ring, g, S, E, C.tid);
            PHASE_BEGIN();
            for (int u = C.bid; u < 32; u += C.G) skinny_unit<2, true>(C, B.MG + (size_t)MR * DM, DM, WOl + (size_t)u * 64 * DM, DM, B.RS2, 64, 2 * u, SkRes{B.H + (size_t)MR * DM + u * 64, B.HB + (size_t)MR * DM + u * 64});
            SEAM(p + 6);
        }
    }
    if (IN(N_PHASES - 1)) { PHASE_BEGIN(); final_phase(C); }
#undef IN
#undef SEAM
}

extern "C" void kernel_launch(void* const* d_in, const int* in_sizes, int n_in, void* d_out, int out_size, void* d_ws, size_t ws_size, hipStream_t stream) {
    static int grid = 0;
    if (grid == 0) {
        if (n_in != 16 || ws_size < WS_END) { fprintf(stderr, "kernel_launch: unexpected inputs (n_in %d, ws %zu, need %zu)\n", n_in, ws_size, (size_t)WS_END); grid = -1; return; }
        int dev = 0, cus = 0;
        if (hipGetDevice(&dev) != hipSuccess || hipDeviceGetAttribute(&cus, hipDeviceAttributeMultiprocessorCount, dev) != hipSuccess) { grid = -1; return; }
        if (hipFuncSetAttribute((const void*)fwd_kernel, hipFuncAttributeMaxDynamicSharedMemorySize, LDS_BYTES) != hipSuccess) { fprintf(stderr, "kernel_launch: hipFuncSetAttribute failed\n"); grid = -1; return; }
        int per_cu = 0;
        if (hipOccupancyMaxActiveBlocksPerMultiprocessor(&per_cu, (const void*)fwd_kernel, NWAVES * 64, LDS_BYTES) != hipSuccess || per_cu < 1) fprintf(stderr, "kernel_launch: occupancy query says %d\n", per_cu);
        (void)hipGetLastError();
        grid = cus;
    }
    if (grid < 0) return;
    if (hipMemsetAsync((char*)d_ws + WS_CTL, 0, CTL_ZERO_BYTES, stream) != hipSuccess) return;
    Args a{};
    a.x = (const float*)d_in[0]; a.meta = (const float*)d_in[1]; a.bias_table = (const float*)d_in[2]; a.norm_g = (const float*)d_in[3]; a.w_in = (const float*)d_in[4];
    a.q_norm_g = (const float*)d_in[5]; a.kv_norm_g = (const float*)d_in[6]; a.w_qb = (const float*)d_in[7]; a.w_iq = (const float*)d_in[8]; a.w_uk = (const float*)d_in[9];
    a.w_uv = (const float*)d_in[10]; a.sinks = (const float*)d_in[11]; a.w_proj_a = (const float*)d_in[12]; a.w_proj_b = (const float*)d_in[13]; a.w_out = (const float*)d_in[14];
    a.final_g = (const float*)d_in[15]; a.out = (float*)d_out; a.ws = (unsigned char*)d_ws;
#if MK_ONE_LAUNCH
    a.ph_lo = 0; a.ph_hi = N_PHASES;
    hipLaunchKernelGGL(fwd_kernel, dim3(grid), dim3(NWAVES * 64), LDS_BYTES, stream, a);
#else
    for (int p = 0; p < N_PHASES; ++p) { a.ph_lo = p; a.ph_hi = p + 1; hipLaunchKernelGGL(fwd_kernel, dim3(grid), dim3(NWAVES * 64), LDS_BYTES, stream, a); }
#endif
}
```

```cpp
#include <hip/hip_runtime.h>
#include <cstdio>
#include <cstdint>
namespace pg8 {
#define PG8_LAS __attribute__((address_space(3)))
typedef unsigned short bf16_t;
typedef short bf16x8 __attribute__((ext_vector_type(8)));
typedef float f32x4 __attribute__((ext_vector_type(4)));
typedef unsigned u32x4 __attribute__((ext_vector_type(4)));
constexpr int BM = 256, BK = 64, HALF = 128, HTB = HALF * BK * 2  , STAGE_BYTES = 8 * HTB, NXCD = 8, WGM = 8;

__host__ __device__ __forceinline__ int lds_byte(int r, int c) { const int st = (r >> 4) * 2 + (c >> 5), rr = r & 15, cc = c & 31, ob = rr * 64 + cc * 2; return st * 1024 + (ob ^ (((ob >> 9) & 1) << 5)); }
__host__ __device__ __forceinline__ void stage_rc(int b, int& R, int& C) { const int st = b / 1024, sb = b % 1024, swz = sb ^ (((sb >> 9) & 1) << 5); R = (st >> 1) * 16 + swz / 64; C = (st & 1) * 32 + (swz % 64) / 2; }
__host__ __device__ __forceinline__ int perm32(int rho) { const int n = rho >> 4, i = rho & 15; return 8 * (i >> 2) + 4 * n + (i & 3); }

struct Unit { int pm, pn, sel; };
struct Gemm { const bf16_t* A; const bf16_t* Bt; int M, N, K; const bf16_t* A2; const bf16_t* Bt2; int lda; };

struct StaticOrder {
    int nM, nN, nwg, G, c;
    __host__ __device__ void init(int M, int N, int G_, int c_) { nM = M / BM; nN = N / BM; nwg = nM * nN; G = G_; c = c_; }
    __host__ __device__ bool next(int i, Unit& u) const {
        const long L = (long)i * G + c; if (L >= nwg) return false;
        int wgid = (int)L; { const int q = nwg / NXCD, r = nwg % NXCD, xcd = wgid % NXCD, off = wgid / NXCD; wgid = (xcd < r ? xcd * (q + 1) : r * (q + 1) + (xcd - r) * q) + off; }
        const int nig = WGM * nN, gid = wgid / nig, fm = gid * WGM, gsz = (nM - fm) < WGM ? (nM - fm) : WGM;
        u.pm = fm + ((wgid % nig) % gsz); u.pn = (wgid % nig) / gsz; u.sel = 0; return true;
    }
    __device__ __forceinline__ void a_ready(const Unit&) const {}
    __device__ __forceinline__ void done(const Unit&) const {}
};

__device__ __forceinline__ unsigned cvt_pk_bf16(float lo, float hi) { unsigned r; asm volatile("v_cvt_pk_bf16_f32 %0, %1, %2" : "=v"(r) : "v"(lo), "v"(hi)); return r; }
typedef float f32x2 __attribute__((ext_vector_type(2)));
__device__ __forceinline__ f32x2 gelu_pk(f32x2 v) {
    const f32x2 av = __builtin_elementwise_abs(v), d = av * 0.2316418882f + 1.0f;
    f32x2 t; t.x = __builtin_amdgcn_rcpf(d.x); t.y = __builtin_amdgcn_rcpf(d.y);
    f32x2 q = t * 0.5307027145f + (-0.7265760135f); q = q * t + 0.7107068705f; q = q * t + (-0.142248368f); q = q * t + 0.127414796f; q = q * t;
    const f32x2 s = (v * v) * (-0.72134752044f);
    f32x2 e; e.x = __builtin_amdgcn_exp2f(s.x); e.y = __builtin_amdgcn_exp2f(s.y);
    const f32x2 m = v * (q * e), r = v - m;
    f32x2 o; o.x = v.x < 0.f ? m.x : r.x; o.y = v.y < 0.f ? m.y : r.y; return o;
}

template <int ACT  > struct EpiBf16 {
    static constexpr bool PERM = true, AFTER_DRAIN = false; static_assert(ACT == 0 || ACT == 1, "EpiBf16: ACT is 0 (none) or 1 (gelu_pk)");
    bf16_t* O; int ldc; const float* bias; int split_cols; size_t split_stride; float scale0;
    __device__ __forceinline__ void operator()(const f32x4 (&acc)[2][2][4][2], const Unit& u, int ui, int wr, int wc, int fr, int fq) const {
        const int row0 = u.pm * BM + wr * 64 + fr; int colt = u.pn * BM; bf16_t* base = O;
        float sc = 1.f; if (split_cols) { const int t = colt / split_cols; base += (size_t)t * split_stride; colt -= t * split_cols; if (t == 0) sc = scale0; }
        const int col0 = colt + wc * 32 + 8 * fq, bcol0 = u.pn * BM + wc * 32 + 8 * fq;
        f32x4 bv[2][2];
#pragma unroll
        for (int bj = 0; bj < 2; ++bj)
#pragma unroll
            for (int n = 0; n < 2; ++n) bv[bj][n] = bias ? *(const f32x4*)(bias + bcol0 + bj * HALF + 4 * n) : (f32x4){0.f, 0.f, 0.f, 0.f};
#pragma unroll
        for (int ai = 0; ai < 2; ++ai)
#pragma unroll
            for (int m = 0; m < 4; ++m) { bf16_t* rowp = base + (size_t)(row0 + ai * HALF + m * 16) * ldc + col0;
#pragma unroll
                for (int bj = 0; bj < 2; ++bj) { f32x4 v0 = acc[ai][bj][m][0] + bv[bj][0], v1 = acc[ai][bj][m][1] + bv[bj][1];
                    if (ACT == 1) { f32x2 a = gelu_pk((f32x2){v0[0], v0[1]}), b = gelu_pk((f32x2){v0[2], v0[3]}), c = gelu_pk((f32x2){v1[0], v1[1]}), d = gelu_pk((f32x2){v1[2], v1[3]});
                        v0 = (f32x4){a.x, a.y, b.x, b.y}; v1 = (f32x4){c.x, c.y, d.x, d.y}; }
                    v0 = v0 * sc; v1 = v1 * sc; u32x4 w; w.x = cvt_pk_bf16(v0[0], v0[1]); w.y = cvt_pk_bf16(v0[2], v0[3]); w.z = cvt_pk_bf16(v1[0], v1[1]); w.w = cvt_pk_bf16(v1[2], v1[3]);
                    *(u32x4*)(rowp + bj * HALF) = w; } }
    }
};

template <class T, class = void> struct pg8_has_midk { static constexpr bool value = false; };
template <class T> struct pg8_has_midk<T, decltype((void)T::MIDK)> { static constexpr bool value = T::MIDK; };
template <class Epi, class Sched, bool ALIGN_EPI = false, bool SP2 = false>
__device__ __forceinline__ void gemm_phase(PG8_LAS unsigned char* lds, const Gemm g, const Sched& S, const Epi& E, int tid_in) {
    int tid_ = tid_in; asm volatile("" : "+v"(tid_));
    const int tid = tid_, wid = __builtin_amdgcn_readfirstlane(tid >> 6), lane = tid & 63, wr = wid >> 2, wc = wid & 3, fr = lane & 15, fq = lane >> 4;
    const int K = g.K, nt = K / BK, lda = g.lda ? g.lda : K;
    unsigned voffA[2], voffB[2];
#pragma unroll
    for (int i = 0; i < 2; ++i) { int R, C; stage_rc(tid * 16 + i * 8192, R, C); const int Rb = Epi::PERM ? ((R & ~31) + perm32(R & 31)) : R;
        voffA[i] = (unsigned)(R * lda + C) * 2u; voffB[i] = (unsigned)(Rb * K + C) * 2u; }
    const size_t kstep = (size_t)(BK * 2);
    const size_t hstepA = (size_t)HALF * lda * 2, tstepA = 2 * hstepA;
    const size_t hstep = (size_t)HALF * K * 2;
    const size_t tstep = 2 * hstep;
    const unsigned ldsw = (unsigned)wid * 1024u;
    const int aoff = lds_byte(wr * 64 + fr, fq * 8), boff = lds_byte(wc * 32 + fr, fq * 8);
#define PG8_SA(b, h) (((b) * 2 + (h)) * HTB)
#define PG8_SB(b, h) ((4 + (b) * 2 + (h)) * HTB)
#define PG8_STAGE(bufoff, gbase, voff) do { _Pragma("unroll") for (int _i = 0; _i < 2; ++_i) \
        __builtin_amdgcn_global_load_lds((const unsigned*)((const char*)(gbase) + (voff)[_i]), (PG8_LAS unsigned*)(lds + (bufoff) + ldsw + _i * 8192), 16, 0, 0); } while (0)
#define PG8_LDA(dst, b, h) do { _Pragma("unroll") for (int m = 0; m < 4; ++m) _Pragma("unroll") for (int k = 0; k < 2; ++k) dst[m][k] = *(const PG8_LAS bf16x8*)(lds + PG8_SA(b, h) + aoff + m * 2048 + k * 1024); } while (0)
#define PG8_LDB(dst, b, h) do { _Pragma("unroll") for (int n = 0; n < 2; ++n) _Pragma("unroll") for (int k = 0; k < 2; ++k) dst[n][k] = *(const PG8_LAS bf16x8*)(lds + PG8_SB(b, h) + boff + n * 2048 + k * 1024); } while (0)
#define PG8_MMA(ai, bj, At, Bt) do { __builtin_amdgcn_s_setprio(1); _Pragma("unroll") for (int m = 0; m < 4; ++m) _Pragma("unroll") for (int n = 0; n < 2; ++n) _Pragma("unroll") for (int k = 0; k < 2; ++k) \
        acc[ai][bj][m][n] = __builtin_amdgcn_mfma_f32_16x16x32_bf16(Bt[n][k], At[m][k], acc[ai][bj][m][n], 0, 0, 0); __builtin_amdgcn_s_setprio(0); } while (0)
#define PG8_WAIT_V(n) asm volatile("s_waitcnt vmcnt(" #n ")" ::: "memory")
#define PG8_WAIT_L(n) asm volatile("s_waitcnt lgkmcnt(" #n ")" ::: "memory")
#define PG8_BAR __builtin_amdgcn_s_barrier()
#define PG8_SCHED __builtin_amdgcn_sched_barrier(0)
    Unit cur, nxt; int ui = 0;
    if (!S.next(0, cur)) return;
    f32x4 acc[2][2][4][2];
#pragma unroll
    for (int a = 0; a < 2; ++a)
#pragma unroll
        for (int b = 0; b < 2; ++b)
#pragma unroll
            for (int m = 0; m < 4; ++m)
#pragma unroll
                for (int n = 0; n < 2; ++n) acc[a][b][m][n] = (f32x4){0.f, 0.f, 0.f, 0.f};
    bf16x8 At[4][2], B0[2][2], B1[2][2];
    const char* cA = (const char*)(cur.sel ? g.A2 : g.A) + (size_t)cur.pm * tstepA; const char* cB = (const char*)(cur.sel ? g.Bt2 : g.Bt) + (size_t)cur.pn * tstep;
    S.a_ready(cur);
    if constexpr (SP2) {
        PG8_STAGE(PG8_SB(0, 0), cB, voffB); PG8_STAGE(PG8_SB(0, 1), cB + hstep, voffB); PG8_STAGE(PG8_SA(0, 0), cA, voffA); PG8_STAGE(PG8_SA(0, 1), cA + hstepA, voffA);
        if (wr == 1) PG8_BAR;
        PG8_WAIT_V(2); PG8_BAR;
        PG8_STAGE(PG8_SB(1, 0), cB + kstep, voffB); PG8_STAGE(PG8_SA(1, 0), cA + kstep, voffA); PG8_STAGE(PG8_SB(1, 1), cB + hstep + kstep, voffB);
        PG8_WAIT_V(6); PG8_BAR;
    } else {
        PG8_STAGE(PG8_SB(0, 0), cB, voffB); PG8_STAGE(PG8_SA(0, 0), cA, voffA); PG8_STAGE(PG8_SB(0, 1), cB + hstep, voffB); PG8_STAGE(PG8_SA(0, 1), cA + hstepA, voffA);
        if (wr == 1) PG8_BAR;
        PG8_WAIT_V(4); PG8_BAR;
        PG8_STAGE(PG8_SB(1, 0), cB + kstep, voffB); PG8_STAGE(PG8_SA(1, 0), cA + kstep, voffA); PG8_STAGE(PG8_SB(1, 1), cB + hstep + kstep, voffB);
        PG8_WAIT_V(6); PG8_BAR;
    }
    for (;;) {
        const bool has_next = S.next(ui + 1, nxt);
        const char* nA = has_next ? (const char*)(nxt.sel ? g.A2 : g.A) + (size_t)nxt.pm * tstepA : cA; const char* nB = has_next ? (const char*)(nxt.sel ? g.Bt2 : g.Bt) + (size_t)nxt.pn * tstep : cB;
        for (int t = 0; t < nt; t += 2) {
            if constexpr (pg8_has_midk<Epi>::value) { if (t == (nt >> 1)) E.midk(acc, cur, wr, wc, fr, fq); }
            const bool last = (t == nt - 2);
            const char* a1 = cA + (size_t)(t + 1) * kstep;
            const char* a2 = last ? nA : cA + (size_t)(t + 2) * kstep; const char* b2 = last ? nB : cB + (size_t)(t + 2) * kstep;
            const char* a3 = a2 + kstep; const char* b3 = b2 + kstep;
            if (last && has_next) S.a_ready(nxt);
            if constexpr (SP2) {
            PG8_LDB(B0, 0, 0); PG8_LDB(B1, 0, 1); PG8_SCHED; PG8_LDA(At, 0, 0); PG8_STAGE(PG8_SA(1, 1), a1 + hstepA, voffA);
            PG8_WAIT_V(8); PG8_WAIT_L(0); PG8_BAR; PG8_MMA(0, 0, At, B0); PG8_MMA(0, 1, At, B1); PG8_BAR; PG8_SCHED;
            PG8_LDA(At, 0, 1); PG8_STAGE(PG8_SB(0, 0), b2, voffB); PG8_STAGE(PG8_SB(0, 1), b2 + hstep, voffB); PG8_STAGE(PG8_SA(0, 0), a2, voffA);
            PG8_WAIT_V(8); PG8_WAIT_L(0); PG8_BAR; PG8_MMA(1, 0, At, B0); PG8_MMA(1, 1, At, B1); PG8_BAR; PG8_SCHED;
            PG8_LDB(B0, 1, 0); PG8_LDB(B1, 1, 1); PG8_SCHED; PG8_LDA(At, 1, 0); PG8_STAGE(PG8_SA(0, 1), a2 + hstepA, voffA);
            PG8_WAIT_V(8); PG8_WAIT_L(0); PG8_BAR; PG8_MMA(0, 0, At, B0); PG8_MMA(0, 1, At, B1); PG8_BAR; PG8_SCHED;
            PG8_LDA(At, 1, 1); PG8_STAGE(PG8_SB(1, 0), b3, voffB); PG8_STAGE(PG8_SB(1, 1), b3 + hstep, voffB); PG8_STAGE(PG8_SA(1, 0), a3, voffA);
            PG8_WAIT_V(8); PG8_WAIT_L(0); PG8_BAR; PG8_MMA(1, 0, At, B0); PG8_MMA(1, 1, At, B1); PG8_BAR; PG8_SCHED;
            } else {
            PG8_LDB(B0, 0, 0); PG8_SCHED; PG8_LDA(At, 0, 0); PG8_STAGE(PG8_SA(1, 1), a1 + hstepA, voffA);
            PG8_WAIT_L(8); PG8_BAR; PG8_WAIT_L(0); PG8_MMA(0, 0, At, B0); PG8_BAR; PG8_SCHED;
            PG8_LDB(B1, 0, 1); PG8_STAGE(PG8_SB(0, 0), b2, voffB);
            PG8_BAR; PG8_WAIT_L(0); PG8_MMA(0, 1, At, B1); PG8_BAR;
            PG8_LDA(At, 0, 1); PG8_STAGE(PG8_SA(0, 0), a2, voffA);
            PG8_BAR; PG8_WAIT_L(0); PG8_MMA(1, 0, At, B0); PG8_BAR; PG8_SCHED;
            PG8_STAGE(PG8_SB(0, 1), b2 + hstep, voffB);
            PG8_WAIT_V(6); PG8_BAR; PG8_MMA(1, 1, At, B1); PG8_BAR;
            PG8_LDB(B0, 1, 0); PG8_SCHED; PG8_LDA(At, 1, 0); PG8_STAGE(PG8_SA(0, 1), a2 + hstepA, voffA);
            PG8_WAIT_L(8); PG8_BAR; PG8_WAIT_L(0); PG8_MMA(0, 0, At, B0); PG8_BAR; PG8_SCHED;
            PG8_LDB(B1, 1, 1); PG8_STAGE(PG8_SB(1, 0), b3, voffB);
            PG8_BAR; PG8_WAIT_L(0); PG8_MMA(0, 1, At, B1); PG8_BAR;
            PG8_LDA(At, 1, 1); PG8_STAGE(PG8_SA(1, 0), a3, voffA);
            PG8_BAR; PG8_WAIT_L(0); PG8_MMA(1, 0, At, B0); PG8_BAR; PG8_SCHED;
            PG8_STAGE(PG8_SB(1, 1), b3 + hstep, voffB);
            PG8_WAIT_V(6); PG8_BAR; PG8_MMA(1, 1, At, B1); PG8_BAR;
            }
        }
        if constexpr (ALIGN_EPI) { if (wr == 0) PG8_BAR; }
        if constexpr (!Epi::AFTER_DRAIN) { E(acc, cur, ui, wr, wc, fr, fq); S.done(cur); }
        if (!has_next) break;
#pragma unroll
        for (int a = 0; a < 2; ++a)
#pragma unroll
            for (int b = 0; b < 2; ++b)
#pragma unroll
                for (int m = 0; m < 4; ++m)
#pragma unroll
                    for (int n = 0; n < 2; ++n) acc[a][b][m][n] = (f32x4){0.f, 0.f, 0.f, 0.f};
        cur = nxt; cA = nA; cB = nB; ++ui;
        if constexpr (ALIGN_EPI) { if (wr == 1) PG8_BAR; }
    }
    PG8_WAIT_V(0);
    if constexpr (!ALIGN_EPI) { if (wr == 0) PG8_BAR; }
    PG8_BAR;
    if constexpr (Epi::AFTER_DRAIN) { E.fused(acc, cur, wr, wc, fr, fq, lds, wid, lane); S.done(cur); }
#undef PG8_SA
#undef PG8_SB
#undef PG8_STAGE
#undef PG8_LDA
#undef PG8_LDB
#undef PG8_MMA
#undef PG8_WAIT_V
#undef PG8_WAIT_L
#undef PG8_BAR
#undef PG8_SCHED
}
}
namespace pg8 {
__device__ __forceinline__ float bf_lo(unsigned w) { return __uint_as_float(w << 16); }
__device__ __forceinline__ float bf_hi(unsigned w) { return __uint_as_float(w & 0xffff0000u); }
__device__ __forceinline__ float sigm(float x) { return 1.0f / (1.0f + __expf(-x)); }
typedef unsigned u32x2 __attribute__((ext_vector_type(2)));

struct EpiProj {
    static constexpr bool PERM = true, AFTER_DRAIN = false;
    bf16_t* O; int ldc; const PG8_LAS float* rstd;
    __device__ __forceinline__ void operator()(const f32x4 (&acc)[2][2][4][2], const Unit& u, int ui, int wr, int wc, int fr, int fq) const {
        const int rt0 = wr * 64 + fr, col0 = u.pn * BM + wc * 32 + 8 * fq;
#pragma unroll
        for (int ai = 0; ai < 2; ++ai)
#pragma unroll
            for (int m = 0; m < 4; ++m) { const int rt = rt0 + ai * HALF + m * 16; const float s = rstd[ui * 256 + rt]; bf16_t* rowp = O + (size_t)(u.pm * BM + rt) * ldc + col0;
#pragma unroll
                for (int bj = 0; bj < 2; ++bj) { const f32x4 v0 = acc[ai][bj][m][0] * s, v1 = acc[ai][bj][m][1] * s;
                    u32x4 w; w.x = cvt_pk_bf16(v0[0], v0[1]); w.y = cvt_pk_bf16(v0[2], v0[3]); w.z = cvt_pk_bf16(v1[0], v1[1]); w.w = cvt_pk_bf16(v1[2], v1[3]);
                    *(u32x4*)(rowp + bj * HALF) = w; } }
    }
};
struct EpiPA {
    static constexpr bool PERM = false, AFTER_DRAIN = false;
    float* P; const bf16_t* G; int ldg;
    __device__ __forceinline__ void operator()(const f32x4 (&acc)[2][2][4][2], const Unit& u, int ui, int wr, int wc, int fr, int fq) const {
        const int col0 = u.pn * BM + wc * 32 + 4 * fq;
#pragma unroll
        for (int ai = 0; ai < 2; ++ai)
#pragma unroll
            for (int m = 0; m < 4; ++m) { const int row = u.pm * BM + ai * HALF + wr * 64 + m * 16 + fr;
#pragma unroll
                for (int bj = 0; bj < 2; ++bj)
#pragma unroll
                    for (int n = 0; n < 2; ++n) { const int c = col0 + bj * HALF + n * 16; const u32x2 g = *(const u32x2*)(G + (size_t)row * ldg + c);
                        f32x4 v = acc[ai][bj][m][n]; v[0] *= sigm(bf_lo(g.x)); v[1] *= sigm(bf_hi(g.x)); v[2] *= sigm(bf_lo(g.y)); v[3] *= sigm(bf_hi(g.y));
                        *(f32x4*)(P + (size_t)row * 2048 + c) = v; } }
    }
};
struct EpiMerge {
    static constexpr bool PERM = true, AFTER_DRAIN = false;
    bf16_t* O; const float* P; const bf16_t* G; int ldg;
    __device__ __forceinline__ void operator()(const f32x4 (&acc)[2][2][4][2], const Unit& u, int ui, int wr, int wc, int fr, int fq) const {
        const int col0 = u.pn * BM + wc * 32 + 8 * fq;
#pragma unroll
        for (int ai = 0; ai < 2; ++ai)
#pragma unroll
            for (int m = 0; m < 4; ++m) { const int row = u.pm * BM + ai * HALF + wr * 64 + m * 16 + fr;
#pragma unroll
                for (int bj = 0; bj < 2; ++bj) { const int c = col0 + bj * HALF; const u32x4 g = *(const u32x4*)(G + (size_t)row * ldg + c);
                    const f32x4 p0 = *(const f32x4*)(P + (size_t)row * 2048 + c), p1 = *(const f32x4*)(P + (size_t)row * 2048 + c + 4);
                    f32x4 v0 = acc[ai][bj][m][0], v1 = acc[ai][bj][m][1];
                    v0[0] = p0[0] + sigm(bf_lo(g.x)) * v0[0]; v0[1] = p0[1] + sigm(bf_hi(g.x)) * v0[1]; v0[2] = p0[2] + sigm(bf_lo(g.y)) * v0[2]; v0[3] = p0[3] + sigm(bf_hi(g.y)) * v0[3];
                    v1[0] = p1[0] + sigm(bf_lo(g.z)) * v1[0]; v1[1] = p1[1] + sigm(bf_hi(g.z)) * v1[1]; v1[2] = p1[2] + sigm(bf_lo(g.w)) * v1[2]; v1[3] = p1[3] + sigm(bf_hi(g.w)) * v1[3];
                    u32x4 w; w.x = cvt_pk_bf16(v0[0], v0[1]); w.y = cvt_pk_bf16(v0[2], v0[3]); w.z = cvt_pk_bf16(v1[0], v1[1]); w.w = cvt_pk_bf16(v1[2], v1[3]);
                    *(u32x4*)(O + (size_t)row * 2048 + c) = w; } }
    }
};
struct EpiG4 {
    static constexpr bool PERM = true, AFTER_DRAIN = false;
    bf16_t* O; float* P; const bf16_t* GA; const bf16_t* GB; int ldg;
    __device__ __forceinline__ void operator()(const f32x4 (&acc)[2][2][4][2], const Unit& u, int ui, int wr, int wc, int fr, int fq) const {
        const int col0 = u.pn * BM + wc * 32 + 8 * fq;
        const bf16_t* G = u.sel ? GB : GA;
#pragma unroll
        for (int ai = 0; ai < 2; ++ai)
#pragma unroll
            for (int m = 0; m < 4; ++m) { const int row = u.pm * BM + ai * HALF + wr * 64 + m * 16 + fr;
#pragma unroll
                for (int bj = 0; bj < 2; ++bj) { const int c = col0 + bj * HALF; const u32x4 g = *(const u32x4*)(G + (size_t)row * ldg + c);
                    f32x4 v0 = acc[ai][bj][m][0], v1 = acc[ai][bj][m][1];
                    v0[0] *= sigm(bf_lo(g.x)); v0[1] *= sigm(bf_hi(g.x)); v0[2] *= sigm(bf_lo(g.y)); v0[3] *= sigm(bf_hi(g.y));
                    v1[0] *= sigm(bf_lo(g.z)); v1[1] *= sigm(bf_hi(g.z)); v1[2] *= sigm(bf_lo(g.w)); v1[3] *= sigm(bf_hi(g.w));
                    float* pp = P + (size_t)row * 2048 + c;
                    if (u.sel == 0) { *(f32x4*)pp = v0; *(f32x4*)(pp + 4) = v1; }
                    else { v0 += *(const f32x4*)pp; v1 += *(const f32x4*)(pp + 4);
                        u32x4 w; w.x = cvt_pk_bf16(v0[0], v0[1]); w.y = cvt_pk_bf16(v0[2], v0[3]); w.z = cvt_pk_bf16(v1[0], v1[1]); w.w = cvt_pk_bf16(v1[2], v1[3]);
                        *(u32x4*)(O + (size_t)row * 2048 + c) = w; } } }
    }
};
struct EpiG4m {
    static constexpr bool PERM = true, AFTER_DRAIN = false, MIDK = true;
    bf16_t* O; const bf16_t* GA; const bf16_t* GB; int ldg;
    __device__ __forceinline__ void midk(f32x4 (&acc)[2][2][4][2], const Unit& u, int wr, int wc, int fr, int fq) const {
        asm volatile("" : "+v"(fr), "+v"(fq));
        const int col0 = u.pn * BM + wc * 32 + 8 * fq;
#pragma unroll
        for (int ai = 0; ai < 2; ++ai)
#pragma unroll
            for (int m = 0; m < 4; ++m) { const size_t ro = (size_t)(u.pm * BM + ai * HALF + wr * 64 + m * 16 + fr) * ldg;
#pragma unroll
                for (int bj = 0; bj < 2; ++bj) { const int c = col0 + bj * HALF; const u32x4 a = *(const u32x4*)(GA + ro + c), b = *(const u32x4*)(GB + ro + c);
#define PG8_RHO(x, y) ((1.0f + __expf(-(y))) / (1.0f + __expf(-(x))))
                    f32x4& v0 = acc[ai][bj][m][0]; f32x4& v1 = acc[ai][bj][m][1];
                    v0[0] *= PG8_RHO(bf_lo(a.x), bf_lo(b.x)); v0[1] *= PG8_RHO(bf_hi(a.x), bf_hi(b.x)); v0[2] *= PG8_RHO(bf_lo(a.y), bf_lo(b.y)); v0[3] *= PG8_RHO(bf_hi(a.y), bf_hi(b.y));
                    v1[0] *= PG8_RHO(bf_lo(a.z), bf_lo(b.z)); v1[1] *= PG8_RHO(bf_hi(a.z), bf_hi(b.z)); v1[2] *= PG8_RHO(bf_lo(a.w), bf_lo(b.w)); v1[3] *= PG8_RHO(bf_hi(a.w), bf_hi(b.w));
#undef PG8_RHO
                }
                asm volatile("" ::: "memory"); }
    }
    __device__ __forceinline__ void operator()(const f32x4 (&acc)[2][2][4][2], const Unit& u, int ui, int wr, int wc, int fr, int fq) const {
        const int col0 = u.pn * BM + wc * 32 + 8 * fq;
#pragma unroll
        for (int ai = 0; ai < 2; ++ai)
#pragma unroll
            for (int m = 0; m < 4; ++m) { const int row = u.pm * BM + ai * HALF + wr * 64 + m * 16 + fr;
#pragma unroll
                for (int bj = 0; bj < 2; ++bj) { const int c = col0 + bj * HALF; const u32x4 g = *(const u32x4*)(GB + (size_t)row * ldg + c);
                    f32x4 v0 = acc[ai][bj][m][0], v1 = acc[ai][bj][m][1];
                    v0[0] *= sigm(bf_lo(g.x)); v0[1] *= sigm(bf_hi(g.x)); v0[2] *= sigm(bf_lo(g.y)); v0[3] *= sigm(bf_hi(g.y));
                    v1[0] *= sigm(bf_lo(g.z)); v1[1] *= sigm(bf_hi(g.z)); v1[2] *= sigm(bf_lo(g.w)); v1[3] *= sigm(bf_hi(g.w));
                    u32x4 w; w.x = cvt_pk_bf16(v0[0], v0[1]); w.y = cvt_pk_bf16(v0[2], v0[3]); w.z = cvt_pk_bf16(v1[0], v1[1]); w.w = cvt_pk_bf16(v1[2], v1[3]);
                    *(u32x4*)(O + (size_t)row * 2048 + c) = w; } }
    }
};
struct DualOrder : StaticOrder {
    __host__ __device__ bool next(int i, Unit& u) const { if (!StaticOrder::next(i >> 1, u)) return false; u.sel = i & 1; return true; }
};
struct EpiRes {
    static constexpr bool PERM = false, AFTER_DRAIN = false;
    float* H; bf16_t* HB; float* RS;
    __device__ __forceinline__ void operator()(const f32x4 (&acc)[2][2][4][2], const Unit& u, int ui, int wr, int wc, int fr, int fq) const {
        const int col0 = u.pn * BM + wc * 32 + 4 * fq;
#pragma unroll
        for (int ai = 0; ai < 2; ++ai)
#pragma unroll
            for (int m = 0; m < 4; ++m) { const int row = u.pm * BM + ai * HALF + wr * 64 + m * 16 + fr; float ss = 0.f;
#pragma unroll
                for (int bj = 0; bj < 2; ++bj)
#pragma unroll
                    for (int n = 0; n < 2; ++n) { const size_t off = (size_t)row * 2048 + col0 + bj * HALF + n * 16;
                        f32x4 hv = *(const f32x4*)(H + off); hv += acc[ai][bj][m][n]; *(f32x4*)(H + off) = hv;
                        u32x2 w; w.x = cvt_pk_bf16(hv[0], hv[1]); w.y = cvt_pk_bf16(hv[2], hv[3]); *(u32x2*)(HB + off) = w;
                        ss += (hv[0] * hv[0] + hv[1] * hv[1]) + (hv[2] * hv[2] + hv[3] * hv[3]); }
                ss += __shfl_xor(ss, 16); ss += __shfl_xor(ss, 32);
                if (fq == 0) RS[(size_t)row * 32 + u.pn * 4 + wc] = ss; }
    }
};
}

#define GAS __attribute__((address_space(1)))
#define LAS __attribute__((address_space(3)))
typedef unsigned short bf16;
typedef unsigned v4u __attribute__((ext_vector_type(4)));
typedef float f32x4 __attribute__((ext_vector_type(4)));
typedef short bf16x8 __attribute__((ext_vector_type(8)));
typedef GAS unsigned gu32;
typedef GAS unsigned long long gu64;
#define RLX_AGENT __ATOMIC_RELAXED, __HIP_MEMORY_SCOPE_AGENT
#define LDS_WAIT() asm volatile("s_waitcnt lgkmcnt(0)" ::: "memory")
#define VM_WAIT() asm volatile("s_waitcnt vmcnt(0)" ::: "memory")
__device__ __forceinline__ unsigned long long rt() { return __builtin_amdgcn_s_memrealtime(); }
__device__ __forceinline__ unsigned f2bf(float f) { unsigned u = __builtin_bit_cast(unsigned, f); return (u + 0x7fffu + ((u >> 16) & 1u)) >> 16; }
__device__ __forceinline__ unsigned pk2(float lo, float hi) { return f2bf(lo) | (f2bf(hi) << 16); }

#define XB_TMO      128
#define XB_XCNT(j)  (256  + 64 * (j))
#define XB_XSUB(j)  (1280 + 64 * (j))
#define XB_XGEN(j)  (2304 + 64 * (j))
#define XB_TOP      3328
#define XB_TOPGEN   3392
#define XCD_BAR_WORDS 3456
#define XB_SPIN_CAP (1u << 18)

__device__ __forceinline__ unsigned xb_ld(unsigned* p)              { return __hip_atomic_load(p, __ATOMIC_RELAXED, __HIP_MEMORY_SCOPE_AGENT); }
__device__ __forceinline__ unsigned xb_add(unsigned* p, unsigned v) { return __hip_atomic_fetch_add(p, v, __ATOMIC_RELAXED, __HIP_MEMORY_SCOPE_AGENT); }
__device__ __forceinline__ unsigned xb_xcc_id() { return (unsigned)__builtin_amdgcn_s_getreg((3 << 11) | 20) & 0xFu; }
#define XB_SPIN(cond, bar) do { unsigned _sp = 0; while (cond) { __builtin_amdgcn_s_sleep(1); \
    if ((++_sp & 255u) == 0u) { if (xb_ld(&(bar)[XB_TMO])) break; if (_sp > XB_SPIN_CAP) { atomicAdd(&(bar)[XB_TMO], 1u); break; } } } } while (0)

struct XcdBarrier {
    unsigned* bar; unsigned x;
    volatile LAS unsigned* st;
};

__device__ __forceinline__ XcdBarrier xcd_barrier_post(unsigned* bar, volatile LAS unsigned* st) {
    XcdBarrier b; b.bar = bar; b.x = xb_xcc_id(); b.st = st;
    if (threadIdx.x == 0) (void)xb_add(&bar[XB_XCNT(b.x)], 1u);
    return b;
}
__device__ __forceinline__ void xcd_barrier_complete(unsigned* bar, unsigned x, unsigned& nloc, unsigned& nx) {
    const unsigned G = gridDim.x * gridDim.y * gridDim.z;
    unsigned sum, cnt, mine, sp = 0u;
    for (;;) {
        sum = 0u; cnt = 0u; mine = 0u;
#pragma unroll
        for (unsigned j = 0; j < 16; ++j) { const unsigned c = xb_ld(&bar[XB_XCNT(j)]); sum += c; cnt += (c > 0u) ? 1u : 0u; mine = (j == x) ? c : mine; }
        if (sum == G) break;
        __builtin_amdgcn_s_sleep(1);
        if ((++sp & 255u) == 0u) { if (xb_ld(&bar[XB_TMO])) break; if (sp > XB_SPIN_CAP) { atomicAdd(&bar[XB_TMO], 1u); break; } }
    }
    nloc = mine > 0u ? mine : 1u; nx = cnt > 0u ? cnt : 1u;
}

__device__ __forceinline__ void xcd_barrier(const XcdBarrier& b, bool thread0) {
    asm volatile("s_waitcnt vmcnt(0)" ::: "memory");
    __syncthreads();
    if (thread0) {
        unsigned* bar = b.bar;
        __builtin_amdgcn_s_waitcnt(0);
        unsigned nloc = b.st[0], nx = b.st[1];
        if (nloc == 0u) { xcd_barrier_complete(bar, b.x, nloc, nx); b.st[0] = nloc; b.st[1] = nx; }
        const unsigned old = xb_add(&bar[XB_XSUB(b.x)], 1u);
        const unsigned gen = old / nloc;
        if (old + 1u == (gen + 1u) * nloc) {
            __builtin_amdgcn_fence(__ATOMIC_RELEASE, "agent");
            asm volatile("s_waitcnt vmcnt(0)" ::: "memory");
            const unsigned og = xb_add(&bar[XB_TOP], 1u);
            const unsigned tg = og / nx;
            if (og + 1u == (tg + 1u) * nx) xb_add(&bar[XB_TOPGEN], 1u);
            else XB_SPIN(xb_ld(&bar[XB_TOPGEN]) == tg, bar);
            __builtin_amdgcn_fence(__ATOMIC_ACQUIRE, "agent");
            xb_add(&bar[XB_XGEN(b.x)], 1u);
            asm volatile("s_waitcnt vmcnt(0)" ::: "memory");
        } else {
            XB_SPIN(xb_ld(&bar[XB_XGEN(b.x)]) == gen, bar);
            __builtin_amdgcn_fence(__ATOMIC_ACQUIRE, "agent");
            asm volatile("s_waitcnt vmcnt(0)" ::: "memory");
        }
    }
    __syncthreads();
}
#ifndef MK_PROBE
#define MK_PROBE (-1)
#endif
#ifndef MK_PROBE_SCALE
#define MK_PROBE_SCALE 4e-6f
#endif
#define PROBE_T0() unsigned long long pt0_ = 0; if (MK_PROBE >= 0) { pt0_ = __builtin_amdgcn_s_memtime(); asm volatile("s_waitcnt lgkmcnt(0)" ::: "memory"); }
#define PROBE_T1(id) do { if (MK_PROBE == (id)) { const unsigned long long pt1_ = __builtin_amdgcn_s_memtime(); asm volatile("s_waitcnt lgkmcnt(0)" ::: "memory"); \
    if (C.bid == 0 && C.wave == 0 && C.lane == 0) { volatile LAS unsigned* pw_ = (volatile LAS unsigned*)(C.lds + MISC_OFF + 64); pw_[0] = pw_[0] + (unsigned)(pt1_ - pt0_); } } } while (0)
constexpr int NWAVES = 8;
constexpr int NLAYER = 4, DM = 2048, NBATCH = 2, SEQ = 4096, NMETA = 16, LTOK = SEQ + NMETA, NTOK = NBATCH * LTOK;
constexpr int MP = 8448;
constexpr int NP1 = 8448;
constexpr int NC_IN = 8264;
constexpr int PC_QA = 0, PC_KA = 1024, PC_VA = 1152, PC_ZA = 1280, PC_CQ = 2304, PC_CKV = 2816, PC_ZB = 3072, PC_GA = 4096, PC_GB = 6144, PC_KIDX = 8192, PC_WIDX = 8256;
constexpr int NQ2 = 4608;
constexpr int TOPK = 256;
constexpr int YLD = 2048;
constexpr float RMS_EPS = 1e-6f;

__device__ __forceinline__ int rowof(int b, int t) { return t < NMETA ? 8192 + b * NMETA + t : b * SEQ + (t - NMETA); }
__device__ __forceinline__ int t5_bucket(int d) {
    const int n = d < 0 ? 0 : d;
    if (n < 16) return n;
    return 16 + (n >= 19) + (n >= 21) + (n >= 24) + (n >= 27) + (n >= 31) + (n >= 35) + (n >= 40) + (n >= 46) + (n >= 52) + (n >= 59) + (n >= 67) + (n >= 77) + (n >= 87) + (n >= 99) + (n >= 113);
}
__device__ __forceinline__ float bf2f(bf16 v) { return __uint_as_float((unsigned)v << 16); }
__device__ __forceinline__ float sigmoidf_(float x) { return 1.0f / (1.0f + __expf(-x)); }
__device__ __forceinline__ float siluf_(float x) { return x / (1.0f + __expf(-x)); }
__device__ __forceinline__ float wave_sum(float v) {
#pragma unroll
    for (int o = 1; o < 64; o <<= 1) v += __shfl_xor(v, o);
    return v;
}
__device__ __forceinline__ float wave_max(float v) {
#pragma unroll
    for (int o = 1; o < 64; o <<= 1) v = fmaxf(v, __shfl_xor(v, o));
    return v;
}
__device__ __forceinline__ int wave_sum_i(int v) {
#pragma unroll
    for (int o = 1; o < 64; o <<= 1) v += __shfl_xor(v, o);
    return v;
}

constexpr size_t MiB = 1u << 20;
constexpr size_t WS_CTL = 0, CTL_ZERO_BYTES = 1 * MiB;
constexpr size_t SZ_W1 = (size_t)NLAYER * NP1 * DM * 2, SZ_W2 = (size_t)NLAYER * NQ2 * 512 * 2, SZ_WA = (size_t)NLAYER * DM * 1024 * 2, SZ_WO = (size_t)NLAYER * DM * DM * 2;
constexpr size_t al(size_t x) { return (x + 4095) / 4096 * 4096; }
constexpr size_t WS_W1 = 1 * MiB, WS_W2 = WS_W1 + al(SZ_W1), WS_WA = WS_W2 + al(SZ_W2), WS_WB = WS_WA + 1024 * 2, WS_WO = WS_WA + al(2 * SZ_WA);
constexpr size_t SZ_WUV = (size_t)NLAYER * 16 * 64 * 256 * 2;
constexpr size_t WS_WUV = WS_WO + al(SZ_WO);
constexpr size_t WS_VT = WS_WUV + al(SZ_WUV);
constexpr size_t WS_H = WS_VT + al((size_t)2 * 128 * 4128 * 2), WS_HB = WS_H + al((size_t)MP * DM * 4), WS_RS = WS_HB + al((size_t)MP * DM * 2);
constexpr size_t WS_RS2 = WS_RS + al((size_t)MP * 32 * 4);
constexpr size_t WS_PROJ = WS_RS2 + al((size_t)32 * 64 * 4), WS_CQN = WS_PROJ + al((size_t)MP * NP1 * 2), WS_CKVN = WS_CQN + al((size_t)MP * 512 * 2);
constexpr size_t WS_Q2 = WS_CKVN + al((size_t)MP * 256 * 2), WS_OLAT = WS_Q2 + al((size_t)MP * NQ2 * 2), WS_YA = WS_OLAT + al((size_t)256 * 3 * 16 * 8 * 64 * 8 * 2);
constexpr size_t WS_YB = WS_YA + 1024 * 2, WS_PA = WS_YA + al((size_t)MP * 2048 * 2),
 WS_MG = WS_PA + al((size_t)MP * DM * 4), WS_END = WS_MG + al((size_t)MP * DM * 2);
constexpr int CW_TMO = 0, CW_CODE = 1, CW_BAR = 4096;

constexpr int LDSCTL_OFF = 0, MISC_OFF = LDSCTL_OFF + 320;
constexpr int RSTD_OFF = 512;
constexpr int RING_OFF = 8192, RING_BYTES = 131072;
constexpr int LDS_BYTES = 163840;
static_assert(RSTD_OFF + 5 * 256 * 4 <= RING_OFF, "LDS map");

struct Args {
    const float* x; const float* meta; const float* bias_table; const float* norm_g; const float* w_in; const float* q_norm_g; const float* kv_norm_g; const float* w_qb; const float* w_iq;
    const float* w_uk; const float* w_uv; const float* sinks; const float* w_proj_a; const float* w_proj_b; const float* w_out; const float* final_g;
    float* out; unsigned char* ws; int ph_lo, ph_hi;
};

struct XDesc { const float* W; const float* scale; bf16* out; int ldw, k0, c0, nvalid, K; };
__device__ __forceinline__ void xpose_load(const XDesc& d, float (&v)[32], int lane) {
    const int c = lane & 31; const float* p = d.W + (size_t)(d.k0 + (lane >> 5)) * d.ldw + d.c0 + c;
#pragma unroll
    for (int i = 0; i < 32; ++i) v[i] = (c < d.nvalid) ? p[(size_t)(2 * i) * d.ldw] : 0.f;
    if (d.scale) {
#pragma unroll
        for (int i = 0; i < 32; ++i) v[i] *= d.scale[d.k0 + 2 * i + (lane >> 5)];
    }
}
__device__ __forceinline__ void xpose_store(const XDesc& d, const float (&v)[32], LAS float* scr, int lane) {
    const int c = lane & 31;
#pragma unroll
    for (int i = 0; i < 32; ++i) scr[(2 * i + (lane >> 5)) * 33 + c] = v[i];
    LDS_WAIT(); asm volatile("" ::: "memory");
    const int cc = lane & 7;
#pragma unroll
    for (int j = 0; j < 4; ++j) { const int n = (lane >> 3) + 8 * j; const LAS float* s = scr + (8 * cc) * 33 + n;
        v4u o; o.x = pk2(s[0 * 33], s[1 * 33]); o.y = pk2(s[2 * 33], s[3 * 33]); o.z = pk2(s[4 * 33], s[5 * 33]); o.w = pk2(s[6 * 33], s[7 * 33]);
        *(GAS v4u*)(d.out + (size_t)n * d.K + d.k0 + 8 * cc) = o; }
    LDS_WAIT(); asm volatile("" ::: "memory");
}
__device__ __forceinline__ void fold_item(const float* __restrict__ wqb, const float* __restrict__ wuk, const float* __restrict__ gq, bf16* W2l, int h, int kb, int rb, LAS float* scr, int lane) {
    const int rr = lane & 31, r = rb * 32 + rr;
    float uk[64];
#pragma unroll
    for (int d = 0; d < 64; ++d) uk[d] = wuk[((size_t)h * 64 + d) * 256 + r];
    for (int i = 0; i < 32; ++i) { const int kk = 2 * i + (lane >> 5), k = kb * 64 + kk; const f32x4* qp = (const f32x4*)(wqb + (size_t)k * 1024 + h * 64); float a = 0.f;
#pragma unroll
        for (int d4 = 0; d4 < 16; ++d4) { const f32x4 q = qp[d4]; a = fmaf(q[0], uk[4 * d4], a); a = fmaf(q[1], uk[4 * d4 + 1], a); a = fmaf(q[2], uk[4 * d4 + 2], a); a = fmaf(q[3], uk[4 * d4 + 3], a); }
        scr[kk * 33 + rr] = a * gq[k]; }
    LDS_WAIT(); asm volatile("" ::: "memory");
    const int cc = lane & 7; bf16* out = W2l + (size_t)(h * 256 + rb * 32) * 512;
#pragma unroll
    for (int j = 0; j < 4; ++j) { const int n = (lane >> 3) + 8 * j; const LAS float* s = scr + (8 * cc) * 33 + n;
        v4u o; o.x = pk2(s[0 * 33], s[1 * 33]); o.y = pk2(s[2 * 33], s[3 * 33]); o.z = pk2(s[4 * 33], s[5 * 33]); o.w = pk2(s[6 * 33], s[7 * 33]);
        *(GAS v4u*)(out + (size_t)n * 512 + kb * 64 + 8 * cc) = o; }
    LDS_WAIT(); asm volatile("" ::: "memory");
}

struct Ctx {
    LAS unsigned char* lds; int tid, lane, wave, G, gw, NGW, bid;
    Args a;
};
__device__ __forceinline__ unsigned char* launder(unsigned char* p) { asm volatile("" : "+s"(p)); return p; }
__device__ __forceinline__ const float* launderf(const float* p) { asm volatile("" : "+s"(p)); return p; }
struct Bufs {
    bf16 *W1, *W2, *WA, *WB, *WO, *WUV, *VT, *HB, *PROJ, *CQN, *CKVN, *Q2, *OLAT, *YA, *YB, *MG; float *H, *RS, *RS2, *PA;
    __device__ __forceinline__ explicit Bufs(unsigned char* ws0) {
        unsigned char* ws = launder(ws0);
        W1 = (bf16*)(ws + WS_W1); W2 = (bf16*)(ws + WS_W2); WA = (bf16*)(ws + WS_WA); WB = (bf16*)(ws + WS_WB); WO = (bf16*)(ws + WS_WO); WUV = (bf16*)(ws + WS_WUV); VT = (bf16*)(ws + WS_VT);
        H = (float*)(ws + WS_H); HB = (bf16*)(ws + WS_HB); RS = (float*)(ws + WS_RS); RS2 = (float*)(ws + WS_RS2); PROJ = (bf16*)(ws + WS_PROJ); CQN = (bf16*)(ws + WS_CQN); CKVN = (bf16*)(ws + WS_CKVN);
        Q2 = (bf16*)(ws + WS_Q2); OLAT = (bf16*)(ws + WS_OLAT); YA = (bf16*)(ws + WS_YA); YB = (bf16*)(ws + WS_YB); PA = (float*)(ws + WS_PA); MG = (bf16*)(ws + WS_MG);
    }
};

__device__ __forceinline__ void p0_prologue(const Ctx& C) {
    const Bufs B(C.a.ws);
    const Args& A = C.a;
    LAS float* scr = (LAS float*)(C.lds + RING_OFF + C.wave * 16384);
    constexpr int I_T1 = (DM / 64) * (NP1 / 32), I_T2 = (512 / 64) * (512 / 32), I_T3 = (1024 / 64) * (DM / 32), I_T5 = (DM / 64) * (DM / 32), I_F = 16 * 8 * 8, I_UV = 16 * 8;
    constexpr int I_X = I_T1 + I_T2 + 2 * I_T3 + I_T5, NX = NLAYER * I_X;
    auto decode = [&](int it) -> XDesc {
        const int l = it / I_X; int r = it % I_X; XDesc d;
        if (r < I_T1) { const int nblk = NP1 / 32, kb = r / nblk, n0 = (r % nblk) * 32; int c0, nvalid = 32;
            if (n0 < 4096) c0 = n0; else if (n0 < 8192) c0 = n0 + 72; else { c0 = n0 - 8192 + 4096; nvalid = (8264 - n0) < 0 ? 0 : ((8264 - n0) > 32 ? 32 : (8264 - n0)); }
            d = XDesc{A.w_in + (size_t)l * DM * NC_IN, A.norm_g + l * DM, B.W1 + ((size_t)l * NP1 + n0) * DM, NC_IN, kb * 64, c0, nvalid, DM}; return d; }
        r -= I_T1;
        if (r < I_T2) { const int nblk = 512 / 32, kb = r / nblk, nb = r % nblk;
            d = XDesc{A.w_iq + (size_t)l * 512 * 512, A.q_norm_g + l * 512, B.W2 + ((size_t)l * NQ2 + 4096 + nb * 32) * 512, 512, kb * 64, nb * 32, 32, 512}; return d; }
        r -= I_T2;
        if (r < 2 * I_T3) { const bool second = r >= I_T3; if (second) r -= I_T3; const int nblk = DM / 32, kb = r / nblk, nb = r % nblk;
            d = XDesc{(second ? A.w_proj_b : A.w_proj_a) + (size_t)l * 1024 * DM, nullptr, (second ? B.WB : B.WA) + ((size_t)l * DM + nb * 32) * 2048, DM, kb * 64, nb * 32, 32, 2048}; return d; }
        r -= 2 * I_T3;
        { const int nblk = DM / 32, kb = r / nblk, nb = r % nblk;
            d = XDesc{A.w_out + (size_t)l * DM * DM, nullptr, B.WO + ((size_t)l * DM + nb * 32) * DM, DM, kb * 64, nb * 32, 32, DM}; return d; }
    };
    {
        int it = C.gw;
        if (it < NX) {
            XDesc dc = decode(it); float vc[32]; xpose_load(dc, vc, C.lane);
            for (;;) {
                const int itn = it + C.NGW; const bool more = itn < NX;
                XDesc dn = dc; float vn[32];
                if (more) { dn = decode(itn); xpose_load(dn, vn, C.lane); }
                xpose_store(dc, vc, scr, C.lane);
                if (!more) break;
                dc = dn; it = itn;
#pragma unroll
                for (int i = 0; i < 32; ++i) vc[i] = vn[i];
            }
        }
    }
    for (int it = C.gw; it < NLAYER * (I_F + I_UV); it += C.NGW) {
        const int l = it / (I_F + I_UV); int r = it % (I_F + I_UV);
        if (r >= I_F) { r -= I_F; const int h = r / 8, s = r % 8;
            const float* wsrc = A.w_uv + ((size_t)l * 16 + h) * 256 * 64; const int gg = C.lane >> 4, cc = C.lane & 15;
#pragma unroll
            for (int nt = 0; nt < 4; ++nt) { const float* p = wsrc + (size_t)(32 * s + 8 * gg) * 64 + 16 * nt + cc;
                v4u o; o.x = pk2(p[0 * 64], p[1 * 64]); o.y = pk2(p[2 * 64], p[3 * 64]); o.z = pk2(p[4 * 64], p[5 * 64]); o.w = pk2(p[6 * 64], p[7 * 64]);
                *(GAS v4u*)(B.WUV + ((((size_t)l * 16 + h) * 8 + s) * 4 + nt) * 512 + C.lane * 8) = o; }
            continue; }
        { const int h = r / 64, kb = (r / 8) % 8, rb = r % 8;
            fold_item(A.w_qb + (size_t)l * 512 * 1024, A.w_uk + (size_t)l * 16 * 64 * 256, A.q_norm_g + l * 512, B.W2 + (size_t)l * NQ2 * 512, h, kb, rb, scr, C.lane); }
    }
    for (int m = C.gw; m < MP; m += C.NGW) {
        const float* src = nullptr;
        if (m < 8192) src = A.x + (size_t)m * DM; else if (m < 8224) src = A.meta + (size_t)((m - 8192) % NMETA) * DM;
        float ss = 0.f;
#pragma unroll
        for (int j = 0; j < 8; ++j) { f32x4 v = src ? *(const f32x4*)(src + j * 256 + C.lane * 4) : (f32x4){0.f, 0.f, 0.f, 0.f};
            *(f32x4*)(B.H + (size_t)m * DM + j * 256 + C.lane * 4) = v;
            pg8::u32x2 w; w.x = pk2(v[0], v[1]); w.y = pk2(v[2], v[3]); *(pg8::u32x2*)(B.HB + (size_t)m * DM + j * 256 + C.lane * 4) = w;
            ss += (v[0] * v[0] + v[1] * v[1]) + (v[2] * v[2] + v[3] * v[3]); }
        ss = wave_sum(ss);
        if (C.lane < 32) B.RS[(size_t)m * 32 + C.lane] = (C.lane == 0) ? ss : 0.f;
        if (m >= 8192 && m < 8224) B.RS2[(size_t)(m - 8192) * 64 + C.lane] = (C.lane == 0) ? ss : 0.f;
        if (m >= NTOK) {
#pragma unroll
            for (int j = 0; j < 2; ++j) { *(v4u*)(B.YA + (size_t)m * YLD + j * 512 + C.lane * 8) = (v4u){0u, 0u, 0u, 0u}; *(v4u*)(B.YB + (size_t)m * YLD + j * 512 + C.lane * 8) = (v4u){0u, 0u, 0u, 0u}; }
        }
    }
}

__device__ __forceinline__ void g1_rstd_table(const Ctx& C, const pg8::StaticOrder& S) {
    const Bufs B(C.a.ws);
    LAS float* tbl = (LAS float*)(C.lds + RSTD_OFF);
    pg8::Unit u;
    for (int ui = 0; ui < 5 && S.next(ui, u); ++ui) {
        if (C.tid < 256) { const f32x4* p = (const f32x4*)(B.RS + (size_t)(u.pm * 256 + C.tid) * 32); float s = 0.f;
#pragma unroll
            for (int j = 0; j < 8; ++j) { const f32x4 v = p[j]; s += (v[0] + v[1]) + (v[2] + v[3]); }
            tbl[ui * 256 + C.tid] = rsqrtf(s * (1.0f / DM) + RMS_EPS); }
    }
    __syncthreads();
}

__device__ __forceinline__ void norm_phase(const Ctx& C, int l) {
    const Bufs B(C.a.ws);
    const Args& A = C.a;
    for (int m = C.gw; m < NTOK; m += C.NGW) {
        const bf16* pr = B.PROJ + (size_t)m * NP1;
        { const v4u w = *(const v4u*)(pr + PC_CQ + C.lane * 8); float v[8] = {pg8::bf_lo(w.x), pg8::bf_hi(w.x), pg8::bf_lo(w.y), pg8::bf_hi(w.y), pg8::bf_lo(w.z), pg8::bf_hi(w.z), pg8::bf_lo(w.w), pg8::bf_hi(w.w)};
          float ss = 0.f;
#pragma unroll
          for (int j = 0; j < 8; ++j) ss += v[j] * v[j];
          ss = wave_sum(ss); const float r = rsqrtf(ss * (1.0f / 512.0f) + RMS_EPS);
          v4u o; o.x = pk2(v[0] * r, v[1] * r); o.y = pk2(v[2] * r, v[3] * r); o.z = pk2(v[4] * r, v[5] * r); o.w = pk2(v[6] * r, v[7] * r);
          *(v4u*)(B.CQN + (size_t)m * 512 + C.lane * 8) = o; }
        { const pg8::u32x2 w = *(const pg8::u32x2*)(pr + PC_CKV + C.lane * 4); float v[4] = {pg8::bf_lo(w.x), pg8::bf_hi(w.x), pg8::bf_lo(w.y), pg8::bf_hi(w.y)};
          float ss = (v[0] * v[0] + v[1] * v[1]) + (v[2] * v[2] + v[3] * v[3]);
          ss = wave_sum(ss); const float r = rsqrtf(ss * (1.0f / 256.0f) + RMS_EPS);
          const f32x4 g = *(const f32x4*)(A.kv_norm_g + l * 256 + C.lane * 4);
          pg8::u32x2 o; o.x = pk2(v[0] * r * g[0], v[1] * r * g[1]); o.y = pk2(v[2] * r * g[2], v[3] * r * g[3]);
          *(pg8::u32x2*)(B.CKVN + (size_t)m * 256 + C.lane * 4) = o; }
    }
    for (int it = C.gw; it < 2 * 65; it += C.NGW) { const int b = it / 65, pos = (it % 65) * 64 + C.lane;
        if (pos < LTOK) { const bf16* vr = B.PROJ + (size_t)rowof(b, pos) * NP1 + PC_VA;
#pragma unroll 4
            for (int c8 = 0; c8 < 16; ++c8) { const v4u w = *(const v4u*)(vr + 8 * c8); bf16* o = B.VT + ((size_t)b * 128 + 8 * c8) * 4128 + pos;
                o[0 * 4128] = (bf16)(w.x & 0xffffu); o[1 * 4128] = (bf16)(w.x >> 16); o[2 * 4128] = (bf16)(w.y & 0xffffu); o[3 * 4128] = (bf16)(w.y >> 16);
                o[4 * 4128] = (bf16)(w.z & 0xffffu); o[5 * 4128] = (bf16)(w.z >> 16); o[6 * 4128] = (bf16)(w.w & 0xffffu); o[7 * 4128] = (bf16)(w.w >> 16); } } }
}

__device__ __forceinline__ void swa_naive(const Ctx& C, int l) {
    const Bufs B(C.a.ws);
    const Args& A = C.a;
    LAS float* ps = (LAS float*)(C.lds + RING_OFF + C.wave * 2048);
    LAS int* kp = (LAS int*)(C.lds + RING_OFF + C.wave * 2048 + 1024);
    const int lane = C.lane;
    for (int item = C.gw; item < NTOK * 16; item += C.NGW) {
        const int tok = item >> 4, head = item & 15, b = tok / LTOK, t = tok % LTOK, g = head >> 3, row = rowof(b, t);
        const int nmeta = t < NMETA ? t + 1 : NMETA;
        const int wlo = t - 127 < NMETA ? NMETA : t - 127;
        const int nwin = t < NMETA ? 0 : t - wlo + 1;
        const int ncand = nmeta + nwin;
        const bf16* q = B.PROJ + (size_t)row * NP1 + PC_QA + head * 64;
        const float sink = A.sinks[l * 16 + head];
        float mx = -3.0e38f;
        for (int c = lane; c < ncand; c += 64) {
            const int kpos = c < nmeta ? c : wlo + (c - nmeta), krow = rowof(b, kpos);
            const bf16* k = B.PROJ + (size_t)krow * NP1 + PC_KA + g * 64;
            float s = 0.f;
            for (int d = 0; d < 64; ++d) s = fmaf(bf2f(q[d]), bf2f(k[d]), s);
            s = s * 0.125f + A.bias_table[t5_bucket(t - kpos) * 32 + head];
            ps[c] = s; kp[c] = krow;
            mx = fmaxf(mx, s);
        }
        mx = fmaxf(wave_max(mx), sink);
        float sum = 0.f;
        for (int c = lane; c < ncand; c += 64) { const float p = __expf(ps[c] - mx); ps[c] = p; sum += p; }
        sum = wave_sum(sum) + __expf(sink - mx);
        LDS_WAIT(); asm volatile("" ::: "memory");
        float o = 0.f;
        for (int c = 0; c < ncand; ++c) o = fmaf(ps[c], bf2f(B.PROJ[(size_t)kp[c] * NP1 + PC_VA + g * 64 + lane]), o);
        o /= sum;
        const float z = bf2f(B.PROJ[(size_t)row * NP1 + PC_ZA + head * 64 + lane]);
        B.YA[(size_t)row * YLD + head * 64 + lane] = (bf16)f2bf(o * siluf_(z));
        LDS_WAIT(); asm volatile("" ::: "memory");
    }
}

__device__ __forceinline__ unsigned f2key(float f) { const unsigned u = __float_as_uint(f); return (u & 0x80000000u) ? ~u : (u | 0x80000000u); }

__device__ __forceinline__ void dsa_naive(const Ctx& C, int l) {
    const Bufs B(C.a.ws);
    const Args& A = C.a;
    LAS float* s_qi = (LAS float*)(C.lds + RING_OFF + 0);
    LAS float* s_wi = (LAS float*)(C.lds + RING_OFF + 2048);
    LAS unsigned* s_key = (LAS unsigned*)(C.lds + RING_OFF + 2112);
    LAS int* s_sel = (LAS int*)(C.lds + RING_OFF + 18560);
    LAS float* s_ql = (LAS float*)(C.lds + RING_OFF + 19584);
    LAS float* s_p = (LAS float*)(C.lds + RING_OFF + 35968);
    LAS int* s_cnt = (LAS int*)(C.lds + RING_OFF + 52352);
    LAS int* s_n = (LAS int*)(C.lds + RING_OFF + 52384);
    const int tid = C.tid, lane = C.lane, wid = C.wave;
    for (int item = C.bid; item < NTOK; item += C.G) {
        const int b = item / LTOK, t = item % LTOK, row = rowof(b, t);
        __syncthreads();
        s_qi[tid] = bf2f(B.Q2[(size_t)row * NQ2 + 4096 + tid]);
        if (tid < 8) s_wi[tid] = bf2f(B.PROJ[(size_t)row * NP1 + PC_WIDX + tid]) * 0.35355339059327373f;
        for (int i = tid; i < 4096; i += 512) s_ql[i] = bf2f(B.Q2[(size_t)row * NQ2 + i]);
        __syncthreads();
        const int n = t + 1;
        for (int k = tid; k < n; k += 512) {
            const bf16* kr = B.PROJ + (size_t)rowof(b, k) * NP1 + PC_KIDX;
            float isc = 0.f;
            for (int hh = 0; hh < 8; ++hh) {
                float s = 0.f;
                for (int d = 0; d < 64; ++d) s = fmaf(s_qi[hh * 64 + d], bf2f(kr[d]), s);
                isc += s_wi[hh] * fmaxf(s * 0.125f, 0.f);
            }
            s_key[k] = f2key(isc);
        }
        __syncthreads();
        int cnt;
        if (n <= TOPK) {
            for (int i = tid; i < n; i += 512) s_sel[i] = i;
            cnt = n;
        } else {
            unsigned T = 0u;
            for (int bit = 31; bit >= 0; --bit) {
                const unsigned cand = T | (1u << bit);
                int c = 0;
                for (int k = tid; k < n; k += 512) c += (s_key[k] >= cand) ? 1 : 0;
                c = wave_sum_i(c);
                __syncthreads();
                if (lane == 0) s_cnt[wid] = c;
                __syncthreads();
                int tot = 0;
#pragma unroll
                for (int w = 0; w < 8; ++w) tot += s_cnt[w];
                if (tot >= TOPK) T = cand;
            }
            int c = 0;
            for (int k = tid; k < n; k += 512) c += (s_key[k] > T) ? 1 : 0;
            c = wave_sum_i(c);
            __syncthreads();
            if (lane == 0) s_cnt[wid] = c;
            __syncthreads();
            int ngt = 0;
#pragma unroll
            for (int w = 0; w < 8; ++w) ngt += s_cnt[w];
            const int need = TOPK - ngt;
            if (wid == 0) {
                int base = 0, eqbase = 0;
                for (int k0 = 0; k0 < n; k0 += 64) {
                    const int k = k0 + lane;
                    const unsigned key = k < n ? s_key[k] : 0u;
                    const bool gt = (k < n) && key > T, eq = (k < n) && key == T;
                    const unsigned long long meq = __ballot(eq);
                    const unsigned long long lt = (1ull << lane) - 1ull;
                    const int eqrank = eqbase + __popcll(meq & lt);
                    const bool sel = gt || (eq && eqrank < need);
                    const unsigned long long ms = __ballot(sel);
                    if (sel) s_sel[base + __popcll(ms & lt)] = k;
                    base += __popcll(ms); eqbase += __popcll(meq);
                }
                if (lane == 0) s_n[0] = base;
            }
            __syncthreads();
            cnt = s_n[0];
        }
        __syncthreads();
        {
            const int j = tid & 255, hb = (tid >> 8) * 8;
            float sc[8];
#pragma unroll
            for (int hh = 0; hh < 8; ++hh) sc[hh] = 0.f;
            if (j < cnt) {
                const int idx = s_sel[j];
                const bf16* kr = B.CKVN + (size_t)rowof(b, idx) * 256;
                for (int r = 0; r < 256; ++r) {
                    const float v = bf2f(kr[r]);
#pragma unroll
                    for (int hh = 0; hh < 8; ++hh) sc[hh] = fmaf(s_ql[(hb + hh) * 256 + r], v, sc[hh]);
                }
                const int bk = t5_bucket(t - idx);
#pragma unroll
                for (int hh = 0; hh < 8; ++hh) s_p[(hb + hh) * 256 + j] = sc[hh] * 0.125f + A.bias_table[bk * 32 + 16 + hb + hh];
            } else {
#pragma unroll
                for (int hh = 0; hh < 8; ++hh) s_p[(hb + hh) * 256 + j] = -3.0e38f;
            }
        }
        __syncthreads();
        for (int hh = wid * 2; hh < wid * 2 + 2; ++hh) {
            float v[4]; float mx = -3.0e38f;
#pragma unroll
            for (int i = 0; i < 4; ++i) { v[i] = s_p[hh * 256 + lane + 64 * i]; mx = fmaxf(mx, v[i]); }
            mx = wave_max(mx);
            float sum = 0.f;
#pragma unroll
            for (int i = 0; i < 4; ++i) { v[i] = (lane + 64 * i < cnt) ? __expf(v[i] - mx) : 0.f; sum += v[i]; }
            sum = wave_sum(sum);
            const float inv = 1.0f / sum;
#pragma unroll
            for (int i = 0; i < 4; ++i) s_p[hh * 256 + lane + 64 * i] = bf2f((bf16)f2bf(v[i] * inv));
        }
        __syncthreads();
        {
            const int r = tid & 255, hb = (tid >> 8) * 8;
            float acc[8];
#pragma unroll
            for (int hh = 0; hh < 8; ++hh) acc[hh] = 0.f;
            for (int j = 0; j < cnt; ++j) {
                const float v = bf2f(B.CKVN[(size_t)rowof(b, s_sel[j]) * 256 + r]);
#pragma unroll
                for (int hh = 0; hh < 8; ++hh) acc[hh] = fmaf(s_p[(hb + hh) * 256 + j], v, acc[hh]);
            }
#pragma unroll
            for (int hh = 0; hh < 8; ++hh) B.OLAT[(size_t)row * 4096 + (hb + hh) * 256 + r] = (bf16)f2bf(acc[hh]);
        }
    }
    __syncthreads();
}
__device__ __forceinline__ void wuv_naive(const Ctx& C, int l) {
    const Bufs B(C.a.ws);
    const Args& A = C.a;
    const float* wuv = A.w_uv + (size_t)l * 16 * 256 * 64;
    for (int item = C.bid; item < NTOK; item += C.G) {
        const int b = item / LTOK, t = item % LTOK, row = rowof(b, t);
        for (int c = C.tid; c < 1024; c += 512) {
            const int h = c >> 6, d = c & 63;
            const bf16* o = B.OLAT + (size_t)row * 4096 + h * 256;
            float a = 0.f;
            for (int r = 0; r < 256; ++r) a = fmaf(bf2f(__builtin_nontemporal_load(o + r)), bf2f((bf16)f2bf(wuv[((size_t)h * 256 + r) * 64 + d])), a);
            const float z = bf2f(B.PROJ[(size_t)row * NP1 + PC_ZB + c]);
            B.YB[(size_t)row * YLD + c] = (bf16)f2bf(a * siluf_(z));
        }
    }
}
__device__ __forceinline__ void final_phase(const Ctx& C) {
    const Bufs B(C.a.ws);
    const Args& A = C.a;
    for (int m = C.gw; m < 8192; m += C.NGW) {
        float s = (C.lane < 32) ? B.RS[(size_t)m * 32 + C.lane] : 0.f;
        s = wave_sum(s);
        const float r = rsqrtf(s * (1.0f / DM) + RMS_EPS);
#pragma unroll
        for (int j = 0; j < 8; ++j) { const f32x4 v = *(const f32x4*)(B.H + (size_t)m * DM + j * 256 + C.lane * 4); const f32x4 g = *(const f32x4*)(A.final_g + j * 256 + C.lane * 4);
            *(f32x4*)(A.out + (size_t)m * DM + j * 256 + C.lane * 4) = v * r * g; }
    }
#if defined(MK_PROBE)
    if (MK_PROBE >= 0 && C.gw == 0) { VM_WAIT(); if (C.lane == 0) A.out[0] += (float)((volatile LAS unsigned*)(C.lds + MISC_OFF + 64))[0] * MK_PROBE_SCALE; }
#endif
}


struct SkProj { bf16* O; const LAS float* tbl; __device__ __forceinline__ float operator()(int rloc, int c, float v) const { O[(size_t)rloc * NP1 + c] = (bf16)f2bf(v * tbl[rloc]); return 0.f; } };
struct SkQ2 { bf16* O; __device__ __forceinline__ float operator()(int rloc, int c, float v) const { O[(size_t)rloc * NQ2 + c] = (bf16)f2bf(v); return 0.f; } };
struct SkPA { float* P; const bf16* G; __device__ __forceinline__ float operator()(int rloc, int c, float v) const { P[(size_t)rloc * DM + c] = sigmoidf_(bf2f(G[(size_t)rloc * NP1 + c])) * v; return 0.f; } };
struct SkMerge { bf16* O; const float* P; const bf16* G; __device__ __forceinline__ float operator()(int rloc, int c, float v) const { O[(size_t)rloc * DM + c] = (bf16)f2bf(P[(size_t)rloc * DM + c] + sigmoidf_(bf2f(G[(size_t)rloc * NP1 + c])) * v); return 0.f; } };
struct SkRes { float* H; bf16* HB; __device__ __forceinline__ float operator()(int rloc, int c, float v) const { const float h = H[(size_t)rloc * DM + c] + v; H[(size_t)rloc * DM + c] = h; HB[(size_t)rloc * DM + c] = (bf16)f2bf(h); return h; } };
constexpr int MR = 8192;
typedef float f32x16 __attribute__((ext_vector_type(16)));
template <int NT, int GPI, bool WANT_SS, class F>
__device__ __forceinline__ void skinny_unit(const Ctx& C, const bf16* __restrict__ A, int lda, const bf16* __restrict__ Bt, int ldb, int K, float* ss_out  , int ss_ld, int ss_col0, const F& epi) {
    const int lane = C.lane, w = C.wave, r32 = lane & 31, hh = lane >> 5;
    f32x16 acc[NT];
#pragma unroll
    for (int nt = 0; nt < NT; ++nt) acc[nt] = (f32x16){};
    const int kper = K >> 3, ngroups = kper >> 6;
    const bf16* ap = A + (size_t)r32 * lda + w * kper + 8 * hh;
    const bf16* bp = Bt + (size_t)r32 * ldb + w * kper + 8 * hh;
#pragma unroll 1
    for (int g0 = 0; g0 < ngroups; g0 += GPI) {
        bf16x8 a[GPI][4], bv[NT][GPI][4];
#pragma unroll
        for (int gi = 0; gi < GPI; ++gi)
#pragma unroll
            for (int s = 0; s < 4; ++s) a[gi][s] = *(const bf16x8*)(ap + (g0 + gi) * 64 + 16 * s);
#pragma unroll
        for (int nt = 0; nt < NT; ++nt)
#pragma unroll
            for (int gi = 0; gi < GPI; ++gi)
#pragma unroll
                for (int s = 0; s < 4; ++s) bv[nt][gi][s] = *(const bf16x8*)(bp + (size_t)nt * 32 * ldb + (g0 + gi) * 64 + 16 * s);
#pragma unroll
        for (int gi = 0; gi < GPI; ++gi)
#pragma unroll
            for (int s = 0; s < 4; ++s)
#pragma unroll
                for (int nt = 0; nt < NT; ++nt) acc[nt] = __builtin_amdgcn_mfma_f32_32x32x16_bf16(a[gi][s], bv[nt][gi][s], acc[nt], 0, 0, 0);
    }
    LAS float* part = (LAS float*)(C.lds + RING_OFF);
#pragma unroll
    for (int nt = 0; nt < NT; ++nt)
#pragma unroll
        for (int i = 0; i < 16; ++i) part[(w * NT * 16 + nt * 16 + i) * 64 + lane] = acc[nt][i];
    LDS_WAIT(); __syncthreads();
#pragma unroll
    for (int j = 0; j < 2 * NT; ++j) { const int e = (w + 8 * j) * 64 + lane;
        const int nti = w + 8 * j, nt = nti >> 4, i = nti & 15;
        float v = 0.f;
#pragma unroll
        for (int ww = 0; ww < 8; ++ww) v += part[ww * NT * 1024 + e];
        const int rloc = (i & 3) + 8 * (i >> 2) + 4 * hh, c = nt * 32 + r32;
        float sv = epi(rloc, c, v);
        if (WANT_SS) { sv = sv * sv;
#pragma unroll
            for (int o = 1; o < 32; o <<= 1) sv += __shfl_xor(sv, o);
            if (r32 == 0) ss_out[(size_t)rloc * ss_ld + ss_col0 + nt] = sv; }
    }
    LDS_WAIT(); __syncthreads();
}
__device__ __forceinline__ void skinny_rstd(const Ctx& C, const float* __restrict__ rs, int np, LAS float* tbl) {
    if (C.tid < 32) { float s = 0.f; const f32x4* p = (const f32x4*)(rs + (size_t)C.tid * np);
        for (int j = 0; j < np / 4; ++j) { const f32x4 v = p[j]; s += (v[0] + v[1]) + (v[2] + v[3]); }
        tbl[C.tid] = rsqrtf(s * (1.0f / DM) + RMS_EPS); }
    LDS_WAIT(); __syncthreads();
}

typedef short s16x4 __attribute__((ext_vector_type(4)));
typedef unsigned short u16x4 __attribute__((ext_vector_type(4)));
constexpr int DS_ISC = RING_OFF, DS_ISC_WORDS = 4128, DS_ISC_STRIDE = DS_ISC_WORDS * 4;
constexpr int DS_SEL = DS_ISC + 8 * DS_ISC_STRIDE;
constexpr int DS_BIAS = DS_SEL + 8 * 512;
constexpr int DS_HIST = DS_BIAS + 2048;
constexpr int DS_QROW = DS_HIST + 8 * 272 * 4;
constexpr int DS_END = DS_QROW + 256;
constexpr size_t OL_BLOCK = (size_t)3 * 16 * 8 * 64 * 8;
static_assert(DS_END <= LDS_BYTES, "DSA LDS map");

__device__ __forceinline__ void glds16(const void* gsrc, unsigned lds_dst) { unsigned keep;
    asm volatile("s_mov_b32 %0, m0\n\ts_mov_b32 m0, %2\n\ts_nop 0\n\tglobal_load_lds_dwordx4 %1, off\n\ts_mov_b32 m0, %0" : "=&s"(keep) : "v"(gsrc), "s"(lds_dst) : "memory"); }
__device__ __forceinline__ s16x4 tr_read(LAS unsigned char* p) { typedef short v4i16_t __attribute__((ext_vector_type(4))); return __builtin_bit_cast(s16x4, __builtin_amdgcn_ds_read_tr16_b64_v4i16((LAS v4i16_t*)p)); }
__device__ __forceinline__ unsigned cvtpk(float lo, float hi) { typedef float f2_t __attribute__((ext_vector_type(2))); typedef __bf16 b2_t __attribute__((ext_vector_type(2))); f2_t v = {lo, hi}; b2_t b = __builtin_convertvector(v, b2_t); return __builtin_bit_cast(unsigned, b); }

#define DSA_LOCALS() const int w = C.wave; LAS unsigned* ISC = (LAS unsigned*)(C.lds + DS_ISC); LAS unsigned short* sel = (LAS unsigned short*)(C.lds + DS_SEL) + w * 256; const LAS float* biasl = (const LAS float*)(C.lds + DS_BIAS); (void)ISC; (void)sel; (void)biasl
#define RELANE() do { asm volatile("" : "+v"(lane)); asm volatile("" : "+s"(t0), "+s"(b)); } while (0)
__device__ __forceinline__ void dsa_step1(const Ctx& C, const Bufs& B, int b, int t0) {
    int lane = C.lane; RELANE(); DSA_LOCALS();
    {
        const int r32 = lane & 31, hh = lane >> 5;
        bf16x8 qa[2][4]; float wq[2][2][8];
        const int qi = 2 * ((r32 >> 2) & 1) + (r32 >> 4), hA = (r32 & 3) + 4 * ((r32 >> 3) & 1);
#pragma unroll
        for (int g = 0; g < 2; ++g) { const int row = rowof(b, t0 + 4 * g + qi);
#pragma unroll
            for (int s = 0; s < 4; ++s) qa[g][s] = *(const bf16x8*)(B.Q2 + (size_t)row * NQ2 + 4096 + hA * 64 + 16 * s + 8 * hh);
#pragma unroll
            for (int j = 0; j < 2; ++j) { const int rw = rowof(b, t0 + 4 * g + 2 * hh + j); const v4u ww = *(const v4u*)(B.PROJ + (size_t)rw * NP1 + PC_WIDX);
                const float sc = 0.35355339059327373f * 0.125f;
                wq[g][j][0] = pg8::bf_lo(ww.x) * sc; wq[g][j][1] = pg8::bf_hi(ww.x) * sc; wq[g][j][2] = pg8::bf_lo(ww.y) * sc; wq[g][j][3] = pg8::bf_hi(ww.y) * sc;
                wq[g][j][4] = pg8::bf_lo(ww.z) * sc; wq[g][j][5] = pg8::bf_hi(ww.z) * sc; wq[g][j][6] = pg8::bf_lo(ww.w) * sc; wq[g][j][7] = pg8::bf_hi(ww.w) * sc; } }
        const int nkeys = t0 + 8, nkt = (nkeys + 31) >> 5;
        for (int kt = w; kt < nkt; kt += 8) {
            const int key = kt * 32 + r32, kc = key < nkeys ? key : nkeys - 1, krow = rowof(b, kc);
            bf16x8 kb[4];
#pragma unroll
            for (int s = 0; s < 4; ++s) kb[s] = *(const bf16x8*)(B.PROJ + (size_t)krow * NP1 + PC_KIDX + 16 * s + 8 * hh);
#pragma unroll
            for (int g = 0; g < 2; ++g) { f32x16 acc = {};
#pragma unroll
                for (int s = 0; s < 4; ++s) acc = __builtin_amdgcn_mfma_f32_32x32x16_bf16(qa[g][s], kb[s], acc, 0, 0, 0);
#pragma unroll
                for (int j = 0; j < 2; ++j) { float isc = 0.f;
#pragma unroll
                    for (int h = 0; h < 8; ++h) isc += wq[g][j][h] * fmaxf(acc[8 * j + h], 0.f);
                    ISC[(4 * g + 2 * hh + j) * DS_ISC_WORDS + key] = f2key(isc); } }
        }
    }
}
__device__ __forceinline__ int dsa_step2(const Ctx& C, int b, int t0) {
    int lane = C.lane; RELANE(); DSA_LOCALS();
    const int t = t0 + w, n = t + 1;
    int cnt;
    if (n <= TOPK) { for (int j = lane; j < n; j += 64) sel[j] = (unsigned short)j; cnt = n; }
    else {
        const LAS unsigned* myrow = ISC + w * DS_ISC_WORDS;
        const int nI = (n + 255) >> 8;
        unsigned v[68];
#pragma unroll
        for (int i = 0; i < 17; ++i) { pg8::u32x4 x = {0u, 0u, 0u, 0u}; if (i < nI) x = *(const LAS pg8::u32x4*)(myrow + 256 * i + 4 * lane);
#pragma unroll
            for (int e = 0; e < 4; ++e) v[4 * i + e] = (256 * i + 4 * lane + e <= t) ? x[e] : 0u; }
        unsigned T = 0u; bool exact = false;
#define DSA_COUNT(res, pred_expr) do { int c_ = 0; \
        _Pragma("unroll") for (int i = 0; i < 17; ++i) { if (i < nI) { _Pragma("unroll") for (int e = 0; e < 4; ++e) { const unsigned x_ = v[4 * i + e]; c_ += (pred_expr) ? 1 : 0; } } } \
        int tot_ = 0; _Pragma("unroll") for (int bt = 0; bt < 7; ++bt) tot_ += __popcll(__ballot((c_ >> bt) & 1)) << bt; res = tot_; } while (0)
#pragma unroll 1
        for (int bit = 31; bit >= 0; --bit) {
            const unsigned cand = T | (1u << bit); int c;
            DSA_COUNT(c, x_ >= cand);
            if (c >= TOPK) { T = cand; if (c == TOPK) { exact = true; break; } }
        }
        if (!exact) { int c; DSA_COUNT(c, x_ >= T); exact = (c == TOPK); }
#undef DSA_COUNT
        int base = 0;
#pragma unroll
        for (int k = 0; k < 68; ++k) { const bool p = exact ? (v[k] >= T) : (v[k] > T); const unsigned long long m = __ballot(p);
            const int pos = base + (int)__builtin_amdgcn_mbcnt_hi((unsigned)(m >> 32), __builtin_amdgcn_mbcnt_lo((unsigned)m, 0u));
            if (p) sel[pos] = (unsigned short)(256 * (k >> 2) + 4 * lane + (k & 3));
            base += __popcll(m); }
        if (!exact) {
            int last = -1;
            while (base < TOPK) { int mi = 0x7fffffff;
#pragma unroll
                for (int k = 0; k < 68; ++k) { const int idx = 256 * (k >> 2) + 4 * lane + (k & 3); if (v[k] == T && idx > last && idx < mi) mi = idx; }
#pragma unroll
                for (int o = 1; o < 64; o <<= 1) { const int oth = __shfl_xor(mi, o); mi = oth < mi ? oth : mi; }
                if (lane == 0) sel[base] = (unsigned short)mi;
                last = mi; ++base; }
        }
        cnt = TOPK;
    }
    return cnt;
}
__device__ __forceinline__ void dsa_step3(const Ctx& C, const Bufs& B, int b, int t0, int cnt, int qslot) {
    int lane = C.lane; RELANE(); DSA_LOCALS(); const int t = t0 + w;
    {
        const int g = lane >> 4, c16 = lane & 15, rowq = rowof(b, t);
        bf16x8 qf[8];
#pragma unroll
        for (int s = 0; s < 8; ++s) qf[s] = *(const bf16x8*)(B.Q2 + (size_t)rowq * NQ2 + c16 * 256 + 32 * s + 8 * g);
        f32x4 O[16];
#pragma unroll
        for (int rt = 0; rt < 16; ++rt) O[rt] = (f32x4){0.f, 0.f, 0.f, 0.f};
        float m_ref = 0.f, lsum = 0.f;
        const int buf0 = DS_ISC + w * DS_ISC_STRIDE;
        const int nch = (cnt + 15) >> 4;
        const int swz = (c16 & 7) << 1;
        const int trow = 4 * g + (c16 >> 2), tswz = (trow & 7) << 1, tp = c16 & 3;
        const int arow = (c16 & 7) * 1024 + (c16 >> 3) * 512, trowo = (trow & 7) * 1024 + (trow >> 3) * 512;
        const unsigned ldsb = (unsigned)(uintptr_t)(C.lds + buf0);
#define DSA_GATHER(c_) do { const unsigned bo_ = (unsigned)__builtin_amdgcn_readfirstlane(ldsb + ((c_) & 1) * 8192); \
        const pg8::u32x4 sp_ = *(const LAS pg8::u32x4*)(sel + 16 * (c_) + 8 * (lane >> 5)); const unsigned spw_[4] = {sp_.x, sp_.y, sp_.z, sp_.w}; \
        _Pragma("unroll") for (int p = 0; p < 8; ++p) { const int j = 16 * (c_) + 8 * (lane >> 5) + p; int pos = (int)((spw_[p >> 1] >> (16 * (p & 1))) & 0xffffu); pos = j < cnt ? pos : 0; \
            const int logical = (lane & 31) ^ (p << 1); \
            glds16((const unsigned char*)B.CKVN + (size_t)rowof(b, pos) * 512 + logical * 16, bo_ + p * 1024); } } while (0)
        DSA_GATHER(0);
#pragma unroll 1
        for (int c = 0; c < nch; ++c) {
            const int bo = buf0 + (c & 1) * 8192;
            if (c + 1 < nch) { DSA_GATHER(c + 1); asm volatile("s_waitcnt vmcnt(8)" ::: "memory"); }
            else asm volatile("s_waitcnt vmcnt(0)" ::: "memory");
            bf16x8 af8[8]; s16x4 av[16];
#pragma unroll
            for (int s = 0; s < 8; ++s) af8[s] = *(const LAS bf16x8*)(C.lds + bo + arow + (((4 * s + g) ^ swz) << 4));
#pragma unroll
            for (int rt = 0; rt < 16; ++rt) av[rt] = tr_read(C.lds + bo + trowo + (((2 * rt + (tp >> 1)) ^ tswz) << 4) + 8 * (tp & 1));
            const u16x4 p0 = *(const LAS u16x4*)(sel + 16 * c + 4 * g);
            __builtin_amdgcn_sched_barrier(0);
            f32x4 s0 = {0.f, 0.f, 0.f, 0.f};
#pragma unroll
            for (int s = 0; s < 8; ++s) s0 = __builtin_amdgcn_mfma_f32_16x16x32_bf16(af8[s], qf[s], s0, 0, 0, 0);
            float x0[4]; float mloc = -INFINITY;
#pragma unroll
            for (int i = 0; i < 4; ++i) { const int j0 = 16 * c + 4 * g + i;
                x0[i] = (j0 < cnt) ? 0.125f * s0[i] + biasl[t5_bucket(t - (int)p0[i]) * 16 + c16] : -INFINITY;
                mloc = fmaxf(mloc, x0[i]); }
            mloc = fmaxf(mloc, __shfl_xor(mloc, 16)); mloc = fmaxf(mloc, __shfl_xor(mloc, 32));
            if (c == 0) m_ref = mloc;
            else if (__any(mloc > m_ref + 8.0f)) { const float mn = fmaxf(m_ref, mloc), al = __expf(m_ref - mn);
#pragma unroll
                for (int rt = 0; rt < 16; ++rt) O[rt] *= al;
                lsum *= al; m_ref = mn; }
            float pe0[4];
#pragma unroll
            for (int i = 0; i < 4; ++i) { pe0[i] = __expf(x0[i] - m_ref); lsum += pe0[i]; }
            pg8::u32x2 pw; pw.x = cvtpk(pe0[0], pe0[1]); pw.y = cvtpk(pe0[2], pe0[3]);
            const s16x4 pf = __builtin_bit_cast(s16x4, pw);
#pragma unroll
            for (int rt = 0; rt < 16; ++rt) O[rt] = __builtin_amdgcn_mfma_f32_16x16x16bf16_1k(av[rt], pf, O[rt], 0, 0, 0);
            LDS_WAIT(); asm volatile("" ::: "memory");
        }
#undef DSA_GATHER
        lsum += __shfl_xor(lsum, 16); lsum += __shfl_xor(lsum, 32);
        const float inv = 1.0f / lsum;
#pragma unroll
        for (int rt = 0; rt < 16; ++rt) { const f32x4 o = O[rt] * inv; pg8::u32x2 wv; wv.x = cvtpk(o[0], o[1]); wv.y = cvtpk(o[2], o[3]);
            const int s_ = rt >> 1, gp = 2 * (rt & 1) + (g >> 1), jo = 4 * (g & 1);
            *(pg8::u32x2*)(B.OLAT + (size_t)C.bid * OL_BLOCK + ((((size_t)(qslot >> 4) * 16 + c16) * 8 + s_) * 64 + gp * 16 + (qslot & 15)) * 8 + jo) = wv; }
    }
}
__device__ __forceinline__ void dsa_wuv(const Ctx& C, const Bufs& B, int l, int nq) {
    const int lane = C.lane, w = C.wave, g = lane >> 4, c16 = lane & 15;
    const LAS int* qrow = (const LAS int*)(C.lds + DS_QROW);
    const int nmt = (nq + 15) >> 4;
#pragma unroll 1
    for (int hq = 0; hq < 2; ++hq) { const int h = 2 * w + hq;
        f32x4 Dv[3][4];
#pragma unroll
        for (int mt = 0; mt < 3; ++mt)
#pragma unroll
            for (int nt = 0; nt < 4; ++nt) Dv[mt][nt] = (f32x4){0.f, 0.f, 0.f, 0.f};
        const bf16* wb = B.WUV + (((size_t)l * 16 + h) * 32) * 512 + lane * 8;
        const bf16* ab = B.OLAT + (size_t)C.bid * OL_BLOCK + ((size_t)h * 8) * 512 + lane * 8;
#pragma unroll
        for (int s = 0; s < 8; ++s) { bf16x8 bw[4];
#pragma unroll
            for (int nt = 0; nt < 4; ++nt) bw[nt] = *(const bf16x8*)(wb + (s * 4 + nt) * 512);
#pragma unroll
            for (int mt = 0; mt < 3; ++mt) { if (mt < nmt) { const v4u av = __builtin_nontemporal_load((const v4u*)(ab + ((size_t)mt * 16 * 8 + s) * 512)); const bf16x8 a = __builtin_bit_cast(bf16x8, av);
#pragma unroll
                for (int nt = 0; nt < 4; ++nt) Dv[mt][nt] = __builtin_amdgcn_mfma_f32_16x16x32_bf16(a, bw[nt], Dv[mt][nt], 0, 0, 0); } } }
        LAS float* stg = (LAS float*)(C.lds + RING_OFF + w * 4608);
#pragma unroll
        for (int mt = 0; mt < 3; ++mt) { if (mt < nmt) {
#pragma unroll
            for (int nt = 0; nt < 4; ++nt)
#pragma unroll
                for (int i = 0; i < 4; ++i) stg[(4 * g + i) * 68 + 16 * nt + c16] = Dv[mt][nt][i];
            LDS_WAIT(); asm volatile("" ::: "memory");
            const int slot = lane >> 2, q = mt * 16 + slot, d0 = (lane & 3) * 16;
            if (q < nq) { const int row = qrow[q];
                const bf16* zp = B.PROJ + (size_t)row * NP1 + PC_ZB + h * 64 + d0; bf16* op = B.YB + (size_t)row * YLD + h * 64 + d0;
#pragma unroll
                for (int hf = 0; hf < 2; ++hf) { const v4u zw = *(const v4u*)(zp + 8 * hf);
                    const f32x4 xa = *(const LAS f32x4*)(stg + slot * 68 + d0 + 8 * hf), xb = *(const LAS f32x4*)(stg + slot * 68 + d0 + 8 * hf + 4);
                    v4u o; o.x = pk2(xa[0] * siluf_(pg8::bf_lo(zw.x)), xa[1] * siluf_(pg8::bf_hi(zw.x))); o.y = pk2(xa[2] * siluf_(pg8::bf_lo(zw.y)), xa[3] * siluf_(pg8::bf_hi(zw.y)));
                    o.z = pk2(xb[0] * siluf_(pg8::bf_lo(zw.z)), xb[1] * siluf_(pg8::bf_hi(zw.z))); o.w = pk2(xb[2] * siluf_(pg8::bf_lo(zw.w)), xb[3] * siluf_(pg8::bf_hi(zw.w)));
                    *(v4u*)(op + 8 * hf) = o; } }
            LDS_WAIT(); asm volatile("" ::: "memory"); } }
    }
}
#ifndef MK_DSUB
#define MK_DSUB 0
#endif
__device__ __forceinline__ void dsa_unit(const Ctx& C, const Bufs& B, int l, int b, int t0, int uidx) {
    { PROBE_T0(); for (int rep = 0; rep < ((MK_DSUB & 1) ? 2 : 1); ++rep) { dsa_step1(C, B, b, t0); LDS_WAIT(); PROBE_T1(10); __syncthreads(); } PROBE_T1(0); }
    int cnt = 0;
    { PROBE_T0(); for (int rep = 0; rep < ((MK_DSUB & 2) ? 2 : 1); ++rep) { cnt = dsa_step2(C, b, t0); LDS_WAIT(); asm volatile("" ::: "memory"); } PROBE_T1(1); }
    if (C.lane == 0) ((LAS int*)(C.lds + DS_QROW))[uidx * 8 + C.wave] = rowof(b, t0 + C.wave);
    { PROBE_T0(); for (int rep = 0; rep < ((MK_DSUB & 4) ? 2 : 1); ++rep) { dsa_step3(C, B, b, t0, cnt, uidx * 8 + C.wave); } PROBE_T1(2); }
    { PROBE_T0(); LDS_WAIT(); __syncthreads(); PROBE_T1(7); }
}
#undef RELANE
#undef DSA_LOCALS

__device__ __forceinline__ void dsa_phase(const Ctx& C, int l) {
    const Bufs B(C.a.ws);
    const Args& A = C.a;
    if (C.tid < 512) { const int bk = C.tid >> 4, h = C.tid & 15; ((LAS float*)(C.lds + DS_BIAS))[C.tid] = A.bias_table[bk * 32 + 16 + h]; }
    __syncthreads();
    int nu = 0;
    for (int it = 0;; ++it) {
        int b, j;
        if (C.G == 256) { const int k = C.bid >> 1; b = C.bid & 1;
            if (it < 4) j = 513 - (128 * it + ((it & 1) ? 127 - k : k)); else if (it == 4 && k < 2) j = 1 - k; else break; }
        else { const int s = C.bid + it * C.G; if (s >= 1028) break; b = s & 1; j = 513 - (s >> 1); }
        dsa_unit(C, B, l, b, 8 * j, it); nu = it + 1;
    }
    VM_WAIT(); LDS_WAIT(); __syncthreads();
    { PROBE_T0(); dsa_wuv(C, B, l, nu * 8); PROBE_T1(3); }
    __syncthreads();
}

constexpr int VT_PITCH = 4128;
constexpr int SW_BIAS = RING_OFF;
constexpr int SW_WS = SW_BIAS + 8192;
constexpr int SW_STG = SW_WS + 1024;

__device__ __forceinline__ void swa_item(const Ctx& C, const Bufs& B, const float* __restrict__ sinks, int b, int head, int p0, bool meta) {
    const int lane = C.lane, r32 = lane & 31, hh = lane >> 5, g = head >> 3;
    const LAS float* biasl = (const LAS float*)(C.lds + SW_BIAS);
    LAS float* wsf = (LAS float*)(C.lds + SW_WS) + C.wave * 32;
    const int tq = p0 + r32;
    const int tqc = meta ? (tq < NMETA ? tq : NMETA - 1) : tq;
    const int rowq = rowof(b, tqc);
    bf16x8 qf[4];
#pragma unroll
    for (int s = 0; s < 4; ++s) qf[s] = *(const bf16x8*)(B.PROJ + (size_t)rowq * NP1 + PC_QA + head * 64 + 16 * s + 8 * hh);
    const int ntile = meta ? 1 : 6;
    f32x16 S[6];
#pragma unroll
    for (int kt = 0; kt < 6; ++kt) {
        if (kt < ntile) {
            const int k0 = (kt == 0) ? 0 : p0 - 128 + 32 * (kt - 1);
            int kpos = k0 + r32; kpos = kpos < 0 ? 0 : kpos;
            const int krow = rowof(b, kpos);
            f32x16 acc = {};
#pragma unroll
            for (int s = 0; s < 4; ++s) { const bf16x8 kf = *(const bf16x8*)(B.PROJ + (size_t)krow * NP1 + PC_KA + g * 64 + 16 * s + 8 * hh);
                acc = __builtin_amdgcn_mfma_f32_32x32x16_bf16(kf, qf[s], acc, 0, 0, 0); }
#pragma unroll
            for (int i = 0; i < 16; ++i) { const int kp = k0 + (i & 3) + 8 * (i >> 2) + 4 * hh; const int d = tq - kp;
                bool ok;
                if (kt == 0) ok = kp < NMETA && d >= 0; else ok = kp >= NMETA && d >= 0 && d < 128;
                const int dc = d < 0 ? 0 : (d > 127 ? 127 : d);
                acc[i] = ok ? 0.125f * acc[i] + biasl[dc * 16 + head] : -INFINITY; }
            S[kt] = acc;
        } else S[kt] = (f32x16){-INFINITY, -INFINITY, -INFINITY, -INFINITY, -INFINITY, -INFINITY, -INFINITY, -INFINITY, -INFINITY, -INFINITY, -INFINITY, -INFINITY, -INFINITY, -INFINITY, -INFINITY, -INFINITY};
    }
    const float sink = sinks[head];
    float mx = sink;
#pragma unroll
    for (int kt = 0; kt < 6; ++kt)
#pragma unroll
        for (int i = 0; i < 16; ++i) mx = fmaxf(mx, S[kt][i]);
    mx = fmaxf(mx, __shfl_xor(mx, 32));
    float sum = 0.f;
#pragma unroll
    for (int kt = 0; kt < 6; ++kt)
#pragma unroll
        for (int i = 0; i < 16; ++i) { const float p = __expf(S[kt][i] - mx); S[kt][i] = p; sum += p; }
    sum += __shfl_xor(sum, 32);
    sum += __expf(sink - mx);
    if (hh == 0) wsf[r32] = sum;
    f32x16 O0 = {}, O1 = {};
#pragma unroll
    for (int kt = 0; kt < 6; ++kt) {
        if (kt < ntile) {
            const int k0 = (kt == 0) ? 0 : p0 - 128 + 32 * (kt - 1);
#pragma unroll
            for (int s2 = 0; s2 < 2; ++s2) {
                pg8::u32x4 pw; pw.x = cvtpk(S[kt][8 * s2 + 0], S[kt][8 * s2 + 1]); pw.y = cvtpk(S[kt][8 * s2 + 2], S[kt][8 * s2 + 3]); pw.z = cvtpk(S[kt][8 * s2 + 4], S[kt][8 * s2 + 5]); pw.w = cvtpk(S[kt][8 * s2 + 6], S[kt][8 * s2 + 7]);
                const bf16x8 pf = __builtin_bit_cast(bf16x8, pw);
                int ka = k0 + 16 * s2 + 4 * hh, kb2 = ka + 8; ka = ka < 0 ? 0 : ka; kb2 = kb2 < 0 ? 0 : kb2;
#pragma unroll
                for (int dt = 0; dt < 2; ++dt) { const bf16* vrow = B.VT + ((size_t)b * 128 + g * 64 + 32 * dt + r32) * VT_PITCH;
                    const pg8::u32x2 lo = *(const pg8::u32x2*)(vrow + ka), hi2 = *(const pg8::u32x2*)(vrow + kb2);
                    const pg8::u32x4 vw = {lo.x, lo.y, hi2.x, hi2.y}; const bf16x8 vf = __builtin_bit_cast(bf16x8, vw);
                    if (dt == 0) O0 = __builtin_amdgcn_mfma_f32_32x32x16_bf16(pf, vf, O0, 0, 0, 0); else O1 = __builtin_amdgcn_mfma_f32_32x32x16_bf16(pf, vf, O1, 0, 0, 0); }
            }
        }
    }
    LDS_WAIT(); asm volatile("" ::: "memory");
    LAS float* stg = (LAS float*)(C.lds + SW_STG) + C.wave * (32 * 68);
#pragma unroll
    for (int i = 0; i < 16; ++i) { const int q = (i & 3) + 8 * (i >> 2) + 4 * hh; stg[q * 68 + r32] = O0[i]; stg[q * 68 + 32 + r32] = O1[i]; }
    LDS_WAIT(); asm volatile("" ::: "memory");
    { const int q = lane >> 1, d0 = (lane & 1) * 32, t = p0 + q;
      if (!meta || t < NMETA) { const int row = rowof(b, t); const float inv = 1.0f / wsf[q];
          const bf16* zp = B.PROJ + (size_t)row * NP1 + PC_ZA + head * 64 + d0; bf16* op = B.YA + (size_t)row * YLD + head * 64 + d0;
#pragma unroll
          for (int hf = 0; hf < 4; ++hf) { const v4u zw = *(const v4u*)(zp + 8 * hf);
              const f32x4 xa = *(const LAS f32x4*)(stg + q * 68 + d0 + 8 * hf) * inv, xb = *(const LAS f32x4*)(stg + q * 68 + d0 + 8 * hf + 4) * inv;
              v4u o; o.x = pk2(xa[0] * siluf_(pg8::bf_lo(zw.x)), xa[1] * siluf_(pg8::bf_hi(zw.x))); o.y = pk2(xa[2] * siluf_(pg8::bf_lo(zw.y)), xa[3] * siluf_(pg8::bf_hi(zw.y)));
              o.z = pk2(xb[0] * siluf_(pg8::bf_lo(zw.z)), xb[1] * siluf_(pg8::bf_hi(zw.z))); o.w = pk2(xb[2] * siluf_(pg8::bf_lo(zw.w)), xb[3] * siluf_(pg8::bf_hi(zw.w)));
              *(v4u*)(op + 8 * hf) = o; } } }
    LDS_WAIT(); asm volatile("" ::: "memory");
}

__device__ __forceinline__ void swa_phase(const Ctx& C, int l) {
    const Bufs B(C.a.ws);
    const Args& A = C.a;
    __syncthreads();
    for (int i = C.tid; i < 128 * 16; i += NWAVES * 64) { const int d = i >> 4, h = i & 15; ((LAS float*)(C.lds + SW_BIAS))[i] = A.bias_table[t5_bucket(d) * 32 + h]; }
    __syncthreads();
    const float* sinks = A.sinks + l * 16;
    for (int it = C.gw; it < 4096 + 32; it += C.NGW) {
        if (it < 4096) { const int blk = it & 127, head = (it >> 7) & 15, b = it >> 11; swa_item(C, B, sinks, b, head, NMETA + 32 * blk, false); }
        else { const int r = it - 4096, head = r & 15, b = r >> 4; swa_item(C, B, sinks, b, head, 0, true); }
    }
    __syncthreads();
}


constexpr int PH_PER_LAYER = 6, N_PHASES = 1 + NLAYER * PH_PER_LAYER + 1;
#ifndef MK_DUP
#define MK_DUP 0
#endif
#ifndef MK_NAIVE_SWA
#define MK_NAIVE_SWA 0
#endif
#ifndef MK_NAIVE_DSA
#define MK_NAIVE_DSA 0
#endif
#ifndef MK_ONE_LAUNCH
#define MK_ONE_LAUNCH 1
#endif

__global__ void __launch_bounds__(NWAVES * 64, 2) fwd_kernel(Args args) {
    extern __shared__ __attribute__((aligned(16))) unsigned char lds[];
    Ctx C;
    C.lds = (LAS unsigned char*)lds; C.tid = threadIdx.x; C.lane = C.tid & 63; C.wave = __builtin_amdgcn_readfirstlane(C.tid >> 6);
    C.G = gridDim.x; C.bid = blockIdx.x; C.gw = blockIdx.x * NWAVES + C.wave; C.NGW = C.G * NWAVES; C.a = args;
    unsigned char* ws = args.ws;
    gu32* ctl = (gu32*)(ws + WS_CTL);
    for (int u = C.tid; u < RING_OFF / 4; u += NWAVES * 64) ((LAS unsigned*)(C.lds + LDSCTL_OFF))[u] = 0u;
    __syncthreads();
    volatile LAS unsigned* MISC = (volatile LAS unsigned*)(C.lds + MISC_OFF);
    XcdBarrier bar; bar.bar = (unsigned*)(ctl + CW_BAR); bar.x = 0; bar.st = nullptr;
    const int lo = args.ph_lo, hi = args.ph_hi;
    const bool one = (hi - lo) > 1;
    if (one) bar = xcd_barrier_post((unsigned*)(ctl + CW_BAR), MISC + 8);
#define IN(k) (lo <= (k) && (k) < hi)
#define PHASE_BEGIN() do { int l_ = (int)__builtin_amdgcn_mbcnt_hi(~0u, __builtin_amdgcn_mbcnt_lo(~0u, 0u)); asm volatile("" : "+v"(l_)); int b_ = blockIdx.x; asm volatile("" : "+s"(b_)); \
    C.lane = l_; C.tid = C.wave * 64 + l_; C.bid = b_; C.gw = b_ * NWAVES + C.wave; } while (0)
#define SEAM(k) do { if (IN((k) + 1)) { PROBE_T0(); xcd_barrier(bar, C.wave == 0 && (int)__builtin_amdgcn_mbcnt_hi(~0u, __builtin_amdgcn_mbcnt_lo(~0u, 0u)) == 0); PROBE_T1(29); } } while (0)
    LAS unsigned char* ring = C.lds + RING_OFF;

    if (IN(0)) { PROBE_T0(); PHASE_BEGIN(); p0_prologue(C); PROBE_T1(20); if (MK_DUP & 128) { PHASE_BEGIN(); p0_prologue(C); } SEAM(0); }
    for (int l = 0; l < NLAYER; ++l) {
        const int p = 1 + l * PH_PER_LAYER;
        if (IN(p)) {
            PHASE_BEGIN(); const Bufs B(ws);
            const bf16* W1l = B.W1 + (size_t)l * NP1 * DM;
            pg8::Gemm g{B.HB, W1l, MR, 8192, DM}; pg8::StaticOrder S; S.init(MR, 8192, C.G, C.bid);
            g1_rstd_table(C, S);
            pg8::EpiProj E{B.PROJ, NP1, (const LAS float*)(C.lds + RSTD_OFF)};
            { PROBE_T0(); pg8::gemm_phase<pg8::EpiProj, pg8::StaticOrder, true, true>(ring, g, S, E, C.tid); PROBE_T1(21); }
            if (MK_DUP & 1) { PHASE_BEGIN(); pg8::gemm_phase<pg8::EpiProj, pg8::StaticOrder, true, true>(ring, g, S, E, C.tid); }
            PHASE_BEGIN();
            LAS float* tbl = (LAS float*)(C.lds + RSTD_OFF);
            PROBE_T0();
            for (int u = C.bid; u < 256 + 259; u += C.G) {
                if (u < 256) { const int row0 = 32 * u; skinny_rstd(C, B.RS + (size_t)row0 * 32, 32, tbl);
                    skinny_unit<3, 2, false>(C, B.HB + (size_t)row0 * DM, DM, W1l + (size_t)8192 * DM, DM, DM, nullptr, 0, 0, SkProj{B.PROJ + (size_t)row0 * NP1 + 8192, tbl}); }
                else { const int gc = u - 256; skinny_rstd(C, B.RS2, 64, tbl);
                    skinny_unit<1, 4, false>(C, B.HB + (size_t)MR * DM, DM, W1l + (size_t)gc * 32 * DM, DM, DM, nullptr, 0, 0, SkProj{B.PROJ + (size_t)MR * NP1 + gc * 32, tbl}); }
            }
            PROBE_T1(22);
            SEAM(p);
        }
        if (IN(p + 1)) { PROBE_T0(); PHASE_BEGIN(); norm_phase(C, l); PROBE_T1(23); if (MK_DUP & 2) { PHASE_BEGIN(); norm_phase(C, l); } SEAM(p + 1); }
        if (IN(p + 2)) {
            PHASE_BEGIN(); const Bufs B(ws);
            const bf16* W2l = B.W2 + (size_t)l * NQ2 * 512;
            pg8::Gemm g{B.CQN, W2l, MR, NQ2, 512}; pg8::StaticOrder S; S.init(MR, NQ2, C.G, C.bid);
            pg8::EpiBf16<0> E{B.Q2, NQ2, nullptr, 0, 0, 1.f};
            PROBE_T0();
            pg8::gemm_phase<pg8::EpiBf16<0>, pg8::StaticOrder, true, true>(ring, g, S, E, C.tid);
            if (MK_DUP & 4) { PHASE_BEGIN(); pg8::gemm_phase<pg8::EpiBf16<0>, pg8::StaticOrder, true, true>(ring, g, S, E, C.tid); }
            PHASE_BEGIN();
            for (int u = C.bid; u < 48; u += C.G) skinny_unit<3, 1, false>(C, B.CQN + (size_t)MR * 512, 512, W2l + (size_t)u * 96 * 512, 512, 512, nullptr, 0, 0, SkQ2{B.Q2 + (size_t)MR * NQ2 + u * 96});
            PROBE_T1(24);
            SEAM(p + 2);
        }
        if (IN(p + 3)) {
#if MK_NAIVE_SWA
            PHASE_BEGIN(); swa_naive(C, l);
#else
            { PROBE_T0(); PHASE_BEGIN(); swa_phase(C, l); PROBE_T1(5); }
            if (MK_DUP & 8) { PHASE_BEGIN(); swa_phase(C, l); }
#endif
#if MK_NAIVE_DSA
            PHASE_BEGIN(); dsa_naive(C, l);
            VM_WAIT(); __syncthreads();
            PHASE_BEGIN(); wuv_naive(C, l);
#else
            { PROBE_T0(); PHASE_BEGIN(); dsa_phase(C, l); PROBE_T1(4); }
            if (MK_DUP & 16) { PHASE_BEGIN(); dsa_phase(C, l); }
#endif
            SEAM(p + 3);
        }
        if (IN(p + 4)) {
            PHASE_BEGIN(); const Bufs B(ws);
            const bf16* WABl = B.WA + (size_t)l * DM * 2048;
            pg8::Gemm g{B.YA, WABl, MR, DM, 2048, nullptr, nullptr, 0}; pg8::StaticOrder S; S.init(MR, DM, C.G, C.bid);
            pg8::EpiG4m E{B.MG, B.PROJ + PC_GA, B.PROJ + PC_GB, NP1};
            PROBE_T0();
            pg8::gemm_phase<pg8::EpiG4m, pg8::StaticOrder, true, true>(ring, g, S, E, C.tid);
            PROBE_T1(35);
            PHASE_BEGIN();
            for (int u = C.bid; u < 64; u += C.G) {
                skinny_unit<1, 2, false>(C, B.YA + (size_t)MR * YLD, YLD, WABl + (size_t)u * 32 * 2048, 2048, 1024, nullptr, 0, 0, SkPA{B.PA + (size_t)MR * DM + u * 32, B.PROJ + (size_t)MR * NP1 + PC_GA + u * 32});
                skinny_unit<1, 2, false>(C, B.YB + (size_t)MR * YLD, YLD, WABl + 1024 + (size_t)u * 32 * 2048, 2048, 1024, nullptr, 0, 0, SkMerge{B.MG + (size_t)MR * DM + u * 32, B.PA + (size_t)MR * DM + u * 32, B.PROJ + (size_t)MR * NP1 + PC_GB + u * 32}); }
            PROBE_T1(25);
            SEAM(p + 4);
        }
        if (IN(p + 5)) {
            PHASE_BEGIN(); const Bufs B(ws);
            const bf16* WOl = B.WO + (size_t)l * DM * DM;
            pg8::Gemm g{B.MG, WOl, MR, DM, DM}; pg8::StaticOrder S; S.init(MR, DM, C.G, C.bid);
            pg8::EpiRes E{B.H, B.HB, B.RS};
            PROBE_T0();
            pg8::gemm_phase<pg8::EpiRes, pg8::StaticOrder, true, true>(ring, g, S, E, C.tid);
            PHASE_BEGIN();
            for (int u = C.bid; u < 64; u += C.G) skinny_unit<1, 4, true>(C, B.MG + (size_t)MR * DM, DM, WOl + (size_t)u * 32 * DM, DM, DM, B.RS2, 64, u, SkRes{B.H + (size_t)MR * DM + u * 32, B.HB + (size_t)MR * DM + u * 32});
            PROBE_T1(27);
            SEAM(p + 5);
        }
    }
    if (IN(N_PHASES - 1)) { PHASE_BEGIN(); final_phase(C); }
#undef IN
#undef SEAM
}

extern "C" void kernel_launch(void* const* d_in, const int* in_sizes, int n_in, void* d_out, int out_size, void* d_ws, size_t ws_size, hipStream_t stream) {
    static int grid = 0;
    if (grid == 0) {
        if (n_in != 16 || ws_size < WS_END) { fprintf(stderr, "kernel_launch: unexpected inputs (n_in %d, ws %zu, need %zu)\n", n_in, ws_size, (size_t)WS_END); grid = -1; return; }
        int dev = 0, cus = 0;
        if (hipGetDevice(&dev) != hipSuccess || hipDeviceGetAttribute(&cus, hipDeviceAttributeMultiprocessorCount, dev) != hipSuccess) { grid = -1; return; }
        if (hipFuncSetAttribute((const void*)fwd_kernel, hipFuncAttributeMaxDynamicSharedMemorySize, LDS_BYTES) != hipSuccess) { fprintf(stderr, "kernel_launch: hipFuncSetAttribute failed\n"); grid = -1; return; }
        int per_cu = 0;
        if (hipOccupancyMaxActiveBlocksPerMultiprocessor(&per_cu, (const void*)fwd_kernel, NWAVES * 64, LDS_BYTES) != hipSuccess || per_cu < 1) fprintf(stderr, "kernel_launch: occupancy query says %d\n", per_cu);
        (void)hipGetLastError();
        grid = cus;
    }
    if (grid < 0) return;
    if (hipMemsetAsync((char*)d_ws + WS_CTL, 0, CTL_ZERO_BYTES, stream) != hipSuccess) return;
    Args a{};
    a.x = (const float*)d_in[0]; a.meta = (const float*)d_in[1]; a.bias_table = (const float*)d_in[2]; a.norm_g = (const float*)d_in[3]; a.w_in = (const float*)d_in[4];
    a.q_norm_g = (const float*)d_in[5]; a.kv_norm_g = (const float*)d_in[6]; a.w_qb = (const float*)d_in[7]; a.w_iq = (const float*)d_in[8]; a.w_uk = (const float*)d_in[9];
    a.w_uv = (const float*)d_in[10]; a.sinks = (const float*)d_in[11]; a.w_proj_a = (const float*)d_in[12]; a.w_proj_b = (const float*)d_in[13]; a.w_out = (const float*)d_in[14];
    a.final_g = (const float*)d_in[15]; a.out = (float*)d_out; a.ws = (unsigned char*)d_ws;
#if MK_ONE_LAUNCH
    a.ph_lo = 0; a.ph_hi = N_PHASES;
    hipLaunchKernelGGL(fwd_kernel, dim3(grid), dim3(NWAVES * 64), LDS_BYTES, stream, a);
#else
    for (int p = 0; p < N_PHASES; ++p) { a.ph_lo = p; a.ph_hi = p + 1; hipLaunchKernelGGL(fwd_kernel, dim3(grid), dim3(NWAVES * 64), LDS_BYTES, stream, a); }
#endif
}
```

```cpp
#include <hip/hip_runtime.h>
#include <cstdio>
#include <cstdint>
namespace pg8 {
#define PG8_LAS __attribute__((address_space(3)))
typedef unsigned short bf16_t;
typedef short bf16x8 __attribute__((ext_vector_type(8)));
typedef float f32x4 __attribute__((ext_vector_type(4)));
typedef unsigned u32x4 __attribute__((ext_vector_type(4)));
constexpr int BM = 256, BK = 64, HALF = 128, HTB = HALF * BK * 2  , STAGE_BYTES = 8 * HTB, NXCD = 8, WGM = 8;

__host__ __device__ __forceinline__ int lds_byte(int r, int c) { const int st = (r >> 4) * 2 + (c >> 5), rr = r & 15, cc = c & 31, ob = rr * 64 + cc * 2; return st * 1024 + (ob ^ (((ob >> 9) & 1) << 5)); }
__host__ __device__ __forceinline__ void stage_rc(int b, int& R, int& C) { const int st = b / 1024, sb = b % 1024, swz = sb ^ (((sb >> 9) & 1) << 5); R = (st >> 1) * 16 + swz / 64; C = (st & 1) * 32 + (swz % 64) / 2; }
__host__ __device__ __forceinline__ int perm32(int rho) { const int n = rho >> 4, i = rho & 15; return 8 * (i >> 2) + 4 * n + (i & 3); }

struct Unit { int pm, pn, sel; };
struct Gemm { const bf16_t* A; const bf16_t* Bt; int M, N, K; const bf16_t* A2; const bf16_t* Bt2; int lda; };

struct StaticOrder {
    int nM, nN, nwg, G, c;
    __host__ __device__ void init(int M, int N, int G_, int c_) { nM = M / BM; nN = N / BM; nwg = nM * nN; G = G_; c = c_; }
    __host__ __device__ bool next(int i, Unit& u) const {
        const long L = (long)i * G + c; if (L >= nwg) return false;
        int wgid = (int)L; { const int q = nwg / NXCD, r = nwg % NXCD, xcd = wgid % NXCD, off = wgid / NXCD; wgid = (xcd < r ? xcd * (q + 1) : r * (q + 1) + (xcd - r) * q) + off; }
        const int nig = WGM * nN, gid = wgid / nig, fm = gid * WGM, gsz = (nM - fm) < WGM ? (nM - fm) : WGM;
        u.pm = fm + ((wgid % nig) % gsz); u.pn = (wgid % nig) / gsz; u.sel = 0; return true;
    }
    __device__ __forceinline__ void a_ready(const Unit&) const {}
    __device__ __forceinline__ void done(const Unit&) const {}
};

__device__ __forceinline__ unsigned cvt_pk_bf16(float lo, float hi) { unsigned r; asm volatile("v_cvt_pk_bf16_f32 %0, %1, %2" : "=v"(r) : "v"(lo), "v"(hi)); return r; }
typedef float f32x2 __attribute__((ext_vector_type(2)));
__device__ __forceinline__ f32x2 gelu_pk(f32x2 v) {
    const f32x2 av = __builtin_elementwise_abs(v), d = av * 0.2316418882f + 1.0f;
    f32x2 t; t.x = __builtin_amdgcn_rcpf(d.x); t.y = __builtin_amdgcn_rcpf(d.y);
    f32x2 q = t * 0.5307027145f + (-0.7265760135f); q = q * t + 0.7107068705f; q = q * t + (-0.142248368f); q = q * t + 0.127414796f; q = q * t;
    const f32x2 s = (v * v) * (-0.72134752044f);
    f32x2 e; e.x = __builtin_amdgcn_exp2f(s.x); e.y = __builtin_amdgcn_exp2f(s.y);
    const f32x2 m = v * (q * e), r = v - m;
    f32x2 o; o.x = v.x < 0.f ? m.x : r.x; o.y = v.y < 0.f ? m.y : r.y; return o;
}

template <int ACT  > struct EpiBf16 {
    static constexpr bool PERM = true, AFTER_DRAIN = false; static_assert(ACT == 0 || ACT == 1, "EpiBf16: ACT is 0 (none) or 1 (gelu_pk)");
    bf16_t* O; int ldc; const float* bias; int split_cols; size_t split_stride; float scale0;
    __device__ __forceinline__ void operator()(const f32x4 (&acc)[2][2][4][2], const Unit& u, int ui, int wr, int wc, int fr, int fq) const {
        const int row0 = u.pm * BM + wr * 64 + fr; int colt = u.pn * BM; bf16_t* base = O;
        float sc = 1.f; if (split_cols) { const int t = colt / split_cols; base += (size_t)t * split_stride; colt -= t * split_cols; if (t == 0) sc = scale0; }
        const int col0 = colt + wc * 32 + 8 * fq, bcol0 = u.pn * BM + wc * 32 + 8 * fq;
        f32x4 bv[2][2];
#pragma unroll
        for (int bj = 0; bj < 2; ++bj)
#pragma unroll
            for (int n = 0; n < 2; ++n) bv[bj][n] = bias ? *(const f32x4*)(bias + bcol0 + bj * HALF + 4 * n) : (f32x4){0.f, 0.f, 0.f, 0.f};
#pragma unroll
        for (int ai = 0; ai < 2; ++ai)
#pragma unroll
            for (int m = 0; m < 4; ++m) { bf16_t* rowp = base + (size_t)(row0 + ai * HALF + m * 16) * ldc + col0;
#pragma unroll
                for (int bj = 0; bj < 2; ++bj) { f32x4 v0 = acc[ai][bj][m][0] + bv[bj][0], v1 = acc[ai][bj][m][1] + bv[bj][1];
                    if (ACT == 1) { f32x2 a = gelu_pk((f32x2){v0[0], v0[1]}), b = gelu_pk((f32x2){v0[2], v0[3]}), c = gelu_pk((f32x2){v1[0], v1[1]}), d = gelu_pk((f32x2){v1[2], v1[3]});
                        v0 = (f32x4){a.x, a.y, b.x, b.y}; v1 = (f32x4){c.x, c.y, d.x, d.y}; }
                    v0 = v0 * sc; v1 = v1 * sc; u32x4 w; w.x = cvt_pk_bf16(v0[0], v0[1]); w.y = cvt_pk_bf16(v0[2], v0[3]); w.z = cvt_pk_bf16(v1[0], v1[1]); w.w = cvt_pk_bf16(v1[2], v1[3]);
                    *(u32x4*)(rowp + bj * HALF) = w; } }
    }
};

template <class T, class = void> struct pg8_has_midk { static constexpr bool value = false; };
template <class T> struct pg8_has_midk<T, decltype((void)T::MIDK)> { static constexpr bool value = T::MIDK; };
template <class Epi, class Sched, bool ALIGN_EPI = false, bool SP2 = false>
__device__ __forceinline__ void gemm_phase(PG8_LAS unsigned char* lds, const Gemm g, const Sched& S, const Epi& E, int tid_in) {
    int tid_ = tid_in; asm volatile("" : "+v"(tid_));
    const int tid = tid_, wid = __builtin_amdgcn_readfirstlane(tid >> 6), lane = tid & 63, wr = wid >> 2, wc = wid & 3, fr = lane & 15, fq = lane >> 4;
    const int K = g.K, nt = K / BK, lda = g.lda ? g.lda : K;
    unsigned voffA[2], voffB[2];
#pragma unroll
    for (int i = 0; i < 2; ++i) { int R, C; stage_rc(tid * 16 + i * 8192, R, C); const int Rb = Epi::PERM ? ((R & ~31) + perm32(R & 31)) : R;
        voffA[i] = (unsigned)(R * lda + C) * 2u; voffB[i] = (unsigned)(Rb * K + C) * 2u; }
    const size_t kstep = (size_t)(BK * 2);
    const size_t hstepA = (size_t)HALF * lda * 2, tstepA = 2 * hstepA;
    const size_t hstep = (size_t)HALF * K * 2;
    const size_t tstep = 2 * hstep;
    const unsigned ldsw = (unsigned)wid * 1024u;
    const int aoff = lds_byte(wr * 64 + fr, fq * 8), boff = lds_byte(wc * 32 + fr, fq * 8);
#define PG8_SA(b, h) (((b) * 2 + (h)) * HTB)
#define PG8_SB(b, h) ((4 + (b) * 2 + (h)) * HTB)
#define PG8_STAGE(bufoff, gbase, voff) do { _Pragma("unroll") for (int _i = 0; _i < 2; ++_i) \
        __builtin_amdgcn_global_load_lds((const unsigned*)((const char*)(gbase) + (voff)[_i]), (PG8_LAS unsigned*)(lds + (bufoff) + ldsw + _i * 8192), 16, 0, 0); } while (0)
#define PG8_LDA(dst, b, h) do { _Pragma("unroll") for (int m = 0; m < 4; ++m) _Pragma("unroll") for (int k = 0; k < 2; ++k) dst[m][k] = *(const PG8_LAS bf16x8*)(lds + PG8_SA(b, h) + aoff + m * 2048 + k * 1024); } while (0)
#define PG8_LDB(dst, b, h) do { _Pragma("unroll") for (int n = 0; n < 2; ++n) _Pragma("unroll") for (int k = 0; k < 2; ++k) dst[n][k] = *(const PG8_LAS bf16x8*)(lds + PG8_SB(b, h) + boff + n * 2048 + k * 1024); } while (0)
#define PG8_MMA(ai, bj, At, Bt) do { __builtin_amdgcn_s_setprio(1); _Pragma("unroll") for (int m = 0; m < 4; ++m) _Pragma("unroll") for (int n = 0; n < 2; ++n) _Pragma("unroll") for (int k = 0; k < 2; ++k) \
        acc[ai][bj][m][n] = __builtin_amdgcn_mfma_f32_16x16x32_bf16(Bt[n][k], At[m][k], acc[ai][bj][m][n], 0, 0, 0); __builtin_amdgcn_s_setprio(0); } while (0)
#define PG8_WAIT_V(n) asm volatile("s_waitcnt vmcnt(" #n ")" ::: "memory")
#define PG8_WAIT_L(n) asm volatile("s_waitcnt lgkmcnt(" #n ")" ::: "memory")
#define PG8_BAR __builtin_amdgcn_s_barrier()
#define PG8_SCHED __builtin_amdgcn_sched_barrier(0)
    Unit cur, nxt; int ui = 0;
    if (!S.next(0, cur)) return;
    f32x4 acc[2][2][4][2];
#pragma unroll
    for (int a = 0; a < 2; ++a)
#pragma unroll
        for (int b = 0; b < 2; ++b)
#pragma unroll
            for (int m = 0; m < 4; ++m)
#pragma unroll
                for (int n = 0; n < 2; ++n) acc[a][b][m][n] = (f32x4){0.f, 0.f, 0.f, 0.f};
    bf16x8 At[4][2], B0[2][2], B1[2][2];
    const char* cA = (const char*)(cur.sel ? g.A2 : g.A) + (size_t)cur.pm * tstepA; const char* cB = (const char*)(cur.sel ? g.Bt2 : g.Bt) + (size_t)cur.pn * tstep;
    S.a_ready(cur);
    if constexpr (SP2) {
        PG8_STAGE(PG8_SB(0, 0), cB, voffB); PG8_STAGE(PG8_SB(0, 1), cB + hstep, voffB); PG8_STAGE(PG8_SA(0, 0), cA, voffA); PG8_STAGE(PG8_SA(0, 1), cA + hstepA, voffA);
        if (wr == 1) PG8_BAR;
        PG8_WAIT_V(2); PG8_BAR;
        PG8_STAGE(PG8_SB(1, 0), cB + kstep, voffB); PG8_STAGE(PG8_SA(1, 0), cA + kstep, voffA); PG8_STAGE(PG8_SB(1, 1), cB + hstep + kstep, voffB);
        PG8_WAIT_V(6); PG8_BAR;
    } else {
        PG8_STAGE(PG8_SB(0, 0), cB, voffB); PG8_STAGE(PG8_SA(0, 0), cA, voffA); PG8_STAGE(PG8_SB(0, 1), cB + hstep, voffB); PG8_STAGE(PG8_SA(0, 1), cA + hstepA, voffA);
        if (wr == 1) PG8_BAR;
        PG8_WAIT_V(4); PG8_BAR;
        PG8_STAGE(PG8_SB(1, 0), cB + kstep, voffB); PG8_STAGE(PG8_SA(1, 0), cA + kstep, voffA); PG8_STAGE(PG8_SB(1, 1), cB + hstep + kstep, voffB);
        PG8_WAIT_V(6); PG8_BAR;
    }
    for (;;) {
        const bool has_next = S.next(ui + 1, nxt);
        const char* nA = has_next ? (const char*)(nxt.sel ? g.A2 : g.A) + (size_t)nxt.pm * tstepA : cA; const char* nB = has_next ? (const char*)(nxt.sel ? g.Bt2 : g.Bt) + (size_t)nxt.pn * tstep : cB;
        for (int t = 0; t < nt; t += 2) {
            if constexpr (pg8_has_midk<Epi>::value) { if (t == (nt >> 1)) E.midk(acc, cur, wr, wc, fr, fq); }
            const bool last = (t == nt - 2);
            const char* a1 = cA + (size_t)(t + 1) * kstep;
            const char* a2 = last ? nA : cA + (size_t)(t + 2) * kstep; const char* b2 = last ? nB : cB + (size_t)(t + 2) * kstep;
            const char* a3 = a2 + kstep; const char* b3 = b2 + kstep;
            if (last && has_next) S.a_ready(nxt);
            if constexpr (SP2) {
            PG8_LDB(B0, 0, 0); PG8_LDB(B1, 0, 1); PG8_SCHED; PG8_LDA(At, 0, 0); PG8_STAGE(PG8_SA(1, 1), a1 + hstepA, voffA);
            PG8_WAIT_V(8); PG8_WAIT_L(0); PG8_BAR; PG8_MMA(0, 0, At, B0); PG8_MMA(0, 1, At, B1); PG8_BAR; PG8_SCHED;
            PG8_LDA(At, 0, 1); PG8_STAGE(PG8_SB(0, 0), b2, voffB); PG8_STAGE(PG8_SB(0, 1), b2 + hstep, voffB); PG8_STAGE(PG8_SA(0, 0), a2, voffA);
            PG8_WAIT_V(8); PG8_WAIT_L(0); PG8_BAR; PG8_MMA(1, 0, At, B0); PG8_MMA(1, 1, At, B1); PG8_BAR; PG8_SCHED;
            PG8_LDB(B0, 1, 0); PG8_LDB(B1, 1, 1); PG8_SCHED; PG8_LDA(At, 1, 0); PG8_STAGE(PG8_SA(0, 1), a2 + hstepA, voffA);
            PG8_WAIT_V(8); PG8_WAIT_L(0); PG8_BAR; PG8_MMA(0, 0, At, B0); PG8_MMA(0, 1, At, B1); PG8_BAR; PG8_SCHED;
            PG8_LDA(At, 1, 1); PG8_STAGE(PG8_SB(1, 0), b3, voffB); PG8_STAGE(PG8_SB(1, 1), b3 + hstep, voffB); PG8_STAGE(PG8_SA(1, 0), a3, voffA);
            PG8_WAIT_V(8); PG8_WAIT_L(0); PG8_BAR; PG8_MMA(1, 0, At, B0); PG8_MMA(1, 1, At, B1); PG8_BAR; PG8_SCHED;
            } else {
            PG8_LDB(B0, 0, 0); PG8_SCHED; PG8_LDA(At, 0, 0); PG8_STAGE(PG8_SA(1, 1), a1 + hstepA, voffA);
            PG8_WAIT_L(8); PG8_BAR; PG8_WAIT_L(0); PG8_MMA(0, 0, At, B0); PG8_BAR; PG8_SCHED;
            PG8_LDB(B1, 0, 1); PG8_STAGE(PG8_SB(0, 0), b2, voffB);
            PG8_BAR; PG8_WAIT_L(0); PG8_MMA(0, 1, At, B1); PG8_BAR;
            PG8_LDA(At, 0, 1); PG8_STAGE(PG8_SA(0, 0), a2, voffA);
            PG8_BAR; PG8_WAIT_L(0); PG8_MMA(1, 0, At, B0); PG8_BAR; PG8_SCHED;
            PG8_STAGE(PG8_SB(0, 1), b2 + hstep, voffB);
            PG8_WAIT_V(6); PG8_BAR; PG8_MMA(1, 1, At, B1); PG8_BAR;
            PG8_LDB(B0, 1, 0); PG8_SCHED; PG8_LDA(At, 1, 0); PG8_STAGE(PG8_SA(0, 1), a2 + hstepA, voffA);
            PG8_WAIT_L(8); PG8_BAR; PG8_WAIT_L(0); PG8_MMA(0, 0, At, B0); PG8_BAR; PG8_SCHED;
            PG8_LDB(B1, 1, 1); PG8_STAGE(PG8_SB(1, 0), b3, voffB);
            PG8_BAR; PG8_WAIT_L(0); PG8_MMA(0, 1, At, B1); PG8_BAR;
            PG8_LDA(At, 1, 1); PG8_STAGE(PG8_SA(1, 0), a3, voffA);
            PG8_BAR; PG8_WAIT_L(0); PG8_MMA(1, 0, At, B0); PG8_BAR; PG8_SCHED;
            PG8_STAGE(PG8_SB(1, 1), b3 + hstep, voffB);
            PG8_WAIT_V(6); PG8_BAR; PG8_MMA(1, 1, At, B1); PG8_BAR;
            }
        }
        if constexpr (ALIGN_EPI) { if (wr == 0) PG8_BAR; }
        if constexpr (!Epi::AFTER_DRAIN) { E(acc, cur, ui, wr, wc, fr, fq); S.done(cur); }
        if (!has_next) break;
#pragma unroll
        for (int a = 0; a < 2; ++a)
#pragma unroll
            for (int b = 0; b < 2; ++b)
#pragma unroll
                for (int m = 0; m < 4; ++m)
#pragma unroll
                    for (int n = 0; n < 2; ++n) acc[a][b][m][n] = (f32x4){0.f, 0.f, 0.f, 0.f};
        cur = nxt; cA = nA; cB = nB; ++ui;
        if constexpr (ALIGN_EPI) { if (wr == 1) PG8_BAR; }
    }
    PG8_WAIT_V(0);
    if constexpr (!ALIGN_EPI) { if (wr == 0) PG8_BAR; }
    PG8_BAR;
    if constexpr (Epi::AFTER_DRAIN) { E.fused(acc, cur, wr, wc, fr, fq, lds, wid, lane); S.done(cur); }
#undef PG8_SA
#undef PG8_SB
#undef PG8_STAGE
#undef PG8_LDA
#undef PG8_LDB
#undef PG8_MMA
#undef PG8_WAIT_V
#undef PG8_WAIT_L
#undef PG8_BAR
#undef PG8_SCHED
}
}
namespace pg8 {
__device__ __forceinline__ float bf_lo(unsigned w) { return __uint_as_float(w << 16); }
__device__ __forceinline__ float bf_hi(unsigned w) { return __uint_as_float(w & 0xffff0000u); }
__device__ __forceinline__ float sigm(float x) { return 1.0f / (1.0f + __expf(-x)); }
typedef unsigned u32x2 __attribute__((ext_vector_type(2)));

struct EpiProj {
    static constexpr bool PERM = true, AFTER_DRAIN = false;
    bf16_t* O; int ldc; const PG8_LAS float* rstd; bf16_t* KV;
    __device__ __forceinline__ void operator()(const f32x4 (&acc)[2][2][4][2], const Unit& u, int ui, int wr, int wc, int fr, int fq) const {
        const int rt0 = wr * 64 + fr, col0 = u.pn * BM + wc * 32 + 8 * fq;
#pragma unroll
        for (int ai = 0; ai < 2; ++ai)
#pragma unroll
            for (int m = 0; m < 4; ++m) { const int rt = rt0 + ai * HALF + m * 16; const float s = rstd[ui * 256 + rt]; bf16_t* rowp = (u.pn == 4) ? KV + (size_t)(u.pm * BM + rt) * 256 + wc * 32 + 8 * fq : O + (size_t)(u.pm * BM + rt) * ldc + col0;
#pragma unroll
                for (int bj = 0; bj < 2; ++bj) { const f32x4 v0 = acc[ai][bj][m][0] * s, v1 = acc[ai][bj][m][1] * s;
                    u32x4 w; w.x = cvt_pk_bf16(v0[0], v0[1]); w.y = cvt_pk_bf16(v0[2], v0[3]); w.z = cvt_pk_bf16(v1[0], v1[1]); w.w = cvt_pk_bf16(v1[2], v1[3]);
                    *(u32x4*)(rowp + bj * HALF) = w; } }
    }
};
struct EpiPA {
    static constexpr bool PERM = false, AFTER_DRAIN = false;
    float* P; const bf16_t* G; int ldg;
    __device__ __forceinline__ void operator()(const f32x4 (&acc)[2][2][4][2], const Unit& u, int ui, int wr, int wc, int fr, int fq) const {
        const int col0 = u.pn * BM + wc * 32 + 4 * fq;
#pragma unroll
        for (int ai = 0; ai < 2; ++ai)
#pragma unroll
            for (int m = 0; m < 4; ++m) { const int row = u.pm * BM + ai * HALF + wr * 64 + m * 16 + fr;
#pragma unroll
                for (int bj = 0; bj < 2; ++bj)
#pragma unroll
                    for (int n = 0; n < 2; ++n) { const int c = col0 + bj * HALF + n * 16; const u32x2 g = *(const u32x2*)(G + (size_t)row * ldg + c);
                        f32x4 v = acc[ai][bj][m][n]; v[0] *= sigm(bf_lo(g.x)); v[1] *= sigm(bf_hi(g.x)); v[2] *= sigm(bf_lo(g.y)); v[3] *= sigm(bf_hi(g.y));
                        *(f32x4*)(P + (size_t)row * 2048 + c) = v; } }
    }
};
struct EpiMerge {
    static constexpr bool PERM = true, AFTER_DRAIN = false;
    bf16_t* O; const float* P; const bf16_t* G; int ldg;
    __device__ __forceinline__ void operator()(const f32x4 (&acc)[2][2][4][2], const Unit& u, int ui, int wr, int wc, int fr, int fq) const {
        const int col0 = u.pn * BM + wc * 32 + 8 * fq;
#pragma unroll
        for (int ai = 0; ai < 2; ++ai)
#pragma unroll
            for (int m = 0; m < 4; ++m) { const int row = u.pm * BM + ai * HALF + wr * 64 + m * 16 + fr;
#pragma unroll
                for (int bj = 0; bj < 2; ++bj) { const int c = col0 + bj * HALF; const u32x4 g = *(const u32x4*)(G + (size_t)row * ldg + c);
                    const f32x4 p0 = *(const f32x4*)(P + (size_t)row * 2048 + c), p1 = *(const f32x4*)(P + (size_t)row * 2048 + c + 4);
                    f32x4 v0 = acc[ai][bj][m][0], v1 = acc[ai][bj][m][1];
                    v0[0] = p0[0] + sigm(bf_lo(g.x)) * v0[0]; v0[1] = p0[1] + sigm(bf_hi(g.x)) * v0[1]; v0[2] = p0[2] + sigm(bf_lo(g.y)) * v0[2]; v0[3] = p0[3] + sigm(bf_hi(g.y)) * v0[3];
                    v1[0] = p1[0] + sigm(bf_lo(g.z)) * v1[0]; v1[1] = p1[1] + sigm(bf_hi(g.z)) * v1[1]; v1[2] = p1[2] + sigm(bf_lo(g.w)) * v1[2]; v1[3] = p1[3] + sigm(bf_hi(g.w)) * v1[3];
                    u32x4 w; w.x = cvt_pk_bf16(v0[0], v0[1]); w.y = cvt_pk_bf16(v0[2], v0[3]); w.z = cvt_pk_bf16(v1[0], v1[1]); w.w = cvt_pk_bf16(v1[2], v1[3]);
                    *(u32x4*)(O + (size_t)row * 2048 + c) = w; } }
    }
};
struct EpiG4 {
    static constexpr bool PERM = true, AFTER_DRAIN = false;
    bf16_t* O; float* P; const bf16_t* GA; const bf16_t* GB; int ldg;
    __device__ __forceinline__ void operator()(const f32x4 (&acc)[2][2][4][2], const Unit& u, int ui, int wr, int wc, int fr, int fq) const {
        const int col0 = u.pn * BM + wc * 32 + 8 * fq;
        const bf16_t* G = u.sel ? GB : GA;
#pragma unroll
        for (int ai = 0; ai < 2; ++ai)
#pragma unroll
            for (int m = 0; m < 4; ++m) { const int row = u.pm * BM + ai * HALF + wr * 64 + m * 16 + fr;
#pragma unroll
                for (int bj = 0; bj < 2; ++bj) { const int c = col0 + bj * HALF; const u32x4 g = *(const u32x4*)(G + (size_t)row * ldg + c);
                    f32x4 v0 = acc[ai][bj][m][0], v1 = acc[ai][bj][m][1];
                    v0[0] *= sigm(bf_lo(g.x)); v0[1] *= sigm(bf_hi(g.x)); v0[2] *= sigm(bf_lo(g.y)); v0[3] *= sigm(bf_hi(g.y));
                    v1[0] *= sigm(bf_lo(g.z)); v1[1] *= sigm(bf_hi(g.z)); v1[2] *= sigm(bf_lo(g.w)); v1[3] *= sigm(bf_hi(g.w));
                    float* pp = P + (size_t)row * 2048 + c;
                    if (u.sel == 0) { *(f32x4*)pp = v0; *(f32x4*)(pp + 4) = v1; }
                    else { v0 += *(const f32x4*)pp; v1 += *(const f32x4*)(pp + 4);
                        u32x4 w; w.x = cvt_pk_bf16(v0[0], v0[1]); w.y = cvt_pk_bf16(v0[2], v0[3]); w.z = cvt_pk_bf16(v1[0], v1[1]); w.w = cvt_pk_bf16(v1[2], v1[3]);
                        *(u32x4*)(O + (size_t)row * 2048 + c) = w; } } }
    }
};
struct EpiG4m {
    static constexpr bool PERM = true, AFTER_DRAIN = false, MIDK = true;
    bf16_t* O; const bf16_t* GA; const bf16_t* GB; int ldg;
    __device__ __forceinline__ void midk(f32x4 (&acc)[2][2][4][2], const Unit& u, int wr, int wc, int fr, int fq) const {
        asm volatile("" : "+v"(fr), "+v"(fq));
        const int col0 = u.pn * BM + wc * 32 + 8 * fq;
#pragma unroll
        for (int ai = 0; ai < 2; ++ai)
#pragma unroll
            for (int m = 0; m < 4; ++m) { const size_t ro = (size_t)(u.pm * BM + ai * HALF + wr * 64 + m * 16 + fr) * ldg;
#pragma unroll
                for (int bj = 0; bj < 2; ++bj) { const int c = col0 + bj * HALF; const u32x4 a = *(const u32x4*)(GA + ro + c), b = *(const u32x4*)(GB + ro + c);
#define PG8_RHO(x, y) ((1.0f + __expf(-(y))) / (1.0f + __expf(-(x))))
                    f32x4& v0 = acc[ai][bj][m][0]; f32x4& v1 = acc[ai][bj][m][1];
                    v0[0] *= PG8_RHO(bf_lo(a.x), bf_lo(b.x)); v0[1] *= PG8_RHO(bf_hi(a.x), bf_hi(b.x)); v0[2] *= PG8_RHO(bf_lo(a.y), bf_lo(b.y)); v0[3] *= PG8_RHO(bf_hi(a.y), bf_hi(b.y));
                    v1[0] *= PG8_RHO(bf_lo(a.z), bf_lo(b.z)); v1[1] *= PG8_RHO(bf_hi(a.z), bf_hi(b.z)); v1[2] *= PG8_RHO(bf_lo(a.w), bf_lo(b.w)); v1[3] *= PG8_RHO(bf_hi(a.w), bf_hi(b.w));
#undef PG8_RHO
                }
                asm volatile("" ::: "memory"); }
    }
    __device__ __forceinline__ void operator()(const f32x4 (&acc)[2][2][4][2], const Unit& u, int ui, int wr, int wc, int fr, int fq) const {
        const int col0 = u.pn * BM + wc * 32 + 8 * fq;
#pragma unroll
        for (int ai = 0; ai < 2; ++ai)
#pragma unroll
            for (int m = 0; m < 4; ++m) { const int row = u.pm * BM + ai * HALF + wr * 64 + m * 16 + fr;
#pragma unroll
                for (int bj = 0; bj < 2; ++bj) { const int c = col0 + bj * HALF; const u32x4 g = *(const u32x4*)(GB + (size_t)row * ldg + c);
                    f32x4 v0 = acc[ai][bj][m][0], v1 = acc[ai][bj][m][1];
                    v0[0] *= sigm(bf_lo(g.x)); v0[1] *= sigm(bf_hi(g.x)); v0[2] *= sigm(bf_lo(g.y)); v0[3] *= sigm(bf_hi(g.y));
                    v1[0] *= sigm(bf_lo(g.z)); v1[1] *= sigm(bf_hi(g.z)); v1[2] *= sigm(bf_lo(g.w)); v1[3] *= sigm(bf_hi(g.w));
                    u32x4 w; w.x = cvt_pk_bf16(v0[0], v0[1]); w.y = cvt_pk_bf16(v0[2], v0[3]); w.z = cvt_pk_bf16(v1[0], v1[1]); w.w = cvt_pk_bf16(v1[2], v1[3]);
                    *(u32x4*)(O + (size_t)row * 2048 + c) = w; } }
    }
};
struct DualOrder : StaticOrder {
    __host__ __device__ bool next(int i, Unit& u) const { if (!StaticOrder::next(i >> 1, u)) return false; u.sel = i & 1; return true; }
};
struct EpiRes {
    static constexpr bool PERM = false, AFTER_DRAIN = false;
    float* H; bf16_t* HB; float* RS;
    __device__ __forceinline__ void operator()(const f32x4 (&acc)[2][2][4][2], const Unit& u, int ui, int wr, int wc, int fr, int fq) const {
        const int col0 = u.pn * BM + wc * 32 + 4 * fq;
#pragma unroll
        for (int ai = 0; ai < 2; ++ai)
#pragma unroll
            for (int m = 0; m < 4; ++m) { const int row = u.pm * BM + ai * HALF + wr * 64 + m * 16 + fr; float ss = 0.f;
#pragma unroll
                for (int bj = 0; bj < 2; ++bj)
#pragma unroll
                    for (int n = 0; n < 2; ++n) { const size_t off = (size_t)row * 2048 + col0 + bj * HALF + n * 16;
                        f32x4 hv = *(const f32x4*)(H + off); hv += acc[ai][bj][m][n]; *(f32x4*)(H + off) = hv;
                        u32x2 w; w.x = cvt_pk_bf16(hv[0], hv[1]); w.y = cvt_pk_bf16(hv[2], hv[3]); *(u32x2*)(HB + off) = w;
                        ss += (hv[0] * hv[0] + hv[1] * hv[1]) + (hv[2] * hv[2] + hv[3] * hv[3]); }
                ss += __shfl_xor(ss, 16); ss += __shfl_xor(ss, 32);
                if (fq == 0) RS[(size_t)row * 32 + u.pn * 4 + wc] = ss; }
    }
};
}

#define GAS __attribute__((address_space(1)))
#define LAS __attribute__((address_space(3)))
typedef unsigned short bf16;
typedef unsigned v4u __attribute__((ext_vector_type(4)));
typedef float f32x4 __attribute__((ext_vector_type(4)));
typedef short bf16x8 __attribute__((ext_vector_type(8)));
typedef GAS unsigned gu32;
typedef GAS unsigned long long gu64;
#define RLX_AGENT __ATOMIC_RELAXED, __HIP_MEMORY_SCOPE_AGENT
#define LDS_WAIT() asm volatile("s_waitcnt lgkmcnt(0)" ::: "memory")
#define VM_WAIT() asm volatile("s_waitcnt vmcnt(0)" ::: "memory")
__device__ __forceinline__ unsigned long long rt() { return __builtin_amdgcn_s_memrealtime(); }
__device__ __forceinline__ unsigned f2bf(float f) { unsigned u = __builtin_bit_cast(unsigned, f); return (u + 0x7fffu + ((u >> 16) & 1u)) >> 16; }
__device__ __forceinline__ unsigned pk2(float lo, float hi) { return f2bf(lo) | (f2bf(hi) << 16); }

#define XB_TMO      128
#define XB_XCNT(j)  (256  + 64 * (j))
#define XB_XSUB(j)  (1280 + 64 * (j))
#define XB_XGEN(j)  (2304 + 64 * (j))
#define XB_TOP      3328
#define XB_TOPGEN   3392
#define XCD_BAR_WORDS 3456
#define XB_SPIN_CAP (1u << 18)

__device__ __forceinline__ unsigned xb_ld(unsigned* p)              { return __hip_atomic_load(p, __ATOMIC_RELAXED, __HIP_MEMORY_SCOPE_AGENT); }
__device__ __forceinline__ unsigned xb_add(unsigned* p, unsigned v) { return __hip_atomic_fetch_add(p, v, __ATOMIC_RELAXED, __HIP_MEMORY_SCOPE_AGENT); }
__device__ __forceinline__ unsigned xb_xcc_id() { return (unsigned)__builtin_amdgcn_s_getreg((3 << 11) | 20) & 0xFu; }
#define XB_SPIN(cond, bar) do { unsigned _sp = 0; while (cond) { __builtin_amdgcn_s_sleep(1); \
    if ((++_sp & 255u) == 0u) { if (xb_ld(&(bar)[XB_TMO])) break; if (_sp > XB_SPIN_CAP) { atomicAdd(&(bar)[XB_TMO], 1u); break; } } } } while (0)

struct XcdBarrier {
    unsigned* bar; unsigned x;
    volatile LAS unsigned* st;
};

__device__ __forceinline__ XcdBarrier xcd_barrier_post(unsigned* bar, volatile LAS unsigned* st) {
    XcdBarrier b; b.bar = bar; b.x = xb_xcc_id(); b.st = st;
    if (threadIdx.x == 0) (void)xb_add(&bar[XB_XCNT(b.x)], 1u);
    return b;
}
__device__ __forceinline__ void xcd_barrier_complete(unsigned* bar, unsigned x, unsigned& nloc, unsigned& nx) {
    const unsigned G = gridDim.x * gridDim.y * gridDim.z;
    unsigned sum, cnt, mine, sp = 0u;
    for (;;) {
        sum = 0u; cnt = 0u; mine = 0u;
#pragma unroll
        for (unsigned j = 0; j < 16; ++j) { const unsigned c = xb_ld(&bar[XB_XCNT(j)]); sum += c; cnt += (c > 0u) ? 1u : 0u; mine = (j == x) ? c : mine; }
        if (sum == G) break;
        __builtin_amdgcn_s_sleep(1);
        if ((++sp & 255u) == 0u) { if (xb_ld(&bar[XB_TMO])) break; if (sp > XB_SPIN_CAP) { atomicAdd(&bar[XB_TMO], 1u); break; } }
    }
    nloc = mine > 0u ? mine : 1u; nx = cnt > 0u ? cnt : 1u;
}

__device__ __forceinline__ void xcd_barrier(const XcdBarrier& b, bool thread0) {
    asm volatile("s_waitcnt vmcnt(0)" ::: "memory");
    __syncthreads();
    if (thread0) {
        unsigned* bar = b.bar;
        __builtin_amdgcn_s_waitcnt(0);
        unsigned nloc = b.st[0], nx = b.st[1];
        if (nloc == 0u) { xcd_barrier_complete(bar, b.x, nloc, nx); b.st[0] = nloc; b.st[1] = nx; }
        const unsigned old = xb_add(&bar[XB_XSUB(b.x)], 1u);
        const unsigned gen = old / nloc;
        if (old + 1u == (gen + 1u) * nloc) {
            __builtin_amdgcn_fence(__ATOMIC_RELEASE, "agent");
            asm volatile("s_waitcnt vmcnt(0)" ::: "memory");
            const unsigned og = xb_add(&bar[XB_TOP], 1u);
            const unsigned tg = og / nx;
            if (og + 1u == (tg + 1u) * nx) xb_add(&bar[XB_TOPGEN], 1u);
            else XB_SPIN(xb_ld(&bar[XB_TOPGEN]) == tg, bar);
            __builtin_amdgcn_fence(__ATOMIC_ACQUIRE, "agent");
            xb_add(&bar[XB_XGEN(b.x)], 1u);
            asm volatile("s_waitcnt vmcnt(0)" ::: "memory");
        } else {
            XB_SPIN(xb_ld(&bar[XB_XGEN(b.x)]) == gen, bar);
            __builtin_amdgcn_fence(__ATOMIC_ACQUIRE, "agent");
            asm volatile("s_waitcnt vmcnt(0)" ::: "memory");
        }
    }
    __syncthreads();
}
#ifndef MK_PROBE
#define MK_PROBE (-1)
#endif
#ifndef MK_PROBE_SCALE
#define MK_PROBE_SCALE 4e-6f
#endif
#define PROBE_T0() unsigned long long pt0_ = 0; if (MK_PROBE >= 0) { pt0_ = __builtin_amdgcn_s_memtime(); asm volatile("s_waitcnt lgkmcnt(0)" ::: "memory"); }
#define PROBE_T1(id) do { if (MK_PROBE == (id)) { const unsigned long long pt1_ = __builtin_amdgcn_s_memtime(); asm volatile("s_waitcnt lgkmcnt(0)" ::: "memory"); \
    if (C.bid == 0 && C.wave == 0 && C.lane == 0) { volatile LAS unsigned* pw_ = (volatile LAS unsigned*)(C.lds + MISC_OFF + 64); pw_[0] = pw_[0] + (unsigned)(pt1_ - pt0_); } } } while (0)
constexpr int NWAVES = 8;
constexpr int NLAYER = 4, DM = 2048, NBATCH = 2, SEQ = 4096, NMETA = 16, LTOK = SEQ + NMETA, NTOK = NBATCH * LTOK;
constexpr int MP = 8448;
constexpr int NP1 = 8448;
constexpr int NC_IN = 8264;
constexpr int PC_QA = 0, PC_KA = 1024, PC_VA = 1152, PC_ZA = 1280, PC_CQ = 2304, PC_CKV = 2816, PC_ZB = 3072, PC_GA = 4096, PC_GB = 6144, PC_KIDX = 8192, PC_WIDX = 8256;
constexpr int NQ2 = 4608;
constexpr int TOPK = 256;
constexpr int YLD = 2048;
constexpr float RMS_EPS = 1e-6f;

__device__ __forceinline__ int rowof(int b, int t) { return t < NMETA ? 8192 + b * NMETA + t : b * SEQ + (t - NMETA); }
__device__ __forceinline__ int t5_bucket(int d) {
    const int n = d < 0 ? 0 : d;
    if (n < 16) return n;
    return 16 + (n >= 19) + (n >= 21) + (n >= 24) + (n >= 27) + (n >= 31) + (n >= 35) + (n >= 40) + (n >= 46) + (n >= 52) + (n >= 59) + (n >= 67) + (n >= 77) + (n >= 87) + (n >= 99) + (n >= 113);
}
__device__ __forceinline__ float bf2f(bf16 v) { return __uint_as_float((unsigned)v << 16); }
__device__ __forceinline__ float sigmoidf_(float x) { return 1.0f / (1.0f + __expf(-x)); }
__device__ __forceinline__ float siluf_(float x) { return x / (1.0f + __expf(-x)); }
__device__ __forceinline__ float wave_sum(float v) {
#pragma unroll
    for (int o = 1; o < 64; o <<= 1) v += __shfl_xor(v, o);
    return v;
}
__device__ __forceinline__ float wave_max(float v) {
#pragma unroll
    for (int o = 1; o < 64; o <<= 1) v = fmaxf(v, __shfl_xor(v, o));
    return v;
}
__device__ __forceinline__ int wave_sum_i(int v) {
#pragma unroll
    for (int o = 1; o < 64; o <<= 1) v += __shfl_xor(v, o);
    return v;
}

constexpr size_t MiB = 1u << 20;
constexpr size_t WS_CTL = 0, CTL_ZERO_BYTES = 1 * MiB;
constexpr size_t SZ_W1 = (size_t)NLAYER * NP1 * DM * 2, SZ_W2 = (size_t)NLAYER * NQ2 * 512 * 2, SZ_WA = (size_t)NLAYER * DM * 1024 * 2, SZ_WO = (size_t)NLAYER * DM * DM * 2;
constexpr size_t al(size_t x) { return (x + 4095) / 4096 * 4096; }
constexpr size_t WS_W1 = 1 * MiB, WS_W2 = WS_W1 + al(SZ_W1), WS_WA = WS_W2 + al(SZ_W2), WS_WB = WS_WA + 1024 * 2, WS_WO = WS_WA + al(2 * SZ_WA);
constexpr size_t SZ_WUV = (size_t)NLAYER * 16 * 64 * 256 * 2;
constexpr size_t WS_WUV = WS_WO + al(SZ_WO);
constexpr size_t WS_VT = WS_WUV + al(SZ_WUV);
constexpr size_t WS_KV = WS_VT + al((size_t)2 * 128 * 4128 * 2), WS_KIDX = WS_KV + al((size_t)MP * 256 * 2);
constexpr size_t WS_H = WS_KIDX + al((size_t)MP * 64 * 2), WS_HB = WS_H + al((size_t)MP * DM * 4), WS_RS = WS_HB + al((size_t)MP * DM * 2);
constexpr size_t WS_RS2 = WS_RS + al((size_t)MP * 32 * 4);
constexpr size_t WS_PROJ = WS_RS2 + al((size_t)32 * 64 * 4), WS_CQN = WS_PROJ + al((size_t)MP * NP1 * 2), WS_CKVN = WS_CQN + al((size_t)MP * 512 * 2);
constexpr size_t WS_Q2 = WS_CKVN + al((size_t)MP * 256 * 2), WS_OLAT = WS_Q2 + al((size_t)MP * NQ2 * 2), WS_YA = WS_OLAT + al((size_t)256 * 3 * 16 * 8 * 64 * 8 * 2);
constexpr size_t WS_YB = WS_YA + 1024 * 2, WS_PA = WS_YA + al((size_t)MP * 2048 * 2),
 WS_MG = WS_PA + al((size_t)MP * DM * 4), WS_END = WS_MG + al((size_t)MP * DM * 2);
constexpr int CW_TMO = 0, CW_CODE = 1, CW_BAR = 4096;

constexpr int LDSCTL_OFF = 0, MISC_OFF = LDSCTL_OFF + 320;
constexpr int RSTD_OFF = 512;
constexpr int RING_OFF = 8192, RING_BYTES = 131072;
constexpr int LDS_BYTES = 163840;
static_assert(RSTD_OFF + 5 * 256 * 4 <= RING_OFF, "LDS map");

struct Args {
    const float* x; const float* meta; const float* bias_table; const float* norm_g; const float* w_in; const float* q_norm_g; const float* kv_norm_g; const float* w_qb; const float* w_iq;
    const float* w_uk; const float* w_uv; const float* sinks; const float* w_proj_a; const float* w_proj_b; const float* w_out; const float* final_g;
    float* out; unsigned char* ws; int ph_lo, ph_hi;
};

struct XDesc { const float* W; const float* scale; bf16* out; int ldw, k0, c0, nvalid, K; };
__device__ __forceinline__ void xpose_load(const XDesc& d, float (&v)[32], int lane) {
    asm volatile("" : "+v"(lane));
    const int c = lane & 31; const float* p = d.W + (size_t)(d.k0 + (lane >> 5)) * d.ldw + d.c0 + c;
#pragma unroll
    for (int i = 0; i < 32; ++i) v[i] = (c < d.nvalid) ? p[(size_t)(2 * i) * d.ldw] : 0.f;
    if (d.scale) {
#pragma unroll
        for (int i = 0; i < 32; ++i) v[i] *= d.scale[d.k0 + 2 * i + (lane >> 5)];
    }
}
__device__ __forceinline__ void xpose_store(const XDesc& d, const float (&v)[32], LAS float* scr, int lane) {
    asm volatile("" : "+v"(lane));
    const int c = lane & 31;
#pragma unroll
    for (int i = 0; i < 32; ++i) scr[(2 * i + (lane >> 5)) * 33 + c] = v[i];
    LDS_WAIT(); asm volatile("" ::: "memory");
    const int cc = lane & 7;
#pragma unroll
    for (int j = 0; j < 4; ++j) { const int n = (lane >> 3) + 8 * j; const LAS float* s = scr + (8 * cc) * 33 + n;
        v4u o; o.x = pk2(s[0 * 33], s[1 * 33]); o.y = pk2(s[2 * 33], s[3 * 33]); o.z = pk2(s[4 * 33], s[5 * 33]); o.w = pk2(s[6 * 33], s[7 * 33]);
        *(GAS v4u*)(d.out + (size_t)n * d.K + d.k0 + 8 * cc) = o; }
    LDS_WAIT(); asm volatile("" ::: "memory");
}
__device__ __forceinline__ void fold_item(const float* __restrict__ wqb, const float* __restrict__ wuk, const float* __restrict__ gq, bf16* W2l, int h, int kb, int rb, LAS float* scr, int lane) {
    const int rr = lane & 31, r = rb * 32 + rr;
    float uk[64];
#pragma unroll
    for (int d = 0; d < 64; ++d) uk[d] = wuk[((size_t)h * 64 + d) * 256 + r];
    for (int i = 0; i < 32; ++i) { const int kk = 2 * i + (lane >> 5), k = kb * 64 + kk; const f32x4* qp = (const f32x4*)(wqb + (size_t)k * 1024 + h * 64); float a = 0.f;
#pragma unroll
        for (int d4 = 0; d4 < 16; ++d4) { const f32x4 q = qp[d4]; a = fmaf(q[0], uk[4 * d4], a); a = fmaf(q[1], uk[4 * d4 + 1], a); a = fmaf(q[2], uk[4 * d4 + 2], a); a = fmaf(q[3], uk[4 * d4 + 3], a); }
        scr[kk * 33 + rr] = a * gq[k]; }
    LDS_WAIT(); asm volatile("" ::: "memory");
    const int cc = lane & 7; bf16* out = W2l + (size_t)(h * 256 + rb * 32) * 512;
#pragma unroll
    for (int j = 0; j < 4; ++j) { const int n = (lane >> 3) + 8 * j; const LAS float* s = scr + (8 * cc) * 33 + n;
        v4u o; o.x = pk2(s[0 * 33], s[1 * 33]); o.y = pk2(s[2 * 33], s[3 * 33]); o.z = pk2(s[4 * 33], s[5 * 33]); o.w = pk2(s[6 * 33], s[7 * 33]);
        *(GAS v4u*)(out + (size_t)n * 512 + kb * 64 + 8 * cc) = o; }
    LDS_WAIT(); asm volatile("" ::: "memory");
}

struct Ctx {
    LAS unsigned char* lds; int tid, lane, wave, G, gw, NGW, bid;
    Args a;
};
#if defined(__HIP_DEVICE_COMPILE__)
#define ASSUME_GLOBAL(p) do { __builtin_assume(!__builtin_amdgcn_is_shared((const void*)(p))); __builtin_assume(!__builtin_amdgcn_is_private((const void*)(p))); } while (0)
#else
#define ASSUME_GLOBAL(p) do { } while (0)
#endif
__device__ __forceinline__ unsigned char* launder(unsigned char* p) { size_t z = 0; asm volatile("" : "+s"(z)); return p + z; }
__device__ __forceinline__ const float* launderf(const float* p) { size_t z = 0; asm volatile("" : "+s"(z)); return p + z; }
struct Bufs {
    bf16 *W1, *W2, *WA, *WB, *WO, *WUV, *VT, *KV, *KIDX, *HB, *PROJ, *CQN, *CKVN, *Q2, *OLAT, *YA, *YB, *MG; float *H, *RS, *RS2, *PA;
    __device__ __forceinline__ explicit Bufs(unsigned char* ws0) {
        unsigned char* ws = launder(ws0);
        W1 = (bf16*)(ws + WS_W1); W2 = (bf16*)(ws + WS_W2); WA = (bf16*)(ws + WS_WA); WB = (bf16*)(ws + WS_WB); WO = (bf16*)(ws + WS_WO); WUV = (bf16*)(ws + WS_WUV); VT = (bf16*)(ws + WS_VT); KV = (bf16*)(ws + WS_KV); KIDX = (bf16*)(ws + WS_KIDX);
        H = (float*)(ws + WS_H); HB = (bf16*)(ws + WS_HB); RS = (float*)(ws + WS_RS); RS2 = (float*)(ws + WS_RS2); PROJ = (bf16*)(ws + WS_PROJ); CQN = (bf16*)(ws + WS_CQN); CKVN = (bf16*)(ws + WS_CKVN);
        Q2 = (bf16*)(ws + WS_Q2); OLAT = (bf16*)(ws + WS_OLAT); YA = (bf16*)(ws + WS_YA); YB = (bf16*)(ws + WS_YB); PA = (float*)(ws + WS_PA); MG = (bf16*)(ws + WS_MG);
    }
};

__device__ __forceinline__ void p0_prologue(const Ctx& C) {
    const Bufs B(C.a.ws);
    const Args& A = C.a;
    LAS float* scr = (LAS float*)(C.lds + RING_OFF + C.wave * 16384);
    constexpr int I_T1 = (DM / 64) * (NP1 / 32), I_T2 = (512 / 64) * (512 / 32), I_T3 = (1024 / 64) * (DM / 32), I_T5 = (DM / 64) * (DM / 32), I_F = 16 * 8 * 8, I_UV = 16 * 8;
    constexpr int I_X = I_T1 + I_T2 + 2 * I_T3 + I_T5, NX = NLAYER * I_X;
    auto decode = [&](int it) -> XDesc {
        const int l = it / I_X; int r = it % I_X; XDesc d;
        if (r < I_T1) { const int nblk = NP1 / 32, kb = r / nblk, n0 = (r % nblk) * 32; int c0, nvalid = 32;
            if (n0 < 4096) c0 = n0; else if (n0 < 8192) c0 = n0 + 72; else { c0 = n0 - 8192 + 4096; nvalid = (8264 - n0) < 0 ? 0 : ((8264 - n0) > 32 ? 32 : (8264 - n0)); }
            d = XDesc{A.w_in + (size_t)l * DM * NC_IN, A.norm_g + l * DM, B.W1 + ((size_t)l * NP1 + n0) * DM, NC_IN, kb * 64, c0, nvalid, DM}; return d; }
        r -= I_T1;
        if (r < I_T2) { const int nblk = 512 / 32, kb = r / nblk, nb = r % nblk;
            d = XDesc{A.w_iq + (size_t)l * 512 * 512, A.q_norm_g + l * 512, B.W2 + ((size_t)l * NQ2 + 4096 + nb * 32) * 512, 512, kb * 64, nb * 32, 32, 512}; return d; }
        r -= I_T2;
        if (r < 2 * I_T3) { const bool second = r >= I_T3; if (second) r -= I_T3; const int nblk = DM / 32, kb = r / nblk, nb = r % nblk;
            d = XDesc{(second ? A.w_proj_b : A.w_proj_a) + (size_t)l * 1024 * DM, nullptr, (second ? B.WB : B.WA) + ((size_t)l * DM + nb * 32) * 2048, DM, kb * 64, nb * 32, 32, 2048}; return d; }
        r -= 2 * I_T3;
        { const int nblk = DM / 32, kb = r / nblk, nb = r % nblk;
            d = XDesc{A.w_out + (size_t)l * DM * DM, nullptr, B.WO + ((size_t)l * DM + nb * 32) * DM, DM, kb * 64, nb * 32, 32, DM}; return d; }
    };
    {
        int it = C.gw;
        if (it < NX) {
            XDesc dc = decode(it); float vc[32]; xpose_load(dc, vc, C.lane);
            for (;;) {
                const int itn = it + C.NGW; const bool more = itn < NX;
                XDesc dn = dc; float vn[32];
                if (more) { dn = decode(itn); xpose_load(dn, vn, C.lane); }
                xpose_store(dc, vc, scr, C.lane);
                if (!more) break;
                dc = dn; it = itn;
#pragma unroll
                for (int i = 0; i < 32; ++i) vc[i] = vn[i];
            }
        }
    }
    for (int it = C.gw; it < NLAYER * (I_F + I_UV); it += C.NGW) {
        const int l = it / (I_F + I_UV); int r = it % (I_F + I_UV);
        if (r >= I_F) { r -= I_F; const int h = r / 8, s = r % 8;
            const float* wsrc = A.w_uv + ((size_t)l * 16 + h) * 256 * 64; const int gg = C.lane >> 4, cc = C.lane & 15;
#pragma unroll
            for (int nt = 0; nt < 4; ++nt) { const float* p = wsrc + (size_t)(32 * s + 8 * gg) * 64 + 16 * nt + cc;
                v4u o; o.x = pk2(p[0 * 64], p[1 * 64]); o.y = pk2(p[2 * 64], p[3 * 64]); o.z = pk2(p[4 * 64], p[5 * 64]); o.w = pk2(p[6 * 64], p[7 * 64]);
                *(GAS v4u*)(B.WUV + ((((size_t)l * 16 + h) * 8 + s) * 4 + nt) * 512 + C.lane * 8) = o; }
            continue; }
        { const int h = r / 64, kb = (r / 8) % 8, rb = r % 8;
            fold_item(A.w_qb + (size_t)l * 512 * 1024, A.w_uk + (size_t)l * 16 * 64 * 256, A.q_norm_g + l * 512, B.W2 + (size_t)l * NQ2 * 512, h, kb, rb, scr, C.lane); }
    }
    for (int m = C.gw; m < MP; m += C.NGW) {
        const float* src = nullptr;
        if (m < 8192) src = A.x + (size_t)m * DM; else if (m < 8224) src = A.meta + (size_t)((m - 8192) % NMETA) * DM;
        float ss = 0.f;
#pragma unroll
        for (int j = 0; j < 8; ++j) { f32x4 v = src ? *(const f32x4*)(src + j * 256 + C.lane * 4) : (f32x4){0.f, 0.f, 0.f, 0.f};
            *(f32x4*)(B.H + (size_t)m * DM + j * 256 + C.lane * 4) = v;
            pg8::u32x2 w; w.x = pk2(v[0], v[1]); w.y = pk2(v[2], v[3]); *(pg8::u32x2*)(B.HB + (size_t)m * DM + j * 256 + C.lane * 4) = w;
            ss += (v[0] * v[0] + v[1] * v[1]) + (v[2] * v[2] + v[3] * v[3]); }
        ss = wave_sum(ss);
        if (C.lane < 32) B.RS[(size_t)m * 32 + C.lane] = (C.lane == 0) ? ss : 0.f;
        if (m >= 8192 && m < 8224) B.RS2[(size_t)(m - 8192) * 64 + C.lane] = (C.lane == 0) ? ss : 0.f;
        if (m >= NTOK) {
#pragma unroll
            for (int j = 0; j < 2; ++j) { *(v4u*)(B.YA + (size_t)m * YLD + j * 512 + C.lane * 8) = (v4u){0u, 0u, 0u, 0u}; *(v4u*)(B.YB + (size_t)m * YLD + j * 512 + C.lane * 8) = (v4u){0u, 0u, 0u, 0u}; }
        }
    }
}

__device__ __forceinline__ void g1_rstd_table(const Ctx& C, const pg8::StaticOrder& S) {
    const Bufs B(C.a.ws);
    LAS float* tbl = (LAS float*)(C.lds + RSTD_OFF);
    pg8::Unit u;
    for (int ui = 0; ui < 5 && S.next(ui, u); ++ui) {
        if (C.tid < 256) { const f32x4* p = (const f32x4*)(B.RS + (size_t)(u.pm * 256 + C.tid) * 32); float s = 0.f;
#pragma unroll
            for (int j = 0; j < 8; ++j) { const f32x4 v = p[j]; s += (v[0] + v[1]) + (v[2] + v[3]); }
            tbl[ui * 256 + C.tid] = rsqrtf(s * (1.0f / DM) + RMS_EPS); }
    }
    __syncthreads();
}

__device__ __forceinline__ void norm_phase(const Ctx& C, int l) {
    const Bufs B(C.a.ws);
    const Args& A = C.a;
    for (int m = C.gw; m < NTOK; m += C.NGW) {
        const bf16* pr = B.PROJ + (size_t)m * NP1;
        { const v4u w = *(const v4u*)(pr + PC_CQ + C.lane * 8); float v[8] = {pg8::bf_lo(w.x), pg8::bf_hi(w.x), pg8::bf_lo(w.y), pg8::bf_hi(w.y), pg8::bf_lo(w.z), pg8::bf_hi(w.z), pg8::bf_lo(w.w), pg8::bf_hi(w.w)};
          float ss = 0.f;
#pragma unroll
          for (int j = 0; j < 8; ++j) ss += v[j] * v[j];
          ss = wave_sum(ss); const float r = rsqrtf(ss * (1.0f / 512.0f) + RMS_EPS);
          v4u o; o.x = pk2(v[0] * r, v[1] * r); o.y = pk2(v[2] * r, v[3] * r); o.z = pk2(v[4] * r, v[5] * r); o.w = pk2(v[6] * r, v[7] * r);
          *(v4u*)(B.CQN + (size_t)m * 512 + C.lane * 8) = o; }
        { const pg8::u32x2 w = *(const pg8::u32x2*)(pr + PC_CKV + C.lane * 4); float v[4] = {pg8::bf_lo(w.x), pg8::bf_hi(w.x), pg8::bf_lo(w.y), pg8::bf_hi(w.y)};
          float ss = (v[0] * v[0] + v[1] * v[1]) + (v[2] * v[2] + v[3] * v[3]);
          ss = wave_sum(ss); const float r = rsqrtf(ss * (1.0f / 256.0f) + RMS_EPS);
          const f32x4 g = *(const f32x4*)(A.kv_norm_g + l * 256 + C.lane * 4);
          pg8::u32x2 o; o.x = pk2(v[0] * r * g[0], v[1] * r * g[1]); o.y = pk2(v[2] * r * g[2], v[3] * r * g[3]);
          *(pg8::u32x2*)(B.CKVN + (size_t)m * 256 + C.lane * 4) = o; }
    }
    for (int it = C.gw; it < 2 * 65; it += C.NGW) { const int b = it / 65, pos = (it % 65) * 64 + C.lane;
        if (pos < LTOK) { const bf16* vr = B.KV + (size_t)rowof(b, pos) * 256 + 128;
#pragma unroll 4
            for (int c8 = 0; c8 < 16; ++c8) { const v4u w = *(const v4u*)(vr + 8 * c8); bf16* o = B.VT + ((size_t)b * 128 + 8 * c8) * 4128 + pos;
                o[0 * 4128] = (bf16)(w.x & 0xffffu); o[1 * 4128] = (bf16)(w.x >> 16); o[2 * 4128] = (bf16)(w.y & 0xffffu); o[3 * 4128] = (bf16)(w.y >> 16);
                o[4 * 4128] = (bf16)(w.z & 0xffffu); o[5 * 4128] = (bf16)(w.z >> 16); o[6 * 4128] = (bf16)(w.w & 0xffffu); o[7 * 4128] = (bf16)(w.w >> 16); } } }
}

__device__ __forceinline__ unsigned f2key(float f) { const unsigned u = __float_as_uint(f); return (u & 0x80000000u) ? ~u : (u | 0x80000000u); }

__device__ __forceinline__ void final_phase(const Ctx& C) {
    const Bufs B(C.a.ws);
    const Args& A = C.a;
    for (int m = C.gw; m < 8192; m += C.NGW) {
        float s = (C.lane < 32) ? B.RS[(size_t)m * 32 + C.lane] : 0.f;
        s = wave_sum(s);
        const float r = rsqrtf(s * (1.0f / DM) + RMS_EPS);
#pragma unroll
        for (int j = 0; j < 8; ++j) { const f32x4 v = *(const f32x4*)(B.H + (size_t)m * DM + j * 256 + C.lane * 4); const f32x4 g = *(const f32x4*)(A.final_g + j * 256 + C.lane * 4);
            *(f32x4*)(A.out + (size_t)m * DM + j * 256 + C.lane * 4) = v * r * g; }
    }
#if defined(MK_PROBE)
    if (MK_PROBE >= 0 && C.gw == 0) { VM_WAIT(); if (C.lane == 0) A.out[0] += (float)((volatile LAS unsigned*)(C.lds + MISC_OFF + 64))[0] * MK_PROBE_SCALE; }
#endif
}


struct SkProj {
    bf16* P; bf16* KV; bf16* KIDX; int cb; const LAS float* tbl;
    __device__ __forceinline__ float operator()(int rloc, int c, float v) const { const int ac = cb + c; const bf16 o = (bf16)f2bf(v * tbl[rloc]);
        if (ac >= 1024 && ac < 1280) KV[(size_t)rloc * 256 + ac - 1024] = o; else if (ac >= 8192 && ac < 8256) KIDX[(size_t)rloc * 64 + ac - 8192] = o; else P[(size_t)rloc * NP1 + ac] = o;
        return 0.f; } };
struct SkQ2 { bf16* O; __device__ __forceinline__ float operator()(int rloc, int c, float v) const { O[(size_t)rloc * NQ2 + c] = (bf16)f2bf(v); return 0.f; } };
struct SkPA { float* P; const bf16* G; __device__ __forceinline__ float operator()(int rloc, int c, float v) const { P[(size_t)rloc * DM + c] = sigmoidf_(bf2f(G[(size_t)rloc * NP1 + c])) * v; return 0.f; } };
struct SkMerge { bf16* O; const float* P; const bf16* G; __device__ __forceinline__ float operator()(int rloc, int c, float v) const { O[(size_t)rloc * DM + c] = (bf16)f2bf(P[(size_t)rloc * DM + c] + sigmoidf_(bf2f(G[(size_t)rloc * NP1 + c])) * v); return 0.f; } };
struct SkRes { float* H; bf16* HB; __device__ __forceinline__ float operator()(int rloc, int c, float v) const { const float h = H[(size_t)rloc * DM + c] + v; H[(size_t)rloc * DM + c] = h; HB[(size_t)rloc * DM + c] = (bf16)f2bf(h); return h; } };
constexpr int MR = 8192;
typedef float f32x16 __attribute__((ext_vector_type(16)));
template <int NT, int GPI, bool WANT_SS, class F>
__device__ __forceinline__ void skinny_unit(const Ctx& C, const bf16* __restrict__ A, int lda, const bf16* __restrict__ Bt, int ldb, int K, float* ss_out  , int ss_ld, int ss_col0, const F& epi) {
    const int lane = C.lane, w = C.wave, r32 = lane & 31, hh = lane >> 5;
    f32x16 acc[NT];
#pragma unroll
    for (int nt = 0; nt < NT; ++nt) acc[nt] = (f32x16){};
    const int kper = K >> 3, ngroups = kper >> 6;
    const bf16* ap = A + (size_t)r32 * lda + w * kper + 8 * hh;
    const bf16* bp = Bt + (size_t)r32 * ldb + w * kper + 8 * hh;
#pragma unroll 1
    for (int g0 = 0; g0 < ngroups; g0 += GPI) {
        bf16x8 a[GPI][4], bv[NT][GPI][4];
#pragma unroll
        for (int gi = 0; gi < GPI; ++gi)
#pragma unroll
            for (int s = 0; s < 4; ++s) a[gi][s] = *(const bf16x8*)(ap + (g0 + gi) * 64 + 16 * s);
#pragma unroll
        for (int nt = 0; nt < NT; ++nt)
#pragma unroll
            for (int gi = 0; gi < GPI; ++gi)
#pragma unroll
                for (int s = 0; s < 4; ++s) bv[nt][gi][s] = *(const bf16x8*)(bp + (size_t)nt * 32 * ldb + (g0 + gi) * 64 + 16 * s);
        __builtin_amdgcn_sched_barrier(0);
#pragma unroll
        for (int gi = 0; gi < GPI; ++gi)
#pragma unroll
            for (int s = 0; s < 4; ++s)
#pragma unroll
                for (int nt = 0; nt < NT; ++nt) acc[nt] = __builtin_amdgcn_mfma_f32_32x32x16_bf16(a[gi][s], bv[nt][gi][s], acc[nt], 0, 0, 0);
        __builtin_amdgcn_sched_barrier(0);
    }
    LAS float* part = (LAS float*)(C.lds + RING_OFF);
#pragma unroll
    for (int nt = 0; nt < NT; ++nt)
#pragma unroll
        for (int i = 0; i < 16; ++i) part[(w * NT * 16 + nt * 16 + i) * 64 + lane] = acc[nt][i];
    LDS_WAIT(); __syncthreads();
#pragma unroll
    for (int j = 0; j < 2 * NT; ++j) { const int e = (w + 8 * j) * 64 + lane;
        const int nti = w + 8 * j, nt = nti >> 4, i = nti & 15;
        float v = 0.f;
#pragma unroll
        for (int ww = 0; ww < 8; ++ww) v += part[ww * NT * 1024 + e];
        const int rloc = (i & 3) + 8 * (i >> 2) + 4 * hh, c = nt * 32 + r32;
        float sv = epi(rloc, c, v);
        if (WANT_SS) { sv = sv * sv;
#pragma unroll
            for (int o = 1; o < 32; o <<= 1) sv += __shfl_xor(sv, o);
            if (r32 == 0) ss_out[(size_t)rloc * ss_ld + ss_col0 + nt] = sv; }
    }
    LDS_WAIT(); __syncthreads();
}
__device__ __forceinline__ void skinny_rstd(const Ctx& C, const float* __restrict__ rs, int np, LAS float* tbl) {
    if (C.tid < 32) { float s = 0.f; const f32x4* p = (const f32x4*)(rs + (size_t)C.tid * np);
        for (int j = 0; j < np / 4; ++j) { const f32x4 v = p[j]; s += (v[0] + v[1]) + (v[2] + v[3]); }
        tbl[C.tid] = rsqrtf(s * (1.0f / DM) + RMS_EPS); }
    LDS_WAIT(); __syncthreads();
}

typedef short s16x4 __attribute__((ext_vector_type(4)));
typedef unsigned short u16x4 __attribute__((ext_vector_type(4)));
constexpr int DS_ISC = RING_OFF, DS_ISC_WORDS = 4128, DS_ISC_STRIDE = DS_ISC_WORDS * 4;
constexpr int DS_SEL = DS_ISC + 8 * DS_ISC_STRIDE;
constexpr int DS_BIAS = DS_SEL + 8 * 512;
constexpr int DS_QROW = DS_BIAS + 8192;
constexpr int DS_END = DS_QROW + 256;
constexpr size_t OL_BLOCK = (size_t)3 * 16 * 8 * 64 * 8;
static_assert(DS_END <= LDS_BYTES, "DSA LDS map");

__device__ __forceinline__ void glds16(const void* gsrc, unsigned lds_dst) { unsigned keep;
    asm volatile("s_mov_b32 %0, m0\n\ts_mov_b32 m0, %2\n\ts_nop 0\n\tglobal_load_lds_dwordx4 %1, off\n\ts_mov_b32 m0, %0" : "=&s"(keep) : "v"(gsrc), "s"(lds_dst) : "memory"); }
__device__ __forceinline__ float relu1(float x) { return __builtin_amdgcn_fmed3f(x, 0.f, __builtin_inff()); }
__device__ __forceinline__ s16x4 tr_read(LAS unsigned char* p) { typedef short v4i16_t __attribute__((ext_vector_type(4))); return __builtin_bit_cast(s16x4, __builtin_amdgcn_ds_read_tr16_b64_v4i16((LAS v4i16_t*)p)); }
__device__ __forceinline__ unsigned cvtpk(float lo, float hi) { typedef float f2_t __attribute__((ext_vector_type(2))); typedef __bf16 b2_t __attribute__((ext_vector_type(2))); f2_t v = {lo, hi}; b2_t b = __builtin_convertvector(v, b2_t); return __builtin_bit_cast(unsigned, b); }

#define DSA_LOCALS() const int w = C.wave; LAS unsigned* ISC = (LAS unsigned*)(C.lds + DS_ISC); LAS unsigned short* sel = (LAS unsigned short*)(C.lds + DS_SEL) + w * 256; const LAS float* biasl = (const LAS float*)(C.lds + DS_BIAS); (void)ISC; (void)sel; (void)biasl
#define RELANE() do { asm volatile("" : "+v"(lane)); asm volatile("" : "+s"(t0), "+s"(b)); } while (0)
__device__ __forceinline__ void dsa_step1(const Ctx& C, const Bufs& B, int b, int t0) {
    int lane = C.lane; RELANE(); DSA_LOCALS();
    PROBE_T0();
    {
        const int r32 = lane & 31, hh = lane >> 5;
        bf16x8 qa[2][4]; float wq[2][2][8];
        const int qi = 2 * ((r32 >> 2) & 1) + (r32 >> 4), hA = (r32 & 3) + 4 * ((r32 >> 3) & 1);
#pragma unroll
        for (int g = 0; g < 2; ++g) { const int row = rowof(b, t0 + 4 * g + qi);
#pragma unroll
            for (int s = 0; s < 4; ++s) qa[g][s] = *(const bf16x8*)(B.Q2 + (size_t)row * NQ2 + 4096 + hA * 64 + 16 * s + 8 * hh);
#pragma unroll
            for (int j = 0; j < 2; ++j) { const int rw = rowof(b, t0 + 4 * g + 2 * hh + j); const v4u ww = *(const v4u*)(B.PROJ + (size_t)rw * NP1 + PC_WIDX);
                const float sc = 0.35355339059327373f * 0.125f;
                wq[g][j][0] = pg8::bf_lo(ww.x) * sc; wq[g][j][1] = pg8::bf_hi(ww.x) * sc; wq[g][j][2] = pg8::bf_lo(ww.y) * sc; wq[g][j][3] = pg8::bf_hi(ww.y) * sc;
                wq[g][j][4] = pg8::bf_lo(ww.z) * sc; wq[g][j][5] = pg8::bf_hi(ww.z) * sc; wq[g][j][6] = pg8::bf_lo(ww.w) * sc; wq[g][j][7] = pg8::bf_hi(ww.w) * sc; } }
        PROBE_T1(40);
        const int nkeys = t0 + 8, nkt = (nkeys + 31) >> 5;
        bf16x8 kA[4], kB[4];
#define IDX_LOAD(dst, kt_) do { const int key_ = (kt_) * 32 + r32, kc_ = key_ < nkeys ? key_ : nkeys - 1; const bf16* kp_ = B.KIDX + (size_t)rowof(b, kc_) * 64 + 8 * hh; \
        _Pragma("unroll") for (int s = 0; s < 4; ++s) dst[s] = *(const bf16x8*)(kp_ + 16 * s); } while (0)
#define IDX_TILE(src, kt_) do { const int key_ = (kt_) * 32 + r32; \
        _Pragma("unroll") for (int g = 0; g < 2; ++g) { f32x16 acc = {}; \
            _Pragma("unroll") for (int s = 0; s < 4; ++s) acc = __builtin_amdgcn_mfma_f32_32x32x16_bf16(qa[g][s], src[s], acc, 0, 0, 0); \
            _Pragma("unroll") for (int j = 0; j < 2; ++j) { float isc = 0.f; \
                _Pragma("unroll") for (int h = 0; h < 8; ++h) isc += wq[g][j][h] * relu1(acc[8 * j + h]); \
                ISC[(4 * g + 2 * hh + j) * DS_ISC_WORDS + key_] = f2key(isc); } } } while (0)
        int kt = w;
        if (kt < nkt) IDX_LOAD(kA, kt);
#pragma unroll 1
        while (kt < nkt) {
            if (kt + 8 < nkt) IDX_LOAD(kB, kt + 8);
            __builtin_amdgcn_sched_barrier(0);
            IDX_TILE(kA, kt);
            __builtin_amdgcn_sched_barrier(0);
            kt += 8; if (kt >= nkt) break;
            if (kt + 8 < nkt) IDX_LOAD(kA, kt + 8);
            __builtin_amdgcn_sched_barrier(0);
            IDX_TILE(kB, kt);
            __builtin_amdgcn_sched_barrier(0);
            kt += 8;
        }
#undef IDX_LOAD
#undef IDX_TILE
        PROBE_T1(41);
    }
}
__device__ __forceinline__ int dsa_step2(const Ctx& C, int b, int t0) {
    int lane = C.lane; RELANE(); DSA_LOCALS();
    const int t = t0 + w, n = t + 1;
    int cnt;
    if (n <= TOPK) { for (int j = lane; j < n; j += 64) sel[j] = (unsigned short)j; cnt = n; }
    else {
        const LAS unsigned* myrow = ISC + w * DS_ISC_WORDS;
        const int nI = (n + 255) >> 8;
        unsigned v[68];
#pragma unroll
        for (int i = 0; i < 17; ++i) { const pg8::u32x4 x = *(const LAS pg8::u32x4*)(myrow + 256 * i + 4 * lane);
#pragma unroll
            for (int e = 0; e < 4; ++e) v[4 * i + e] = (256 * i + 4 * lane + e <= t) ? x[e] : 0u; }
        unsigned T = 0u; bool exact = false;
#define DSA_COUNT(res, pred_expr) do { int c_ = 0; \
        _Pragma("unroll") for (int i = 0; i < 17; ++i) { if (i < nI) { _Pragma("unroll") for (int e = 0; e < 4; ++e) { const unsigned x_ = v[4 * i + e]; c_ += (pred_expr) ? 1 : 0; } } } \
        int tot_ = 0; _Pragma("unroll") for (int bt = 0; bt < 7; ++bt) tot_ += __popcll(__ballot((c_ >> bt) & 1)) << bt; res = tot_; } while (0)
#pragma unroll 1
        for (int bit = 31; bit >= 0; --bit) {
            const unsigned cand = T | (1u << bit); int c;
            DSA_COUNT(c, x_ >= cand);
            if (c >= TOPK) { T = cand; if (c == TOPK) { exact = true; break; } }
        }
        if (!exact) { int c; DSA_COUNT(c, x_ >= T); exact = (c == TOPK); }
#undef DSA_COUNT
        int base = 0;
#pragma unroll
        for (int k = 0; k < 68; ++k) { const bool p = exact ? (v[k] >= T) : (v[k] > T); const unsigned long long m = __ballot(p);
            const int pos = base + (int)__builtin_amdgcn_mbcnt_hi((unsigned)(m >> 32), __builtin_amdgcn_mbcnt_lo((unsigned)m, 0u));
            if (p) sel[pos] = (unsigned short)(256 * (k >> 2) + 4 * lane + (k & 3));
            base += __popcll(m); }
        if (!exact) {
            int last = -1;
            while (base < TOPK) { int mi = 0x7fffffff;
#pragma unroll
                for (int k = 0; k < 68; ++k) { const int idx = 256 * (k >> 2) + 4 * lane + (k & 3); if (v[k] == T && idx > last && idx < mi) mi = idx; }
#pragma unroll
                for (int o = 1; o < 64; o <<= 1) { const int oth = __shfl_xor(mi, o); mi = oth < mi ? oth : mi; }
                if (lane == 0) sel[base] = (unsigned short)mi;
                last = mi; ++base; }
        }
        cnt = TOPK;
    }
    return cnt;
}
__device__ __forceinline__ void dsa_step3(const Ctx& C, const Bufs& B, int b, int t0, int cnt, int qslot) {
    int lane = C.lane; RELANE(); DSA_LOCALS(); const int t = t0 + w;
    {
        const int g = lane >> 4, c16 = lane & 15, rowq = rowof(b, t);
        bf16x8 qf[8];
#pragma unroll
        for (int s = 0; s < 8; ++s) qf[s] = *(const bf16x8*)(B.Q2 + (size_t)rowq * NQ2 + c16 * 256 + 32 * s + 8 * g);
        f32x4 O[16];
#pragma unroll
        for (int rt = 0; rt < 16; ++rt) O[rt] = (f32x4){0.f, 0.f, 0.f, 0.f};
        float m_ref = 0.f, lsum = 0.f;
        const int buf0 = DS_ISC + w * DS_ISC_STRIDE;
        const int npairs = (cnt + 31) >> 5;
        const int swz = (c16 & 7) << 1;
        const int trow = 4 * g + (c16 >> 2), tswz = (trow & 7) << 1, tp = c16 & 3;
        const int arow = (c16 & 7) * 1024 + (c16 >> 3) * 512, trowo = (trow & 7) * 1024 + (trow >> 3) * 512;
        const unsigned ldsb = (unsigned)(uintptr_t)(C.lds + buf0);
#define DSA_GATHER(c_) do { const unsigned bo_ = (unsigned)__builtin_amdgcn_readfirstlane(ldsb + ((c_) & 1) * 8192); \
        const pg8::u32x4 sp_ = *(const LAS pg8::u32x4*)(sel + 16 * (c_) + 8 * (lane >> 5)); const unsigned spw_[4] = {sp_.x, sp_.y, sp_.z, sp_.w}; \
        _Pragma("unroll") for (int p = 0; p < 8; ++p) { const int j = 16 * (c_) + 8 * (lane >> 5) + p; int pos = (int)((spw_[p >> 1] >> (16 * (p & 1))) & 0xffffu); pos = j < cnt ? pos : 0; \
            const int logical = (lane & 31) ^ (p << 1); \
            glds16((const unsigned char*)B.CKVN + (size_t)rowof(b, pos) * 512 + logical * 16, bo_ + p * 1024); } } while (0)
#pragma unroll 1
        for (int kp = 0; kp < npairs; ++kp) {
            DSA_GATHER(2 * kp); DSA_GATHER(2 * kp + 1);
            asm volatile("s_waitcnt vmcnt(0)" ::: "memory");
            bf16x8 a0[8], a1[8]; s16x4 v0[16], v1[16];
#pragma unroll
            for (int s = 0; s < 8; ++s) { const int off = arow + (((4 * s + g) ^ swz) << 4); a0[s] = *(const LAS bf16x8*)(C.lds + buf0 + off); a1[s] = *(const LAS bf16x8*)(C.lds + buf0 + 8192 + off); }
            const u16x4 p0 = *(const LAS u16x4*)(sel + 32 * kp + 4 * g), p1 = *(const LAS u16x4*)(sel + 32 * kp + 16 + 4 * g);
            __builtin_amdgcn_sched_barrier(0);
            f32x4 s0 = {0.f, 0.f, 0.f, 0.f}, s1 = {0.f, 0.f, 0.f, 0.f};
#pragma unroll
            for (int s = 0; s < 8; ++s) { s0 = __builtin_amdgcn_mfma_f32_16x16x32_bf16(a0[s], qf[s], s0, 0, 0, 0); s1 = __builtin_amdgcn_mfma_f32_16x16x32_bf16(a1[s], qf[s], s1, 0, 0, 0); }
            __builtin_amdgcn_sched_barrier(0);
#pragma unroll
            for (int rt = 0; rt < 16; ++rt) { const int off = trowo + (((2 * rt + (tp >> 1)) ^ tswz) << 4) + 8 * (tp & 1); v0[rt] = tr_read(C.lds + buf0 + off); v1[rt] = tr_read(C.lds + buf0 + 8192 + off); }
            __builtin_amdgcn_sched_barrier(0);
            float x0[4], x1[4]; float mloc = -INFINITY;
#pragma unroll
            for (int i = 0; i < 4; ++i) { const int j0 = 32 * kp + 4 * g + i, j1 = j0 + 16; int d0 = t - (int)p0[i], d1 = t - (int)p1[i]; d0 = d0 < 0 ? 0 : (d0 > 127 ? 127 : d0); d1 = d1 < 0 ? 0 : (d1 > 127 ? 127 : d1);
                const float b0 = biasl[d0 * 16 + c16], b1 = biasl[d1 * 16 + c16];
                const float y0 = 0.125f * s0[i] + b0, y1 = 0.125f * s1[i] + b1;
                x0[i] = (j0 < cnt) ? y0 : -INFINITY; x1[i] = (j1 < cnt) ? y1 : -INFINITY;
                mloc = fmaxf(mloc, fmaxf(x0[i], x1[i])); }
            mloc = fmaxf(mloc, __shfl_xor(mloc, 16)); mloc = fmaxf(mloc, __shfl_xor(mloc, 32));
            if (kp == 0) m_ref = mloc;
            else if (__any(mloc > m_ref + 8.0f)) { const float mn = fmaxf(m_ref, mloc), al = __expf(m_ref - mn);
#pragma unroll
                for (int rt = 0; rt < 16; ++rt) O[rt] *= al;
                lsum *= al; m_ref = mn; }
            float pe0[4], pe1[4];
#pragma unroll
            for (int i = 0; i < 4; ++i) { pe0[i] = __expf(x0[i] - m_ref); pe1[i] = __expf(x1[i] - m_ref); lsum += pe0[i] + pe1[i]; }
            pg8::u32x4 pw; pw.x = cvtpk(pe0[0], pe0[1]); pw.y = cvtpk(pe0[2], pe0[3]); pw.z = cvtpk(pe1[0], pe1[1]); pw.w = cvtpk(pe1[2], pe1[3]);
            const bf16x8 pf = __builtin_bit_cast(bf16x8, pw);
#pragma unroll
            for (int rt = 0; rt < 16; ++rt) { const bf16x8 af = {v0[rt][0], v0[rt][1], v0[rt][2], v0[rt][3], v1[rt][0], v1[rt][1], v1[rt][2], v1[rt][3]};
                O[rt] = __builtin_amdgcn_mfma_f32_16x16x32_bf16(af, pf, O[rt], 0, 0, 0); }
            LDS_WAIT(); asm volatile("" ::: "memory");
        }
#undef DSA_GATHER
        lsum += __shfl_xor(lsum, 16); lsum += __shfl_xor(lsum, 32);
        const float inv = 1.0f / lsum;
#pragma unroll
        for (int rt = 0; rt < 16; ++rt) { const f32x4 o = O[rt] * inv; pg8::u32x2 wv; wv.x = cvtpk(o[0], o[1]); wv.y = cvtpk(o[2], o[3]);
            const int s_ = rt >> 1, gp = 2 * (rt & 1) + (g >> 1), jo = 4 * (g & 1);
            *(pg8::u32x2*)(B.OLAT + (size_t)C.bid * OL_BLOCK + ((((size_t)(qslot >> 4) * 16 + c16) * 8 + s_) * 64 + gp * 16 + (qslot & 15)) * 8 + jo) = wv; }
    }
}
__device__ __forceinline__ void dsa_wuv(const Ctx& C, const Bufs& B, int l, int nq) {
    const int lane = C.lane, w = C.wave, g = lane >> 4, c16 = lane & 15;
    const LAS int* qrow = (const LAS int*)(C.lds + DS_QROW);
    const int nmt = (nq + 15) >> 4;
#pragma unroll 1
    for (int hq = 0; hq < 2; ++hq) { const int h = 2 * w + hq;
        f32x4 Dv[3][4];
#pragma unroll
        for (int mt = 0; mt < 3; ++mt)
#pragma unroll
            for (int nt = 0; nt < 4; ++nt) Dv[mt][nt] = (f32x4){0.f, 0.f, 0.f, 0.f};
        const bf16* wb = B.WUV + (((size_t)l * 16 + h) * 32) * 512 + lane * 8;
        const bf16* ab = B.OLAT + (size_t)C.bid * OL_BLOCK + ((size_t)h * 8) * 512 + lane * 8;
#pragma unroll
        for (int s = 0; s < 8; ++s) { bf16x8 bw[4], aw[3];
#pragma unroll
            for (int nt = 0; nt < 4; ++nt) bw[nt] = *(const bf16x8*)(wb + (s * 4 + nt) * 512);
#pragma unroll
            for (int mt = 0; mt < 3; ++mt) { const v4u av = __builtin_nontemporal_load((const v4u*)(ab + ((size_t)mt * 16 * 8 + s) * 512)); aw[mt] = __builtin_bit_cast(bf16x8, av); }
            __builtin_amdgcn_sched_barrier(0);
#pragma unroll
            for (int mt = 0; mt < 3; ++mt)
#pragma unroll
                for (int nt = 0; nt < 4; ++nt) Dv[mt][nt] = __builtin_amdgcn_mfma_f32_16x16x32_bf16(aw[mt], bw[nt], Dv[mt][nt], 0, 0, 0); }
        LAS float* stg = (LAS float*)(C.lds + RING_OFF + w * 4608);
#pragma unroll
        for (int mt = 0; mt < 3; ++mt) { if (mt < nmt) {
#pragma unroll
            for (int nt = 0; nt < 4; ++nt)
#pragma unroll
                for (int i = 0; i < 4; ++i) stg[(4 * g + i) * 68 + 16 * nt + c16] = Dv[mt][nt][i];
            LDS_WAIT(); asm volatile("" ::: "memory");
            const int slot = lane >> 2, q = mt * 16 + slot, d0 = (lane & 3) * 16;
            if (q < nq) { const int row = qrow[q];
                const bf16* zp = B.PROJ + (size_t)row * NP1 + PC_ZB + h * 64 + d0; bf16* op = B.YB + (size_t)row * YLD + h * 64 + d0;
#pragma unroll
                for (int hf = 0; hf < 2; ++hf) { const v4u zw = *(const v4u*)(zp + 8 * hf);
                    const f32x4 xa = *(const LAS f32x4*)(stg + slot * 68 + d0 + 8 * hf), xb = *(const LAS f32x4*)(stg + slot * 68 + d0 + 8 * hf + 4);
                    v4u o; o.x = pk2(xa[0] * siluf_(pg8::bf_lo(zw.x)), xa[1] * siluf_(pg8::bf_hi(zw.x))); o.y = pk2(xa[2] * siluf_(pg8::bf_lo(zw.y)), xa[3] * siluf_(pg8::bf_hi(zw.y)));
                    o.z = pk2(xb[0] * siluf_(pg8::bf_lo(zw.z)), xb[1] * siluf_(pg8::bf_hi(zw.z))); o.w = pk2(xb[2] * siluf_(pg8::bf_lo(zw.w)), xb[3] * siluf_(pg8::bf_hi(zw.w)));
                    *(v4u*)(op + 8 * hf) = o; } }
            LDS_WAIT(); asm volatile("" ::: "memory"); } }
    }
}
#ifndef MK_DSUB
#define MK_DSUB 0
#endif
__device__ __forceinline__ void dsa_unit(const Ctx& C, const Bufs& B, int l, int b, int t0, int uidx) {
    { PROBE_T0(); for (int rep = 0; rep < ((MK_DSUB & 1) ? 2 : 1); ++rep) { dsa_step1(C, B, b, t0); LDS_WAIT(); PROBE_T1(10); __syncthreads(); } PROBE_T1(0); }
    int cnt = 0;
    { PROBE_T0(); for (int rep = 0; rep < ((MK_DSUB & 2) ? 2 : 1); ++rep) { cnt = dsa_step2(C, b, t0); LDS_WAIT(); asm volatile("" ::: "memory"); } PROBE_T1(1); }
    if (C.lane == 0) ((LAS int*)(C.lds + DS_QROW))[uidx * 8 + C.wave] = rowof(b, t0 + C.wave);
    { PROBE_T0(); for (int rep = 0; rep < ((MK_DSUB & 4) ? 2 : 1); ++rep) { dsa_step3(C, B, b, t0, cnt, uidx * 8 + C.wave); } PROBE_T1(2); }
    { PROBE_T0(); LDS_WAIT(); __syncthreads(); PROBE_T1(7); }
}
#undef RELANE
#undef DSA_LOCALS

__device__ __forceinline__ void dsa_phase(const Ctx& C, int l) {
    const Bufs B(C.a.ws);
    const Args& A = C.a;
    for (int i = C.tid; i < 128 * 16; i += NWAVES * 64) { const int dd = i >> 4, h = i & 15; ((LAS float*)(C.lds + DS_BIAS))[i] = A.bias_table[t5_bucket(dd) * 32 + 16 + h]; }
    __syncthreads();
    int nu = 0;
    for (int it = 0;; ++it) {
        int b, j;
        if (C.G == 256) { const int k = C.bid >> 1; b = C.bid & 1;
            if (it < 4) j = 513 - (128 * it + ((it & 1) ? 127 - k : k)); else if (it == 4 && k < 2) j = 1 - k; else break; }
        else { const int s = C.bid + it * C.G; if (s >= 1028) break; b = s & 1; j = 513 - (s >> 1); }
        dsa_unit(C, B, l, b, 8 * j, it); nu = it + 1;
    }
    VM_WAIT(); LDS_WAIT(); __syncthreads();
    { PROBE_T0(); dsa_wuv(C, B, l, nu * 8); PROBE_T1(3); }
    __syncthreads();
}

constexpr int VT_PITCH = 4128;
constexpr int SW_BIAS = RING_OFF;
constexpr int SW_WS = SW_BIAS + 8192;
constexpr int SW_STG = SW_WS + 1024;

__device__ __forceinline__ void swa_item(const Ctx& C, const Bufs& B, const float* __restrict__ sinks, int b, int head, int p0, bool meta) {
    const int lane = C.lane, r32 = lane & 31, hh = lane >> 5, g = head >> 3;
    const LAS float* biasl = (const LAS float*)(C.lds + SW_BIAS);
    LAS float* wsf = (LAS float*)(C.lds + SW_WS) + C.wave * 32;
    const int tq = p0 + r32;
    const int tqc = meta ? (tq < NMETA ? tq : NMETA - 1) : tq;
    const int rowq = rowof(b, tqc);
    bf16x8 qf[4];
#pragma unroll
    for (int s = 0; s < 4; ++s) qf[s] = *(const bf16x8*)(B.PROJ + (size_t)rowq * NP1 + PC_QA + head * 64 + 16 * s + 8 * hh);
    const int ntile = meta ? 1 : 6;
    f32x16 S[6];
    bf16x8 kf[6][4];
#pragma unroll
    for (int kt = 0; kt < 6; ++kt) {
        if (kt < ntile) {
            const int k0 = (kt == 0) ? 0 : p0 - 128 + 32 * (kt - 1);
            int kpos = k0 + r32; kpos = kpos < 0 ? 0 : kpos;
            const bf16* kp = B.KV + (size_t)rowof(b, kpos) * 256 + g * 64 + 8 * hh;
#pragma unroll
            for (int s = 0; s < 4; ++s) kf[kt][s] = *(const bf16x8*)(kp + 16 * s);
        }
    }
    __builtin_amdgcn_sched_barrier(0);
#pragma unroll
    for (int kt = 0; kt < 6; ++kt) {
        if (kt < ntile) {
            f32x16 acc = {};
#pragma unroll
            for (int s = 0; s < 4; ++s) acc = __builtin_amdgcn_mfma_f32_32x32x16_bf16(kf[kt][s], qf[s], acc, 0, 0, 0);
            S[kt] = acc;
        } else S[kt] = (f32x16){-INFINITY, -INFINITY, -INFINITY, -INFINITY, -INFINITY, -INFINITY, -INFINITY, -INFINITY, -INFINITY, -INFINITY, -INFINITY, -INFINITY, -INFINITY, -INFINITY, -INFINITY, -INFINITY};
    }
    __builtin_amdgcn_sched_barrier(0);
#pragma unroll
    for (int kt = 0; kt < 6; ++kt) {
        if (kt < ntile) {
            const int k0 = (kt == 0) ? 0 : p0 - 128 + 32 * (kt - 1);
            float bz[16];
#pragma unroll
            for (int i = 0; i < 16; ++i) { const int kp = k0 + (i & 3) + 8 * (i >> 2) + 4 * hh; int d = tq - kp; d = d < 0 ? 0 : (d > 127 ? 127 : d); bz[i] = biasl[d * 16 + head]; }
#pragma unroll
            for (int i = 0; i < 16; ++i) { const int kp = k0 + (i & 3) + 8 * (i >> 2) + 4 * hh; const int d = tq - kp;
                const bool ok = (kt == 0) ? (kp < NMETA && d >= 0) : (kp >= NMETA && d >= 0 && d < 128);
                const float x = 0.125f * S[kt][i] + bz[i];
                S[kt][i] = ok ? x : -INFINITY; }
        }
    }
    const float sink = sinks[head];
    float mx = sink;
#pragma unroll
    for (int kt = 0; kt < 6; ++kt)
#pragma unroll
        for (int i = 0; i < 16; ++i) mx = fmaxf(mx, S[kt][i]);
    mx = fmaxf(mx, __shfl_xor(mx, 32));
    float sum = 0.f;
#pragma unroll
    for (int kt = 0; kt < 6; ++kt)
#pragma unroll
        for (int i = 0; i < 16; ++i) { const float p = __expf(S[kt][i] - mx); S[kt][i] = p; sum += p; }
    sum += __shfl_xor(sum, 32);
    sum += __expf(sink - mx);
    if (hh == 0) wsf[r32] = sum;
    f32x16 O0 = {}, O1 = {};
#pragma unroll
    for (int kt = 0; kt < 6; ++kt) {
        if (kt < ntile) {
            const int k0 = (kt == 0) ? 0 : p0 - 128 + 32 * (kt - 1);
            pg8::u32x2 vl[2][2], vh[2][2];
#pragma unroll
            for (int s2 = 0; s2 < 2; ++s2) { int ka = k0 + 16 * s2 + 4 * hh, kb2 = ka + 8; ka = ka < 0 ? 0 : ka; kb2 = kb2 < 0 ? 0 : kb2;
#pragma unroll
                for (int dt = 0; dt < 2; ++dt) { const bf16* vrow = B.VT + ((size_t)b * 128 + g * 64 + 32 * dt + r32) * VT_PITCH;
                    vl[s2][dt] = *(const pg8::u32x2*)(vrow + ka); vh[s2][dt] = *(const pg8::u32x2*)(vrow + kb2); } }
            __builtin_amdgcn_sched_barrier(0);
#pragma unroll
            for (int s2 = 0; s2 < 2; ++s2) {
                pg8::u32x4 pw; pw.x = cvtpk(S[kt][8 * s2 + 0], S[kt][8 * s2 + 1]); pw.y = cvtpk(S[kt][8 * s2 + 2], S[kt][8 * s2 + 3]); pw.z = cvtpk(S[kt][8 * s2 + 4], S[kt][8 * s2 + 5]); pw.w = cvtpk(S[kt][8 * s2 + 6], S[kt][8 * s2 + 7]);
                const bf16x8 pf = __builtin_bit_cast(bf16x8, pw);
#pragma unroll
                for (int dt = 0; dt < 2; ++dt) { const pg8::u32x4 vw = {vl[s2][dt].x, vl[s2][dt].y, vh[s2][dt].x, vh[s2][dt].y}; const bf16x8 vf = __builtin_bit_cast(bf16x8, vw);
                    if (dt == 0) O0 = __builtin_amdgcn_mfma_f32_32x32x16_bf16(pf, vf, O0, 0, 0, 0); else O1 = __builtin_amdgcn_mfma_f32_32x32x16_bf16(pf, vf, O1, 0, 0, 0); }
            }
            __builtin_amdgcn_sched_barrier(0);
        }
    }
    LDS_WAIT(); asm volatile("" ::: "memory");
    LAS float* stg = (LAS float*)(C.lds + SW_STG) + C.wave * (32 * 68);
#pragma unroll
    for (int i = 0; i < 16; ++i) { const int q = (i & 3) + 8 * (i >> 2) + 4 * hh; stg[q * 68 + r32] = O0[i]; stg[q * 68 + 32 + r32] = O1[i]; }
    LDS_WAIT(); asm volatile("" ::: "memory");
    { const int q = lane >> 1, d0 = (lane & 1) * 32, t = p0 + q;
      if (!meta || t < NMETA) { const int row = rowof(b, t); const float inv = 1.0f / wsf[q];
          const bf16* zp = B.PROJ + (size_t)row * NP1 + PC_ZA + head * 64 + d0; bf16* op = B.YA + (size_t)row * YLD + head * 64 + d0;
#pragma unroll
          for (int hf = 0; hf < 4; ++hf) { const v4u zw = *(const v4u*)(zp + 8 * hf);
              const f32x4 xa = *(const LAS f32x4*)(stg + q * 68 + d0 + 8 * hf) * inv, xb = *(const LAS f32x4*)(stg + q * 68 + d0 + 8 * hf + 4) * inv;
              v4u o; o.x = pk2(xa[0] * siluf_(pg8::bf_lo(zw.x)), xa[1] * siluf_(pg8::bf_hi(zw.x))); o.y = pk2(xa[2] * siluf_(pg8::bf_lo(zw.y)), xa[3] * siluf_(pg8::bf_hi(zw.y)));
              o.z = pk2(xb[0] * siluf_(pg8::bf_lo(zw.z)), xb[1] * siluf_(pg8::bf_hi(zw.z))); o.w = pk2(xb[2] * siluf_(pg8::bf_lo(zw.w)), xb[3] * siluf_(pg8::bf_hi(zw.w)));
              *(v4u*)(op + 8 * hf) = o; } } }
    LDS_WAIT(); asm volatile("" ::: "memory");
}

__device__ __forceinline__ void swa_phase(const Ctx& C, int l) {
    const Bufs B(C.a.ws);
    const Args& A = C.a;
    __syncthreads();
    for (int i = C.tid; i < 128 * 16; i += NWAVES * 64) { const int d = i >> 4, h = i & 15; ((LAS float*)(C.lds + SW_BIAS))[i] = A.bias_table[t5_bucket(d) * 32 + h]; }
    __syncthreads();
    const float* sinks = A.sinks + l * 16;
    for (int it = C.gw; it < 4096 + 32; it += C.NGW) {
        if (it < 4096) { const int blk = it & 127, head = (it >> 7) & 15, b = it >> 11; swa_item(C, B, sinks, b, head, NMETA + 32 * blk, false); }
        else { const int r = it - 4096, head = r & 15, b = r >> 4; swa_item(C, B, sinks, b, head, 0, true); }
    }
    __syncthreads();
}


constexpr int PH_PER_LAYER = 6, N_PHASES = 1 + NLAYER * PH_PER_LAYER + 1;
#ifndef MK_DUP
#define MK_DUP 0
#endif
#ifndef MK_NAIVE_SWA
#define MK_NAIVE_SWA 0
#endif
#ifndef MK_NAIVE_DSA
#define MK_NAIVE_DSA 0
#endif
#ifndef MK_ONE_LAUNCH
#define MK_ONE_LAUNCH 1
#endif

__global__ void __launch_bounds__(NWAVES * 64, 2) fwd_kernel(Args args) {
    extern __shared__ __attribute__((aligned(16))) unsigned char lds[];
    Ctx C;
    C.lds = (LAS unsigned char*)lds; C.tid = threadIdx.x; C.lane = C.tid & 63; C.wave = __builtin_amdgcn_readfirstlane(C.tid >> 6);
    C.G = gridDim.x; C.bid = blockIdx.x; C.gw = blockIdx.x * NWAVES + C.wave; C.NGW = C.G * NWAVES; C.a = args;
    unsigned char* ws = args.ws;
    gu32* ctl = (gu32*)(ws + WS_CTL);
    for (int u = C.tid; u < RING_OFF / 4; u += NWAVES * 64) ((LAS unsigned*)(C.lds + LDSCTL_OFF))[u] = 0u;
    __syncthreads();
    volatile LAS unsigned* MISC = (volatile LAS unsigned*)(C.lds + MISC_OFF);
    XcdBarrier bar; bar.bar = (unsigned*)(ctl + CW_BAR); bar.x = 0; bar.st = nullptr;
    const int lo = args.ph_lo, hi = args.ph_hi;
    const bool one = (hi - lo) > 1;
    if (one) bar = xcd_barrier_post((unsigned*)(ctl + CW_BAR), MISC + 8);
#define IN(k) (lo <= (k) && (k) < hi)
#define PHASE_BEGIN() do { int l_ = (int)__builtin_amdgcn_mbcnt_hi(~0u, __builtin_amdgcn_mbcnt_lo(~0u, 0u)); asm volatile("" : "+v"(l_)); int b_ = blockIdx.x; asm volatile("" : "+s"(b_)); \
    C.lane = l_; C.tid = C.wave * 64 + l_; C.bid = b_; C.gw = b_ * NWAVES + C.wave; } while (0)
#define SEAM(k) do { if (IN((k) + 1)) { PROBE_T0(); xcd_barrier(bar, C.wave == 0 && (int)__builtin_amdgcn_mbcnt_hi(~0u, __builtin_amdgcn_mbcnt_lo(~0u, 0u)) == 0); PROBE_T1(29); } } while (0)
    LAS unsigned char* ring = C.lds + RING_OFF;

    if (IN(0)) { PROBE_T0(); PHASE_BEGIN(); p0_prologue(C); PROBE_T1(20); if (MK_DUP & 128) { PHASE_BEGIN(); p0_prologue(C); } SEAM(0); }
    for (int l = 0; l < NLAYER; ++l) {
        const int p = 1 + l * PH_PER_LAYER;
        if (IN(p)) {
            PHASE_BEGIN(); const Bufs B(ws);
            const bf16* W1l = B.W1 + (size_t)l * NP1 * DM;
            pg8::Gemm g{B.HB, W1l, MR, 8192, DM}; pg8::StaticOrder S; S.init(MR, 8192, C.G, C.bid);
            g1_rstd_table(C, S);
            pg8::EpiProj E{B.PROJ, NP1, (const LAS float*)(C.lds + RSTD_OFF), B.KV};
            { PROBE_T0(); pg8::gemm_phase<pg8::EpiProj, pg8::StaticOrder, true, true>(ring, g, S, E, C.tid); PROBE_T1(21); }
            if (MK_DUP & 1) { PHASE_BEGIN(); pg8::gemm_phase<pg8::EpiProj, pg8::StaticOrder, true, true>(ring, g, S, E, C.tid); }
            PHASE_BEGIN();
            LAS float* tbl = (LAS float*)(C.lds + RSTD_OFF);
            PROBE_T0();
            for (int u = C.bid; u < 256 + 259; u += C.G) {
                if (u < 256) { const int row0 = 32 * u; skinny_rstd(C, B.RS + (size_t)row0 * 32, 32, tbl);
                    skinny_unit<3, 1, false>(C, B.HB + (size_t)row0 * DM, DM, W1l + (size_t)8192 * DM, DM, DM, nullptr, 0, 0, SkProj{B.PROJ + (size_t)row0 * NP1, B.KV + (size_t)row0 * 256, B.KIDX + (size_t)row0 * 64, 8192, tbl}); }
                else { const int gc = u - 256; skinny_rstd(C, B.RS2, 64, tbl);
                    skinny_unit<1, 4, false>(C, B.HB + (size_t)MR * DM, DM, W1l + (size_t)gc * 32 * DM, DM, DM, nullptr, 0, 0, SkProj{B.PROJ + (size_t)MR * NP1, B.KV + (size_t)MR * 256, B.KIDX + (size_t)MR * 64, gc * 32, tbl}); }
            }
            PROBE_T1(22);
            SEAM(p);
        }
        if (IN(p + 1)) { PROBE_T0(); PHASE_BEGIN(); norm_phase(C, l); PROBE_T1(23); if (MK_DUP & 2) { PHASE_BEGIN(); norm_phase(C, l); } SEAM(p + 1); }
        if (IN(p + 2)) {
            PHASE_BEGIN(); const Bufs B(ws);
            const bf16* W2l = B.W2 + (size_t)l * NQ2 * 512;
            pg8::Gemm g{B.CQN, W2l, MR, NQ2, 512}; pg8::StaticOrder S; S.init(MR, NQ2, C.G, C.bid);
            pg8::EpiBf16<0> E{B.Q2, NQ2, nullptr, 0, 0, 1.f};
            PROBE_T0();
            pg8::gemm_phase<pg8::EpiBf16<0>, pg8::StaticOrder, true, true>(ring, g, S, E, C.tid);
            if (MK_DUP & 4) { PHASE_BEGIN(); pg8::gemm_phase<pg8::EpiBf16<0>, pg8::StaticOrder, true, true>(ring, g, S, E, C.tid); }
            PHASE_BEGIN();
            for (int u = C.bid; u < 48; u += C.G) skinny_unit<3, 1, false>(C, B.CQN + (size_t)MR * 512, 512, W2l + (size_t)u * 96 * 512, 512, 512, nullptr, 0, 0, SkQ2{B.Q2 + (size_t)MR * NQ2 + u * 96});
            PROBE_T1(24);
            SEAM(p + 2);
        }
        if (IN(p + 3)) {
            { PROBE_T0(); PHASE_BEGIN(); swa_phase(C, l); PROBE_T1(5); }
            if (MK_DUP & 8) { PHASE_BEGIN(); swa_phase(C, l); }
            { PROBE_T0(); PHASE_BEGIN(); dsa_phase(C, l); PROBE_T1(4); }
            if (MK_DUP & 16) { PHASE_BEGIN(); dsa_phase(C, l); }
            SEAM(p + 3);
        }
        if (IN(p + 4)) {
            PHASE_BEGIN(); const Bufs B(ws);
            const bf16* WABl = B.WA + (size_t)l * DM * 2048;
            pg8::Gemm g{B.YA, WABl, MR, DM, 2048, nullptr, nullptr, 0}; pg8::StaticOrder S; S.init(MR, DM, C.G, C.bid);
            pg8::EpiG4m E{B.MG, B.PROJ + PC_GA, B.PROJ + PC_GB, NP1};
            PROBE_T0();
            pg8::gemm_phase<pg8::EpiG4m, pg8::StaticOrder, true, true>(ring, g, S, E, C.tid);
            PROBE_T1(35);
            PHASE_BEGIN();
            for (int u = C.bid; u < 64; u += C.G) {
                skinny_unit<1, 2, false>(C, B.YA + (size_t)MR * YLD, YLD, WABl + (size_t)u * 32 * 2048, 2048, 1024, nullptr, 0, 0, SkPA{B.PA + (size_t)MR * DM + u * 32, B.PROJ + (size_t)MR * NP1 + PC_GA + u * 32});
                skinny_unit<1, 2, false>(C, B.YB + (size_t)MR * YLD, YLD, WABl + 1024 + (size_t)u * 32 * 2048, 2048, 1024, nullptr, 0, 0, SkMerge{B.MG + (size_t)MR * DM + u * 32, B.PA + (size_t)MR * DM + u * 32, B.PROJ + (size_t)MR * NP1 + PC_GB + u * 32}); }
            PROBE_T1(25);
            SEAM(p + 4);
        }
        if (IN(p + 5)) {
            PHASE_BEGIN(); const Bufs B(ws);
            const bf16* WOl = B.WO + (size_t)l * DM * DM;
            pg8::Gemm g{B.MG, WOl, MR, DM, DM}; pg8::StaticOrder S; S.init(MR, DM, C.G, C.bid);
            pg8::EpiRes E{B.H, B.HB, B.RS};
            PROBE_T0();
            pg8::gemm_phase<pg8::EpiRes, pg8::StaticOrder, true, true>(ring, g, S, E, C.tid);
            PHASE_BEGIN();
            for (int u = C.bid; u < 64; u += C.G) skinny_unit<1, 4, true>(C, B.MG + (size_t)MR * DM, DM, WOl + (size_t)u * 32 * DM, DM, DM, B.RS2, 64, u, SkRes{B.H + (size_t)MR * DM + u * 32, B.HB + (size_t)MR * DM + u * 32});
            PROBE_T1(27);
            SEAM(p + 5);
        }
    }
    if (IN(N_PHASES - 1)) { PHASE_BEGIN(); final_phase(C); }
#undef IN
#undef SEAM
}

extern "C" void kernel_launch(void* const* d_in, const int* in_sizes, int n_in, void* d_out, int out_size, void* d_ws, size_t ws_size, hipStream_t stream) {
    static int grid = 0;
    if (grid == 0) {
        if (n_in != 16 || ws_size < WS_END) { fprintf(stderr, "kernel_launch: unexpected inputs (n_in %d, ws %zu, need %zu)\n", n_in, ws_size, (size_t)WS_END); grid = -1; return; }
        int dev = 0, cus = 0;
        if (hipGetDevice(&dev) != hipSuccess || hipDeviceGetAttribute(&cus, hipDeviceAttributeMultiprocessorCount, dev) != hipSuccess) { grid = -1; return; }
        if (hipFuncSetAttribute((const void*)fwd_kernel, hipFuncAttributeMaxDynamicSharedMemorySize, LDS_BYTES) != hipSuccess) { fprintf(stderr, "kernel_launch: hipFuncSetAttribute failed\n"); grid = -1; return; }
        int per_cu = 0;
        if (hipOccupancyMaxActiveBlocksPerMultiprocessor(&per_cu, (const void*)fwd_kernel, NWAVES * 64, LDS_BYTES) != hipSuccess || per_cu < 1) fprintf(stderr, "kernel_launch: occupancy query says %d\n", per_cu);
        (void)hipGetLastError();
        grid = cus;
    }
    if (grid < 0) return;
    if (hipMemsetAsync((char*)d_ws + WS_CTL, 0, CTL_ZERO_BYTES, stream) != hipSuccess) return;
    Args a{};
    a.x = (const float*)d_in[0]; a.meta = (const float*)d_in[1]; a.bias_table = (const float*)d_in[2]; a.norm_g = (const float*)d_in[3]; a.w_in = (const float*)d_in[4];
    a.q_norm_g = (const float*)d_in[5]; a.kv_norm_g = (const float*)d_in[6]; a.w_qb = (const float*)d_in[7]; a.w_iq = (const float*)d_in[8]; a.w_uk = (const float*)d_in[9];
    a.w_uv = (const float*)d_in[10]; a.sinks = (const float*)d_in[11]; a.w_proj_a = (const float*)d_in[12]; a.w_proj_b = (const float*)d_in[13]; a.w_out = (const float*)d_in[14];
    a.final_g = (const float*)d_in[15]; a.out = (float*)d_out; a.ws = (unsigned char*)d_ws;
#if MK_ONE_LAUNCH
    a.ph_lo = 0; a.ph_hi = N_PHASES;
    hipLaunchKernelGGL(fwd_kernel, dim3(grid), dim3(NWAVES * 64), LDS_BYTES, stream, a);
#else
    for (int p = 0; p < N_PHASES; ++p) { a.ph_lo = p; a.ph_hi = p + 1; hipLaunchKernelGGL(fwd_kernel, dim3(grid), dim3(NWAVES * 64), LDS_BYTES, stream, a); }
#endif
}
```

```cpp
#include <hip/hip_runtime.h>
#include <cstdio>
#include <cstdint>
namespace pg8 {
#define PG8_LAS __attribute__((address_space(3)))
typedef unsigned short bf16_t;
typedef short bf16x8 __attribute__((ext_vector_type(8)));
typedef float f32x4 __attribute__((ext_vector_type(4)));
typedef unsigned u32x4 __attribute__((ext_vector_type(4)));
constexpr int BM = 256, BK = 64, HALF = 128, HTB = HALF * BK * 2  , STAGE_BYTES = 8 * HTB, NXCD = 8, WGM = 8;

__host__ __device__ __forceinline__ int lds_byte(int r, int c) { const int st = (r >> 4) * 2 + (c >> 5), rr = r & 15, cc = c & 31, ob = rr * 64 + cc * 2; return st * 1024 + (ob ^ (((ob >> 9) & 1) << 5)); }
__host__ __device__ __forceinline__ void stage_rc(int b, int& R, int& C) { const int st = b / 1024, sb = b % 1024, swz = sb ^ (((sb >> 9) & 1) << 5); R = (st >> 1) * 16 + swz / 64; C = (st & 1) * 32 + (swz % 64) / 2; }
__host__ __device__ __forceinline__ int perm32(int rho) { const int n = rho >> 4, i = rho & 15; return 8 * (i >> 2) + 4 * n + (i & 3); }

struct Unit { int pm, pn, sel; };
struct Gemm { const bf16_t* A; const bf16_t* Bt; int M, N, K; const bf16_t* A2; const bf16_t* Bt2; int lda; };

struct StaticOrder {
    int nM, nN, nwg, G, c;
    __host__ __device__ void init(int M, int N, int G_, int c_) { nM = M / BM; nN = N / BM; nwg = nM * nN; G = G_; c = c_; }
    __host__ __device__ bool next(int i, Unit& u) const {
        const long L = (long)i * G + c; if (L >= nwg) return false;
        int wgid = (int)L; { const int q = nwg / NXCD, r = nwg % NXCD, xcd = wgid % NXCD, off = wgid / NXCD; wgid = (xcd < r ? xcd * (q + 1) : r * (q + 1) + (xcd - r) * q) + off; }
        const int nig = WGM * nN, gid = wgid / nig, fm = gid * WGM, gsz = (nM - fm) < WGM ? (nM - fm) : WGM;
        u.pm = fm + ((wgid % nig) % gsz); u.pn = (wgid % nig) / gsz; u.sel = 0; return true;
    }
    __device__ __forceinline__ void a_ready(const Unit&) const {}
    __device__ __forceinline__ void done(const Unit&) const {}
};

__device__ __forceinline__ unsigned cvt_pk_bf16(float lo, float hi) { unsigned r; asm volatile("v_cvt_pk_bf16_f32 %0, %1, %2" : "=v"(r) : "v"(lo), "v"(hi)); return r; }
typedef float f32x2 __attribute__((ext_vector_type(2)));
__device__ __forceinline__ f32x2 gelu_pk(f32x2 v) {
    const f32x2 av = __builtin_elementwise_abs(v), d = av * 0.2316418882f + 1.0f;
    f32x2 t; t.x = __builtin_amdgcn_rcpf(d.x); t.y = __builtin_amdgcn_rcpf(d.y);
    f32x2 q = t * 0.5307027145f + (-0.7265760135f); q = q * t + 0.7107068705f; q = q * t + (-0.142248368f); q = q * t + 0.127414796f; q = q * t;
    const f32x2 s = (v * v) * (-0.72134752044f);
    f32x2 e; e.x = __builtin_amdgcn_exp2f(s.x); e.y = __builtin_amdgcn_exp2f(s.y);
    const f32x2 m = v * (q * e), r = v - m;
    f32x2 o; o.x = v.x < 0.f ? m.x : r.x; o.y = v.y < 0.f ? m.y : r.y; return o;
}

template <int ACT  > struct EpiBf16 {
    static constexpr bool PERM = true, AFTER_DRAIN = false; static_assert(ACT == 0 || ACT == 1, "EpiBf16: ACT is 0 (none) or 1 (gelu_pk)");
    bf16_t* O; int ldc; const float* bias; int split_cols; size_t split_stride; float scale0;
    __device__ __forceinline__ void operator()(const f32x4 (&acc)[2][2][4][2], const Unit& u, int ui, int wr, int wc, int fr, int fq) const {
        const int row0 = u.pm * BM + wr * 64 + fr; int colt = u.pn * BM; bf16_t* base = O;
        float sc = 1.f; if (split_cols) { const int t = colt / split_cols; base += (size_t)t * split_stride; colt -= t * split_cols; if (t == 0) sc = scale0; }
        const int col0 = colt + wc * 32 + 8 * fq, bcol0 = u.pn * BM + wc * 32 + 8 * fq;
        f32x4 bv[2][2];
#pragma unroll
        for (int bj = 0; bj < 2; ++bj)
#pragma unroll
            for (int n = 0; n < 2; ++n) bv[bj][n] = bias ? *(const f32x4*)(bias + bcol0 + bj * HALF + 4 * n) : (f32x4){0.f, 0.f, 0.f, 0.f};
#pragma unroll
        for (int ai = 0; ai < 2; ++ai)
#pragma unroll
            for (int m = 0; m < 4; ++m) { bf16_t* rowp = base + (size_t)(row0 + ai * HALF + m * 16) * ldc + col0;
#pragma unroll
                for (int bj = 0; bj < 2; ++bj) { f32x4 v0 = acc[ai][bj][m][0] + bv[bj][0], v1 = acc[ai][bj][m][1] + bv[bj][1];
                    if (ACT == 1) { f32x2 a = gelu_pk((f32x2){v0[0], v0[1]}), b = gelu_pk((f32x2){v0[2], v0[3]}), c = gelu_pk((f32x2){v1[0], v1[1]}), d = gelu_pk((f32x2){v1[2], v1[3]});
                        v0 = (f32x4){a.x, a.y, b.x, b.y}; v1 = (f32x4){c.x, c.y, d.x, d.y}; }
                    v0 = v0 * sc; v1 = v1 * sc; u32x4 w; w.x = cvt_pk_bf16(v0[0], v0[1]); w.y = cvt_pk_bf16(v0[2], v0[3]); w.z = cvt_pk_bf16(v1[0], v1[1]); w.w = cvt_pk_bf16(v1[2], v1[3]);
                    *(u32x4*)(rowp + bj * HALF) = w; } }
    }
};

template <class T, class = void> struct pg8_has_midk { static constexpr bool value = false; };
template <class T> struct pg8_has_midk<T, decltype((void)T::MIDK)> { static constexpr bool value = T::MIDK; };
template <class Epi, class Sched, bool ALIGN_EPI = false, bool SP2 = false>
__device__ __forceinline__ void gemm_phase(PG8_LAS unsigned char* lds, const Gemm g, const Sched& S, const Epi& E, int tid_in) {
    int tid_ = tid_in; asm volatile("" : "+v"(tid_));
    const int tid = tid_, wid = __builtin_amdgcn_readfirstlane(tid >> 6), lane = tid & 63, wr = wid >> 2, wc = wid & 3, fr = lane & 15, fq = lane >> 4;
    const int K = g.K, nt = K / BK, lda = g.lda ? g.lda : K;
    unsigned voffA[2], voffB[2];
#pragma unroll
    for (int i = 0; i < 2; ++i) { int R, C; stage_rc(tid * 16 + i * 8192, R, C); const int Rb = Epi::PERM ? ((R & ~31) + perm32(R & 31)) : R;
        voffA[i] = (unsigned)(R * lda + C) * 2u; voffB[i] = (unsigned)(Rb * K + C) * 2u; }
    const size_t kstep = (size_t)(BK * 2);
    const size_t hstepA = (size_t)HALF * lda * 2, tstepA = 2 * hstepA;
    const size_t hstep = (size_t)HALF * K * 2;
    const size_t tstep = 2 * hstep;
    const unsigned ldsw = (unsigned)wid * 1024u;
    const int aoff = lds_byte(wr * 64 + fr, fq * 8), boff = lds_byte(wc * 32 + fr, fq * 8);
#define PG8_SA(b, h) (((b) * 2 + (h)) * HTB)
#define PG8_SB(b, h) ((4 + (b) * 2 + (h)) * HTB)
#define PG8_STAGE(bufoff, gbase, voff) do { _Pragma("unroll") for (int _i = 0; _i < 2; ++_i) \
        __builtin_amdgcn_global_load_lds((const unsigned*)((const char*)(gbase) + (voff)[_i]), (PG8_LAS unsigned*)(lds + (bufoff) + ldsw + _i * 8192), 16, 0, 0); } while (0)
#define PG8_LDA(dst, b, h) do { _Pragma("unroll") for (int m = 0; m < 4; ++m) _Pragma("unroll") for (int k = 0; k < 2; ++k) dst[m][k] = *(const PG8_LAS bf16x8*)(lds + PG8_SA(b, h) + aoff + m * 2048 + k * 1024); } while (0)
#define PG8_LDB(dst, b, h) do { _Pragma("unroll") for (int n = 0; n < 2; ++n) _Pragma("unroll") for (int k = 0; k < 2; ++k) dst[n][k] = *(const PG8_LAS bf16x8*)(lds + PG8_SB(b, h) + boff + n * 2048 + k * 1024); } while (0)
#define PG8_MMA(ai, bj, At, Bt) do { __builtin_amdgcn_s_setprio(1); _Pragma("unroll") for (int m = 0; m < 4; ++m) _Pragma("unroll") for (int n = 0; n < 2; ++n) _Pragma("unroll") for (int k = 0; k < 2; ++k) \
        acc[ai][bj][m][n] = __builtin_amdgcn_mfma_f32_16x16x32_bf16(Bt[n][k], At[m][k], acc[ai][bj][m][n], 0, 0, 0); __builtin_amdgcn_s_setprio(0); } while (0)
#define PG8_WAIT_V(n) asm volatile("s_waitcnt vmcnt(" #n ")" ::: "memory")
#define PG8_WAIT_L(n) asm volatile("s_waitcnt lgkmcnt(" #n ")" ::: "memory")
#define PG8_BAR __builtin_amdgcn_s_barrier()
#define PG8_SCHED __builtin_amdgcn_sched_barrier(0)
    Unit cur, nxt; int ui = 0;
    if (!S.next(0, cur)) return;
    f32x4 acc[2][2][4][2];
#pragma unroll
    for (int a = 0; a < 2; ++a)
#pragma unroll
        for (int b = 0; b < 2; ++b)
#pragma unroll
            for (int m = 0; m < 4; ++m)
#pragma unroll
                for (int n = 0; n < 2; ++n) acc[a][b][m][n] = (f32x4){0.f, 0.f, 0.f, 0.f};
    bf16x8 At[4][2], B0[2][2], B1[2][2];
    const char* cA = (const char*)(cur.sel ? g.A2 : g.A) + (size_t)cur.pm * tstepA; const char* cB = (const char*)(cur.sel ? g.Bt2 : g.Bt) + (size_t)cur.pn * tstep;
    S.a_ready(cur);
    if constexpr (SP2) {
        PG8_STAGE(PG8_SB(0, 0), cB, voffB); PG8_STAGE(PG8_SB(0, 1), cB + hstep, voffB); PG8_STAGE(PG8_SA(0, 0), cA, voffA); PG8_STAGE(PG8_SA(0, 1), cA + hstepA, voffA);
        if (wr == 1) PG8_BAR;
        PG8_WAIT_V(2); PG8_BAR;
        PG8_STAGE(PG8_SB(1, 0), cB + kstep, voffB); PG8_STAGE(PG8_SA(1, 0), cA + kstep, voffA); PG8_STAGE(PG8_SB(1, 1), cB + hstep + kstep, voffB);
        PG8_WAIT_V(6); PG8_BAR;
    } else {
        PG8_STAGE(PG8_SB(0, 0), cB, voffB); PG8_STAGE(PG8_SA(0, 0), cA, voffA); PG8_STAGE(PG8_SB(0, 1), cB + hstep, voffB); PG8_STAGE(PG8_SA(0, 1), cA + hstepA, voffA);
        if (wr == 1) PG8_BAR;
        PG8_WAIT_V(4); PG8_BAR;
        PG8_STAGE(PG8_SB(1, 0), cB + kstep, voffB); PG8_STAGE(PG8_SA(1, 0), cA + kstep, voffA); PG8_STAGE(PG8_SB(1, 1), cB + hstep + kstep, voffB);
        PG8_WAIT_V(6); PG8_BAR;
    }
    for (;;) {
        const bool has_next = S.next(ui + 1, nxt);
        const char* nA = has_next ? (const char*)(nxt.sel ? g.A2 : g.A) + (size_t)nxt.pm * tstepA : cA; const char* nB = has_next ? (const char*)(nxt.sel ? g.Bt2 : g.Bt) + (size_t)nxt.pn * tstep : cB;
        for (int t = 0; t < nt; t += 2) {
            if constexpr (pg8_has_midk<Epi>::value) { if (t == (nt >> 1)) E.midk(acc, cur, wr, wc, fr, fq); }
            const bool last = (t == nt - 2);
            const char* a1 = cA + (size_t)(t + 1) * kstep;
            const char* a2 = last ? nA : cA + (size_t)(t + 2) * kstep; const char* b2 = last ? nB : cB + (size_t)(t + 2) * kstep;
            const char* a3 = a2 + kstep; const char* b3 = b2 + kstep;
            if (last && has_next) S.a_ready(nxt);
            if constexpr (SP2) {
            PG8_LDB(B0, 0, 0); PG8_LDB(B1, 0, 1); PG8_SCHED; PG8_LDA(At, 0, 0); PG8_STAGE(PG8_SA(1, 1), a1 + hstepA, voffA);
            PG8_WAIT_V(8); PG8_WAIT_L(0); PG8_BAR; PG8_MMA(0, 0, At, B0); PG8_MMA(0, 1, At, B1); PG8_BAR; PG8_SCHED;
            PG8_LDA(At, 0, 1); PG8_STAGE(PG8_SB(0, 0), b2, voffB); PG8_STAGE(PG8_SB(0, 1), b2 + hstep, voffB); PG8_STAGE(PG8_SA(0, 0), a2, voffA);
            PG8_WAIT_V(8); PG8_WAIT_L(0); PG8_BAR; PG8_MMA(1, 0, At, B0); PG8_MMA(1, 1, At, B1); PG8_BAR; PG8_SCHED;
            PG8_LDB(B0, 1, 0); PG8_LDB(B1, 1, 1); PG8_SCHED; PG8_LDA(At, 1, 0); PG8_STAGE(PG8_SA(0, 1), a2 + hstepA, voffA);
            PG8_WAIT_V(8); PG8_WAIT_L(0); PG8_BAR; PG8_MMA(0, 0, At, B0); PG8_MMA(0, 1, At, B1); PG8_BAR; PG8_SCHED;
            PG8_LDA(At, 1, 1); PG8_STAGE(PG8_SB(1, 0), b3, voffB); PG8_STAGE(PG8_SB(1, 1), b3 + hstep, voffB); PG8_STAGE(PG8_SA(1, 0), a3, voffA);
            PG8_WAIT_V(8); PG8_WAIT_L(0); PG8_BAR; PG8_MMA(1, 0, At, B0); PG8_MMA(1, 1, At, B1); PG8_BAR; PG8_SCHED;
            } else {
            PG8_LDB(B0, 0, 0); PG8_SCHED; PG8_LDA(At, 0, 0); PG8_STAGE(PG8_SA(1, 1), a1 + hstepA, voffA);
            PG8_WAIT_L(8); PG8_BAR; PG8_WAIT_L(0); PG8_MMA(0, 0, At, B0); PG8_BAR; PG8_SCHED;
            PG8_LDB(B1, 0, 1); PG8_STAGE(PG8_SB(0, 0), b2, voffB);
            PG8_BAR; PG8_WAIT_L(0); PG8_MMA(0, 1, At, B1); PG8_BAR;
            PG8_LDA(At, 0, 1); PG8_STAGE(PG8_SA(0, 0), a2, voffA);
            PG8_BAR; PG8_WAIT_L(0); PG8_MMA(1, 0, At, B0); PG8_BAR; PG8_SCHED;
            PG8_STAGE(PG8_SB(0, 1), b2 + hstep, voffB);
            PG8_WAIT_V(6); PG8_BAR; PG8_MMA(1, 1, At, B1); PG8_BAR;
            PG8_LDB(B0, 1, 0); PG8_SCHED; PG8_LDA(At, 1, 0); PG8_STAGE(PG8_SA(0, 1), a2 + hstepA, voffA);
            PG8_WAIT_L(8); PG8_BAR; PG8_WAIT_L(0); PG8_MMA(0, 0, At, B0); PG8_BAR; PG8_SCHED;
            PG8_LDB(B1, 1, 1); PG8_STAGE(PG8_SB(1, 0), b3, voffB);
            PG8_BAR; PG8_WAIT_L(0); PG8_MMA(0, 1, At, B1); PG8_BAR;
            PG8_LDA(At, 1, 1); PG8_STAGE(PG8_SA(1, 0), a3, voffA);
            PG8_BAR; PG8_WAIT_L(0); PG8_MMA(1, 0, At, B0); PG8_BAR; PG8_SCHED;
            PG8_STAGE(PG8_SB(1, 1), b3 + hstep, voffB);
            PG8_WAIT_V(6); PG8_BAR; PG8_MMA(1, 1, At, B1); PG8_BAR;
            }
        }
        if constexpr (ALIGN_EPI) { if (wr == 0) PG8_BAR; }
        if constexpr (!Epi::AFTER_DRAIN) { E(acc, cur, ui, wr, wc, fr, fq); S.done(cur); }
        if (!has_next) break;
#pragma unroll
        for (int a = 0; a < 2; ++a)
#pragma unroll
            for (int b = 0; b < 2; ++b)
#pragma unroll
                for (int m = 0; m < 4; ++m)
#pragma unroll
                    for (int n = 0; n < 2; ++n) acc[a][b][m][n] = (f32x4){0.f, 0.f, 0.f, 0.f};
        cur = nxt; cA = nA; cB = nB; ++ui;
        if constexpr (ALIGN_EPI) { if (wr == 1) PG8_BAR; }
    }
    PG8_WAIT_V(0);
    if constexpr (!ALIGN_EPI) { if (wr == 0) PG8_BAR; }
    PG8_BAR;
    if constexpr (Epi::AFTER_DRAIN) { E.fused(acc, cur, wr, wc, fr, fq, lds, wid, lane); S.done(cur); }
#undef PG8_SA
#undef PG8_SB
#undef PG8_STAGE
#undef PG8_LDA
#undef PG8_LDB
#undef PG8_MMA
#undef PG8_WAIT_V
#undef PG8_WAIT_L
#undef PG8_BAR
#undef PG8_SCHED
}
}
namespace pg8 {
__device__ __forceinline__ float bf_lo(unsigned w) { return __uint_as_float(w << 16); }
__device__ __forceinline__ float bf_hi(unsigned w) { return __uint_as_float(w & 0xffff0000u); }
__device__ __forceinline__ float sigm(float x) { return 1.0f / (1.0f + __expf(-x)); }
typedef unsigned u32x2 __attribute__((ext_vector_type(2)));

template <bool G1>
struct EpiProjT {
    static constexpr bool PERM = true, AFTER_DRAIN = false;
    bf16_t* O; int ldc; const PG8_LAS float* rstd; bf16_t* KV; float* RSQ;
    static constexpr int kvtile = 4, sqtile = 9;
    __device__ __forceinline__ void operator()(const f32x4 (&acc)[2][2][4][2], const Unit& u, int ui, int wr, int wc, int fr, int fq) const {
        const int rt0 = wr * 64 + fr, col0 = u.pn * BM + wc * 32 + 8 * fq;
        const bool sq = G1 && (u.pn == sqtile || u.pn == sqtile + 1);
#pragma unroll
        for (int ai = 0; ai < 2; ++ai)
#pragma unroll
            for (int m = 0; m < 4; ++m) { const int rt = rt0 + ai * HALF + m * 16; const float s = rstd[ui * 256 + rt];
                bf16_t* rowp = O + (size_t)(u.pm * BM + rt) * ldc + col0;
                if constexpr (G1) { if (u.pn == kvtile) rowp = KV + (size_t)(u.pm * BM + rt) * 256 + wc * 32 + 8 * fq; }
                float ss = 0.f;
#pragma unroll
                for (int bj = 0; bj < 2; ++bj) { const f32x4 v0 = acc[ai][bj][m][0] * s, v1 = acc[ai][bj][m][1] * s;
                    ss += (v0[0] * v0[0] + v0[1] * v0[1]) + (v0[2] * v0[2] + v0[3] * v0[3]) + (v1[0] * v1[0] + v1[1] * v1[1]) + (v1[2] * v1[2] + v1[3] * v1[3]);
                    u32x4 w; w.x = cvt_pk_bf16(v0[0], v0[1]); w.y = cvt_pk_bf16(v0[2], v0[3]); w.z = cvt_pk_bf16(v1[0], v1[1]); w.w = cvt_pk_bf16(v1[2], v1[3]);
                    *(u32x4*)(rowp + bj * HALF) = w; }
                if constexpr (G1) if (sq) { ss += __shfl_xor(ss, 16); ss += __shfl_xor(ss, 32); if (fq == 0) RSQ[(size_t)(u.pm * BM + rt) * 8 + (u.pn - sqtile) * 4 + wc] = ss; } }
    }
};
struct EpiPA {
    static constexpr bool PERM = false, AFTER_DRAIN = false;
    float* P; const bf16_t* G; int ldg;
    __device__ __forceinline__ void operator()(const f32x4 (&acc)[2][2][4][2], const Unit& u, int ui, int wr, int wc, int fr, int fq) const {
        const int col0 = u.pn * BM + wc * 32 + 4 * fq;
#pragma unroll
        for (int ai = 0; ai < 2; ++ai)
#pragma unroll
            for (int m = 0; m < 4; ++m) { const int row = u.pm * BM + ai * HALF + wr * 64 + m * 16 + fr;
#pragma unroll
                for (int bj = 0; bj < 2; ++bj)
#pragma unroll
                    for (int n = 0; n < 2; ++n) { const int c = col0 + bj * HALF + n * 16; const u32x2 g = *(const u32x2*)(G + (size_t)row * ldg + c);
                        f32x4 v = acc[ai][bj][m][n]; v[0] *= sigm(bf_lo(g.x)); v[1] *= sigm(bf_hi(g.x)); v[2] *= sigm(bf_lo(g.y)); v[3] *= sigm(bf_hi(g.y));
                        *(f32x4*)(P + (size_t)row * 2048 + c) = v; } }
    }
};
struct EpiMerge {
    static constexpr bool PERM = true, AFTER_DRAIN = false;
    bf16_t* O; const float* P; const bf16_t* G; int ldg;
    __device__ __forceinline__ void operator()(const f32x4 (&acc)[2][2][4][2], const Unit& u, int ui, int wr, int wc, int fr, int fq) const {
        const int col0 = u.pn * BM + wc * 32 + 8 * fq;
#pragma unroll
        for (int ai = 0; ai < 2; ++ai)
#pragma unroll
            for (int m = 0; m < 4; ++m) { const int row = u.pm * BM + ai * HALF + wr * 64 + m * 16 + fr;
#pragma unroll
                for (int bj = 0; bj < 2; ++bj) { const int c = col0 + bj * HALF; const u32x4 g = *(const u32x4*)(G + (size_t)row * ldg + c);
                    const f32x4 p0 = *(const f32x4*)(P + (size_t)row * 2048 + c), p1 = *(const f32x4*)(P + (size_t)row * 2048 + c + 4);
                    f32x4 v0 = acc[ai][bj][m][0], v1 = acc[ai][bj][m][1];
                    v0[0] = p0[0] + sigm(bf_lo(g.x)) * v0[0]; v0[1] = p0[1] + sigm(bf_hi(g.x)) * v0[1]; v0[2] = p0[2] + sigm(bf_lo(g.y)) * v0[2]; v0[3] = p0[3] + sigm(bf_hi(g.y)) * v0[3];
                    v1[0] = p1[0] + sigm(bf_lo(g.z)) * v1[0]; v1[1] = p1[1] + sigm(bf_hi(g.z)) * v1[1]; v1[2] = p1[2] + sigm(bf_lo(g.w)) * v1[2]; v1[3] = p1[3] + sigm(bf_hi(g.w)) * v1[3];
                    u32x4 w; w.x = cvt_pk_bf16(v0[0], v0[1]); w.y = cvt_pk_bf16(v0[2], v0[3]); w.z = cvt_pk_bf16(v1[0], v1[1]); w.w = cvt_pk_bf16(v1[2], v1[3]);
                    *(u32x4*)(O + (size_t)row * 2048 + c) = w; } }
    }
};
struct EpiG4 {
    static constexpr bool PERM = true, AFTER_DRAIN = false;
    bf16_t* O; float* P; const bf16_t* GA; const bf16_t* GB; int ldg;
    __device__ __forceinline__ void operator()(const f32x4 (&acc)[2][2][4][2], const Unit& u, int ui, int wr, int wc, int fr, int fq) const {
        const int col0 = u.pn * BM + wc * 32 + 8 * fq;
        const bf16_t* G = u.sel ? GB : GA;
#pragma unroll
        for (int ai = 0; ai < 2; ++ai)
#pragma unroll
            for (int m = 0; m < 4; ++m) { const int row = u.pm * BM + ai * HALF + wr * 64 + m * 16 + fr;
#pragma unroll
                for (int bj = 0; bj < 2; ++bj) { const int c = col0 + bj * HALF; const u32x4 g = *(const u32x4*)(G + (size_t)row * ldg + c);
                    f32x4 v0 = acc[ai][bj][m][0], v1 = acc[ai][bj][m][1];
                    v0[0] *= sigm(bf_lo(g.x)); v0[1] *= sigm(bf_hi(g.x)); v0[2] *= sigm(bf_lo(g.y)); v0[3] *= sigm(bf_hi(g.y));
                    v1[0] *= sigm(bf_lo(g.z)); v1[1] *= sigm(bf_hi(g.z)); v1[2] *= sigm(bf_lo(g.w)); v1[3] *= sigm(bf_hi(g.w));
                    float* pp = P + (size_t)row * 2048 + c;
                    if (u.sel == 0) { *(f32x4*)pp = v0; *(f32x4*)(pp + 4) = v1; }
                    else { v0 += *(const f32x4*)pp; v1 += *(const f32x4*)(pp + 4);
                        u32x4 w; w.x = cvt_pk_bf16(v0[0], v0[1]); w.y = cvt_pk_bf16(v0[2], v0[3]); w.z = cvt_pk_bf16(v1[0], v1[1]); w.w = cvt_pk_bf16(v1[2], v1[3]);
                        *(u32x4*)(O + (size_t)row * 2048 + c) = w; } } }
    }
};
struct EpiG4m {
    static constexpr bool PERM = true, AFTER_DRAIN = false, MIDK = true;
    bf16_t* O; const bf16_t* GA; const bf16_t* GB; int ldg;
    __device__ __forceinline__ void midk(f32x4 (&acc)[2][2][4][2], const Unit& u, int wr, int wc, int fr, int fq) const {
        asm volatile("" : "+v"(fr), "+v"(fq));
        const int col0 = u.pn * BM + wc * 32 + 8 * fq;
#pragma unroll
        for (int ai = 0; ai < 2; ++ai)
#pragma unroll
            for (int m = 0; m < 4; ++m) { const size_t ro = (size_t)(u.pm * BM + ai * HALF + wr * 64 + m * 16 + fr) * ldg;
#pragma unroll
                for (int bj = 0; bj < 2; ++bj) { const int c = col0 + bj * HALF; const u32x4 a = *(const u32x4*)(GA + ro + c), b = *(const u32x4*)(GB + ro + c);
#define PG8_RHO(x, y) ((1.0f + __expf(-(y))) / (1.0f + __expf(-(x))))
                    f32x4& v0 = acc[ai][bj][m][0]; f32x4& v1 = acc[ai][bj][m][1];
                    v0[0] *= PG8_RHO(bf_lo(a.x), bf_lo(b.x)); v0[1] *= PG8_RHO(bf_hi(a.x), bf_hi(b.x)); v0[2] *= PG8_RHO(bf_lo(a.y), bf_lo(b.y)); v0[3] *= PG8_RHO(bf_hi(a.y), bf_hi(b.y));
                    v1[0] *= PG8_RHO(bf_lo(a.z), bf_lo(b.z)); v1[1] *= PG8_RHO(bf_hi(a.z), bf_hi(b.z)); v1[2] *= PG8_RHO(bf_lo(a.w), bf_lo(b.w)); v1[3] *= PG8_RHO(bf_hi(a.w), bf_hi(b.w));
#undef PG8_RHO
                }
                asm volatile("" ::: "memory"); }
    }
    __device__ __forceinline__ void operator()(const f32x4 (&acc)[2][2][4][2], const Unit& u, int ui, int wr, int wc, int fr, int fq) const {
        const int col0 = u.pn * BM + wc * 32 + 8 * fq;
#pragma unroll
        for (int ai = 0; ai < 2; ++ai)
#pragma unroll
            for (int m = 0; m < 4; ++m) { const int row = u.pm * BM + ai * HALF + wr * 64 + m * 16 + fr;
#pragma unroll
                for (int bj = 0; bj < 2; ++bj) { const int c = col0 + bj * HALF; const u32x4 g = *(const u32x4*)(GB + (size_t)row * ldg + c);
                    f32x4 v0 = acc[ai][bj][m][0], v1 = acc[ai][bj][m][1];
                    v0[0] *= sigm(bf_lo(g.x)); v0[1] *= sigm(bf_hi(g.x)); v0[2] *= sigm(bf_lo(g.y)); v0[3] *= sigm(bf_hi(g.y));
                    v1[0] *= sigm(bf_lo(g.z)); v1[1] *= sigm(bf_hi(g.z)); v1[2] *= sigm(bf_lo(g.w)); v1[3] *= sigm(bf_hi(g.w));
                    u32x4 w; w.x = cvt_pk_bf16(v0[0], v0[1]); w.y = cvt_pk_bf16(v0[2], v0[3]); w.z = cvt_pk_bf16(v1[0], v1[1]); w.w = cvt_pk_bf16(v1[2], v1[3]);
                    *(u32x4*)(O + (size_t)row * 2048 + c) = w; } }
    }
};
struct DualOrder : StaticOrder {
    __host__ __device__ bool next(int i, Unit& u) const { if (!StaticOrder::next(i >> 1, u)) return false; u.sel = i & 1; return true; }
};
struct EpiRes {
    static constexpr bool PERM = false, AFTER_DRAIN = false;
    bf16_t* HB; float* RS;
    __device__ __forceinline__ void operator()(const f32x4 (&acc)[2][2][4][2], const Unit& u, int ui, int wr, int wc, int fr, int fq) const {
        const int col0 = u.pn * BM + wc * 32 + 4 * fq;
#pragma unroll
        for (int ai = 0; ai < 2; ++ai)
#pragma unroll
            for (int m = 0; m < 4; ++m) { const int row = u.pm * BM + ai * HALF + wr * 64 + m * 16 + fr; float ss = 0.f;
#pragma unroll
                for (int bj = 0; bj < 2; ++bj)
#pragma unroll
                    for (int n = 0; n < 2; ++n) { const size_t off = (size_t)row * 2048 + col0 + bj * HALF + n * 16;
                        const u32x2 ho = *(const u32x2*)(HB + off);
                        f32x4 hv = {bf_lo(ho.x), bf_hi(ho.x), bf_lo(ho.y), bf_hi(ho.y)}; hv += acc[ai][bj][m][n];
                        u32x2 w; w.x = cvt_pk_bf16(hv[0], hv[1]); w.y = cvt_pk_bf16(hv[2], hv[3]); *(u32x2*)(HB + off) = w;
                        ss += (hv[0] * hv[0] + hv[1] * hv[1]) + (hv[2] * hv[2] + hv[3] * hv[3]); }
                ss += __shfl_xor(ss, 16); ss += __shfl_xor(ss, 32);
                if (fq == 0) RS[(size_t)row * 32 + u.pn * 4 + wc] = ss; }
    }
};
}

#define GAS __attribute__((address_space(1)))
#define LAS __attribute__((address_space(3)))
typedef unsigned short bf16;
typedef unsigned v4u __attribute__((ext_vector_type(4)));
typedef float f32x4 __attribute__((ext_vector_type(4)));
typedef short bf16x8 __attribute__((ext_vector_type(8)));
typedef GAS unsigned gu32;
typedef GAS unsigned long long gu64;
#define RLX_AGENT __ATOMIC_RELAXED, __HIP_MEMORY_SCOPE_AGENT
#define LDS_WAIT() asm volatile("s_waitcnt lgkmcnt(0)" ::: "memory")
#define VM_WAIT() asm volatile("s_waitcnt vmcnt(0)" ::: "memory")
__device__ __forceinline__ unsigned long long rt() { return __builtin_amdgcn_s_memrealtime(); }
__device__ __forceinline__ unsigned f2bf(float f) { unsigned u = __builtin_bit_cast(unsigned, f); return (u + 0x7fffu + ((u >> 16) & 1u)) >> 16; }
__device__ __forceinline__ unsigned pk2(float lo, float hi) { return f2bf(lo) | (f2bf(hi) << 16); }

#define XB_TMO      128
#define XB_XCNT(j)  (256  + 64 * (j))
#define XB_XSUB(j)  (1280 + 64 * (j))
#define XB_XGEN(j)  (2304 + 64 * (j))
#define XB_TOP      3328
#define XB_TOPGEN   3392
#define XCD_BAR_WORDS 3456
#define XB_SPIN_CAP (1u << 18)

__device__ __forceinline__ unsigned xb_ld(unsigned* p)              { return __hip_atomic_load(p, __ATOMIC_RELAXED, __HIP_MEMORY_SCOPE_AGENT); }
__device__ __forceinline__ unsigned xb_add(unsigned* p, unsigned v) { return __hip_atomic_fetch_add(p, v, __ATOMIC_RELAXED, __HIP_MEMORY_SCOPE_AGENT); }
__device__ __forceinline__ unsigned xb_xcc_id() { return (unsigned)__builtin_amdgcn_s_getreg((3 << 11) | 20) & 0xFu; }
#define XB_SPIN(cond, bar) do { unsigned _sp = 0; while (cond) { __builtin_amdgcn_s_sleep(1); \
    if ((++_sp & 255u) == 0u) { if (xb_ld(&(bar)[XB_TMO])) break; if (_sp > XB_SPIN_CAP) { atomicAdd(&(bar)[XB_TMO], 1u); break; } } } } while (0)

struct XcdBarrier {
    unsigned* bar; unsigned x;
    volatile LAS unsigned* st;
};

__device__ __forceinline__ XcdBarrier xcd_barrier_post(unsigned* bar, volatile LAS unsigned* st) {
    XcdBarrier b; b.bar = bar; b.x = xb_xcc_id(); b.st = st;
    if (threadIdx.x == 0) (void)xb_add(&bar[XB_XCNT(b.x)], 1u);
    return b;
}
__device__ __forceinline__ void xcd_barrier_complete(unsigned* bar, unsigned x, unsigned& nloc, unsigned& nx) {
    const unsigned G = gridDim.x * gridDim.y * gridDim.z;
    unsigned sum, cnt, mine, sp = 0u;
    for (;;) {
        sum = 0u; cnt = 0u; mine = 0u;
#pragma unroll
        for (unsigned j = 0; j < 16; ++j) { const unsigned c = xb_ld(&bar[XB_XCNT(j)]); sum += c; cnt += (c > 0u) ? 1u : 0u; mine = (j == x) ? c : mine; }
        if (sum == G) break;
        __builtin_amdgcn_s_sleep(1);
        if ((++sp & 255u) == 0u) { if (xb_ld(&bar[XB_TMO])) break; if (sp > XB_SPIN_CAP) { atomicAdd(&bar[XB_TMO], 1u); break; } }
    }
    nloc = mine > 0u ? mine : 1u; nx = cnt > 0u ? cnt : 1u;
}

__device__ __forceinline__ void xcd_barrier(const XcdBarrier& b, bool thread0) {
    asm volatile("s_waitcnt vmcnt(0)" ::: "memory");
    __syncthreads();
    if (thread0) {
        unsigned* bar = b.bar;
        __builtin_amdgcn_s_waitcnt(0);
        unsigned nloc = b.st[0], nx = b.st[1];
        if (nloc == 0u) { xcd_barrier_complete(bar, b.x, nloc, nx); b.st[0] = nloc; b.st[1] = nx; }
        const unsigned old = xb_add(&bar[XB_XSUB(b.x)], 1u);
        const unsigned gen = old / nloc;
        if (old + 1u == (gen + 1u) * nloc) {
            __builtin_amdgcn_fence(__ATOMIC_RELEASE, "agent");
            asm volatile("s_waitcnt vmcnt(0)" ::: "memory");
            const unsigned og = xb_add(&bar[XB_TOP], 1u);
            const unsigned tg = og / nx;
            if (og + 1u == (tg + 1u) * nx) xb_add(&bar[XB_TOPGEN], 1u);
            else XB_SPIN(xb_ld(&bar[XB_TOPGEN]) == tg, bar);
            __builtin_amdgcn_fence(__ATOMIC_ACQUIRE, "agent");
            xb_add(&bar[XB_XGEN(b.x)], 1u);
            asm volatile("s_waitcnt vmcnt(0)" ::: "memory");
        } else {
            XB_SPIN(xb_ld(&bar[XB_XGEN(b.x)]) == gen, bar);
            __builtin_amdgcn_fence(__ATOMIC_ACQUIRE, "agent");
            asm volatile("s_waitcnt vmcnt(0)" ::: "memory");
        }
    }
    __syncthreads();
}
#ifndef MK_PROBE
#define MK_PROBE (-1)
#endif
#ifndef MK_PROBE_SCALE
#define MK_PROBE_SCALE 4e-6f
#endif
#define PROBE_T0() unsigned long long pt0_ = 0; if (MK_PROBE >= 0) { pt0_ = __builtin_amdgcn_s_memtime(); asm volatile("s_waitcnt lgkmcnt(0)" ::: "memory"); }
#define PROBE_T1(id) do { if (MK_PROBE == (id)) { const unsigned long long pt1_ = __builtin_amdgcn_s_memtime(); asm volatile("s_waitcnt lgkmcnt(0)" ::: "memory"); \
    if (C.bid == 0 && C.wave == 0 && C.lane == 0) { volatile LAS unsigned* pw_ = (volatile LAS unsigned*)(C.lds + MISC_OFF + 64); pw_[0] = pw_[0] + (unsigned)(pt1_ - pt0_); } } } while (0)
constexpr int NWAVES = 8;
constexpr int NLAYER = 4, DM = 2048, NBATCH = 2, SEQ = 4096, NMETA = 16, LTOK = SEQ + NMETA, NTOK = NBATCH * LTOK;
constexpr int MP = 8448;
constexpr int NP1 = 8448;
constexpr int NC_IN = 8264;
constexpr int PC_QA = 0, PC_KA = 1024, PC_VA = 1152, PC_ZA = 1280, PC_CQ = 2304, PC_CKV = 2816, PC_ZB = 3072, PC_GA = 4096, PC_GB = 6144, PC_KIDX = 8192, PC_WIDX = 8256;
constexpr int NQ2 = 4608;
constexpr int TOPK = 256;
constexpr int YLD = 2048;
constexpr float RMS_EPS = 1e-6f;

__device__ __forceinline__ int rowof(int b, int t) { return t < NMETA ? 8192 + b * NMETA + t : b * SEQ + (t - NMETA); }
__device__ __forceinline__ int t5_bucket(int d) {
    const int n = d < 0 ? 0 : d;
    if (n < 16) return n;
    return 16 + (n >= 19) + (n >= 21) + (n >= 24) + (n >= 27) + (n >= 31) + (n >= 35) + (n >= 40) + (n >= 46) + (n >= 52) + (n >= 59) + (n >= 67) + (n >= 77) + (n >= 87) + (n >= 99) + (n >= 113);
}
__device__ __forceinline__ float bf2f(bf16 v) { return __uint_as_float((unsigned)v << 16); }
__device__ __forceinline__ float sigmoidf_(float x) { return 1.0f / (1.0f + __expf(-x)); }
__device__ __forceinline__ float siluf_(float x) { return x / (1.0f + __expf(-x)); }
__device__ __forceinline__ float wave_sum(float v) {
#pragma unroll
    for (int o = 1; o < 64; o <<= 1) v += __shfl_xor(v, o);
    return v;
}
__device__ __forceinline__ float wave_max(float v) {
#pragma unroll
    for (int o = 1; o < 64; o <<= 1) v = fmaxf(v, __shfl_xor(v, o));
    return v;
}
__device__ __forceinline__ int wave_sum_i(int v) {
#pragma unroll
    for (int o = 1; o < 64; o <<= 1) v += __shfl_xor(v, o);
    return v;
}

constexpr size_t MiB = 1u << 20;
constexpr size_t WS_CTL = 0, CTL_ZERO_BYTES = 1 * MiB;
constexpr size_t SZ_W1 = (size_t)NLAYER * NP1 * DM * 2, SZ_W2 = (size_t)NLAYER * NQ2 * 512 * 2, SZ_WA = (size_t)NLAYER * DM * 1024 * 2, SZ_WO = (size_t)NLAYER * DM * DM * 2;
constexpr size_t al(size_t x) { return (x + 4095) / 4096 * 4096; }
constexpr size_t WS_W1 = 1 * MiB, WS_W2 = WS_W1 + al(SZ_W1), WS_WA = WS_W2 + al(SZ_W2), WS_WB = WS_WA + 1024 * 2, WS_WO = WS_WA + al(2 * SZ_WA);
constexpr size_t SZ_WUV = (size_t)NLAYER * 16 * 64 * 256 * 2;
constexpr size_t WS_WUV = WS_WO + al(SZ_WO);
constexpr size_t WS_VT = WS_WUV + al(SZ_WUV);
constexpr size_t WS_KV = WS_VT + al((size_t)2 * 128 * 4128 * 2), WS_KIDX = WS_KV + al((size_t)MP * 256 * 2);
constexpr size_t WS_H = WS_KIDX + al((size_t)MP * 64 * 2), WS_HB = WS_H + al((size_t)MP * DM * 4), WS_RS = WS_HB + al((size_t)MP * DM * 2);
constexpr size_t WS_RS2 = WS_RS + al((size_t)MP * 32 * 4);
constexpr size_t WS_RSQ = WS_RS2 + al((size_t)32 * 64 * 4), WS_RSQ2 = WS_RSQ + al((size_t)MP * 8 * 4);
constexpr size_t WS_PROJ = WS_RSQ2 + al((size_t)32 * 16 * 4), WS_CQN = WS_PROJ + al((size_t)MP * NP1 * 2), WS_CKVN = WS_CQN + al((size_t)MP * 512 * 2);
constexpr size_t WS_Q2 = WS_CKVN + al((size_t)MP * 256 * 2), WS_OLAT = WS_Q2 + al((size_t)MP * NQ2 * 2), WS_YA = WS_OLAT + al((size_t)256 * 3 * 16 * 8 * 64 * 8 * 2);
constexpr size_t WS_YB = WS_YA + 1024 * 2, WS_PA = WS_YA + al((size_t)MP * 2048 * 2),
 WS_MG = WS_PA + al((size_t)MP * DM * 4), WS_END = WS_MG + al((size_t)MP * DM * 2);
constexpr int CW_TMO = 0, CW_CODE = 1, CW_BAR = 4096;

constexpr int LDSCTL_OFF = 0, MISC_OFF = LDSCTL_OFF + 320;
constexpr int RSTD_OFF = 512;
constexpr int RING_OFF = 8192, RING_BYTES = 131072;
constexpr int LDS_BYTES = 163840;
static_assert(RSTD_OFF + 5 * 256 * 4 <= RING_OFF, "LDS map");

struct Args {
    const float* x; const float* meta; const float* bias_table; const float* norm_g; const float* w_in; const float* q_norm_g; const float* kv_norm_g; const float* w_qb; const float* w_iq;
    const float* w_uk; const float* w_uv; const float* sinks; const float* w_proj_a; const float* w_proj_b; const float* w_out; const float* final_g;
    float* out; unsigned char* ws; int ph_lo, ph_hi;
};

struct XDesc { const float* W; const float* scale; bf16* out; int ldw, k0, c0, nvalid, K; };
__device__ __forceinline__ void xpose_load(const XDesc& d, float (&v)[32], int lane) {
    asm volatile("" : "+v"(lane));
    const int c = lane & 31; const float* p = d.W + (size_t)(d.k0 + (lane >> 5)) * d.ldw + d.c0 + c;
#pragma unroll
    for (int i = 0; i < 32; ++i) v[i] = (c < d.nvalid) ? p[(size_t)(2 * i) * d.ldw] : 0.f;
    if (d.scale) {
#pragma unroll
        for (int i = 0; i < 32; ++i) v[i] *= d.scale[d.k0 + 2 * i + (lane >> 5)];
    }
}
__device__ __forceinline__ void xpose_store(const XDesc& d, const float (&v)[32], LAS float* scr, int lane) {
    asm volatile("" : "+v"(lane));
    const int c = lane & 31;
#pragma unroll
    for (int i = 0; i < 32; ++i) scr[(2 * i + (lane >> 5)) * 33 + c] = v[i];
    LDS_WAIT(); asm volatile("" ::: "memory");
    const int cc = lane & 7;
#pragma unroll
    for (int j = 0; j < 4; ++j) { const int n = (lane >> 3) + 8 * j; const LAS float* s = scr + (8 * cc) * 33 + n;
        v4u o; o.x = pk2(s[0 * 33], s[1 * 33]); o.y = pk2(s[2 * 33], s[3 * 33]); o.z = pk2(s[4 * 33], s[5 * 33]); o.w = pk2(s[6 * 33], s[7 * 33]);
        *(GAS v4u*)(d.out + (size_t)n * d.K + d.k0 + 8 * cc) = o; }
    LDS_WAIT(); asm volatile("" ::: "memory");
}
__device__ __forceinline__ void fold_item(const float* __restrict__ wqb, const float* __restrict__ wuk, const float* __restrict__ gq, bf16* W2l, int h, int kb, int rb, LAS float* scr, int lane) {
    const int rr = lane & 31, r = rb * 32 + rr;
    float uk[64];
#pragma unroll
    for (int d = 0; d < 64; ++d) uk[d] = wuk[((size_t)h * 64 + d) * 256 + r];
    for (int i = 0; i < 32; ++i) { const int kk = 2 * i + (lane >> 5), k = kb * 64 + kk; const f32x4* qp = (const f32x4*)(wqb + (size_t)k * 1024 + h * 64); float a = 0.f;
#pragma unroll
        for (int d4 = 0; d4 < 16; ++d4) { const f32x4 q = qp[d4]; a = fmaf(q[0], uk[4 * d4], a); a = fmaf(q[1], uk[4 * d4 + 1], a); a = fmaf(q[2], uk[4 * d4 + 2], a); a = fmaf(q[3], uk[4 * d4 + 3], a); }
        scr[kk * 33 + rr] = a * gq[k]; }
    LDS_WAIT(); asm volatile("" ::: "memory");
    const int cc = lane & 7; bf16* out = W2l + (size_t)(h * 256 + rb * 32) * 512;
#pragma unroll
    for (int j = 0; j < 4; ++j) { const int n = (lane >> 3) + 8 * j; const LAS float* s = scr + (8 * cc) * 33 + n;
        v4u o; o.x = pk2(s[0 * 33], s[1 * 33]); o.y = pk2(s[2 * 33], s[3 * 33]); o.z = pk2(s[4 * 33], s[5 * 33]); o.w = pk2(s[6 * 33], s[7 * 33]);
        *(GAS v4u*)(out + (size_t)n * 512 + kb * 64 + 8 * cc) = o; }
    LDS_WAIT(); asm volatile("" ::: "memory");
}

struct Ctx {
    LAS unsigned char* lds; int tid, lane, wave, G, gw, NGW, bid;
    Args a;
};
#if defined(__HIP_DEVICE_COMPILE__)
#define ASSUME_GLOBAL(p) do { __builtin_assume(!__builtin_amdgcn_is_shared((const void*)(p))); __builtin_assume(!__builtin_amdgcn_is_private((const void*)(p))); } while (0)
#else
#define ASSUME_GLOBAL(p) do { } while (0)
#endif
__device__ __forceinline__ unsigned char* launder(unsigned char* p) { size_t z = 0; asm volatile("" : "+s"(z)); return p + z; }
__device__ __forceinline__ const float* launderf(const float* p) { size_t z = 0; asm volatile("" : "+s"(z)); return p + z; }
struct Bufs {
    bf16 *W1, *W2, *WA, *WB, *WO, *WUV, *VT, *KV, *KIDX, *HB, *PROJ, *CQN, *CKVN, *Q2, *OLAT, *YA, *YB, *MG; float *H, *RS, *RS2, *RSQ, *RSQ2, *PA;
    __device__ __forceinline__ explicit Bufs(unsigned char* ws0) {
        unsigned char* ws = launder(ws0);
        W1 = (bf16*)(ws + WS_W1); W2 = (bf16*)(ws + WS_W2); WA = (bf16*)(ws + WS_WA); WB = (bf16*)(ws + WS_WB); WO = (bf16*)(ws + WS_WO); WUV = (bf16*)(ws + WS_WUV); VT = (bf16*)(ws + WS_VT); KV = (bf16*)(ws + WS_KV); KIDX = (bf16*)(ws + WS_KIDX);
        H = (float*)(ws + WS_H); HB = (bf16*)(ws + WS_HB); RS = (float*)(ws + WS_RS); RS2 = (float*)(ws + WS_RS2); RSQ = (float*)(ws + WS_RSQ); RSQ2 = (float*)(ws + WS_RSQ2); PROJ = (bf16*)(ws + WS_PROJ); CQN = (bf16*)(ws + WS_CQN); CKVN = (bf16*)(ws + WS_CKVN);
        Q2 = (bf16*)(ws + WS_Q2); OLAT = (bf16*)(ws + WS_OLAT); YA = (bf16*)(ws + WS_YA); YB = (bf16*)(ws + WS_YB); PA = (float*)(ws + WS_PA); MG = (bf16*)(ws + WS_MG);
    }
};

__device__ __forceinline__ void p0_prologue(const Ctx& C) {
    const Bufs B(C.a.ws);
    const Args& A = C.a;
    LAS float* scr = (LAS float*)(C.lds + RING_OFF + C.wave * 16384);
    constexpr int I_T1 = (DM / 64) * (NP1 / 32), I_T2 = (512 / 64) * (512 / 32), I_T3 = (1024 / 64) * (DM / 32), I_T5 = (DM / 64) * (DM / 32), I_F = 16 * 8 * 8, I_UV = 16 * 8;
    constexpr int I_X = I_T1 + I_T2 + 2 * I_T3 + I_T5, NX = NLAYER * I_X;
    auto decode = [&](int it) -> XDesc {
        const int l = it / I_X; int r = it % I_X; XDesc d;
        if (r < I_T1) { const int nblk = NP1 / 32, kb = r / nblk, n0 = (r % nblk) * 32; int c0, nvalid = 32;
            if (n0 < 4096) c0 = n0; else if (n0 < 8192) c0 = n0 + 72; else { c0 = n0 - 8192 + 4096; nvalid = (8264 - n0) < 0 ? 0 : ((8264 - n0) > 32 ? 32 : (8264 - n0)); }
            d = XDesc{A.w_in + (size_t)l * DM * NC_IN, A.norm_g + l * DM, B.W1 + ((size_t)l * NP1 + n0) * DM, NC_IN, kb * 64, c0, nvalid, DM}; return d; }
        r -= I_T1;
        if (r < I_T2) { const int nblk = 512 / 32, kb = r / nblk, nb = r % nblk;
            d = XDesc{A.w_iq + (size_t)l * 512 * 512, A.q_norm_g + l * 512, B.W2 + ((size_t)l * NQ2 + 4096 + nb * 32) * 512, 512, kb * 64, nb * 32, 32, 512}; return d; }
        r -= I_T2;
        if (r < 2 * I_T3) { const bool second = r >= I_T3; if (second) r -= I_T3; const int nblk = DM / 32, kb = r / nblk, nb = r % nblk;
            d = XDesc{(second ? A.w_proj_b : A.w_proj_a) + (size_t)l * 1024 * DM, nullptr, (second ? B.WB : B.WA) + ((size_t)l * DM + nb * 32) * 2048, DM, kb * 64, nb * 32, 32, 2048}; return d; }
        r -= 2 * I_T3;
        { const int nblk = DM / 32, kb = r / nblk, nb = r % nblk;
            d = XDesc{A.w_out + (size_t)l * DM * DM, nullptr, B.WO + ((size_t)l * DM + nb * 32) * DM, DM, kb * 64, nb * 32, 32, DM}; return d; }
    };
    {
        int it = C.gw;
        if (it < NX) {
            XDesc dc = decode(it); float vc[32]; xpose_load(dc, vc, C.lane);
            for (;;) {
                const int itn = it + C.NGW; const bool more = itn < NX;
                XDesc dn = dc; float vn[32];
                if (more) { dn = decode(itn); xpose_load(dn, vn, C.lane); }
                xpose_store(dc, vc, scr, C.lane);
                if (!more) break;
                dc = dn; it = itn;
#pragma unroll
                for (int i = 0; i < 32; ++i) vc[i] = vn[i];
            }
        }
    }
    for (int it = C.gw; it < NLAYER * (I_F + I_UV); it += C.NGW) {
        const int l = it / (I_F + I_UV); int r = it % (I_F + I_UV);
        if (r >= I_F) { r -= I_F; const int h = r / 8, s = r % 8;
            const float* wsrc = A.w_uv + ((size_t)l * 16 + h) * 256 * 64; const int gg = C.lane >> 4, cc = C.lane & 15;
#pragma unroll
            for (int nt = 0; nt < 4; ++nt) { const float* p = wsrc + (size_t)(32 * s + 8 * gg) * 64 + 16 * nt + cc;
                v4u o; o.x = pk2(p[0 * 64], p[1 * 64]); o.y = pk2(p[2 * 64], p[3 * 64]); o.z = pk2(p[4 * 64], p[5 * 64]); o.w = pk2(p[6 * 64], p[7 * 64]);
                *(GAS v4u*)(B.WUV + ((((size_t)l * 16 + h) * 8 + s) * 4 + nt) * 512 + C.lane * 8) = o; }
            continue; }
        { const int h = r / 64, kb = (r / 8) % 8, rb = r % 8;
            fold_item(A.w_qb + (size_t)l * 512 * 1024, A.w_uk + (size_t)l * 16 * 64 * 256, A.q_norm_g + l * 512, B.W2 + (size_t)l * NQ2 * 512, h, kb, rb, scr, C.lane); }
    }
    for (int m = C.gw; m < MP; m += C.NGW) {
        const float* src = nullptr;
        if (m < 8192) src = A.x + (size_t)m * DM; else if (m < 8224) src = A.meta + (size_t)((m - 8192) % NMETA) * DM;
        float ss = 0.f;
#pragma unroll
        for (int j = 0; j < 8; ++j) { f32x4 v = src ? *(const f32x4*)(src + j * 256 + C.lane * 4) : (f32x4){0.f, 0.f, 0.f, 0.f};
            pg8::u32x2 w; w.x = pk2(v[0], v[1]); w.y = pk2(v[2], v[3]); *(pg8::u32x2*)(B.HB + (size_t)m * DM + j * 256 + C.lane * 4) = w;
            ss += (v[0] * v[0] + v[1] * v[1]) + (v[2] * v[2] + v[3] * v[3]); }
        ss = wave_sum(ss);
        if (C.lane < 32) B.RS[(size_t)m * 32 + C.lane] = (C.lane == 0) ? ss : 0.f;
        if (m >= 8192 && m < 8224) B.RS2[(size_t)(m - 8192) * 64 + C.lane] = (C.lane == 0) ? ss : 0.f;
        if (m >= NTOK) {
#pragma unroll
            for (int j = 0; j < 2; ++j) { *(v4u*)(B.YA + (size_t)m * YLD + j * 512 + C.lane * 8) = (v4u){0u, 0u, 0u, 0u}; *(v4u*)(B.YB + (size_t)m * YLD + j * 512 + C.lane * 8) = (v4u){0u, 0u, 0u, 0u}; }
        }
    }
}

template <int NP4>
__device__ __forceinline__ void rstd_table(const Ctx& C, const pg8::StaticOrder& S, const float* __restrict__ rs, float inv_dim) {
    LAS float* tbl = (LAS float*)(C.lds + RSTD_OFF);
    pg8::Unit u;
    for (int ui = 0; ui < 5 && S.next(ui, u); ++ui) {
        if (C.tid < 256) { const f32x4* p = (const f32x4*)(rs + (size_t)(u.pm * 256 + C.tid) * (NP4 * 4)); float s = 0.f;
#pragma unroll
            for (int j = 0; j < NP4; ++j) { const f32x4 v = p[j]; s += (v[0] + v[1]) + (v[2] + v[3]); }
            tbl[ui * 256 + C.tid] = rsqrtf(s * inv_dim + RMS_EPS); }
    }
    __syncthreads();
}

__device__ __forceinline__ void norm_tail(const Ctx& C, int l) {
    const Bufs B(C.a.ws);
    const Args& A = C.a;
    for (int m = C.gw; m < NTOK; m += C.NGW) {
        const bf16* pr = B.PROJ + (size_t)m * NP1;
        { const pg8::u32x2 w = *(const pg8::u32x2*)(pr + PC_CKV + C.lane * 4); float v[4] = {pg8::bf_lo(w.x), pg8::bf_hi(w.x), pg8::bf_lo(w.y), pg8::bf_hi(w.y)};
          float ss = (v[0] * v[0] + v[1] * v[1]) + (v[2] * v[2] + v[3] * v[3]);
          ss = wave_sum(ss); const float r = rsqrtf(ss * (1.0f / 256.0f) + RMS_EPS);
          const f32x4 g = *(const f32x4*)(A.kv_norm_g + l * 256 + C.lane * 4);
          pg8::u32x2 o; o.x = pk2(v[0] * r * g[0], v[1] * r * g[1]); o.y = pk2(v[2] * r * g[2], v[3] * r * g[3]);
          *(pg8::u32x2*)(B.CKVN + (size_t)m * 256 + C.lane * 4) = o; }
    }
    for (int it = C.gw; it < 2 * 65; it += C.NGW) { const int b = it / 65, pos = (it % 65) * 64 + C.lane;
        if (pos < LTOK) { const bf16* vr = B.KV + (size_t)rowof(b, pos) * 256 + 128;
#pragma unroll 4
            for (int c8 = 0; c8 < 16; ++c8) { const v4u w = *(const v4u*)(vr + 8 * c8); bf16* o = B.VT + ((size_t)b * 128 + 8 * c8) * 4128 + pos;
                o[0 * 4128] = (bf16)(w.x & 0xffffu); o[1 * 4128] = (bf16)(w.x >> 16); o[2 * 4128] = (bf16)(w.y & 0xffffu); o[3 * 4128] = (bf16)(w.y >> 16);
                o[4 * 4128] = (bf16)(w.z & 0xffffu); o[5 * 4128] = (bf16)(w.z >> 16); o[6 * 4128] = (bf16)(w.w & 0xffffu); o[7 * 4128] = (bf16)(w.w >> 16); } } }
}

__device__ __forceinline__ unsigned f2key(float f) { const unsigned u = __float_as_uint(f); return (u & 0x80000000u) ? ~u : (u | 0x80000000u); }

__device__ __forceinline__ void final_phase(const Ctx& C) {
    const Bufs B(C.a.ws);
    const Args& A = C.a;
    for (int m = C.gw; m < 8192; m += C.NGW) {
        float s = (C.lane < 32) ? B.RS[(size_t)m * 32 + C.lane] : 0.f;
        s = wave_sum(s);
        const float r = rsqrtf(s * (1.0f / DM) + RMS_EPS);
#pragma unroll
        for (int j = 0; j < 8; ++j) { const pg8::u32x2 hw = *(const pg8::u32x2*)(B.HB + (size_t)m * DM + j * 256 + C.lane * 4); const f32x4 v = {pg8::bf_lo(hw.x), pg8::bf_hi(hw.x), pg8::bf_lo(hw.y), pg8::bf_hi(hw.y)}; const f32x4 g = *(const f32x4*)(A.final_g + j * 256 + C.lane * 4);
            *(f32x4*)(A.out + (size_t)m * DM + j * 256 + C.lane * 4) = v * r * g; }
    }
#if defined(MK_PROBE)
    if (MK_PROBE >= 0 && C.gw == 0) { VM_WAIT(); if (C.lane == 0) A.out[0] += (float)((volatile LAS unsigned*)(C.lds + MISC_OFF + 64))[0] * MK_PROBE_SCALE; }
#endif
}


struct SkProj {
    bf16* P; bf16* KV; bf16* KIDX; int cb; const LAS float* tbl;
    __device__ __forceinline__ float operator()(int rloc, int c, float v) const { const int ac = cb + c; const bf16 o = (bf16)f2bf(v * tbl[rloc]);
        if (ac >= 1024 && ac < 1280) KV[(size_t)rloc * 256 + ac - 1024] = o; else if (ac >= 8192 && ac < 8256) KIDX[(size_t)rloc * 64 + ac - 8192] = o; else P[(size_t)rloc * NP1 + ac] = o;
        return v * tbl[rloc]; } };
struct SkQ2 { bf16* O; const LAS float* tbl; __device__ __forceinline__ float operator()(int rloc, int c, float v) const { O[(size_t)rloc * NQ2 + c] = (bf16)f2bf(v * tbl[rloc]); return 0.f; } };
struct SkPA { float* P; const bf16* G; __device__ __forceinline__ float operator()(int rloc, int c, float v) const { P[(size_t)rloc * DM + c] = sigmoidf_(bf2f(G[(size_t)rloc * NP1 + c])) * v; return 0.f; } };
struct SkMerge { bf16* O; const float* P; const bf16* G; __device__ __forceinline__ float operator()(int rloc, int c, float v) const { O[(size_t)rloc * DM + c] = (bf16)f2bf(P[(size_t)rloc * DM + c] + sigmoidf_(bf2f(G[(size_t)rloc * NP1 + c])) * v); return 0.f; } };
struct SkRes { bf16* HB; __device__ __forceinline__ float operator()(int rloc, int c, float v) const { const float h = bf2f(HB[(size_t)rloc * DM + c]) + v; HB[(size_t)rloc * DM + c] = (bf16)f2bf(h); return h; } };
constexpr int MR = 8192;
typedef float f32x16 __attribute__((ext_vector_type(16)));
__device__ __forceinline__ void sk_glds16(const void* gsrc, unsigned lds_dst) { unsigned keep;
    asm volatile("s_mov_b32 %0, m0\n\ts_mov_b32 m0, %2\n\ts_nop 0\n\tglobal_load_lds_dwordx4 %1, off\n\ts_mov_b32 m0, %0" : "=&s"(keep) : "v"(gsrc), "s"(lds_dst) : "memory"); }
template <int NT, int GPI, class F>
__device__ __forceinline__ void skinny_unit(const Ctx& C, const bf16* __restrict__ A, int lda, const bf16* __restrict__ Bt, int ldb, int K, float* ss_out  , int ss_ld, int ss_col0, const F& epi) {
    const int lane = C.lane, w = C.wave, r32 = lane & 31, hh = lane >> 5;
    f32x16 acc[NT];
#pragma unroll
    for (int nt = 0; nt < NT; ++nt) acc[nt] = (f32x16){};
    const int kper = K >> 3, ngroups = kper >> 6;
    const unsigned stg = (unsigned)__builtin_amdgcn_readfirstlane((unsigned)(uintptr_t)(C.lds + RING_OFF) + (unsigned)w * 16384u);
    LAS unsigned char* stp = C.lds + RING_OFF + w * 16384;
    const int prow = lane >> 3, pch = lane & 7;
    const int foff = r32 * 128;
    const int fsw = (r32 >> 1) & 7;
#pragma unroll 1
    for (int g0 = 0; g0 < ngroups; ++g0) {
        const size_t kbyte = ((size_t)w * kper + (size_t)g0 * 64) * 2;
#pragma unroll
        for (int p = 0; p < 4; ++p) { const int row = 8 * p + prow; const int lg = pch ^ ((row >> 1) & 7);
            sk_glds16((const unsigned char*)A + (size_t)row * lda * 2 + kbyte + lg * 16, stg + p * 1024); }
#pragma unroll
        for (int nt = 0; nt < NT; ++nt)
#pragma unroll
            for (int p = 0; p < 4; ++p) { const int row = 8 * p + prow; const int lg = pch ^ ((row >> 1) & 7);
                sk_glds16((const unsigned char*)Bt + (size_t)(nt * 32 + row) * ldb * 2 + kbyte + lg * 16, stg + 4096 * (1 + nt) + p * 1024); }
        asm volatile("s_waitcnt vmcnt(0)" ::: "memory");
        bf16x8 a[4], bv[NT][4];
#pragma unroll
        for (int s = 0; s < 4; ++s) { const int o = foff + (((2 * s + hh) ^ fsw) << 4); a[s] = *(const LAS bf16x8*)(stp + o);
#pragma unroll
            for (int nt = 0; nt < NT; ++nt) bv[nt][s] = *(const LAS bf16x8*)(stp + 4096 * (1 + nt) + o); }
        __builtin_amdgcn_sched_barrier(0);
#pragma unroll
        for (int s = 0; s < 4; ++s)
#pragma unroll
            for (int nt = 0; nt < NT; ++nt) acc[nt] = __builtin_amdgcn_mfma_f32_32x32x16_bf16(a[s], bv[nt][s], acc[nt], 0, 0, 0);
        LDS_WAIT(); asm volatile("" ::: "memory");
    }
    LDS_WAIT(); __syncthreads();
    LAS float* part = (LAS float*)(C.lds + RING_OFF);
#pragma unroll
    for (int nt = 0; nt < NT; ++nt)
#pragma unroll
        for (int i = 0; i < 16; ++i) part[(w * NT * 16 + nt * 16 + i) * 64 + lane] = acc[nt][i];
    LDS_WAIT(); __syncthreads();
#pragma unroll
    for (int j = 0; j < 2 * NT; ++j) { const int e = (w + 8 * j) * 64 + lane;
        const int nti = w + 8 * j, nt = nti >> 4, i = nti & 15;
        float v = 0.f;
#pragma unroll
        for (int ww = 0; ww < 8; ++ww) v += part[ww * NT * 1024 + e];
        const int rloc = (i & 3) + 8 * (i >> 2) + 4 * hh, c = nt * 32 + r32;
        float sv = epi(rloc, c, v);
        if (ss_out != nullptr) { sv = sv * sv;
#pragma unroll
            for (int o = 1; o < 32; o <<= 1) sv += __shfl_xor(sv, o);
            if (r32 == 0) ss_out[(size_t)rloc * ss_ld + ss_col0 + nt] = sv; }
    }
    LDS_WAIT(); __syncthreads();
}
__device__ __forceinline__ void skinny_rstd(const Ctx& C, const float* __restrict__ rs, int np, float inv_dim, LAS float* tbl) {
    if (C.tid < 32) { float s = 0.f; const f32x4* p = (const f32x4*)(rs + (size_t)C.tid * np);
        for (int j = 0; j < np / 4; ++j) { const f32x4 v = p[j]; s += (v[0] + v[1]) + (v[2] + v[3]); }
        tbl[C.tid] = rsqrtf(s * inv_dim + RMS_EPS); }
    LDS_WAIT(); __syncthreads();
}

typedef short s16x4 __attribute__((ext_vector_type(4)));
typedef unsigned short u16x4 __attribute__((ext_vector_type(4)));
constexpr int DS_ISC = RING_OFF, DS_ISC_WORDS = 4128, DS_ISC_STRIDE = DS_ISC_WORDS * 4;
constexpr int DS_SEL = DS_ISC + 8 * DS_ISC_STRIDE;
constexpr int DS_BIAS = DS_SEL + 8 * 512;
constexpr int DS_QROW = DS_BIAS + 8192;
constexpr int DS_END = DS_QROW + 256;
constexpr size_t OL_BLOCK = (size_t)3 * 16 * 8 * 64 * 8;
static_assert(DS_END <= LDS_BYTES, "DSA LDS map");

__device__ __forceinline__ void glds16(const void* gsrc, unsigned lds_dst) { unsigned keep;
    asm volatile("s_mov_b32 %0, m0\n\ts_mov_b32 m0, %2\n\ts_nop 0\n\tglobal_load_lds_dwordx4 %1, off\n\ts_mov_b32 m0, %0" : "=&s"(keep) : "v"(gsrc), "s"(lds_dst) : "memory"); }
__device__ __forceinline__ float relu1(float x) { return __builtin_amdgcn_fmed3f(x, 0.f, __builtin_inff()); }
__device__ __forceinline__ s16x4 tr_read(LAS unsigned char* p) { typedef short v4i16_t __attribute__((ext_vector_type(4))); return __builtin_bit_cast(s16x4, __builtin_amdgcn_ds_read_tr16_b64_v4i16((LAS v4i16_t*)p)); }
__device__ __forceinline__ unsigned cvtpk(float lo, float hi) { typedef float f2_t __attribute__((ext_vector_type(2))); typedef __bf16 b2_t __attribute__((ext_vector_type(2))); f2_t v = {lo, hi}; b2_t b = __builtin_convertvector(v, b2_t); return __builtin_bit_cast(unsigned, b); }

#define DSA_LOCALS() const int w = C.wave; LAS unsigned* ISC = (LAS unsigned*)(C.lds + DS_ISC); LAS unsigned short* sel = (LAS unsigned short*)(C.lds + DS_SEL) + w * 256; const LAS float* biasl = (const LAS float*)(C.lds + DS_BIAS); (void)ISC; (void)sel; (void)biasl
#define RELANE() do { asm volatile("" : "+v"(lane)); asm volatile("" : "+s"(t0), "+s"(b)); } while (0)
__device__ __forceinline__ void dsa_step1(const Ctx& C, const Bufs& B, int b, int t0) {
    int lane = C.lane; RELANE(); DSA_LOCALS();
    PROBE_T0();
    {
        const int r32 = lane & 31, hh = lane >> 5;
        bf16x8 qa[2][4]; float wq[2][2][8];
        const int qi = 2 * ((r32 >> 2) & 1) + (r32 >> 4), hA = (r32 & 3) + 4 * ((r32 >> 3) & 1);
#pragma unroll
        for (int g = 0; g < 2; ++g) { const int row = rowof(b, t0 + 4 * g + qi);
#pragma unroll
            for (int s = 0; s < 4; ++s) qa[g][s] = *(const bf16x8*)(B.Q2 + (size_t)row * NQ2 + 4096 + hA * 64 + 16 * s + 8 * hh);
#pragma unroll
            for (int j = 0; j < 2; ++j) { const int rw = rowof(b, t0 + 4 * g + 2 * hh + j); const v4u ww = *(const v4u*)(B.PROJ + (size_t)rw * NP1 + PC_WIDX);
                const float sc = 0.35355339059327373f * 0.125f;
                wq[g][j][0] = pg8::bf_lo(ww.x) * sc; wq[g][j][1] = pg8::bf_hi(ww.x) * sc; wq[g][j][2] = pg8::bf_lo(ww.y) * sc; wq[g][j][3] = pg8::bf_hi(ww.y) * sc;
                wq[g][j][4] = pg8::bf_lo(ww.z) * sc; wq[g][j][5] = pg8::bf_hi(ww.z) * sc; wq[g][j][6] = pg8::bf_lo(ww.w) * sc; wq[g][j][7] = pg8::bf_hi(ww.w) * sc; } }
        PROBE_T1(40);
        const int nkeys = t0 + 8, nkt = (nkeys + 31) >> 5;
        bf16x8 kA[4], kB[4];
#define IDX_LOAD(dst, kt_) do { const int key_ = (kt_) * 32 + r32, kc_ = key_ < nkeys ? key_ : nkeys - 1; const bf16* kp_ = B.KIDX + (size_t)rowof(b, kc_) * 64 + 8 * hh; \
        _Pragma("unroll") for (int s = 0; s < 4; ++s) dst[s] = *(const bf16x8*)(kp_ + 16 * s); } while (0)
#define IDX_TILE(src, kt_) do { const int key_ = (kt_) * 32 + r32; \
        _Pragma("unroll") for (int g = 0; g < 2; ++g) { f32x16 acc = {}; \
            _Pragma("unroll") for (int s = 0; s < 4; ++s) acc = __builtin_amdgcn_mfma_f32_32x32x16_bf16(qa[g][s], src[s], acc, 0, 0, 0); \
            _Pragma("unroll") for (int j = 0; j < 2; ++j) { float isc = 0.f; \
                _Pragma("unroll") for (int h = 0; h < 8; ++h) isc += wq[g][j][h] * relu1(acc[8 * j + h]); \
                ISC[(4 * g + 2 * hh + j) * DS_ISC_WORDS + key_] = f2key(isc); } } } while (0)
        int kt = w;
        if (kt < nkt) IDX_LOAD(kA, kt);
#pragma unroll 1
        while (kt < nkt) {
            if (kt + 8 < nkt) IDX_LOAD(kB, kt + 8);
            __builtin_amdgcn_sched_barrier(0);
            IDX_TILE(kA, kt);
            __builtin_amdgcn_sched_barrier(0);
            kt += 8; if (kt >= nkt) break;
            if (kt + 8 < nkt) IDX_LOAD(kA, kt + 8);
            __builtin_amdgcn_sched_barrier(0);
            IDX_TILE(kB, kt);
            __builtin_amdgcn_sched_barrier(0);
            kt += 8;
        }
#undef IDX_LOAD
#undef IDX_TILE
        PROBE_T1(41);
    }
}
__device__ __forceinline__ int dsa_step2(const Ctx& C, int b, int t0) {
    int lane = C.lane; RELANE(); DSA_LOCALS();
    const int t = t0 + w, n = t + 1;
    int cnt;
    if (n <= TOPK) { for (int j = lane; j < n; j += 64) sel[j] = (unsigned short)j; cnt = n; }
    else {
        const LAS unsigned* myrow = ISC + w * DS_ISC_WORDS;
        const int nI = (n + 255) >> 8;
        unsigned v[68];
#pragma unroll
        for (int i = 0; i < 17; ++i) { const pg8::u32x4 x = *(const LAS pg8::u32x4*)(myrow + 256 * i + 4 * lane);
#pragma unroll
            for (int e = 0; e < 4; ++e) v[4 * i + e] = (256 * i + 4 * lane + e <= t) ? x[e] : 0u; }
        unsigned T = 0u; bool exact = false;
#define DSA_COUNT(res, pred_expr) do { int c_ = 0; \
        _Pragma("unroll") for (int i = 0; i < 17; ++i) { if (i < nI) { _Pragma("unroll") for (int e = 0; e < 4; ++e) { const unsigned x_ = v[4 * i + e]; c_ += (pred_expr) ? 1 : 0; } } } \
        int tot_ = 0; _Pragma("unroll") for (int bt = 0; bt < 7; ++bt) tot_ += __popcll(__ballot((c_ >> bt) & 1)) << bt; res = tot_; } while (0)
#pragma unroll 1
        for (int bit = 31; bit >= 0; --bit) {
            const unsigned cand = T | (1u << bit); int c;
            DSA_COUNT(c, x_ >= cand);
            if (c >= TOPK) { T = cand; if (c == TOPK) { exact = true; break; } }
        }
        if (!exact) { int c; DSA_COUNT(c, x_ >= T); exact = (c == TOPK); }
#undef DSA_COUNT
        int base = 0;
#pragma unroll
        for (int k = 0; k < 68; ++k) { const bool p = exact ? (v[k] >= T) : (v[k] > T); const unsigned long long m = __ballot(p);
            const int pos = base + (int)__builtin_amdgcn_mbcnt_hi((unsigned)(m >> 32), __builtin_amdgcn_mbcnt_lo((unsigned)m, 0u));
            if (p) sel[pos] = (unsigned short)(256 * (k >> 2) + 4 * lane + (k & 3));
            base += __popcll(m); }
        if (!exact) {
            int last = -1;
            while (base < TOPK) { int mi = 0x7fffffff;
#pragma unroll
                for (int k = 0; k < 68; ++k) { const int idx = 256 * (k >> 2) + 4 * lane + (k & 3); if (v[k] == T && idx > last && idx < mi) mi = idx; }
#pragma unroll
                for (int o = 1; o < 64; o <<= 1) { const int oth = __shfl_xor(mi, o); mi = oth < mi ? oth : mi; }
                if (lane == 0) sel[base] = (unsigned short)mi;
                last = mi; ++base; }
        }
        cnt = TOPK;
    }
    return cnt;
}
__device__ __forceinline__ void dsa_step3(const Ctx& C, const Bufs& B, int b, int t0, int cnt, int qslot) {
    int lane = C.lane; RELANE(); DSA_LOCALS(); const int t = t0 + w;
    {
        const int g = lane >> 4, c16 = lane & 15, rowq = rowof(b, t);
        bf16x8 qf[8];
#pragma unroll
        for (int s = 0; s < 8; ++s) qf[s] = *(const bf16x8*)(B.Q2 + (size_t)rowq * NQ2 + c16 * 256 + 32 * s + 8 * g);
        f32x4 O[16];
#pragma unroll
        for (int rt = 0; rt < 16; ++rt) O[rt] = (f32x4){0.f, 0.f, 0.f, 0.f};
        float m_ref = 0.f, lsum = 0.f;
        const int buf0 = DS_ISC + w * DS_ISC_STRIDE;
        const int npairs = (cnt + 31) >> 5;
        const int swz = (c16 & 7) << 1;
        const int trow = 4 * g + (c16 >> 2), tswz = (trow & 7) << 1, tp = c16 & 3;
        const int arow = (c16 & 7) * 1024 + (c16 >> 3) * 512, trowo = (trow & 7) * 1024 + (trow >> 3) * 512;
        const unsigned ldsb = (unsigned)(uintptr_t)(C.lds + buf0);
#define DSA_GATHER(c_) do { const unsigned bo_ = (unsigned)__builtin_amdgcn_readfirstlane(ldsb + ((c_) & 1) * 8192); \
        const pg8::u32x4 sp_ = *(const LAS pg8::u32x4*)(sel + 16 * (c_) + 8 * (lane >> 5)); const unsigned spw_[4] = {sp_.x, sp_.y, sp_.z, sp_.w}; \
        _Pragma("unroll") for (int p = 0; p < 8; ++p) { const int j = 16 * (c_) + 8 * (lane >> 5) + p; int pos = (int)((spw_[p >> 1] >> (16 * (p & 1))) & 0xffffu); pos = j < cnt ? pos : 0; \
            const int logical = (lane & 31) ^ (p << 1); \
            glds16((const unsigned char*)B.CKVN + (size_t)rowof(b, pos) * 512 + logical * 16, bo_ + p * 1024); } } while (0)
#pragma unroll 1
        for (int kp = 0; kp < npairs; ++kp) {
            DSA_GATHER(2 * kp); DSA_GATHER(2 * kp + 1);
            asm volatile("s_waitcnt vmcnt(0)" ::: "memory");
            bf16x8 a0[8], a1[8]; s16x4 v0[16], v1[16];
#pragma unroll
            for (int s = 0; s < 8; ++s) { const int off = arow + (((4 * s + g) ^ swz) << 4); a0[s] = *(const LAS bf16x8*)(C.lds + buf0 + off); a1[s] = *(const LAS bf16x8*)(C.lds + buf0 + 8192 + off); }
            const u16x4 p0 = *(const LAS u16x4*)(sel + 32 * kp + 4 * g), p1 = *(const LAS u16x4*)(sel + 32 * kp + 16 + 4 * g);
            __builtin_amdgcn_sched_barrier(0);
            f32x4 s0 = {0.f, 0.f, 0.f, 0.f}, s1 = {0.f, 0.f, 0.f, 0.f};
#pragma unroll
            for (int s = 0; s < 8; ++s) { s0 = __builtin_amdgcn_mfma_f32_16x16x32_bf16(a0[s], qf[s], s0, 0, 0, 0); s1 = __builtin_amdgcn_mfma_f32_16x16x32_bf16(a1[s], qf[s], s1, 0, 0, 0); }
            __builtin_amdgcn_sched_barrier(0);
#pragma unroll
            for (int rt = 0; rt < 16; ++rt) { const int off = trowo + (((2 * rt + (tp >> 1)) ^ tswz) << 4) + 8 * (tp & 1); v0[rt] = tr_read(C.lds + buf0 + off); v1[rt] = tr_read(C.lds + buf0 + 8192 + off); }
            __builtin_amdgcn_sched_barrier(0);
            float x0[4], x1[4]; float mloc = -INFINITY;
#pragma unroll
            for (int i = 0; i < 4; ++i) { const int j0 = 32 * kp + 4 * g + i, j1 = j0 + 16; int d0 = t - (int)p0[i], d1 = t - (int)p1[i]; d0 = d0 < 0 ? 0 : (d0 > 127 ? 127 : d0); d1 = d1 < 0 ? 0 : (d1 > 127 ? 127 : d1);
                const float b0 = biasl[d0 * 16 + c16], b1 = biasl[d1 * 16 + c16];
                const float y0 = 0.125f * s0[i] + b0, y1 = 0.125f * s1[i] + b1;
                x0[i] = (j0 < cnt) ? y0 : -INFINITY; x1[i] = (j1 < cnt) ? y1 : -INFINITY;
                mloc = fmaxf(mloc, fmaxf(x0[i], x1[i])); }
            mloc = fmaxf(mloc, __shfl_xor(mloc, 16)); mloc = fmaxf(mloc, __shfl_xor(mloc, 32));
            if (kp == 0) m_ref = mloc;
            else if (__any(mloc > m_ref + 8.0f)) { const float mn = fmaxf(m_ref, mloc), al = __expf(m_ref - mn);
#pragma unroll
                for (int rt = 0; rt < 16; ++rt) O[rt] *= al;
                lsum *= al; m_ref = mn; }
            float pe0[4], pe1[4];
#pragma unroll
            for (int i = 0; i < 4; ++i) { pe0[i] = __expf(x0[i] - m_ref); pe1[i] = __expf(x1[i] - m_ref); lsum += pe0[i] + pe1[i]; }
            pg8::u32x4 pw; pw.x = cvtpk(pe0[0], pe0[1]); pw.y = cvtpk(pe0[2], pe0[3]); pw.z = cvtpk(pe1[0], pe1[1]); pw.w = cvtpk(pe1[2], pe1[3]);
            const bf16x8 pf = __builtin_bit_cast(bf16x8, pw);
#pragma unroll
            for (int rt = 0; rt < 16; ++rt) { const bf16x8 af = {v0[rt][0], v0[rt][1], v0[rt][2], v0[rt][3], v1[rt][0], v1[rt][1], v1[rt][2], v1[rt][3]};
                O[rt] = __builtin_amdgcn_mfma_f32_16x16x32_bf16(af, pf, O[rt], 0, 0, 0); }
            LDS_WAIT(); asm volatile("" ::: "memory");
        }
#undef DSA_GATHER
        lsum += __shfl_xor(lsum, 16); lsum += __shfl_xor(lsum, 32);
        const float inv = 1.0f / lsum;
#pragma unroll
        for (int rt = 0; rt < 16; ++rt) { const f32x4 o = O[rt] * inv; pg8::u32x2 wv; wv.x = cvtpk(o[0], o[1]); wv.y = cvtpk(o[2], o[3]);
            const int s_ = rt >> 1, gp = 2 * (rt & 1) + (g >> 1), jo = 4 * (g & 1);
            *(pg8::u32x2*)(B.OLAT + (size_t)C.bid * OL_BLOCK + ((((size_t)(qslot >> 4) * 16 + c16) * 8 + s_) * 64 + gp * 16 + (qslot & 15)) * 8 + jo) = wv; }
    }
}
__device__ __forceinline__ void dsa_wuv(const Ctx& C, const Bufs& B, int l, int nq) {
    const int lane = C.lane, w = C.wave, g = lane >> 4, c16 = lane & 15;
    const LAS int* qrow = (const LAS int*)(C.lds + DS_QROW);
    const int nmt = (nq + 15) >> 4;
#pragma unroll 1
    for (int hq = 0; hq < 2; ++hq) { const int h = 2 * w + hq;
        f32x4 Dv[3][4];
#pragma unroll
        for (int mt = 0; mt < 3; ++mt)
#pragma unroll
            for (int nt = 0; nt < 4; ++nt) Dv[mt][nt] = (f32x4){0.f, 0.f, 0.f, 0.f};
        const bf16* wb = B.WUV + (((size_t)l * 16 + h) * 32) * 512 + lane * 8;
        const bf16* ab = B.OLAT + (size_t)C.bid * OL_BLOCK + ((size_t)h * 8) * 512 + lane * 8;
        bf16x8 bwA[4], awA[3], bwB[4], awB[3];
#define WUV_LOAD(bw_, aw_, s_) do { _Pragma("unroll") for (int nt = 0; nt < 4; ++nt) bw_[nt] = *(const bf16x8*)(wb + ((s_) * 4 + nt) * 512); \
        _Pragma("unroll") for (int mt = 0; mt < 3; ++mt) { const v4u av_ = __builtin_nontemporal_load((const v4u*)(ab + ((size_t)mt * 16 * 8 + (s_)) * 512)); aw_[mt] = __builtin_bit_cast(bf16x8, av_); } } while (0)
#define WUV_MMA(bw_, aw_) do { _Pragma("unroll") for (int mt = 0; mt < 3; ++mt) _Pragma("unroll") for (int nt = 0; nt < 4; ++nt) Dv[mt][nt] = __builtin_amdgcn_mfma_f32_16x16x32_bf16(aw_[mt], bw_[nt], Dv[mt][nt], 0, 0, 0); } while (0)
        WUV_LOAD(bwA, awA, 0);
#pragma unroll
        for (int s = 0; s < 8; s += 2) {
            WUV_LOAD(bwB, awB, s + 1);
            __builtin_amdgcn_sched_barrier(0);
            WUV_MMA(bwA, awA);
            __builtin_amdgcn_sched_barrier(0);
            if (s + 2 < 8) WUV_LOAD(bwA, awA, s + 2);
            __builtin_amdgcn_sched_barrier(0);
            WUV_MMA(bwB, awB);
            __builtin_amdgcn_sched_barrier(0);
        }
#undef WUV_LOAD
#undef WUV_MMA
        LAS float* stg = (LAS float*)(C.lds + RING_OFF + w * 4608);
#pragma unroll
        for (int mt = 0; mt < 3; ++mt) { if (mt < nmt) {
#pragma unroll
            for (int nt = 0; nt < 4; ++nt)
#pragma unroll
                for (int i = 0; i < 4; ++i) stg[(4 * g + i) * 68 + 16 * nt + c16] = Dv[mt][nt][i];
            LDS_WAIT(); asm volatile("" ::: "memory");
            const int slot = lane >> 2, q = mt * 16 + slot, d0 = (lane & 3) * 16;
            if (q < nq) { const int row = qrow[q];
                const bf16* zp = B.PROJ + (size_t)row * NP1 + PC_ZB + h * 64 + d0; bf16* op = B.YB + (size_t)row * YLD + h * 64 + d0;
#pragma unroll
                for (int hf = 0; hf < 2; ++hf) { const v4u zw = *(const v4u*)(zp + 8 * hf);
                    const f32x4 xa = *(const LAS f32x4*)(stg + slot * 68 + d0 + 8 * hf), xb = *(const LAS f32x4*)(stg + slot * 68 + d0 + 8 * hf + 4);
                    v4u o; o.x = pk2(xa[0] * siluf_(pg8::bf_lo(zw.x)), xa[1] * siluf_(pg8::bf_hi(zw.x))); o.y = pk2(xa[2] * siluf_(pg8::bf_lo(zw.y)), xa[3] * siluf_(pg8::bf_hi(zw.y)));
                    o.z = pk2(xb[0] * siluf_(pg8::bf_lo(zw.z)), xb[1] * siluf_(pg8::bf_hi(zw.z))); o.w = pk2(xb[2] * siluf_(pg8::bf_lo(zw.w)), xb[3] * siluf_(pg8::bf_hi(zw.w)));
                    *(v4u*)(op + 8 * hf) = o; } }
            LDS_WAIT(); asm volatile("" ::: "memory"); } }
    }
}
#ifndef MK_DSUB
#define MK_DSUB 0
#endif
__device__ __forceinline__ void dsa_unit(const Ctx& C, const Bufs& B, int l, int b, int t0, int uidx) {
    { PROBE_T0(); for (int rep = 0; rep < ((MK_DSUB & 1) ? 2 : 1); ++rep) { dsa_step1(C, B, b, t0); LDS_WAIT(); PROBE_T1(10); __syncthreads(); } PROBE_T1(0); }
    int cnt = 0;
    { PROBE_T0(); for (int rep = 0; rep < ((MK_DSUB & 2) ? 2 : 1); ++rep) { cnt = dsa_step2(C, b, t0); LDS_WAIT(); asm volatile("" ::: "memory"); } PROBE_T1(1); }
    if (C.lane == 0) ((LAS int*)(C.lds + DS_QROW))[uidx * 8 + C.wave] = rowof(b, t0 + C.wave);
    { PROBE_T0(); for (int rep = 0; rep < ((MK_DSUB & 4) ? 2 : 1); ++rep) { dsa_step3(C, B, b, t0, cnt, uidx * 8 + C.wave); } PROBE_T1(2); }
    { PROBE_T0(); LDS_WAIT(); __syncthreads(); PROBE_T1(7); }
}
#undef RELANE
#undef DSA_LOCALS

__device__ __forceinline__ void dsa_phase(const Ctx& C, int l) {
    const Bufs B(C.a.ws);
    const Args& A = C.a;
    for (int i = C.tid; i < 128 * 16; i += NWAVES * 64) { const int dd = i >> 4, h = i & 15; ((LAS float*)(C.lds + DS_BIAS))[i] = A.bias_table[t5_bucket(dd) * 32 + 16 + h]; }
    __syncthreads();
    int nu = 0;
    for (int it = 0;; ++it) {
        int b, j;
        if (C.G == 256) { const int k = C.bid >> 1; b = C.bid & 1;
            if (it < 4) j = 513 - (128 * it + ((it & 1) ? 127 - k : k)); else if (it == 4 && k < 2) j = 1 - k; else break; }
        else { const int s = C.bid + it * C.G; if (s >= 1028) break; b = s & 1; j = 513 - (s >> 1); }
        dsa_unit(C, B, l, b, 8 * j, it); nu = it + 1;
    }
    VM_WAIT(); LDS_WAIT(); __syncthreads();
    { PROBE_T0(); dsa_wuv(C, B, l, nu * 8); PROBE_T1(3); }
    __syncthreads();
}

constexpr int VT_PITCH = 4128;
constexpr int SW_BIAS = RING_OFF;
constexpr int SW_WS = SW_BIAS + 8192;
constexpr int SW_STG = SW_WS + 1024;

__device__ __forceinline__ void swa_item(const Ctx& C, const Bufs& B, const float* __restrict__ sinks, int b, int head, int p0, bool meta) {
    const int lane = C.lane, r32 = lane & 31, hh = lane >> 5, g = head >> 3;
    const LAS float* biasl = (const LAS float*)(C.lds + SW_BIAS);
    LAS float* wsf = (LAS float*)(C.lds + SW_WS) + C.wave * 32;
    const int tq = p0 + r32;
    const int tqc = meta ? (tq < NMETA ? tq : NMETA - 1) : tq;
    const int rowq = rowof(b, tqc);
    bf16x8 qf[4];
#pragma unroll
    for (int s = 0; s < 4; ++s) qf[s] = *(const bf16x8*)(B.PROJ + (size_t)rowq * NP1 + PC_QA + head * 64 + 16 * s + 8 * hh);
    const int ntile = meta ? 1 : 6;
    f32x16 S[6];
    bf16x8 kf[6][4];
#pragma unroll
    for (int kt = 0; kt < 6; ++kt) {
        if (kt < ntile) {
            const int k0 = (kt == 0) ? 0 : p0 - 128 + 32 * (kt - 1);
            int kpos = k0 + r32; kpos = kpos < 0 ? 0 : kpos;
            const bf16* kp = B.KV + (size_t)rowof(b, kpos) * 256 + g * 64 + 8 * hh;
#pragma unroll
            for (int s = 0; s < 4; ++s) kf[kt][s] = *(const bf16x8*)(kp + 16 * s);
        }
    }
    __builtin_amdgcn_sched_barrier(0);
#pragma unroll
    for (int kt = 0; kt < 6; ++kt) {
        if (kt < ntile) {
            f32x16 acc = {};
#pragma unroll
            for (int s = 0; s < 4; ++s) acc = __builtin_amdgcn_mfma_f32_32x32x16_bf16(kf[kt][s], qf[s], acc, 0, 0, 0);
            S[kt] = acc;
        } else S[kt] = (f32x16){-INFINITY, -INFINITY, -INFINITY, -INFINITY, -INFINITY, -INFINITY, -INFINITY, -INFINITY, -INFINITY, -INFINITY, -INFINITY, -INFINITY, -INFINITY, -INFINITY, -INFINITY, -INFINITY};
    }
    __builtin_amdgcn_sched_barrier(0);
#pragma unroll
    for (int kt = 0; kt < 6; ++kt) {
        if (kt < ntile) {
            const int k0 = (kt == 0) ? 0 : p0 - 128 + 32 * (kt - 1);
            float bz[16];
#pragma unroll
            for (int i = 0; i < 16; ++i) { const int kp = k0 + (i & 3) + 8 * (i >> 2) + 4 * hh; int d = tq - kp; d = d < 0 ? 0 : (d > 127 ? 127 : d); bz[i] = biasl[d * 16 + head]; }
#pragma unroll
            for (int i = 0; i < 16; ++i) { const int kp = k0 + (i & 3) + 8 * (i >> 2) + 4 * hh; const int d = tq - kp;
                const bool ok = (kt == 0) ? (kp < NMETA && d >= 0) : (kp >= NMETA && d >= 0 && d < 128);
                const float x = 0.125f * S[kt][i] + bz[i];
                S[kt][i] = ok ? x : -INFINITY; }
        }
    }
    const float sink = sinks[head];
    float mx = sink;
#pragma unroll
    for (int kt = 0; kt < 6; ++kt)
#pragma unroll
        for (int i = 0; i < 16; ++i) mx = fmaxf(mx, S[kt][i]);
    mx = fmaxf(mx, __shfl_xor(mx, 32));
    float sum = 0.f;
#pragma unroll
    for (int kt = 0; kt < 6; ++kt)
#pragma unroll
        for (int i = 0; i < 16; ++i) { const float p = __expf(S[kt][i] - mx); S[kt][i] = p; sum += p; }
    sum += __shfl_xor(sum, 32);
    sum += __expf(sink - mx);
    if (hh == 0) wsf[r32] = sum;
    f32x16 O0 = {}, O1 = {};
#pragma unroll
    for (int kt = 0; kt < 6; ++kt) {
        if (kt < ntile) {
            const int k0 = (kt == 0) ? 0 : p0 - 128 + 32 * (kt - 1);
            pg8::u32x2 vl[2][2], vh[2][2];
#pragma unroll
            for (int s2 = 0; s2 < 2; ++s2) { int ka = k0 + 16 * s2 + 4 * hh, kb2 = ka + 8; ka = ka < 0 ? 0 : ka; kb2 = kb2 < 0 ? 0 : kb2;
#pragma unroll
                for (int dt = 0; dt < 2; ++dt) { const bf16* vrow = B.VT + ((size_t)b * 128 + g * 64 + 32 * dt + r32) * VT_PITCH;
                    vl[s2][dt] = *(const pg8::u32x2*)(vrow + ka); vh[s2][dt] = *(const pg8::u32x2*)(vrow + kb2); } }
            __builtin_amdgcn_sched_barrier(0);
#pragma unroll
            for (int s2 = 0; s2 < 2; ++s2) {
                pg8::u32x4 pw; pw.x = cvtpk(S[kt][8 * s2 + 0], S[kt][8 * s2 + 1]); pw.y = cvtpk(S[kt][8 * s2 + 2], S[kt][8 * s2 + 3]); pw.z = cvtpk(S[kt][8 * s2 + 4], S[kt][8 * s2 + 5]); pw.w = cvtpk(S[kt][8 * s2 + 6], S[kt][8 * s2 + 7]);
                const bf16x8 pf = __builtin_bit_cast(bf16x8, pw);
#pragma unroll
                for (int dt = 0; dt < 2; ++dt) { const pg8::u32x4 vw = {vl[s2][dt].x, vl[s2][dt].y, vh[s2][dt].x, vh[s2][dt].y}; const bf16x8 vf = __builtin_bit_cast(bf16x8, vw);
                    if (dt == 0) O0 = __builtin_amdgcn_mfma_f32_32x32x16_bf16(pf, vf, O0, 0, 0, 0); else O1 = __builtin_amdgcn_mfma_f32_32x32x16_bf16(pf, vf, O1, 0, 0, 0); }
            }
            __builtin_amdgcn_sched_barrier(0);
        }
    }
    LDS_WAIT(); asm volatile("" ::: "memory");
    LAS float* stg = (LAS float*)(C.lds + SW_STG) + C.wave * (32 * 68);
#pragma unroll
    for (int i = 0; i < 16; ++i) { const int q = (i & 3) + 8 * (i >> 2) + 4 * hh; stg[q * 68 + r32] = O0[i]; stg[q * 68 + 32 + r32] = O1[i]; }
    LDS_WAIT(); asm volatile("" ::: "memory");
    { const int q = lane >> 1, d0 = (lane & 1) * 32, t = p0 + q;
      if (!meta || t < NMETA) { const int row = rowof(b, t); const float inv = 1.0f / wsf[q];
          const bf16* zp = B.PROJ + (size_t)row * NP1 + PC_ZA + head * 64 + d0; bf16* op = B.YA + (size_t)row * YLD + head * 64 + d0;
#pragma unroll
          for (int hf = 0; hf < 4; ++hf) { const v4u zw = *(const v4u*)(zp + 8 * hf);
              const f32x4 xa = *(const LAS f32x4*)(stg + q * 68 + d0 + 8 * hf) * inv, xb = *(const LAS f32x4*)(stg + q * 68 + d0 + 8 * hf + 4) * inv;
              v4u o; o.x = pk2(xa[0] * siluf_(pg8::bf_lo(zw.x)), xa[1] * siluf_(pg8::bf_hi(zw.x))); o.y = pk2(xa[2] * siluf_(pg8::bf_lo(zw.y)), xa[3] * siluf_(pg8::bf_hi(zw.y)));
              o.z = pk2(xb[0] * siluf_(pg8::bf_lo(zw.z)), xb[1] * siluf_(pg8::bf_hi(zw.z))); o.w = pk2(xb[2] * siluf_(pg8::bf_lo(zw.w)), xb[3] * siluf_(pg8::bf_hi(zw.w)));
              *(v4u*)(op + 8 * hf) = o; } } }
    LDS_WAIT(); asm volatile("" ::: "memory");
}

__device__ __forceinline__ void swa_phase(const Ctx& C, int l) {
    const Bufs B(C.a.ws);
    const Args& A = C.a;
    __syncthreads();
    for (int i = C.tid; i < 128 * 16; i += NWAVES * 64) { const int d = i >> 4, h = i & 15; ((LAS float*)(C.lds + SW_BIAS))[i] = A.bias_table[t5_bucket(d) * 32 + h]; }
    __syncthreads();
    const float* sinks = A.sinks + l * 16;
    for (int it = C.gw; it < 4096 + 32; it += C.NGW) {
        if (it < 4096) { const int blk = it & 127, head = (it >> 7) & 15, b = it >> 11; swa_item(C, B, sinks, b, head, NMETA + 32 * blk, false); }
        else { const int r = it - 4096, head = r & 15, b = r >> 4; swa_item(C, B, sinks, b, head, 0, true); }
    }
    __syncthreads();
}


constexpr int PH_PER_LAYER = 5, N_PHASES = 1 + NLAYER * PH_PER_LAYER + 1;
#ifndef MK_DUP
#define MK_DUP 0
#endif
#ifndef MK_NAIVE_SWA
#define MK_NAIVE_SWA 0
#endif
#ifndef MK_NAIVE_DSA
#define MK_NAIVE_DSA 0
#endif
#ifndef MK_ONE_LAUNCH
#define MK_ONE_LAUNCH 1
#endif

__global__ void __launch_bounds__(NWAVES * 64, 2) fwd_kernel(Args args) {
    extern __shared__ __attribute__((aligned(16))) unsigned char lds[];
    Ctx C;
    C.lds = (LAS unsigned char*)lds; C.tid = threadIdx.x; C.lane = C.tid & 63; C.wave = __builtin_amdgcn_readfirstlane(C.tid >> 6);
    C.G = gridDim.x; C.bid = blockIdx.x; C.gw = blockIdx.x * NWAVES + C.wave; C.NGW = C.G * NWAVES; C.a = args;
    unsigned char* ws = args.ws;
    gu32* ctl = (gu32*)(ws + WS_CTL);
    for (int u = C.tid; u < RING_OFF / 4; u += NWAVES * 64) ((LAS unsigned*)(C.lds + LDSCTL_OFF))[u] = 0u;
    __syncthreads();
    volatile LAS unsigned* MISC = (volatile LAS unsigned*)(C.lds + MISC_OFF);
    XcdBarrier bar; bar.bar = (unsigned*)(ctl + CW_BAR); bar.x = 0; bar.st = nullptr;
    const int lo = args.ph_lo, hi = args.ph_hi;
    const bool one = (hi - lo) > 1;
    if (one) bar = xcd_barrier_post((unsigned*)(ctl + CW_BAR), MISC + 8);
#define IN(k) (lo <= (k) && (k) < hi)
#define PHASE_BEGIN() do { int l_ = (int)__builtin_amdgcn_mbcnt_hi(~0u, __builtin_amdgcn_mbcnt_lo(~0u, 0u)); asm volatile("" : "+v"(l_)); int b_ = blockIdx.x; asm volatile("" : "+s"(b_)); \
    C.lane = l_; C.tid = C.wave * 64 + l_; C.bid = b_; C.gw = b_ * NWAVES + C.wave; } while (0)
#define SEAM(k) do { if (IN((k) + 1)) { PROBE_T0(); xcd_barrier(bar, C.wave == 0 && (int)__builtin_amdgcn_mbcnt_hi(~0u, __builtin_amdgcn_mbcnt_lo(~0u, 0u)) == 0); PROBE_T1(29); } } while (0)
    LAS unsigned char* ring = C.lds + RING_OFF;

    if (IN(0)) { PROBE_T0(); PHASE_BEGIN(); p0_prologue(C); PROBE_T1(20); if (MK_DUP & 128) { PHASE_BEGIN(); p0_prologue(C); } SEAM(0); }
    for (int l = 0; l < NLAYER; ++l) {
        const int p = 1 + l * PH_PER_LAYER;
        if (IN(p)) {
            PHASE_BEGIN(); const Bufs B(ws);
            const bf16* W1l = B.W1 + (size_t)l * NP1 * DM;
            pg8::Gemm g{B.HB, W1l, MR, 8192, DM}; pg8::StaticOrder S; S.init(MR, 8192, C.G, C.bid);
            rstd_table<8>(C, S, B.RS, 1.0f / DM);
            pg8::EpiProjT<true> E{B.PROJ, NP1, (const LAS float*)(C.lds + RSTD_OFF), B.KV, B.RSQ};
            { PROBE_T0(); pg8::gemm_phase<pg8::EpiProjT<true>, pg8::StaticOrder, true, true>(ring, g, S, E, C.tid); PROBE_T1(21); }
            PHASE_BEGIN();
            LAS float* tbl = (LAS float*)(C.lds + RSTD_OFF);
            PROBE_T0();
            for (int u = C.bid; u < 256 + 259; u += C.G) {
                if (u < 256) { const int row0 = 32 * u; skinny_rstd(C, B.RS + (size_t)row0 * 32, 32, 1.0f / DM, tbl);
                    skinny_unit<3, 1>(C, B.HB + (size_t)row0 * DM, DM, W1l + (size_t)8192 * DM, DM, DM, nullptr, 0, 0, SkProj{B.PROJ + (size_t)row0 * NP1, B.KV + (size_t)row0 * 256, B.KIDX + (size_t)row0 * 64, 8192, tbl}); }
                else { const int gc = u - 256; skinny_rstd(C, B.RS2, 64, 1.0f / DM, tbl);
                    const SkProj E2{B.PROJ + (size_t)MR * NP1, B.KV + (size_t)MR * 256, B.KIDX + (size_t)MR * 64, gc * 32, tbl};
                    const bool sqc = gc >= 72 && gc < 88;
                    skinny_unit<1, 4>(C, B.HB + (size_t)MR * DM, DM, W1l + (size_t)gc * 32 * DM, DM, DM, sqc ? B.RSQ2 : nullptr, 16, gc - 72, E2); }
            }
            PROBE_T1(22);
            SEAM(p);
        }
        if (IN(p + 1)) {
            PHASE_BEGIN(); const Bufs B(ws);
            const bf16* W2l = B.W2 + (size_t)l * NQ2 * 512;
            pg8::Gemm g{B.PROJ + PC_CQ, W2l, MR, NQ2, 512, nullptr, nullptr, NP1}; pg8::StaticOrder S; S.init(MR, NQ2, C.G, C.bid);
            rstd_table<2>(C, S, B.RSQ, 1.0f / 512.0f);
            pg8::EpiProjT<false> E{B.Q2, NQ2, (const LAS float*)(C.lds + RSTD_OFF), nullptr, nullptr};
            PROBE_T0();
            pg8::gemm_phase<pg8::EpiProjT<false>, pg8::StaticOrder, true, true>(ring, g, S, E, C.tid);
            PHASE_BEGIN();
            { LAS float* tbl = (LAS float*)(C.lds + RSTD_OFF);
              for (int u = C.bid; u < 48; u += C.G) { skinny_rstd(C, B.RSQ2, 16, 1.0f / 512.0f, tbl);
                skinny_unit<3, 1>(C, B.PROJ + (size_t)MR * NP1 + PC_CQ, NP1, W2l + (size_t)u * 96 * 512, 512, 512, nullptr, 0, 0, SkQ2{B.Q2 + (size_t)MR * NQ2 + u * 96, tbl}); } }
            PHASE_BEGIN(); norm_tail(C, l);
            PROBE_T1(24);
            SEAM(p + 1);
        }
        if (IN(p + 2)) {
            { PROBE_T0(); PHASE_BEGIN(); swa_phase(C, l); PROBE_T1(5); }
            if (MK_DUP & 8) { PHASE_BEGIN(); swa_phase(C, l); }
            { PROBE_T0(); PHASE_BEGIN(); dsa_phase(C, l); PROBE_T1(4); }
            if (MK_DUP & 16) { PHASE_BEGIN(); dsa_phase(C, l); }
            SEAM(p + 2);
        }
        if (IN(p + 3)) {
            PHASE_BEGIN(); const Bufs B(ws);
            const bf16* WABl = B.WA + (size_t)l * DM * 2048;
            pg8::Gemm g{B.YA, WABl, MR, DM, 2048, nullptr, nullptr, 0}; pg8::StaticOrder S; S.init(MR, DM, C.G, C.bid);
            pg8::EpiG4m E{B.MG, B.PROJ + PC_GA, B.PROJ + PC_GB, NP1};
            PROBE_T0();
            pg8::gemm_phase<pg8::EpiG4m, pg8::StaticOrder, true, true>(ring, g, S, E, C.tid);
            PROBE_T1(35);
            PHASE_BEGIN();
            for (int u = C.bid; u < 64; u += C.G) {
                skinny_unit<1, 2>(C, B.YA + (size_t)MR * YLD, YLD, WABl + (size_t)u * 32 * 2048, 2048, 1024, nullptr, 0, 0, SkPA{B.PA + (size_t)MR * DM + u * 32, B.PROJ + (size_t)MR * NP1 + PC_GA + u * 32});
                skinny_unit<1, 2>(C, B.YB + (size_t)MR * YLD, YLD, WABl + 1024 + (size_t)u * 32 * 2048, 2048, 1024, nullptr, 0, 0, SkMerge{B.MG + (size_t)MR * DM + u * 32, B.PA + (size_t)MR * DM + u * 32, B.PROJ + (size_t)MR * NP1 + PC_GB + u * 32}); }
            PROBE_T1(25);
            SEAM(p + 3);
        }
        if (IN(p + 4)) {
            PHASE_BEGIN(); const Bufs B(ws);
            const bf16* WOl = B.WO + (size_t)l * DM * DM;
            pg8::Gemm g{B.MG, WOl, MR, DM, DM}; pg8::StaticOrder S; S.init(MR, DM, C.G, C.bid);
            pg8::EpiRes E{B.HB, B.RS};
            PROBE_T0();
            pg8::gemm_phase<pg8::EpiRes, pg8::StaticOrder, true, true>(ring, g, S, E, C.tid);
            PROBE_T1(37);
            PHASE_BEGIN();
            for (int u = C.bid; u < 64; u += C.G) skinny_unit<1, 4>(C, B.MG + (size_t)MR * DM, DM, WOl + (size_t)u * 32 * DM, DM, DM, B.RS2, 64, u, SkRes{B.HB + (size_t)MR * DM + u * 32});
            PROBE_T1(27);
            SEAM(p + 4);
        }
    }
    if (IN(N_PHASES - 1)) { PHASE_BEGIN(); final_phase(C); }
#undef IN
#undef SEAM
}

extern "C" void kernel_launch(void* const* d_in, const int* in_sizes, int n_in, void* d_out, int out_size, void* d_ws, size_t ws_size, hipStream_t stream) {
    static int grid = 0;
    if (grid == 0) {
        if (n_in != 16 || ws_size < WS_END) { fprintf(stderr, "kernel_launch: unexpected inputs (n_in %d, ws %zu, need %zu)\n", n_in, ws_size, (size_t)WS_END); grid = -1; return; }
        int dev = 0, cus = 0;
        if (hipGetDevice(&dev) != hipSuccess || hipDeviceGetAttribute(&cus, hipDeviceAttributeMultiprocessorCount, dev) != hipSuccess) { grid = -1; return; }
        if (hipFuncSetAttribute((const void*)fwd_kernel, hipFuncAttributeMaxDynamicSharedMemorySize, LDS_BYTES) != hipSuccess) { fprintf(stderr, "kernel_launch: hipFuncSetAttribute failed\n"); grid = -1; return; }
        int per_cu = 0;
        if (hipOccupancyMaxActiveBlocksPerMultiprocessor(&per_cu, (const void*)fwd_kernel, NWAVES * 64, LDS_BYTES) != hipSuccess || per_cu < 1) fprintf(stderr, "kernel_launch: occupancy query says %d\n", per_cu);
        (void)hipGetLastError();
        grid = cus;
    }
    if (grid < 0) return;
    if (hipMemsetAsync((char*)d_ws + WS_CTL, 0, CTL_ZERO_BYTES, stream) != hipSuccess) return;
    Args a{};
    a.x = (const float*)d_in[0]; a.meta = (const float*)d_in[1]; a.bias_table = (const float*)d_in[2]; a.norm_g = (const float*)d_in[3]; a.w_in = (const float*)d_in[4];
    a.q_norm_g = (const float*)d_in[5]; a.kv_norm_g = (const float*)d_in[6]; a.w_qb = (const float*)d_in[7]; a.w_iq = (const float*)d_in[8]; a.w_uk = (const float*)d_in[9];
    a.w_uv = (const float*)d_in[10]; a.sinks = (const float*)d_in[11]; a.w_proj_a = (const float*)d_in[12]; a.w_proj_b = (const float*)d_in[13]; a.w_out = (const float*)d_in[14];
    a.final_g = (const float*)d_in[15]; a.out = (float*)d_out; a.ws = (unsigned char*)d_ws;
#if MK_ONE_LAUNCH
    a.ph_lo = 0; a.ph_hi = N_PHASES;
    hipLaunchKernelGGL(fwd_kernel, dim3(grid), dim3(NWAVES * 64), LDS_BYTES, stream, a);
#else
    for (int p = 0; p < N_PHASES; ++p) { a.ph_lo = p; a.ph_hi = p + 1; hipLaunchKernelGGL(fwd_kernel, dim3(grid), dim3(NWAVES * 64), LDS_BYTES, stream, a); }
#endif
}
```

```cpp
#include <hip/hip_runtime.h>
#include <cstdio>
#include <cstdint>
namespace pg8 {
#define PG8_LAS __attribute__((address_space(3)))
typedef unsigned short bf16_t;
typedef short bf16x8 __attribute__((ext_vector_type(8)));
typedef float f32x4 __attribute__((ext_vector_type(4)));
typedef unsigned u32x4 __attribute__((ext_vector_type(4)));
constexpr int BM = 256, BK = 64, HALF = 128, HTB = HALF * BK * 2  , STAGE_BYTES = 8 * HTB, NXCD = 8, WGM = 8;

__host__ __device__ __forceinline__ int lds_byte(int r, int c) { const int st = (r >> 4) * 2 + (c >> 5), rr = r & 15, cc = c & 31, ob = rr * 64 + cc * 2; return st * 1024 + (ob ^ (((ob >> 9) & 1) << 5)); }
__host__ __device__ __forceinline__ void stage_rc(int b, int& R, int& C) { const int st = b / 1024, sb = b % 1024, swz = sb ^ (((sb >> 9) & 1) << 5); R = (st >> 1) * 16 + swz / 64; C = (st & 1) * 32 + (swz % 64) / 2; }
__host__ __device__ __forceinline__ int perm32(int rho) { const int n = rho >> 4, i = rho & 15; return 8 * (i >> 2) + 4 * n + (i & 3); }

struct Unit { int pm, pn, sel; };
struct Gemm { const bf16_t* A; const bf16_t* Bt; int M, N, K; const bf16_t* A2; const bf16_t* Bt2; int lda; };

struct StaticOrder {
    int nM, nN, nwg, G, c;
    __host__ __device__ void init(int M, int N, int G_, int c_) { nM = M / BM; nN = N / BM; nwg = nM * nN; G = G_; c = c_; }
    __host__ __device__ bool next(int i, Unit& u) const {
        const long L = (long)i * G + c; if (L >= nwg) return false;
        int wgid = (int)L; { const int q = nwg / NXCD, r = nwg % NXCD, xcd = wgid % NXCD, off = wgid / NXCD; wgid = (xcd < r ? xcd * (q + 1) : r * (q + 1) + (xcd - r) * q) + off; }
        const int nig = WGM * nN, gid = wgid / nig, fm = gid * WGM, gsz = (nM - fm) < WGM ? (nM - fm) : WGM;
        u.pm = fm + ((wgid % nig) % gsz); u.pn = (wgid % nig) / gsz; u.sel = 0; return true;
    }
    __device__ __forceinline__ void a_ready(const Unit&) const {}
    __device__ __forceinline__ void done(const Unit&) const {}
};

__device__ __forceinline__ unsigned cvt_pk_bf16(float lo, float hi) { unsigned r; asm volatile("v_cvt_pk_bf16_f32 %0, %1, %2" : "=v"(r) : "v"(lo), "v"(hi)); return r; }
typedef float f32x2 __attribute__((ext_vector_type(2)));
__device__ __forceinline__ f32x2 gelu_pk(f32x2 v) {
    const f32x2 av = __builtin_elementwise_abs(v), d = av * 0.2316418882f + 1.0f;
    f32x2 t; t.x = __builtin_amdgcn_rcpf(d.x); t.y = __builtin_amdgcn_rcpf(d.y);
    f32x2 q = t * 0.5307027145f + (-0.7265760135f); q = q * t + 0.7107068705f; q = q * t + (-0.142248368f); q = q * t + 0.127414796f; q = q * t;
    const f32x2 s = (v * v) * (-0.72134752044f);
    f32x2 e; e.x = __builtin_amdgcn_exp2f(s.x); e.y = __builtin_amdgcn_exp2f(s.y);
    const f32x2 m = v * (q * e), r = v - m;
    f32x2 o; o.x = v.x < 0.f ? m.x : r.x; o.y = v.y < 0.f ? m.y : r.y; return o;
}

template <int ACT  > struct EpiBf16 {
    static constexpr bool PERM = true, AFTER_DRAIN = false; static_assert(ACT == 0 || ACT == 1, "EpiBf16: ACT is 0 (none) or 1 (gelu_pk)");
    bf16_t* O; int ldc; const float* bias; int split_cols; size_t split_stride; float scale0;
    __device__ __forceinline__ void operator()(const f32x4 (&acc)[2][2][4][2], const Unit& u, int ui, int wr, int wc, int fr, int fq) const {
        const int row0 = u.pm * BM + wr * 64 + fr; int colt = u.pn * BM; bf16_t* base = O;
        float sc = 1.f; if (split_cols) { const int t = colt / split_cols; base += (size_t)t * split_stride; colt -= t * split_cols; if (t == 0) sc = scale0; }
        const int col0 = colt + wc * 32 + 8 * fq, bcol0 = u.pn * BM + wc * 32 + 8 * fq;
        f32x4 bv[2][2];
#pragma unroll
        for (int bj = 0; bj < 2; ++bj)
#pragma unroll
            for (int n = 0; n < 2; ++n) bv[bj][n] = bias ? *(const f32x4*)(bias + bcol0 + bj * HALF + 4 * n) : (f32x4){0.f, 0.f, 0.f, 0.f};
#pragma unroll
        for (int ai = 0; ai < 2; ++ai)
#pragma unroll
            for (int m = 0; m < 4; ++m) { bf16_t* rowp = base + (size_t)(row0 + ai * HALF + m * 16) * ldc + col0;
#pragma unroll
                for (int bj = 0; bj < 2; ++bj) { f32x4 v0 = acc[ai][bj][m][0] + bv[bj][0], v1 = acc[ai][bj][m][1] + bv[bj][1];
                    if (ACT == 1) { f32x2 a = gelu_pk((f32x2){v0[0], v0[1]}), b = gelu_pk((f32x2){v0[2], v0[3]}), c = gelu_pk((f32x2){v1[0], v1[1]}), d = gelu_pk((f32x2){v1[2], v1[3]});
                        v0 = (f32x4){a.x, a.y, b.x, b.y}; v1 = (f32x4){c.x, c.y, d.x, d.y}; }
                    v0 = v0 * sc; v1 = v1 * sc; u32x4 w; w.x = cvt_pk_bf16(v0[0], v0[1]); w.y = cvt_pk_bf16(v0[2], v0[3]); w.z = cvt_pk_bf16(v1[0], v1[1]); w.w = cvt_pk_bf16(v1[2], v1[3]);
                    *(u32x4*)(rowp + bj * HALF) = w; } }
    }
};

template <class T, class = void> struct pg8_has_midk { static constexpr bool value = false; };
template <class T> struct pg8_has_midk<T, decltype((void)T::MIDK)> { static constexpr bool value = T::MIDK; };
template <class Epi, class Sched, bool ALIGN_EPI = false, bool SP2 = false>
__device__ __forceinline__ void gemm_phase(PG8_LAS unsigned char* lds, const Gemm g, const Sched& S, const Epi& E, int tid_in) {
    int tid_ = tid_in; asm volatile("" : "+v"(tid_));
    const int tid = tid_, wid = __builtin_amdgcn_readfirstlane(tid >> 6), lane = tid & 63, wr = wid >> 2, wc = wid & 3, fr = lane & 15, fq = lane >> 4;
    const int K = g.K, nt = K / BK, lda = g.lda ? g.lda : K;
    unsigned voffA[2], voffB[2];
#pragma unroll
    for (int i = 0; i < 2; ++i) { int R, C; stage_rc(tid * 16 + i * 8192, R, C); const int Rb = Epi::PERM ? ((R & ~31) + perm32(R & 31)) : R;
        voffA[i] = (unsigned)(R * lda + C) * 2u; voffB[i] = (unsigned)(Rb * K + C) * 2u; }
    const size_t kstep = (size_t)(BK * 2);
    const size_t hstepA = (size_t)HALF * lda * 2, tstepA = 2 * hstepA;
    const size_t hstep = (size_t)HALF * K * 2;
    const size_t tstep = 2 * hstep;
    const unsigned ldsw = (unsigned)wid * 1024u;
    const int aoff = lds_byte(wr * 64 + fr, fq * 8), boff = lds_byte(wc * 32 + fr, fq * 8);
#define PG8_SA(b, h) (((b) * 2 + (h)) * HTB)
#define PG8_SB(b, h) ((4 + (b) * 2 + (h)) * HTB)
#define PG8_STAGE(bufoff, gbase, voff) do { _Pragma("unroll") for (int _i = 0; _i < 2; ++_i) \
        __builtin_amdgcn_global_load_lds((const unsigned*)((const char*)(gbase) + (voff)[_i]), (PG8_LAS unsigned*)(lds + (bufoff) + ldsw + _i * 8192), 16, 0, 0); } while (0)
#define PG8_LDA(dst, b, h) do { _Pragma("unroll") for (int m = 0; m < 4; ++m) _Pragma("unroll") for (int k = 0; k < 2; ++k) dst[m][k] = *(const PG8_LAS bf16x8*)(lds + PG8_SA(b, h) + aoff + m * 2048 + k * 1024); } while (0)
#define PG8_LDB(dst, b, h) do { _Pragma("unroll") for (int n = 0; n < 2; ++n) _Pragma("unroll") for (int k = 0; k < 2; ++k) dst[n][k] = *(const PG8_LAS bf16x8*)(lds + PG8_SB(b, h) + boff + n * 2048 + k * 1024); } while (0)
#define PG8_MMA(ai, bj, At, Bt) do { __builtin_amdgcn_s_setprio(1); _Pragma("unroll") for (int m = 0; m < 4; ++m) _Pragma("unroll") for (int n = 0; n < 2; ++n) _Pragma("unroll") for (int k = 0; k < 2; ++k) \
        acc[ai][bj][m][n] = __builtin_amdgcn_mfma_f32_16x16x32_bf16(Bt[n][k], At[m][k], acc[ai][bj][m][n], 0, 0, 0); __builtin_amdgcn_s_setprio(0); } while (0)
#define PG8_WAIT_V(n) asm volatile("s_waitcnt vmcnt(" #n ")" ::: "memory")
#define PG8_WAIT_L(n) asm volatile("s_waitcnt lgkmcnt(" #n ")" ::: "memory")
#define PG8_BAR __builtin_amdgcn_s_barrier()
#define PG8_SCHED __builtin_amdgcn_sched_barrier(0)
    Unit cur, nxt; int ui = 0;
    if (!S.next(0, cur)) return;
    f32x4 acc[2][2][4][2];
#pragma unroll
    for (int a = 0; a < 2; ++a)
#pragma unroll
        for (int b = 0; b < 2; ++b)
#pragma unroll
            for (int m = 0; m < 4; ++m)
#pragma unroll
                for (int n = 0; n < 2; ++n) acc[a][b][m][n] = (f32x4){0.f, 0.f, 0.f, 0.f};
    bf16x8 At[4][2], B0[2][2], B1[2][2];
    const char* cA = (const char*)(cur.sel ? g.A2 : g.A) + (size_t)cur.pm * tstepA; const char* cB = (const char*)(cur.sel ? g.Bt2 : g.Bt) + (size_t)cur.pn * tstep;
    S.a_ready(cur);
    if constexpr (SP2) {
        PG8_STAGE(PG8_SB(0, 0), cB, voffB); PG8_STAGE(PG8_SB(0, 1), cB + hstep, voffB); PG8_STAGE(PG8_SA(0, 0), cA, voffA); PG8_STAGE(PG8_SA(0, 1), cA + hstepA, voffA);
        if (wr == 1) PG8_BAR;
        PG8_WAIT_V(2); PG8_BAR;
        PG8_STAGE(PG8_SB(1, 0), cB + kstep, voffB); PG8_STAGE(PG8_SA(1, 0), cA + kstep, voffA); PG8_STAGE(PG8_SB(1, 1), cB + hstep + kstep, voffB);
        PG8_WAIT_V(6); PG8_BAR;
    } else {
        PG8_STAGE(PG8_SB(0, 0), cB, voffB); PG8_STAGE(PG8_SA(0, 0), cA, voffA); PG8_STAGE(PG8_SB(0, 1), cB + hstep, voffB); PG8_STAGE(PG8_SA(0, 1), cA + hstepA, voffA);
        if (wr == 1) PG8_BAR;
        PG8_WAIT_V(4); PG8_BAR;
        PG8_STAGE(PG8_SB(1, 0), cB + kstep, voffB); PG8_STAGE(PG8_SA(1, 0), cA + kstep, voffA); PG8_STAGE(PG8_SB(1, 1), cB + hstep + kstep, voffB);
        PG8_WAIT_V(6); PG8_BAR;
    }
    for (;;) {
        const bool has_next = S.next(ui + 1, nxt);
        const char* nA = has_next ? (const char*)(nxt.sel ? g.A2 : g.A) + (size_t)nxt.pm * tstepA : cA; const char* nB = has_next ? (const char*)(nxt.sel ? g.Bt2 : g.Bt) + (size_t)nxt.pn * tstep : cB;
        for (int t = 0; t < nt; t += 2) {
            if constexpr (pg8_has_midk<Epi>::value) { if (t == (nt >> 1)) E.midk(acc, cur, wr, wc, fr, fq); }
            const bool last = (t == nt - 2);
            const char* a1 = cA + (size_t)(t + 1) * kstep;
            const char* a2 = last ? nA : cA + (size_t)(t + 2) * kstep; const char* b2 = last ? nB : cB + (size_t)(t + 2) * kstep;
            const char* a3 = a2 + kstep; const char* b3 = b2 + kstep;
            if (last && has_next) S.a_ready(nxt);
            if constexpr (SP2) {
            PG8_LDB(B0, 0, 0); PG8_LDB(B1, 0, 1); PG8_SCHED; PG8_LDA(At, 0, 0); PG8_STAGE(PG8_SA(1, 1), a1 + hstepA, voffA);
            PG8_WAIT_V(8); PG8_WAIT_L(0); PG8_BAR; PG8_MMA(0, 0, At, B0); PG8_MMA(0, 1, At, B1); PG8_BAR; PG8_SCHED;
            PG8_LDA(At, 0, 1); PG8_STAGE(PG8_SB(0, 0), b2, voffB); PG8_STAGE(PG8_SB(0, 1), b2 + hstep, voffB); PG8_STAGE(PG8_SA(0, 0), a2, voffA);
            PG8_WAIT_V(8); PG8_WAIT_L(0); PG8_BAR; PG8_MMA(1, 0, At, B0); PG8_MMA(1, 1, At, B1); PG8_BAR; PG8_SCHED;
            PG8_LDB(B0, 1, 0); PG8_LDB(B1, 1, 1); PG8_SCHED; PG8_LDA(At, 1, 0); PG8_STAGE(PG8_SA(0, 1), a2 + hstepA, voffA);
            PG8_WAIT_V(8); PG8_WAIT_L(0); PG8_BAR; PG8_MMA(0, 0, At, B0); PG8_MMA(0, 1, At, B1); PG8_BAR; PG8_SCHED;
            PG8_LDA(At, 1, 1); PG8_STAGE(PG8_SB(1, 0), b3, voffB); PG8_STAGE(PG8_SB(1, 1), b3 + hstep, voffB); PG8_STAGE(PG8_SA(1, 0), a3, voffA);
            PG8_WAIT_V(8); PG8_WAIT_L(0); PG8_BAR; PG8_MMA(1, 0, At, B0); PG8_MMA(1, 1, At, B1); PG8_BAR; PG8_SCHED;
            } else {
            PG8_LDB(B0, 0, 0); PG8_SCHED; PG8_LDA(At, 0, 0); PG8_STAGE(PG8_SA(1, 1), a1 + hstepA, voffA);
            PG8_WAIT_L(8); PG8_BAR; PG8_WAIT_L(0); PG8_MMA(0, 0, At, B0); PG8_BAR; PG8_SCHED;
            PG8_LDB(B1, 0, 1); PG8_STAGE(PG8_SB(0, 0), b2, voffB);
            PG8_BAR; PG8_WAIT_L(0); PG8_MMA(0, 1, At, B1); PG8_BAR;
            PG8_LDA(At, 0, 1); PG8_STAGE(PG8_SA(0, 0), a2, voffA);
            PG8_BAR; PG8_WAIT_L(0); PG8_MMA(1, 0, At, B0); PG8_BAR; PG8_SCHED;
            PG8_STAGE(PG8_SB(0, 1), b2 + hstep, voffB);
            PG8_WAIT_V(6); PG8_BAR; PG8_MMA(1, 1, At, B1); PG8_BAR;
            PG8_LDB(B0, 1, 0); PG8_SCHED; PG8_LDA(At, 1, 0); PG8_STAGE(PG8_SA(0, 1), a2 + hstepA, voffA);
            PG8_WAIT_L(8); PG8_BAR; PG8_WAIT_L(0); PG8_MMA(0, 0, At, B0); PG8_BAR; PG8_SCHED;
            PG8_LDB(B1, 1, 1); PG8_STAGE(PG8_SB(1, 0), b3, voffB);
            PG8_BAR; PG8_WAIT_L(0); PG8_MMA(0, 1, At, B1); PG8_BAR;
            PG8_LDA(At, 1, 1); PG8_STAGE(PG8_SA(1, 0), a3, voffA);
            PG8_BAR; PG8_WAIT_L(0); PG8_MMA(1, 0, At, B0); PG8_BAR; PG8_SCHED;
            PG8_STAGE(PG8_SB(1, 1), b3 + hstep, voffB);
            PG8_WAIT_V(6); PG8_BAR; PG8_MMA(1, 1, At, B1); PG8_BAR;
            }
        }
        if constexpr (ALIGN_EPI) { if (wr == 0) PG8_BAR; }
        if constexpr (!Epi::AFTER_DRAIN) { E(acc, cur, ui, wr, wc, fr, fq); S.done(cur); }
        if (!has_next) break;
#pragma unroll
        for (int a = 0; a < 2; ++a)
#pragma unroll
            for (int b = 0; b < 2; ++b)
#pragma unroll
                for (int m = 0; m < 4; ++m)
#pragma unroll
                    for (int n = 0; n < 2; ++n) acc[a][b][m][n] = (f32x4){0.f, 0.f, 0.f, 0.f};
        cur = nxt; cA = nA; cB = nB; ++ui;
        if constexpr (ALIGN_EPI) { if (wr == 1) PG8_BAR; }
    }
    PG8_WAIT_V(0);
    if constexpr (!ALIGN_EPI) { if (wr == 0) PG8_BAR; }
    PG8_BAR;
    if constexpr (Epi::AFTER_DRAIN) { E.fused(acc, cur, wr, wc, fr, fq, lds, wid, lane); S.done(cur); }
#undef PG8_SA
#undef PG8_SB
#undef PG8_STAGE
#undef PG8_LDA
#undef PG8_LDB
#undef PG8_MMA
#undef PG8_WAIT_V
#undef PG8_WAIT_L
#undef PG8_BAR
#undef PG8_SCHED
}
}
namespace pg8 {
__device__ __forceinline__ float bf_lo(unsigned w) { return __uint_as_float(w << 16); }
__device__ __forceinline__ float bf_hi(unsigned w) { return __uint_as_float(w & 0xffff0000u); }
__device__ __forceinline__ float sigm(float x) { return 1.0f / (1.0f + __expf(-x)); }
typedef unsigned u32x2 __attribute__((ext_vector_type(2)));

template <bool G1>
struct EpiProjT {
    static constexpr bool PERM = true, AFTER_DRAIN = false;
    bf16_t* O; int ldc; const PG8_LAS float* rstd; bf16_t* KV; float* RSQ; bf16_t* RHO; bf16_t* SGB;
    static constexpr int kvtile = 4, sqtile = 9, gtile = 16;
    __device__ __forceinline__ void operator()(const f32x4 (&acc)[2][2][4][2], const Unit& u, int ui, int wr, int wc, int fr, int fq) const {
        const int rt0 = wr * 64 + fr, col0 = u.pn * BM + wc * 32 + 8 * fq;
        const bool sq = G1 && (u.pn == sqtile || u.pn == sqtile + 1);
#pragma unroll
        for (int ai = 0; ai < 2; ++ai)
#pragma unroll
            for (int m = 0; m < 4; ++m) { const int rt = rt0 + ai * HALF + m * 16; const float s = rstd[ui * 256 + rt];
                bf16_t* rowp = O + (size_t)(u.pm * BM + rt) * ldc + col0;
                if constexpr (G1) { if (u.pn == kvtile) rowp = KV + (size_t)(u.pm * BM + rt) * 256 + wc * 32 + 8 * fq; }
                float ss = 0.f;
                if constexpr (G1) { if (u.pn >= gtile) {
                    const f32x4 a0 = acc[ai][0][m][0] * s, a1 = acc[ai][0][m][1] * s, b0 = acc[ai][1][m][0] * s, b1 = acc[ai][1][m][1] * s;
                    float ea[8], eb[8], rh[8], sb[8];
#pragma unroll
                    for (int j = 0; j < 4; ++j) { ea[j] = 1.0f + __expf(-a0[j]); ea[4 + j] = 1.0f + __expf(-a1[j]); eb[j] = 1.0f + __expf(-b0[j]); eb[4 + j] = 1.0f + __expf(-b1[j]); }
#pragma unroll
                    for (int j = 0; j < 8; ++j) { const float ia = __builtin_amdgcn_rcpf(ea[j]); rh[j] = eb[j] * ia; sb[j] = __builtin_amdgcn_rcpf(eb[j]); }
                    const size_t go = (size_t)(u.pm * BM + rt) * 2048 + (u.pn - gtile) * 128 + wc * 32 + 8 * fq;
                    u32x4 wr_, ws_; wr_.x = cvt_pk_bf16(rh[0], rh[1]); wr_.y = cvt_pk_bf16(rh[2], rh[3]); wr_.z = cvt_pk_bf16(rh[4], rh[5]); wr_.w = cvt_pk_bf16(rh[6], rh[7]);
                    ws_.x = cvt_pk_bf16(sb[0], sb[1]); ws_.y = cvt_pk_bf16(sb[2], sb[3]); ws_.z = cvt_pk_bf16(sb[4], sb[5]); ws_.w = cvt_pk_bf16(sb[6], sb[7]);
                    *(u32x4*)(RHO + go) = wr_; *(u32x4*)(SGB + go) = ws_;
                    continue; } }
#pragma unroll
                for (int bj = 0; bj < 2; ++bj) { const f32x4 v0 = acc[ai][bj][m][0] * s, v1 = acc[ai][bj][m][1] * s;
                    ss += (v0[0] * v0[0] + v0[1] * v0[1]) + (v0[2] * v0[2] + v0[3] * v0[3]) + (v1[0] * v1[0] + v1[1] * v1[1]) + (v1[2] * v1[2] + v1[3] * v1[3]);
                    u32x4 w; w.x = cvt_pk_bf16(v0[0], v0[1]); w.y = cvt_pk_bf16(v0[2], v0[3]); w.z = cvt_pk_bf16(v1[0], v1[1]); w.w = cvt_pk_bf16(v1[2], v1[3]);
                    *(u32x4*)(rowp + bj * HALF) = w; }
                if constexpr (G1) if (sq) { ss += __shfl_xor(ss, 16); ss += __shfl_xor(ss, 32); if (fq == 0) RSQ[(size_t)(u.pm * BM + rt) * 8 + (u.pn - sqtile) * 4 + wc] = ss; } }
    }
};
struct EpiPA {
    static constexpr bool PERM = false, AFTER_DRAIN = false;
    float* P; const bf16_t* G; int ldg;
    __device__ __forceinline__ void operator()(const f32x4 (&acc)[2][2][4][2], const Unit& u, int ui, int wr, int wc, int fr, int fq) const {
        const int col0 = u.pn * BM + wc * 32 + 4 * fq;
#pragma unroll
        for (int ai = 0; ai < 2; ++ai)
#pragma unroll
            for (int m = 0; m < 4; ++m) { const int row = u.pm * BM + ai * HALF + wr * 64 + m * 16 + fr;
#pragma unroll
                for (int bj = 0; bj < 2; ++bj)
#pragma unroll
                    for (int n = 0; n < 2; ++n) { const int c = col0 + bj * HALF + n * 16; const u32x2 g = *(const u32x2*)(G + (size_t)row * ldg + c);
                        f32x4 v = acc[ai][bj][m][n]; v[0] *= sigm(bf_lo(g.x)); v[1] *= sigm(bf_hi(g.x)); v[2] *= sigm(bf_lo(g.y)); v[3] *= sigm(bf_hi(g.y));
                        *(f32x4*)(P + (size_t)row * 2048 + c) = v; } }
    }
};
struct EpiMerge {
    static constexpr bool PERM = true, AFTER_DRAIN = false;
    bf16_t* O; const float* P; const bf16_t* G; int ldg;
    __device__ __forceinline__ void operator()(const f32x4 (&acc)[2][2][4][2], const Unit& u, int ui, int wr, int wc, int fr, int fq) const {
        const int col0 = u.pn * BM + wc * 32 + 8 * fq;
#pragma unroll
        for (int ai = 0; ai < 2; ++ai)
#pragma unroll
            for (int m = 0; m < 4; ++m) { const int row = u.pm * BM + ai * HALF + wr * 64 + m * 16 + fr;
#pragma unroll
                for (int bj = 0; bj < 2; ++bj) { const int c = col0 + bj * HALF; const u32x4 g = *(const u32x4*)(G + (size_t)row * ldg + c);
                    const f32x4 p0 = *(const f32x4*)(P + (size_t)row * 2048 + c), p1 = *(const f32x4*)(P + (size_t)row * 2048 + c + 4);
                    f32x4 v0 = acc[ai][bj][m][0], v1 = acc[ai][bj][m][1];
                    v0[0] = p0[0] + sigm(bf_lo(g.x)) * v0[0]; v0[1] = p0[1] + sigm(bf_hi(g.x)) * v0[1]; v0[2] = p0[2] + sigm(bf_lo(g.y)) * v0[2]; v0[3] = p0[3] + sigm(bf_hi(g.y)) * v0[3];
                    v1[0] = p1[0] + sigm(bf_lo(g.z)) * v1[0]; v1[1] = p1[1] + sigm(bf_hi(g.z)) * v1[1]; v1[2] = p1[2] + sigm(bf_lo(g.w)) * v1[2]; v1[3] = p1[3] + sigm(bf_hi(g.w)) * v1[3];
                    u32x4 w; w.x = cvt_pk_bf16(v0[0], v0[1]); w.y = cvt_pk_bf16(v0[2], v0[3]); w.z = cvt_pk_bf16(v1[0], v1[1]); w.w = cvt_pk_bf16(v1[2], v1[3]);
                    *(u32x4*)(O + (size_t)row * 2048 + c) = w; } }
    }
};
struct EpiG4 {
    static constexpr bool PERM = true, AFTER_DRAIN = false;
    bf16_t* O; float* P; const bf16_t* GA; const bf16_t* GB; int ldg;
    __device__ __forceinline__ void operator()(const f32x4 (&acc)[2][2][4][2], const Unit& u, int ui, int wr, int wc, int fr, int fq) const {
        const int col0 = u.pn * BM + wc * 32 + 8 * fq;
        const bf16_t* G = u.sel ? GB : GA;
#pragma unroll
        for (int ai = 0; ai < 2; ++ai)
#pragma unroll
            for (int m = 0; m < 4; ++m) { const int row = u.pm * BM + ai * HALF + wr * 64 + m * 16 + fr;
#pragma unroll
                for (int bj = 0; bj < 2; ++bj) { const int c = col0 + bj * HALF; const u32x4 g = *(const u32x4*)(G + (size_t)row * ldg + c);
                    f32x4 v0 = acc[ai][bj][m][0], v1 = acc[ai][bj][m][1];
                    v0[0] *= sigm(bf_lo(g.x)); v0[1] *= sigm(bf_hi(g.x)); v0[2] *= sigm(bf_lo(g.y)); v0[3] *= sigm(bf_hi(g.y));
                    v1[0] *= sigm(bf_lo(g.z)); v1[1] *= sigm(bf_hi(g.z)); v1[2] *= sigm(bf_lo(g.w)); v1[3] *= sigm(bf_hi(g.w));
                    float* pp = P + (size_t)row * 2048 + c;
                    if (u.sel == 0) { *(f32x4*)pp = v0; *(f32x4*)(pp + 4) = v1; }
                    else { v0 += *(const f32x4*)pp; v1 += *(const f32x4*)(pp + 4);
                        u32x4 w; w.x = cvt_pk_bf16(v0[0], v0[1]); w.y = cvt_pk_bf16(v0[2], v0[3]); w.z = cvt_pk_bf16(v1[0], v1[1]); w.w = cvt_pk_bf16(v1[2], v1[3]);
                        *(u32x4*)(O + (size_t)row * 2048 + c) = w; } } }
    }
};
struct EpiG4m {
    static constexpr bool PERM = true, AFTER_DRAIN = false, MIDK = true;
    bf16_t* O; const bf16_t* RHO; const bf16_t* SGB;
    __device__ __forceinline__ void scale(f32x4 (&acc)[2][2][4][2], const bf16_t* T, const Unit& u, int wr, int wc, int fr, int fq) const {
        const int col0 = u.pn * BM + wc * 32 + 8 * fq;
        u32x4 gv[2][4][2];
#pragma unroll
        for (int ai = 0; ai < 2; ++ai)
#pragma unroll
            for (int m = 0; m < 4; ++m)
#pragma unroll
                for (int bj = 0; bj < 2; ++bj) gv[ai][m][bj] = *(const u32x4*)(T + (size_t)(u.pm * BM + ai * HALF + wr * 64 + m * 16 + fr) * 2048 + col0 + bj * HALF);
        __builtin_amdgcn_sched_barrier(0);
#pragma unroll
        for (int ai = 0; ai < 2; ++ai)
#pragma unroll
            for (int m = 0; m < 4; ++m)
#pragma unroll
                for (int bj = 0; bj < 2; ++bj) { const u32x4 g = gv[ai][m][bj]; f32x4& v0 = acc[ai][bj][m][0]; f32x4& v1 = acc[ai][bj][m][1];
                    v0[0] *= bf_lo(g.x); v0[1] *= bf_hi(g.x); v0[2] *= bf_lo(g.y); v0[3] *= bf_hi(g.y); v1[0] *= bf_lo(g.z); v1[1] *= bf_hi(g.z); v1[2] *= bf_lo(g.w); v1[3] *= bf_hi(g.w); }
    }
    __device__ __forceinline__ void midk(f32x4 (&acc)[2][2][4][2], const Unit& u, int wr, int wc, int fr, int fq) const {
        asm volatile("" : "+v"(fr), "+v"(fq));
        scale(acc, RHO, u, wr, wc, fr, fq);
    }
    __device__ __forceinline__ void operator()(const f32x4 (&acc_)[2][2][4][2], const Unit& u, int ui, int wr, int wc, int fr, int fq) const {
        f32x4 acc[2][2][4][2];
#pragma unroll
        for (int a = 0; a < 2; ++a)
#pragma unroll
            for (int b = 0; b < 2; ++b)
#pragma unroll
                for (int m = 0; m < 4; ++m)
#pragma unroll
                    for (int n = 0; n < 2; ++n) acc[a][b][m][n] = acc_[a][b][m][n];
        scale(acc, SGB, u, wr, wc, fr, fq);
        const int col0 = u.pn * BM + wc * 32 + 8 * fq;
#pragma unroll
        for (int ai = 0; ai < 2; ++ai)
#pragma unroll
            for (int m = 0; m < 4; ++m) { const int row = u.pm * BM + ai * HALF + wr * 64 + m * 16 + fr;
#pragma unroll
                for (int bj = 0; bj < 2; ++bj) { const f32x4 v0 = acc[ai][bj][m][0], v1 = acc[ai][bj][m][1];
                    u32x4 w; w.x = cvt_pk_bf16(v0[0], v0[1]); w.y = cvt_pk_bf16(v0[2], v0[3]); w.z = cvt_pk_bf16(v1[0], v1[1]); w.w = cvt_pk_bf16(v1[2], v1[3]);
                    *(u32x4*)(O + (size_t)row * 2048 + col0 + bj * HALF) = w; } }
    }
};
struct DualOrder : StaticOrder {
    __host__ __device__ bool next(int i, Unit& u) const { if (!StaticOrder::next(i >> 1, u)) return false; u.sel = i & 1; return true; }
};
struct EpiRes {
    static constexpr bool PERM = false, AFTER_DRAIN = false;
    bf16_t* HB; float* RS;
    __device__ __forceinline__ void operator()(const f32x4 (&acc)[2][2][4][2], const Unit& u, int ui, int wr, int wc, int fr, int fq) const {
        const int col0 = u.pn * BM + wc * 32 + 4 * fq;
        u32x2 ho[2][4][2][2];
#pragma unroll
        for (int ai = 0; ai < 2; ++ai)
#pragma unroll
            for (int m = 0; m < 4; ++m) { const int row = u.pm * BM + ai * HALF + wr * 64 + m * 16 + fr;
#pragma unroll
                for (int bj = 0; bj < 2; ++bj)
#pragma unroll
                    for (int n = 0; n < 2; ++n) ho[ai][m][bj][n] = *(const u32x2*)(HB + (size_t)row * 2048 + col0 + bj * HALF + n * 16); }
        __builtin_amdgcn_sched_barrier(0);
#pragma unroll
        for (int ai = 0; ai < 2; ++ai)
#pragma unroll
            for (int m = 0; m < 4; ++m) { const int row = u.pm * BM + ai * HALF + wr * 64 + m * 16 + fr; float ss = 0.f;
#pragma unroll
                for (int bj = 0; bj < 2; ++bj)
#pragma unroll
                    for (int n = 0; n < 2; ++n) { const size_t off = (size_t)row * 2048 + col0 + bj * HALF + n * 16;
                        const u32x2 h0 = ho[ai][m][bj][n];
                        f32x4 hv = {bf_lo(h0.x), bf_hi(h0.x), bf_lo(h0.y), bf_hi(h0.y)}; hv += acc[ai][bj][m][n];
                        u32x2 w; w.x = cvt_pk_bf16(hv[0], hv[1]); w.y = cvt_pk_bf16(hv[2], hv[3]); *(u32x2*)(HB + off) = w;
                        ss += (hv[0] * hv[0] + hv[1] * hv[1]) + (hv[2] * hv[2] + hv[3] * hv[3]); }
                ss += __shfl_xor(ss, 16); ss += __shfl_xor(ss, 32);
                if (fq == 0) RS[(size_t)row * 32 + u.pn * 4 + wc] = ss; }
    }
};
}

#define GAS __attribute__((address_space(1)))
#define LAS __attribute__((address_space(3)))
typedef unsigned short bf16;
typedef unsigned v4u __attribute__((ext_vector_type(4)));
typedef float f32x4 __attribute__((ext_vector_type(4)));
typedef short bf16x8 __attribute__((ext_vector_type(8)));
typedef GAS unsigned gu32;
typedef GAS unsigned long long gu64;
#define RLX_AGENT __ATOMIC_RELAXED, __HIP_MEMORY_SCOPE_AGENT
#define LDS_WAIT() asm volatile("s_waitcnt lgkmcnt(0)" ::: "memory")
#define VM_WAIT() asm volatile("s_waitcnt vmcnt(0)" ::: "memory")
__device__ __forceinline__ unsigned long long rt() { return __builtin_amdgcn_s_memrealtime(); }
__device__ __forceinline__ unsigned f2bf(float f) { unsigned u = __builtin_bit_cast(unsigned, f); return (u + 0x7fffu + ((u >> 16) & 1u)) >> 16; }
__device__ __forceinline__ unsigned pk2(float lo, float hi) { return f2bf(lo) | (f2bf(hi) << 16); }

#define XB_TMO      128
#define XB_XCNT(j)  (256  + 64 * (j))
#define XB_XSUB(j)  (1280 + 64 * (j))
#define XB_XGEN(j)  (2304 + 64 * (j))
#define XB_TOP      3328
#define XB_TOPGEN   3392
#define XCD_BAR_WORDS 3456
#define XB_SPIN_CAP (1u << 18)

__device__ __forceinline__ unsigned xb_ld(unsigned* p)              { return __hip_atomic_load(p, __ATOMIC_RELAXED, __HIP_MEMORY_SCOPE_AGENT); }
__device__ __forceinline__ unsigned xb_add(unsigned* p, unsigned v) { return __hip_atomic_fetch_add(p, v, __ATOMIC_RELAXED, __HIP_MEMORY_SCOPE_AGENT); }
__device__ __forceinline__ unsigned xb_xcc_id() { return (unsigned)__builtin_amdgcn_s_getreg((3 << 11) | 20) & 0xFu; }
#define XB_SPIN(cond, bar) do { unsigned _sp = 0; while (cond) { __builtin_amdgcn_s_sleep(1); \
    if ((++_sp & 255u) == 0u) { if (xb_ld(&(bar)[XB_TMO])) break; if (_sp > XB_SPIN_CAP) { atomicAdd(&(bar)[XB_TMO], 1u); break; } } } } while (0)

struct XcdBarrier {
    unsigned* bar; unsigned x;
    volatile LAS unsigned* st;
};

__device__ __forceinline__ XcdBarrier xcd_barrier_post(unsigned* bar, volatile LAS unsigned* st) {
    XcdBarrier b; b.bar = bar; b.x = xb_xcc_id(); b.st = st;
    if (threadIdx.x == 0) (void)xb_add(&bar[XB_XCNT(b.x)], 1u);
    return b;
}
__device__ __forceinline__ void xcd_barrier_complete(unsigned* bar, unsigned x, unsigned& nloc, unsigned& nx) {
    const unsigned G = gridDim.x * gridDim.y * gridDim.z;
    unsigned sum, cnt, mine, sp = 0u;
    for (;;) {
        sum = 0u; cnt = 0u; mine = 0u;
#pragma unroll
        for (unsigned j = 0; j < 16; ++j) { const unsigned c = xb_ld(&bar[XB_XCNT(j)]); sum += c; cnt += (c > 0u) ? 1u : 0u; mine = (j == x) ? c : mine; }
        if (sum == G) break;
        __builtin_amdgcn_s_sleep(1);
        if ((++sp & 255u) == 0u) { if (xb_ld(&bar[XB_TMO])) break; if (sp > XB_SPIN_CAP) { atomicAdd(&bar[XB_TMO], 1u); break; } }
    }
    nloc = mine > 0u ? mine : 1u; nx = cnt > 0u ? cnt : 1u;
}

__device__ __forceinline__ void xcd_barrier(const XcdBarrier& b, bool thread0) {
    asm volatile("s_waitcnt vmcnt(0)" ::: "memory");
    __syncthreads();
    if (thread0) {
        unsigned* bar = b.bar;
        __builtin_amdgcn_s_waitcnt(0);
        unsigned nloc = b.st[0], nx = b.st[1];
        if (nloc == 0u) { xcd_barrier_complete(bar, b.x, nloc, nx); b.st[0] = nloc; b.st[1] = nx; }
        const unsigned old = xb_add(&bar[XB_XSUB(b.x)], 1u);
        const unsigned gen = old / nloc;
        if (old + 1u == (gen + 1u) * nloc) {
            __builtin_amdgcn_fence(__ATOMIC_RELEASE, "agent");
            asm volatile("s_waitcnt vmcnt(0)" ::: "memory");
            const unsigned og = xb_add(&bar[XB_TOP], 1u);
            const unsigned tg = og / nx;
            if (og + 1u == (tg + 1u) * nx) xb_add(&bar[XB_TOPGEN], 1u);
            else XB_SPIN(xb_ld(&bar[XB_TOPGEN]) == tg, bar);
            __builtin_amdgcn_fence(__ATOMIC_ACQUIRE, "agent");
            xb_add(&bar[XB_XGEN(b.x)], 1u);
            asm volatile("s_waitcnt vmcnt(0)" ::: "memory");
        } else {
            XB_SPIN(xb_ld(&bar[XB_XGEN(b.x)]) == gen, bar);
            __builtin_amdgcn_fence(__ATOMIC_ACQUIRE, "agent");
            asm volatile("s_waitcnt vmcnt(0)" ::: "memory");
        }
    }
    __syncthreads();
}
#ifndef MK_PROBE
#define MK_PROBE (-1)
#endif
#ifndef MK_PROBE_SCALE
#define MK_PROBE_SCALE 4e-6f
#endif
#define PROBE_T0() unsigned long long pt0_ = 0; if (MK_PROBE >= 0) { pt0_ = __builtin_amdgcn_s_memtime(); asm volatile("s_waitcnt lgkmcnt(0)" ::: "memory"); }
#define PROBE_T1(id) do { if (MK_PROBE == (id)) { const unsigned long long pt1_ = __builtin_amdgcn_s_memtime(); asm volatile("s_waitcnt lgkmcnt(0)" ::: "memory"); \
    if (C.bid == 0 && C.wave == 0 && C.lane == 0) { volatile LAS unsigned* pw_ = (volatile LAS unsigned*)(C.lds + MISC_OFF + 64); pw_[0] = pw_[0] + (unsigned)(pt1_ - pt0_); } } } while (0)
constexpr int NWAVES = 8;
constexpr int NLAYER = 4, DM = 2048, NBATCH = 2, SEQ = 4096, NMETA = 16, LTOK = SEQ + NMETA, NTOK = NBATCH * LTOK;
constexpr int MP = 8448;
constexpr int NP1 = 8448;
constexpr int NC_IN = 8264;
constexpr int PC_QA = 0, PC_KA = 1024, PC_VA = 1152, PC_ZA = 1280, PC_CQ = 2304, PC_CKV = 2816, PC_ZB = 3072, PC_GA = 4096, PC_GB = 6144, PC_KIDX = 8192, PC_WIDX = 8256;
constexpr int NQ2 = 4608;
constexpr int TOPK = 256;
constexpr int YLD = 2048;
constexpr float RMS_EPS = 1e-6f;

__device__ __forceinline__ int rowof(int b, int t) { return t < NMETA ? 8192 + b * NMETA + t : b * SEQ + (t - NMETA); }
__device__ __forceinline__ int t5_bucket(int d) {
    const int n = d < 0 ? 0 : d;
    if (n < 16) return n;
    return 16 + (n >= 19) + (n >= 21) + (n >= 24) + (n >= 27) + (n >= 31) + (n >= 35) + (n >= 40) + (n >= 46) + (n >= 52) + (n >= 59) + (n >= 67) + (n >= 77) + (n >= 87) + (n >= 99) + (n >= 113);
}
__device__ __forceinline__ float bf2f(bf16 v) { return __uint_as_float((unsigned)v << 16); }
__device__ __forceinline__ float sigmoidf_(float x) { return 1.0f / (1.0f + __expf(-x)); }
__device__ __forceinline__ float siluf_(float x) { return x / (1.0f + __expf(-x)); }
__device__ __forceinline__ float wave_sum(float v) {
#pragma unroll
    for (int o = 1; o < 64; o <<= 1) v += __shfl_xor(v, o);
    return v;
}
__device__ __forceinline__ float wave_max(float v) {
#pragma unroll
    for (int o = 1; o < 64; o <<= 1) v = fmaxf(v, __shfl_xor(v, o));
    return v;
}
__device__ __forceinline__ int wave_sum_i(int v) {
#pragma unroll
    for (int o = 1; o < 64; o <<= 1) v += __shfl_xor(v, o);
    return v;
}

constexpr size_t MiB = 1u << 20;
constexpr size_t WS_CTL = 0, CTL_ZERO_BYTES = 1 * MiB;
constexpr size_t SZ_W1 = (size_t)NLAYER * NP1 * DM * 2, SZ_W2 = (size_t)NLAYER * NQ2 * 512 * 2, SZ_WA = (size_t)NLAYER * DM * 1024 * 2, SZ_WO = (size_t)NLAYER * DM * DM * 2;
constexpr size_t al(size_t x) { return (x + 4095) / 4096 * 4096; }
constexpr size_t WS_W1 = 1 * MiB, WS_W2 = WS_W1 + al(SZ_W1), WS_WA = WS_W2 + al(SZ_W2), WS_WB = WS_WA + 1024 * 2, WS_WO = WS_WA + al(2 * SZ_WA);
constexpr size_t SZ_WUV = (size_t)NLAYER * 16 * 64 * 256 * 2;
constexpr size_t WS_WUV = WS_WO + al(SZ_WO);
constexpr size_t WS_VT = WS_WUV + al(SZ_WUV);
constexpr size_t WS_KV = WS_VT + al((size_t)2 * 128 * 4128 * 2), WS_KIDX = WS_KV + al((size_t)MP * 256 * 2);
constexpr size_t WS_H = WS_KIDX + al((size_t)MP * 64 * 2), WS_HB = WS_H + al((size_t)MP * DM * 4), WS_RS = WS_HB + al((size_t)MP * DM * 2);
constexpr size_t WS_RS2 = WS_RS + al((size_t)MP * 32 * 4);
constexpr size_t WS_RSQ = WS_RS2 + al((size_t)32 * 64 * 4), WS_RSQ2 = WS_RSQ + al((size_t)MP * 8 * 4);
constexpr size_t WS_PROJ = WS_RSQ2 + al((size_t)32 * 16 * 4), WS_CQN = WS_PROJ + al((size_t)MP * NP1 * 2), WS_CKVN = WS_CQN + al((size_t)MP * 512 * 2);
constexpr size_t WS_Q2 = WS_CKVN + al((size_t)MP * 256 * 2), WS_OLAT = WS_Q2 + al((size_t)MP * NQ2 * 2), WS_YA = WS_OLAT + al((size_t)256 * 3 * 16 * 8 * 64 * 8 * 2);
constexpr size_t WS_YB = WS_YA + 1024 * 2, WS_PA = WS_YA + al((size_t)MP * 2048 * 2),
 WS_MG = WS_PA + al((size_t)MP * DM * 4), WS_RHO = WS_MG + al((size_t)MP * DM * 2), WS_SGB = WS_RHO + al((size_t)MP * DM * 2), WS_END = WS_SGB + al((size_t)MP * DM * 2);
constexpr int CW_TMO = 0, CW_CODE = 1, CW_BAR = 4096;

constexpr int LDSCTL_OFF = 0, MISC_OFF = LDSCTL_OFF + 320;
constexpr int RSTD_OFF = 512;
constexpr int RING_OFF = 8192, RING_BYTES = 131072;
constexpr int LDS_BYTES = 163840;
static_assert(RSTD_OFF + 5 * 256 * 4 <= RING_OFF, "LDS map");

struct Args {
    const float* x; const float* meta; const float* bias_table; const float* norm_g; const float* w_in; const float* q_norm_g; const float* kv_norm_g; const float* w_qb; const float* w_iq;
    const float* w_uk; const float* w_uv; const float* sinks; const float* w_proj_a; const float* w_proj_b; const float* w_out; const float* final_g;
    float* out; unsigned char* ws; int ph_lo, ph_hi;
};

struct XDesc { const float* W; const float* scale; bf16* out; int ldw, k0, c0, nvalid, K; };
__device__ __forceinline__ void xpose_load(const XDesc& d, float (&v)[32], int lane) {
    asm volatile("" : "+v"(lane));
    const int c = lane & 31; const float* p = d.W + (size_t)(d.k0 + (lane >> 5)) * d.ldw + d.c0 + c;
#pragma unroll
    for (int i = 0; i < 32; ++i) v[i] = (c < d.nvalid) ? p[(size_t)(2 * i) * d.ldw] : 0.f;
    if (d.scale) {
#pragma unroll
        for (int i = 0; i < 32; ++i) v[i] *= d.scale[d.k0 + 2 * i + (lane >> 5)];
    }
}
__device__ __forceinline__ void xpose_store(const XDesc& d, const float (&v)[32], LAS float* scr, int lane) {
    asm volatile("" : "+v"(lane));
    const int c = lane & 31;
#pragma unroll
    for (int i = 0; i < 32; ++i) scr[(2 * i + (lane >> 5)) * 33 + c] = v[i];
    LDS_WAIT(); asm volatile("" ::: "memory");
    const int cc = lane & 7;
#pragma unroll
    for (int j = 0; j < 4; ++j) { const int n = (lane >> 3) + 8 * j; const LAS float* s = scr + (8 * cc) * 33 + n;
        v4u o; o.x = pk2(s[0 * 33], s[1 * 33]); o.y = pk2(s[2 * 33], s[3 * 33]); o.z = pk2(s[4 * 33], s[5 * 33]); o.w = pk2(s[6 * 33], s[7 * 33]);
        *(GAS v4u*)(d.out + (size_t)n * d.K + d.k0 + 8 * cc) = o; }
    LDS_WAIT(); asm volatile("" ::: "memory");
}
__device__ __forceinline__ void fold_item(const float* __restrict__ wqb, const float* __restrict__ wuk, const float* __restrict__ gq, bf16* W2l, int h, int kb, int rb, LAS float* scr, int lane) {
    const int rr = lane & 31, r = rb * 32 + rr;
    float uk[64];
#pragma unroll
    for (int d = 0; d < 64; ++d) uk[d] = wuk[((size_t)h * 64 + d) * 256 + r];
    for (int i = 0; i < 32; ++i) { const int kk = 2 * i + (lane >> 5), k = kb * 64 + kk; const f32x4* qp = (const f32x4*)(wqb + (size_t)k * 1024 + h * 64); float a = 0.f;
#pragma unroll
        for (int d4 = 0; d4 < 16; ++d4) { const f32x4 q = qp[d4]; a = fmaf(q[0], uk[4 * d4], a); a = fmaf(q[1], uk[4 * d4 + 1], a); a = fmaf(q[2], uk[4 * d4 + 2], a); a = fmaf(q[3], uk[4 * d4 + 3], a); }
        scr[kk * 33 + rr] = a * gq[k]; }
    LDS_WAIT(); asm volatile("" ::: "memory");
    const int cc = lane & 7; bf16* out = W2l + (size_t)(h * 256 + rb * 32) * 512;
#pragma unroll
    for (int j = 0; j < 4; ++j) { const int n = (lane >> 3) + 8 * j; const LAS float* s = scr + (8 * cc) * 33 + n;
        v4u o; o.x = pk2(s[0 * 33], s[1 * 33]); o.y = pk2(s[2 * 33], s[3 * 33]); o.z = pk2(s[4 * 33], s[5 * 33]); o.w = pk2(s[6 * 33], s[7 * 33]);
        *(GAS v4u*)(out + (size_t)n * 512 + kb * 64 + 8 * cc) = o; }
    LDS_WAIT(); asm volatile("" ::: "memory");
}

struct Ctx {
    LAS unsigned char* lds; int tid, lane, wave, G, gw, NGW, bid;
    Args a;
};
#if defined(__HIP_DEVICE_COMPILE__)
#define ASSUME_GLOBAL(p) do { __builtin_assume(!__builtin_amdgcn_is_shared((const void*)(p))); __builtin_assume(!__builtin_amdgcn_is_private((const void*)(p))); } while (0)
#else
#define ASSUME_GLOBAL(p) do { } while (0)
#endif
__device__ __forceinline__ unsigned char* launder(unsigned char* p) { size_t z = 0; asm volatile("" : "+s"(z)); return p + z; }
__device__ __forceinline__ const float* launderf(const float* p) { size_t z = 0; asm volatile("" : "+s"(z)); return p + z; }
struct Bufs {
    bf16 *W1, *W2, *WA, *WB, *WO, *WUV, *VT, *KV, *KIDX, *RHO, *SGB, *HB, *PROJ, *CQN, *CKVN, *Q2, *OLAT, *YA, *YB, *MG; float *H, *RS, *RS2, *RSQ, *RSQ2, *PA;
    __device__ __forceinline__ explicit Bufs(unsigned char* ws0) {
        unsigned char* ws = launder(ws0);
        W1 = (bf16*)(ws + WS_W1); W2 = (bf16*)(ws + WS_W2); WA = (bf16*)(ws + WS_WA); WB = (bf16*)(ws + WS_WB); WO = (bf16*)(ws + WS_WO); WUV = (bf16*)(ws + WS_WUV); VT = (bf16*)(ws + WS_VT); KV = (bf16*)(ws + WS_KV); KIDX = (bf16*)(ws + WS_KIDX); RHO = (bf16*)(ws + WS_RHO); SGB = (bf16*)(ws + WS_SGB);
        H = (float*)(ws + WS_H); HB = (bf16*)(ws + WS_HB); RS = (float*)(ws + WS_RS); RS2 = (float*)(ws + WS_RS2); RSQ = (float*)(ws + WS_RSQ); RSQ2 = (float*)(ws + WS_RSQ2); PROJ = (bf16*)(ws + WS_PROJ); CQN = (bf16*)(ws + WS_CQN); CKVN = (bf16*)(ws + WS_CKVN);
        Q2 = (bf16*)(ws + WS_Q2); OLAT = (bf16*)(ws + WS_OLAT); YA = (bf16*)(ws + WS_YA); YB = (bf16*)(ws + WS_YB); PA = (float*)(ws + WS_PA); MG = (bf16*)(ws + WS_MG);
    }
};

__device__ __forceinline__ void p0_prologue(const Ctx& C) {
    const Bufs B(C.a.ws);
    const Args& A = C.a;
    LAS float* scr = (LAS float*)(C.lds + RING_OFF + C.wave * 16384);
    constexpr int I_T1 = (DM / 64) * (NP1 / 32), I_T2 = (512 / 64) * (512 / 32), I_T3 = (1024 / 64) * (DM / 32), I_T5 = (DM / 64) * (DM / 32), I_F = 16 * 8 * 8, I_UV = 16 * 8;
    constexpr int I_X = I_T1 + I_T2 + 2 * I_T3 + I_T5, NX = NLAYER * I_X;
    auto decode = [&](int it) -> XDesc {
        const int l = it / I_X; int r = it % I_X; XDesc d;
        if (r < I_T1) { const int nblk = NP1 / 32, kb = r / nblk, n0 = (r % nblk) * 32; int c0, nvalid = 32;
            if (n0 < 4096) c0 = n0; else if (n0 < 8192) { const int tt = (n0 - 4096) >> 8, wi = (n0 - 4096) & 255; c0 = (wi < 128 ? 4168 : 6216 - 128) + 128 * tt + wi; }
            else { c0 = n0 - 8192 + 4096; nvalid = (8264 - n0) < 0 ? 0 : ((8264 - n0) > 32 ? 32 : (8264 - n0)); }
            d = XDesc{A.w_in + (size_t)l * DM * NC_IN, A.norm_g + l * DM, B.W1 + ((size_t)l * NP1 + n0) * DM, NC_IN, kb * 64, c0, nvalid, DM}; return d; }
        r -= I_T1;
        if (r < I_T2) { const int nblk = 512 / 32, kb = r / nblk, nb = r % nblk;
            d = XDesc{A.w_iq + (size_t)l * 512 * 512, A.q_norm_g + l * 512, B.W2 + ((size_t)l * NQ2 + 4096 + nb * 32) * 512, 512, kb * 64, nb * 32, 32, 512}; return d; }
        r -= I_T2;
        if (r < 2 * I_T3) { const bool second = r >= I_T3; if (second) r -= I_T3; const int nblk = DM / 32, kb = r / nblk, nb = r % nblk;
            d = XDesc{(second ? A.w_proj_b : A.w_proj_a) + (size_t)l * 1024 * DM, nullptr, (second ? B.WB : B.WA) + ((size_t)l * DM + nb * 32) * 2048, DM, kb * 64, nb * 32, 32, 2048}; return d; }
        r -= 2 * I_T3;
        { const int nblk = DM / 32, kb = r / nblk, nb = r % nblk;
            d = XDesc{A.w_out + (size_t)l * DM * DM, nullptr, B.WO + ((size_t)l * DM + nb * 32) * DM, DM, kb * 64, nb * 32, 32, DM}; return d; }
    };
    {
        int it = C.gw;
        if (it < NX) {
            XDesc dc = decode(it); float vc[32]; xpose_load(dc, vc, C.lane);
            for (;;) {
                const int itn = it + C.NGW; const bool more = itn < NX;
                XDesc dn = dc; float vn[32];
                if (more) { dn = decode(itn); xpose_load(dn, vn, C.lane); }
                xpose_store(dc, vc, scr, C.lane);
                if (!more) break;
                dc = dn; it = itn;
#pragma unroll
                for (int i = 0; i < 32; ++i) vc[i] = vn[i];
            }
        }
    }
    for (int it = C.gw; it < NLAYER * (I_F + I_UV); it += C.NGW) {
        const int l = it / (I_F + I_UV); int r = it % (I_F + I_UV);
        if (r >= I_F) { r -= I_F; const int h = r / 8, s = r % 8;
            const float* wsrc = A.w_uv + ((size_t)l * 16 + h) * 256 * 64; const int gg = C.lane >> 4, cc = C.lane & 15;
#pragma unroll
            for (int nt = 0; nt < 4; ++nt) { const float* p = wsrc + (size_t)(32 * s + 8 * gg) * 64 + 16 * nt + cc;
                v4u o; o.x = pk2(p[0 * 64], p[1 * 64]); o.y = pk2(p[2 * 64], p[3 * 64]); o.z = pk2(p[4 * 64], p[5 * 64]); o.w = pk2(p[6 * 64], p[7 * 64]);
                *(GAS v4u*)(B.WUV + ((((size_t)l * 16 + h) * 8 + s) * 4 + nt) * 512 + C.lane * 8) = o; }
            continue; }
        { const int h = r / 64, kb = (r / 8) % 8, rb = r % 8;
            fold_item(A.w_qb + (size_t)l * 512 * 1024, A.w_uk + (size_t)l * 16 * 64 * 256, A.q_norm_g + l * 512, B.W2 + (size_t)l * NQ2 * 512, h, kb, rb, scr, C.lane); }
    }
    for (int m = C.gw; m < MP; m += C.NGW) {
        const float* src = nullptr;
        if (m < 8192) src = A.x + (size_t)m * DM; else if (m < 8224) src = A.meta + (size_t)((m - 8192) % NMETA) * DM;
        float ss = 0.f;
#pragma unroll
        for (int j = 0; j < 8; ++j) { f32x4 v = src ? *(const f32x4*)(src + j * 256 + C.lane * 4) : (f32x4){0.f, 0.f, 0.f, 0.f};
            pg8::u32x2 w; w.x = pk2(v[0], v[1]); w.y = pk2(v[2], v[3]); *(pg8::u32x2*)(B.HB + (size_t)m * DM + j * 256 + C.lane * 4) = w;
            ss += (v[0] * v[0] + v[1] * v[1]) + (v[2] * v[2] + v[3] * v[3]); }
        ss = wave_sum(ss);
        if (C.lane < 32) B.RS[(size_t)m * 32 + C.lane] = (C.lane == 0) ? ss : 0.f;
        if (m >= 8192 && m < 8224) B.RS2[(size_t)(m - 8192) * 64 + C.lane] = (C.lane == 0) ? ss : 0.f;
        if (m >= NTOK) {
#pragma unroll
            for (int j = 0; j < 2; ++j) { *(v4u*)(B.YA + (size_t)m * YLD + j * 512 + C.lane * 8) = (v4u){0u, 0u, 0u, 0u}; *(v4u*)(B.YB + (size_t)m * YLD + j * 512 + C.lane * 8) = (v4u){0u, 0u, 0u, 0u}; }
        }
    }
}

template <int NP4>
__device__ __forceinline__ void rstd_table(const Ctx& C, const pg8::StaticOrder& S, const float* __restrict__ rs, float inv_dim) {
    LAS float* tbl = (LAS float*)(C.lds + RSTD_OFF);
    pg8::Unit u;
    for (int ui = 0; ui < 5 && S.next(ui, u); ++ui) {
        if (C.tid < 256) { const f32x4* p = (const f32x4*)(rs + (size_t)(u.pm * 256 + C.tid) * (NP4 * 4)); float s = 0.f;
#pragma unroll
            for (int j = 0; j < NP4; ++j) { const f32x4 v = p[j]; s += (v[0] + v[1]) + (v[2] + v[3]); }
            tbl[ui * 256 + C.tid] = rsqrtf(s * inv_dim + RMS_EPS); }
    }
    __syncthreads();
}

__device__ __forceinline__ void norm_tail(const Ctx& C, int l) {
    const Bufs B(C.a.ws);
    const Args& A = C.a;
    for (int m = C.gw; m < NTOK; m += C.NGW) {
        const bf16* pr = B.PROJ + (size_t)m * NP1;
        { const pg8::u32x2 w = *(const pg8::u32x2*)(pr + PC_CKV + C.lane * 4); float v[4] = {pg8::bf_lo(w.x), pg8::bf_hi(w.x), pg8::bf_lo(w.y), pg8::bf_hi(w.y)};
          float ss = (v[0] * v[0] + v[1] * v[1]) + (v[2] * v[2] + v[3] * v[3]);
          ss = wave_sum(ss); const float r = rsqrtf(ss * (1.0f / 256.0f) + RMS_EPS);
          const f32x4 g = *(const f32x4*)(A.kv_norm_g + l * 256 + C.lane * 4);
          pg8::u32x2 o; o.x = pk2(v[0] * r * g[0], v[1] * r * g[1]); o.y = pk2(v[2] * r * g[2], v[3] * r * g[3]);
          *(pg8::u32x2*)(B.CKVN + (size_t)m * 256 + C.lane * 4) = o; }
    }
    for (int it = C.gw; it < 2 * 65; it += C.NGW) { const int b = it / 65, pos = (it % 65) * 64 + C.lane;
        if (pos < LTOK) { const bf16* vr = B.KV + (size_t)rowof(b, pos) * 256 + 128;
#pragma unroll 4
            for (int c8 = 0; c8 < 16; ++c8) { const v4u w = *(const v4u*)(vr + 8 * c8); bf16* o = B.VT + ((size_t)b * 128 + 8 * c8) * 4128 + pos;
                o[0 * 4128] = (bf16)(w.x & 0xffffu); o[1 * 4128] = (bf16)(w.x >> 16); o[2 * 4128] = (bf16)(w.y & 0xffffu); o[3 * 4128] = (bf16)(w.y >> 16);
                o[4 * 4128] = (bf16)(w.z & 0xffffu); o[5 * 4128] = (bf16)(w.z >> 16); o[6 * 4128] = (bf16)(w.w & 0xffffu); o[7 * 4128] = (bf16)(w.w >> 16); } } }
}

__device__ __forceinline__ unsigned f2key(float f) { const unsigned u = __float_as_uint(f); return (u & 0x80000000u) ? ~u : (u | 0x80000000u); }

__device__ __forceinline__ void final_phase(const Ctx& C) {
    const Bufs B(C.a.ws);
    const Args& A = C.a;
    for (int m = C.gw; m < 8192; m += C.NGW) {
        float s = (C.lane < 32) ? B.RS[(size_t)m * 32 + C.lane] : 0.f;
        s = wave_sum(s);
        const float r = rsqrtf(s * (1.0f / DM) + RMS_EPS);
#pragma unroll
        for (int j = 0; j < 8; ++j) { const pg8::u32x2 hw = *(const pg8::u32x2*)(B.HB + (size_t)m * DM + j * 256 + C.lane * 4); const f32x4 v = {pg8::bf_lo(hw.x), pg8::bf_hi(hw.x), pg8::bf_lo(hw.y), pg8::bf_hi(hw.y)}; const f32x4 g = *(const f32x4*)(A.final_g + j * 256 + C.lane * 4);
            *(f32x4*)(A.out + (size_t)m * DM + j * 256 + C.lane * 4) = v * r * g; }
    }
#if defined(MK_PROBE)
    if (MK_PROBE >= 0 && C.gw == 0) { VM_WAIT(); if (C.lane == 0) A.out[0] += (float)((volatile LAS unsigned*)(C.lds + MISC_OFF + 64))[0] * MK_PROBE_SCALE; }
#endif
}


struct SkProj {
    bf16* P; bf16* KV; bf16* KIDX; int cb; const LAS float* tbl;
    __device__ __forceinline__ float operator()(int rloc, int c, float v) const { const int ac = cb + c; const bf16 o = (bf16)f2bf(v * tbl[rloc]);
        if (ac >= 1024 && ac < 1280) KV[(size_t)rloc * 256 + ac - 1024] = o; else if (ac >= 8192 && ac < 8256) KIDX[(size_t)rloc * 64 + ac - 8192] = o; else P[(size_t)rloc * NP1 + ac] = o;
        return v * tbl[rloc]; } };
struct SkQ2 { bf16* O; const LAS float* tbl; __device__ __forceinline__ float operator()(int rloc, int c, float v) const { O[(size_t)rloc * NQ2 + c] = (bf16)f2bf(v * tbl[rloc]); return 0.f; } };
struct SkPA { float* P; const bf16* G; int c0; __device__ __forceinline__ float operator()(int rloc, int c, float v) const { const int cg = c0 + c; P[(size_t)rloc * DM + c] = sigmoidf_(bf2f(G[(size_t)rloc * NP1 + 256 * (cg >> 7) + (cg & 127)])) * v; return 0.f; } };
struct SkMerge { bf16* O; const float* P; const bf16* G; int c0; __device__ __forceinline__ float operator()(int rloc, int c, float v) const { const int cg = c0 + c; O[(size_t)rloc * DM + c] = (bf16)f2bf(P[(size_t)rloc * DM + c] + sigmoidf_(bf2f(G[(size_t)rloc * NP1 + 256 * (cg >> 7) + (cg & 127) + 128])) * v); return 0.f; } };
struct SkRes { bf16* HB; __device__ __forceinline__ float operator()(int rloc, int c, float v) const { const float h = bf2f(HB[(size_t)rloc * DM + c]) + v; HB[(size_t)rloc * DM + c] = (bf16)f2bf(h); return h; } };
constexpr int MR = 8192;
typedef float f32x16 __attribute__((ext_vector_type(16)));
__device__ __forceinline__ void sk_glds16(const void* gsrc, unsigned lds_dst) { unsigned keep;
    asm volatile("s_mov_b32 %0, m0\n\ts_mov_b32 m0, %2\n\ts_nop 0\n\tglobal_load_lds_dwordx4 %1, off\n\ts_mov_b32 m0, %0" : "=&s"(keep) : "v"(gsrc), "s"(lds_dst) : "memory"); }
template <int NT, int GPI, class F>
__device__ __forceinline__ void skinny_unit(const Ctx& C, const bf16* __restrict__ A, int lda, const bf16* __restrict__ Bt, int ldb, int K, float* ss_out  , int ss_ld, int ss_col0, const F& epi) {
    const int lane = C.lane, w = C.wave, r32 = lane & 31, hh = lane >> 5;
    f32x16 acc[NT];
#pragma unroll
    for (int nt = 0; nt < NT; ++nt) acc[nt] = (f32x16){};
    const int kper = K >> 3, ngroups = kper >> 6;
    const unsigned stg = (unsigned)__builtin_amdgcn_readfirstlane((unsigned)(uintptr_t)(C.lds + RING_OFF) + (unsigned)w * 16384u);
    LAS unsigned char* stp = C.lds + RING_OFF + w * 16384;
    const int prow = lane >> 3, pch = lane & 7;
    const int foff = r32 * 128;
    const int fsw = (r32 >> 1) & 7;
#pragma unroll 1
    for (int g0 = 0; g0 < ngroups; ++g0) {
        const size_t kbyte = ((size_t)w * kper + (size_t)g0 * 64) * 2;
#pragma unroll
        for (int p = 0; p < 4; ++p) { const int row = 8 * p + prow; const int lg = pch ^ ((row >> 1) & 7);
            sk_glds16((const unsigned char*)A + (size_t)row * lda * 2 + kbyte + lg * 16, stg + p * 1024); }
#pragma unroll
        for (int nt = 0; nt < NT; ++nt)
#pragma unroll
            for (int p = 0; p < 4; ++p) { const int row = 8 * p + prow; const int lg = pch ^ ((row >> 1) & 7);
                sk_glds16((const unsigned char*)Bt + (size_t)(nt * 32 + row) * ldb * 2 + kbyte + lg * 16, stg + 4096 * (1 + nt) + p * 1024); }
        asm volatile("s_waitcnt vmcnt(0)" ::: "memory");
        bf16x8 a[4], bv[NT][4];
#pragma unroll
        for (int s = 0; s < 4; ++s) { const int o = foff + (((2 * s + hh) ^ fsw) << 4); a[s] = *(const LAS bf16x8*)(stp + o);
#pragma unroll
            for (int nt = 0; nt < NT; ++nt) bv[nt][s] = *(const LAS bf16x8*)(stp + 4096 * (1 + nt) + o); }
        __builtin_amdgcn_sched_barrier(0);
#pragma unroll
        for (int s = 0; s < 4; ++s)
#pragma unroll
            for (int nt = 0; nt < NT; ++nt) acc[nt] = __builtin_amdgcn_mfma_f32_32x32x16_bf16(a[s], bv[nt][s], acc[nt], 0, 0, 0);
        LDS_WAIT(); asm volatile("" ::: "memory");
    }
    LDS_WAIT(); __syncthreads();
    LAS float* part = (LAS float*)(C.lds + RING_OFF);
#pragma unroll
    for (int nt = 0; nt < NT; ++nt)
#pragma unroll
        for (int i = 0; i < 16; ++i) part[(w * NT * 16 + nt * 16 + i) * 64 + lane] = acc[nt][i];
    LDS_WAIT(); __syncthreads();
#pragma unroll
    for (int j = 0; j < 2 * NT; ++j) { const int e = (w + 8 * j) * 64 + lane;
        const int nti = w + 8 * j, nt = nti >> 4, i = nti & 15;
        float v = 0.f;
#pragma unroll
        for (int ww = 0; ww < 8; ++ww) v += part[ww * NT * 1024 + e];
        const int rloc = (i & 3) + 8 * (i >> 2) + 4 * hh, c = nt * 32 + r32;
        float sv = epi(rloc, c, v);
        if (ss_out != nullptr) { sv = sv * sv;
#pragma unroll
            for (int o = 1; o < 32; o <<= 1) sv += __shfl_xor(sv, o);
            if (r32 == 0) ss_out[(size_t)rloc * ss_ld + ss_col0 + nt] = sv; }
    }
    LDS_WAIT(); __syncthreads();
}
__device__ __forceinline__ void skinny_rstd(const Ctx& C, const float* __restrict__ rs, int np, float inv_dim, LAS float* tbl) {
    if (C.tid < 32) { float s = 0.f; const f32x4* p = (const f32x4*)(rs + (size_t)C.tid * np);
        for (int j = 0; j < np / 4; ++j) { const f32x4 v = p[j]; s += (v[0] + v[1]) + (v[2] + v[3]); }
        tbl[C.tid] = rsqrtf(s * inv_dim + RMS_EPS); }
    LDS_WAIT(); __syncthreads();
}

typedef short s16x4 __attribute__((ext_vector_type(4)));
typedef unsigned short u16x4 __attribute__((ext_vector_type(4)));
constexpr int DS_ISC = RING_OFF, DS_ISC_WORDS = 4128, DS_ISC_STRIDE = DS_ISC_WORDS * 4;
constexpr int DS_SEL = DS_ISC + 8 * DS_ISC_STRIDE;
constexpr int DS_BIAS = DS_SEL + 8 * 512;
constexpr int DS_QROW = DS_BIAS + 8192;
constexpr int DS_END = DS_QROW + 256;
constexpr size_t OL_BLOCK = (size_t)3 * 16 * 8 * 64 * 8;
static_assert(DS_END <= LDS_BYTES, "DSA LDS map");

__device__ __forceinline__ void glds16(const void* gsrc, unsigned lds_dst) { unsigned keep;
    asm volatile("s_mov_b32 %0, m0\n\ts_mov_b32 m0, %2\n\ts_nop 0\n\tglobal_load_lds_dwordx4 %1, off\n\ts_mov_b32 m0, %0" : "=&s"(keep) : "v"(gsrc), "s"(lds_dst) : "memory"); }
__device__ __forceinline__ float relu1(float x) { const int i = __float_as_int(x); return __int_as_float(i > 0 ? i : 0); }
__device__ __forceinline__ void glds16o(const void* base, unsigned voff, unsigned lds_dst) { unsigned keep;
    asm volatile("s_mov_b32 %0, m0\n\ts_mov_b32 m0, %3\n\ts_nop 0\n\tglobal_load_lds_dwordx4 %1, %2\n\ts_mov_b32 m0, %0" : "=&s"(keep) : "v"(voff), "s"(base), "s"(lds_dst) : "memory"); }
__device__ __forceinline__ s16x4 tr_read(LAS unsigned char* p) { typedef short v4i16_t __attribute__((ext_vector_type(4))); return __builtin_bit_cast(s16x4, __builtin_amdgcn_ds_read_tr16_b64_v4i16((LAS v4i16_t*)p)); }
__device__ __forceinline__ unsigned cvtpk(float lo, float hi) { typedef float f2_t __attribute__((ext_vector_type(2))); typedef __bf16 b2_t __attribute__((ext_vector_type(2))); f2_t v = {lo, hi}; b2_t b = __builtin_convertvector(v, b2_t); return __builtin_bit_cast(unsigned, b); }

#define DSA_LOCALS() const int w = C.wave; LAS unsigned* ISC = (LAS unsigned*)(C.lds + DS_ISC); LAS unsigned short* sel = (LAS unsigned short*)(C.lds + DS_SEL) + w * 256; const LAS float* biasl = (const LAS float*)(C.lds + DS_BIAS); (void)ISC; (void)sel; (void)biasl
#define RELANE() do { asm volatile("" : "+v"(lane)); asm volatile("" : "+s"(t0), "+s"(b)); } while (0)
__device__ __forceinline__ void dsa_step1(const Ctx& C, const Bufs& B, int b, int t0) {
    int lane = C.lane; RELANE(); DSA_LOCALS();
    PROBE_T0();
    {
        const int r32 = lane & 31, hh = lane >> 5;
        bf16x8 qa[2][4]; float wq[2][2][8];
        const int qi = 2 * ((r32 >> 2) & 1) + (r32 >> 4), hA = (r32 & 3) + 4 * ((r32 >> 3) & 1);
#pragma unroll
        for (int g = 0; g < 2; ++g) { const int row = rowof(b, t0 + 4 * g + qi);
#pragma unroll
            for (int s = 0; s < 4; ++s) qa[g][s] = *(const bf16x8*)(B.Q2 + (size_t)row * NQ2 + 4096 + hA * 64 + 16 * s + 8 * hh);
#pragma unroll
            for (int j = 0; j < 2; ++j) { const int rw = rowof(b, t0 + 4 * g + 2 * hh + j); const v4u ww = *(const v4u*)(B.PROJ + (size_t)rw * NP1 + PC_WIDX);
                const float sc = 0.35355339059327373f * 0.125f;
                wq[g][j][0] = pg8::bf_lo(ww.x) * sc; wq[g][j][1] = pg8::bf_hi(ww.x) * sc; wq[g][j][2] = pg8::bf_lo(ww.y) * sc; wq[g][j][3] = pg8::bf_hi(ww.y) * sc;
                wq[g][j][4] = pg8::bf_lo(ww.z) * sc; wq[g][j][5] = pg8::bf_hi(ww.z) * sc; wq[g][j][6] = pg8::bf_lo(ww.w) * sc; wq[g][j][7] = pg8::bf_hi(ww.w) * sc; } }
        PROBE_T1(40);
        const int nkeys = t0 + 8, nkt = (nkeys + 31) >> 5;
        bf16x8 kA[4], kB[4];
#define IDX_LOAD(dst, kt_) do { const int key_ = (kt_) * 32 + r32, kc_ = key_ < nkeys ? key_ : nkeys - 1; const bf16* kp_ = B.KIDX + (size_t)rowof(b, kc_) * 64 + 8 * hh; \
        asm volatile("global_load_dwordx4 %0, %4, off\n\tglobal_load_dwordx4 %1, %4, off offset:32\n\tglobal_load_dwordx4 %2, %4, off offset:64\n\tglobal_load_dwordx4 %3, %4, off offset:96" \
                     : "=&v"(dst[0]), "=&v"(dst[1]), "=&v"(dst[2]), "=&v"(dst[3]) : "v"(kp_) : "memory"); } while (0)
#define IDX_WAIT(cur) asm volatile("s_waitcnt vmcnt(12)" : "+v"(cur[0]), "+v"(cur[1]), "+v"(cur[2]), "+v"(cur[3]) :: "memory")
#define IDX_TILE(src, kt_) do { const int key_ = (kt_) * 32 + r32; \
        _Pragma("unroll") for (int g = 0; g < 2; ++g) { f32x16 acc = {}; \
            _Pragma("unroll") for (int s = 0; s < 4; ++s) acc = __builtin_amdgcn_mfma_f32_32x32x16_bf16(qa[g][s], src[s], acc, 0, 0, 0); \
            _Pragma("unroll") for (int j = 0; j < 2; ++j) { float isc = 0.f; \
                _Pragma("unroll") for (int h = 0; h < 8; ++h) isc += wq[g][j][h] * relu1(acc[8 * j + h]); \
                ISC[(4 * g + 2 * hh + j) * DS_ISC_WORDS + key_] = f2key(isc); } } } while (0)
        bf16x8 kC[4], kD[4];
        int kt = w;
        const int ktl = nkt - 1;
        if (kt < nkt) {
            __builtin_amdgcn_s_waitcnt(0x0F70);
            IDX_LOAD(kA, kt); IDX_LOAD(kB, (kt + 8 < nkt ? kt + 8 : ktl)); IDX_LOAD(kC, (kt + 16 < nkt ? kt + 16 : ktl));
#define IDX_STEP(cur, nxt) { IDX_LOAD(nxt, (kt + 24 < nkt ? kt + 24 : ktl)); IDX_WAIT(cur); __builtin_amdgcn_sched_barrier(0); IDX_TILE(cur, kt); __builtin_amdgcn_sched_barrier(0); kt += 8; if (kt >= nkt) break; }
#pragma unroll 1
            for (;;) {
                IDX_STEP(kA, kD)
                IDX_STEP(kB, kA)
                IDX_STEP(kC, kB)
                IDX_STEP(kD, kC)
            }
#undef IDX_STEP
            asm volatile("s_waitcnt vmcnt(0)" : "+v"(kA[0]), "+v"(kA[1]), "+v"(kA[2]), "+v"(kA[3]), "+v"(kB[0]), "+v"(kB[1]), "+v"(kB[2]), "+v"(kB[3]) :: "memory");
            asm volatile("" : "+v"(kC[0]), "+v"(kC[1]), "+v"(kC[2]), "+v"(kC[3]), "+v"(kD[0]), "+v"(kD[1]), "+v"(kD[2]), "+v"(kD[3]) :: "memory");
        }
#undef IDX_WAIT
#undef IDX_LOAD
#undef IDX_TILE
        PROBE_T1(41);
    }
}
__device__ __forceinline__ int dsa_step2(const Ctx& C, int b, int t0) {
    int lane = C.lane; RELANE(); DSA_LOCALS();
    const int t = t0 + w, n = t + 1;
    int cnt;
    if (n <= TOPK) { for (int j = lane; j < n; j += 64) sel[j] = (unsigned short)j; cnt = n; }
    else {
        const LAS unsigned* myrow = ISC + w * DS_ISC_WORDS;
        const int nI = (n + 255) >> 8;
        unsigned v[68];
#pragma unroll
        for (int i = 0; i < 17; ++i) { const pg8::u32x4 x = *(const LAS pg8::u32x4*)(myrow + 256 * i + 4 * lane);
#pragma unroll
            for (int e = 0; e < 4; ++e) v[4 * i + e] = (256 * i + 4 * lane + e <= t) ? x[e] : 0u; }
        unsigned T = 0u; bool exact = false;
#define DSA_COUNT(res, pred_expr) do { int c_ = 0; \
        _Pragma("unroll") for (int i = 0; i < 17; ++i) { if (i < nI) { _Pragma("unroll") for (int e = 0; e < 4; ++e) { const unsigned x_ = v[4 * i + e]; c_ += (pred_expr) ? 1 : 0; } } } \
        int tot_ = 0; _Pragma("unroll") for (int bt = 0; bt < 7; ++bt) tot_ += __popcll(__ballot((c_ >> bt) & 1)) << bt; res = tot_; } while (0)
#pragma unroll 1
        for (int bit = 31; bit >= 0; --bit) {
            const unsigned cand = T | (1u << bit); int c;
            DSA_COUNT(c, x_ >= cand);
            if (c >= TOPK) { T = cand; if (c == TOPK) { exact = true; break; } }
        }
        if (!exact) { int c; DSA_COUNT(c, x_ >= T); exact = (c == TOPK); }
#undef DSA_COUNT
        int base = 0;
#pragma unroll
        for (int k = 0; k < 68; ++k) { const bool p = exact ? (v[k] >= T) : (v[k] > T); const unsigned long long m = __ballot(p);
            const int pos = base + (int)__builtin_amdgcn_mbcnt_hi((unsigned)(m >> 32), __builtin_amdgcn_mbcnt_lo((unsigned)m, 0u));
            if (p) sel[pos] = (unsigned short)(256 * (k >> 2) + 4 * lane + (k & 3));
            base += __popcll(m); }
        if (!exact) {
            int last = -1;
            while (base < TOPK) { int mi = 0x7fffffff;
#pragma unroll
                for (int k = 0; k < 68; ++k) { const int idx = 256 * (k >> 2) + 4 * lane + (k & 3); if (v[k] == T && idx > last && idx < mi) mi = idx; }
#pragma unroll
                for (int o = 1; o < 64; o <<= 1) { const int oth = __shfl_xor(mi, o); mi = oth < mi ? oth : mi; }
                if (lane == 0) sel[base] = (unsigned short)mi;
                last = mi; ++base; }
        }
        cnt = TOPK;
    }
    return cnt;
}
__device__ __forceinline__ void dsa_step3(const Ctx& C, const Bufs& B, int b, int t0, int cnt, int qslot) {
    int lane = C.lane; RELANE(); DSA_LOCALS(); const int t = t0 + w;
    {
        const int g = lane >> 4, c16 = lane & 15, rowq = rowof(b, t);
        bf16x8 qf[8];
#pragma unroll
        for (int s = 0; s < 8; ++s) qf[s] = *(const bf16x8*)(B.Q2 + (size_t)rowq * NQ2 + c16 * 256 + 32 * s + 8 * g);
        f32x4 O[16];
#pragma unroll
        for (int rt = 0; rt < 16; ++rt) O[rt] = (f32x4){0.f, 0.f, 0.f, 0.f};
        float m_ref = 0.f, lsum = 0.f;
        const int buf0 = DS_ISC + w * DS_ISC_STRIDE;
        const int npairs = (cnt + 31) >> 5;
        const int swz = (c16 & 7) << 1;
        const int trow = 4 * g + (c16 >> 2), tswz = (trow & 7) << 1, tp = c16 & 3;
        const int arow = (c16 & 7) * 1024 + (c16 >> 3) * 512, trowo = (trow & 7) * 1024 + (trow >> 3) * 512;
        const unsigned ldsb = (unsigned)(uintptr_t)(C.lds + buf0);
#define DSA_GATHER(c_) do { const unsigned bo_ = (unsigned)__builtin_amdgcn_readfirstlane(ldsb + ((c_) & 1) * 8192); \
        const pg8::u32x4 sp_ = *(const LAS pg8::u32x4*)(sel + 16 * (c_) + 8 * (lane >> 5)); const unsigned spw_[4] = {sp_.x, sp_.y, sp_.z, sp_.w}; \
        _Pragma("unroll") for (int p = 0; p < 8; ++p) { const int j = 16 * (c_) + 8 * (lane >> 5) + p; int pos = (int)((spw_[p >> 1] >> (16 * (p & 1))) & 0xffffu); pos = j < cnt ? pos : 0; \
            const int logical = (lane & 31) ^ (p << 1); \
            glds16o(B.CKVN, (unsigned)rowof(b, pos) * 512u + (unsigned)logical * 16u, bo_ + p * 1024); } } while (0)
        DSA_GATHER(0); DSA_GATHER(1);
#pragma unroll 1
        for (int kp = 0; kp < npairs; ++kp) {
            asm volatile("s_waitcnt vmcnt(0)" ::: "memory");
            bf16x8 a0[8], a1[8]; s16x4 v0[16], v1[16];
#pragma unroll
            for (int s = 0; s < 8; ++s) { const int off = arow + (((4 * s + g) ^ swz) << 4); a0[s] = *(const LAS bf16x8*)(C.lds + buf0 + off); a1[s] = *(const LAS bf16x8*)(C.lds + buf0 + 8192 + off); }
            const u16x4 p0 = *(const LAS u16x4*)(sel + 32 * kp + 4 * g), p1 = *(const LAS u16x4*)(sel + 32 * kp + 16 + 4 * g);
            __builtin_amdgcn_sched_barrier(0);
            f32x4 s0 = {0.f, 0.f, 0.f, 0.f}, s1 = {0.f, 0.f, 0.f, 0.f};
#pragma unroll
            for (int s = 0; s < 8; ++s) { s0 = __builtin_amdgcn_mfma_f32_16x16x32_bf16(a0[s], qf[s], s0, 0, 0, 0); s1 = __builtin_amdgcn_mfma_f32_16x16x32_bf16(a1[s], qf[s], s1, 0, 0, 0); }
            __builtin_amdgcn_sched_barrier(0);
#pragma unroll
            for (int rt = 0; rt < 16; ++rt) { const int off = trowo + (((2 * rt + (tp >> 1)) ^ tswz) << 4) + 8 * (tp & 1); v0[rt] = tr_read(C.lds + buf0 + off); v1[rt] = tr_read(C.lds + buf0 + 8192 + off); }
            __builtin_amdgcn_sched_barrier(0);
            LDS_WAIT(); asm volatile("" ::: "memory");
            if (kp + 1 < npairs) { DSA_GATHER(2 * kp + 2); DSA_GATHER(2 * kp + 3); }
            __builtin_amdgcn_sched_barrier(0);
            float x0[4], x1[4]; float mloc = -INFINITY;
#pragma unroll
            for (int i = 0; i < 4; ++i) { const int j0 = 32 * kp + 4 * g + i, j1 = j0 + 16; int d0 = t - (int)p0[i], d1 = t - (int)p1[i]; d0 = d0 < 0 ? 0 : (d0 > 127 ? 127 : d0); d1 = d1 < 0 ? 0 : (d1 > 127 ? 127 : d1);
                const float b0 = biasl[d0 * 16 + c16], b1 = biasl[d1 * 16 + c16];
                const float y0 = 0.125f * s0[i] + b0, y1 = 0.125f * s1[i] + b1;
                x0[i] = (j0 < cnt) ? y0 : -INFINITY; x1[i] = (j1 < cnt) ? y1 : -INFINITY;
                mloc = fmaxf(mloc, fmaxf(x0[i], x1[i])); }
            mloc = fmaxf(mloc, __shfl_xor(mloc, 16)); mloc = fmaxf(mloc, __shfl_xor(mloc, 32));
            if (kp == 0) m_ref = mloc;
            else if (__any(mloc > m_ref + 8.0f)) { const float mn = fmaxf(m_ref, mloc), al = __expf(m_ref - mn);
#pragma unroll
                for (int rt = 0; rt < 16; ++rt) O[rt] *= al;
                lsum *= al; m_ref = mn; }
            float pe0[4], pe1[4];
#pragma unroll
            for (int i = 0; i < 4; ++i) { pe0[i] = __expf(x0[i] - m_ref); pe1[i] = __expf(x1[i] - m_ref); lsum += pe0[i] + pe1[i]; }
            pg8::u32x4 pw; pw.x = cvtpk(pe0[0], pe0[1]); pw.y = cvtpk(pe0[2], pe0[3]); pw.z = cvtpk(pe1[0], pe1[1]); pw.w = cvtpk(pe1[2], pe1[3]);
            const bf16x8 pf = __builtin_bit_cast(bf16x8, pw);
#pragma unroll
            for (int rt = 0; rt < 16; ++rt) { const bf16x8 af = {v0[rt][0], v0[rt][1], v0[rt][2], v0[rt][3], v1[rt][0], v1[rt][1], v1[rt][2], v1[rt][3]};
                O[rt] = __builtin_amdgcn_mfma_f32_16x16x32_bf16(af, pf, O[rt], 0, 0, 0); }
            LDS_WAIT(); asm volatile("" ::: "memory");
        }
#undef DSA_GATHER
        lsum += __shfl_xor(lsum, 16); lsum += __shfl_xor(lsum, 32);
        const float inv = 1.0f / lsum;
#pragma unroll
        for (int rt = 0; rt < 16; ++rt) { const f32x4 o = O[rt] * inv; pg8::u32x2 wv; wv.x = cvtpk(o[0], o[1]); wv.y = cvtpk(o[2], o[3]);
            const int s_ = rt >> 1, gp = 2 * (rt & 1) + (g >> 1), jo = 4 * (g & 1);
            *(pg8::u32x2*)(B.OLAT + (size_t)C.bid * OL_BLOCK + ((((size_t)(qslot >> 4) * 16 + c16) * 8 + s_) * 64 + gp * 16 + (qslot & 15)) * 8 + jo) = wv; }
    }
}
__device__ __forceinline__ void dsa_wuv(const Ctx& C, const Bufs& B, int l, int nq) {
    const int lane = C.lane, w = C.wave, g = lane >> 4, c16 = lane & 15;
    const LAS int* qrow = (const LAS int*)(C.lds + DS_QROW);
    const int nmt = (nq + 15) >> 4;
#pragma unroll 1
    for (int hq = 0; hq < 2; ++hq) { const int h = 2 * w + hq;
        f32x4 Dv[3][4];
#pragma unroll
        for (int mt = 0; mt < 3; ++mt)
#pragma unroll
            for (int nt = 0; nt < 4; ++nt) Dv[mt][nt] = (f32x4){0.f, 0.f, 0.f, 0.f};
        const bf16* wb = B.WUV + (((size_t)l * 16 + h) * 32) * 512 + lane * 8;
        const bf16* ab = B.OLAT + (size_t)C.bid * OL_BLOCK + ((size_t)h * 8) * 512 + lane * 8;
        bf16x8 bwA[4], awA[3], bwB[4], awB[3];
#define WUV_LOAD(bw_, aw_, s_) do { _Pragma("unroll") for (int nt = 0; nt < 4; ++nt) bw_[nt] = *(const bf16x8*)(wb + ((s_) * 4 + nt) * 512); \
        _Pragma("unroll") for (int mt = 0; mt < 3; ++mt) { const v4u av_ = __builtin_nontemporal_load((const v4u*)(ab + ((size_t)mt * 16 * 8 + (s_)) * 512)); aw_[mt] = __builtin_bit_cast(bf16x8, av_); } } while (0)
#define WUV_MMA(bw_, aw_) do { _Pragma("unroll") for (int mt = 0; mt < 3; ++mt) _Pragma("unroll") for (int nt = 0; nt < 4; ++nt) Dv[mt][nt] = __builtin_amdgcn_mfma_f32_16x16x32_bf16(aw_[mt], bw_[nt], Dv[mt][nt], 0, 0, 0); } while (0)
        WUV_LOAD(bwA, awA, 0);
#pragma unroll
        for (int s = 0; s < 8; s += 2) {
            WUV_LOAD(bwB, awB, s + 1);
            __builtin_amdgcn_sched_barrier(0);
            WUV_MMA(bwA, awA);
            __builtin_amdgcn_sched_barrier(0);
            if (s + 2 < 8) WUV_LOAD(bwA, awA, s + 2);
            __builtin_amdgcn_sched_barrier(0);
            WUV_MMA(bwB, awB);
            __builtin_amdgcn_sched_barrier(0);
        }
#undef WUV_LOAD
#undef WUV_MMA
        LAS float* stg = (LAS float*)(C.lds + RING_OFF + w * 4608);
#pragma unroll
        for (int mt = 0; mt < 3; ++mt) { if (mt < nmt) {
#pragma unroll
            for (int nt = 0; nt < 4; ++nt)
#pragma unroll
                for (int i = 0; i < 4; ++i) stg[(4 * g + i) * 68 + 16 * nt + c16] = Dv[mt][nt][i];
            LDS_WAIT(); asm volatile("" ::: "memory");
            const int slot = lane >> 2, q = mt * 16 + slot, d0 = (lane & 3) * 16;
            if (q < nq) { const int row = qrow[q];
                const bf16* zp = B.PROJ + (size_t)row * NP1 + PC_ZB + h * 64 + d0; bf16* op = B.YB + (size_t)row * YLD + h * 64 + d0;
#pragma unroll
                for (int hf = 0; hf < 2; ++hf) { const v4u zw = *(const v4u*)(zp + 8 * hf);
                    const f32x4 xa = *(const LAS f32x4*)(stg + slot * 68 + d0 + 8 * hf), xb = *(const LAS f32x4*)(stg + slot * 68 + d0 + 8 * hf + 4);
                    v4u o; o.x = pk2(xa[0] * siluf_(pg8::bf_lo(zw.x)), xa[1] * siluf_(pg8::bf_hi(zw.x))); o.y = pk2(xa[2] * siluf_(pg8::bf_lo(zw.y)), xa[3] * siluf_(pg8::bf_hi(zw.y)));
                    o.z = pk2(xb[0] * siluf_(pg8::bf_lo(zw.z)), xb[1] * siluf_(pg8::bf_hi(zw.z))); o.w = pk2(xb[2] * siluf_(pg8::bf_lo(zw.w)), xb[3] * siluf_(pg8::bf_hi(zw.w)));
                    *(v4u*)(op + 8 * hf) = o; } }
            LDS_WAIT(); asm volatile("" ::: "memory"); } }
    }
}
#ifndef MK_DSUB
#define MK_DSUB 0
#endif
__device__ __forceinline__ void dsa_unit(const Ctx& C, const Bufs& B, int l, int b, int t0, int uidx) {
    { PROBE_T0(); for (int rep = 0; rep < ((MK_DSUB & 1) ? 2 : 1); ++rep) { dsa_step1(C, B, b, t0); LDS_WAIT(); PROBE_T1(10); __syncthreads(); } PROBE_T1(0); }
    int cnt = 0;
    { PROBE_T0(); for (int rep = 0; rep < ((MK_DSUB & 2) ? 2 : 1); ++rep) { cnt = dsa_step2(C, b, t0); LDS_WAIT(); asm volatile("" ::: "memory"); } PROBE_T1(1); }
    if (C.lane == 0) ((LAS int*)(C.lds + DS_QROW))[uidx * 8 + C.wave] = rowof(b, t0 + C.wave);
    { PROBE_T0(); for (int rep = 0; rep < ((MK_DSUB & 4) ? 2 : 1); ++rep) { dsa_step3(C, B, b, t0, cnt, uidx * 8 + C.wave); } PROBE_T1(2); }
    { PROBE_T0(); LDS_WAIT(); __syncthreads(); PROBE_T1(7); }
}
#undef RELANE
#undef DSA_LOCALS

__device__ __forceinline__ void dsa_phase(const Ctx& C, int l) {
    const Bufs B(C.a.ws);
    const Args& A = C.a;
    for (int i = C.tid; i < 128 * 16; i += NWAVES * 64) { const int dd = i >> 4, h = i & 15; ((LAS float*)(C.lds + DS_BIAS))[i] = A.bias_table[t5_bucket(dd) * 32 + 16 + h]; }
    __syncthreads();
    int nu = 0;
    for (int it = 0;; ++it) {
        int b, j;
        if (C.G == 256) { const int k = C.bid >> 1; b = C.bid & 1;
            if (it < 4) j = 513 - (128 * it + ((it & 1) ? 127 - k : k)); else if (it == 4 && k < 2) j = 1 - k; else break; }
        else { const int s = C.bid + it * C.G; if (s >= 1028) break; b = s & 1; j = 513 - (s >> 1); }
        dsa_unit(C, B, l, b, 8 * j, it); nu = it + 1;
    }
    VM_WAIT(); LDS_WAIT(); __syncthreads();
    { PROBE_T0(); dsa_wuv(C, B, l, nu * 8); PROBE_T1(3); }
    __syncthreads();
}

constexpr int VT_PITCH = 4128;
constexpr int SW_BIAS = RING_OFF;
constexpr int SW_WS = SW_BIAS + 8192;
constexpr int SW_STG = SW_WS + 1024;

__device__ __forceinline__ void swa_item(const Ctx& C, const Bufs& B, const float* __restrict__ sinks, int b, int head, int p0, bool meta) {
    const int lane = C.lane, r32 = lane & 31, hh = lane >> 5, g = head >> 3;
    const LAS float* biasl = (const LAS float*)(C.lds + SW_BIAS);
    LAS float* wsf = (LAS float*)(C.lds + SW_WS) + C.wave * 32;
    const int tq = p0 + r32;
    const int tqc = meta ? (tq < NMETA ? tq : NMETA - 1) : tq;
    const int rowq = rowof(b, tqc);
    bf16x8 qf[4];
#pragma unroll
    for (int s = 0; s < 4; ++s) qf[s] = *(const bf16x8*)(B.PROJ + (size_t)rowq * NP1 + PC_QA + head * 64 + 16 * s + 8 * hh);
    const int ntile = meta ? 1 : 6;
    f32x16 S[6];
    bf16x8 kf[6][4];
#pragma unroll
    for (int kt = 0; kt < 6; ++kt) {
        if (kt < ntile) {
            const int k0 = (kt == 0) ? 0 : p0 - 128 + 32 * (kt - 1);
            int kpos = k0 + r32; kpos = kpos < 0 ? 0 : kpos;
            const bf16* kp = B.KV + (size_t)rowof(b, kpos) * 256 + g * 64 + 8 * hh;
#pragma unroll
            for (int s = 0; s < 4; ++s) kf[kt][s] = *(const bf16x8*)(kp + 16 * s);
        }
    }
    __builtin_amdgcn_sched_barrier(0);
#pragma unroll
    for (int kt = 0; kt < 6; ++kt) {
        if (kt < ntile) {
            f32x16 acc = {};
#pragma unroll
            for (int s = 0; s < 4; ++s) acc = __builtin_amdgcn_mfma_f32_32x32x16_bf16(kf[kt][s], qf[s], acc, 0, 0, 0);
            S[kt] = acc;
        } else S[kt] = (f32x16){-INFINITY, -INFINITY, -INFINITY, -INFINITY, -INFINITY, -INFINITY, -INFINITY, -INFINITY, -INFINITY, -INFINITY, -INFINITY, -INFINITY, -INFINITY, -INFINITY, -INFINITY, -INFINITY};
    }
    __builtin_amdgcn_sched_barrier(0);
#pragma unroll
    for (int kt = 0; kt < 6; ++kt) {
        if (kt < ntile) {
            const int k0 = (kt == 0) ? 0 : p0 - 128 + 32 * (kt - 1);
            float bz[16];
#pragma unroll
            for (int i = 0; i < 16; ++i) { const int kp = k0 + (i & 3) + 8 * (i >> 2) + 4 * hh; int d = tq - kp; d = d < 0 ? 0 : (d > 127 ? 127 : d); bz[i] = biasl[d * 16 + head]; }
#pragma unroll
            for (int i = 0; i < 16; ++i) { const int kp = k0 + (i & 3) + 8 * (i >> 2) + 4 * hh; const int d = tq - kp;
                const bool ok = (kt == 0) ? (kp < NMETA && d >= 0) : (kp >= NMETA && d >= 0 && d < 128);
                const float x = 0.125f * S[kt][i] + bz[i];
                S[kt][i] = ok ? x : -INFINITY; }
        }
    }
    const float sink = sinks[head];
    float mx = sink;
#pragma unroll
    for (int kt = 0; kt < 6; ++kt)
#pragma unroll
        for (int i = 0; i < 16; ++i) mx = fmaxf(mx, S[kt][i]);
    mx = fmaxf(mx, __shfl_xor(mx, 32));
    float sum = 0.f;
#pragma unroll
    for (int kt = 0; kt < 6; ++kt)
#pragma unroll
        for (int i = 0; i < 16; ++i) { const float p = __expf(S[kt][i] - mx); S[kt][i] = p; sum += p; }
    sum += __shfl_xor(sum, 32);
    sum += __expf(sink - mx);
    if (hh == 0) wsf[r32] = sum;
    f32x16 O0 = {}, O1 = {};
#pragma unroll
    for (int kt = 0; kt < 6; ++kt) {
        if (kt < ntile) {
            const int k0 = (kt == 0) ? 0 : p0 - 128 + 32 * (kt - 1);
            pg8::u32x2 vl[2][2], vh[2][2];
#pragma unroll
            for (int s2 = 0; s2 < 2; ++s2) { int ka = k0 + 16 * s2 + 4 * hh, kb2 = ka + 8; ka = ka < 0 ? 0 : ka; kb2 = kb2 < 0 ? 0 : kb2;
#pragma unroll
                for (int dt = 0; dt < 2; ++dt) { const bf16* vrow = B.VT + ((size_t)b * 128 + g * 64 + 32 * dt + r32) * VT_PITCH;
                    vl[s2][dt] = *(const pg8::u32x2*)(vrow + ka); vh[s2][dt] = *(const pg8::u32x2*)(vrow + kb2); } }
            __builtin_amdgcn_sched_barrier(0);
#pragma unroll
            for (int s2 = 0; s2 < 2; ++s2) {
                pg8::u32x4 pw; pw.x = cvtpk(S[kt][8 * s2 + 0], S[kt][8 * s2 + 1]); pw.y = cvtpk(S[kt][8 * s2 + 2], S[kt][8 * s2 + 3]); pw.z = cvtpk(S[kt][8 * s2 + 4], S[kt][8 * s2 + 5]); pw.w = cvtpk(S[kt][8 * s2 + 6], S[kt][8 * s2 + 7]);
                const bf16x8 pf = __builtin_bit_cast(bf16x8, pw);
#pragma unroll
                for (int dt = 0; dt < 2; ++dt) { const pg8::u32x4 vw = {vl[s2][dt].x, vl[s2][dt].y, vh[s2][dt].x, vh[s2][dt].y}; const bf16x8 vf = __builtin_bit_cast(bf16x8, vw);
                    if (dt == 0) O0 = __builtin_amdgcn_mfma_f32_32x32x16_bf16(pf, vf, O0, 0, 0, 0); else O1 = __builtin_amdgcn_mfma_f32_32x32x16_bf16(pf, vf, O1, 0, 0, 0); }
            }
            __builtin_amdgcn_sched_barrier(0);
        }
    }
    LDS_WAIT(); asm volatile("" ::: "memory");
    LAS float* stg = (LAS float*)(C.lds + SW_STG) + C.wave * (32 * 68);
#pragma unroll
    for (int i = 0; i < 16; ++i) { const int q = (i & 3) + 8 * (i >> 2) + 4 * hh; stg[q * 68 + r32] = O0[i]; stg[q * 68 + 32 + r32] = O1[i]; }
    LDS_WAIT(); asm volatile("" ::: "memory");
    { const int q = lane >> 1, d0 = (lane & 1) * 32, t = p0 + q;
      if (!meta || t < NMETA) { const int row = rowof(b, t); const float inv = 1.0f / wsf[q];
          const bf16* zp = B.PROJ + (size_t)row * NP1 + PC_ZA + head * 64 + d0; bf16* op = B.YA + (size_t)row * YLD + head * 64 + d0;
#pragma unroll
          for (int hf = 0; hf < 4; ++hf) { const v4u zw = *(const v4u*)(zp + 8 * hf);
              const f32x4 xa = *(const LAS f32x4*)(stg + q * 68 + d0 + 8 * hf) * inv, xb = *(const LAS f32x4*)(stg + q * 68 + d0 + 8 * hf + 4) * inv;
              v4u o; o.x = pk2(xa[0] * siluf_(pg8::bf_lo(zw.x)), xa[1] * siluf_(pg8::bf_hi(zw.x))); o.y = pk2(xa[2] * siluf_(pg8::bf_lo(zw.y)), xa[3] * siluf_(pg8::bf_hi(zw.y)));
              o.z = pk2(xb[0] * siluf_(pg8::bf_lo(zw.z)), xb[1] * siluf_(pg8::bf_hi(zw.z))); o.w = pk2(xb[2] * siluf_(pg8::bf_lo(zw.w)), xb[3] * siluf_(pg8::bf_hi(zw.w)));
              *(v4u*)(op + 8 * hf) = o; } } }
    LDS_WAIT(); asm volatile("" ::: "memory");
}

__device__ __forceinline__ void swa_phase(const Ctx& C, int l) {
    const Bufs B(C.a.ws);
    const Args& A = C.a;
    __syncthreads();
    for (int i = C.tid; i < 128 * 16; i += NWAVES * 64) { const int d = i >> 4, h = i & 15; ((LAS float*)(C.lds + SW_BIAS))[i] = A.bias_table[t5_bucket(d) * 32 + h]; }
    __syncthreads();
    const float* sinks = A.sinks + l * 16;
    for (int it = C.gw; it < 4096 + 32; it += C.NGW) {
        if (it < 4096) { const int blk = it & 127, head = (it >> 7) & 15, b = it >> 11; swa_item(C, B, sinks, b, head, NMETA + 32 * blk, false); }
        else { const int r = it - 4096, head = r & 15, b = r >> 4; swa_item(C, B, sinks, b, head, 0, true); }
    }
    __syncthreads();
}


constexpr int PH_PER_LAYER = 5, N_PHASES = 1 + NLAYER * PH_PER_LAYER + 1;
#ifndef MK_DUP
#define MK_DUP 0
#endif
#ifndef MK_NAIVE_SWA
#define MK_NAIVE_SWA 0
#endif
#ifndef MK_NAIVE_DSA
#define MK_NAIVE_DSA 0
#endif
#ifndef MK_ONE_LAUNCH
#define MK_ONE_LAUNCH 1
#endif

__global__ void __launch_bounds__(NWAVES * 64, 2) fwd_kernel(Args args) {
    extern __shared__ __attribute__((aligned(16))) unsigned char lds[];
    Ctx C;
    C.lds = (LAS unsigned char*)lds; C.tid = threadIdx.x; C.lane = C.tid & 63; C.wave = __builtin_amdgcn_readfirstlane(C.tid >> 6);
    C.G = gridDim.x; C.bid = blockIdx.x; C.gw = blockIdx.x * NWAVES + C.wave; C.NGW = C.G * NWAVES; C.a = args;
    unsigned char* ws = args.ws;
    gu32* ctl = (gu32*)(ws + WS_CTL);
    for (int u = C.tid; u < RING_OFF / 4; u += NWAVES * 64) ((LAS unsigned*)(C.lds + LDSCTL_OFF))[u] = 0u;
    __syncthreads();
    volatile LAS unsigned* MISC = (volatile LAS unsigned*)(C.lds + MISC_OFF);
    XcdBarrier bar; bar.bar = (unsigned*)(ctl + CW_BAR); bar.x = 0; bar.st = nullptr;
    const int lo = args.ph_lo, hi = args.ph_hi;
    const bool one = (hi - lo) > 1;
    if (one) bar = xcd_barrier_post((unsigned*)(ctl + CW_BAR), MISC + 8);
#define IN(k) (lo <= (k) && (k) < hi)
#define PHASE_BEGIN() do { int l_ = (int)__builtin_amdgcn_mbcnt_hi(~0u, __builtin_amdgcn_mbcnt_lo(~0u, 0u)); asm volatile("" : "+v"(l_)); int b_ = blockIdx.x; asm volatile("" : "+s"(b_)); \
    C.lane = l_; C.tid = C.wave * 64 + l_; C.bid = b_; C.gw = b_ * NWAVES + C.wave; } while (0)
#define SEAM(k) do { if (IN((k) + 1)) { PROBE_T0(); xcd_barrier(bar, C.wave == 0 && (int)__builtin_amdgcn_mbcnt_hi(~0u, __builtin_amdgcn_mbcnt_lo(~0u, 0u)) == 0); PROBE_T1(29); if (MK_DUP & 256) xcd_barrier(bar, C.wave == 0 && (int)__builtin_amdgcn_mbcnt_hi(~0u, __builtin_amdgcn_mbcnt_lo(~0u, 0u)) == 0); } } while (0)
    LAS unsigned char* ring = C.lds + RING_OFF;

    if (IN(0)) { PROBE_T0(); PHASE_BEGIN(); p0_prologue(C); PROBE_T1(20); if (MK_DUP & 128) { PHASE_BEGIN(); p0_prologue(C); } SEAM(0); }
    for (int l = 0; l < NLAYER; ++l) {
        const int p = 1 + l * PH_PER_LAYER;
        if (IN(p)) {
            PHASE_BEGIN(); const Bufs B(ws);
            const bf16* W1l = B.W1 + (size_t)l * NP1 * DM;
            pg8::Gemm g{B.HB, W1l, MR, 8192, DM}; pg8::StaticOrder S; S.init(MR, 8192, C.G, C.bid);
            rstd_table<8>(C, S, B.RS, 1.0f / DM);
            pg8::EpiProjT<true> E{B.PROJ, NP1, (const LAS float*)(C.lds + RSTD_OFF), B.KV, B.RSQ, B.RHO, B.SGB};
            { PROBE_T0(); pg8::gemm_phase<pg8::EpiProjT<true>, pg8::StaticOrder, true, true>(ring, g, S, E, C.tid); PROBE_T1(21); }
            PHASE_BEGIN();
            LAS float* tbl = (LAS float*)(C.lds + RSTD_OFF);
            PROBE_T0();
            for (int u = C.bid; u < 256 + 259; u += C.G) {
                if (u < 256) { const int row0 = 32 * u; skinny_rstd(C, B.RS + (size_t)row0 * 32, 32, 1.0f / DM, tbl);
                    skinny_unit<3, 1>(C, B.HB + (size_t)row0 * DM, DM, W1l + (size_t)8192 * DM, DM, DM, nullptr, 0, 0, SkProj{B.PROJ + (size_t)row0 * NP1, B.KV + (size_t)row0 * 256, B.KIDX + (size_t)row0 * 64, 8192, tbl}); }
                else { const int gc = u - 256; skinny_rstd(C, B.RS2, 64, 1.0f / DM, tbl);
                    const SkProj E2{B.PROJ + (size_t)MR * NP1, B.KV + (size_t)MR * 256, B.KIDX + (size_t)MR * 64, gc * 32, tbl};
                    const bool sqc = gc >= 72 && gc < 88;
                    skinny_unit<1, 4>(C, B.HB + (size_t)MR * DM, DM, W1l + (size_t)gc * 32 * DM, DM, DM, sqc ? B.RSQ2 : nullptr, 16, gc - 72, E2); }
            }
            PROBE_T1(22);
            SEAM(p);
        }
        if (IN(p + 1)) {
            PHASE_BEGIN(); const Bufs B(ws);
            const bf16* W2l = B.W2 + (size_t)l * NQ2 * 512;
            pg8::Gemm g{B.PROJ + PC_CQ, W2l, MR, NQ2, 512, nullptr, nullptr, NP1}; pg8::StaticOrder S; S.init(MR, NQ2, C.G, C.bid);
            rstd_table<2>(C, S, B.RSQ, 1.0f / 512.0f);
            pg8::EpiProjT<false> E{B.Q2, NQ2, (const LAS float*)(C.lds + RSTD_OFF), nullptr, nullptr, nullptr, nullptr};
            PROBE_T0();
            pg8::gemm_phase<pg8::EpiProjT<false>, pg8::StaticOrder, true, true>(ring, g, S, E, C.tid);
            PHASE_BEGIN();
            { LAS float* tbl = (LAS float*)(C.lds + RSTD_OFF);
              for (int u = C.bid; u < 48; u += C.G) { skinny_rstd(C, B.RSQ2, 16, 1.0f / 512.0f, tbl);
                skinny_unit<3, 1>(C, B.PROJ + (size_t)MR * NP1 + PC_CQ, NP1, W2l + (size_t)u * 96 * 512, 512, 512, nullptr, 0, 0, SkQ2{B.Q2 + (size_t)MR * NQ2 + u * 96, tbl}); } }
            PHASE_BEGIN(); norm_tail(C, l);
            PROBE_T1(24);
            SEAM(p + 1);
        }
        if (IN(p + 2)) {
            { PROBE_T0(); PHASE_BEGIN(); swa_phase(C, l); PROBE_T1(5); }
            if (MK_DUP & 8) { PHASE_BEGIN(); swa_phase(C, l); }
            { PROBE_T0(); PHASE_BEGIN(); dsa_phase(C, l); PROBE_T1(4); }
            if (MK_DUP & 16) { PHASE_BEGIN(); dsa_phase(C, l); }
            SEAM(p + 2);
        }
        if (IN(p + 3)) {
            PHASE_BEGIN(); const Bufs B(ws);
            const bf16* WABl = B.WA + (size_t)l * DM * 2048;
            pg8::Gemm g{B.YA, WABl, MR, DM, 2048, nullptr, nullptr, 0}; pg8::StaticOrder S; S.init(MR, DM, C.G, C.bid);
            pg8::EpiG4m E{B.MG, B.RHO, B.SGB};
            PROBE_T0();
            pg8::gemm_phase<pg8::EpiG4m, pg8::StaticOrder, true, true>(ring, g, S, E, C.tid);
            PROBE_T1(35);
            PHASE_BEGIN();
            for (int u = C.bid; u < 64; u += C.G) {
                skinny_unit<1, 2>(C, B.YA + (size_t)MR * YLD, YLD, WABl + (size_t)u * 32 * 2048, 2048, 1024, nullptr, 0, 0, SkPA{B.PA + (size_t)MR * DM + u * 32, B.PROJ + (size_t)MR * NP1 + 4096, u * 32});
                skinny_unit<1, 2>(C, B.YB + (size_t)MR * YLD, YLD, WABl + 1024 + (size_t)u * 32 * 2048, 2048, 1024, nullptr, 0, 0, SkMerge{B.MG + (size_t)MR * DM + u * 32, B.PA + (size_t)MR * DM + u * 32, B.PROJ + (size_t)MR * NP1 + 4096, u * 32}); }
            PROBE_T1(25);
            SEAM(p + 3);
        }
        if (IN(p + 4)) {
            PHASE_BEGIN(); const Bufs B(ws);
            const bf16* WOl = B.WO + (size_t)l * DM * DM;
            pg8::Gemm g{B.MG, WOl, MR, DM, DM}; pg8::StaticOrder S; S.init(MR, DM, C.G, C.bid);
            pg8::EpiRes E{B.HB, B.RS};
            PROBE_T0();
            pg8::gemm_phase<pg8::EpiRes, pg8::StaticOrder, true, true>(ring, g, S, E, C.tid);
            PROBE_T1(37);
            PHASE_BEGIN();
            for (int u = C.bid; u < 64; u += C.G) skinny_unit<1, 4>(C, B.MG + (size_t)MR * DM, DM, WOl + (size_t)u * 32 * DM, DM, DM, B.RS2, 64, u, SkRes{B.HB + (size_t)MR * DM + u * 32});
            PROBE_T1(27);
            SEAM(p + 4);
        }
    }
    if (IN(N_PHASES - 1)) { PHASE_BEGIN(); final_phase(C); }
#undef IN
#undef SEAM
}

extern "C" void kernel_launch(void* const* d_in, const int* in_sizes, int n_in, void* d_out, int out_size, void* d_ws, size_t ws_size, hipStream_t stream) {
    static int grid = 0;
    if (grid == 0) {
        if (n_in != 16 || ws_size < WS_END) { fprintf(stderr, "kernel_launch: unexpected inputs (n_in %d, ws %zu, need %zu)\n", n_in, ws_size, (size_t)WS_END); grid = -1; return; }
        int dev = 0, cus = 0;
        if (hipGetDevice(&dev) != hipSuccess || hipDeviceGetAttribute(&cus, hipDeviceAttributeMultiprocessorCount, dev) != hipSuccess) { grid = -1; return; }
        if (hipFuncSetAttribute((const void*)fwd_kernel, hipFuncAttributeMaxDynamicSharedMemorySize, LDS_BYTES) != hipSuccess) { fprintf(stderr, "kernel_launch: hipFuncSetAttribute failed\n"); grid = -1; return; }
        int per_cu = 0;
        if (hipOccupancyMaxActiveBlocksPerMultiprocessor(&per_cu, (const void*)fwd_kernel, NWAVES * 64, LDS_BYTES) != hipSuccess || per_cu < 1) fprintf(stderr, "kernel_launch: occupancy query says %d\n", per_cu);
        (void)hipGetLastError();
        grid = cus;
    }
    if (grid < 0) return;
    if (hipMemsetAsync((char*)d_ws + WS_CTL, 0, CTL_ZERO_BYTES, stream) != hipSuccess) return;
    Args a{};
    a.x = (const float*)d_in[0]; a.meta = (const float*)d_in[1]; a.bias_table = (const float*)d_in[2]; a.norm_g = (const float*)d_in[3]; a.w_in = (const float*)d_in[4];
    a.q_norm_g = (const float*)d_in[5]; a.kv_norm_g = (const float*)d_in[6]; a.w_qb = (const float*)d_in[7]; a.w_iq = (const float*)d_in[8]; a.w_uk = (const float*)d_in[9];
    a.w_uv = (const float*)d_in[10]; a.sinks = (const float*)d_in[11]; a.w_proj_a = (const float*)d_in[12]; a.w_proj_b = (const float*)d_in[13]; a.w_out = (const float*)d_in[14];
    a.final_g = (const float*)d_in[15]; a.out = (float*)d_out; a.ws = (unsigned char*)d_ws;
#if MK_ONE_LAUNCH
    a.ph_lo = 0; a.ph_hi = N_PHASES;
    hipLaunchKernelGGL(fwd_kernel, dim3(grid), dim3(NWAVES * 64), LDS_BYTES, stream, a);
#else
    for (int p = 0; p < N_PHASES; ++p) { a.ph_lo = p; a.ph_hi = p + 1; hipLaunchKernelGGL(fwd_kernel, dim3(grid), dim3(NWAVES * 64), LDS_BYTES, stream, a); }
#endif
}
```

```cpp
#include <hip/hip_runtime.h>
#include <cstdio>
#include <cstdint>
namespace pg8 {
#define PG8_LAS __attribute__((address_space(3)))
typedef unsigned short bf16_t;
typedef short bf16x8 __attribute__((ext_vector_type(8)));
typedef float f32x4 __attribute__((ext_vector_type(4)));
typedef unsigned u32x4 __attribute__((ext_vector_type(4)));
constexpr int BM = 256, BK = 64, HALF = 128, HTB = HALF * BK * 2  , STAGE_BYTES = 8 * HTB, NXCD = 8, WGM = 8;

__host__ __device__ __forceinline__ int lds_byte(int r, int c) { const int st = (r >> 4) * 2 + (c >> 5), rr = r & 15, cc = c & 31, ob = rr * 64 + cc * 2; return st * 1024 + (ob ^ (((ob >> 9) & 1) << 5)); }
__host__ __device__ __forceinline__ void stage_rc(int b, int& R, int& C) { const int st = b / 1024, sb = b % 1024, swz = sb ^ (((sb >> 9) & 1) << 5); R = (st >> 1) * 16 + swz / 64; C = (st & 1) * 32 + (swz % 64) / 2; }
__host__ __device__ __forceinline__ int perm32(int rho) { const int n = rho >> 4, i = rho & 15; return 8 * (i >> 2) + 4 * n + (i & 3); }

struct Unit { int pm, pn, sel; };
struct Gemm { const bf16_t* A; const bf16_t* Bt; int M, N, K; const bf16_t* A2; const bf16_t* Bt2; int lda; };

struct StaticOrder {
    int nM, nN, nwg, G, c;
    __host__ __device__ void init(int M, int N, int G_, int c_) { nM = M / BM; nN = N / BM; nwg = nM * nN; G = G_; c = c_; }
    __host__ __device__ bool next(int i, Unit& u) const {
        const long L = (long)i * G + c; if (L >= nwg) return false;
        int wgid = (int)L; { const int q = nwg / NXCD, r = nwg % NXCD, xcd = wgid % NXCD, off = wgid / NXCD; wgid = (xcd < r ? xcd * (q + 1) : r * (q + 1) + (xcd - r) * q) + off; }
        const int nig = WGM * nN, gid = wgid / nig, fm = gid * WGM, gsz = (nM - fm) < WGM ? (nM - fm) : WGM;
        u.pm = fm + ((wgid % nig) % gsz); u.pn = (wgid % nig) / gsz; u.sel = 0; return true;
    }
    __device__ __forceinline__ void a_ready(const Unit&) const {}
    __device__ __forceinline__ void done(const Unit&) const {}
};

__device__ __forceinline__ unsigned cvt_pk_bf16(float lo, float hi) { unsigned r; asm volatile("v_cvt_pk_bf16_f32 %0, %1, %2" : "=v"(r) : "v"(lo), "v"(hi)); return r; }
typedef float f32x2 __attribute__((ext_vector_type(2)));
__device__ __forceinline__ f32x2 gelu_pk(f32x2 v) {
    const f32x2 av = __builtin_elementwise_abs(v), d = av * 0.2316418882f + 1.0f;
    f32x2 t; t.x = __builtin_amdgcn_rcpf(d.x); t.y = __builtin_amdgcn_rcpf(d.y);
    f32x2 q = t * 0.5307027145f + (-0.7265760135f); q = q * t + 0.7107068705f; q = q * t + (-0.142248368f); q = q * t + 0.127414796f; q = q * t;
    const f32x2 s = (v * v) * (-0.72134752044f);
    f32x2 e; e.x = __builtin_amdgcn_exp2f(s.x); e.y = __builtin_amdgcn_exp2f(s.y);
    const f32x2 m = v * (q * e), r = v - m;
    f32x2 o; o.x = v.x < 0.f ? m.x : r.x; o.y = v.y < 0.f ? m.y : r.y; return o;
}

template <int ACT  > struct EpiBf16 {
    static constexpr bool PERM = true, AFTER_DRAIN = false; static_assert(ACT == 0 || ACT == 1, "EpiBf16: ACT is 0 (none) or 1 (gelu_pk)");
    bf16_t* O; int ldc; const float* bias; int split_cols; size_t split_stride; float scale0;
    __device__ __forceinline__ void operator()(const f32x4 (&acc)[2][2][4][2], const Unit& u, int ui, int wr, int wc, int fr, int fq) const {
        const int row0 = u.pm * BM + wr * 64 + fr; int colt = u.pn * BM; bf16_t* base = O;
        float sc = 1.f; if (split_cols) { const int t = colt / split_cols; base += (size_t)t * split_stride; colt -= t * split_cols; if (t == 0) sc = scale0; }
        const int col0 = colt + wc * 32 + 8 * fq, bcol0 = u.pn * BM + wc * 32 + 8 * fq;
        f32x4 bv[2][2];
#pragma unroll
        for (int bj = 0; bj < 2; ++bj)
#pragma unroll
            for (int n = 0; n < 2; ++n) bv[bj][n] = bias ? *(const f32x4*)(bias + bcol0 + bj * HALF + 4 * n) : (f32x4){0.f, 0.f, 0.f, 0.f};
#pragma unroll
        for (int ai = 0; ai < 2; ++ai)
#pragma unroll
            for (int m = 0; m < 4; ++m) { bf16_t* rowp = base + (size_t)(row0 + ai * HALF + m * 16) * ldc + col0;
#pragma unroll
                for (int bj = 0; bj < 2; ++bj) { f32x4 v0 = acc[ai][bj][m][0] + bv[bj][0], v1 = acc[ai][bj][m][1] + bv[bj][1];
                    if (ACT == 1) { f32x2 a = gelu_pk((f32x2){v0[0], v0[1]}), b = gelu_pk((f32x2){v0[2], v0[3]}), c = gelu_pk((f32x2){v1[0], v1[1]}), d = gelu_pk((f32x2){v1[2], v1[3]});
                        v0 = (f32x4){a.x, a.y, b.x, b.y}; v1 = (f32x4){c.x, c.y, d.x, d.y}; }
                    v0 = v0 * sc; v1 = v1 * sc; u32x4 w; w.x = cvt_pk_bf16(v0[0], v0[1]); w.y = cvt_pk_bf16(v0[2], v0[3]); w.z = cvt_pk_bf16(v1[0], v1[1]); w.w = cvt_pk_bf16(v1[2], v1[3]);
                    *(u32x4*)(rowp + bj * HALF) = w; } }
    }
};

template <class T, class = void> struct pg8_has_midk { static constexpr bool value = false; };
template <class T> struct pg8_has_midk<T, decltype((void)T::MIDK)> { static constexpr bool value = T::MIDK; };
template <class Epi, class Sched, bool ALIGN_EPI = false, bool SP2 = false>
__device__ __forceinline__ void gemm_phase(PG8_LAS unsigned char* lds, const Gemm g, const Sched& S, const Epi& E, int tid_in) {
    int tid_ = tid_in; asm volatile("" : "+v"(tid_));
    const int tid = tid_, wid = __builtin_amdgcn_readfirstlane(tid >> 6), lane = tid & 63, wr = wid >> 2, wc = wid & 3, fr = lane & 15, fq = lane >> 4;
    const int K = g.K, nt = K / BK, lda = g.lda ? g.lda : K;
    unsigned voffA[2], voffB[2];
#pragma unroll
    for (int i = 0; i < 2; ++i) { int R, C; stage_rc(tid * 16 + i * 8192, R, C); const int Rb = Epi::PERM ? ((R & ~31) + perm32(R & 31)) : R;
        voffA[i] = (unsigned)(R * lda + C) * 2u; voffB[i] = (unsigned)(Rb * K + C) * 2u; }
    const size_t kstep = (size_t)(BK * 2);
    const size_t hstepA = (size_t)HALF * lda * 2, tstepA = 2 * hstepA;
    const size_t hstep = (size_t)HALF * K * 2;
    const size_t tstep = 2 * hstep;
    const unsigned ldsw = (unsigned)wid * 1024u;
    const int aoff = lds_byte(wr * 64 + fr, fq * 8), boff = lds_byte(wc * 32 + fr, fq * 8);
#define PG8_SA(b, h) (((b) * 2 + (h)) * HTB)
#define PG8_SB(b, h) ((4 + (b) * 2 + (h)) * HTB)
#define PG8_STAGE(bufoff, gbase, voff) do { _Pragma("unroll") for (int _i = 0; _i < 2; ++_i) \
        __builtin_amdgcn_global_load_lds((const unsigned*)((const char*)(gbase) + (voff)[_i]), (PG8_LAS unsigned*)(lds + (bufoff) + ldsw + _i * 8192), 16, 0, 0); } while (0)
#define PG8_LDA(dst, b, h) do { _Pragma("unroll") for (int m = 0; m < 4; ++m) _Pragma("unroll") for (int k = 0; k < 2; ++k) dst[m][k] = *(const PG8_LAS bf16x8*)(lds + PG8_SA(b, h) + aoff + m * 2048 + k * 1024); } while (0)
#define PG8_LDB(dst, b, h) do { _Pragma("unroll") for (int n = 0; n < 2; ++n) _Pragma("unroll") for (int k = 0; k < 2; ++k) dst[n][k] = *(const PG8_LAS bf16x8*)(lds + PG8_SB(b, h) + boff + n * 2048 + k * 1024); } while (0)
#define PG8_MMA(ai, bj, At, Bt) do { __builtin_amdgcn_s_setprio(1); _Pragma("unroll") for (int m = 0; m < 4; ++m) _Pragma("unroll") for (int n = 0; n < 2; ++n) _Pragma("unroll") for (int k = 0; k < 2; ++k) \
        acc[ai][bj][m][n] = __builtin_amdgcn_mfma_f32_16x16x32_bf16(Bt[n][k], At[m][k], acc[ai][bj][m][n], 0, 0, 0); __builtin_amdgcn_s_setprio(0); } while (0)
#define PG8_WAIT_V(n) asm volatile("s_waitcnt vmcnt(" #n ")" ::: "memory")
#define PG8_WAIT_L(n) asm volatile("s_waitcnt lgkmcnt(" #n ")" ::: "memory")
#define PG8_BAR __builtin_amdgcn_s_barrier()
#define PG8_SCHED __builtin_amdgcn_sched_barrier(0)
    Unit cur, nxt; int ui = 0;
    if (!S.next(0, cur)) return;
    f32x4 acc[2][2][4][2];
#pragma unroll
    for (int a = 0; a < 2; ++a)
#pragma unroll
        for (int b = 0; b < 2; ++b)
#pragma unroll
            for (int m = 0; m < 4; ++m)
#pragma unroll
                for (int n = 0; n < 2; ++n) acc[a][b][m][n] = (f32x4){0.f, 0.f, 0.f, 0.f};
    bf16x8 At[4][2], B0[2][2], B1[2][2];
    const char* cA = (const char*)(cur.sel ? g.A2 : g.A) + (size_t)cur.pm * tstepA; const char* cB = (const char*)(cur.sel ? g.Bt2 : g.Bt) + (size_t)cur.pn * tstep;
    S.a_ready(cur);
    if constexpr (SP2) {
        PG8_STAGE(PG8_SB(0, 0), cB, voffB); PG8_STAGE(PG8_SB(0, 1), cB + hstep, voffB); PG8_STAGE(PG8_SA(0, 0), cA, voffA); PG8_STAGE(PG8_SA(0, 1), cA + hstepA, voffA);
        if (wr == 1) PG8_BAR;
        PG8_WAIT_V(2); PG8_BAR;
        PG8_STAGE(PG8_SB(1, 0), cB + kstep, voffB); PG8_STAGE(PG8_SA(1, 0), cA + kstep, voffA); PG8_STAGE(PG8_SB(1, 1), cB + hstep + kstep, voffB);
        PG8_WAIT_V(6); PG8_BAR;
    } else {
        PG8_STAGE(PG8_SB(0, 0), cB, voffB); PG8_STAGE(PG8_SA(0, 0), cA, voffA); PG8_STAGE(PG8_SB(0, 1), cB + hstep, voffB); PG8_STAGE(PG8_SA(0, 1), cA + hstepA, voffA);
        if (wr == 1) PG8_BAR;
        PG8_WAIT_V(4); PG8_BAR;
        PG8_STAGE(PG8_SB(1, 0), cB + kstep, voffB); PG8_STAGE(PG8_SA(1, 0), cA + kstep, voffA); PG8_STAGE(PG8_SB(1, 1), cB + hstep + kstep, voffB);
        PG8_WAIT_V(6); PG8_BAR;
    }
    for (;;) {
        const bool has_next = S.next(ui + 1, nxt);
        const char* nA = has_next ? (const char*)(nxt.sel ? g.A2 : g.A) + (size_t)nxt.pm * tstepA : cA; const char* nB = has_next ? (const char*)(nxt.sel ? g.Bt2 : g.Bt) + (size_t)nxt.pn * tstep : cB;
        for (int t = 0; t < nt; t += 2) {
            if constexpr (pg8_has_midk<Epi>::value) { if (t == (nt >> 1)) E.midk(acc, cur, wr, wc, fr, fq); }
            const bool last = (t == nt - 2);
            const char* a1 = cA + (size_t)(t + 1) * kstep;
            const char* a2 = last ? nA : cA + (size_t)(t + 2) * kstep; const char* b2 = last ? nB : cB + (size_t)(t + 2) * kstep;
            const char* a3 = a2 + kstep; const char* b3 = b2 + kstep;
            if (last && has_next) S.a_ready(nxt);
            if constexpr (SP2) {
            PG8_LDB(B0, 0, 0); PG8_LDB(B1, 0, 1); PG8_SCHED; PG8_LDA(At, 0, 0); PG8_STAGE(PG8_SA(1, 1), a1 + hstepA, voffA);
            PG8_WAIT_V(8); PG8_WAIT_L(0); PG8_BAR; PG8_MMA(0, 0, At, B0); PG8_MMA(0, 1, At, B1); PG8_BAR; PG8_SCHED;
            PG8_LDA(At, 0, 1); PG8_STAGE(PG8_SB(0, 0), b2, voffB); PG8_STAGE(PG8_SB(0, 1), b2 + hstep, voffB); PG8_STAGE(PG8_SA(0, 0), a2, voffA);
            PG8_WAIT_V(8); PG8_WAIT_L(0); PG8_BAR; PG8_MMA(1, 0, At, B0); PG8_MMA(1, 1, At, B1); PG8_BAR; PG8_SCHED;
            PG8_LDB(B0, 1, 0); PG8_LDB(B1, 1, 1); PG8_SCHED; PG8_LDA(At, 1, 0); PG8_STAGE(PG8_SA(0, 1), a2 + hstepA, voffA);
            PG8_WAIT_V(8); PG8_WAIT_L(0); PG8_BAR; PG8_MMA(0, 0, At, B0); PG8_MMA(0, 1, At, B1); PG8_BAR; PG8_SCHED;
            PG8_LDA(At, 1, 1); PG8_STAGE(PG8_SB(1, 0), b3, voffB); PG8_STAGE(PG8_SB(1, 1), b3 + hstep, voffB); PG8_STAGE(PG8_SA(1, 0), a3, voffA);
            PG8_WAIT_V(8); PG8_WAIT_L(0); PG8_BAR; PG8_MMA(1, 0, At, B0); PG8_MMA(1, 1, At, B1); PG8_BAR; PG8_SCHED;
            } else {
            PG8_LDB(B0, 0, 0); PG8_SCHED; PG8_LDA(At, 0, 0); PG8_STAGE(PG8_SA(1, 1), a1 + hstepA, voffA);
            PG8_WAIT_L(8); PG8_BAR; PG8_WAIT_L(0); PG8_MMA(0, 0, At, B0); PG8_BAR; PG8_SCHED;
            PG8_LDB(B1, 0, 1); PG8_STAGE(PG8_SB(0, 0), b2, voffB);
            PG8_BAR; PG8_WAIT_L(0); PG8_MMA(0, 1, At, B1); PG8_BAR;
            PG8_LDA(At, 0, 1); PG8_STAGE(PG8_SA(0, 0), a2, voffA);
            PG8_BAR; PG8_WAIT_L(0); PG8_MMA(1, 0, At, B0); PG8_BAR; PG8_SCHED;
            PG8_STAGE(PG8_SB(0, 1), b2 + hstep, voffB);
            PG8_WAIT_V(6); PG8_BAR; PG8_MMA(1, 1, At, B1); PG8_BAR;
            PG8_LDB(B0, 1, 0); PG8_SCHED; PG8_LDA(At, 1, 0); PG8_STAGE(PG8_SA(0, 1), a2 + hstepA, voffA);
            PG8_WAIT_L(8); PG8_BAR; PG8_WAIT_L(0); PG8_MMA(0, 0, At, B0); PG8_BAR; PG8_SCHED;
            PG8_LDB(B1, 1, 1); PG8_STAGE(PG8_SB(1, 0), b3, voffB);
            PG8_BAR; PG8_WAIT_L(0); PG8_MMA(0, 1, At, B1); PG8_BAR;
            PG8_LDA(At, 1, 1); PG8_STAGE(PG8_SA(1, 0), a3, voffA);
            PG8_BAR; PG8_WAIT_L(0); PG8_MMA(1, 0, At, B0); PG8_BAR; PG8_SCHED;
            PG8_STAGE(PG8_SB(1, 1), b3 + hstep, voffB);
            PG8_WAIT_V(6); PG8_BAR; PG8_MMA(1, 1, At, B1); PG8_BAR;
            }
        }
        if constexpr (ALIGN_EPI) { if (wr == 0) PG8_BAR; }
        if constexpr (!Epi::AFTER_DRAIN) { E(acc, cur, ui, wr, wc, fr, fq); S.done(cur); }
        if (!has_next) break;
#pragma unroll
        for (int a = 0; a < 2; ++a)
#pragma unroll
            for (int b = 0; b < 2; ++b)
#pragma unroll
                for (int m = 0; m < 4; ++m)
#pragma unroll
                    for (int n = 0; n < 2; ++n) acc[a][b][m][n] = (f32x4){0.f, 0.f, 0.f, 0.f};
        cur = nxt; cA = nA; cB = nB; ++ui;
        if constexpr (ALIGN_EPI) { if (wr == 1) PG8_BAR; }
    }
    PG8_WAIT_V(0);
    if constexpr (!ALIGN_EPI) { if (wr == 0) PG8_BAR; }
    PG8_BAR;
    if constexpr (Epi::AFTER_DRAIN) { E.fused(acc, cur, wr, wc, fr, fq, lds, wid, lane); S.done(cur); }
#undef PG8_SA
#undef PG8_SB
#undef PG8_STAGE
#undef PG8_LDA
#undef PG8_LDB
#undef PG8_MMA
#undef PG8_WAIT_V
#undef PG8_WAIT_L
#undef PG8_BAR
#undef PG8_SCHED
}
}
namespace pg8 {
__device__ __forceinline__ float bf_lo(unsigned w) { return __uint_as_float(w << 16); }
__device__ __forceinline__ float bf_hi(unsigned w) { return __uint_as_float(w & 0xffff0000u); }
__device__ __forceinline__ float sigm(float x) { return 1.0f / (1.0f + __expf(-x)); }
typedef unsigned u32x2 __attribute__((ext_vector_type(2)));

template <bool G1>
struct EpiProjT {
    static constexpr bool PERM = true, AFTER_DRAIN = false;
    bf16_t* O; int ldc; const PG8_LAS float* rstd; bf16_t* KV; float* RSQ; bf16_t* RHO; bf16_t* SGB;
    static constexpr int kvtile = 4, sqtile = 9, gtile = 16;
    __device__ __forceinline__ void operator()(const f32x4 (&acc)[2][2][4][2], const Unit& u, int ui, int wr, int wc, int fr, int fq) const {
        const int rt0 = wr * 64 + fr, col0 = u.pn * BM + wc * 32 + 8 * fq;
        const bool sq = G1 && (u.pn == sqtile || u.pn == sqtile + 1);
#pragma unroll
        for (int ai = 0; ai < 2; ++ai)
#pragma unroll
            for (int m = 0; m < 4; ++m) { const int rt = rt0 + ai * HALF + m * 16; const float s = rstd[ui * 256 + rt];
                bf16_t* rowp = O + (size_t)(u.pm * BM + rt) * ldc + col0;
                if constexpr (G1) { if (u.pn == kvtile) rowp = KV + (size_t)(u.pm * BM + rt) * 256 + wc * 32 + 8 * fq; }
                float ss = 0.f;
                if constexpr (G1) { if (u.pn >= gtile) {
                    const f32x4 a0 = acc[ai][0][m][0] * s, a1 = acc[ai][0][m][1] * s, b0 = acc[ai][1][m][0] * s, b1 = acc[ai][1][m][1] * s;
                    float ea[8], eb[8], rh[8], sb[8];
#pragma unroll
                    for (int j = 0; j < 4; ++j) { ea[j] = 1.0f + __expf(-a0[j]); ea[4 + j] = 1.0f + __expf(-a1[j]); eb[j] = 1.0f + __expf(-b0[j]); eb[4 + j] = 1.0f + __expf(-b1[j]); }
#pragma unroll
                    for (int j = 0; j < 8; ++j) { const float ia = __builtin_amdgcn_rcpf(ea[j]); rh[j] = eb[j] * ia; sb[j] = __builtin_amdgcn_rcpf(eb[j]); }
                    const size_t go = (size_t)(u.pm * BM + rt) * 2048 + (u.pn - gtile) * 128 + wc * 32 + 8 * fq;
                    u32x4 wr_, ws_; wr_.x = cvt_pk_bf16(rh[0], rh[1]); wr_.y = cvt_pk_bf16(rh[2], rh[3]); wr_.z = cvt_pk_bf16(rh[4], rh[5]); wr_.w = cvt_pk_bf16(rh[6], rh[7]);
                    ws_.x = cvt_pk_bf16(sb[0], sb[1]); ws_.y = cvt_pk_bf16(sb[2], sb[3]); ws_.z = cvt_pk_bf16(sb[4], sb[5]); ws_.w = cvt_pk_bf16(sb[6], sb[7]);
                    *(u32x4*)(RHO + go) = wr_; *(u32x4*)(SGB + go) = ws_;
                    continue; } }
#pragma unroll
                for (int bj = 0; bj < 2; ++bj) { const f32x4 v0 = acc[ai][bj][m][0] * s, v1 = acc[ai][bj][m][1] * s;
                    ss += (v0[0] * v0[0] + v0[1] * v0[1]) + (v0[2] * v0[2] + v0[3] * v0[3]) + (v1[0] * v1[0] + v1[1] * v1[1]) + (v1[2] * v1[2] + v1[3] * v1[3]);
                    u32x4 w; w.x = cvt_pk_bf16(v0[0], v0[1]); w.y = cvt_pk_bf16(v0[2], v0[3]); w.z = cvt_pk_bf16(v1[0], v1[1]); w.w = cvt_pk_bf16(v1[2], v1[3]);
                    *(u32x4*)(rowp + bj * HALF) = w; }
                if constexpr (G1) if (sq) { ss += __shfl_xor(ss, 16); ss += __shfl_xor(ss, 32); if (fq == 0) RSQ[(size_t)(u.pm * BM + rt) * 8 + (u.pn - sqtile) * 4 + wc] = ss; } }
    }
};
struct EpiPA {
    static constexpr bool PERM = false, AFTER_DRAIN = false;
    float* P; const bf16_t* G; int ldg;
    __device__ __forceinline__ void operator()(const f32x4 (&acc)[2][2][4][2], const Unit& u, int ui, int wr, int wc, int fr, int fq) const {
        const int col0 = u.pn * BM + wc * 32 + 4 * fq;
#pragma unroll
        for (int ai = 0; ai < 2; ++ai)
#pragma unroll
            for (int m = 0; m < 4; ++m) { const int row = u.pm * BM + ai * HALF + wr * 64 + m * 16 + fr;
#pragma unroll
                for (int bj = 0; bj < 2; ++bj)
#pragma unroll
                    for (int n = 0; n < 2; ++n) { const int c = col0 + bj * HALF + n * 16; const u32x2 g = *(const u32x2*)(G + (size_t)row * ldg + c);
                        f32x4 v = acc[ai][bj][m][n]; v[0] *= sigm(bf_lo(g.x)); v[1] *= sigm(bf_hi(g.x)); v[2] *= sigm(bf_lo(g.y)); v[3] *= sigm(bf_hi(g.y));
                        *(f32x4*)(P + (size_t)row * 2048 + c) = v; } }
    }
};
struct EpiMerge {
    static constexpr bool PERM = true, AFTER_DRAIN = false;
    bf16_t* O; const float* P; const bf16_t* G; int ldg;
    __device__ __forceinline__ void operator()(const f32x4 (&acc)[2][2][4][2], const Unit& u, int ui, int wr, int wc, int fr, int fq) const {
        const int col0 = u.pn * BM + wc * 32 + 8 * fq;
#pragma unroll
        for (int ai = 0; ai < 2; ++ai)
#pragma unroll
            for (int m = 0; m < 4; ++m) { const int row = u.pm * BM + ai * HALF + wr * 64 + m * 16 + fr;
#pragma unroll
                for (int bj = 0; bj < 2; ++bj) { const int c = col0 + bj * HALF; const u32x4 g = *(const u32x4*)(G + (size_t)row * ldg + c);
                    const f32x4 p0 = *(const f32x4*)(P + (size_t)row * 2048 + c), p1 = *(const f32x4*)(P + (size_t)row * 2048 + c + 4);
                    f32x4 v0 = acc[ai][bj][m][0], v1 = acc[ai][bj][m][1];
                    v0[0] = p0[0] + sigm(bf_lo(g.x)) * v0[0]; v0[1] = p0[1] + sigm(bf_hi(g.x)) * v0[1]; v0[2] = p0[2] + sigm(bf_lo(g.y)) * v0[2]; v0[3] = p0[3] + sigm(bf_hi(g.y)) * v0[3];
                    v1[0] = p1[0] + sigm(bf_lo(g.z)) * v1[0]; v1[1] = p1[1] + sigm(bf_hi(g.z)) * v1[1]; v1[2] = p1[2] + sigm(bf_lo(g.w)) * v1[2]; v1[3] = p1[3] + sigm(bf_hi(g.w)) * v1[3];
                    u32x4 w; w.x = cvt_pk_bf16(v0[0], v0[1]); w.y = cvt_pk_bf16(v0[2], v0[3]); w.z = cvt_pk_bf16(v1[0], v1[1]); w.w = cvt_pk_bf16(v1[2], v1[3]);
                    *(u32x4*)(O + (size_t)row * 2048 + c) = w; } }
    }
};
struct EpiG4 {
    static constexpr bool PERM = true, AFTER_DRAIN = false;
    bf16_t* O; float* P; const bf16_t* GA; const bf16_t* GB; int ldg;
    __device__ __forceinline__ void operator()(const f32x4 (&acc)[2][2][4][2], const Unit& u, int ui, int wr, int wc, int fr, int fq) const {
        const int col0 = u.pn * BM + wc * 32 + 8 * fq;
        const bf16_t* G = u.sel ? GB : GA;
#pragma unroll
        for (int ai = 0; ai < 2; ++ai)
#pragma unroll
            for (int m = 0; m < 4; ++m) { const int row = u.pm * BM + ai * HALF + wr * 64 + m * 16 + fr;
#pragma unroll
                for (int bj = 0; bj < 2; ++bj) { const int c = col0 + bj * HALF; const u32x4 g = *(const u32x4*)(G + (size_t)row * ldg + c);
                    f32x4 v0 = acc[ai][bj][m][0], v1 = acc[ai][bj][m][1];
                    v0[0] *= sigm(bf_lo(g.x)); v0[1] *= sigm(bf_hi(g.x)); v0[2] *= sigm(bf_lo(g.y)); v0[3] *= sigm(bf_hi(g.y));
                    v1[0] *= sigm(bf_lo(g.z)); v1[1] *= sigm(bf_hi(g.z)); v1[2] *= sigm(bf_lo(g.w)); v1[3] *= sigm(bf_hi(g.w));
                    float* pp = P + (size_t)row * 2048 + c;
                    if (u.sel == 0) { *(f32x4*)pp = v0; *(f32x4*)(pp + 4) = v1; }
                    else { v0 += *(const f32x4*)pp; v1 += *(const f32x4*)(pp + 4);
                        u32x4 w; w.x = cvt_pk_bf16(v0[0], v0[1]); w.y = cvt_pk_bf16(v0[2], v0[3]); w.z = cvt_pk_bf16(v1[0], v1[1]); w.w = cvt_pk_bf16(v1[2], v1[3]);
                        *(u32x4*)(O + (size_t)row * 2048 + c) = w; } } }
    }
};
struct EpiG4m {
    static constexpr bool PERM = true, AFTER_DRAIN = false, MIDK = true;
    bf16_t* O; const bf16_t* RHO; const bf16_t* SGB;
    __device__ __forceinline__ void scale(f32x4 (&acc)[2][2][4][2], const bf16_t* T, const Unit& u, int wr, int wc, int fr, int fq) const {
        const int col0 = u.pn * BM + wc * 32 + 8 * fq;
        u32x4 gv[2][4][2];
#pragma unroll
        for (int ai = 0; ai < 2; ++ai)
#pragma unroll
            for (int m = 0; m < 4; ++m)
#pragma unroll
                for (int bj = 0; bj < 2; ++bj) gv[ai][m][bj] = *(const u32x4*)(T + (size_t)(u.pm * BM + ai * HALF + wr * 64 + m * 16 + fr) * 2048 + col0 + bj * HALF);
        __builtin_amdgcn_sched_barrier(0);
#pragma unroll
        for (int ai = 0; ai < 2; ++ai)
#pragma unroll
            for (int m = 0; m < 4; ++m)
#pragma unroll
                for (int bj = 0; bj < 2; ++bj) { const u32x4 g = gv[ai][m][bj]; f32x4& v0 = acc[ai][bj][m][0]; f32x4& v1 = acc[ai][bj][m][1];
                    v0[0] *= bf_lo(g.x); v0[1] *= bf_hi(g.x); v0[2] *= bf_lo(g.y); v0[3] *= bf_hi(g.y); v1[0] *= bf_lo(g.z); v1[1] *= bf_hi(g.z); v1[2] *= bf_lo(g.w); v1[3] *= bf_hi(g.w); }
    }
    __device__ __forceinline__ void midk(f32x4 (&acc)[2][2][4][2], const Unit& u, int wr, int wc, int fr, int fq) const {
        asm volatile("" : "+v"(fr), "+v"(fq));
        scale(acc, RHO, u, wr, wc, fr, fq);
    }
    __device__ __forceinline__ void operator()(const f32x4 (&acc_)[2][2][4][2], const Unit& u, int ui, int wr, int wc, int fr, int fq) const {
        f32x4 acc[2][2][4][2];
#pragma unroll
        for (int a = 0; a < 2; ++a)
#pragma unroll
            for (int b = 0; b < 2; ++b)
#pragma unroll
                for (int m = 0; m < 4; ++m)
#pragma unroll
                    for (int n = 0; n < 2; ++n) acc[a][b][m][n] = acc_[a][b][m][n];
        scale(acc, SGB, u, wr, wc, fr, fq);
        const int col0 = u.pn * BM + wc * 32 + 8 * fq;
#pragma unroll
        for (int ai = 0; ai < 2; ++ai)
#pragma unroll
            for (int m = 0; m < 4; ++m) { const int row = u.pm * BM + ai * HALF + wr * 64 + m * 16 + fr;
#pragma unroll
                for (int bj = 0; bj < 2; ++bj) { const f32x4 v0 = acc[ai][bj][m][0], v1 = acc[ai][bj][m][1];
                    u32x4 w; w.x = cvt_pk_bf16(v0[0], v0[1]); w.y = cvt_pk_bf16(v0[2], v0[3]); w.z = cvt_pk_bf16(v1[0], v1[1]); w.w = cvt_pk_bf16(v1[2], v1[3]);
                    *(u32x4*)(O + (size_t)row * 2048 + col0 + bj * HALF) = w; } }
    }
};
struct DualOrder : StaticOrder {
    __host__ __device__ bool next(int i, Unit& u) const { if (!StaticOrder::next(i >> 1, u)) return false; u.sel = i & 1; return true; }
};
struct EpiRes {
    static constexpr bool PERM = false, AFTER_DRAIN = false;
    bf16_t* HB; float* RS;
    __device__ __forceinline__ void operator()(const f32x4 (&acc)[2][2][4][2], const Unit& u, int ui, int wr, int wc, int fr, int fq) const {
        const int col0 = u.pn * BM + wc * 32 + 4 * fq;
        u32x2 ho[2][4][2][2];
#pragma unroll
        for (int ai = 0; ai < 2; ++ai)
#pragma unroll
            for (int m = 0; m < 4; ++m) { const int row = u.pm * BM + ai * HALF + wr * 64 + m * 16 + fr;
#pragma unroll
                for (int bj = 0; bj < 2; ++bj)
#pragma unroll
                    for (int n = 0; n < 2; ++n) ho[ai][m][bj][n] = *(const u32x2*)(HB + (size_t)row * 2048 + col0 + bj * HALF + n * 16); }
        __builtin_amdgcn_sched_barrier(0);
#pragma unroll
        for (int ai = 0; ai < 2; ++ai)
#pragma unroll
            for (int m = 0; m < 4; ++m) { const int row = u.pm * BM + ai * HALF + wr * 64 + m * 16 + fr; float ss = 0.f;
#pragma unroll
                for (int bj = 0; bj < 2; ++bj)
#pragma unroll
                    for (int n = 0; n < 2; ++n) { const size_t off = (size_t)row * 2048 + col0 + bj * HALF + n * 16;
                        const u32x2 h0 = ho[ai][m][bj][n];
                        f32x4 hv = {bf_lo(h0.x), bf_hi(h0.x), bf_lo(h0.y), bf_hi(h0.y)}; hv += acc[ai][bj][m][n];
                        u32x2 w; w.x = cvt_pk_bf16(hv[0], hv[1]); w.y = cvt_pk_bf16(hv[2], hv[3]); *(u32x2*)(HB + off) = w;
                        ss += (hv[0] * hv[0] + hv[1] * hv[1]) + (hv[2] * hv[2] + hv[3] * hv[3]); }
                ss += __shfl_xor(ss, 16); ss += __shfl_xor(ss, 32);
                if (fq == 0) RS[(size_t)row * 32 + u.pn * 4 + wc] = ss; }
    }
};
}

#define GAS __attribute__((address_space(1)))
#define LAS __attribute__((address_space(3)))
typedef unsigned short bf16;
typedef unsigned v4u __attribute__((ext_vector_type(4)));
typedef float f32x4 __attribute__((ext_vector_type(4)));
typedef short bf16x8 __attribute__((ext_vector_type(8)));
typedef GAS unsigned gu32;
typedef GAS unsigned long long gu64;
#define RLX_AGENT __ATOMIC_RELAXED, __HIP_MEMORY_SCOPE_AGENT
#define LDS_WAIT() asm volatile("s_waitcnt lgkmcnt(0)" ::: "memory")
#define VM_WAIT() asm volatile("s_waitcnt vmcnt(0)" ::: "memory")
__device__ __forceinline__ unsigned long long rt() { return __builtin_amdgcn_s_memrealtime(); }
__device__ __forceinline__ unsigned f2bf(float f) { unsigned u = __builtin_bit_cast(unsigned, f); return (u + 0x7fffu + ((u >> 16) & 1u)) >> 16; }
__device__ __forceinline__ unsigned pk2(float lo, float hi) { return f2bf(lo) | (f2bf(hi) << 16); }

#define XB_TMO      128
#define XB_XCNT(j)  (256  + 64 * (j))
#define XB_XSUB(j)  (1280 + 64 * (j))
#define XB_XGEN(j)  (2304 + 64 * (j))
#define XB_TOP      3328
#define XB_TOPGEN   3392
#define XCD_BAR_WORDS 3456
#define XB_SPIN_CAP (1u << 18)

__device__ __forceinline__ unsigned xb_ld(unsigned* p)              { return __hip_atomic_load(p, __ATOMIC_RELAXED, __HIP_MEMORY_SCOPE_AGENT); }
__device__ __forceinline__ unsigned xb_add(unsigned* p, unsigned v) { return __hip_atomic_fetch_add(p, v, __ATOMIC_RELAXED, __HIP_MEMORY_SCOPE_AGENT); }
__device__ __forceinline__ unsigned xb_xcc_id() { return (unsigned)__builtin_amdgcn_s_getreg((3 << 11) | 20) & 0xFu; }
#define XB_SPIN(cond, bar) do { unsigned _sp = 0; while (cond) { __builtin_amdgcn_s_sleep(1); \
    if ((++_sp & 255u) == 0u) { if (xb_ld(&(bar)[XB_TMO])) break; if (_sp > XB_SPIN_CAP) { atomicAdd(&(bar)[XB_TMO], 1u); break; } } } } while (0)

struct XcdBarrier {
    unsigned* bar; unsigned x;
    volatile LAS unsigned* st;
};

__device__ __forceinline__ XcdBarrier xcd_barrier_post(unsigned* bar, volatile LAS unsigned* st) {
    XcdBarrier b; b.bar = bar; b.x = xb_xcc_id(); b.st = st;
    if (threadIdx.x == 0) (void)xb_add(&bar[XB_XCNT(b.x)], 1u);
    return b;
}
__device__ __forceinline__ void xcd_barrier_complete(unsigned* bar, unsigned x, unsigned& nloc, unsigned& nx) {
    const unsigned G = gridDim.x * gridDim.y * gridDim.z;
    unsigned sum, cnt, mine, sp = 0u;
    for (;;) {
        sum = 0u; cnt = 0u; mine = 0u;
#pragma unroll
        for (unsigned j = 0; j < 16; ++j) { const unsigned c = xb_ld(&bar[XB_XCNT(j)]); sum += c; cnt += (c > 0u) ? 1u : 0u; mine = (j == x) ? c : mine; }
        if (sum == G) break;
        __builtin_amdgcn_s_sleep(1);
        if ((++sp & 255u) == 0u) { if (xb_ld(&bar[XB_TMO])) break; if (sp > XB_SPIN_CAP) { atomicAdd(&bar[XB_TMO], 1u); break; } }
    }
    nloc = mine > 0u ? mine : 1u; nx = cnt > 0u ? cnt : 1u;
}

__device__ __forceinline__ void xcd_barrier(const XcdBarrier& b, bool thread0) {
    asm volatile("s_waitcnt vmcnt(0)" ::: "memory");
    __syncthreads();
    if (thread0) {
        unsigned* bar = b.bar;
        __builtin_amdgcn_s_waitcnt(0);
        unsigned nloc = b.st[0], nx = b.st[1];
        if (nloc == 0u) { xcd_barrier_complete(bar, b.x, nloc, nx); b.st[0] = nloc; b.st[1] = nx; }
        const unsigned old = xb_add(&bar[XB_XSUB(b.x)], 1u);
        const unsigned gen = old / nloc;
        if (old + 1u == (gen + 1u) * nloc) {
            __builtin_amdgcn_fence(__ATOMIC_RELEASE, "agent");
            asm volatile("s_waitcnt vmcnt(0)" ::: "memory");
            const unsigned og = xb_add(&bar[XB_TOP], 1u);
            const unsigned tg = og / nx;
            if (og + 1u == (tg + 1u) * nx) xb_add(&bar[XB_TOPGEN], 1u);
            else XB_SPIN(xb_ld(&bar[XB_TOPGEN]) == tg, bar);
            __builtin_amdgcn_fence(__ATOMIC_ACQUIRE, "agent");
            xb_add(&bar[XB_XGEN(b.x)], 1u);
            asm volatile("s_waitcnt vmcnt(0)" ::: "memory");
        } else {
            XB_SPIN(xb_ld(&bar[XB_XGEN(b.x)]) == gen, bar);
            __builtin_amdgcn_fence(__ATOMIC_ACQUIRE, "agent");
            asm volatile("s_waitcnt vmcnt(0)" ::: "memory");
        }
    }
    __syncthreads();
}
#ifndef MK_PROBE
#define MK_PROBE (-1)
#endif
#ifndef MK_PROBE_SCALE
#define MK_PROBE_SCALE 4e-6f
#endif
#define PROBE_T0() unsigned long long pt0_ = 0; if (MK_PROBE >= 0) { pt0_ = __builtin_amdgcn_s_memtime(); asm volatile("s_waitcnt lgkmcnt(0)" ::: "memory"); }
#define PROBE_T1(id) do { if (MK_PROBE == (id)) { const unsigned long long pt1_ = __builtin_amdgcn_s_memtime(); asm volatile("s_waitcnt lgkmcnt(0)" ::: "memory"); \
    if (C.bid == 0 && C.wave == 0 && C.lane == 0) { volatile LAS unsigned* pw_ = (volatile LAS unsigned*)(C.lds + MISC_OFF + 64); pw_[0] = pw_[0] + (unsigned)(pt1_ - pt0_); } } } while (0)
constexpr int NWAVES = 8;
constexpr int NLAYER = 4, DM = 2048, NBATCH = 2, SEQ = 4096, NMETA = 16, LTOK = SEQ + NMETA, NTOK = NBATCH * LTOK;
constexpr int MP = 8448;
constexpr int NP1 = 8448;
constexpr int NC_IN = 8264;
constexpr int PC_QA = 0, PC_KA = 1024, PC_VA = 1152, PC_ZA = 1280, PC_CQ = 2304, PC_CKV = 2816, PC_ZB = 3072, PC_GA = 4096, PC_GB = 6144, PC_KIDX = 8192, PC_WIDX = 8256;
constexpr int NQ2 = 4608;
constexpr int TOPK = 256;
constexpr int YLD = 2048;
constexpr float RMS_EPS = 1e-6f;

__device__ __forceinline__ int rowof(int b, int t) { return t < NMETA ? 8192 + b * NMETA + t : b * SEQ + (t - NMETA); }
__device__ __forceinline__ int t5_bucket(int d) {
    const int n = d < 0 ? 0 : d;
    if (n < 16) return n;
    return 16 + (n >= 19) + (n >= 21) + (n >= 24) + (n >= 27) + (n >= 31) + (n >= 35) + (n >= 40) + (n >= 46) + (n >= 52) + (n >= 59) + (n >= 67) + (n >= 77) + (n >= 87) + (n >= 99) + (n >= 113);
}
__device__ __forceinline__ float bf2f(bf16 v) { return __uint_as_float((unsigned)v << 16); }
__device__ __forceinline__ float sigmoidf_(float x) { return 1.0f / (1.0f + __expf(-x)); }
__device__ __forceinline__ float siluf_(float x) { return x / (1.0f + __expf(-x)); }
__device__ __forceinline__ float wave_sum(float v) {
#pragma unroll
    for (int o = 1; o < 64; o <<= 1) v += __shfl_xor(v, o);
    return v;
}
__device__ __forceinline__ float wave_max(float v) {
#pragma unroll
    for (int o = 1; o < 64; o <<= 1) v = fmaxf(v, __shfl_xor(v, o));
    return v;
}
__device__ __forceinline__ int wave_sum_i(int v) {
#pragma unroll
    for (int o = 1; o < 64; o <<= 1) v += __shfl_xor(v, o);
    return v;
}

constexpr size_t MiB = 1u << 20;
constexpr size_t WS_CTL = 0, CTL_ZERO_BYTES = 1 * MiB;
constexpr size_t SZ_W1 = (size_t)NLAYER * NP1 * DM * 2, SZ_W2 = (size_t)NLAYER * NQ2 * 512 * 2, SZ_WA = (size_t)NLAYER * DM * 1024 * 2, SZ_WO = (size_t)NLAYER * DM * DM * 2;
constexpr size_t al(size_t x) { return (x + 4095) / 4096 * 4096; }
constexpr size_t WS_W1 = 1 * MiB, WS_W2 = WS_W1 + al(SZ_W1), WS_WA = WS_W2 + al(SZ_W2), WS_WB = WS_WA + 1024 * 2, WS_WO = WS_WA + al(2 * SZ_WA);
constexpr size_t SZ_WUV = (size_t)NLAYER * 16 * 64 * 256 * 2;
constexpr size_t WS_WUV = WS_WO + al(SZ_WO);
constexpr size_t WS_VT = WS_WUV + al(SZ_WUV);
constexpr size_t WS_KV = WS_VT + al((size_t)2 * 128 * 4128 * 2), WS_KIDX = WS_KV + al((size_t)MP * 256 * 2);
constexpr size_t WS_H = WS_KIDX + al((size_t)MP * 64 * 2), WS_HB = WS_H + al((size_t)MP * DM * 4), WS_RS = WS_HB + al((size_t)MP * DM * 2);
constexpr size_t WS_RS2 = WS_RS + al((size_t)MP * 32 * 4);
constexpr size_t WS_RSQ = WS_RS2 + al((size_t)32 * 64 * 4), WS_RSQ2 = WS_RSQ + al((size_t)MP * 8 * 4);
constexpr size_t WS_PROJ = WS_RSQ2 + al((size_t)32 * 16 * 4), WS_CQN = WS_PROJ + al((size_t)MP * NP1 * 2), WS_CKVN = WS_CQN + al((size_t)MP * 512 * 2);
constexpr size_t WS_Q2 = WS_CKVN + al((size_t)MP * 256 * 2), WS_OLAT = WS_Q2 + al((size_t)MP * NQ2 * 2), WS_YA = WS_OLAT + al((size_t)256 * 3 * 16 * 8 * 64 * 8 * 2);
constexpr size_t WS_YB = WS_YA + 1024 * 2, WS_PA = WS_YA + al((size_t)MP * 2048 * 2),
 WS_MG = WS_PA + al((size_t)MP * DM * 4), WS_RHO = WS_MG + al((size_t)MP * DM * 2), WS_SGB = WS_RHO + al((size_t)MP * DM * 2), WS_END = WS_SGB + al((size_t)MP * DM * 2);
constexpr int CW_TMO = 0, CW_CODE = 1, CW_BAR = 4096;

constexpr int LDSCTL_OFF = 0, MISC_OFF = LDSCTL_OFF + 320;
constexpr int RSTD_OFF = 512;
constexpr int RING_OFF = 8192, RING_BYTES = 131072;
constexpr int LDS_BYTES = 163840;
static_assert(RSTD_OFF + 5 * 256 * 4 <= RING_OFF, "LDS map");

struct Args {
    const float* x; const float* meta; const float* bias_table; const float* norm_g; const float* w_in; const float* q_norm_g; const float* kv_norm_g; const float* w_qb; const float* w_iq;
    const float* w_uk; const float* w_uv; const float* sinks; const float* w_proj_a; const float* w_proj_b; const float* w_out; const float* final_g;
    float* out; unsigned char* ws; int ph_lo, ph_hi;
};

__device__ __forceinline__ unsigned pkh(float lo, float hi) { typedef float f2_t __attribute__((ext_vector_type(2))); typedef __bf16 b2_t __attribute__((ext_vector_type(2))); f2_t v = {lo, hi}; b2_t b = __builtin_convertvector(v, b2_t); return __builtin_bit_cast(unsigned, b); }
struct XDesc { const float* W; const float* scale; bf16* out; int ldw, k0, c0, nvalid, K; };
__device__ __forceinline__ void xpose_load(const XDesc& d, float (&v)[32], int lane) {
    asm volatile("" : "+v"(lane));
    const int c = lane & 31, cc = (c < d.nvalid) ? c : 0; const float* p = d.W + (size_t)(d.k0 + (lane >> 5)) * d.ldw + d.c0 + cc;
    const float keep = (c < d.nvalid) ? 1.f : 0.f;
#pragma unroll
    for (int i = 0; i < 32; ++i) v[i] = p[(size_t)(2 * i) * d.ldw];
#pragma unroll
    for (int i = 0; i < 32; ++i) v[i] *= keep;
    if (d.scale) {
#pragma unroll
        for (int i = 0; i < 32; ++i) v[i] *= d.scale[d.k0 + 2 * i + (lane >> 5)];
    }
}
__device__ __forceinline__ void xpose_store(const XDesc& d, const float (&v)[32], LAS float* scr, int lane) {
    asm volatile("" : "+v"(lane));
    const int c = lane & 31;
#pragma unroll
    for (int i = 0; i < 32; ++i) scr[(2 * i + (lane >> 5)) * 33 + c] = v[i];
    LDS_WAIT(); asm volatile("" ::: "memory");
    const int cc = lane & 7;
#pragma unroll
    for (int j = 0; j < 4; ++j) { const int n = (lane >> 3) + 8 * j; const LAS float* s = scr + (8 * cc) * 33 + n;
        v4u o; o.x = pkh(s[0 * 33], s[1 * 33]); o.y = pkh(s[2 * 33], s[3 * 33]); o.z = pkh(s[4 * 33], s[5 * 33]); o.w = pkh(s[6 * 33], s[7 * 33]);
        *(GAS v4u*)(d.out + (size_t)n * d.K + d.k0 + 8 * cc) = o; }
    LDS_WAIT(); asm volatile("" ::: "memory");
}
__device__ __forceinline__ void fold_item(const float* __restrict__ wqb, const float* __restrict__ wuk, const float* __restrict__ gq, bf16* W2l, int h, int kb, int rb, LAS float* scr, int lane) {
    const int rr = lane & 31, r = rb * 32 + rr;
    float uk[64];
#pragma unroll
    for (int d = 0; d < 64; ++d) uk[d] = wuk[((size_t)h * 64 + d) * 256 + r];
    for (int i = 0; i < 32; ++i) { const int kk = 2 * i + (lane >> 5), k = kb * 64 + kk; const f32x4* qp = (const f32x4*)(wqb + (size_t)k * 1024 + h * 64); float a = 0.f;
#pragma unroll
        for (int d4 = 0; d4 < 16; ++d4) { const f32x4 q = qp[d4]; a = fmaf(q[0], uk[4 * d4], a); a = fmaf(q[1], uk[4 * d4 + 1], a); a = fmaf(q[2], uk[4 * d4 + 2], a); a = fmaf(q[3], uk[4 * d4 + 3], a); }
        scr[kk * 33 + rr] = a * gq[k]; }
    LDS_WAIT(); asm volatile("" ::: "memory");
    const int cc = lane & 7; bf16* out = W2l + (size_t)(h * 256 + rb * 32) * 512;
#pragma unroll
    for (int j = 0; j < 4; ++j) { const int n = (lane >> 3) + 8 * j; const LAS float* s = scr + (8 * cc) * 33 + n;
        v4u o; o.x = pkh(s[0 * 33], s[1 * 33]); o.y = pkh(s[2 * 33], s[3 * 33]); o.z = pkh(s[4 * 33], s[5 * 33]); o.w = pkh(s[6 * 33], s[7 * 33]);
        *(GAS v4u*)(out + (size_t)n * 512 + kb * 64 + 8 * cc) = o; }
    LDS_WAIT(); asm volatile("" ::: "memory");
}

struct Ctx {
    LAS unsigned char* lds; int tid, lane, wave, G, gw, NGW, bid;
    Args a;
};
#if defined(__HIP_DEVICE_COMPILE__)
#define ASSUME_GLOBAL(p) do { __builtin_assume(!__builtin_amdgcn_is_shared((const void*)(p))); __builtin_assume(!__builtin_amdgcn_is_private((const void*)(p))); } while (0)
#else
#define ASSUME_GLOBAL(p) do { } while (0)
#endif
__device__ __forceinline__ unsigned char* launder(unsigned char* p) { size_t z = 0; asm volatile("" : "+s"(z)); return p + z; }
__device__ __forceinline__ const float* launderf(const float* p) { size_t z = 0; asm volatile("" : "+s"(z)); return p + z; }
struct Bufs {
    bf16 *W1, *W2, *WA, *WB, *WO, *WUV, *VT, *KV, *KIDX, *RHO, *SGB, *HB, *PROJ, *CQN, *CKVN, *Q2, *OLAT, *YA, *YB, *MG; float *H, *RS, *RS2, *RSQ, *RSQ2, *PA;
    __device__ __forceinline__ explicit Bufs(unsigned char* ws0) {
        unsigned char* ws = launder(ws0);
        W1 = (bf16*)(ws + WS_W1); W2 = (bf16*)(ws + WS_W2); WA = (bf16*)(ws + WS_WA); WB = (bf16*)(ws + WS_WB); WO = (bf16*)(ws + WS_WO); WUV = (bf16*)(ws + WS_WUV); VT = (bf16*)(ws + WS_VT); KV = (bf16*)(ws + WS_KV); KIDX = (bf16*)(ws + WS_KIDX); RHO = (bf16*)(ws + WS_RHO); SGB = (bf16*)(ws + WS_SGB);
        H = (float*)(ws + WS_H); HB = (bf16*)(ws + WS_HB); RS = (float*)(ws + WS_RS); RS2 = (float*)(ws + WS_RS2); RSQ = (float*)(ws + WS_RSQ); RSQ2 = (float*)(ws + WS_RSQ2); PROJ = (bf16*)(ws + WS_PROJ); CQN = (bf16*)(ws + WS_CQN); CKVN = (bf16*)(ws + WS_CKVN);
        Q2 = (bf16*)(ws + WS_Q2); OLAT = (bf16*)(ws + WS_OLAT); YA = (bf16*)(ws + WS_YA); YB = (bf16*)(ws + WS_YB); PA = (float*)(ws + WS_PA); MG = (bf16*)(ws + WS_MG);
    }
};

__device__ __forceinline__ void p0_prologue(const Ctx& C) {
    const Bufs B(C.a.ws);
    const Args& A = C.a;
    LAS float* scr = (LAS float*)(C.lds + RING_OFF + C.wave * 16384);
    constexpr int I_T1 = (DM / 64) * (NP1 / 32), I_T2 = (512 / 64) * (512 / 32), I_T3 = (1024 / 64) * (DM / 32), I_T5 = (DM / 64) * (DM / 32), I_F = 16 * 8 * 8, I_UV = 16 * 8;
    constexpr int I_X = I_T1 + I_T2 + 2 * I_T3 + I_T5, NX = NLAYER * I_X;
    auto decode = [&](int it) -> XDesc {
        const int l = it / I_X; int r = it % I_X; XDesc d;
        if (r < I_T1) { const int nblk = NP1 / 32, kb = r / nblk, n0 = (r % nblk) * 32; int c0, nvalid = 32;
            if (n0 < 4096) c0 = n0; else if (n0 < 8192) { const int tt = (n0 - 4096) >> 8, wi = (n0 - 4096) & 255; c0 = (wi < 128 ? 4168 : 6216 - 128) + 128 * tt + wi; }
            else { c0 = n0 - 8192 + 4096; nvalid = (8264 - n0) < 0 ? 0 : ((8264 - n0) > 32 ? 32 : (8264 - n0)); }
            d = XDesc{A.w_in + (size_t)l * DM * NC_IN, A.norm_g + l * DM, B.W1 + ((size_t)l * NP1 + n0) * DM, NC_IN, kb * 64, c0, nvalid, DM}; return d; }
        r -= I_T1;
        if (r < I_T2) { const int nblk = 512 / 32, kb = r / nblk, nb = r % nblk;
            d = XDesc{A.w_iq + (size_t)l * 512 * 512, A.q_norm_g + l * 512, B.W2 + ((size_t)l * NQ2 + 4096 + nb * 32) * 512, 512, kb * 64, nb * 32, 32, 512}; return d; }
        r -= I_T2;
        if (r < 2 * I_T3) { const bool second = r >= I_T3; if (second) r -= I_T3; const int nblk = DM / 32, kb = r / nblk, nb = r % nblk;
            d = XDesc{(second ? A.w_proj_b : A.w_proj_a) + (size_t)l * 1024 * DM, nullptr, (second ? B.WB : B.WA) + ((size_t)l * DM + nb * 32) * 2048, DM, kb * 64, nb * 32, 32, 2048}; return d; }
        r -= 2 * I_T3;
        { const int nblk = DM / 32, kb = r / nblk, nb = r % nblk;
            d = XDesc{A.w_out + (size_t)l * DM * DM, nullptr, B.WO + ((size_t)l * DM + nb * 32) * DM, DM, kb * 64, nb * 32, 32, DM}; return d; }
    };
    {
        int it = C.gw;
        if (it < NX) {
            XDesc dc = decode(it); float vc[32]; xpose_load(dc, vc, C.lane);
            for (;;) {
                const int itn = it + C.NGW; const bool more = itn < NX;
                XDesc dn = dc; float vn[32];
                if (more) { dn = decode(itn); xpose_load(dn, vn, C.lane); }
                xpose_store(dc, vc, scr, C.lane);
                if (!more) break;
                dc = dn; it = itn;
#pragma unroll
                for (int i = 0; i < 32; ++i) vc[i] = vn[i];
            }
        }
    }
    for (int it = C.gw; it < NLAYER * (I_F + I_UV); it += C.NGW) {
        const int l = it / (I_F + I_UV); int r = it % (I_F + I_UV);
        if (r >= I_F) { r -= I_F; const int h = r / 8, s = r % 8;
            const float* wsrc = A.w_uv + ((size_t)l * 16 + h) * 256 * 64; const int gg = C.lane >> 4, cc = C.lane & 15;
#pragma unroll
            for (int nt = 0; nt < 4; ++nt) { const float* p = wsrc + (size_t)(32 * s + 8 * gg) * 64 + 16 * nt + cc;
                v4u o; o.x = pkh(p[0 * 64], p[1 * 64]); o.y = pkh(p[2 * 64], p[3 * 64]); o.z = pkh(p[4 * 64], p[5 * 64]); o.w = pkh(p[6 * 64], p[7 * 64]);
                *(GAS v4u*)(B.WUV + ((((size_t)l * 16 + h) * 8 + s) * 4 + nt) * 512 + C.lane * 8) = o; }
            continue; }
        { const int h = r / 64, kb = (r / 8) % 8, rb = r % 8;
            fold_item(A.w_qb + (size_t)l * 512 * 1024, A.w_uk + (size_t)l * 16 * 64 * 256, A.q_norm_g + l * 512, B.W2 + (size_t)l * NQ2 * 512, h, kb, rb, scr, C.lane); }
    }
    for (int m = C.gw; m < MP; m += C.NGW) {
        const float* src = nullptr;
        if (m < 8192) src = A.x + (size_t)m * DM; else if (m < 8224) src = A.meta + (size_t)((m - 8192) % NMETA) * DM;
        float ss = 0.f;
#pragma unroll
        for (int j = 0; j < 8; ++j) { f32x4 v = src ? *(const f32x4*)(src + j * 256 + C.lane * 4) : (f32x4){0.f, 0.f, 0.f, 0.f};
            pg8::u32x2 w; w.x = pkh(v[0], v[1]); w.y = pkh(v[2], v[3]); *(pg8::u32x2*)(B.HB + (size_t)m * DM + j * 256 + C.lane * 4) = w;
            ss += (v[0] * v[0] + v[1] * v[1]) + (v[2] * v[2] + v[3] * v[3]); }
        ss = wave_sum(ss);
        if (C.lane < 32) B.RS[(size_t)m * 32 + C.lane] = (C.lane == 0) ? ss : 0.f;
        if (m >= 8192 && m < 8224) B.RS2[(size_t)(m - 8192) * 64 + C.lane] = (C.lane == 0) ? ss : 0.f;
        if (m >= NTOK) {
#pragma unroll
            for (int j = 0; j < 2; ++j) { *(v4u*)(B.YA + (size_t)m * YLD + j * 512 + C.lane * 8) = (v4u){0u, 0u, 0u, 0u}; *(v4u*)(B.YB + (size_t)m * YLD + j * 512 + C.lane * 8) = (v4u){0u, 0u, 0u, 0u}; }
        }
    }
}

template <int NP4>
__device__ __forceinline__ void rstd_table(const Ctx& C, const pg8::StaticOrder& S, const float* __restrict__ rs, float inv_dim) {
    LAS float* tbl = (LAS float*)(C.lds + RSTD_OFF);
    pg8::Unit u;
    for (int ui = 0; ui < 5 && S.next(ui, u); ++ui) {
        if (C.tid < 256) { const f32x4* p = (const f32x4*)(rs + (size_t)(u.pm * 256 + C.tid) * (NP4 * 4)); float s = 0.f;
#pragma unroll
            for (int j = 0; j < NP4; ++j) { const f32x4 v = p[j]; s += (v[0] + v[1]) + (v[2] + v[3]); }
            tbl[ui * 256 + C.tid] = rsqrtf(s * inv_dim + RMS_EPS); }
    }
    __syncthreads();
}

__device__ __forceinline__ void norm_tail(const Ctx& C, int l) {
    const Bufs B(C.a.ws);
    const Args& A = C.a;
    const int gw2 = (C.G == 256) ? C.gw - 64 * NWAVES : C.gw, ngw2 = (C.G == 256) ? C.NGW - 64 * NWAVES : C.NGW;
    if (gw2 < 0) return;
    for (int m = gw2; m < NTOK; m += ngw2) {
        const bf16* pr = B.PROJ + (size_t)m * NP1;
        { const pg8::u32x2 w = *(const pg8::u32x2*)(pr + PC_CKV + C.lane * 4); float v[4] = {pg8::bf_lo(w.x), pg8::bf_hi(w.x), pg8::bf_lo(w.y), pg8::bf_hi(w.y)};
          float ss = (v[0] * v[0] + v[1] * v[1]) + (v[2] * v[2] + v[3] * v[3]);
          ss = wave_sum(ss); const float r = rsqrtf(ss * (1.0f / 256.0f) + RMS_EPS);
          const f32x4 g = *(const f32x4*)(A.kv_norm_g + l * 256 + C.lane * 4);
          pg8::u32x2 o; o.x = pkh(v[0] * r * g[0], v[1] * r * g[1]); o.y = pkh(v[2] * r * g[2], v[3] * r * g[3]);
          *(pg8::u32x2*)(B.CKVN + (size_t)m * 256 + C.lane * 4) = o; }
    }
    for (int it = gw2; it < 2 * 65; it += ngw2) { const int b = it / 65, pos = (it % 65) * 64 + C.lane;
        if (pos < LTOK) { const bf16* vr = B.KV + (size_t)rowof(b, pos) * 256 + 128;
#pragma unroll 4
            for (int c8 = 0; c8 < 16; ++c8) { const v4u w = *(const v4u*)(vr + 8 * c8); bf16* o = B.VT + ((size_t)b * 128 + 8 * c8) * 4128 + pos;
                o[0 * 4128] = (bf16)(w.x & 0xffffu); o[1 * 4128] = (bf16)(w.x >> 16); o[2 * 4128] = (bf16)(w.y & 0xffffu); o[3 * 4128] = (bf16)(w.y >> 16);
                o[4 * 4128] = (bf16)(w.z & 0xffffu); o[5 * 4128] = (bf16)(w.z >> 16); o[6 * 4128] = (bf16)(w.w & 0xffffu); o[7 * 4128] = (bf16)(w.w >> 16); } } }
}

__device__ __forceinline__ unsigned f2key(float f) { const unsigned u = __float_as_uint(f); return (u & 0x80000000u) ? ~u : (u | 0x80000000u); }

__device__ __forceinline__ void final_phase(const Ctx& C) {
    const Bufs B(C.a.ws);
    const Args& A = C.a;
    for (int m = C.gw; m < 8192; m += C.NGW) {
        float s = (C.lane < 32) ? B.RS[(size_t)m * 32 + C.lane] : 0.f;
        s = wave_sum(s);
        const float r = rsqrtf(s * (1.0f / DM) + RMS_EPS);
#pragma unroll
        for (int j = 0; j < 8; ++j) { const pg8::u32x2 hw = *(const pg8::u32x2*)(B.HB + (size_t)m * DM + j * 256 + C.lane * 4); const f32x4 v = {pg8::bf_lo(hw.x), pg8::bf_hi(hw.x), pg8::bf_lo(hw.y), pg8::bf_hi(hw.y)}; const f32x4 g = *(const f32x4*)(A.final_g + j * 256 + C.lane * 4);
            *(f32x4*)(A.out + (size_t)m * DM + j * 256 + C.lane * 4) = v * r * g; }
    }
#if defined(MK_PROBE)
    if (MK_PROBE >= 0 && C.gw == 0) { VM_WAIT(); if (C.lane == 0) A.out[0] += (float)((volatile LAS unsigned*)(C.lds + MISC_OFF + 64))[0] * MK_PROBE_SCALE; }
#endif
}


struct SkProj {
    bf16* P; bf16* KV; bf16* KIDX; int cb; const LAS float* tbl;
    __device__ __forceinline__ float operator()(int rloc, int c, float v) const { const int ac = cb + c; const bf16 o = (bf16)f2bf(v * tbl[rloc]);
        if (ac >= 1024 && ac < 1280) KV[(size_t)rloc * 256 + ac - 1024] = o; else if (ac >= 8192 && ac < 8256) KIDX[(size_t)rloc * 64 + ac - 8192] = o; else P[(size_t)rloc * NP1 + ac] = o;
        return v * tbl[rloc]; } };
struct SkQ2 { bf16* O; const LAS float* tbl; __device__ __forceinline__ float operator()(int rloc, int c, float v) const { O[(size_t)rloc * NQ2 + c] = (bf16)f2bf(v * tbl[rloc]); return 0.f; } };
struct SkPA { float* P; const bf16* G; int c0; __device__ __forceinline__ float operator()(int rloc, int c, float v) const { const int cg = c0 + c; P[(size_t)rloc * DM + c] = sigmoidf_(bf2f(G[(size_t)rloc * NP1 + 256 * (cg >> 7) + (cg & 127)])) * v; return 0.f; } };
struct SkMerge { bf16* O; const float* P; const bf16* G; int c0; __device__ __forceinline__ float operator()(int rloc, int c, float v) const { const int cg = c0 + c; O[(size_t)rloc * DM + c] = (bf16)f2bf(P[(size_t)rloc * DM + c] + sigmoidf_(bf2f(G[(size_t)rloc * NP1 + 256 * (cg >> 7) + (cg & 127) + 128])) * v); return 0.f; } };
struct SkRes { bf16* HB; __device__ __forceinline__ float operator()(int rloc, int c, float v) const { const float h = bf2f(HB[(size_t)rloc * DM + c]) + v; HB[(size_t)rloc * DM + c] = (bf16)f2bf(h); return h; } };
constexpr int MR = 8192;
typedef float f32x16 __attribute__((ext_vector_type(16)));
__device__ __forceinline__ void sk_glds16(const void* gsrc, unsigned lds_dst) { unsigned keep;
    asm volatile("s_mov_b32 %0, m0\n\ts_mov_b32 m0, %2\n\ts_nop 0\n\tglobal_load_lds_dwordx4 %1, off\n\ts_mov_b32 m0, %0" : "=&s"(keep) : "v"(gsrc), "s"(lds_dst) : "memory"); }
template <int NT, int GPI, class F>
__device__ __forceinline__ void skinny_unit(const Ctx& C, const bf16* __restrict__ A, int lda, const bf16* __restrict__ Bt, int ldb, int K, float* ss_out  , int ss_ld, int ss_col0, const F& epi) {
    const int lane = C.lane, w = C.wave, r32 = lane & 31, hh = lane >> 5;
    f32x16 acc[NT];
#pragma unroll
    for (int nt = 0; nt < NT; ++nt) acc[nt] = (f32x16){};
    const int kper = K >> 3, ngroups = kper >> 6;
    const unsigned stg = (unsigned)__builtin_amdgcn_readfirstlane((unsigned)(uintptr_t)(C.lds + RING_OFF) + (unsigned)w * 16384u);
    LAS unsigned char* stp = C.lds + RING_OFF + w * 16384;
    const int prow = lane >> 3, pch = lane & 7;
    const int foff = r32 * 128;
    const int fsw = (r32 >> 1) & 7;
#pragma unroll 1
    for (int g0 = 0; g0 < ngroups; ++g0) {
        const size_t kbyte = ((size_t)w * kper + (size_t)g0 * 64) * 2;
#pragma unroll
        for (int p = 0; p < 4; ++p) { const int row = 8 * p + prow; const int lg = pch ^ ((row >> 1) & 7);
            sk_glds16((const unsigned char*)A + (size_t)row * lda * 2 + kbyte + lg * 16, stg + p * 1024); }
#pragma unroll
        for (int nt = 0; nt < NT; ++nt)
#pragma unroll
            for (int p = 0; p < 4; ++p) { const int row = 8 * p + prow; const int lg = pch ^ ((row >> 1) & 7);
                sk_glds16((const unsigned char*)Bt + (size_t)(nt * 32 + row) * ldb * 2 + kbyte + lg * 16, stg + 4096 * (1 + nt) + p * 1024); }
        asm volatile("s_waitcnt vmcnt(0)" ::: "memory");
        bf16x8 a[4], bv[NT][4];
#pragma unroll
        for (int s = 0; s < 4; ++s) { const int o = foff + (((2 * s + hh) ^ fsw) << 4); a[s] = *(const LAS bf16x8*)(stp + o);
#pragma unroll
            for (int nt = 0; nt < NT; ++nt) bv[nt][s] = *(const LAS bf16x8*)(stp + 4096 * (1 + nt) + o); }
        __builtin_amdgcn_sched_barrier(0);
#pragma unroll
        for (int s = 0; s < 4; ++s)
#pragma unroll
            for (int nt = 0; nt < NT; ++nt) acc[nt] = __builtin_amdgcn_mfma_f32_32x32x16_bf16(a[s], bv[nt][s], acc[nt], 0, 0, 0);
        LDS_WAIT(); asm volatile("" ::: "memory");
    }
    LDS_WAIT(); __syncthreads();
    LAS float* part = (LAS float*)(C.lds + RING_OFF);
#pragma unroll
    for (int nt = 0; nt < NT; ++nt)
#pragma unroll
        for (int i = 0; i < 16; ++i) part[(w * NT * 16 + nt * 16 + i) * 64 + lane] = acc[nt][i];
    LDS_WAIT(); __syncthreads();
#pragma unroll
    for (int j = 0; j < 2 * NT; ++j) { const int e = (w + 8 * j) * 64 + lane;
        const int nti = w + 8 * j, nt = nti >> 4, i = nti & 15;
        float v = 0.f;
#pragma unroll
        for (int ww = 0; ww < 8; ++ww) v += part[ww * NT * 1024 + e];
        const int rloc = (i & 3) + 8 * (i >> 2) + 4 * hh, c = nt * 32 + r32;
        float sv = epi(rloc, c, v);
        if (ss_out != nullptr) { sv = sv * sv;
#pragma unroll
            for (int o = 1; o < 32; o <<= 1) sv += __shfl_xor(sv, o);
            if (r32 == 0) ss_out[(size_t)rloc * ss_ld + ss_col0 + nt] = sv; }
    }
    LDS_WAIT(); __syncthreads();
}
__device__ __forceinline__ void skinny_rstd(const Ctx& C, const float* __restrict__ rs, int np, float inv_dim, LAS float* tbl) {
    if (C.tid < 32) { float s = 0.f; const f32x4* p = (const f32x4*)(rs + (size_t)C.tid * np);
        for (int j = 0; j < np / 4; ++j) { const f32x4 v = p[j]; s += (v[0] + v[1]) + (v[2] + v[3]); }
        tbl[C.tid] = rsqrtf(s * inv_dim + RMS_EPS); }
    LDS_WAIT(); __syncthreads();
}

typedef short s16x4 __attribute__((ext_vector_type(4)));
typedef unsigned short u16x4 __attribute__((ext_vector_type(4)));
constexpr int DS_ISC = RING_OFF, DS_ISC_WORDS = 4128, DS_ISC_STRIDE = DS_ISC_WORDS * 4;
constexpr int DS_SEL = DS_ISC + 8 * DS_ISC_STRIDE;
constexpr int DS_BIAS = DS_SEL + 8 * 512;
constexpr int DS_QROW = DS_BIAS + 8192;
constexpr int DS_END = DS_QROW + 256;
constexpr size_t OL_BLOCK = (size_t)3 * 16 * 8 * 64 * 8;
static_assert(DS_END <= LDS_BYTES, "DSA LDS map");

__device__ __forceinline__ void glds16(const void* gsrc, unsigned lds_dst) { unsigned keep;
    asm volatile("s_mov_b32 %0, m0\n\ts_mov_b32 m0, %2\n\ts_nop 0\n\tglobal_load_lds_dwordx4 %1, off\n\ts_mov_b32 m0, %0" : "=&s"(keep) : "v"(gsrc), "s"(lds_dst) : "memory"); }
__device__ __forceinline__ float relu1(float x) { const int i = __float_as_int(x); return __int_as_float(i > 0 ? i : 0); }
__device__ __forceinline__ void glds16o(const void* base, unsigned voff, unsigned lds_dst) { unsigned keep;
    asm volatile("s_mov_b32 %0, m0\n\ts_mov_b32 m0, %3\n\ts_nop 0\n\tglobal_load_lds_dwordx4 %1, %2\n\ts_mov_b32 m0, %0" : "=&s"(keep) : "v"(voff), "s"(base), "s"(lds_dst) : "memory"); }
__device__ __forceinline__ s16x4 tr_read(LAS unsigned char* p) { typedef short v4i16_t __attribute__((ext_vector_type(4))); return __builtin_bit_cast(s16x4, __builtin_amdgcn_ds_read_tr16_b64_v4i16((LAS v4i16_t*)p)); }
__device__ __forceinline__ unsigned cvtpk(float lo, float hi) { typedef float f2_t __attribute__((ext_vector_type(2))); typedef __bf16 b2_t __attribute__((ext_vector_type(2))); f2_t v = {lo, hi}; b2_t b = __builtin_convertvector(v, b2_t); return __builtin_bit_cast(unsigned, b); }

#define DSA_LOCALS() const int w = C.wave; LAS unsigned* ISC = (LAS unsigned*)(C.lds + DS_ISC); LAS unsigned short* sel = (LAS unsigned short*)(C.lds + DS_SEL) + w * 256; const LAS float* biasl = (const LAS float*)(C.lds + DS_BIAS); (void)ISC; (void)sel; (void)biasl
#define RELANE() do { asm volatile("" : "+v"(lane)); asm volatile("" : "+s"(t0), "+s"(b)); } while (0)
__device__ __forceinline__ void dsa_step1(const Ctx& C, const Bufs& B, int b, int t0) {
    int lane = C.lane; RELANE(); DSA_LOCALS();
    PROBE_T0();
    {
        const int r32 = lane & 31, hh = lane >> 5;
        bf16x8 qa[2][4]; float wq[2][2][8];
        const int qi = 2 * ((r32 >> 2) & 1) + (r32 >> 4), hA = (r32 & 3) + 4 * ((r32 >> 3) & 1);
#pragma unroll
        for (int g = 0; g < 2; ++g) { const int row = rowof(b, t0 + 4 * g + qi);
#pragma unroll
            for (int s = 0; s < 4; ++s) qa[g][s] = *(const bf16x8*)(B.Q2 + (size_t)row * NQ2 + 4096 + hA * 64 + 16 * s + 8 * hh);
#pragma unroll
            for (int j = 0; j < 2; ++j) { const int rw = rowof(b, t0 + 4 * g + 2 * hh + j); const v4u ww = *(const v4u*)(B.PROJ + (size_t)rw * NP1 + PC_WIDX);
                const float sc = 0.35355339059327373f * 0.125f;
                wq[g][j][0] = pg8::bf_lo(ww.x) * sc; wq[g][j][1] = pg8::bf_hi(ww.x) * sc; wq[g][j][2] = pg8::bf_lo(ww.y) * sc; wq[g][j][3] = pg8::bf_hi(ww.y) * sc;
                wq[g][j][4] = pg8::bf_lo(ww.z) * sc; wq[g][j][5] = pg8::bf_hi(ww.z) * sc; wq[g][j][6] = pg8::bf_lo(ww.w) * sc; wq[g][j][7] = pg8::bf_hi(ww.w) * sc; } }
        PROBE_T1(40);
        const int nkeys = t0 + 8, nkt = (nkeys + 31) >> 5;
        bf16x8 kA[4], kB[4];
#define IDX_LOAD(dst, kt_) do { const int key_ = (kt_) * 32 + r32, kc_ = key_ < nkeys ? key_ : nkeys - 1; const bf16* kp_ = B.KIDX + (size_t)rowof(b, kc_) * 64 + 8 * hh; \
        asm volatile("global_load_dwordx4 %0, %4, off\n\tglobal_load_dwordx4 %1, %4, off offset:32\n\tglobal_load_dwordx4 %2, %4, off offset:64\n\tglobal_load_dwordx4 %3, %4, off offset:96" \
                     : "=&v"(dst[0]), "=&v"(dst[1]), "=&v"(dst[2]), "=&v"(dst[3]) : "v"(kp_) : "memory"); } while (0)
#define IDX_WAIT(cur) asm volatile("s_waitcnt vmcnt(12)" : "+v"(cur[0]), "+v"(cur[1]), "+v"(cur[2]), "+v"(cur[3]) :: "memory")
#define IDX_TILE(src, kt_) do { const int key_ = (kt_) * 32 + r32; \
        _Pragma("unroll") for (int g = 0; g < 2; ++g) { f32x16 acc = {}; \
            _Pragma("unroll") for (int s = 0; s < 4; ++s) acc = __builtin_amdgcn_mfma_f32_32x32x16_bf16(qa[g][s], src[s], acc, 0, 0, 0); \
            _Pragma("unroll") for (int j = 0; j < 2; ++j) { float isc = 0.f; \
                _Pragma("unroll") for (int h = 0; h < 8; ++h) isc += wq[g][j][h] * relu1(acc[8 * j + h]); \
                ISC[(4 * g + 2 * hh + j) * DS_ISC_WORDS + key_] = f2key(isc); } } } while (0)
        bf16x8 kC[4], kD[4];
        int kt = w;
        const int ktl = nkt - 1;
        if (kt < nkt) {
            __builtin_amdgcn_s_waitcnt(0x0F70);
            IDX_LOAD(kA, kt); IDX_LOAD(kB, (kt + 8 < nkt ? kt + 8 : ktl)); IDX_LOAD(kC, (kt + 16 < nkt ? kt + 16 : ktl));
#define IDX_STEP(cur, nxt) { IDX_LOAD(nxt, (kt + 24 < nkt ? kt + 24 : ktl)); IDX_WAIT(cur); __builtin_amdgcn_sched_barrier(0); IDX_TILE(cur, kt); __builtin_amdgcn_sched_barrier(0); kt += 8; if (kt >= nkt) break; }
#pragma unroll 1
            for (;;) {
                IDX_STEP(kA, kD)
                IDX_STEP(kB, kA)
                IDX_STEP(kC, kB)
                IDX_STEP(kD, kC)
            }
#undef IDX_STEP
            asm volatile("s_waitcnt vmcnt(0)" : "+v"(kA[0]), "+v"(kA[1]), "+v"(kA[2]), "+v"(kA[3]), "+v"(kB[0]), "+v"(kB[1]), "+v"(kB[2]), "+v"(kB[3]) :: "memory");
            asm volatile("" : "+v"(kC[0]), "+v"(kC[1]), "+v"(kC[2]), "+v"(kC[3]), "+v"(kD[0]), "+v"(kD[1]), "+v"(kD[2]), "+v"(kD[3]) :: "memory");
        }
#undef IDX_WAIT
#undef IDX_LOAD
#undef IDX_TILE
        PROBE_T1(41);
    }
}
__device__ __forceinline__ int dsa_step2(const Ctx& C, int b, int t0) {
    int lane = C.lane; RELANE(); DSA_LOCALS();
    const int t = t0 + w, n = t + 1;
    int cnt;
    if (n <= TOPK) { for (int j = lane; j < n; j += 64) sel[j] = (unsigned short)j; cnt = n; }
    else {
        const LAS unsigned* myrow = ISC + w * DS_ISC_WORDS;
        const int nI = (n + 255) >> 8;
        unsigned v[68];
#pragma unroll
        for (int i = 0; i < 17; ++i) { const pg8::u32x4 x = *(const LAS pg8::u32x4*)(myrow + 256 * i + 4 * lane);
#pragma unroll
            for (int e = 0; e < 4; ++e) v[4 * i + e] = (256 * i + 4 * lane + e <= t) ? x[e] : 0u; }
        unsigned T = 0u; bool exact = false;
#define DSA_COUNT(res, cand_) do { int c_ = 0; const unsigned t_ = (cand_); \
        _Pragma("unroll") for (int i = 0; i < 17; ++i) { if (i < nI) { unsigned long long m0_, m1_, m2_, m3_; \
            asm volatile("v_cmp_ge_u32_e64 %1, %5, %9\n\tv_cmp_ge_u32_e64 %2, %6, %9\n\tv_cmp_ge_u32_e64 %3, %7, %9\n\tv_cmp_ge_u32_e64 %4, %8, %9\n\t" \
                         "v_addc_co_u32_e64 %0, %1, 0, %0, %1\n\tv_addc_co_u32_e64 %0, %2, 0, %0, %2\n\tv_addc_co_u32_e64 %0, %3, 0, %0, %3\n\tv_addc_co_u32_e64 %0, %4, 0, %0, %4" \
                         : "+v"(c_), "=&s"(m0_), "=&s"(m1_), "=&s"(m2_), "=&s"(m3_) : "v"(v[4 * i]), "v"(v[4 * i + 1]), "v"(v[4 * i + 2]), "v"(v[4 * i + 3]), "v"(t_)); } } \
        int tot_ = 0; _Pragma("unroll") for (int bt = 0; bt < 7; ++bt) tot_ += __popcll(__ballot((c_ >> bt) & 1)) << bt; res = tot_; } while (0)
        {
            unsigned kmax = 0u, kmin = 0xffffffffu;
#pragma unroll
            for (int i = 0; i < 17; ++i) { if (i < nI) {
#pragma unroll
                for (int e = 0; e < 4; ++e) { const unsigned x = v[4 * i + e]; kmax = x > kmax ? x : kmax; const unsigned y = x ? x : 0xffffffffu; kmin = y < kmin ? y : kmin; } } }
#pragma unroll
            for (int o = 1; o < 64; o <<= 1) { const unsigned a = (unsigned)__shfl_xor((int)kmax, o), bq = (unsigned)__shfl_xor((int)kmin, o); kmax = a > kmax ? a : kmax; kmin = bq < kmin ? bq : kmin; }
#define DSA_K2F(k_) __uint_as_float(((k_) & 0x80000000u) ? ((k_) & 0x7fffffffu) : ~(k_))
            float lo = DSA_K2F(kmin), hi = DSA_K2F(kmax), flo = (float)(n - TOPK), fhi = (float)(1 - TOPK); int side = 0;
#pragma unroll 1
            for (int it = 0; it < 20 && !exact; ++it) {
                float x = (lo * fhi - hi * flo) / (fhi - flo);
                if (!(x > lo && x < hi)) x = 0.5f * (lo + hi);
                if (!(x > lo && x < hi)) break;
                const unsigned cand = f2key(x); int c;
                DSA_COUNT(c, cand);
                if (c == TOPK) { T = cand; exact = true; }
                else if (c > TOPK) { lo = x; flo = (float)(c - TOPK); if (side == 1) fhi *= 0.5f; side = 1; }
                else { hi = x; fhi = (float)(c - TOPK); if (side == -1) flo *= 0.5f; side = -1; }
            }
#undef DSA_K2F
        }
        if (!exact) {
            T = 0u;
#pragma unroll 1
            for (int bit = 31; bit >= 0; --bit) {
                const unsigned cand = T | (1u << bit); int c;
                DSA_COUNT(c, cand);
                if (c >= TOPK) { T = cand; if (c == TOPK) { exact = true; break; } }
            }
            if (!exact) { int c; DSA_COUNT(c, T); exact = (c == TOPK); }
        }
#undef DSA_COUNT
        int base = 0;
#pragma unroll
        for (int k = 0; k < 68; ++k) { const bool p = exact ? (v[k] >= T) : (v[k] > T); const unsigned long long m = __ballot(p);
            const int pos = base + (int)__builtin_amdgcn_mbcnt_hi((unsigned)(m >> 32), __builtin_amdgcn_mbcnt_lo((unsigned)m, 0u));
            if (p) sel[pos] = (unsigned short)(256 * (k >> 2) + 4 * lane + (k & 3));
            base += __popcll(m); }
        if (!exact) {
            int last = -1;
            while (base < TOPK) { int mi = 0x7fffffff;
#pragma unroll
                for (int k = 0; k < 68; ++k) { const int idx = 256 * (k >> 2) + 4 * lane + (k & 3); if (v[k] == T && idx > last && idx < mi) mi = idx; }
#pragma unroll
                for (int o = 1; o < 64; o <<= 1) { const int oth = __shfl_xor(mi, o); mi = oth < mi ? oth : mi; }
                if (lane == 0) sel[base] = (unsigned short)mi;
                last = mi; ++base; }
        }
        cnt = TOPK;
    }
    return cnt;
}
__device__ __forceinline__ void dsa_step3(const Ctx& C, const Bufs& B, int b, int t0, int cnt, int qslot) {
    int lane = C.lane; RELANE(); DSA_LOCALS(); const int t = t0 + w;
    {
        const int g = lane >> 4, c16 = lane & 15, rowq = rowof(b, t);
        bf16x8 qf[8];
#pragma unroll
        for (int s = 0; s < 8; ++s) qf[s] = *(const bf16x8*)(B.Q2 + (size_t)rowq * NQ2 + c16 * 256 + 32 * s + 8 * g);
        f32x4 O[16];
#pragma unroll
        for (int rt = 0; rt < 16; ++rt) O[rt] = (f32x4){0.f, 0.f, 0.f, 0.f};
        float m_ref = 0.f, lsum = 0.f;
        const int buf0 = DS_ISC + w * DS_ISC_STRIDE;
        const int npairs = (cnt + 31) >> 5;
        const int swz = (c16 & 7) << 1;
        const int trow = 4 * g + (c16 >> 2), tswz = (trow & 7) << 1, tp = c16 & 3;
        const int arow = (c16 & 7) * 1024 + (c16 >> 3) * 512, trowo = (trow & 7) * 1024 + (trow >> 3) * 512;
        const unsigned ldsb = (unsigned)(uintptr_t)(C.lds + buf0);
#define DSA_GATHER(c_) do { const unsigned bo_ = (unsigned)__builtin_amdgcn_readfirstlane(ldsb + ((c_) & 1) * 8192); \
        const pg8::u32x4 sp_ = *(const LAS pg8::u32x4*)(sel + 16 * (c_) + 8 * (lane >> 5)); const unsigned spw_[4] = {sp_.x, sp_.y, sp_.z, sp_.w}; \
        _Pragma("unroll") for (int p = 0; p < 8; ++p) { const int j = 16 * (c_) + 8 * (lane >> 5) + p; int pos = (int)((spw_[p >> 1] >> (16 * (p & 1))) & 0xffffu); pos = j < cnt ? pos : 0; \
            const int logical = (lane & 31) ^ (p << 1); \
            glds16o(B.CKVN, (unsigned)rowof(b, pos) * 512u + (unsigned)logical * 16u, bo_ + p * 1024); } } while (0)
        DSA_GATHER(0); DSA_GATHER(1);
#pragma unroll 1
        for (int kp = 0; kp < npairs; ++kp) {
            asm volatile("s_waitcnt vmcnt(0)" ::: "memory");
            bf16x8 a0[8], a1[8]; s16x4 v0[16], v1[16];
#pragma unroll
            for (int s = 0; s < 8; ++s) { const int off = arow + (((4 * s + g) ^ swz) << 4); a0[s] = *(const LAS bf16x8*)(C.lds + buf0 + off); a1[s] = *(const LAS bf16x8*)(C.lds + buf0 + 8192 + off); }
            const u16x4 p0 = *(const LAS u16x4*)(sel + 32 * kp + 4 * g), p1 = *(const LAS u16x4*)(sel + 32 * kp + 16 + 4 * g);
            __builtin_amdgcn_sched_barrier(0);
            f32x4 s0 = {0.f, 0.f, 0.f, 0.f}, s1 = {0.f, 0.f, 0.f, 0.f};
#pragma unroll
            for (int s = 0; s < 8; ++s) { s0 = __builtin_amdgcn_mfma_f32_16x16x32_bf16(a0[s], qf[s], s0, 0, 0, 0); s1 = __builtin_amdgcn_mfma_f32_16x16x32_bf16(a1[s], qf[s], s1, 0, 0, 0); }
            __builtin_amdgcn_sched_barrier(0);
#pragma unroll
            for (int rt = 0; rt < 16; ++rt) { const int off = trowo + (((2 * rt + (tp >> 1)) ^ tswz) << 4) + 8 * (tp & 1); v0[rt] = tr_read(C.lds + buf0 + off); v1[rt] = tr_read(C.lds + buf0 + 8192 + off); }
            __builtin_amdgcn_sched_barrier(0);
            LDS_WAIT(); asm volatile("" ::: "memory");
            if (kp + 1 < npairs) { DSA_GATHER(2 * kp + 2); DSA_GATHER(2 * kp + 3); }
            __builtin_amdgcn_sched_barrier(0);
            float x0[4], x1[4]; float mloc = -INFINITY;
#pragma unroll
            for (int i = 0; i < 4; ++i) { const int j0 = 32 * kp + 4 * g + i, j1 = j0 + 16; int d0 = t - (int)p0[i], d1 = t - (int)p1[i]; d0 = d0 < 0 ? 0 : (d0 > 127 ? 127 : d0); d1 = d1 < 0 ? 0 : (d1 > 127 ? 127 : d1);
                const float b0 = biasl[d0 * 16 + c16], b1 = biasl[d1 * 16 + c16];
                const float y0 = 0.125f * s0[i] + b0, y1 = 0.125f * s1[i] + b1;
                x0[i] = (j0 < cnt) ? y0 : -INFINITY; x1[i] = (j1 < cnt) ? y1 : -INFINITY;
                mloc = fmaxf(mloc, fmaxf(x0[i], x1[i])); }
            mloc = fmaxf(mloc, __shfl_xor(mloc, 16)); mloc = fmaxf(mloc, __shfl_xor(mloc, 32));
            if (kp == 0) m_ref = mloc;
            else if (__any(mloc > m_ref + 8.0f)) { const float mn = fmaxf(m_ref, mloc), al = __expf(m_ref - mn);
#pragma unroll
                for (int rt = 0; rt < 16; ++rt) O[rt] *= al;
                lsum *= al; m_ref = mn; }
            float pe0[4], pe1[4];
#pragma unroll
            for (int i = 0; i < 4; ++i) { pe0[i] = __expf(x0[i] - m_ref); pe1[i] = __expf(x1[i] - m_ref); lsum += pe0[i] + pe1[i]; }
            pg8::u32x4 pw; pw.x = cvtpk(pe0[0], pe0[1]); pw.y = cvtpk(pe0[2], pe0[3]); pw.z = cvtpk(pe1[0], pe1[1]); pw.w = cvtpk(pe1[2], pe1[3]);
            const bf16x8 pf = __builtin_bit_cast(bf16x8, pw);
#pragma unroll
            for (int rt = 0; rt < 16; ++rt) { const bf16x8 af = {v0[rt][0], v0[rt][1], v0[rt][2], v0[rt][3], v1[rt][0], v1[rt][1], v1[rt][2], v1[rt][3]};
                O[rt] = __builtin_amdgcn_mfma_f32_16x16x32_bf16(af, pf, O[rt], 0, 0, 0); }
            LDS_WAIT(); asm volatile("" ::: "memory");
        }
#undef DSA_GATHER
        lsum += __shfl_xor(lsum, 16); lsum += __shfl_xor(lsum, 32);
        const float inv = 1.0f / lsum;
#pragma unroll
        for (int rt = 0; rt < 16; ++rt) { const f32x4 o = O[rt] * inv; pg8::u32x2 wv; wv.x = cvtpk(o[0], o[1]); wv.y = cvtpk(o[2], o[3]);
            const int s_ = rt >> 1, gp = 2 * (rt & 1) + (g >> 1), jo = 4 * (g & 1);
            *(pg8::u32x2*)(B.OLAT + (size_t)C.bid * OL_BLOCK + ((((size_t)(qslot >> 4) * 16 + c16) * 8 + s_) * 64 + gp * 16 + (qslot & 15)) * 8 + jo) = wv; }
    }
}
__device__ __forceinline__ void dsa_wuv(const Ctx& C, const Bufs& B, int l, int nq) {
    const int lane = C.lane, w = C.wave, g = lane >> 4, c16 = lane & 15;
    const LAS int* qrow = (const LAS int*)(C.lds + DS_QROW);
    const int nmt = (nq + 15) >> 4;
#pragma unroll 1
    for (int hq = 0; hq < 2; ++hq) { const int h = 2 * w + hq;
        f32x4 Dv[3][4];
#pragma unroll
        for (int mt = 0; mt < 3; ++mt)
#pragma unroll
            for (int nt = 0; nt < 4; ++nt) Dv[mt][nt] = (f32x4){0.f, 0.f, 0.f, 0.f};
        const bf16* wb = B.WUV + (((size_t)l * 16 + h) * 32) * 512 + lane * 8;
        const bf16* ab = B.OLAT + (size_t)C.bid * OL_BLOCK + ((size_t)h * 8) * 512 + lane * 8;
        bf16x8 bwA[4], awA[3], bwB[4], awB[3];
#define WUV_LOAD(bw_, aw_, s_) do { _Pragma("unroll") for (int nt = 0; nt < 4; ++nt) bw_[nt] = *(const bf16x8*)(wb + ((s_) * 4 + nt) * 512); \
        _Pragma("unroll") for (int mt = 0; mt < 3; ++mt) { const v4u av_ = __builtin_nontemporal_load((const v4u*)(ab + ((size_t)mt * 16 * 8 + (s_)) * 512)); aw_[mt] = __builtin_bit_cast(bf16x8, av_); } } while (0)
#define WUV_MMA(bw_, aw_) do { _Pragma("unroll") for (int mt = 0; mt < 3; ++mt) _Pragma("unroll") for (int nt = 0; nt < 4; ++nt) Dv[mt][nt] = __builtin_amdgcn_mfma_f32_16x16x32_bf16(aw_[mt], bw_[nt], Dv[mt][nt], 0, 0, 0); } while (0)
        WUV_LOAD(bwA, awA, 0);
#pragma unroll
        for (int s = 0; s < 8; s += 2) {
            WUV_LOAD(bwB, awB, s + 1);
            __builtin_amdgcn_sched_barrier(0);
            WUV_MMA(bwA, awA);
            __builtin_amdgcn_sched_barrier(0);
            if (s + 2 < 8) WUV_LOAD(bwA, awA, s + 2);
            __builtin_amdgcn_sched_barrier(0);
            WUV_MMA(bwB, awB);
            __builtin_amdgcn_sched_barrier(0);
        }
#undef WUV_LOAD
#undef WUV_MMA
        LAS float* stg = (LAS float*)(C.lds + RING_OFF + w * 4608);
#pragma unroll
        for (int mt = 0; mt < 3; ++mt) { if (mt < nmt) {
#pragma unroll
            for (int nt = 0; nt < 4; ++nt)
#pragma unroll
                for (int i = 0; i < 4; ++i) stg[(4 * g + i) * 68 + 16 * nt + c16] = Dv[mt][nt][i];
            LDS_WAIT(); asm volatile("" ::: "memory");
            const int slot = lane >> 2, q = mt * 16 + slot, d0 = (lane & 3) * 16;
            if (q < nq) { const int row = qrow[q];
                const bf16* zp = B.PROJ + (size_t)row * NP1 + PC_ZB + h * 64 + d0; bf16* op = B.YB + (size_t)row * YLD + h * 64 + d0;
#pragma unroll
                for (int hf = 0; hf < 2; ++hf) { const v4u zw = *(const v4u*)(zp + 8 * hf);
                    const f32x4 xa = *(const LAS f32x4*)(stg + slot * 68 + d0 + 8 * hf), xb = *(const LAS f32x4*)(stg + slot * 68 + d0 + 8 * hf + 4);
                    v4u o; o.x = pk2(xa[0] * siluf_(pg8::bf_lo(zw.x)), xa[1] * siluf_(pg8::bf_hi(zw.x))); o.y = pk2(xa[2] * siluf_(pg8::bf_lo(zw.y)), xa[3] * siluf_(pg8::bf_hi(zw.y)));
                    o.z = pk2(xb[0] * siluf_(pg8::bf_lo(zw.z)), xb[1] * siluf_(pg8::bf_hi(zw.z))); o.w = pk2(xb[2] * siluf_(pg8::bf_lo(zw.w)), xb[3] * siluf_(pg8::bf_hi(zw.w)));
                    *(v4u*)(op + 8 * hf) = o; } }
            LDS_WAIT(); asm volatile("" ::: "memory"); } }
    }
}
#ifndef MK_DSUB
#define MK_DSUB 0
#endif
__device__ __forceinline__ void dsa_unit(const Ctx& C, const Bufs& B, int l, int b, int t0, int uidx) {
    { PROBE_T0(); for (int rep = 0; rep < ((MK_DSUB & 1) ? 2 : 1); ++rep) { dsa_step1(C, B, b, t0); LDS_WAIT(); PROBE_T1(10); __syncthreads(); } PROBE_T1(0); }
    int cnt = 0;
    { PROBE_T0(); for (int rep = 0; rep < ((MK_DSUB & 2) ? 2 : 1); ++rep) { cnt = dsa_step2(C, b, t0); LDS_WAIT(); asm volatile("" ::: "memory"); } PROBE_T1(1); }
    if (C.lane == 0) ((LAS int*)(C.lds + DS_QROW))[uidx * 8 + C.wave] = rowof(b, t0 + C.wave);
    { PROBE_T0(); for (int rep = 0; rep < ((MK_DSUB & 4) ? 2 : 1); ++rep) { dsa_step3(C, B, b, t0, cnt, uidx * 8 + C.wave); } PROBE_T1(2); }
    { PROBE_T0(); LDS_WAIT(); __syncthreads(); PROBE_T1(7); }
}
#undef RELANE
#undef DSA_LOCALS

__device__ __forceinline__ void dsa_phase(const Ctx& C, int l) {
    const Bufs B(C.a.ws);
    const Args& A = C.a;
    for (int i = C.tid; i < 128 * 16; i += NWAVES * 64) { const int dd = i >> 4, h = i & 15; ((LAS float*)(C.lds + DS_BIAS))[i] = A.bias_table[t5_bucket(dd) * 32 + 16 + h]; }
    __syncthreads();
    int nu = 0;
    for (int it = 0;; ++it) {
        int b, j;
        if (C.G == 256) { const int k = C.bid >> 1; b = C.bid & 1;
            if (it < 4) j = 513 - (128 * it + ((it & 1) ? 127 - k : k)); else if (it == 4 && k < 2) j = 1 - k; else break; }
        else { const int s = C.bid + it * C.G; if (s >= 1028) break; b = s & 1; j = 513 - (s >> 1); }
        dsa_unit(C, B, l, b, 8 * j, it); nu = it + 1;
    }
    VM_WAIT(); LDS_WAIT(); __syncthreads();
    { PROBE_T0(); dsa_wuv(C, B, l, nu * 8); PROBE_T1(3); }
    __syncthreads();
}

constexpr int VT_PITCH = 4128;
constexpr int SW_BIAS = RING_OFF;
constexpr int SW_WS = SW_BIAS + 8192;
constexpr int SW_STG = SW_WS + 1024;

constexpr int SW_Q = SW_STG, SW_WAVE = 16384, SW_SLOT = 4096;
__device__ __forceinline__ void swa_item(const Ctx& C, const Bufs& B, const float* __restrict__ sinks, int b, int head, int p0, bool meta) {
    const int lane = C.lane, r32 = lane & 31, hh = lane >> 5, g = head >> 3;
    const LAS float* biasl = (const LAS float*)(C.lds + SW_BIAS);
    LAS float* wsf = (LAS float*)(C.lds + SW_WS) + C.wave * 32;
    LAS unsigned char* wl = C.lds + SW_Q + C.wave * SW_WAVE;
    const unsigned wlb = (unsigned)__builtin_amdgcn_readfirstlane((unsigned)(uintptr_t)(C.lds + SW_Q) + (unsigned)C.wave * SW_WAVE);
    const int tq = p0 + r32;
    const int ntile = meta ? 1 : 6;
    PROBE_T0();
    const int prow = lane >> 3, pch = lane & 7, vrow = lane >> 2, vch = lane & 3;
#define SW_DMA_K(kt_, slot_) do { const int k0_ = ((kt_) == 0) ? 0 : p0 - 128 + 32 * ((kt_) - 1); \
        _Pragma("unroll") for (int p = 0; p < 4; ++p) { const int r_ = 8 * p + prow; int kp_ = k0_ + r_; kp_ = kp_ < 0 ? 0 : kp_; \
            glds16o(B.KV, (unsigned)rowof(b, kp_) * 512u + (unsigned)(g * 128 + ((pch ^ ((r_ >> 1) & 7)) << 4)), wlb + 4096u + (unsigned)(slot_) * SW_SLOT + p * 1024); } } while (0)
#define SW_DMA_V(kt_, slot_) do { const int k0_ = ((kt_) == 0) ? 0 : p0 - 128 + 32 * ((kt_) - 1); \
        _Pragma("unroll") for (int p = 0; p < 4; ++p) { const int r_ = 16 * p + vrow; int ks_ = k0_ + 8 * (vch ^ ((r_ >> 2) & 3)); ks_ = ks_ < 0 ? 0 : ks_; \
            glds16o(B.VT, (unsigned)((b * 128 + g * 64 + r_) * VT_PITCH + ks_) * 2u, wlb + 4096u + (unsigned)(slot_) * SW_SLOT + p * 1024); } } while (0)
    {
#pragma unroll
        for (int p = 0; p < 4; ++p) { const int r_ = 8 * p + prow; int tqq = p0 + r_; if (meta) tqq = tqq < NMETA ? tqq : NMETA - 1;
            glds16o(B.PROJ, ((unsigned)rowof(b, tqq) * (unsigned)NP1 + (unsigned)(PC_QA + head * 64)) * 2u + (unsigned)((pch ^ ((r_ >> 1) & 7)) << 4), wlb + p * 1024); }
    }
    SW_DMA_K(0, 0);
    if (!meta) { SW_DMA_K(1, 1); SW_DMA_K(2, 2); }
    const int foff = r32 * 128, fsw = (r32 >> 1) & 7;
    bf16x8 qf[4];
    if (meta) asm volatile("s_waitcnt vmcnt(0)" ::: "memory"); else asm volatile("s_waitcnt vmcnt(8)" ::: "memory");
#pragma unroll
    for (int s = 0; s < 4; ++s) qf[s] = *(const LAS bf16x8*)(wl + foff + (((2 * s + hh) ^ fsw) << 4));
    f32x16 S[6];
#pragma unroll
    for (int kt = 0; kt < 6; ++kt) {
        if (kt < ntile) {
            if (meta || kt >= 4) { if (kt == 4) asm volatile("s_waitcnt vmcnt(4)" ::: "memory"); else asm volatile("s_waitcnt vmcnt(0)" ::: "memory"); }
            else asm volatile("s_waitcnt vmcnt(8)" ::: "memory");
            bf16x8 kf[4];
#pragma unroll
            for (int s = 0; s < 4; ++s) kf[s] = *(const LAS bf16x8*)(wl + 4096 + (kt % 3) * SW_SLOT + foff + (((2 * s + hh) ^ fsw) << 4));
            __builtin_amdgcn_sched_barrier(0);
            f32x16 acc = {};
#pragma unroll
            for (int s = 0; s < 4; ++s) acc = __builtin_amdgcn_mfma_f32_32x32x16_bf16(kf[s], qf[s], acc, 0, 0, 0);
            S[kt] = acc;
            LDS_WAIT(); asm volatile("" ::: "memory");
            if (kt + 3 < ntile) SW_DMA_K(kt + 3, kt % 3);
        } else S[kt] = (f32x16){-INFINITY, -INFINITY, -INFINITY, -INFINITY, -INFINITY, -INFINITY, -INFINITY, -INFINITY, -INFINITY, -INFINITY, -INFINITY, -INFINITY, -INFINITY, -INFINITY, -INFINITY, -INFINITY};
    }
    PROBE_T1(50);
    SW_DMA_V(0, 0);
    if (!meta) { SW_DMA_V(1, 1); SW_DMA_V(2, 2); }
#pragma unroll
    for (int kt = 0; kt < 6; ++kt) {
        if (kt < ntile) {
            const int k0 = (kt == 0) ? 0 : p0 - 128 + 32 * (kt - 1);
            float bz[16];
#pragma unroll
            for (int i = 0; i < 16; ++i) { const int kp = k0 + (i & 3) + 8 * (i >> 2) + 4 * hh; int d = tq - kp; d = d < 0 ? 0 : (d > 127 ? 127 : d); bz[i] = biasl[head * 128 + d]; }
#pragma unroll
            for (int i = 0; i < 16; ++i) { const int kp = k0 + (i & 3) + 8 * (i >> 2) + 4 * hh; const int d = tq - kp;
                const bool ok = (kt == 0) ? (kp < NMETA && d >= 0) : (kp >= NMETA && d >= 0 && d < 128);
                const float x = 0.125f * S[kt][i] + bz[i];
                S[kt][i] = ok ? x : -INFINITY; }
        }
    }
    const float sink = sinks[head];
    float mx = sink;
#pragma unroll
    for (int kt = 0; kt < 6; ++kt)
#pragma unroll
        for (int i = 0; i < 16; ++i) mx = fmaxf(mx, S[kt][i]);
    mx = fmaxf(mx, __shfl_xor(mx, 32));
    float sum = 0.f;
#pragma unroll
    for (int kt = 0; kt < 6; ++kt)
#pragma unroll
        for (int i = 0; i < 16; ++i) { const float p = __expf(S[kt][i] - mx); S[kt][i] = p; sum += p; }
    sum += __shfl_xor(sum, 32);
    sum += __expf(sink - mx);
    if (hh == 0) wsf[r32] = sum;
    PROBE_T1(51);
    f32x16 O0 = {}, O1 = {};
#pragma unroll
    for (int kt = 0; kt < 6; ++kt) {
        if (kt < ntile) {
            if (meta || kt >= 4) { if (kt == 4) asm volatile("s_waitcnt vmcnt(4)" ::: "memory"); else asm volatile("s_waitcnt vmcnt(0)" ::: "memory"); }
            else asm volatile("s_waitcnt vmcnt(8)" ::: "memory");
            pg8::u32x2 vl[2][2], vh[2][2];
#pragma unroll
            for (int s2 = 0; s2 < 2; ++s2)
#pragma unroll
                for (int dt = 0; dt < 2; ++dt) { const int r_ = 32 * dt + r32; const LAS unsigned char* vp = wl + 4096 + (kt % 3) * SW_SLOT + r_ * 64 + 8 * hh; const int sw_ = (r_ >> 2) & 3;
                    vl[s2][dt] = *(const LAS pg8::u32x2*)(vp + (((2 * s2) ^ sw_) << 4)); vh[s2][dt] = *(const LAS pg8::u32x2*)(vp + (((2 * s2 + 1) ^ sw_) << 4)); }
            __builtin_amdgcn_sched_barrier(0);
#pragma unroll
            for (int s2 = 0; s2 < 2; ++s2) {
                pg8::u32x4 pw; pw.x = cvtpk(S[kt][8 * s2 + 0], S[kt][8 * s2 + 1]); pw.y = cvtpk(S[kt][8 * s2 + 2], S[kt][8 * s2 + 3]); pw.z = cvtpk(S[kt][8 * s2 + 4], S[kt][8 * s2 + 5]); pw.w = cvtpk(S[kt][8 * s2 + 6], S[kt][8 * s2 + 7]);
                const bf16x8 pf = __builtin_bit_cast(bf16x8, pw);
#pragma unroll
                for (int dt = 0; dt < 2; ++dt) { const pg8::u32x4 vw = {vl[s2][dt].x, vl[s2][dt].y, vh[s2][dt].x, vh[s2][dt].y}; const bf16x8 vf = __builtin_bit_cast(bf16x8, vw);
                    if (dt == 0) O0 = __builtin_amdgcn_mfma_f32_32x32x16_bf16(pf, vf, O0, 0, 0, 0); else O1 = __builtin_amdgcn_mfma_f32_32x32x16_bf16(pf, vf, O1, 0, 0, 0); }
            }
            LDS_WAIT(); asm volatile("" ::: "memory");
            if (kt + 3 < ntile) SW_DMA_V(kt + 3, kt % 3);
            __builtin_amdgcn_sched_barrier(0);
        }
    }
#undef SW_DMA_K
#undef SW_DMA_V
    PROBE_T1(52);
    LDS_WAIT(); asm volatile("" ::: "memory");
    LAS float* stg = (LAS float*)(wl + 4096);
#pragma unroll
    for (int i = 0; i < 16; ++i) { const int q = (i & 3) + 8 * (i >> 2) + 4 * hh; stg[q * 68 + r32] = O0[i]; stg[q * 68 + 32 + r32] = O1[i]; }
    LDS_WAIT(); asm volatile("" ::: "memory");
    { const int q = lane >> 1, d0 = (lane & 1) * 32, t = p0 + q;
      if (!meta || t < NMETA) { const int row = rowof(b, t); const float inv = 1.0f / wsf[q];
          const bf16* zp = B.PROJ + (size_t)row * NP1 + PC_ZA + head * 64 + d0; bf16* op = B.YA + (size_t)row * YLD + head * 64 + d0;
#pragma unroll
          for (int hf = 0; hf < 4; ++hf) { const v4u zw = *(const v4u*)(zp + 8 * hf);
              const f32x4 xa = *(const LAS f32x4*)(stg + q * 68 + d0 + 8 * hf) * inv, xb = *(const LAS f32x4*)(stg + q * 68 + d0 + 8 * hf + 4) * inv;
              v4u o; o.x = pk2(xa[0] * siluf_(pg8::bf_lo(zw.x)), xa[1] * siluf_(pg8::bf_hi(zw.x))); o.y = pk2(xa[2] * siluf_(pg8::bf_lo(zw.y)), xa[3] * siluf_(pg8::bf_hi(zw.y)));
              o.z = pk2(xb[0] * siluf_(pg8::bf_lo(zw.z)), xb[1] * siluf_(pg8::bf_hi(zw.z))); o.w = pk2(xb[2] * siluf_(pg8::bf_lo(zw.w)), xb[3] * siluf_(pg8::bf_hi(zw.w)));
              *(v4u*)(op + 8 * hf) = o; } } }
    LDS_WAIT(); asm volatile("" ::: "memory");
}

__device__ __forceinline__ void swa_phase(const Ctx& C, int l) {
    const Bufs B(C.a.ws);
    const Args& A = C.a;
    __syncthreads();
    for (int i = C.tid; i < 128 * 16; i += NWAVES * 64) { const int h = i >> 7, d = i & 127; ((LAS float*)(C.lds + SW_BIAS))[i] = A.bias_table[t5_bucket(d) * 32 + h]; }
    __syncthreads();
    const float* sinks = A.sinks + l * 16;
    for (int it = C.gw; it < 4096 + 32; it += C.NGW) {
        if (it < 4096) { const int blk = it & 127, head = (it >> 7) & 15, b = it >> 11; swa_item(C, B, sinks, b, head, NMETA + 32 * blk, false); }
        else { const int r = it - 4096, head = r & 15, b = r >> 4; swa_item(C, B, sinks, b, head, 0, true); }
    }
    __syncthreads();
}


constexpr int PH_PER_LAYER = 5, N_PHASES = 1 + NLAYER * PH_PER_LAYER + 1;
#ifndef MK_DUP
#define MK_DUP 0
#endif
#ifndef MK_NAIVE_SWA
#define MK_NAIVE_SWA 0
#endif
#ifndef MK_NAIVE_DSA
#define MK_NAIVE_DSA 0
#endif
#ifndef MK_ONE_LAUNCH
#define MK_ONE_LAUNCH 1
#endif

__global__ void __launch_bounds__(NWAVES * 64, 2) fwd_kernel(Args args) {
    extern __shared__ __attribute__((aligned(16))) unsigned char lds[];
    Ctx C;
    C.lds = (LAS unsigned char*)lds; C.tid = threadIdx.x; C.lane = C.tid & 63; C.wave = __builtin_amdgcn_readfirstlane(C.tid >> 6);
    C.G = gridDim.x; C.bid = blockIdx.x; C.gw = blockIdx.x * NWAVES + C.wave; C.NGW = C.G * NWAVES; C.a = args;
    unsigned char* ws = args.ws;
    gu32* ctl = (gu32*)(ws + WS_CTL);
    for (int u = C.tid; u < RING_OFF / 4; u += NWAVES * 64) ((LAS unsigned*)(C.lds + LDSCTL_OFF))[u] = 0u;
    __syncthreads();
    volatile LAS unsigned* MISC = (volatile LAS unsigned*)(C.lds + MISC_OFF);
    XcdBarrier bar; bar.bar = (unsigned*)(ctl + CW_BAR); bar.x = 0; bar.st = nullptr;
    const int lo = args.ph_lo, hi = args.ph_hi;
    const bool one = (hi - lo) > 1;
    if (one) bar = xcd_barrier_post((unsigned*)(ctl + CW_BAR), MISC + 8);
#define IN(k) (lo <= (k) && (k) < hi)
#define PHASE_BEGIN() do { int l_ = (int)__builtin_amdgcn_mbcnt_hi(~0u, __builtin_amdgcn_mbcnt_lo(~0u, 0u)); asm volatile("" : "+v"(l_)); int b_ = blockIdx.x; asm volatile("" : "+s"(b_)); \
    C.lane = l_; C.tid = C.wave * 64 + l_; C.bid = b_; C.gw = b_ * NWAVES + C.wave; } while (0)
#define SEAM(k) do { if (IN((k) + 1)) { PROBE_T0(); xcd_barrier(bar, C.wave == 0 && (int)__builtin_amdgcn_mbcnt_hi(~0u, __builtin_amdgcn_mbcnt_lo(~0u, 0u)) == 0); PROBE_T1(29); if (MK_DUP & 256) xcd_barrier(bar, C.wave == 0 && (int)__builtin_amdgcn_mbcnt_hi(~0u, __builtin_amdgcn_mbcnt_lo(~0u, 0u)) == 0); } } while (0)
    LAS unsigned char* ring = C.lds + RING_OFF;

    if (IN(0)) { PROBE_T0(); PHASE_BEGIN(); p0_prologue(C); PROBE_T1(20); if (MK_DUP & 128) { PHASE_BEGIN(); p0_prologue(C); } SEAM(0); }
    for (int l = 0; l < NLAYER; ++l) {
        const int p = 1 + l * PH_PER_LAYER;
        if (IN(p)) {
            PHASE_BEGIN(); const Bufs B(ws);
            const bf16* W1l = B.W1 + (size_t)l * NP1 * DM;
            pg8::Gemm g{B.HB, W1l, MR, 8192, DM}; pg8::StaticOrder S; S.init(MR, 8192, C.G, C.bid);
            rstd_table<8>(C, S, B.RS, 1.0f / DM);
            pg8::EpiProjT<true> E{B.PROJ, NP1, (const LAS float*)(C.lds + RSTD_OFF), B.KV, B.RSQ, B.RHO, B.SGB};
            { PROBE_T0(); pg8::gemm_phase<pg8::EpiProjT<true>, pg8::StaticOrder, true, true>(ring, g, S, E, C.tid); PROBE_T1(21); }
            PHASE_BEGIN();
            LAS float* tbl = (LAS float*)(C.lds + RSTD_OFF);
            PROBE_T0();
            for (int u = C.bid; u < 256 + 259; u += C.G) {
                if (u < 256) { const int row0 = 32 * u; skinny_rstd(C, B.RS + (size_t)row0 * 32, 32, 1.0f / DM, tbl);
                    skinny_unit<3, 1>(C, B.HB + (size_t)row0 * DM, DM, W1l + (size_t)8192 * DM, DM, DM, nullptr, 0, 0, SkProj{B.PROJ + (size_t)row0 * NP1, B.KV + (size_t)row0 * 256, B.KIDX + (size_t)row0 * 64, 8192, tbl}); }
                else { const int gc = u - 256; skinny_rstd(C, B.RS2, 64, 1.0f / DM, tbl);
                    const SkProj E2{B.PROJ + (size_t)MR * NP1, B.KV + (size_t)MR * 256, B.KIDX + (size_t)MR * 64, gc * 32, tbl};
                    const bool sqc = gc >= 72 && gc < 88;
                    skinny_unit<1, 4>(C, B.HB + (size_t)MR * DM, DM, W1l + (size_t)gc * 32 * DM, DM, DM, sqc ? B.RSQ2 : nullptr, 16, gc - 72, E2); }
            }
            PROBE_T1(22);
            SEAM(p);
        }
        if (IN(p + 1)) {
            PHASE_BEGIN(); const Bufs B(ws);
            const bf16* W2l = B.W2 + (size_t)l * NQ2 * 512;
            pg8::Gemm g{B.PROJ + PC_CQ, W2l, MR, NQ2, 512, nullptr, nullptr, NP1}; pg8::StaticOrder S; S.init(MR, NQ2, C.G, C.bid);
            rstd_table<2>(C, S, B.RSQ, 1.0f / 512.0f);
            pg8::EpiProjT<false> E{B.Q2, NQ2, (const LAS float*)(C.lds + RSTD_OFF), nullptr, nullptr, nullptr, nullptr};
            PROBE_T0();
            pg8::gemm_phase<pg8::EpiProjT<false>, pg8::StaticOrder, true, true>(ring, g, S, E, C.tid);
            PHASE_BEGIN();
            { LAS float* tbl = (LAS float*)(C.lds + RSTD_OFF);
              const int sb = (C.G == 256) ? C.bid - 64 : C.bid;
              for (int u = sb; u >= 0 && u < 48; u += C.G) { skinny_rstd(C, B.RSQ2, 16, 1.0f / 512.0f, tbl);
                skinny_unit<3, 1>(C, B.PROJ + (size_t)MR * NP1 + PC_CQ, NP1, W2l + (size_t)u * 96 * 512, 512, 512, nullptr, 0, 0, SkQ2{B.Q2 + (size_t)MR * NQ2 + u * 96, tbl}); } }
            PHASE_BEGIN(); norm_tail(C, l);
            PROBE_T1(24);
            SEAM(p + 1);
        }
        if (IN(p + 2)) {
            { PROBE_T0(); PHASE_BEGIN(); swa_phase(C, l); PROBE_T1(5); }
            if (MK_DUP & 8) { PHASE_BEGIN(); swa_phase(C, l); }
            { PROBE_T0(); PHASE_BEGIN(); dsa_phase(C, l); PROBE_T1(4); }
            if (MK_DUP & 16) { PHASE_BEGIN(); dsa_phase(C, l); }
            SEAM(p + 2);
        }
        if (IN(p + 3)) {
            PHASE_BEGIN(); const Bufs B(ws);
            const bf16* WABl = B.WA + (size_t)l * DM * 2048;
            pg8::Gemm g{B.YA, WABl, MR, DM, 2048, nullptr, nullptr, 0}; pg8::StaticOrder S; S.init(MR, DM, C.G, C.bid);
            pg8::EpiG4m E{B.MG, B.RHO, B.SGB};
            PROBE_T0();
            pg8::gemm_phase<pg8::EpiG4m, pg8::StaticOrder, true, true>(ring, g, S, E, C.tid);
            PROBE_T1(35);
            PHASE_BEGIN();
            for (int u = C.bid; u < 64; u += C.G) {
                skinny_unit<1, 2>(C, B.YA + (size_t)MR * YLD, YLD, WABl + (size_t)u * 32 * 2048, 2048, 1024, nullptr, 0, 0, SkPA{B.PA + (size_t)MR * DM + u * 32, B.PROJ + (size_t)MR * NP1 + 4096, u * 32});
                skinny_unit<1, 2>(C, B.YB + (size_t)MR * YLD, YLD, WABl + 1024 + (size_t)u * 32 * 2048, 2048, 1024, nullptr, 0, 0, SkMerge{B.MG + (size_t)MR * DM + u * 32, B.PA + (size_t)MR * DM + u * 32, B.PROJ + (size_t)MR * NP1 + 4096, u * 32}); }
            PROBE_T1(25);
            SEAM(p + 3);
        }
        if (IN(p + 4)) {
            PHASE_BEGIN(); const Bufs B(ws);
            const bf16* WOl = B.WO + (size_t)l * DM * DM;
            pg8::Gemm g{B.MG, WOl, MR, DM, DM}; pg8::StaticOrder S; S.init(MR, DM, C.G, C.bid);
            pg8::EpiRes E{B.HB, B.RS};
            PROBE_T0();
            pg8::gemm_phase<pg8::EpiRes, pg8::StaticOrder, true, true>(ring, g, S, E, C.tid);
            PROBE_T1(37);
            PHASE_BEGIN();
            for (int u = C.bid; u < 64; u += C.G) skinny_unit<1, 4>(C, B.MG + (size_t)MR * DM, DM, WOl + (size_t)u * 32 * DM, DM, DM, B.RS2, 64, u, SkRes{B.HB + (size_t)MR * DM + u * 32});
            PROBE_T1(27);
            SEAM(p + 4);
        }
    }
    if (IN(N_PHASES - 1)) { PHASE_BEGIN(); final_phase(C); }
#undef IN
#undef SEAM
}

extern "C" void kernel_launch(void* const* d_in, const int* in_sizes, int n_in, void* d_out, int out_size, void* d_ws, size_t ws_size, hipStream_t stream) {
    static int grid = 0;
    if (grid == 0) {
        if (n_in != 16 || ws_size < WS_END) { fprintf(stderr, "kernel_launch: unexpected inputs (n_in %d, ws %zu, need %zu)\n", n_in, ws_size, (size_t)WS_END); grid = -1; return; }
        int dev = 0, cus = 0;
        if (hipGetDevice(&dev) != hipSuccess || hipDeviceGetAttribute(&cus, hipDeviceAttributeMultiprocessorCount, dev) != hipSuccess) { grid = -1; return; }
        if (hipFuncSetAttribute((const void*)fwd_kernel, hipFuncAttributeMaxDynamicSharedMemorySize, LDS_BYTES) != hipSuccess) { fprintf(stderr, "kernel_launch: hipFuncSetAttribute failed\n"); grid = -1; return; }
        int per_cu = 0;
        if (hipOccupancyMaxActiveBlocksPerMultiprocessor(&per_cu, (const void*)fwd_kernel, NWAVES * 64, LDS_BYTES) != hipSuccess || per_cu < 1) fprintf(stderr, "kernel_launch: occupancy query says %d\n", per_cu);
        (void)hipGetLastError();
        grid = cus;
    }
    if (grid < 0) return;
    if (hipMemsetAsync((char*)d_ws + WS_CTL, 0, CTL_ZERO_BYTES, stream) != hipSuccess) return;
    Args a{};
    a.x = (const float*)d_in[0]; a.meta = (const float*)d_in[1]; a.bias_table = (const float*)d_in[2]; a.norm_g = (const float*)d_in[3]; a.w_in = (const float*)d_in[4];
    a.q_norm_g = (const float*)d_in[5]; a.kv_norm_g = (const float*)d_in[6]; a.w_qb = (const float*)d_in[7]; a.w_iq = (const float*)d_in[8]; a.w_uk = (const float*)d_in[9];
    a.w_uv = (const float*)d_in[10]; a.sinks = (const float*)d_in[11]; a.w_proj_a = (const float*)d_in[12]; a.w_proj_b = (const float*)d_in[13]; a.w_out = (const float*)d_in[14];
    a.final_g = (const float*)d_in[15]; a.out = (float*)d_out; a.ws = (unsigned char*)d_ws;
#if MK_ONE_LAUNCH
    a.ph_lo = 0; a.ph_hi = N_PHASES;
    hipLaunchKernelGGL(fwd_kernel, dim3(grid), dim3(NWAVES * 64), LDS_BYTES, stream, a);
#else
    for (int p = 0; p < N_PHASES; ++p) { a.ph_lo = p; a.ph_hi = p + 1; hipLaunchKernelGGL(fwd_kernel, dim3(grid), dim3(NWAVES * 64), LDS_BYTES, stream, a); }
#endif
}
```

```cpp
#include <hip/hip_runtime.h>
#include <cstdio>
#include <cstdint>
namespace pg8 {
#define PG8_LAS __attribute__((address_space(3)))
typedef unsigned short bf16_t;
typedef short bf16x8 __attribute__((ext_vector_type(8)));
typedef float f32x4 __attribute__((ext_vector_type(4)));
typedef unsigned u32x4 __attribute__((ext_vector_type(4)));
constexpr int BM = 256, BK = 64, HALF = 128, HTB = HALF * BK * 2  , STAGE_BYTES = 8 * HTB, NXCD = 8, WGM = 8;

__host__ __device__ __forceinline__ int lds_byte(int r, int c) { const int st = (r >> 4) * 2 + (c >> 5), rr = r & 15, cc = c & 31, ob = rr * 64 + cc * 2; return st * 1024 + (ob ^ (((ob >> 9) & 1) << 5)); }
__host__ __device__ __forceinline__ void stage_rc(int b, int& R, int& C) { const int st = b / 1024, sb = b % 1024, swz = sb ^ (((sb >> 9) & 1) << 5); R = (st >> 1) * 16 + swz / 64; C = (st & 1) * 32 + (swz % 64) / 2; }
__host__ __device__ __forceinline__ int perm32(int rho) { const int n = rho >> 4, i = rho & 15; return 8 * (i >> 2) + 4 * n + (i & 3); }

struct Unit { int pm, pn, sel; };
struct Gemm { const bf16_t* A; const bf16_t* Bt; int M, N, K; const bf16_t* A2; const bf16_t* Bt2; int lda; };

struct StaticOrder {
    int nM, nN, nwg, G, c;
    __host__ __device__ void init(int M, int N, int G_, int c_) { nM = M / BM; nN = N / BM; nwg = nM * nN; G = G_; c = c_; }
    __host__ __device__ bool next(int i, Unit& u) const {
        const long L = (long)i * G + c; if (L >= nwg) return false;
        int wgid = (int)L; { const int q = nwg / NXCD, r = nwg % NXCD, xcd = wgid % NXCD, off = wgid / NXCD; wgid = (xcd < r ? xcd * (q + 1) : r * (q + 1) + (xcd - r) * q) + off; }
        const int nig = WGM * nN, gid = wgid / nig, fm = gid * WGM, gsz = (nM - fm) < WGM ? (nM - fm) : WGM;
        u.pm = fm + ((wgid % nig) % gsz); u.pn = (wgid % nig) / gsz; u.sel = 0; return true;
    }
    __device__ __forceinline__ void a_ready(const Unit&) const {}
    __device__ __forceinline__ void done(const Unit&) const {}
};

__device__ __forceinline__ unsigned cvt_pk_bf16(float lo, float hi) { unsigned r; asm volatile("v_cvt_pk_bf16_f32 %0, %1, %2" : "=v"(r) : "v"(lo), "v"(hi)); return r; }
typedef float f32x2 __attribute__((ext_vector_type(2)));
__device__ __forceinline__ f32x2 gelu_pk(f32x2 v) {
    const f32x2 av = __builtin_elementwise_abs(v), d = av * 0.2316418882f + 1.0f;
    f32x2 t; t.x = __builtin_amdgcn_rcpf(d.x); t.y = __builtin_amdgcn_rcpf(d.y);
    f32x2 q = t * 0.5307027145f + (-0.7265760135f); q = q * t + 0.7107068705f; q = q * t + (-0.142248368f); q = q * t + 0.127414796f; q = q * t;
    const f32x2 s = (v * v) * (-0.72134752044f);
    f32x2 e; e.x = __builtin_amdgcn_exp2f(s.x); e.y = __builtin_amdgcn_exp2f(s.y);
    const f32x2 m = v * (q * e), r = v - m;
    f32x2 o; o.x = v.x < 0.f ? m.x : r.x; o.y = v.y < 0.f ? m.y : r.y; return o;
}

template <int ACT  > struct EpiBf16 {
    static constexpr bool PERM = true, AFTER_DRAIN = false; static_assert(ACT == 0 || ACT == 1, "EpiBf16: ACT is 0 (none) or 1 (gelu_pk)");
    bf16_t* O; int ldc; const float* bias; int split_cols; size_t split_stride; float scale0;
    __device__ __forceinline__ void operator()(const f32x4 (&acc)[2][2][4][2], const Unit& u, int ui, int wr, int wc, int fr, int fq) const {
        const int row0 = u.pm * BM + wr * 64 + fr; int colt = u.pn * BM; bf16_t* base = O;
        float sc = 1.f; if (split_cols) { const int t = colt / split_cols; base += (size_t)t * split_stride; colt -= t * split_cols; if (t == 0) sc = scale0; }
        const int col0 = colt + wc * 32 + 8 * fq, bcol0 = u.pn * BM + wc * 32 + 8 * fq;
        f32x4 bv[2][2];
#pragma unroll
        for (int bj = 0; bj < 2; ++bj)
#pragma unroll
            for (int n = 0; n < 2; ++n) bv[bj][n] = bias ? *(const f32x4*)(bias + bcol0 + bj * HALF + 4 * n) : (f32x4){0.f, 0.f, 0.f, 0.f};
#pragma unroll
        for (int ai = 0; ai < 2; ++ai)
#pragma unroll
            for (int m = 0; m < 4; ++m) { bf16_t* rowp = base + (size_t)(row0 + ai * HALF + m * 16) * ldc + col0;
#pragma unroll
                for (int bj = 0; bj < 2; ++bj) { f32x4 v0 = acc[ai][bj][m][0] + bv[bj][0], v1 = acc[ai][bj][m][1] + bv[bj][1];
                    if (ACT == 1) { f32x2 a = gelu_pk((f32x2){v0[0], v0[1]}), b = gelu_pk((f32x2){v0[2], v0[3]}), c = gelu_pk((f32x2){v1[0], v1[1]}), d = gelu_pk((f32x2){v1[2], v1[3]});
                        v0 = (f32x4){a.x, a.y, b.x, b.y}; v1 = (f32x4){c.x, c.y, d.x, d.y}; }
                    v0 = v0 * sc; v1 = v1 * sc; u32x4 w; w.x = cvt_pk_bf16(v0[0], v0[1]); w.y = cvt_pk_bf16(v0[2], v0[3]); w.z = cvt_pk_bf16(v1[0], v1[1]); w.w = cvt_pk_bf16(v1[2], v1[3]);
                    *(u32x4*)(rowp + bj * HALF) = w; } }
    }
};

template <class T, class = void> struct pg8_has_midk { static constexpr bool value = false; };
template <class T> struct pg8_has_midk<T, decltype((void)T::MIDK)> { static constexpr bool value = T::MIDK; };
template <class Epi, class Sched, bool ALIGN_EPI = false, bool SP2 = false>
__device__ __forceinline__ void gemm_phase(PG8_LAS unsigned char* lds, const Gemm g, const Sched& S, const Epi& E, int tid_in) {
    int tid_ = tid_in; asm volatile("" : "+v"(tid_));
    const int tid = tid_, wid = __builtin_amdgcn_readfirstlane(tid >> 6), lane = tid & 63, wr = wid >> 2, wc = wid & 3, fr = lane & 15, fq = lane >> 4;
    const int K = g.K, nt = K / BK, lda = g.lda ? g.lda : K;
    unsigned voffA[2], voffB[2];
#pragma unroll
    for (int i = 0; i < 2; ++i) { int R, C; stage_rc(tid * 16 + i * 8192, R, C); const int Rb = Epi::PERM ? ((R & ~31) + perm32(R & 31)) : R;
        voffA[i] = (unsigned)(R * lda + C) * 2u; voffB[i] = (unsigned)(Rb * K + C) * 2u; }
    const size_t kstep = (size_t)(BK * 2);
    const size_t hstepA = (size_t)HALF * lda * 2, tstepA = 2 * hstepA;
    const size_t hstep = (size_t)HALF * K * 2;
    const size_t tstep = 2 * hstep;
    const unsigned ldsw = (unsigned)wid * 1024u;
    const int aoff = lds_byte(wr * 64 + fr, fq * 8), boff = lds_byte(wc * 32 + fr, fq * 8);
#define PG8_SA(b, h) (((b) * 2 + (h)) * HTB)
#define PG8_SB(b, h) ((4 + (b) * 2 + (h)) * HTB)
#define PG8_STAGE(bufoff, gbase, voff) do { _Pragma("unroll") for (int _i = 0; _i < 2; ++_i) \
        __builtin_amdgcn_global_load_lds((const unsigned*)((const char*)(gbase) + (voff)[_i]), (PG8_LAS unsigned*)(lds + (bufoff) + ldsw + _i * 8192), 16, 0, 0); } while (0)
#define PG8_LDA(dst, b, h) do { _Pragma("unroll") for (int m = 0; m < 4; ++m) _Pragma("unroll") for (int k = 0; k < 2; ++k) dst[m][k] = *(const PG8_LAS bf16x8*)(lds + PG8_SA(b, h) + aoff + m * 2048 + k * 1024); } while (0)
#define PG8_LDB(dst, b, h) do { _Pragma("unroll") for (int n = 0; n < 2; ++n) _Pragma("unroll") for (int k = 0; k < 2; ++k) dst[n][k] = *(const PG8_LAS bf16x8*)(lds + PG8_SB(b, h) + boff + n * 2048 + k * 1024); } while (0)
#define PG8_MMA(ai, bj, At, Bt) do { __builtin_amdgcn_s_setprio(1); _Pragma("unroll") for (int m = 0; m < 4; ++m) _Pragma("unroll") for (int n = 0; n < 2; ++n) _Pragma("unroll") for (int k = 0; k < 2; ++k) \
        acc[ai][bj][m][n] = __builtin_amdgcn_mfma_f32_16x16x32_bf16(Bt[n][k], At[m][k], acc[ai][bj][m][n], 0, 0, 0); __builtin_amdgcn_s_setprio(0); } while (0)
#define PG8_WAIT_V(n) asm volatile("s_waitcnt vmcnt(" #n ")" ::: "memory")
#define PG8_WAIT_L(n) asm volatile("s_waitcnt lgkmcnt(" #n ")" ::: "memory")
#define PG8_BAR __builtin_amdgcn_s_barrier()
#define PG8_SCHED __builtin_amdgcn_sched_barrier(0)
    Unit cur, nxt; int ui = 0;
    if (!S.next(0, cur)) return;
    f32x4 acc[2][2][4][2];
#pragma unroll
    for (int a = 0; a < 2; ++a)
#pragma unroll
        for (int b = 0; b < 2; ++b)
#pragma unroll
            for (int m = 0; m < 4; ++m)
#pragma unroll
                for (int n = 0; n < 2; ++n) acc[a][b][m][n] = (f32x4){0.f, 0.f, 0.f, 0.f};
    bf16x8 At[4][2], B0[2][2], B1[2][2];
    const char* cA = (const char*)(cur.sel ? g.A2 : g.A) + (size_t)cur.pm * tstepA; const char* cB = (const char*)(cur.sel ? g.Bt2 : g.Bt) + (size_t)cur.pn * tstep;
    S.a_ready(cur);
    if constexpr (SP2) {
        PG8_STAGE(PG8_SB(0, 0), cB, voffB); PG8_STAGE(PG8_SB(0, 1), cB + hstep, voffB); PG8_STAGE(PG8_SA(0, 0), cA, voffA); PG8_STAGE(PG8_SA(0, 1), cA + hstepA, voffA);
        if (wr == 1) PG8_BAR;
        PG8_WAIT_V(2); PG8_BAR;
        PG8_STAGE(PG8_SB(1, 0), cB + kstep, voffB); PG8_STAGE(PG8_SA(1, 0), cA + kstep, voffA); PG8_STAGE(PG8_SB(1, 1), cB + hstep + kstep, voffB);
        PG8_WAIT_V(6); PG8_BAR;
    } else {
        PG8_STAGE(PG8_SB(0, 0), cB, voffB); PG8_STAGE(PG8_SA(0, 0), cA, voffA); PG8_STAGE(PG8_SB(0, 1), cB + hstep, voffB); PG8_STAGE(PG8_SA(0, 1), cA + hstepA, voffA);
        if (wr == 1) PG8_BAR;
        PG8_WAIT_V(4); PG8_BAR;
        PG8_STAGE(PG8_SB(1, 0), cB + kstep, voffB); PG8_STAGE(PG8_SA(1, 0), cA + kstep, voffA); PG8_STAGE(PG8_SB(1, 1), cB + hstep + kstep, voffB);
        PG8_WAIT_V(6); PG8_BAR;
    }
    for (;;) {
        const bool has_next = S.next(ui + 1, nxt);
        const char* nA = has_next ? (const char*)(nxt.sel ? g.A2 : g.A) + (size_t)nxt.pm * tstepA : cA; const char* nB = has_next ? (const char*)(nxt.sel ? g.Bt2 : g.Bt) + (size_t)nxt.pn * tstep : cB;
        for (int t = 0; t < nt; t += 2) {
            if constexpr (pg8_has_midk<Epi>::value) { if (t == (nt >> 1)) E.midk(acc, cur, wr, wc, fr, fq); }
            const bool last = (t == nt - 2);
            const char* a1 = cA + (size_t)(t + 1) * kstep;
            const char* a2 = last ? nA : cA + (size_t)(t + 2) * kstep; const char* b2 = last ? nB : cB + (size_t)(t + 2) * kstep;
            const char* a3 = a2 + kstep; const char* b3 = b2 + kstep;
            if (last && has_next) S.a_ready(nxt);
            if constexpr (SP2) {
            PG8_LDB(B0, 0, 0); PG8_LDB(B1, 0, 1); PG8_SCHED; PG8_LDA(At, 0, 0); PG8_STAGE(PG8_SA(1, 1), a1 + hstepA, voffA);
            PG8_WAIT_V(8); PG8_WAIT_L(0); PG8_BAR; PG8_MMA(0, 0, At, B0); PG8_MMA(0, 1, At, B1); PG8_BAR; PG8_SCHED;
            PG8_LDA(At, 0, 1); PG8_STAGE(PG8_SB(0, 0), b2, voffB); PG8_STAGE(PG8_SB(0, 1), b2 + hstep, voffB); PG8_STAGE(PG8_SA(0, 0), a2, voffA);
            PG8_WAIT_V(8); PG8_WAIT_L(0); PG8_BAR; PG8_MMA(1, 0, At, B0); PG8_MMA(1, 1, At, B1); PG8_BAR; PG8_SCHED;
            PG8_LDB(B0, 1, 0); PG8_LDB(B1, 1, 1); PG8_SCHED; PG8_LDA(At, 1, 0); PG8_STAGE(PG8_SA(0, 1), a2 + hstepA, voffA);
            PG8_WAIT_V(8); PG8_WAIT_L(0); PG8_BAR; PG8_MMA(0, 0, At, B0); PG8_MMA(0, 1, At, B1); PG8_BAR; PG8_SCHED;
            PG8_LDA(At, 1, 1); PG8_STAGE(PG8_SB(1, 0), b3, voffB); PG8_STAGE(PG8_SB(1, 1), b3 + hstep, voffB); PG8_STAGE(PG8_SA(1, 0), a3, voffA);
            PG8_WAIT_V(8); PG8_WAIT_L(0); PG8_BAR; PG8_MMA(1, 0, At, B0); PG8_MMA(1, 1, At, B1); PG8_BAR; PG8_SCHED;
            } else {
            PG8_LDB(B0, 0, 0); PG8_SCHED; PG8_LDA(At, 0, 0); PG8_STAGE(PG8_SA(1, 1), a1 + hstepA, voffA);
            PG8_WAIT_L(8); PG8_BAR; PG8_WAIT_L(0); PG8_MMA(0, 0, At, B0); PG8_BAR; PG8_SCHED;
            PG8_LDB(B1, 0, 1); PG8_STAGE(PG8_SB(0, 0), b2, voffB);
            PG8_BAR; PG8_WAIT_L(0); PG8_MMA(0, 1, At, B1); PG8_BAR;
            PG8_LDA(At, 0, 1); PG8_STAGE(PG8_SA(0, 0), a2, voffA);
            PG8_BAR; PG8_WAIT_L(0); PG8_MMA(1, 0, At, B0); PG8_BAR; PG8_SCHED;
            PG8_STAGE(PG8_SB(0, 1), b2 + hstep, voffB);
            PG8_WAIT_V(6); PG8_BAR; PG8_MMA(1, 1, At, B1); PG8_BAR;
            PG8_LDB(B0, 1, 0); PG8_SCHED; PG8_LDA(At, 1, 0); PG8_STAGE(PG8_SA(0, 1), a2 + hstepA, voffA);
            PG8_WAIT_L(8); PG8_BAR; PG8_WAIT_L(0); PG8_MMA(0, 0, At, B0); PG8_BAR; PG8_SCHED;
            PG8_LDB(B1, 1, 1); PG8_STAGE(PG8_SB(1, 0), b3, voffB);
            PG8_BAR; PG8_WAIT_L(0); PG8_MMA(0, 1, At, B1); PG8_BAR;
            PG8_LDA(At, 1, 1); PG8_STAGE(PG8_SA(1, 0), a3, voffA);
            PG8_BAR; PG8_WAIT_L(0); PG8_MMA(1, 0, At, B0); PG8_BAR; PG8_SCHED;
            PG8_STAGE(PG8_SB(1, 1), b3 + hstep, voffB);
            PG8_WAIT_V(6); PG8_BAR; PG8_MMA(1, 1, At, B1); PG8_BAR;
            }
        }
        if constexpr (ALIGN_EPI) { if (wr == 0) PG8_BAR; }
        if constexpr (!Epi::AFTER_DRAIN) { E(acc, cur, ui, wr, wc, fr, fq); S.done(cur); }
        if (!has_next) break;
#pragma unroll
        for (int a = 0; a < 2; ++a)
#pragma unroll
            for (int b = 0; b < 2; ++b)
#pragma unroll
                for (int m = 0; m < 4; ++m)
#pragma unroll
                    for (int n = 0; n < 2; ++n) acc[a][b][m][n] = (f32x4){0.f, 0.f, 0.f, 0.f};
        cur = nxt; cA = nA; cB = nB; ++ui;
        if constexpr (ALIGN_EPI) { if (wr == 1) PG8_BAR; }
    }
    PG8_WAIT_V(0);
    if constexpr (!ALIGN_EPI) { if (wr == 0) PG8_BAR; }
    PG8_BAR;
    if constexpr (Epi::AFTER_DRAIN) { E.fused(acc, cur, wr, wc, fr, fq, lds, wid, lane); S.done(cur); }
#undef PG8_SA
#undef PG8_SB
#undef PG8_STAGE
#undef PG8_LDA
#undef PG8_LDB
#undef PG8_MMA
#undef PG8_WAIT_V
#undef PG8_WAIT_L
#undef PG8_BAR
#undef PG8_SCHED
}
}
namespace pg8 {
__device__ __forceinline__ float bf_lo(unsigned w) { return __uint_as_float(w << 16); }
__device__ __forceinline__ float bf_hi(unsigned w) { return __uint_as_float(w & 0xffff0000u); }
__device__ __forceinline__ float sigm(float x) { return 1.0f / (1.0f + __expf(-x)); }
typedef unsigned u32x2 __attribute__((ext_vector_type(2)));

template <bool G1>
struct EpiProjT {
    static constexpr bool PERM = true, AFTER_DRAIN = false;
    bf16_t* O; int ldc; const PG8_LAS float* rstd; bf16_t* KV; float* RSQ; bf16_t* RHO; bf16_t* SGB;
    static constexpr int kvtile = 4, sqtile = 9, gtile = 16;
    __device__ __forceinline__ void operator()(const f32x4 (&acc)[2][2][4][2], const Unit& u, int ui, int wr, int wc, int fr, int fq) const {
        const int rt0 = wr * 64 + fr, col0 = u.pn * BM + wc * 32 + 8 * fq;
        const bool sq = G1 && (u.pn == sqtile || u.pn == sqtile + 1);
#pragma unroll
        for (int ai = 0; ai < 2; ++ai)
#pragma unroll
            for (int m = 0; m < 4; ++m) { const int rt = rt0 + ai * HALF + m * 16; const float s = rstd[ui * 256 + rt];
                bf16_t* rowp = O + (size_t)(u.pm * BM + rt) * ldc + col0;
                if constexpr (G1) { if (u.pn == kvtile) rowp = KV + (size_t)(u.pm * BM + rt) * 256 + wc * 32 + 8 * fq; }
                float ss = 0.f;
                if constexpr (G1) { if (u.pn >= gtile) {
                    const f32x4 a0 = acc[ai][0][m][0] * s, a1 = acc[ai][0][m][1] * s, b0 = acc[ai][1][m][0] * s, b1 = acc[ai][1][m][1] * s;
                    float ea[8], eb[8], rh[8], sb[8];
#pragma unroll
                    for (int j = 0; j < 4; ++j) { ea[j] = 1.0f + __expf(-a0[j]); ea[4 + j] = 1.0f + __expf(-a1[j]); eb[j] = 1.0f + __expf(-b0[j]); eb[4 + j] = 1.0f + __expf(-b1[j]); }
#pragma unroll
                    for (int j = 0; j < 8; ++j) { const float ia = __builtin_amdgcn_rcpf(ea[j]); rh[j] = eb[j] * ia; sb[j] = __builtin_amdgcn_rcpf(eb[j]); }
                    const size_t go = (size_t)(u.pm * BM + rt) * 2048 + (u.pn - gtile) * 128 + wc * 32 + 8 * fq;
                    u32x4 wr_, ws_; wr_.x = cvt_pk_bf16(rh[0], rh[1]); wr_.y = cvt_pk_bf16(rh[2], rh[3]); wr_.z = cvt_pk_bf16(rh[4], rh[5]); wr_.w = cvt_pk_bf16(rh[6], rh[7]);
                    ws_.x = cvt_pk_bf16(sb[0], sb[1]); ws_.y = cvt_pk_bf16(sb[2], sb[3]); ws_.z = cvt_pk_bf16(sb[4], sb[5]); ws_.w = cvt_pk_bf16(sb[6], sb[7]);
                    *(u32x4*)(RHO + go) = wr_; *(u32x4*)(SGB + go) = ws_;
                    continue; } }
#pragma unroll
                for (int bj = 0; bj < 2; ++bj) { const f32x4 v0 = acc[ai][bj][m][0] * s, v1 = acc[ai][bj][m][1] * s;
                    ss += (v0[0] * v0[0] + v0[1] * v0[1]) + (v0[2] * v0[2] + v0[3] * v0[3]) + (v1[0] * v1[0] + v1[1] * v1[1]) + (v1[2] * v1[2] + v1[3] * v1[3]);
                    u32x4 w; w.x = cvt_pk_bf16(v0[0], v0[1]); w.y = cvt_pk_bf16(v0[2], v0[3]); w.z = cvt_pk_bf16(v1[0], v1[1]); w.w = cvt_pk_bf16(v1[2], v1[3]);
                    *(u32x4*)(rowp + bj * HALF) = w; }
                if constexpr (G1) if (sq) { ss += __shfl_xor(ss, 16); ss += __shfl_xor(ss, 32); if (fq == 0) RSQ[(size_t)(u.pm * BM + rt) * 8 + (u.pn - sqtile) * 4 + wc] = ss; } }
    }
};
struct EpiPA {
    static constexpr bool PERM = false, AFTER_DRAIN = false;
    float* P; const bf16_t* G; int ldg;
    __device__ __forceinline__ void operator()(const f32x4 (&acc)[2][2][4][2], const Unit& u, int ui, int wr, int wc, int fr, int fq) const {
        const int col0 = u.pn * BM + wc * 32 + 4 * fq;
#pragma unroll
        for (int ai = 0; ai < 2; ++ai)
#pragma unroll
            for (int m = 0; m < 4; ++m) { const int row = u.pm * BM + ai * HALF + wr * 64 + m * 16 + fr;
#pragma unroll
                for (int bj = 0; bj < 2; ++bj)
#pragma unroll
                    for (int n = 0; n < 2; ++n) { const int c = col0 + bj * HALF + n * 16; const u32x2 g = *(const u32x2*)(G + (size_t)row * ldg + c);
                        f32x4 v = acc[ai][bj][m][n]; v[0] *= sigm(bf_lo(g.x)); v[1] *= sigm(bf_hi(g.x)); v[2] *= sigm(bf_lo(g.y)); v[3] *= sigm(bf_hi(g.y));
                        *(f32x4*)(P + (size_t)row * 2048 + c) = v; } }
    }
};
struct EpiMerge {
    static constexpr bool PERM = true, AFTER_DRAIN = false;
    bf16_t* O; const float* P; const bf16_t* G; int ldg;
    __device__ __forceinline__ void operator()(const f32x4 (&acc)[2][2][4][2], const Unit& u, int ui, int wr, int wc, int fr, int fq) const {
        const int col0 = u.pn * BM + wc * 32 + 8 * fq;
#pragma unroll
        for (int ai = 0; ai < 2; ++ai)
#pragma unroll
            for (int m = 0; m < 4; ++m) { const int row = u.pm * BM + ai * HALF + wr * 64 + m * 16 + fr;
#pragma unroll
                for (int bj = 0; bj < 2; ++bj) { const int c = col0 + bj * HALF; const u32x4 g = *(const u32x4*)(G + (size_t)row * ldg + c);
                    const f32x4 p0 = *(const f32x4*)(P + (size_t)row * 2048 + c), p1 = *(const f32x4*)(P + (size_t)row * 2048 + c + 4);
                    f32x4 v0 = acc[ai][bj][m][0], v1 = acc[ai][bj][m][1];
                    v0[0] = p0[0] + sigm(bf_lo(g.x)) * v0[0]; v0[1] = p0[1] + sigm(bf_hi(g.x)) * v0[1]; v0[2] = p0[2] + sigm(bf_lo(g.y)) * v0[2]; v0[3] = p0[3] + sigm(bf_hi(g.y)) * v0[3];
                    v1[0] = p1[0] + sigm(bf_lo(g.z)) * v1[0]; v1[1] = p1[1] + sigm(bf_hi(g.z)) * v1[1]; v1[2] = p1[2] + sigm(bf_lo(g.w)) * v1[2]; v1[3] = p1[3] + sigm(bf_hi(g.w)) * v1[3];
                    u32x4 w; w.x = cvt_pk_bf16(v0[0], v0[1]); w.y = cvt_pk_bf16(v0[2], v0[3]); w.z = cvt_pk_bf16(v1[0], v1[1]); w.w = cvt_pk_bf16(v1[2], v1[3]);
                    *(u32x4*)(O + (size_t)row * 2048 + c) = w; } }
    }
};
struct EpiG4 {
    static constexpr bool PERM = true, AFTER_DRAIN = false;
    bf16_t* O; float* P; const bf16_t* GA; const bf16_t* GB; int ldg;
    __device__ __forceinline__ void operator()(const f32x4 (&acc)[2][2][4][2], const Unit& u, int ui, int wr, int wc, int fr, int fq) const {
        const int col0 = u.pn * BM + wc * 32 + 8 * fq;
        const bf16_t* G = u.sel ? GB : GA;
#pragma unroll
        for (int ai = 0; ai < 2; ++ai)
#pragma unroll
            for (int m = 0; m < 4; ++m) { const int row = u.pm * BM + ai * HALF + wr * 64 + m * 16 + fr;
#pragma unroll
                for (int bj = 0; bj < 2; ++bj) { const int c = col0 + bj * HALF; const u32x4 g = *(const u32x4*)(G + (size_t)row * ldg + c);
                    f32x4 v0 = acc[ai][bj][m][0], v1 = acc[ai][bj][m][1];
                    v0[0] *= sigm(bf_lo(g.x)); v0[1] *= sigm(bf_hi(g.x)); v0[2] *= sigm(bf_lo(g.y)); v0[3] *= sigm(bf_hi(g.y));
                    v1[0] *= sigm(bf_lo(g.z)); v1[1] *= sigm(bf_hi(g.z)); v1[2] *= sigm(bf_lo(g.w)); v1[3] *= sigm(bf_hi(g.w));
                    float* pp = P + (size_t)row * 2048 + c;
                    if (u.sel == 0) { *(f32x4*)pp = v0; *(f32x4*)(pp + 4) = v1; }
                    else { v0 += *(const f32x4*)pp; v1 += *(const f32x4*)(pp + 4);
                        u32x4 w; w.x = cvt_pk_bf16(v0[0], v0[1]); w.y = cvt_pk_bf16(v0[2], v0[3]); w.z = cvt_pk_bf16(v1[0], v1[1]); w.w = cvt_pk_bf16(v1[2], v1[3]);
                        *(u32x4*)(O + (size_t)row * 2048 + c) = w; } } }
    }
};
struct EpiG4m {
    static constexpr bool PERM = true, AFTER_DRAIN = false, MIDK = true;
    bf16_t* O; const bf16_t* RHO; const bf16_t* SGB;
    __device__ __forceinline__ void scale(f32x4 (&acc)[2][2][4][2], const bf16_t* T, const Unit& u, int wr, int wc, int fr, int fq) const {
        const int col0 = u.pn * BM + wc * 32 + 8 * fq;
        u32x4 gv[2][4][2];
#pragma unroll
        for (int ai = 0; ai < 2; ++ai)
#pragma unroll
            for (int m = 0; m < 4; ++m)
#pragma unroll
                for (int bj = 0; bj < 2; ++bj) gv[ai][m][bj] = *(const u32x4*)(T + (size_t)(u.pm * BM + ai * HALF + wr * 64 + m * 16 + fr) * 2048 + col0 + bj * HALF);
        __builtin_amdgcn_sched_barrier(0);
#pragma unroll
        for (int ai = 0; ai < 2; ++ai)
#pragma unroll
            for (int m = 0; m < 4; ++m)
#pragma unroll
                for (int bj = 0; bj < 2; ++bj) { const u32x4 g = gv[ai][m][bj]; f32x4& v0 = acc[ai][bj][m][0]; f32x4& v1 = acc[ai][bj][m][1];
                    v0[0] *= bf_lo(g.x); v0[1] *= bf_hi(g.x); v0[2] *= bf_lo(g.y); v0[3] *= bf_hi(g.y); v1[0] *= bf_lo(g.z); v1[1] *= bf_hi(g.z); v1[2] *= bf_lo(g.w); v1[3] *= bf_hi(g.w); }
    }
    __device__ __forceinline__ void midk(f32x4 (&acc)[2][2][4][2], const Unit& u, int wr, int wc, int fr, int fq) const {
        asm volatile("" : "+v"(fr), "+v"(fq));
        scale(acc, RHO, u, wr, wc, fr, fq);
    }
    __device__ __forceinline__ void operator()(const f32x4 (&acc_)[2][2][4][2], const Unit& u, int ui, int wr, int wc, int fr, int fq) const {
        f32x4 acc[2][2][4][2];
#pragma unroll
        for (int a = 0; a < 2; ++a)
#pragma unroll
            for (int b = 0; b < 2; ++b)
#pragma unroll
                for (int m = 0; m < 4; ++m)
#pragma unroll
                    for (int n = 0; n < 2; ++n) acc[a][b][m][n] = acc_[a][b][m][n];
        scale(acc, SGB, u, wr, wc, fr, fq);
        const int col0 = u.pn * BM + wc * 32 + 8 * fq;
#pragma unroll
        for (int ai = 0; ai < 2; ++ai)
#pragma unroll
            for (int m = 0; m < 4; ++m) { const int row = u.pm * BM + ai * HALF + wr * 64 + m * 16 + fr;
#pragma unroll
                for (int bj = 0; bj < 2; ++bj) { const f32x4 v0 = acc[ai][bj][m][0], v1 = acc[ai][bj][m][1];
                    u32x4 w; w.x = cvt_pk_bf16(v0[0], v0[1]); w.y = cvt_pk_bf16(v0[2], v0[3]); w.z = cvt_pk_bf16(v1[0], v1[1]); w.w = cvt_pk_bf16(v1[2], v1[3]);
                    *(u32x4*)(O + (size_t)row * 2048 + col0 + bj * HALF) = w; } }
    }
};
struct DualOrder : StaticOrder {
    __host__ __device__ bool next(int i, Unit& u) const { if (!StaticOrder::next(i >> 1, u)) return false; u.sel = i & 1; return true; }
};
struct EpiRes {
    static constexpr bool PERM = false, AFTER_DRAIN = false;
    bf16_t* HB; float* RS;
    __device__ __forceinline__ void operator()(const f32x4 (&acc)[2][2][4][2], const Unit& u, int ui, int wr, int wc, int fr, int fq) const {
        const int col0 = u.pn * BM + wc * 32 + 4 * fq;
        u32x2 ho[2][4][2][2];
#pragma unroll
        for (int ai = 0; ai < 2; ++ai)
#pragma unroll
            for (int m = 0; m < 4; ++m) { const int row = u.pm * BM + ai * HALF + wr * 64 + m * 16 + fr;
#pragma unroll
                for (int bj = 0; bj < 2; ++bj)
#pragma unroll
                    for (int n = 0; n < 2; ++n) ho[ai][m][bj][n] = *(const u32x2*)(HB + (size_t)row * 2048 + col0 + bj * HALF + n * 16); }
        __builtin_amdgcn_sched_barrier(0);
#pragma unroll
        for (int ai = 0; ai < 2; ++ai)
#pragma unroll
            for (int m = 0; m < 4; ++m) { const int row = u.pm * BM + ai * HALF + wr * 64 + m * 16 + fr; float ss = 0.f;
#pragma unroll
                for (int bj = 0; bj < 2; ++bj)
#pragma unroll
                    for (int n = 0; n < 2; ++n) { const size_t off = (size_t)row * 2048 + col0 + bj * HALF + n * 16;
                        const u32x2 h0 = ho[ai][m][bj][n];
                        f32x4 hv = {bf_lo(h0.x), bf_hi(h0.x), bf_lo(h0.y), bf_hi(h0.y)}; hv += acc[ai][bj][m][n];
                        u32x2 w; w.x = cvt_pk_bf16(hv[0], hv[1]); w.y = cvt_pk_bf16(hv[2], hv[3]); *(u32x2*)(HB + off) = w;
                        ss += (hv[0] * hv[0] + hv[1] * hv[1]) + (hv[2] * hv[2] + hv[3] * hv[3]); }
                ss += __shfl_xor(ss, 16); ss += __shfl_xor(ss, 32);
                if (fq == 0) RS[(size_t)row * 32 + u.pn * 4 + wc] = ss; }
    }
};
}

#define GAS __attribute__((address_space(1)))
#define LAS __attribute__((address_space(3)))
typedef unsigned short bf16;
typedef unsigned v4u __attribute__((ext_vector_type(4)));
typedef float f32x4 __attribute__((ext_vector_type(4)));
typedef short bf16x8 __attribute__((ext_vector_type(8)));
typedef GAS unsigned gu32;
typedef GAS unsigned long long gu64;
#define RLX_AGENT __ATOMIC_RELAXED, __HIP_MEMORY_SCOPE_AGENT
#define LDS_WAIT() asm volatile("s_waitcnt lgkmcnt(0)" ::: "memory")
#define VM_WAIT() asm volatile("s_waitcnt vmcnt(0)" ::: "memory")
__device__ __forceinline__ unsigned long long rt() { return __builtin_amdgcn_s_memrealtime(); }
__device__ __forceinline__ unsigned f2bf(float f) { unsigned u = __builtin_bit_cast(unsigned, f); return (u + 0x7fffu + ((u >> 16) & 1u)) >> 16; }
__device__ __forceinline__ unsigned pk2(float lo, float hi) { return f2bf(lo) | (f2bf(hi) << 16); }

#define XB_TMO      128
#define XB_XCNT(j)  (256  + 64 * (j))
#define XB_XSUB(j)  (1280 + 64 * (j))
#define XB_XGEN(j)  (2304 + 64 * (j))
#define XB_TOP      3328
#define XB_TOPGEN   3392
#define XCD_BAR_WORDS 3456
#define XB_SPIN_CAP (1u << 18)

__device__ __forceinline__ unsigned xb_ld(unsigned* p)              { return __hip_atomic_load(p, __ATOMIC_RELAXED, __HIP_MEMORY_SCOPE_AGENT); }
__device__ __forceinline__ unsigned xb_add(unsigned* p, unsigned v) { return __hip_atomic_fetch_add(p, v, __ATOMIC_RELAXED, __HIP_MEMORY_SCOPE_AGENT); }
__device__ __forceinline__ unsigned xb_xcc_id() { return (unsigned)__builtin_amdgcn_s_getreg((3 << 11) | 20) & 0xFu; }
#define XB_SPIN(cond, bar) do { unsigned _sp = 0; while (cond) { __builtin_amdgcn_s_sleep(1); \
    if ((++_sp & 255u) == 0u) { if (xb_ld(&(bar)[XB_TMO])) break; if (_sp > XB_SPIN_CAP) { atomicAdd(&(bar)[XB_TMO], 1u); break; } } } } while (0)

struct XcdBarrier {
    unsigned* bar; unsigned x;
    volatile LAS unsigned* st;
};

__device__ __forceinline__ XcdBarrier xcd_barrier_post(unsigned* bar, volatile LAS unsigned* st) {
    XcdBarrier b; b.bar = bar; b.x = xb_xcc_id(); b.st = st;
    if (threadIdx.x == 0) (void)xb_add(&bar[XB_XCNT(b.x)], 1u);
    return b;
}
__device__ __forceinline__ void xcd_barrier_complete(unsigned* bar, unsigned x, unsigned& nloc, unsigned& nx) {
    const unsigned G = gridDim.x * gridDim.y * gridDim.z;
    unsigned sum, cnt, mine, sp = 0u;
    for (;;) {
        sum = 0u; cnt = 0u; mine = 0u;
#pragma unroll
        for (unsigned j = 0; j < 16; ++j) { const unsigned c = xb_ld(&bar[XB_XCNT(j)]); sum += c; cnt += (c > 0u) ? 1u : 0u; mine = (j == x) ? c : mine; }
        if (sum == G) break;
        __builtin_amdgcn_s_sleep(1);
        if ((++sp & 255u) == 0u) { if (xb_ld(&bar[XB_TMO])) break; if (sp > XB_SPIN_CAP) { atomicAdd(&bar[XB_TMO], 1u); break; } }
    }
    nloc = mine > 0u ? mine : 1u; nx = cnt > 0u ? cnt : 1u;
}

__device__ __forceinline__ void xcd_barrier(const XcdBarrier& b, bool thread0) {
    asm volatile("s_waitcnt vmcnt(0)" ::: "memory");
    __syncthreads();
    if (thread0) {
        unsigned* bar = b.bar;
        __builtin_amdgcn_s_waitcnt(0);
        unsigned nloc = b.st[0], nx = b.st[1];
        if (nloc == 0u) { xcd_barrier_complete(bar, b.x, nloc, nx); b.st[0] = nloc; b.st[1] = nx; }
        const unsigned old = xb_add(&bar[XB_XSUB(b.x)], 1u);
        const unsigned gen = old / nloc;
        if (old + 1u == (gen + 1u) * nloc) {
            __builtin_amdgcn_fence(__ATOMIC_RELEASE, "agent");
            asm volatile("s_waitcnt vmcnt(0)" ::: "memory");
            const unsigned og = xb_add(&bar[XB_TOP], 1u);
            const unsigned tg = og / nx;
            if (og + 1u == (tg + 1u) * nx) xb_add(&bar[XB_TOPGEN], 1u);
            else XB_SPIN(xb_ld(&bar[XB_TOPGEN]) == tg, bar);
            __builtin_amdgcn_fence(__ATOMIC_ACQUIRE, "agent");
            xb_add(&bar[XB_XGEN(b.x)], 1u);
            asm volatile("s_waitcnt vmcnt(0)" ::: "memory");
        } else {
            XB_SPIN(xb_ld(&bar[XB_XGEN(b.x)]) == gen, bar);
            __builtin_amdgcn_fence(__ATOMIC_ACQUIRE, "agent");
            asm volatile("s_waitcnt vmcnt(0)" ::: "memory");
        }
    }
    __syncthreads();
}
#ifndef MK_PROBE
#define MK_PROBE (-1)
#endif
#ifndef MK_PROBE_BLOCK
#define MK_PROBE_BLOCK 255
#endif
#ifndef MK_PROBE_SCALE
#define MK_PROBE_SCALE 2e-6f
#endif
#define PROBE_T0() unsigned pt0_ = 0; if (MK_PROBE >= 0) { pt0_ = (unsigned)__builtin_amdgcn_readfirstlane((int)(unsigned)__builtin_amdgcn_s_memtime()); asm volatile("s_waitcnt lgkmcnt(0)" ::: "memory"); }
#define PROBE_T1(id) do { if (MK_PROBE == (id)) { const unsigned pt1_ = (unsigned)__builtin_amdgcn_readfirstlane((int)(unsigned)__builtin_amdgcn_s_memtime()); asm volatile("s_waitcnt lgkmcnt(0)" ::: "memory"); \
    if (C.bid == MK_PROBE_BLOCK && C.wave == 0 && C.lane == 0) { volatile LAS unsigned* pw_ = (volatile LAS unsigned*)(C.lds + MISC_OFF + 64); pw_[0] = pw_[0] + (unsigned)(pt1_ - pt0_); } } } while (0)
constexpr int NWAVES = 8;
constexpr int NLAYER = 4, DM = 2048, NBATCH = 2, SEQ = 4096, NMETA = 16, LTOK = SEQ + NMETA, NTOK = NBATCH * LTOK;
constexpr int MP = 8448;
constexpr int NP1 = 8448;
constexpr int NC_IN = 8264;
constexpr int PC_QA = 0, PC_KA = 1024, PC_VA = 1152, PC_ZA = 1280, PC_CQ = 2304, PC_CKV = 2816, PC_ZB = 3072, PC_GA = 4096, PC_GB = 6144, PC_KIDX = 8192, PC_WIDX = 8256;
constexpr int NQ2 = 4608;
constexpr int TOPK = 256;
constexpr int YLD = 2048;
constexpr float RMS_EPS = 1e-6f;

__device__ __forceinline__ int rowof(int b, int t) { return t < NMETA ? 8192 + b * NMETA + t : b * SEQ + (t - NMETA); }
__device__ __forceinline__ int t5_bucket(int d) {
    const int n = d < 0 ? 0 : d;
    if (n < 16) return n;
    return 16 + (n >= 19) + (n >= 21) + (n >= 24) + (n >= 27) + (n >= 31) + (n >= 35) + (n >= 40) + (n >= 46) + (n >= 52) + (n >= 59) + (n >= 67) + (n >= 77) + (n >= 87) + (n >= 99) + (n >= 113);
}
__device__ __forceinline__ float bf2f(bf16 v) { return __uint_as_float((unsigned)v << 16); }
__device__ __forceinline__ float sigmoidf_(float x) { return 1.0f / (1.0f + __expf(-x)); }
__device__ __forceinline__ float siluf_(float x) { return x / (1.0f + __expf(-x)); }
__device__ __forceinline__ float wave_sum(float v) {
#pragma unroll
    for (int o = 1; o < 64; o <<= 1) v += __shfl_xor(v, o);
    return v;
}
__device__ __forceinline__ float wave_max(float v) {
#pragma unroll
    for (int o = 1; o < 64; o <<= 1) v = fmaxf(v, __shfl_xor(v, o));
    return v;
}
__device__ __forceinline__ int wave_sum_i(int v) {
#pragma unroll
    for (int o = 1; o < 64; o <<= 1) v += __shfl_xor(v, o);
    return v;
}

constexpr size_t MiB = 1u << 20;
constexpr size_t WS_CTL = 0, CTL_ZERO_BYTES = 1 * MiB;
constexpr size_t SZ_W1 = (size_t)NLAYER * NP1 * DM * 2, SZ_W2 = (size_t)NLAYER * NQ2 * 512 * 2, SZ_WA = (size_t)NLAYER * DM * 1024 * 2, SZ_WO = (size_t)NLAYER * DM * DM * 2;
constexpr size_t al(size_t x) { return (x + 4095) / 4096 * 4096; }
constexpr size_t WS_W1 = 1 * MiB, WS_W2 = WS_W1 + al(SZ_W1), WS_WA = WS_W2 + al(SZ_W2), WS_WB = WS_WA + 1024 * 2, WS_WO = WS_WA + al(2 * SZ_WA);
constexpr size_t SZ_WUV = (size_t)NLAYER * 16 * 64 * 256 * 2;
constexpr size_t WS_WUV = WS_WO + al(SZ_WO);
constexpr size_t WS_VT = WS_WUV + al(SZ_WUV);
constexpr size_t WS_KV = WS_VT + al((size_t)2 * 128 * 4128 * 2), WS_KIDX = WS_KV + al((size_t)MP * 256 * 2);
constexpr size_t WS_H = WS_KIDX + al((size_t)MP * 64 * 2), WS_HB = WS_H + al((size_t)MP * DM * 4), WS_RS = WS_HB + al((size_t)MP * DM * 2);
constexpr size_t WS_RS2 = WS_RS + al((size_t)MP * 32 * 4);
constexpr size_t WS_RSQ = WS_RS2 + al((size_t)32 * 64 * 4), WS_RSQ2 = WS_RSQ + al((size_t)MP * 8 * 4);
constexpr size_t WS_PROJ = WS_RSQ2 + al((size_t)32 * 16 * 4), WS_CQN = WS_PROJ + al((size_t)MP * NP1 * 2), WS_CKVN = WS_CQN + al((size_t)MP * 512 * 2);
constexpr size_t WS_Q2 = WS_CKVN + al((size_t)MP * 256 * 2), WS_OLAT = WS_Q2 + al((size_t)MP * NQ2 * 2), WS_YA = WS_OLAT + al((size_t)256 * 3 * 16 * 8 * 64 * 8 * 2);
constexpr size_t WS_YB = WS_YA + 1024 * 2, WS_PA = WS_YA + al((size_t)MP * 2048 * 2),
 WS_MG = WS_PA + al((size_t)MP * DM * 4), WS_RHO = WS_MG + al((size_t)MP * DM * 2), WS_SGB = WS_RHO + al((size_t)MP * DM * 2), WS_END = WS_SGB + al((size_t)MP * DM * 2);
constexpr int CW_TMO = 0, CW_CODE = 1, CW_BAR = 4096, CW_DSAQ = 16384;

constexpr int LDSCTL_OFF = 0, MISC_OFF = LDSCTL_OFF + 320;
constexpr int RSTD_OFF = 512;
constexpr int RING_OFF = 8192, RING_BYTES = 131072;
constexpr int LDS_BYTES = 163840;
static_assert(RSTD_OFF + 5 * 256 * 4 <= RING_OFF, "LDS map");

struct Args {
    const float* x; const float* meta; const float* bias_table; const float* norm_g; const float* w_in; const float* q_norm_g; const float* kv_norm_g; const float* w_qb; const float* w_iq;
    const float* w_uk; const float* w_uv; const float* sinks; const float* w_proj_a; const float* w_proj_b; const float* w_out; const float* final_g;
    float* out; unsigned char* ws; int ph_lo, ph_hi;
};

__device__ __forceinline__ unsigned pkh(float lo, float hi) { typedef float f2_t __attribute__((ext_vector_type(2))); typedef __bf16 b2_t __attribute__((ext_vector_type(2))); f2_t v = {lo, hi}; b2_t b = __builtin_convertvector(v, b2_t); return __builtin_bit_cast(unsigned, b); }
struct XDesc { const float* W; const float* scale; bf16* out; int ldw, k0, c0, nvalid, K; };
__device__ __forceinline__ void xpose_load(const XDesc& d, float (&v)[32], int lane) {
    asm volatile("" : "+v"(lane));
    const int c = lane & 31, cc = (c < d.nvalid) ? c : 0; const float* p = d.W + (size_t)(d.k0 + (lane >> 5)) * d.ldw + d.c0 + cc;
    const float keep = (c < d.nvalid) ? 1.f : 0.f;
#pragma unroll
    for (int i = 0; i < 32; ++i) v[i] = p[(size_t)(2 * i) * d.ldw];
#pragma unroll
    for (int i = 0; i < 32; ++i) v[i] *= keep;
    if (d.scale) {
#pragma unroll
        for (int i = 0; i < 32; ++i) v[i] *= d.scale[d.k0 + 2 * i + (lane >> 5)];
    }
}
__device__ __forceinline__ void xpose_store(const XDesc& d, const float (&v)[32], LAS float* scr, int lane) {
    asm volatile("" : "+v"(lane));
    const int c = lane & 31;
#pragma unroll
    for (int i = 0; i < 32; ++i) scr[(2 * i + (lane >> 5)) * 33 + c] = v[i];
    LDS_WAIT(); asm volatile("" ::: "memory");
    const int cc = lane & 7;
#pragma unroll
    for (int j = 0; j < 4; ++j) { const int n = (lane >> 3) + 8 * j; const LAS float* s = scr + (8 * cc) * 33 + n;
        v4u o; o.x = pkh(s[0 * 33], s[1 * 33]); o.y = pkh(s[2 * 33], s[3 * 33]); o.z = pkh(s[4 * 33], s[5 * 33]); o.w = pkh(s[6 * 33], s[7 * 33]);
        *(GAS v4u*)(d.out + (size_t)n * d.K + d.k0 + 8 * cc) = o; }
    LDS_WAIT(); asm volatile("" ::: "memory");
}
__device__ __forceinline__ void fold_item(const float* __restrict__ wqb, const float* __restrict__ wuk, const float* __restrict__ gq, bf16* W2l, int h, int kb, int rb, LAS float* scr, int lane) {
    const int rr = lane & 31, r = rb * 32 + rr;
    float uk[64];
#pragma unroll
    for (int d = 0; d < 64; ++d) uk[d] = wuk[((size_t)h * 64 + d) * 256 + r];
    for (int i = 0; i < 32; ++i) { const int kk = 2 * i + (lane >> 5), k = kb * 64 + kk; const f32x4* qp = (const f32x4*)(wqb + (size_t)k * 1024 + h * 64); float a = 0.f;
#pragma unroll
        for (int d4 = 0; d4 < 16; ++d4) { const f32x4 q = qp[d4]; a = fmaf(q[0], uk[4 * d4], a); a = fmaf(q[1], uk[4 * d4 + 1], a); a = fmaf(q[2], uk[4 * d4 + 2], a); a = fmaf(q[3], uk[4 * d4 + 3], a); }
        scr[kk * 33 + rr] = a * gq[k]; }
    LDS_WAIT(); asm volatile("" ::: "memory");
    const int cc = lane & 7; bf16* out = W2l + (size_t)(h * 256 + rb * 32) * 512;
#pragma unroll
    for (int j = 0; j < 4; ++j) { const int n = (lane >> 3) + 8 * j; const LAS float* s = scr + (8 * cc) * 33 + n;
        v4u o; o.x = pkh(s[0 * 33], s[1 * 33]); o.y = pkh(s[2 * 33], s[3 * 33]); o.z = pkh(s[4 * 33], s[5 * 33]); o.w = pkh(s[6 * 33], s[7 * 33]);
        *(GAS v4u*)(out + (size_t)n * 512 + kb * 64 + 8 * cc) = o; }
    LDS_WAIT(); asm volatile("" ::: "memory");
}

typedef const __attribute__((address_space(4))) Args KArgs;
__device__ __forceinline__ KArgs* kargs() { size_t z = 0; asm volatile("" : "+s"(z)); return (KArgs*)((const __attribute__((address_space(4))) unsigned char*)__builtin_amdgcn_kernarg_segment_ptr() + z); }
struct Ctx {
    LAS unsigned char* lds; int tid, lane, wave, G, gw, NGW, bid;
};
#if defined(__HIP_DEVICE_COMPILE__)
#define ASSUME_GLOBAL(p) do { __builtin_assume(!__builtin_amdgcn_is_shared((const void*)(p))); __builtin_assume(!__builtin_amdgcn_is_private((const void*)(p))); } while (0)
#else
#define ASSUME_GLOBAL(p) do { } while (0)
#endif
__device__ __forceinline__ unsigned char* launder(unsigned char* p) { size_t z = 0; asm volatile("" : "+s"(z)); return p + z; }
__device__ __forceinline__ const float* launderf(const float* p) { size_t z = 0; asm volatile("" : "+s"(z)); return p + z; }
struct Bufs {
    bf16 *W1, *W2, *WA, *WB, *WO, *WUV, *VT, *KV, *KIDX, *RHO, *SGB, *HB, *PROJ, *CQN, *CKVN, *Q2, *OLAT, *YA, *YB, *MG; float *H, *RS, *RS2, *RSQ, *RSQ2, *PA;
    __device__ __forceinline__ explicit Bufs(unsigned char* ws0) {
        unsigned char* ws = launder(ws0);
        W1 = (bf16*)(ws + WS_W1); W2 = (bf16*)(ws + WS_W2); WA = (bf16*)(ws + WS_WA); WB = (bf16*)(ws + WS_WB); WO = (bf16*)(ws + WS_WO); WUV = (bf16*)(ws + WS_WUV); VT = (bf16*)(ws + WS_VT); KV = (bf16*)(ws + WS_KV); KIDX = (bf16*)(ws + WS_KIDX); RHO = (bf16*)(ws + WS_RHO); SGB = (bf16*)(ws + WS_SGB);
        H = (float*)(ws + WS_H); HB = (bf16*)(ws + WS_HB); RS = (float*)(ws + WS_RS); RS2 = (float*)(ws + WS_RS2); RSQ = (float*)(ws + WS_RSQ); RSQ2 = (float*)(ws + WS_RSQ2); PROJ = (bf16*)(ws + WS_PROJ); CQN = (bf16*)(ws + WS_CQN); CKVN = (bf16*)(ws + WS_CKVN);
        Q2 = (bf16*)(ws + WS_Q2); OLAT = (bf16*)(ws + WS_OLAT); YA = (bf16*)(ws + WS_YA); YB = (bf16*)(ws + WS_YB); PA = (float*)(ws + WS_PA); MG = (bf16*)(ws + WS_MG);
    }
};

__device__ __forceinline__ void p0_prologue(const Ctx& C) {
    const Bufs B(kargs()->ws);
    const KArgs& A = *kargs();
    LAS float* scr = (LAS float*)(C.lds + RING_OFF + C.wave * 16384);
    constexpr int I_T1 = (DM / 64) * (NP1 / 32), I_T2 = (512 / 64) * (512 / 32), I_T3 = (1024 / 64) * (DM / 32), I_T5 = (DM / 64) * (DM / 32), I_F = 16 * 8 * 8, I_UV = 16 * 8;
    constexpr int I_X = I_T1 + I_T2 + 2 * I_T3 + I_T5, NX = NLAYER * I_X;
    auto decode = [&](int it) -> XDesc {
        const int l = it / I_X; int r = it % I_X; XDesc d;
        if (r < I_T1) { const int nblk = NP1 / 32, kb = r / nblk, n0 = (r % nblk) * 32; int c0, nvalid = 32;
            if (n0 < 4096) c0 = n0; else if (n0 < 8192) { const int tt = (n0 - 4096) >> 8, wi = (n0 - 4096) & 255; c0 = (wi < 128 ? 4168 : 6216 - 128) + 128 * tt + wi; }
            else { c0 = n0 - 8192 + 4096; nvalid = (8264 - n0) < 0 ? 0 : ((8264 - n0) > 32 ? 32 : (8264 - n0)); }
            d = XDesc{A.w_in + (size_t)l * DM * NC_IN, A.norm_g + l * DM, B.W1 + ((size_t)l * NP1 + n0) * DM, NC_IN, kb * 64, c0, nvalid, DM}; return d; }
        r -= I_T1;
        if (r < I_T2) { const int nblk = 512 / 32, kb = r / nblk, nb = r % nblk;
            d = XDesc{A.w_iq + (size_t)l * 512 * 512, A.q_norm_g + l * 512, B.W2 + ((size_t)l * NQ2 + 4096 + nb * 32) * 512, 512, kb * 64, nb * 32, 32, 512}; return d; }
        r -= I_T2;
        if (r < 2 * I_T3) { const bool second = r >= I_T3; if (second) r -= I_T3; const int nblk = DM / 32, kb = r / nblk, nb = r % nblk;
            d = XDesc{(second ? A.w_proj_b : A.w_proj_a) + (size_t)l * 1024 * DM, nullptr, (second ? B.WB : B.WA) + ((size_t)l * DM + nb * 32) * 2048, DM, kb * 64, nb * 32, 32, 2048}; return d; }
        r -= 2 * I_T3;
        { const int nblk = DM / 32, kb = r / nblk, nb = r % nblk;
            d = XDesc{A.w_out + (size_t)l * DM * DM, nullptr, B.WO + ((size_t)l * DM + nb * 32) * DM, DM, kb * 64, nb * 32, 32, DM}; return d; }
    };
    {
        int it = C.gw;
        if (it < NX) {
            XDesc dA = decode(it), dB = dA, dC = dA; float vA[32], vB[32], vC[32];
            xpose_load(dA, vA, C.lane);
            if (it + C.NGW < NX) { dB = decode(it + C.NGW); xpose_load(dB, vB, C.lane); }
#define PRO_STEP(dc_, vc_, dn_, vn_) { if (it + 2 * C.NGW < NX) { dn_ = decode(it + 2 * C.NGW); xpose_load(dn_, vn_, C.lane); } xpose_store(dc_, vc_, scr, C.lane); it += C.NGW; if (it >= NX) break; }
            for (;;) {
                PRO_STEP(dA, vA, dC, vC)
                PRO_STEP(dB, vB, dA, vA)
                PRO_STEP(dC, vC, dB, vB)
            }
#undef PRO_STEP
        }
    }
    for (int it = C.gw; it < NLAYER * (I_F + I_UV); it += C.NGW) {
        const int l = it / (I_F + I_UV); int r = it % (I_F + I_UV);
        if (r >= I_F) { r -= I_F; const int h = r / 8, s = r % 8;
            const float* wsrc = A.w_uv + ((size_t)l * 16 + h) * 256 * 64; const int gg = C.lane >> 4, cc = C.lane & 15;
#pragma unroll
            for (int nt = 0; nt < 4; ++nt) { const float* p = wsrc + (size_t)(32 * s + 8 * gg) * 64 + 16 * nt + cc;
                v4u o; o.x = pkh(p[0 * 64], p[1 * 64]); o.y = pkh(p[2 * 64], p[3 * 64]); o.z = pkh(p[4 * 64], p[5 * 64]); o.w = pkh(p[6 * 64], p[7 * 64]);
                *(GAS v4u*)(B.WUV + ((((size_t)l * 16 + h) * 8 + s) * 4 + nt) * 512 + C.lane * 8) = o; }
            continue; }
        { const int h = r / 64, kb = (r / 8) % 8, rb = r % 8;
            fold_item(A.w_qb + (size_t)l * 512 * 1024, A.w_uk + (size_t)l * 16 * 64 * 256, A.q_norm_g + l * 512, B.W2 + (size_t)l * NQ2 * 512, h, kb, rb, scr, C.lane); }
    }
    for (int m = C.gw; m < MP; m += C.NGW) {
        const float* src = nullptr;
        if (m < 8192) src = A.x + (size_t)m * DM; else if (m < 8224) src = A.meta + (size_t)((m - 8192) % NMETA) * DM;
        float ss = 0.f;
#pragma unroll
        for (int j = 0; j < 8; ++j) { f32x4 v = src ? *(const f32x4*)(src + j * 256 + C.lane * 4) : (f32x4){0.f, 0.f, 0.f, 0.f};
            pg8::u32x2 w; w.x = pkh(v[0], v[1]); w.y = pkh(v[2], v[3]); *(pg8::u32x2*)(B.HB + (size_t)m * DM + j * 256 + C.lane * 4) = w;
            ss += (v[0] * v[0] + v[1] * v[1]) + (v[2] * v[2] + v[3] * v[3]); }
        ss = wave_sum(ss);
        if (C.lane < 32) B.RS[(size_t)m * 32 + C.lane] = (C.lane == 0) ? ss : 0.f;
        if (m >= 8192 && m < 8224) B.RS2[(size_t)(m - 8192) * 64 + C.lane] = (C.lane == 0) ? ss : 0.f;
        if (m >= NTOK) {
#pragma unroll
            for (int j = 0; j < 2; ++j) { *(v4u*)(B.YA + (size_t)m * YLD + j * 512 + C.lane * 8) = (v4u){0u, 0u, 0u, 0u}; *(v4u*)(B.YB + (size_t)m * YLD + j * 512 + C.lane * 8) = (v4u){0u, 0u, 0u, 0u}; }
        }
    }
}

template <int NP4>
__device__ __forceinline__ void rstd_table(const Ctx& C, const pg8::StaticOrder& S, const float* __restrict__ rs, float inv_dim) {
    LAS float* tbl = (LAS float*)(C.lds + RSTD_OFF);
    pg8::Unit u;
    for (int ui = 0; ui < 5 && S.next(ui, u); ++ui) {
        if (C.tid < 256) { const f32x4* p = (const f32x4*)(rs + (size_t)(u.pm * 256 + C.tid) * (NP4 * 4)); float s = 0.f;
#pragma unroll
            for (int j = 0; j < NP4; ++j) { const f32x4 v = p[j]; s += (v[0] + v[1]) + (v[2] + v[3]); }
            tbl[ui * 256 + C.tid] = rsqrtf(s * inv_dim + RMS_EPS); }
    }
    __syncthreads();
}

__device__ __forceinline__ void norm_tail(const Ctx& C, int l) {
    const Bufs B(kargs()->ws);
    const KArgs& A = *kargs();
    const int gw2 = (C.G == 256) ? C.gw - 64 * NWAVES : C.gw, ngw2 = (C.G == 256) ? C.NGW - 64 * NWAVES : C.NGW;
    if (gw2 < 0) return;
    for (int m = gw2; m < NTOK; m += ngw2) {
        const bf16* pr = B.PROJ + (size_t)m * NP1;
        { const pg8::u32x2 w = *(const pg8::u32x2*)(pr + PC_CKV + C.lane * 4); float v[4] = {pg8::bf_lo(w.x), pg8::bf_hi(w.x), pg8::bf_lo(w.y), pg8::bf_hi(w.y)};
          float ss = (v[0] * v[0] + v[1] * v[1]) + (v[2] * v[2] + v[3] * v[3]);
          ss = wave_sum(ss); const float r = rsqrtf(ss * (1.0f / 256.0f) + RMS_EPS);
          const f32x4 g = *(const f32x4*)(A.kv_norm_g + l * 256 + C.lane * 4);
          pg8::u32x2 o; o.x = pkh(v[0] * r * g[0], v[1] * r * g[1]); o.y = pkh(v[2] * r * g[2], v[3] * r * g[3]);
          *(pg8::u32x2*)(B.CKVN + (size_t)m * 256 + C.lane * 4) = o; }
    }
    for (int it = gw2; it < 2 * 65; it += ngw2) { const int b = it / 65, pos = (it % 65) * 64 + C.lane;
        if (pos < LTOK) { const bf16* vr = B.KV + (size_t)rowof(b, pos) * 256 + 128;
#pragma unroll 4
            for (int c8 = 0; c8 < 16; ++c8) { const v4u w = *(const v4u*)(vr + 8 * c8); bf16* o = B.VT + ((size_t)b * 128 + 8 * c8) * 4128 + pos;
                o[0 * 4128] = (bf16)(w.x & 0xffffu); o[1 * 4128] = (bf16)(w.x >> 16); o[2 * 4128] = (bf16)(w.y & 0xffffu); o[3 * 4128] = (bf16)(w.y >> 16);
                o[4 * 4128] = (bf16)(w.z & 0xffffu); o[5 * 4128] = (bf16)(w.z >> 16); o[6 * 4128] = (bf16)(w.w & 0xffffu); o[7 * 4128] = (bf16)(w.w >> 16); } } }
}

__device__ __forceinline__ unsigned f2key(float f) { const unsigned u = __float_as_uint(f); return (u & 0x80000000u) ? ~u : (u | 0x80000000u); }

__device__ __forceinline__ void final_phase(const Ctx& C) {
    const Bufs B(kargs()->ws);
    const KArgs& A = *kargs();
    for (int m = C.gw; m < 8192; m += C.NGW) {
        float s = (C.lane < 32) ? B.RS[(size_t)m * 32 + C.lane] : 0.f;
        s = wave_sum(s);
        const float r = rsqrtf(s * (1.0f / DM) + RMS_EPS);
#pragma unroll
        for (int j = 0; j < 8; ++j) { const pg8::u32x2 hw = *(const pg8::u32x2*)(B.HB + (size_t)m * DM + j * 256 + C.lane * 4); const f32x4 v = {pg8::bf_lo(hw.x), pg8::bf_hi(hw.x), pg8::bf_lo(hw.y), pg8::bf_hi(hw.y)}; const f32x4 g = *(const f32x4*)(A.final_g + j * 256 + C.lane * 4);
            *(f32x4*)(A.out + (size_t)m * DM + j * 256 + C.lane * 4) = v * r * g; }
    }
#if defined(MK_PROBE)
    if (MK_PROBE >= 0 && C.gw == 0) { VM_WAIT(); if (C.lane == 0) { float* o0 = A.out; o0[0] += (float)__hip_atomic_load((gu32*)(A.ws + WS_CTL) + 3, RLX_AGENT) * MK_PROBE_SCALE; } }
#endif
}


struct SkProj {
    bf16* P; bf16* KV; bf16* KIDX; int cb; const LAS float* tbl;
    __device__ __forceinline__ float operator()(int rloc, int c, float v) const { const int ac = cb + c; const bf16 o = (bf16)f2bf(v * tbl[rloc]);
        if (ac >= 1024 && ac < 1280) KV[(size_t)rloc * 256 + ac - 1024] = o; else if (ac >= 8192 && ac < 8256) KIDX[(size_t)rloc * 64 + ac - 8192] = o; else P[(size_t)rloc * NP1 + ac] = o;
        return v * tbl[rloc]; } };
struct SkQ2 { bf16* O; const LAS float* tbl; __device__ __forceinline__ float operator()(int rloc, int c, float v) const { O[(size_t)rloc * NQ2 + c] = (bf16)f2bf(v * tbl[rloc]); return 0.f; } };
struct SkPA { float* P; const bf16* G; int c0; __device__ __forceinline__ float operator()(int rloc, int c, float v) const { const int cg = c0 + c; P[(size_t)rloc * DM + c] = sigmoidf_(bf2f(G[(size_t)rloc * NP1 + 256 * (cg >> 7) + (cg & 127)])) * v; return 0.f; } };
struct SkMerge { bf16* O; const float* P; const bf16* G; int c0; __device__ __forceinline__ float operator()(int rloc, int c, float v) const { const int cg = c0 + c; O[(size_t)rloc * DM + c] = (bf16)f2bf(P[(size_t)rloc * DM + c] + sigmoidf_(bf2f(G[(size_t)rloc * NP1 + 256 * (cg >> 7) + (cg & 127) + 128])) * v); return 0.f; } };
struct SkRes { bf16* HB; __device__ __forceinline__ float operator()(int rloc, int c, float v) const { const float h = bf2f(HB[(size_t)rloc * DM + c]) + v; HB[(size_t)rloc * DM + c] = (bf16)f2bf(h); return h; } };
constexpr int MR = 8192;
typedef float f32x16 __attribute__((ext_vector_type(16)));
__device__ __forceinline__ void sk_glds16(const void* gsrc, unsigned lds_dst) { unsigned keep;
    asm volatile("s_mov_b32 %0, m0\n\ts_mov_b32 m0, %2\n\ts_nop 0\n\tglobal_load_lds_dwordx4 %1, off\n\ts_mov_b32 m0, %0" : "=&s"(keep) : "v"(gsrc), "s"(lds_dst) : "memory"); }
template <int NT, int GPI, class F>
__device__ __forceinline__ void skinny_unit(const Ctx& C, const bf16* __restrict__ A, int lda, const bf16* __restrict__ Bt, int ldb, int K, float* ss_out  , int ss_ld, int ss_col0, const F& epi) {
    const int lane = C.lane, w = C.wave, r32 = lane & 31, hh = lane >> 5;
    f32x16 acc[NT];
#pragma unroll
    for (int nt = 0; nt < NT; ++nt) acc[nt] = (f32x16){};
    const int kper = K >> 3, ngroups = kper >> 6;
    const unsigned stg = (unsigned)__builtin_amdgcn_readfirstlane((unsigned)(uintptr_t)(C.lds + RING_OFF) + (unsigned)w * 16384u);
    LAS unsigned char* stp = C.lds + RING_OFF + w * 16384;
    const int prow = lane >> 3, pch = lane & 7;
    const int foff = r32 * 128;
    const int fsw = (r32 >> 1) & 7;
#pragma unroll 1
    for (int g0 = 0; g0 < ngroups; ++g0) {
        const size_t kbyte = ((size_t)w * kper + (size_t)g0 * 64) * 2;
#pragma unroll
        for (int p = 0; p < 4; ++p) { const int row = 8 * p + prow; const int lg = pch ^ ((row >> 1) & 7);
            sk_glds16((const unsigned char*)A + (size_t)row * lda * 2 + kbyte + lg * 16, stg + p * 1024); }
#pragma unroll
        for (int nt = 0; nt < NT; ++nt)
#pragma unroll
            for (int p = 0; p < 4; ++p) { const int row = 8 * p + prow; const int lg = pch ^ ((row >> 1) & 7);
                sk_glds16((const unsigned char*)Bt + (size_t)(nt * 32 + row) * ldb * 2 + kbyte + lg * 16, stg + 4096 * (1 + nt) + p * 1024); }
        asm volatile("s_waitcnt vmcnt(0)" ::: "memory");
        bf16x8 a[4], bv[NT][4];
#pragma unroll
        for (int s = 0; s < 4; ++s) { const int o = foff + (((2 * s + hh) ^ fsw) << 4); a[s] = *(const LAS bf16x8*)(stp + o);
#pragma unroll
            for (int nt = 0; nt < NT; ++nt) bv[nt][s] = *(const LAS bf16x8*)(stp + 4096 * (1 + nt) + o); }
        __builtin_amdgcn_sched_barrier(0);
#pragma unroll
        for (int s = 0; s < 4; ++s)
#pragma unroll
            for (int nt = 0; nt < NT; ++nt) acc[nt] = __builtin_amdgcn_mfma_f32_32x32x16_bf16(a[s], bv[nt][s], acc[nt], 0, 0, 0);
        LDS_WAIT(); asm volatile("" ::: "memory");
    }
    LDS_WAIT(); __syncthreads();
    LAS float* part = (LAS float*)(C.lds + RING_OFF);
#pragma unroll
    for (int nt = 0; nt < NT; ++nt)
#pragma unroll
        for (int i = 0; i < 16; ++i) part[(w * NT * 16 + nt * 16 + i) * 64 + lane] = acc[nt][i];
    LDS_WAIT(); __syncthreads();
#pragma unroll
    for (int j = 0; j < 2 * NT; ++j) { const int e = (w + 8 * j) * 64 + lane;
        const int nti = w + 8 * j, nt = nti >> 4, i = nti & 15;
        float v = 0.f;
#pragma unroll
        for (int ww = 0; ww < 8; ++ww) v += part[ww * NT * 1024 + e];
        const int rloc = (i & 3) + 8 * (i >> 2) + 4 * hh, c = nt * 32 + r32;
        float sv = epi(rloc, c, v);
        if (ss_out != nullptr) { sv = sv * sv;
#pragma unroll
            for (int o = 1; o < 32; o <<= 1) sv += __shfl_xor(sv, o);
            if (r32 == 0) ss_out[(size_t)rloc * ss_ld + ss_col0 + nt] = sv; }
    }
    LDS_WAIT(); __syncthreads();
}
__device__ __forceinline__ void skinny_rstd(const Ctx& C, const float* __restrict__ rs, int np, float inv_dim, LAS float* tbl) {
    if (C.tid < 32) { float s = 0.f; const f32x4* p = (const f32x4*)(rs + (size_t)C.tid * np);
        for (int j = 0; j < np / 4; ++j) { const f32x4 v = p[j]; s += (v[0] + v[1]) + (v[2] + v[3]); }
        tbl[C.tid] = rsqrtf(s * inv_dim + RMS_EPS); }
    LDS_WAIT(); __syncthreads();
}

typedef short s16x4 __attribute__((ext_vector_type(4)));
typedef unsigned short u16x4 __attribute__((ext_vector_type(4)));
constexpr int DS_ISC = RING_OFF, DS_ISC_WORDS = 4128, DS_ISC_STRIDE = DS_ISC_WORDS * 4;
constexpr int DS_SEL = DS_ISC + 8 * DS_ISC_STRIDE;
constexpr int DS_BIAS = DS_SEL + 8 * 512;
constexpr int DS_QROW = DS_BIAS + 8192;
constexpr int DS_END = DS_QROW + 256;
constexpr size_t OL_BLOCK = (size_t)3 * 16 * 8 * 64 * 8;
static_assert(DS_END <= LDS_BYTES, "DSA LDS map");

__device__ __forceinline__ void glds16(const void* gsrc, unsigned lds_dst) { unsigned keep;
    asm volatile("s_mov_b32 %0, m0\n\ts_mov_b32 m0, %2\n\ts_nop 0\n\tglobal_load_lds_dwordx4 %1, off\n\ts_mov_b32 m0, %0" : "=&s"(keep) : "v"(gsrc), "s"(lds_dst) : "memory"); }
__device__ __forceinline__ float relu1(float x) { const int i = __float_as_int(x); return __int_as_float(i > 0 ? i : 0); }
__device__ __forceinline__ void glds16o(const void* base, unsigned voff, unsigned lds_dst) { unsigned keep;
    asm volatile("s_mov_b32 %0, m0\n\ts_mov_b32 m0, %3\n\ts_nop 0\n\tglobal_load_lds_dwordx4 %1, %2\n\ts_mov_b32 m0, %0" : "=&s"(keep) : "v"(voff), "s"(base), "s"(lds_dst) : "memory"); }
__device__ __forceinline__ s16x4 tr_read(LAS unsigned char* p) { typedef short v4i16_t __attribute__((ext_vector_type(4))); return __builtin_bit_cast(s16x4, __builtin_amdgcn_ds_read_tr16_b64_v4i16((LAS v4i16_t*)p)); }
__device__ __forceinline__ unsigned cvtpk(float lo, float hi) { typedef float f2_t __attribute__((ext_vector_type(2))); typedef __bf16 b2_t __attribute__((ext_vector_type(2))); f2_t v = {lo, hi}; b2_t b = __builtin_convertvector(v, b2_t); return __builtin_bit_cast(unsigned, b); }

#define DSA_LOCALS() const int w = C.wave; LAS unsigned* ISC = (LAS unsigned*)(C.lds + DS_ISC); LAS unsigned short* sel = (LAS unsigned short*)(C.lds + DS_SEL) + w * 256; const LAS float* biasl = (const LAS float*)(C.lds + DS_BIAS); (void)ISC; (void)sel; (void)biasl
#define RELANE() do { asm volatile("" : "+v"(lane)); asm volatile("" : "+s"(t0), "+s"(b)); } while (0)
__device__ __forceinline__ void dsa_step1(const Ctx& C, const Bufs& B, int b, int t0) {
    int lane = C.lane; RELANE(); DSA_LOCALS();
    PROBE_T0();
    {
        const int r32 = lane & 31, hh = lane >> 5;
        bf16x8 qa[2][4]; float wq[2][2][8];
        const int qi = 2 * ((r32 >> 2) & 1) + (r32 >> 4), hA = (r32 & 3) + 4 * ((r32 >> 3) & 1);
#pragma unroll
        for (int g = 0; g < 2; ++g) { const int row = rowof(b, t0 + 4 * g + qi);
#pragma unroll
            for (int s = 0; s < 4; ++s) qa[g][s] = *(const bf16x8*)(B.Q2 + (size_t)row * NQ2 + 4096 + hA * 64 + 16 * s + 8 * hh);
#pragma unroll
            for (int j = 0; j < 2; ++j) { const int rw = rowof(b, t0 + 4 * g + 2 * hh + j); const v4u ww = *(const v4u*)(B.PROJ + (size_t)rw * NP1 + PC_WIDX);
                const float sc = 0.35355339059327373f * 0.125f;
                wq[g][j][0] = pg8::bf_lo(ww.x) * sc; wq[g][j][1] = pg8::bf_hi(ww.x) * sc; wq[g][j][2] = pg8::bf_lo(ww.y) * sc; wq[g][j][3] = pg8::bf_hi(ww.y) * sc;
                wq[g][j][4] = pg8::bf_lo(ww.z) * sc; wq[g][j][5] = pg8::bf_hi(ww.z) * sc; wq[g][j][6] = pg8::bf_lo(ww.w) * sc; wq[g][j][7] = pg8::bf_hi(ww.w) * sc; } }
        PROBE_T1(40);
        const int nkeys = t0 + 8, nkt = (nkeys + 31) >> 5;
        bf16x8 kA[4], kB[4];
#define IDX_LOAD(dst, kt_) do { const int key_ = (kt_) * 32 + r32, kc_ = key_ < nkeys ? key_ : nkeys - 1; const bf16* kp_ = B.KIDX + (size_t)rowof(b, kc_) * 64 + 8 * hh; \
        asm volatile("global_load_dwordx4 %0, %4, off\n\tglobal_load_dwordx4 %1, %4, off offset:32\n\tglobal_load_dwordx4 %2, %4, off offset:64\n\tglobal_load_dwordx4 %3, %4, off offset:96" \
                     : "=&v"(dst[0]), "=&v"(dst[1]), "=&v"(dst[2]), "=&v"(dst[3]) : "v"(kp_) : "memory"); } while (0)
#define IDX_WAIT(cur) asm volatile("s_waitcnt vmcnt(12)" : "+v"(cur[0]), "+v"(cur[1]), "+v"(cur[2]), "+v"(cur[3]) :: "memory")
#define IDX_TILE(src, kt_) do { const int key_ = (kt_) * 32 + r32; \
        _Pragma("unroll") for (int g = 0; g < 2; ++g) { f32x16 acc = {}; \
            _Pragma("unroll") for (int s = 0; s < 4; ++s) acc = __builtin_amdgcn_mfma_f32_32x32x16_bf16(qa[g][s], src[s], acc, 0, 0, 0); \
            _Pragma("unroll") for (int j = 0; j < 2; ++j) { float isc = 0.f; \
                _Pragma("unroll") for (int h = 0; h < 8; ++h) isc += wq[g][j][h] * relu1(acc[8 * j + h]); \
                ISC[(4 * g + 2 * hh + j) * DS_ISC_WORDS + key_] = f2key(isc); } } } while (0)
        bf16x8 kC[4], kD[4];
        int kt = w;
        const int ktl = nkt - 1;
        if (kt < nkt) {
            __builtin_amdgcn_s_waitcnt(0x0F70);
            IDX_LOAD(kA, kt); IDX_LOAD(kB, (kt + 8 < nkt ? kt + 8 : ktl)); IDX_LOAD(kC, (kt + 16 < nkt ? kt + 16 : ktl));
#define IDX_STEP(cur, nxt) { IDX_LOAD(nxt, (kt + 24 < nkt ? kt + 24 : ktl)); IDX_WAIT(cur); __builtin_amdgcn_sched_barrier(0); IDX_TILE(cur, kt); __builtin_amdgcn_sched_barrier(0); kt += 8; if (kt >= nkt) break; }
#pragma unroll 1
            for (;;) {
                IDX_STEP(kA, kD)
                IDX_STEP(kB, kA)
                IDX_STEP(kC, kB)
                IDX_STEP(kD, kC)
            }
#undef IDX_STEP
            asm volatile("s_waitcnt vmcnt(0)" : "+v"(kA[0]), "+v"(kA[1]), "+v"(kA[2]), "+v"(kA[3]), "+v"(kB[0]), "+v"(kB[1]), "+v"(kB[2]), "+v"(kB[3]) :: "memory");
            asm volatile("" : "+v"(kC[0]), "+v"(kC[1]), "+v"(kC[2]), "+v"(kC[3]), "+v"(kD[0]), "+v"(kD[1]), "+v"(kD[2]), "+v"(kD[3]) :: "memory");
        }
#undef IDX_WAIT
#undef IDX_LOAD
#undef IDX_TILE
        PROBE_T1(41);
    }
}
__device__ __forceinline__ int dsa_step2(const Ctx& C, int b, int t0) {
    int lane = C.lane; RELANE(); DSA_LOCALS();
    const int t = t0 + w, n = t + 1;
    int cnt;
    if (n <= TOPK) { for (int j = lane; j < n; j += 64) sel[j] = (unsigned short)j; cnt = n; }
    else {
        const LAS unsigned* myrow = ISC + w * DS_ISC_WORDS;
        const int nI = (n + 255) >> 8;
        unsigned v[68];
#pragma unroll
        for (int i = 0; i < 17; ++i) { const pg8::u32x4 x = *(const LAS pg8::u32x4*)(myrow + 256 * i + 4 * lane);
#pragma unroll
            for (int e = 0; e < 4; ++e) v[4 * i + e] = (256 * i + 4 * lane + e <= t) ? x[e] : 0u; }
        unsigned T = 0u; bool exact = false;
#define DSA_COUNT(res, cand_) do { int c_ = 0; const unsigned t_ = (cand_); \
        _Pragma("unroll") for (int i = 0; i < 17; ++i) { if (i < nI) { unsigned long long m0_, m1_, m2_, m3_; \
            asm volatile("v_cmp_ge_u32_e64 %1, %5, %9\n\tv_cmp_ge_u32_e64 %2, %6, %9\n\tv_cmp_ge_u32_e64 %3, %7, %9\n\tv_cmp_ge_u32_e64 %4, %8, %9\n\t" \
                         "v_addc_co_u32_e64 %0, %1, 0, %0, %1\n\tv_addc_co_u32_e64 %0, %2, 0, %0, %2\n\tv_addc_co_u32_e64 %0, %3, 0, %0, %3\n\tv_addc_co_u32_e64 %0, %4, 0, %0, %4" \
                         : "+v"(c_), "=&s"(m0_), "=&s"(m1_), "=&s"(m2_), "=&s"(m3_) : "v"(v[4 * i]), "v"(v[4 * i + 1]), "v"(v[4 * i + 2]), "v"(v[4 * i + 3]), "v"(t_)); } } \
        int tot_ = 0; _Pragma("unroll") for (int bt = 0; bt < 7; ++bt) tot_ += __popcll(__ballot((c_ >> bt) & 1)) << bt; res = tot_; } while (0)
        {
            unsigned kmax = 0u, kmin = 0xffffffffu;
#pragma unroll
            for (int i = 0; i < 17; ++i) { if (i < nI) {
#pragma unroll
                for (int e = 0; e < 4; ++e) { const unsigned x = v[4 * i + e]; kmax = x > kmax ? x : kmax; const unsigned y = x ? x : 0xffffffffu; kmin = y < kmin ? y : kmin; } } }
#pragma unroll
            for (int o = 1; o < 64; o <<= 1) { const unsigned a = (unsigned)__shfl_xor((int)kmax, o), bq = (unsigned)__shfl_xor((int)kmin, o); kmax = a > kmax ? a : kmax; kmin = bq < kmin ? bq : kmin; }
#define DSA_K2F(k_) __uint_as_float(((k_) & 0x80000000u) ? ((k_) & 0x7fffffffu) : ~(k_))
            float lo = DSA_K2F(kmin), hi = DSA_K2F(kmax), flo = (float)(n - TOPK), fhi = (float)(1 - TOPK); int side = 0;
#pragma unroll 1
            for (int it = 0; it < 20 && !exact; ++it) {
                float x = (lo * fhi - hi * flo) / (fhi - flo);
                if (!(x > lo && x < hi)) x = 0.5f * (lo + hi);
                if (!(x > lo && x < hi)) break;
                const unsigned cand = f2key(x); int c;
                DSA_COUNT(c, cand);
                if (c == TOPK) { T = cand; exact = true; }
                else if (c > TOPK) { lo = x; flo = (float)(c - TOPK); if (side == 1) fhi *= 0.5f; side = 1; }
                else { hi = x; fhi = (float)(c - TOPK); if (side == -1) flo *= 0.5f; side = -1; }
            }
#undef DSA_K2F
        }
        if (!exact) {
            T = 0u;
#pragma unroll 1
            for (int bit = 31; bit >= 0; --bit) {
                const unsigned cand = T | (1u << bit); int c;
                DSA_COUNT(c, cand);
                if (c >= TOPK) { T = cand; if (c == TOPK) { exact = true; break; } }
            }
            if (!exact) { int c; DSA_COUNT(c, T); exact = (c == TOPK); }
        }
#undef DSA_COUNT
        int base = 0;
#pragma unroll
        for (int k = 0; k < 68; ++k) { const bool p = exact ? (v[k] >= T) : (v[k] > T); const unsigned long long m = __ballot(p);
            const int pos = base + (int)__builtin_amdgcn_mbcnt_hi((unsigned)(m >> 32), __builtin_amdgcn_mbcnt_lo((unsigned)m, 0u));
            if (p) sel[pos] = (unsigned short)(256 * (k >> 2) + 4 * lane + (k & 3));
            base += __popcll(m); }
        if (!exact) {
            int last = -1;
            while (base < TOPK) { int mi = 0x7fffffff;
#pragma unroll
                for (int k = 0; k < 68; ++k) { const int idx = 256 * (k >> 2) + 4 * lane + (k & 3); if (v[k] == T && idx > last && idx < mi) mi = idx; }
#pragma unroll
                for (int o = 1; o < 64; o <<= 1) { const int oth = __shfl_xor(mi, o); mi = oth < mi ? oth : mi; }
                if (lane == 0) sel[base] = (unsigned short)mi;
                last = mi; ++base; }
        }
        cnt = TOPK;
    }
    return cnt;
}
__device__ __forceinline__ void dsa_step3(const Ctx& C, const Bufs& B, int b, int t0, int cnt, int qslot) {
    int lane = C.lane; RELANE(); DSA_LOCALS(); const int t = t0 + w;
    {
        const int g = lane >> 4, c16 = lane & 15, rowq = rowof(b, t);
        bf16x8 qf[8];
#pragma unroll
        for (int s = 0; s < 8; ++s) qf[s] = *(const bf16x8*)(B.Q2 + (size_t)rowq * NQ2 + c16 * 256 + 32 * s + 8 * g);
        f32x4 O[16];
#pragma unroll
        for (int rt = 0; rt < 16; ++rt) O[rt] = (f32x4){0.f, 0.f, 0.f, 0.f};
        float m_ref = 0.f, lsum = 0.f;
        const int buf0 = DS_ISC + w * DS_ISC_STRIDE;
        const int npairs = (cnt + 31) >> 5;
        const int swz = (c16 & 7) << 1;
        const int trow = 4 * g + (c16 >> 2), tswz = (trow & 7) << 1, tp = c16 & 3;
        const int arow = (c16 & 7) * 1024 + (c16 >> 3) * 512, trowo = (trow & 7) * 1024 + (trow >> 3) * 512;
        const unsigned ldsb = (unsigned)(uintptr_t)(C.lds + buf0);
#define DSA_GATHER(c_) do { const unsigned bo_ = (unsigned)__builtin_amdgcn_readfirstlane(ldsb + ((c_) & 1) * 8192); \
        const pg8::u32x4 sp_ = *(const LAS pg8::u32x4*)(sel + 16 * (c_) + 8 * (lane >> 5)); const unsigned spw_[4] = {sp_.x, sp_.y, sp_.z, sp_.w}; \
        _Pragma("unroll") for (int p = 0; p < 8; ++p) { const int j = 16 * (c_) + 8 * (lane >> 5) + p; int pos = (int)((spw_[p >> 1] >> (16 * (p & 1))) & 0xffffu); pos = j < cnt ? pos : 0; \
            const int logical = (lane & 31) ^ (p << 1); \
            glds16o(B.CKVN, (unsigned)rowof(b, pos) * 512u + (unsigned)logical * 16u, bo_ + p * 1024); } } while (0)
        DSA_GATHER(0); DSA_GATHER(1);
#pragma unroll 1
        for (int kp = 0; kp < npairs; ++kp) {
            asm volatile("s_waitcnt vmcnt(0)" ::: "memory");
            bf16x8 a0[8], a1[8]; s16x4 v0[16], v1[16];
#pragma unroll
            for (int s = 0; s < 8; ++s) { const int off = arow + (((4 * s + g) ^ swz) << 4); a0[s] = *(const LAS bf16x8*)(C.lds + buf0 + off); a1[s] = *(const LAS bf16x8*)(C.lds + buf0 + 8192 + off); }
            const u16x4 p0 = *(const LAS u16x4*)(sel + 32 * kp + 4 * g), p1 = *(const LAS u16x4*)(sel + 32 * kp + 16 + 4 * g);
            __builtin_amdgcn_sched_barrier(0);
            f32x4 s0 = {0.f, 0.f, 0.f, 0.f}, s1 = {0.f, 0.f, 0.f, 0.f};
#pragma unroll
            for (int s = 0; s < 8; ++s) { s0 = __builtin_amdgcn_mfma_f32_16x16x32_bf16(a0[s], qf[s], s0, 0, 0, 0); s1 = __builtin_amdgcn_mfma_f32_16x16x32_bf16(a1[s], qf[s], s1, 0, 0, 0); }
            __builtin_amdgcn_sched_barrier(0);
#pragma unroll
            for (int rt = 0; rt < 16; ++rt) { const int off = trowo + (((2 * rt + (tp >> 1)) ^ tswz) << 4) + 8 * (tp & 1); v0[rt] = tr_read(C.lds + buf0 + off); v1[rt] = tr_read(C.lds + buf0 + 8192 + off); }
            __builtin_amdgcn_sched_barrier(0);
            LDS_WAIT(); asm volatile("" ::: "memory");
            if (kp + 1 < npairs) { DSA_GATHER(2 * kp + 2); DSA_GATHER(2 * kp + 3); }
            __builtin_amdgcn_sched_barrier(0);
            float x0[4], x1[4]; float mloc = -INFINITY;
#pragma unroll
            for (int i = 0; i < 4; ++i) { const int j0 = 32 * kp + 4 * g + i, j1 = j0 + 16; int d0 = t - (int)p0[i], d1 = t - (int)p1[i]; d0 = d0 < 0 ? 0 : (d0 > 127 ? 127 : d0); d1 = d1 < 0 ? 0 : (d1 > 127 ? 127 : d1);
                const float b0 = biasl[d0 * 16 + c16], b1 = biasl[d1 * 16 + c16];
                const float y0 = 0.125f * s0[i] + b0, y1 = 0.125f * s1[i] + b1;
                x0[i] = (j0 < cnt) ? y0 : -INFINITY; x1[i] = (j1 < cnt) ? y1 : -INFINITY;
                mloc = fmaxf(mloc, fmaxf(x0[i], x1[i])); }
            mloc = fmaxf(mloc, __shfl_xor(mloc, 16)); mloc = fmaxf(mloc, __shfl_xor(mloc, 32));
            if (kp == 0) m_ref = mloc;
            else if (__any(mloc > m_ref + 8.0f)) { const float mn = fmaxf(m_ref, mloc), al = __expf(m_ref - mn);
#pragma unroll
                for (int rt = 0; rt < 16; ++rt) O[rt] *= al;
                lsum *= al; m_ref = mn; }
            float pe0[4], pe1[4];
#pragma unroll
            for (int i = 0; i < 4; ++i) { pe0[i] = __expf(x0[i] - m_ref); pe1[i] = __expf(x1[i] - m_ref); lsum += pe0[i] + pe1[i]; }
            pg8::u32x4 pw; pw.x = cvtpk(pe0[0], pe0[1]); pw.y = cvtpk(pe0[2], pe0[3]); pw.z = cvtpk(pe1[0], pe1[1]); pw.w = cvtpk(pe1[2], pe1[3]);
            const bf16x8 pf = __builtin_bit_cast(bf16x8, pw);
#pragma unroll
            for (int rt = 0; rt < 16; ++rt) { const bf16x8 af = {v0[rt][0], v0[rt][1], v0[rt][2], v0[rt][3], v1[rt][0], v1[rt][1], v1[rt][2], v1[rt][3]};
                O[rt] = __builtin_amdgcn_mfma_f32_16x16x32_bf16(af, pf, O[rt], 0, 0, 0); }
            LDS_WAIT(); asm volatile("" ::: "memory");
        }
#undef DSA_GATHER
        lsum += __shfl_xor(lsum, 16); lsum += __shfl_xor(lsum, 32);
        const float inv = 1.0f / lsum;
#pragma unroll
        for (int rt = 0; rt < 16; ++rt) { const f32x4 o = O[rt] * inv; pg8::u32x2 wv; wv.x = cvtpk(o[0], o[1]); wv.y = cvtpk(o[2], o[3]);
            const int s_ = rt >> 1, gp = 2 * (rt & 1) + (g >> 1), jo = 4 * (g & 1);
            *(pg8::u32x2*)(B.OLAT + (size_t)C.bid * OL_BLOCK + ((((size_t)(qslot >> 4) * 16 + c16) * 8 + s_) * 64 + gp * 16 + (qslot & 15)) * 8 + jo) = wv; }
    }
}
__device__ __forceinline__ void dsa_wuv(const Ctx& C, const Bufs& B, int l, int nq) {
    const int lane = C.lane, w = C.wave, g = lane >> 4, c16 = lane & 15;
    const LAS int* qrow = (const LAS int*)(C.lds + DS_QROW);
    const int nmt = (nq + 15) >> 4;
#pragma unroll 1
    for (int hq = 0; hq < 2; ++hq) { const int h = 2 * w + hq;
        f32x4 Dv[3][4];
#pragma unroll
        for (int mt = 0; mt < 3; ++mt)
#pragma unroll
            for (int nt = 0; nt < 4; ++nt) Dv[mt][nt] = (f32x4){0.f, 0.f, 0.f, 0.f};
        const bf16* wb = B.WUV + (((size_t)l * 16 + h) * 32) * 512 + lane * 8;
        const bf16* ab = B.OLAT + (size_t)C.bid * OL_BLOCK + ((size_t)h * 8) * 512 + lane * 8;
        v4u zw[3][2];
        { const int slot = lane >> 2, d0 = (lane & 3) * 16;
#pragma unroll
          for (int mt = 0; mt < 3; ++mt) { const int q = mt * 16 + slot; const int row = qrow[q < nq ? q : 0];
#pragma unroll
              for (int hf = 0; hf < 2; ++hf) zw[mt][hf] = *(const v4u*)(B.PROJ + (size_t)row * NP1 + PC_ZB + h * 64 + d0 + 8 * hf); } }
        bf16x8 bwA[4], awA[3], bwB[4], awB[3];
#define WUV_LOAD(bw_, aw_, s_) do { _Pragma("unroll") for (int nt = 0; nt < 4; ++nt) bw_[nt] = *(const bf16x8*)(wb + ((s_) * 4 + nt) * 512); \
        _Pragma("unroll") for (int mt = 0; mt < 3; ++mt) { aw_[mt] = *(const bf16x8*)(ab + ((size_t)mt * 16 * 8 + (s_)) * 512);     } } while (0)
#define WUV_MMA(bw_, aw_) do { _Pragma("unroll") for (int mt = 0; mt < 3; ++mt) _Pragma("unroll") for (int nt = 0; nt < 4; ++nt) Dv[mt][nt] = __builtin_amdgcn_mfma_f32_16x16x32_bf16(aw_[mt], bw_[nt], Dv[mt][nt], 0, 0, 0); } while (0)
        WUV_LOAD(bwA, awA, 0);
#pragma unroll
        for (int s = 0; s < 8; s += 2) {
            WUV_LOAD(bwB, awB, s + 1);
            __builtin_amdgcn_sched_barrier(0);
            WUV_MMA(bwA, awA);
            __builtin_amdgcn_sched_barrier(0);
            if (s + 2 < 8) WUV_LOAD(bwA, awA, s + 2);
            __builtin_amdgcn_sched_barrier(0);
            WUV_MMA(bwB, awB);
            __builtin_amdgcn_sched_barrier(0);
        }
#undef WUV_LOAD
#undef WUV_MMA
        LAS float* stg = (LAS float*)(C.lds + RING_OFF + w * 4608);
#pragma unroll
        for (int mt = 0; mt < 3; ++mt) { if (mt < nmt) {
#pragma unroll
            for (int nt = 0; nt < 4; ++nt)
#pragma unroll
                for (int i = 0; i < 4; ++i) stg[(4 * g + i) * 68 + 16 * nt + c16] = Dv[mt][nt][i];
            LDS_WAIT(); asm volatile("" ::: "memory");
            const int slot = lane >> 2, q = mt * 16 + slot, d0 = (lane & 3) * 16;
            if (q < nq) { const int row = qrow[q]; const v4u zw_[2] = {zw[mt][0], zw[mt][1]};
                bf16* op = B.YB + (size_t)row * YLD + h * 64 + d0;
#pragma unroll
                for (int hf = 0; hf < 2; ++hf) { const v4u zw = zw_[hf];
                    const f32x4 xa = *(const LAS f32x4*)(stg + slot * 68 + d0 + 8 * hf), xb = *(const LAS f32x4*)(stg + slot * 68 + d0 + 8 * hf + 4);
                    v4u o; o.x = pk2(xa[0] * siluf_(pg8::bf_lo(zw.x)), xa[1] * siluf_(pg8::bf_hi(zw.x))); o.y = pk2(xa[2] * siluf_(pg8::bf_lo(zw.y)), xa[3] * siluf_(pg8::bf_hi(zw.y)));
                    o.z = pk2(xb[0] * siluf_(pg8::bf_lo(zw.z)), xb[1] * siluf_(pg8::bf_hi(zw.z))); o.w = pk2(xb[2] * siluf_(pg8::bf_lo(zw.w)), xb[3] * siluf_(pg8::bf_hi(zw.w)));
                    *(v4u*)(op + 8 * hf) = o; } }
            LDS_WAIT(); asm volatile("" ::: "memory"); } }
    }
}
#ifndef MK_DSUB
#define MK_DSUB 0
#endif
__device__ __forceinline__ void dsa_unit(const Ctx& C, const Bufs& B, int l, int b, int t0, int uidx) {
    { PROBE_T0(); for (int rep = 0; rep < ((MK_DSUB & 1) ? 2 : 1); ++rep) { dsa_step1(C, B, b, t0); LDS_WAIT(); PROBE_T1(10); __syncthreads(); } PROBE_T1(0); }
    int cnt = 0;
    { PROBE_T0(); for (int rep = 0; rep < ((MK_DSUB & 2) ? 2 : 1); ++rep) { cnt = dsa_step2(C, b, t0); LDS_WAIT(); asm volatile("" ::: "memory"); } PROBE_T1(1); }
    if (C.lane == 0) ((LAS int*)(C.lds + DS_QROW))[uidx * 8 + C.wave] = rowof(b, t0 + C.wave);
    { PROBE_T0(); for (int rep = 0; rep < ((MK_DSUB & 4) ? 2 : 1); ++rep) { dsa_step3(C, B, b, t0, cnt, uidx * 8 + C.wave); } PROBE_T1(2); }
    { PROBE_T0(); LDS_WAIT(); __syncthreads(); PROBE_T1(7); }
}
#undef RELANE
#undef DSA_LOCALS

__device__ __forceinline__ void dsa_phase(const Ctx& C, int l) {
    const Bufs B(kargs()->ws);
    const KArgs& A = *kargs();
    for (int i = C.tid; i < 128 * 16; i += NWAVES * 64) { const int dd = i >> 4, h = i & 15; ((LAS float*)(C.lds + DS_BIAS))[i] = A.bias_table[t5_bucket(dd) * 32 + 16 + h]; }
    __syncthreads();
    gu32* qctr = (gu32*)(A.ws + WS_CTL) + CW_DSAQ + l * 128;
    LAS int* qslot = (LAS int*)(C.lds + DS_QROW) + 56;
    int nu = 0, myb = C.bid & 1; bool other = false;
    for (;;) {
        if (C.tid == 0) { int s = (int)__hip_atomic_fetch_add(qctr + myb * 64, 1u, __ATOMIC_RELAXED, __HIP_MEMORY_SCOPE_AGENT);
            if (s >= 514 && !other) { s = (int)__hip_atomic_fetch_add(qctr + (myb ^ 1) * 64, 1u, __ATOMIC_RELAXED, __HIP_MEMORY_SCOPE_AGENT); s = s < 514 ? s + 1024 : -1; }
            else if (s >= 514) s = -1;
            qslot[0] = s; }
        LDS_WAIT(); __syncthreads();
        int s = qslot[0];
        __syncthreads();
        const bool done = s < 0;
        if ((done && nu > 0) || nu == 6) {
            VM_WAIT(); LDS_WAIT(); __syncthreads(); { PROBE_T0(); dsa_wuv(C, B, l, nu * 8); PROBE_T1(3); } __syncthreads(); nu = 0; }
        if (done) break;
        int b = myb;
        if (s >= 1024) { s -= 1024; if (!other) { other = true; myb ^= 1; } b = myb; }
        dsa_unit(C, B, l, b, 8 * (513 - s), nu); ++nu;
    }
    __syncthreads();
}

constexpr int VT_PITCH = 4128;
constexpr int SW_BIAS = RING_OFF;
constexpr int SW_WS = SW_BIAS + 8192;
constexpr int SW_STG = SW_WS + 1024;

constexpr int SW_Q = SW_STG, SW_WAVE = 16384, SW_SLOT = 4096;
__device__ __forceinline__ void swa_item(const Ctx& C, const Bufs& B, const float* __restrict__ sinks, int b, int head, int p0, bool meta) {
    const int lane = C.lane, r32 = lane & 31, hh = lane >> 5, g = head >> 3;
    const LAS float* biasl = (const LAS float*)(C.lds + SW_BIAS);
    LAS float* wsf = (LAS float*)(C.lds + SW_WS) + C.wave * 32;
    LAS unsigned char* wl = C.lds + SW_Q + C.wave * SW_WAVE;
    const unsigned wlb = (unsigned)__builtin_amdgcn_readfirstlane((unsigned)(uintptr_t)(C.lds + SW_Q) + (unsigned)C.wave * SW_WAVE);
    const int tq = p0 + r32;
    const int ntile = meta ? 1 : 6;
    PROBE_T0();
    const int prow = lane >> 3, pch = lane & 7, vrow = lane >> 2, vch = lane & 3;
#define SW_DMA_K(kt_, slot_) do { const int k0_ = ((kt_) == 0) ? 0 : p0 - 128 + 32 * ((kt_) - 1); \
        _Pragma("unroll") for (int p = 0; p < 4; ++p) { const int r_ = 8 * p + prow; int kp_ = k0_ + r_; kp_ = kp_ < 0 ? 0 : kp_; \
            glds16o(B.KV, (unsigned)rowof(b, kp_) * 512u + (unsigned)(g * 128 + ((pch ^ ((r_ >> 1) & 7)) << 4)), wlb + 4096u + (unsigned)(slot_) * SW_SLOT + p * 1024); } } while (0)
#define SW_DMA_V(kt_, slot_) do { const int k0_ = ((kt_) == 0) ? 0 : p0 - 128 + 32 * ((kt_) - 1); \
        _Pragma("unroll") for (int p = 0; p < 4; ++p) { const int r_ = 16 * p + vrow; int ks_ = k0_ + 8 * (vch ^ ((r_ >> 2) & 3)); ks_ = ks_ < 0 ? 0 : ks_; \
            glds16o(B.VT, (unsigned)((b * 128 + g * 64 + r_) * VT_PITCH + ks_) * 2u, wlb + 4096u + (unsigned)(slot_) * SW_SLOT + p * 1024); } } while (0)
    {
#pragma unroll
        for (int p = 0; p < 4; ++p) { const int r_ = 8 * p + prow; int tqq = p0 + r_; if (meta) tqq = tqq < NMETA ? tqq : NMETA - 1;
            glds16o(B.PROJ, ((unsigned)rowof(b, tqq) * (unsigned)NP1 + (unsigned)(PC_QA + head * 64)) * 2u + (unsigned)((pch ^ ((r_ >> 1) & 7)) << 4), wlb + p * 1024); }
    }
    SW_DMA_K(0, 0);
    if (!meta) { SW_DMA_K(1, 1); SW_DMA_K(2, 2); }
    const int foff = r32 * 128, fsw = (r32 >> 1) & 7;
    bf16x8 qf[4];
    if (meta) asm volatile("s_waitcnt vmcnt(0)" ::: "memory"); else asm volatile("s_waitcnt vmcnt(8)" ::: "memory");
#pragma unroll
    for (int s = 0; s < 4; ++s) qf[s] = *(const LAS bf16x8*)(wl + foff + (((2 * s + hh) ^ fsw) << 4));
    f32x16 S[6];
#pragma unroll
    for (int kt = 0; kt < 6; ++kt) {
        if (kt < ntile) {
            if (meta || kt >= 4) { if (kt == 4) asm volatile("s_waitcnt vmcnt(4)" ::: "memory"); else asm volatile("s_waitcnt vmcnt(0)" ::: "memory"); }
            else asm volatile("s_waitcnt vmcnt(8)" ::: "memory");
            bf16x8 kf[4];
#pragma unroll
            for (int s = 0; s < 4; ++s) kf[s] = *(const LAS bf16x8*)(wl + 4096 + (kt % 3) * SW_SLOT + foff + (((2 * s + hh) ^ fsw) << 4));
            __builtin_amdgcn_sched_barrier(0);
            f32x16 acc = {};
#pragma unroll
            for (int s = 0; s < 4; ++s) acc = __builtin_amdgcn_mfma_f32_32x32x16_bf16(kf[s], qf[s], acc, 0, 0, 0);
            S[kt] = acc;
            LDS_WAIT(); asm volatile("" ::: "memory");
            if (kt + 3 < ntile) SW_DMA_K(kt + 3, kt % 3);
        } else S[kt] = (f32x16){-INFINITY, -INFINITY, -INFINITY, -INFINITY, -INFINITY, -INFINITY, -INFINITY, -INFINITY, -INFINITY, -INFINITY, -INFINITY, -INFINITY, -INFINITY, -INFINITY, -INFINITY, -INFINITY};
    }
    PROBE_T1(50);
    SW_DMA_V(0, 0);
    if (!meta) { SW_DMA_V(1, 1); SW_DMA_V(2, 2); }
#pragma unroll
    for (int kt = 0; kt < 6; ++kt) {
        if (kt < ntile) {
            const int k0 = (kt == 0) ? 0 : p0 - 128 + 32 * (kt - 1);
            float bz[16];
#pragma unroll
            for (int i = 0; i < 16; ++i) { const int kp = k0 + (i & 3) + 8 * (i >> 2) + 4 * hh; int d = tq - kp; d = d < 0 ? 0 : (d > 127 ? 127 : d); bz[i] = biasl[head * 128 + d]; }
#pragma unroll
            for (int i = 0; i < 16; ++i) { const int kp = k0 + (i & 3) + 8 * (i >> 2) + 4 * hh; const int d = tq - kp;
                const bool ok = (kt == 0) ? (kp < NMETA && d >= 0) : (kp >= NMETA && d >= 0 && d < 128);
                const float x = 0.125f * S[kt][i] + bz[i];
                S[kt][i] = ok ? x : -INFINITY; }
        }
    }
    const float sink = sinks[head];
    float mx = sink;
#pragma unroll
    for (int kt = 0; kt < 6; ++kt)
#pragma unroll
        for (int i = 0; i < 16; ++i) mx = fmaxf(mx, S[kt][i]);
    mx = fmaxf(mx, __shfl_xor(mx, 32));
    float sum = 0.f;
#pragma unroll
    for (int kt = 0; kt < 6; ++kt)
#pragma unroll
        for (int i = 0; i < 16; ++i) { const float p = __expf(S[kt][i] - mx); S[kt][i] = p; sum += p; }
    sum += __shfl_xor(sum, 32);
    sum += __expf(sink - mx);
    if (hh == 0) wsf[r32] = sum;
    PROBE_T1(51);
    f32x16 O0 = {}, O1 = {};
#pragma unroll
    for (int kt = 0; kt < 6; ++kt) {
        if (kt < ntile) {
            if (meta || kt >= 4) { if (kt == 4) asm volatile("s_waitcnt vmcnt(4)" ::: "memory"); else asm volatile("s_waitcnt vmcnt(0)" ::: "memory"); }
            else asm volatile("s_waitcnt vmcnt(8)" ::: "memory");
            pg8::u32x2 vl[2][2], vh[2][2];
#pragma unroll
            for (int s2 = 0; s2 < 2; ++s2)
#pragma unroll
                for (int dt = 0; dt < 2; ++dt) { const int r_ = 32 * dt + r32; const LAS unsigned char* vp = wl + 4096 + (kt % 3) * SW_SLOT + r_ * 64 + 8 * hh; const int sw_ = (r_ >> 2) & 3;
                    vl[s2][dt] = *(const LAS pg8::u32x2*)(vp + (((2 * s2) ^ sw_) << 4)); vh[s2][dt] = *(const LAS pg8::u32x2*)(vp + (((2 * s2 + 1) ^ sw_) << 4)); }
            __builtin_amdgcn_sched_barrier(0);
#pragma unroll
            for (int s2 = 0; s2 < 2; ++s2) {
                pg8::u32x4 pw; pw.x = cvtpk(S[kt][8 * s2 + 0], S[kt][8 * s2 + 1]); pw.y = cvtpk(S[kt][8 * s2 + 2], S[kt][8 * s2 + 3]); pw.z = cvtpk(S[kt][8 * s2 + 4], S[kt][8 * s2 + 5]); pw.w = cvtpk(S[kt][8 * s2 + 6], S[kt][8 * s2 + 7]);
                const bf16x8 pf = __builtin_bit_cast(bf16x8, pw);
#pragma unroll
                for (int dt = 0; dt < 2; ++dt) { const pg8::u32x4 vw = {vl[s2][dt].x, vl[s2][dt].y, vh[s2][dt].x, vh[s2][dt].y}; const bf16x8 vf = __builtin_bit_cast(bf16x8, vw);
                    if (dt == 0) O0 = __builtin_amdgcn_mfma_f32_32x32x16_bf16(pf, vf, O0, 0, 0, 0); else O1 = __builtin_amdgcn_mfma_f32_32x32x16_bf16(pf, vf, O1, 0, 0, 0); }
            }
            LDS_WAIT(); asm volatile("" ::: "memory");
            if (kt + 3 < ntile) SW_DMA_V(kt + 3, kt % 3);
            __builtin_amdgcn_sched_barrier(0);
        }
    }
#undef SW_DMA_K
#undef SW_DMA_V
    PROBE_T1(52);
    LDS_WAIT(); asm volatile("" ::: "memory");
    LAS float* stg = (LAS float*)(wl + 4096);
#pragma unroll
    for (int i = 0; i < 16; ++i) { const int q = (i & 3) + 8 * (i >> 2) + 4 * hh; stg[q * 68 + r32] = O0[i]; stg[q * 68 + 32 + r32] = O1[i]; }
    LDS_WAIT(); asm volatile("" ::: "memory");
    { const int q = lane >> 1, d0 = (lane & 1) * 32, t = p0 + q;
      if (!meta || t < NMETA) { const int row = rowof(b, t); const float inv = 1.0f / wsf[q];
          const bf16* zp = B.PROJ + (size_t)row * NP1 + PC_ZA + head * 64 + d0; bf16* op = B.YA + (size_t)row * YLD + head * 64 + d0;
#pragma unroll
          for (int hf = 0; hf < 4; ++hf) { const v4u zw = *(const v4u*)(zp + 8 * hf);
              const f32x4 xa = *(const LAS f32x4*)(stg + q * 68 + d0 + 8 * hf) * inv, xb = *(const LAS f32x4*)(stg + q * 68 + d0 + 8 * hf + 4) * inv;
              v4u o; o.x = pk2(xa[0] * siluf_(pg8::bf_lo(zw.x)), xa[1] * siluf_(pg8::bf_hi(zw.x))); o.y = pk2(xa[2] * siluf_(pg8::bf_lo(zw.y)), xa[3] * siluf_(pg8::bf_hi(zw.y)));
              o.z = pk2(xb[0] * siluf_(pg8::bf_lo(zw.z)), xb[1] * siluf_(pg8::bf_hi(zw.z))); o.w = pk2(xb[2] * siluf_(pg8::bf_lo(zw.w)), xb[3] * siluf_(pg8::bf_hi(zw.w)));
              *(v4u*)(op + 8 * hf) = o; } } }
    LDS_WAIT(); asm volatile("" ::: "memory");
}

__device__ __forceinline__ void swa_phase(const Ctx& C, int l) {
    const Bufs B(kargs()->ws);
    const KArgs& A = *kargs();
    __syncthreads();
    for (int i = C.tid; i < 128 * 16; i += NWAVES * 64) { const int h = i >> 7, d = i & 127; ((LAS float*)(C.lds + SW_BIAS))[i] = A.bias_table[t5_bucket(d) * 32 + h]; }
    __syncthreads();
    const float* sinks = A.sinks + l * 16;
    for (int it = C.gw; it < 4096 + 32; it += C.NGW) {
        if (it < 4096) { const int blk = it & 127, head = (it >> 7) & 15, b = it >> 11; swa_item(C, B, sinks, b, head, NMETA + 32 * blk, false); }
        else { const int r = it - 4096, head = r & 15, b = r >> 4; swa_item(C, B, sinks, b, head, 0, true); }
    }
    __syncthreads();
}


constexpr int PH_PER_LAYER = 5, N_PHASES = 1 + NLAYER * PH_PER_LAYER + 1;
#ifndef MK_DUP
#define MK_DUP 0
#endif
#ifndef MK_NAIVE_SWA
#define MK_NAIVE_SWA 0
#endif
#ifndef MK_NAIVE_DSA
#define MK_NAIVE_DSA 0
#endif
#ifndef MK_ONE_LAUNCH
#define MK_ONE_LAUNCH 1
#endif

__global__ void __launch_bounds__(NWAVES * 64, 2) fwd_kernel(Args args) {
    extern __shared__ __attribute__((aligned(16))) unsigned char lds[];
    Ctx C;
    C.lds = (LAS unsigned char*)lds; C.tid = threadIdx.x; C.lane = C.tid & 63; C.wave = __builtin_amdgcn_readfirstlane(C.tid >> 6);
    const int wave0 = C.wave;
    C.G = gridDim.x; C.bid = blockIdx.x; C.gw = blockIdx.x * NWAVES + C.wave; C.NGW = C.G * NWAVES;
    unsigned char* ws = args.ws;
    gu32* ctl = (gu32*)(ws + WS_CTL);
    for (int u = C.tid; u < RING_OFF / 4; u += NWAVES * 64) ((LAS unsigned*)(C.lds + LDSCTL_OFF))[u] = 0u;
    __syncthreads();
    volatile LAS unsigned* MISC = (volatile LAS unsigned*)(C.lds + MISC_OFF);
    XcdBarrier bar; bar.bar = (unsigned*)(ctl + CW_BAR); bar.x = 0; bar.st = nullptr;
    const int lo = args.ph_lo, hi = args.ph_hi;
    const bool one = (hi - lo) > 1;
    if (one) bar = xcd_barrier_post((unsigned*)(ctl + CW_BAR), MISC + 8);
#define IN(k) (lo <= (k) && (k) < hi)
#define PHASE_BEGIN() do { int l_ = (int)__builtin_amdgcn_mbcnt_hi(~0u, __builtin_amdgcn_mbcnt_lo(~0u, 0u)); asm volatile("" : "+v"(l_)); int b_ = blockIdx.x; asm volatile("" : "+s"(b_)); \
    int w_ = wave0; asm volatile("" : "+s"(w_)); C.wave = w_; C.lane = l_; C.tid = w_ * 64 + l_; C.bid = b_; C.gw = b_ * NWAVES + w_; } while (0)
#define SEAM(k) do { if (IN((k) + 1)) { PROBE_T0(); XcdBarrier b2_ = bar; b2_.bar = (unsigned*)launder((unsigned char*)bar.bar);     \
    xcd_barrier(b2_, C.wave == 0 && (int)__builtin_amdgcn_mbcnt_hi(~0u, __builtin_amdgcn_mbcnt_lo(~0u, 0u)) == 0); PROBE_T1(29); PROBE_T1(60 + ((k) == 0 ? 5 : ((k) - 1) % PH_PER_LAYER)); if (MK_DUP & 256) xcd_barrier(b2_, C.wave == 0 && (int)__builtin_amdgcn_mbcnt_hi(~0u, __builtin_amdgcn_mbcnt_lo(~0u, 0u)) == 0); } } while (0)
    LAS unsigned char* ring = C.lds + RING_OFF;

    if (IN(0)) { PROBE_T0(); PHASE_BEGIN(); p0_prologue(C); PROBE_T1(20); if (MK_DUP & 128) { PHASE_BEGIN(); p0_prologue(C); } SEAM(0); }
    for (int l = 0; l < NLAYER; ++l) {
        const int p = 1 + l * PH_PER_LAYER;
        if (IN(p)) {
            PHASE_BEGIN(); const Bufs B(kargs()->ws);
            const bf16* W1l = B.W1 + (size_t)l * NP1 * DM;
            pg8::Gemm g{B.HB, W1l, MR, 8192, DM}; pg8::StaticOrder S; S.init(MR, 8192, C.G, C.bid);
            rstd_table<8>(C, S, B.RS, 1.0f / DM);
            pg8::EpiProjT<true> E{B.PROJ, NP1, (const LAS float*)(C.lds + RSTD_OFF), B.KV, B.RSQ, B.RHO, B.SGB};
            { PROBE_T0(); pg8::gemm_phase<pg8::EpiProjT<true>, pg8::StaticOrder, true, true>(ring, g, S, E, C.tid); PROBE_T1(21); }
            PHASE_BEGIN();
            LAS float* tbl = (LAS float*)(C.lds + RSTD_OFF);
            PROBE_T0();
            for (int u = C.bid; u < 256 + 259; u += C.G) {
                if (u < 256) { const int row0 = 32 * u; skinny_rstd(C, B.RS + (size_t)row0 * 32, 32, 1.0f / DM, tbl);
                    skinny_unit<3, 1>(C, B.HB + (size_t)row0 * DM, DM, W1l + (size_t)8192 * DM, DM, DM, nullptr, 0, 0, SkProj{B.PROJ + (size_t)row0 * NP1, B.KV + (size_t)row0 * 256, B.KIDX + (size_t)row0 * 64, 8192, tbl}); }
                else { const int gc = u - 256; skinny_rstd(C, B.RS2, 64, 1.0f / DM, tbl);
                    const SkProj E2{B.PROJ + (size_t)MR * NP1, B.KV + (size_t)MR * 256, B.KIDX + (size_t)MR * 64, gc * 32, tbl};
                    const bool sqc = gc >= 72 && gc < 88;
                    skinny_unit<1, 4>(C, B.HB + (size_t)MR * DM, DM, W1l + (size_t)gc * 32 * DM, DM, DM, sqc ? B.RSQ2 : nullptr, 16, gc - 72, E2); }
            }
            PROBE_T1(22);
            SEAM(p);
        }
        if (IN(p + 1)) {
            PHASE_BEGIN(); const Bufs B(kargs()->ws);
            const bf16* W2l = B.W2 + (size_t)l * NQ2 * 512;
            pg8::Gemm g{B.PROJ + PC_CQ, W2l, MR, NQ2, 512, nullptr, nullptr, NP1}; pg8::StaticOrder S; S.init(MR, NQ2, C.G, C.bid);
            rstd_table<2>(C, S, B.RSQ, 1.0f / 512.0f);
            pg8::EpiProjT<false> E{B.Q2, NQ2, (const LAS float*)(C.lds + RSTD_OFF), nullptr, nullptr, nullptr, nullptr};
            PROBE_T0();
            pg8::gemm_phase<pg8::EpiProjT<false>, pg8::StaticOrder, true, true>(ring, g, S, E, C.tid);
            PHASE_BEGIN();
            { LAS float* tbl = (LAS float*)(C.lds + RSTD_OFF);
              const int sb = (C.G == 256) ? C.bid - 64 : C.bid;
              for (int u = sb; u >= 0 && u < 48; u += C.G) { skinny_rstd(C, B.RSQ2, 16, 1.0f / 512.0f, tbl);
                skinny_unit<3, 1>(C, B.PROJ + (size_t)MR * NP1 + PC_CQ, NP1, W2l + (size_t)u * 96 * 512, 512, 512, nullptr, 0, 0, SkQ2{B.Q2 + (size_t)MR * NQ2 + u * 96, tbl}); } }
            PHASE_BEGIN(); norm_tail(C, l);
            PROBE_T1(24);
            SEAM(p + 1);
        }
        if (IN(p + 2)) {
            { PROBE_T0(); PHASE_BEGIN(); swa_phase(C, l); PROBE_T1(5); }
            if (MK_DUP & 8) { PHASE_BEGIN(); swa_phase(C, l); }
            { PROBE_T0(); PHASE_BEGIN(); dsa_phase(C, l); PROBE_T1(4); }
            if (MK_DUP & 16) { PHASE_BEGIN(); dsa_phase(C, l); }
            SEAM(p + 2);
        }
        if (IN(p + 3)) {
            PHASE_BEGIN(); const Bufs B(kargs()->ws);
            const bf16* WABl = B.WA + (size_t)l * DM * 2048;
            pg8::Gemm g{B.YA, WABl, MR, DM, 2048, nullptr, nullptr, 0}; pg8::StaticOrder S; S.init(MR, DM, C.G, C.bid);
            pg8::EpiG4m E{B.MG, B.RHO, B.SGB};
            PROBE_T0();
            pg8::gemm_phase<pg8::EpiG4m, pg8::StaticOrder, true, true>(ring, g, S, E, C.tid);
            PROBE_T1(35);
            PHASE_BEGIN();
            for (int u = C.bid; u < 64; u += C.G) {
                skinny_unit<1, 2>(C, B.YA + (size_t)MR * YLD, YLD, WABl + (size_t)u * 32 * 2048, 2048, 1024, nullptr, 0, 0, SkPA{B.PA + (size_t)MR * DM + u * 32, B.PROJ + (size_t)MR * NP1 + 4096, u * 32});
                skinny_unit<1, 2>(C, B.YB + (size_t)MR * YLD, YLD, WABl + 1024 + (size_t)u * 32 * 2048, 2048, 1024, nullptr, 0, 0, SkMerge{B.MG + (size_t)MR * DM + u * 32, B.PA + (size_t)MR * DM + u * 32, B.PROJ + (size_t)MR * NP1 + 4096, u * 32}); }
            PROBE_T1(25);
            SEAM(p + 3);
        }
        if (MK_PROBE >= 0 && l == NLAYER - 1 && C.bid == MK_PROBE_BLOCK && C.wave == 0 && C.lane == 0) __hip_atomic_store((gu32*)(kargs()->ws + WS_CTL) + 3, ((volatile LAS unsigned*)(C.lds + MISC_OFF + 64))[0], RLX_AGENT);
        if (IN(p + 4)) {
            PHASE_BEGIN(); const Bufs B(kargs()->ws);
            const bf16* WOl = B.WO + (size_t)l * DM * DM;
            pg8::Gemm g{B.MG, WOl, MR, DM, DM}; pg8::StaticOrder S; S.init(MR, DM, C.G, C.bid);
            pg8::EpiRes E{B.HB, B.RS};
            PROBE_T0();
            pg8::gemm_phase<pg8::EpiRes, pg8::StaticOrder, true, true>(ring, g, S, E, C.tid);
            PROBE_T1(37);
            PHASE_BEGIN();
            for (int u = C.bid; u < 64; u += C.G) skinny_unit<1, 4>(C, B.MG + (size_t)MR * DM, DM, WOl + (size_t)u * 32 * DM, DM, DM, B.RS2, 64, u, SkRes{B.HB + (size_t)MR * DM + u * 32});
            PROBE_T1(27);
            SEAM(p + 4);
        }
    }
    if (IN(N_PHASES - 1)) { PHASE_BEGIN(); final_phase(C); }
#undef IN
#undef SEAM
}

extern "C" void kernel_launch(void* const* d_in, const int* in_sizes, int n_in, void* d_out, int out_size, void* d_ws, size_t ws_size, hipStream_t stream) {
    static int grid = 0;
    if (grid == 0) {
        if (n_in != 16 || ws_size < WS_END) { fprintf(stderr, "kernel_launch: unexpected inputs (n_in %d, ws %zu, need %zu)\n", n_in, ws_size, (size_t)WS_END); grid = -1; return; }
        int dev = 0, cus = 0;
        if (hipGetDevice(&dev) != hipSuccess || hipDeviceGetAttribute(&cus, hipDeviceAttributeMultiprocessorCount, dev) != hipSuccess) { grid = -1; return; }
        if (hipFuncSetAttribute((const void*)fwd_kernel, hipFuncAttributeMaxDynamicSharedMemorySize, LDS_BYTES) != hipSuccess) { fprintf(stderr, "kernel_launch: hipFuncSetAttribute failed\n"); grid = -1; return; }
        int per_cu = 0;
        if (hipOccupancyMaxActiveBlocksPerMultiprocessor(&per_cu, (const void*)fwd_kernel, NWAVES * 64, LDS_BYTES) != hipSuccess || per_cu < 1) fprintf(stderr, "kernel_launch: occupancy query says %d\n", per_cu);
        (void)hipGetLastError();
        grid = cus;
    }
    if (grid < 0) return;
    if (hipMemsetAsync((char*)d_ws + WS_CTL, 0, CTL_ZERO_BYTES, stream) != hipSuccess) return;
    Args a{};
    a.x = (const float*)d_in[0]; a.meta = (const float*)d_in[1]; a.bias_table = (const float*)d_in[2]; a.norm_g = (const float*)d_in[3]; a.w_in = (const float*)d_in[4];
    a.q_norm_g = (const float*)d_in[5]; a.kv_norm_g = (const float*)d_in[6]; a.w_qb = (const float*)d_in[7]; a.w_iq = (const float*)d_in[8]; a.w_uk = (const float*)d_in[9];
    a.w_uv = (const float*)d_in[10]; a.sinks = (const float*)d_in[11]; a.w_proj_a = (const float*)d_in[12]; a.w_proj_b = (const float*)d_in[13]; a.w_out = (const float*)d_in[14];
    a.final_g = (const float*)d_in[15]; a.out = (float*)d_out; a.ws = (unsigned char*)d_ws;
#if MK_ONE_LAUNCH
    a.ph_lo = 0; a.ph_hi = N_PHASES;
    hipLaunchKernelGGL(fwd_kernel, dim3(grid), dim3(NWAVES * 64), LDS_BYTES, stream, a);
#else
    for (int p = 0; p < N_PHASES; ++p) { a.ph_lo = p; a.ph_hi = p + 1; hipLaunchKernelGGL(fwd_kernel, dim3(grid), dim3(NWAVES * 64), LDS_BYTES, stream, a); }
#endif
}
```

```cpp
#include <hip/hip_runtime.h>
#include <cstdio>
#include <cstdint>
namespace pg8 {
#define PG8_LAS __attribute__((address_space(3)))
typedef unsigned short bf16_t;
typedef short bf16x8 __attribute__((ext_vector_type(8)));
typedef float f32x4 __attribute__((ext_vector_type(4)));
typedef unsigned u32x4 __attribute__((ext_vector_type(4)));
constexpr int BM = 256, BK = 64, HALF = 128, HTB = HALF * BK * 2  , STAGE_BYTES = 8 * HTB, NXCD = 8, WGM = 8;

__host__ __device__ __forceinline__ int lds_byte(int r, int c) { const int st = (r >> 4) * 2 + (c >> 5), rr = r & 15, cc = c & 31, ob = rr * 64 + cc * 2; return st * 1024 + (ob ^ (((ob >> 9) & 1) << 5)); }
__host__ __device__ __forceinline__ void stage_rc(int b, int& R, int& C) { const int st = b / 1024, sb = b % 1024, swz = sb ^ (((sb >> 9) & 1) << 5); R = (st >> 1) * 16 + swz / 64; C = (st & 1) * 32 + (swz % 64) / 2; }
__host__ __device__ __forceinline__ int perm32(int rho) { const int n = rho >> 4, i = rho & 15; return 8 * (i >> 2) + 4 * n + (i & 3); }

struct Unit { int pm, pn, sel; };
struct Gemm { const bf16_t* A; const bf16_t* Bt; int M, N, K; const bf16_t* A2; const bf16_t* Bt2; int lda; };

struct StaticOrder {
    int nM, nN, nwg, G, c;
    __host__ __device__ void init(int M, int N, int G_, int c_) { nM = M / BM; nN = N / BM; nwg = nM * nN; G = G_; c = c_; }
    __host__ __device__ bool next(int i, Unit& u) const {
        const long L = (long)i * G + c; if (L >= nwg) return false;
        int wgid = (int)L; { const int q = nwg / NXCD, r = nwg % NXCD, xcd = wgid % NXCD, off = wgid / NXCD; wgid = (xcd < r ? xcd * (q + 1) : r * (q + 1) + (xcd - r) * q) + off; }
        const int nig = WGM * nN, gid = wgid / nig, fm = gid * WGM, gsz = (nM - fm) < WGM ? (nM - fm) : WGM;
        u.pm = fm + ((wgid % nig) % gsz); u.pn = (wgid % nig) / gsz; u.sel = 0; return true;
    }
    __device__ __forceinline__ void a_ready(const Unit&) const {}
    __device__ __forceinline__ void done(const Unit&) const {}
};

__device__ __forceinline__ unsigned cvt_pk_bf16(float lo, float hi) { unsigned r; asm volatile("v_cvt_pk_bf16_f32 %0, %1, %2" : "=v"(r) : "v"(lo), "v"(hi)); return r; }
typedef float f32x2 __attribute__((ext_vector_type(2)));
__device__ __forceinline__ f32x2 gelu_pk(f32x2 v) {
    const f32x2 av = __builtin_elementwise_abs(v), d = av * 0.2316418882f + 1.0f;
    f32x2 t; t.x = __builtin_amdgcn_rcpf(d.x); t.y = __builtin_amdgcn_rcpf(d.y);
    f32x2 q = t * 0.5307027145f + (-0.7265760135f); q = q * t + 0.7107068705f; q = q * t + (-0.142248368f); q = q * t + 0.127414796f; q = q * t;
    const f32x2 s = (v * v) * (-0.72134752044f);
    f32x2 e; e.x = __builtin_amdgcn_exp2f(s.x); e.y = __builtin_amdgcn_exp2f(s.y);
    const f32x2 m = v * (q * e), r = v - m;
    f32x2 o; o.x = v.x < 0.f ? m.x : r.x; o.y = v.y < 0.f ? m.y : r.y; return o;
}

template <int ACT  > struct EpiBf16 {
    static constexpr bool PERM = true, AFTER_DRAIN = false; static_assert(ACT == 0 || ACT == 1, "EpiBf16: ACT is 0 (none) or 1 (gelu_pk)");
    bf16_t* O; int ldc; const float* bias; int split_cols; size_t split_stride; float scale0;
    __device__ __forceinline__ void operator()(const f32x4 (&acc)[2][2][4][2], const Unit& u, int ui, int wr, int wc, int fr, int fq) const {
        const int row0 = u.pm * BM + wr * 64 + fr; int colt = u.pn * BM; bf16_t* base = O;
        float sc = 1.f; if (split_cols) { const int t = colt / split_cols; base += (size_t)t * split_stride; colt -= t * split_cols; if (t == 0) sc = scale0; }
        const int col0 = colt + wc * 32 + 8 * fq, bcol0 = u.pn * BM + wc * 32 + 8 * fq;
        f32x4 bv[2][2];
#pragma unroll
        for (int bj = 0; bj < 2; ++bj)
#pragma unroll
            for (int n = 0; n < 2; ++n) bv[bj][n] = bias ? *(const f32x4*)(bias + bcol0 + bj * HALF + 4 * n) : (f32x4){0.f, 0.f, 0.f, 0.f};
#pragma unroll
        for (int ai = 0; ai < 2; ++ai)
#pragma unroll
            for (int m = 0; m < 4; ++m) { bf16_t* rowp = base + (size_t)(row0 + ai * HALF + m * 16) * ldc + col0;
#pragma unroll
                for (int bj = 0; bj < 2; ++bj) { f32x4 v0 = acc[ai][bj][m][0] + bv[bj][0], v1 = acc[ai][bj][m][1] + bv[bj][1];
                    if (ACT == 1) { f32x2 a = gelu_pk((f32x2){v0[0], v0[1]}), b = gelu_pk((f32x2){v0[2], v0[3]}), c = gelu_pk((f32x2){v1[0], v1[1]}), d = gelu_pk((f32x2){v1[2], v1[3]});
                        v0 = (f32x4){a.x, a.y, b.x, b.y}; v1 = (f32x4){c.x, c.y, d.x, d.y}; }
                    v0 = v0 * sc; v1 = v1 * sc; u32x4 w; w.x = cvt_pk_bf16(v0[0], v0[1]); w.y = cvt_pk_bf16(v0[2], v0[3]); w.z = cvt_pk_bf16(v1[0], v1[1]); w.w = cvt_pk_bf16(v1[2], v1[3]);
                    *(u32x4*)(rowp + bj * HALF) = w; } }
    }
};

template <class T, class = void> struct pg8_has_midk { static constexpr bool value = false; };
template <class T> struct pg8_has_midk<T, decltype((void)T::MIDK)> { static constexpr bool value = T::MIDK; };
template <class Epi, class Sched, bool ALIGN_EPI = false, bool SP2 = false>
__device__ __forceinline__ void gemm_phase(PG8_LAS unsigned char* lds, const Gemm g, const Sched& S, const Epi& E, int tid_in) {
    int tid_ = tid_in; asm volatile("" : "+v"(tid_));
    const int tid = tid_, wid = __builtin_amdgcn_readfirstlane(tid >> 6), lane = tid & 63, wr = wid >> 2, wc = wid & 3, fr = lane & 15, fq = lane >> 4;
    const int K = g.K, nt = K / BK, lda = g.lda ? g.lda : K;
    unsigned voffA[2], voffB[2];
#pragma unroll
    for (int i = 0; i < 2; ++i) { int R, C; stage_rc(tid * 16 + i * 8192, R, C); const int Rb = Epi::PERM ? ((R & ~31) + perm32(R & 31)) : R;
        voffA[i] = (unsigned)(R * lda + C) * 2u; voffB[i] = (unsigned)(Rb * K + C) * 2u; }
    const size_t kstep = (size_t)(BK * 2);
    const size_t hstepA = (size_t)HALF * lda * 2, tstepA = 2 * hstepA;
    const size_t hstep = (size_t)HALF * K * 2;
    const size_t tstep = 2 * hstep;
    const unsigned ldsw = (unsigned)wid * 1024u;
    const int aoff = lds_byte(wr * 64 + fr, fq * 8), boff = lds_byte(wc * 32 + fr, fq * 8);
#define PG8_SA(b, h) (((b) * 2 + (h)) * HTB)
#define PG8_SB(b, h) ((4 + (b) * 2 + (h)) * HTB)
#define PG8_STAGE(bufoff, gbase, voff) do { _Pragma("unroll") for (int _i = 0; _i < 2; ++_i) \
        __builtin_amdgcn_global_load_lds((const unsigned*)((const char*)(gbase) + (voff)[_i]), (PG8_LAS unsigned*)(lds + (bufoff) + ldsw + _i * 8192), 16, 0, 0); } while (0)
#define PG8_LDA(dst, b, h) do { _Pragma("unroll") for (int m = 0; m < 4; ++m) _Pragma("unroll") for (int k = 0; k < 2; ++k) dst[m][k] = *(const PG8_LAS bf16x8*)(lds + PG8_SA(b, h) + aoff + m * 2048 + k * 1024); } while (0)
#define PG8_LDB(dst, b, h) do { _Pragma("unroll") for (int n = 0; n < 2; ++n) _Pragma("unroll") for (int k = 0; k < 2; ++k) dst[n][k] = *(const PG8_LAS bf16x8*)(lds + PG8_SB(b, h) + boff + n * 2048 + k * 1024); } while (0)
#define PG8_MMA(ai, bj, At, Bt) do { __builtin_amdgcn_s_setprio(1); _Pragma("unroll") for (int m = 0; m < 4; ++m) _Pragma("unroll") for (int n = 0; n < 2; ++n) _Pragma("unroll") for (int k = 0; k < 2; ++k) \
        acc[ai][bj][m][n] = __builtin_amdgcn_mfma_f32_16x16x32_bf16(Bt[n][k], At[m][k], acc[ai][bj][m][n], 0, 0, 0); __builtin_amdgcn_s_setprio(0); } while (0)
#define PG8_WAIT_V(n) asm volatile("s_waitcnt vmcnt(" #n ")" ::: "memory")
#define PG8_WAIT_L(n) asm volatile("s_waitcnt lgkmcnt(" #n ")" ::: "memory")
#define PG8_BAR __builtin_amdgcn_s_barrier()
#define PG8_SCHED __builtin_amdgcn_sched_barrier(0)
    Unit cur, nxt; int ui = 0;
    if (!S.next(0, cur)) return;
    f32x4 acc[2][2][4][2];
#pragma unroll
    for (int a = 0; a < 2; ++a)
#pragma unroll
        for (int b = 0; b < 2; ++b)
#pragma unroll
            for (int m = 0; m < 4; ++m)
#pragma unroll
                for (int n = 0; n < 2; ++n) acc[a][b][m][n] = (f32x4){0.f, 0.f, 0.f, 0.f};
    bf16x8 At[4][2], B0[2][2], B1[2][2];
    const char* cA = (const char*)(cur.sel ? g.A2 : g.A) + (size_t)cur.pm * tstepA; const char* cB = (const char*)(cur.sel ? g.Bt2 : g.Bt) + (size_t)cur.pn * tstep;
    S.a_ready(cur);
    if constexpr (SP2) {
        PG8_STAGE(PG8_SB(0, 0), cB, voffB); PG8_STAGE(PG8_SB(0, 1), cB + hstep, voffB); PG8_STAGE(PG8_SA(0, 0), cA, voffA); PG8_STAGE(PG8_SA(0, 1), cA + hstepA, voffA);
        if (wr == 1) PG8_BAR;
        PG8_WAIT_V(2); PG8_BAR;
        PG8_STAGE(PG8_SB(1, 0), cB + kstep, voffB); PG8_STAGE(PG8_SA(1, 0), cA + kstep, voffA); PG8_STAGE(PG8_SB(1, 1), cB + hstep + kstep, voffB);
        PG8_WAIT_V(6); PG8_BAR;
    } else {
        PG8_STAGE(PG8_SB(0, 0), cB, voffB); PG8_STAGE(PG8_SA(0, 0), cA, voffA); PG8_STAGE(PG8_SB(0, 1), cB + hstep, voffB); PG8_STAGE(PG8_SA(0, 1), cA + hstepA, voffA);
        if (wr == 1) PG8_BAR;
        PG8_WAIT_V(4); PG8_BAR;
        PG8_STAGE(PG8_SB(1, 0), cB + kstep, voffB); PG8_STAGE(PG8_SA(1, 0), cA + kstep, voffA); PG8_STAGE(PG8_SB(1, 1), cB + hstep + kstep, voffB);
        PG8_WAIT_V(6); PG8_BAR;
    }
    for (;;) {
        const bool has_next = S.next(ui + 1, nxt);
        const char* nA = has_next ? (const char*)(nxt.sel ? g.A2 : g.A) + (size_t)nxt.pm * tstepA : cA; const char* nB = has_next ? (const char*)(nxt.sel ? g.Bt2 : g.Bt) + (size_t)nxt.pn * tstep : cB;
        for (int t = 0; t < nt; t += 2) {
            if constexpr (pg8_has_midk<Epi>::value) { if (t == (nt >> 1)) E.midk(acc, cur, wr, wc, fr, fq); }
            const bool last = (t == nt - 2);
            const char* a1 = cA + (size_t)(t + 1) * kstep;
            const char* a2 = last ? nA : cA + (size_t)(t + 2) * kstep; const char* b2 = last ? nB : cB + (size_t)(t + 2) * kstep;
            const char* a3 = a2 + kstep; const char* b3 = b2 + kstep;
            if (last && has_next) S.a_ready(nxt);
            if constexpr (SP2) {
            PG8_LDB(B0, 0, 0); PG8_LDB(B1, 0, 1); PG8_SCHED; PG8_LDA(At, 0, 0); PG8_STAGE(PG8_SA(1, 1), a1 + hstepA, voffA);
            PG8_WAIT_V(8); PG8_WAIT_L(0); PG8_BAR; PG8_MMA(0, 0, At, B0); PG8_MMA(0, 1, At, B1); PG8_BAR; PG8_SCHED;
            PG8_LDA(At, 0, 1); PG8_STAGE(PG8_SB(0, 0), b2, voffB); PG8_STAGE(PG8_SB(0, 1), b2 + hstep, voffB); PG8_STAGE(PG8_SA(0, 0), a2, voffA);
            PG8_WAIT_V(8); PG8_WAIT_L(0); PG8_BAR; PG8_MMA(1, 0, At, B0); PG8_MMA(1, 1, At, B1); PG8_BAR; PG8_SCHED;
            PG8_LDB(B0, 1, 0); PG8_LDB(B1, 1, 1); PG8_SCHED; PG8_LDA(At, 1, 0); PG8_STAGE(PG8_SA(0, 1), a2 + hstepA, voffA);
            PG8_WAIT_V(8); PG8_WAIT_L(0); PG8_BAR; PG8_MMA(0, 0, At, B0); PG8_MMA(0, 1, At, B1); PG8_BAR; PG8_SCHED;
            PG8_LDA(At, 1, 1); PG8_STAGE(PG8_SB(1, 0), b3, voffB); PG8_STAGE(PG8_SB(1, 1), b3 + hstep, voffB); PG8_STAGE(PG8_SA(1, 0), a3, voffA);
            PG8_WAIT_V(8); PG8_WAIT_L(0); PG8_BAR; PG8_MMA(1, 0, At, B0); PG8_MMA(1, 1, At, B1); PG8_BAR; PG8_SCHED;
            } else {
            PG8_LDB(B0, 0, 0); PG8_SCHED; PG8_LDA(At, 0, 0); PG8_STAGE(PG8_SA(1, 1), a1 + hstepA, voffA);
            PG8_WAIT_L(8); PG8_BAR; PG8_WAIT_L(0); PG8_MMA(0, 0, At, B0); PG8_BAR; PG8_SCHED;
            PG8_LDB(B1, 0, 1); PG8_STAGE(PG8_SB(0, 0), b2, voffB);
            PG8_BAR; PG8_WAIT_L(0); PG8_MMA(0, 1, At, B1); PG8_BAR;
            PG8_LDA(At, 0, 1); PG8_STAGE(PG8_SA(0, 0), a2, voffA);
            PG8_BAR; PG8_WAIT_L(0); PG8_MMA(1, 0, At, B0); PG8_BAR; PG8_SCHED;
            PG8_STAGE(PG8_SB(0, 1), b2 + hstep, voffB);
            PG8_WAIT_V(6); PG8_BAR; PG8_MMA(1, 1, At, B1); PG8_BAR;
            PG8_LDB(B0, 1, 0); PG8_SCHED; PG8_LDA(At, 1, 0); PG8_STAGE(PG8_SA(0, 1), a2 + hstepA, voffA);
            PG8_WAIT_L(8); PG8_BAR; PG8_WAIT_L(0); PG8_MMA(0, 0, At, B0); PG8_BAR; PG8_SCHED;
            PG8_LDB(B1, 1, 1); PG8_STAGE(PG8_SB(1, 0), b3, voffB);
            PG8_BAR; PG8_WAIT_L(0); PG8_MMA(0, 1, At, B1); PG8_BAR;
            PG8_LDA(At, 1, 1); PG8_STAGE(PG8_SA(1, 0), a3, voffA);
            PG8_BAR; PG8_WAIT_L(0); PG8_MMA(1, 0, At, B0); PG8_BAR; PG8_SCHED;
            PG8_STAGE(PG8_SB(1, 1), b3 + hstep, voffB);
            PG8_WAIT_V(6); PG8_BAR; PG8_MMA(1, 1, At, B1); PG8_BAR;
            }
        }
        if constexpr (ALIGN_EPI) { if (wr == 0) PG8_BAR; }
        if constexpr (!Epi::AFTER_DRAIN) { E(acc, cur, ui, wr, wc, fr, fq); S.done(cur); }
        if (!has_next) break;
#pragma unroll
        for (int a = 0; a < 2; ++a)
#pragma unroll
            for (int b = 0; b < 2; ++b)
#pragma unroll
                for (int m = 0; m < 4; ++m)
#pragma unroll
                    for (int n = 0; n < 2; ++n) acc[a][b][m][n] = (f32x4){0.f, 0.f, 0.f, 0.f};
        cur = nxt; cA = nA; cB = nB; ++ui;
        if constexpr (ALIGN_EPI) { if (wr == 1) PG8_BAR; }
    }
    PG8_WAIT_V(0);
    if constexpr (!ALIGN_EPI) { if (wr == 0) PG8_BAR; }
    PG8_BAR;
    if constexpr (Epi::AFTER_DRAIN) { E.fused(acc, cur, wr, wc, fr, fq, lds, wid, lane); S.done(cur); }
#undef PG8_SA
#undef PG8_SB
#undef PG8_STAGE
#undef PG8_LDA
#undef PG8_LDB
#undef PG8_MMA
#undef PG8_WAIT_V
#undef PG8_WAIT_L
#undef PG8_BAR
#undef PG8_SCHED
}
}
namespace pg8 {
__device__ __forceinline__ float bf_lo(unsigned w) { return __uint_as_float(w << 16); }
__device__ __forceinline__ float bf_hi(unsigned w) { return __uint_as_float(w & 0xffff0000u); }
__device__ __forceinline__ float sigm(float x) { return 1.0f / (1.0f + __expf(-x)); }
typedef unsigned u32x2 __attribute__((ext_vector_type(2)));

template <bool G1>
struct EpiProjT {
    static constexpr bool PERM = true, AFTER_DRAIN = false;
    bf16_t* O; int ldc; const PG8_LAS float* rstd; bf16_t* KV; float* RSQ; bf16_t* RHO; bf16_t* SGB;
    static constexpr int kvtile = 4, sqtile = 9, gtile = 16;
    __device__ __forceinline__ void operator()(const f32x4 (&acc)[2][2][4][2], const Unit& u, int ui, int wr, int wc, int fr, int fq) const {
        const int rt0 = wr * 64 + fr, col0 = u.pn * BM + wc * 32 + 8 * fq;
        const bool sq = G1 && (u.pn == sqtile || u.pn == sqtile + 1);
#pragma unroll
        for (int ai = 0; ai < 2; ++ai)
#pragma unroll
            for (int m = 0; m < 4; ++m) { const int rt = rt0 + ai * HALF + m * 16; const float s = rstd[ui * 256 + rt];
                bf16_t* rowp = O + (size_t)(u.pm * BM + rt) * ldc + col0;
                if constexpr (G1) { if (u.pn == kvtile) rowp = KV + (size_t)(u.pm * BM + rt) * 256 + wc * 32 + 8 * fq; }
                float ss = 0.f;
                if constexpr (G1) { if (u.pn >= gtile) {
                    const f32x4 a0 = acc[ai][0][m][0] * s, a1 = acc[ai][0][m][1] * s, b0 = acc[ai][1][m][0] * s, b1 = acc[ai][1][m][1] * s;
                    float ea[8], eb[8], rh[8], sb[8];
#pragma unroll
                    for (int j = 0; j < 4; ++j) { ea[j] = 1.0f + __expf(-a0[j]); ea[4 + j] = 1.0f + __expf(-a1[j]); eb[j] = 1.0f + __expf(-b0[j]); eb[4 + j] = 1.0f + __expf(-b1[j]); }
#pragma unroll
                    for (int j = 0; j < 8; ++j) { const float ia = __builtin_amdgcn_rcpf(ea[j]); rh[j] = eb[j] * ia; sb[j] = __builtin_amdgcn_rcpf(eb[j]); }
                    const size_t go = (size_t)(u.pm * BM + rt) * 2048 + (u.pn - gtile) * 128 + wc * 32 + 8 * fq;
                    u32x4 wr_, ws_; wr_.x = cvt_pk_bf16(rh[0], rh[1]); wr_.y = cvt_pk_bf16(rh[2], rh[3]); wr_.z = cvt_pk_bf16(rh[4], rh[5]); wr_.w = cvt_pk_bf16(rh[6], rh[7]);
                    ws_.x = cvt_pk_bf16(sb[0], sb[1]); ws_.y = cvt_pk_bf16(sb[2], sb[3]); ws_.z = cvt_pk_bf16(sb[4], sb[5]); ws_.w = cvt_pk_bf16(sb[6], sb[7]);
                    *(u32x4*)(RHO + go) = wr_; *(u32x4*)(SGB + go) = ws_;
                    continue; } }
#pragma unroll
                for (int bj = 0; bj < 2; ++bj) { const f32x4 v0 = acc[ai][bj][m][0] * s, v1 = acc[ai][bj][m][1] * s;
                    ss += (v0[0] * v0[0] + v0[1] * v0[1]) + (v0[2] * v0[2] + v0[3] * v0[3]) + (v1[0] * v1[0] + v1[1] * v1[1]) + (v1[2] * v1[2] + v1[3] * v1[3]);
                    u32x4 w; w.x = cvt_pk_bf16(v0[0], v0[1]); w.y = cvt_pk_bf16(v0[2], v0[3]); w.z = cvt_pk_bf16(v1[0], v1[1]); w.w = cvt_pk_bf16(v1[2], v1[3]);
                    *(u32x4*)(rowp + bj * HALF) = w; }
                if constexpr (G1) if (sq) { ss += __shfl_xor(ss, 16); ss += __shfl_xor(ss, 32); if (fq == 0) RSQ[(size_t)(u.pm * BM + rt) * 8 + (u.pn - sqtile) * 4 + wc] = ss; } }
    }
};
struct EpiPA {
    static constexpr bool PERM = false, AFTER_DRAIN = false;
    float* P; const bf16_t* G; int ldg;
    __device__ __forceinline__ void operator()(const f32x4 (&acc)[2][2][4][2], const Unit& u, int ui, int wr, int wc, int fr, int fq) const {
        const int col0 = u.pn * BM + wc * 32 + 4 * fq;
#pragma unroll
        for (int ai = 0; ai < 2; ++ai)
#pragma unroll
            for (int m = 0; m < 4; ++m) { const int row = u.pm * BM + ai * HALF + wr * 64 + m * 16 + fr;
#pragma unroll
                for (int bj = 0; bj < 2; ++bj)
#pragma unroll
                    for (int n = 0; n < 2; ++n) { const int c = col0 + bj * HALF + n * 16; const u32x2 g = *(const u32x2*)(G + (size_t)row * ldg + c);
                        f32x4 v = acc[ai][bj][m][n]; v[0] *= sigm(bf_lo(g.x)); v[1] *= sigm(bf_hi(g.x)); v[2] *= sigm(bf_lo(g.y)); v[3] *= sigm(bf_hi(g.y));
                        *(f32x4*)(P + (size_t)row * 2048 + c) = v; } }
    }
};
struct EpiMerge {
    static constexpr bool PERM = true, AFTER_DRAIN = false;
    bf16_t* O; const float* P; const bf16_t* G; int ldg;
    __device__ __forceinline__ void operator()(const f32x4 (&acc)[2][2][4][2], const Unit& u, int ui, int wr, int wc, int fr, int fq) const {
        const int col0 = u.pn * BM + wc * 32 + 8 * fq;
#pragma unroll
        for (int ai = 0; ai < 2; ++ai)
#pragma unroll
            for (int m = 0; m < 4; ++m) { const int row = u.pm * BM + ai * HALF + wr * 64 + m * 16 + fr;
#pragma unroll
                for (int bj = 0; bj < 2; ++bj) { const int c = col0 + bj * HALF; const u32x4 g = *(const u32x4*)(G + (size_t)row * ldg + c);
                    const f32x4 p0 = *(const f32x4*)(P + (size_t)row * 2048 + c), p1 = *(const f32x4*)(P + (size_t)row * 2048 + c + 4);
                    f32x4 v0 = acc[ai][bj][m][0], v1 = acc[ai][bj][m][1];
                    v0[0] = p0[0] + sigm(bf_lo(g.x)) * v0[0]; v0[1] = p0[1] + sigm(bf_hi(g.x)) * v0[1]; v0[2] = p0[2] + sigm(bf_lo(g.y)) * v0[2]; v0[3] = p0[3] + sigm(bf_hi(g.y)) * v0[3];
                    v1[0] = p1[0] + sigm(bf_lo(g.z)) * v1[0]; v1[1] = p1[1] + sigm(bf_hi(g.z)) * v1[1]; v1[2] = p1[2] + sigm(bf_lo(g.w)) * v1[2]; v1[3] = p1[3] + sigm(bf_hi(g.w)) * v1[3];
                    u32x4 w; w.x = cvt_pk_bf16(v0[0], v0[1]); w.y = cvt_pk_bf16(v0[2], v0[3]); w.z = cvt_pk_bf16(v1[0], v1[1]); w.w = cvt_pk_bf16(v1[2], v1[3]);
                    *(u32x4*)(O + (size_t)row * 2048 + c) = w; } }
    }
};
struct EpiG4 {
    static constexpr bool PERM = true, AFTER_DRAIN = false;
    bf16_t* O; float* P; const bf16_t* GA; const bf16_t* GB; int ldg;
    __device__ __forceinline__ void operator()(const f32x4 (&acc)[2][2][4][2], const Unit& u, int ui, int wr, int wc, int fr, int fq) const {
        const int col0 = u.pn * BM + wc * 32 + 8 * fq;
        const bf16_t* G = u.sel ? GB : GA;
#pragma unroll
        for (int ai = 0; ai < 2; ++ai)
#pragma unroll
            for (int m = 0; m < 4; ++m) { const int row = u.pm * BM + ai * HALF + wr * 64 + m * 16 + fr;
#pragma unroll
                for (int bj = 0; bj < 2; ++bj) { const int c = col0 + bj * HALF; const u32x4 g = *(const u32x4*)(G + (size_t)row * ldg + c);
                    f32x4 v0 = acc[ai][bj][m][0], v1 = acc[ai][bj][m][1];
                    v0[0] *= sigm(bf_lo(g.x)); v0[1] *= sigm(bf_hi(g.x)); v0[2] *= sigm(bf_lo(g.y)); v0[3] *= sigm(bf_hi(g.y));
                    v1[0] *= sigm(bf_lo(g.z)); v1[1] *= sigm(bf_hi(g.z)); v1[2] *= sigm(bf_lo(g.w)); v1[3] *= sigm(bf_hi(g.w));
                    float* pp = P + (size_t)row * 2048 + c;
                    if (u.sel == 0) { *(f32x4*)pp = v0; *(f32x4*)(pp + 4) = v1; }
                    else { v0 += *(const f32x4*)pp; v1 += *(const f32x4*)(pp + 4);
                        u32x4 w; w.x = cvt_pk_bf16(v0[0], v0[1]); w.y = cvt_pk_bf16(v0[2], v0[3]); w.z = cvt_pk_bf16(v1[0], v1[1]); w.w = cvt_pk_bf16(v1[2], v1[3]);
                        *(u32x4*)(O + (size_t)row * 2048 + c) = w; } } }
    }
};
struct EpiG4m {
    static constexpr bool PERM = true, AFTER_DRAIN = false, MIDK = true;
    bf16_t* O; const bf16_t* RHO; const bf16_t* SGB;
    __device__ __forceinline__ void scale(f32x4 (&acc)[2][2][4][2], const bf16_t* T, const Unit& u, int wr, int wc, int fr, int fq) const {
        const int col0 = u.pn * BM + wc * 32 + 8 * fq;
        u32x4 gv[2][4][2];
#pragma unroll
        for (int ai = 0; ai < 2; ++ai)
#pragma unroll
            for (int m = 0; m < 4; ++m)
#pragma unroll
                for (int bj = 0; bj < 2; ++bj) gv[ai][m][bj] = *(const u32x4*)(T + (size_t)(u.pm * BM + ai * HALF + wr * 64 + m * 16 + fr) * 2048 + col0 + bj * HALF);
        __builtin_amdgcn_sched_barrier(0);
#pragma unroll
        for (int ai = 0; ai < 2; ++ai)
#pragma unroll
            for (int m = 0; m < 4; ++m)
#pragma unroll
                for (int bj = 0; bj < 2; ++bj) { const u32x4 g = gv[ai][m][bj]; f32x4& v0 = acc[ai][bj][m][0]; f32x4& v1 = acc[ai][bj][m][1];
                    v0[0] *= bf_lo(g.x); v0[1] *= bf_hi(g.x); v0[2] *= bf_lo(g.y); v0[3] *= bf_hi(g.y); v1[0] *= bf_lo(g.z); v1[1] *= bf_hi(g.z); v1[2] *= bf_lo(g.w); v1[3] *= bf_hi(g.w); }
    }
    __device__ __forceinline__ void midk(f32x4 (&acc)[2][2][4][2], const Unit& u, int wr, int wc, int fr, int fq) const {
        asm volatile("" : "+v"(fr), "+v"(fq));
        scale(acc, RHO, u, wr, wc, fr, fq);
    }
    __device__ __forceinline__ void operator()(const f32x4 (&acc_)[2][2][4][2], const Unit& u, int ui, int wr, int wc, int fr, int fq) const {
        f32x4 acc[2][2][4][2];
#pragma unroll
        for (int a = 0; a < 2; ++a)
#pragma unroll
            for (int b = 0; b < 2; ++b)
#pragma unroll
                for (int m = 0; m < 4; ++m)
#pragma unroll
                    for (int n = 0; n < 2; ++n) acc[a][b][m][n] = acc_[a][b][m][n];
        scale(acc, SGB, u, wr, wc, fr, fq);
        const int col0 = u.pn * BM + wc * 32 + 8 * fq;
#pragma unroll
        for (int ai = 0; ai < 2; ++ai)
#pragma unroll
            for (int m = 0; m < 4; ++m) { const int row = u.pm * BM + ai * HALF + wr * 64 + m * 16 + fr;
#pragma unroll
                for (int bj = 0; bj < 2; ++bj) { const f32x4 v0 = acc[ai][bj][m][0], v1 = acc[ai][bj][m][1];
                    u32x4 w; w.x = cvt_pk_bf16(v0[0], v0[1]); w.y = cvt_pk_bf16(v0[2], v0[3]); w.z = cvt_pk_bf16(v1[0], v1[1]); w.w = cvt_pk_bf16(v1[2], v1[3]);
                    *(u32x4*)(O + (size_t)row * 2048 + col0 + bj * HALF) = w; } }
    }
};
struct DualOrder : StaticOrder {
    __host__ __device__ bool next(int i, Unit& u) const { if (!StaticOrder::next(i >> 1, u)) return false; u.sel = i & 1; return true; }
};
struct EpiRes {
    static constexpr bool PERM = false, AFTER_DRAIN = false;
    bf16_t* HB; float* RS;
    __device__ __forceinline__ void operator()(const f32x4 (&acc)[2][2][4][2], const Unit& u, int ui, int wr, int wc, int fr, int fq) const {
        const int col0 = u.pn * BM + wc * 32 + 4 * fq;
        u32x2 ho[2][4][2][2];
#pragma unroll
        for (int ai = 0; ai < 2; ++ai)
#pragma unroll
            for (int m = 0; m < 4; ++m) { const int row = u.pm * BM + ai * HALF + wr * 64 + m * 16 + fr;
#pragma unroll
                for (int bj = 0; bj < 2; ++bj)
#pragma unroll
                    for (int n = 0; n < 2; ++n) ho[ai][m][bj][n] = *(const u32x2*)(HB + (size_t)row * 2048 + col0 + bj * HALF + n * 16); }
        __builtin_amdgcn_sched_barrier(0);
#pragma unroll
        for (int ai = 0; ai < 2; ++ai)
#pragma unroll
            for (int m = 0; m < 4; ++m) { const int row = u.pm * BM + ai * HALF + wr * 64 + m * 16 + fr; float ss = 0.f;
#pragma unroll
                for (int bj = 0; bj < 2; ++bj)
#pragma unroll
                    for (int n = 0; n < 2; ++n) { const size_t off = (size_t)row * 2048 + col0 + bj * HALF + n * 16;
                        const u32x2 h0 = ho[ai][m][bj][n];
                        f32x4 hv = {bf_lo(h0.x), bf_hi(h0.x), bf_lo(h0.y), bf_hi(h0.y)}; hv += acc[ai][bj][m][n];
                        u32x2 w; w.x = cvt_pk_bf16(hv[0], hv[1]); w.y = cvt_pk_bf16(hv[2], hv[3]); *(u32x2*)(HB + off) = w;
                        ss += (hv[0] * hv[0] + hv[1] * hv[1]) + (hv[2] * hv[2] + hv[3] * hv[3]); }
                ss += __shfl_xor(ss, 16); ss += __shfl_xor(ss, 32);
                if (fq == 0) RS[(size_t)row * 32 + u.pn * 4 + wc] = ss; }
    }
};
}

#define GAS __attribute__((address_space(1)))
#define LAS __attribute__((address_space(3)))
typedef unsigned short bf16;
typedef unsigned v4u __attribute__((ext_vector_type(4)));
typedef float f32x4 __attribute__((ext_vector_type(4)));
typedef short bf16x8 __attribute__((ext_vector_type(8)));
typedef GAS unsigned gu32;
typedef GAS unsigned long long gu64;
#define RLX_AGENT __ATOMIC_RELAXED, __HIP_MEMORY_SCOPE_AGENT
#define LDS_WAIT() asm volatile("s_waitcnt lgkmcnt(0)" ::: "memory")
#define VM_WAIT() asm volatile("s_waitcnt vmcnt(0)" ::: "memory")
__device__ __forceinline__ unsigned long long rt() { return __builtin_amdgcn_s_memrealtime(); }
__device__ __forceinline__ unsigned f2bf(float f) { unsigned u = __builtin_bit_cast(unsigned, f); return (u + 0x7fffu + ((u >> 16) & 1u)) >> 16; }
__device__ __forceinline__ unsigned pk2(float lo, float hi) { return f2bf(lo) | (f2bf(hi) << 16); }

#define XB_TMO      128
#define XB_XCNT(j)  (256  + 64 * (j))
#define XB_XSUB(j)  (1280 + 64 * (j))
#define XB_XGEN(j)  (2304 + 64 * (j))
#define XB_TOP      3328
#define XB_TOPGEN   3392
#define XCD_BAR_WORDS 3456
#define XB_SPIN_CAP (1u << 18)

__device__ __forceinline__ unsigned xb_ld(unsigned* p)              { return __hip_atomic_load(p, __ATOMIC_RELAXED, __HIP_MEMORY_SCOPE_AGENT); }
__device__ __forceinline__ unsigned xb_add(unsigned* p, unsigned v) { return __hip_atomic_fetch_add(p, v, __ATOMIC_RELAXED, __HIP_MEMORY_SCOPE_AGENT); }
__device__ __forceinline__ unsigned xb_xcc_id() { return (unsigned)__builtin_amdgcn_s_getreg((3 << 11) | 20) & 0xFu; }
#define XB_SPIN(cond, bar) do { unsigned _sp = 0; while (cond) { __builtin_amdgcn_s_sleep(1); \
    if ((++_sp & 255u) == 0u) { if (xb_ld(&(bar)[XB_TMO])) break; if (_sp > XB_SPIN_CAP) { atomicAdd(&(bar)[XB_TMO], 1u); break; } } } } while (0)

struct XcdBarrier {
    unsigned* bar; unsigned x;
    volatile LAS unsigned* st;
};

__device__ __forceinline__ XcdBarrier xcd_barrier_post(unsigned* bar, volatile LAS unsigned* st) {
    XcdBarrier b; b.bar = bar; b.x = xb_xcc_id(); b.st = st;
    if (threadIdx.x == 0) (void)xb_add(&bar[XB_XCNT(b.x)], 1u);
    return b;
}
__device__ __forceinline__ void xcd_barrier_complete(unsigned* bar, unsigned x, unsigned& nloc, unsigned& nx) {
    const unsigned G = gridDim.x * gridDim.y * gridDim.z;
    unsigned sum, cnt, mine, sp = 0u;
    for (;;) {
        sum = 0u; cnt = 0u; mine = 0u;
#pragma unroll
        for (unsigned j = 0; j < 16; ++j) { const unsigned c = xb_ld(&bar[XB_XCNT(j)]); sum += c; cnt += (c > 0u) ? 1u : 0u; mine = (j == x) ? c : mine; }
        if (sum == G) break;
        __builtin_amdgcn_s_sleep(1);
        if ((++sp & 255u) == 0u) { if (xb_ld(&bar[XB_TMO])) break; if (sp > XB_SPIN_CAP) { atomicAdd(&bar[XB_TMO], 1u); break; } }
    }
    nloc = mine > 0u ? mine : 1u; nx = cnt > 0u ? cnt : 1u;
}

__device__ __forceinline__ void xcd_barrier(const XcdBarrier& b, bool thread0) {
    asm volatile("s_waitcnt vmcnt(0)" ::: "memory");
    __syncthreads();
    if (thread0) {
        unsigned* bar = b.bar;
        __builtin_amdgcn_s_waitcnt(0);
        unsigned nloc = b.st[0], nx = b.st[1];
        if (nloc == 0u) { xcd_barrier_complete(bar, b.x, nloc, nx); b.st[0] = nloc; b.st[1] = nx; }
        const unsigned old = xb_add(&bar[XB_XSUB(b.x)], 1u);
        const unsigned gen = old / nloc;
        if (old + 1u == (gen + 1u) * nloc) {
            __builtin_amdgcn_fence(__ATOMIC_RELEASE, "agent");
            asm volatile("s_waitcnt vmcnt(0)" ::: "memory");
            const unsigned og = xb_add(&bar[XB_TOP], 1u);
            const unsigned tg = og / nx;
            if (og + 1u == (tg + 1u) * nx) xb_add(&bar[XB_TOPGEN], 1u);
            else XB_SPIN(xb_ld(&bar[XB_TOPGEN]) == tg, bar);
            __builtin_amdgcn_fence(__ATOMIC_ACQUIRE, "agent");
            xb_add(&bar[XB_XGEN(b.x)], 1u);
            asm volatile("s_waitcnt vmcnt(0)" ::: "memory");
        } else {
            XB_SPIN(xb_ld(&bar[XB_XGEN(b.x)]) == gen, bar);
            __builtin_amdgcn_fence(__ATOMIC_ACQUIRE, "agent");
            asm volatile("s_waitcnt vmcnt(0)" ::: "memory");
        }
    }
    __syncthreads();
}
#ifndef MK_PROBE
#define MK_PROBE (-1)
#endif
#ifndef MK_PROBE_BLOCK
#define MK_PROBE_BLOCK 0
#endif
#ifndef MK_PROBE_SCALE
#define MK_PROBE_SCALE 2e-6f
#endif
#define PROBE_T0() unsigned pt0_ = 0; if (MK_PROBE >= 0) { pt0_ = (unsigned)__builtin_amdgcn_readfirstlane((int)(unsigned)__builtin_amdgcn_s_memtime()); asm volatile("s_waitcnt lgkmcnt(0)" ::: "memory"); }
#define PROBE_T1(id) do { if (MK_PROBE == (id)) { const unsigned pt1_ = (unsigned)__builtin_amdgcn_readfirstlane((int)(unsigned)__builtin_amdgcn_s_memtime()); asm volatile("s_waitcnt lgkmcnt(0)" ::: "memory"); \
    if (C.bid == MK_PROBE_BLOCK && C.wave == 0 && C.lane == 0) { volatile LAS unsigned* pw_ = (volatile LAS unsigned*)(C.lds + MISC_OFF + 64); pw_[0] = pw_[0] + (unsigned)(pt1_ - pt0_); } } } while (0)
constexpr int NWAVES = 8;
constexpr int NLAYER = 4, DM = 2048, NBATCH = 2, SEQ = 4096, NMETA = 16, LTOK = SEQ + NMETA, NTOK = NBATCH * LTOK;
constexpr int MP = 8448;
constexpr int NP1 = 8448;
constexpr int NC_IN = 8264;
constexpr int PC_QA = 0, PC_KA = 1024, PC_VA = 1152, PC_ZA = 1280, PC_CQ = 2304, PC_CKV = 2816, PC_ZB = 3072, PC_GA = 4096, PC_GB = 6144, PC_KIDX = 8192, PC_WIDX = 8256;
constexpr int NQ2 = 4608;
constexpr int TOPK = 256;
constexpr int YLD = 2048;
constexpr float RMS_EPS = 1e-6f;

__device__ __forceinline__ int rowof(int b, int t) { return t < NMETA ? 8192 + b * NMETA + t : b * SEQ + (t - NMETA); }
__device__ __forceinline__ int t5_bucket(int d) {
    const int n = d < 0 ? 0 : d;
    if (n < 16) return n;
    return 16 + (n >= 19) + (n >= 21) + (n >= 24) + (n >= 27) + (n >= 31) + (n >= 35) + (n >= 40) + (n >= 46) + (n >= 52) + (n >= 59) + (n >= 67) + (n >= 77) + (n >= 87) + (n >= 99) + (n >= 113);
}
__device__ __forceinline__ float bf2f(bf16 v) { return __uint_as_float((unsigned)v << 16); }
__device__ __forceinline__ float sigmoidf_(float x) { return 1.0f / (1.0f + __expf(-x)); }
__device__ __forceinline__ float siluf_(float x) { return x / (1.0f + __expf(-x)); }
__device__ __forceinline__ float wave_sum(float v) {
#pragma unroll
    for (int o = 1; o < 64; o <<= 1) v += __shfl_xor(v, o);
    return v;
}
__device__ __forceinline__ float wave_max(float v) {
#pragma unroll
    for (int o = 1; o < 64; o <<= 1) v = fmaxf(v, __shfl_xor(v, o));
    return v;
}
__device__ __forceinline__ int wave_sum_i(int v) {
#pragma unroll
    for (int o = 1; o < 64; o <<= 1) v += __shfl_xor(v, o);
    return v;
}

constexpr size_t MiB = 1u << 20;
constexpr size_t WS_CTL = 0, CTL_ZERO_BYTES = 1 * MiB;
constexpr size_t SZ_W1 = (size_t)NLAYER * NP1 * DM * 2, SZ_W2 = (size_t)NLAYER * NQ2 * 512 * 2, SZ_WA = (size_t)NLAYER * DM * 1024 * 2, SZ_WO = (size_t)NLAYER * DM * DM * 2;
constexpr size_t al(size_t x) { return (x + 4095) / 4096 * 4096; }
constexpr size_t WS_W1 = 1 * MiB, WS_W2 = WS_W1 + al(SZ_W1), WS_WA = WS_W2 + al(SZ_W2), WS_WB = WS_WA + 1024 * 2, WS_WO = WS_WA + al(2 * SZ_WA);
constexpr size_t SZ_WUV = (size_t)NLAYER * 16 * 64 * 256 * 2;
constexpr size_t WS_WUV = WS_WO + al(SZ_WO);
constexpr size_t WS_VT = WS_WUV + al(SZ_WUV);
constexpr size_t WS_KV = WS_VT + al((size_t)2 * 128 * 4128 * 2), WS_KIDX = WS_KV + al((size_t)MP * 256 * 2);
constexpr size_t WS_H = WS_KIDX + al((size_t)MP * 64 * 2), WS_HB = WS_H + al((size_t)MP * DM * 4), WS_RS = WS_HB + al((size_t)MP * DM * 2);
constexpr size_t WS_RS2 = WS_RS + al((size_t)MP * 32 * 4);
constexpr size_t WS_RSQ = WS_RS2 + al((size_t)32 * 64 * 4), WS_RSQ2 = WS_RSQ + al((size_t)MP * 8 * 4);
constexpr size_t WS_PROJ = WS_RSQ2 + al((size_t)32 * 16 * 4), WS_CQN = WS_PROJ + al((size_t)MP * NP1 * 2), WS_CKVN = WS_CQN + al((size_t)MP * 512 * 2);
constexpr size_t WS_Q2 = WS_CKVN + al((size_t)MP * 256 * 2), WS_OLAT = WS_Q2 + al((size_t)MP * NQ2 * 2), WS_YA = WS_OLAT + al((size_t)256 * 3 * 16 * 8 * 64 * 8 * 2);
constexpr size_t WS_YB = WS_YA + 1024 * 2, WS_PA = WS_YA + al((size_t)MP * 2048 * 2),
 WS_MG = WS_PA + al((size_t)MP * DM * 4), WS_RHO = WS_MG + al((size_t)MP * DM * 2), WS_SGB = WS_RHO + al((size_t)MP * DM * 2), WS_END = WS_SGB + al((size_t)MP * DM * 2);
constexpr int CW_TMO = 0, CW_CODE = 1, CW_BAR = 4096, CW_DSAQ = 16384, CW_SWAQ = 20480;

constexpr int LDSCTL_OFF = 0, MISC_OFF = LDSCTL_OFF + 320;
constexpr int RSTD_OFF = 512;
constexpr int RING_OFF = 8192, RING_BYTES = 131072;
constexpr int LDS_BYTES = 163840;
static_assert(RSTD_OFF + 5 * 256 * 4 <= RING_OFF, "LDS map");

struct Args {
    const float* x; const float* meta; const float* bias_table; const float* norm_g; const float* w_in; const float* q_norm_g; const float* kv_norm_g; const float* w_qb; const float* w_iq;
    const float* w_uk; const float* w_uv; const float* sinks; const float* w_proj_a; const float* w_proj_b; const float* w_out; const float* final_g;
    float* out; unsigned char* ws; int ph_lo, ph_hi;
};

__device__ __forceinline__ unsigned pkh(float lo, float hi) { typedef float f2_t __attribute__((ext_vector_type(2))); typedef __bf16 b2_t __attribute__((ext_vector_type(2))); f2_t v = {lo, hi}; b2_t b = __builtin_convertvector(v, b2_t); return __builtin_bit_cast(unsigned, b); }
struct XDesc { const float* W; const float* scale; bf16* out; int ldw, k0, c0, nvalid, K; };
__device__ __forceinline__ void xpose_load(const XDesc& d, float (&v)[32], int lane) {
    asm volatile("" : "+v"(lane));
    const int c = lane & 31, cc = (c < d.nvalid) ? c : 0; const float* p = d.W + (size_t)(d.k0 + (lane >> 5)) * d.ldw + d.c0 + cc;
    const float keep = (c < d.nvalid) ? 1.f : 0.f;
#pragma unroll
    for (int i = 0; i < 32; ++i) v[i] = p[(size_t)(2 * i) * d.ldw];
#pragma unroll
    for (int i = 0; i < 32; ++i) v[i] *= keep;
    if (d.scale) {
#pragma unroll
        for (int i = 0; i < 32; ++i) v[i] *= d.scale[d.k0 + 2 * i + (lane >> 5)];
    }
}
__device__ __forceinline__ void xpose_store(const XDesc& d, const float (&v)[32], LAS float* scr, int lane) {
    asm volatile("" : "+v"(lane));
    const int c = lane & 31;
#pragma unroll
    for (int i = 0; i < 32; ++i) scr[(2 * i + (lane >> 5)) * 33 + c] = v[i];
    LDS_WAIT(); asm volatile("" ::: "memory");
    const int cc = lane & 7;
#pragma unroll
    for (int j = 0; j < 4; ++j) { const int n = (lane >> 3) + 8 * j; const LAS float* s = scr + (8 * cc) * 33 + n;
        v4u o; o.x = pkh(s[0 * 33], s[1 * 33]); o.y = pkh(s[2 * 33], s[3 * 33]); o.z = pkh(s[4 * 33], s[5 * 33]); o.w = pkh(s[6 * 33], s[7 * 33]);
        *(GAS v4u*)(d.out + (size_t)n * d.K + d.k0 + 8 * cc) = o; }
    LDS_WAIT(); asm volatile("" ::: "memory");
}
__device__ __forceinline__ void fold_item(const float* __restrict__ wqb, const float* __restrict__ wuk, const float* __restrict__ gq, bf16* W2l, int h, int kb, int rb, LAS float* scr, int lane) {
    const int rr = lane & 31, r = rb * 32 + rr;
    float uk[64];
#pragma unroll
    for (int d = 0; d < 64; ++d) uk[d] = wuk[((size_t)h * 64 + d) * 256 + r];
    for (int i = 0; i < 32; ++i) { const int kk = 2 * i + (lane >> 5), k = kb * 64 + kk; const f32x4* qp = (const f32x4*)(wqb + (size_t)k * 1024 + h * 64); float a = 0.f;
#pragma unroll
        for (int d4 = 0; d4 < 16; ++d4) { const f32x4 q = qp[d4]; a = fmaf(q[0], uk[4 * d4], a); a = fmaf(q[1], uk[4 * d4 + 1], a); a = fmaf(q[2], uk[4 * d4 + 2], a); a = fmaf(q[3], uk[4 * d4 + 3], a); }
        scr[kk * 33 + rr] = a * gq[k]; }
    LDS_WAIT(); asm volatile("" ::: "memory");
    const int cc = lane & 7; bf16* out = W2l + (size_t)(h * 256 + rb * 32) * 512;
#pragma unroll
    for (int j = 0; j < 4; ++j) { const int n = (lane >> 3) + 8 * j; const LAS float* s = scr + (8 * cc) * 33 + n;
        v4u o; o.x = pkh(s[0 * 33], s[1 * 33]); o.y = pkh(s[2 * 33], s[3 * 33]); o.z = pkh(s[4 * 33], s[5 * 33]); o.w = pkh(s[6 * 33], s[7 * 33]);
        *(GAS v4u*)(out + (size_t)n * 512 + kb * 64 + 8 * cc) = o; }
    LDS_WAIT(); asm volatile("" ::: "memory");
}

typedef const __attribute__((address_space(4))) Args KArgs;
__device__ __forceinline__ KArgs* kargs() { size_t z = 0; asm volatile("" : "+s"(z)); return (KArgs*)((const __attribute__((address_space(4))) unsigned char*)__builtin_amdgcn_kernarg_segment_ptr() + z); }
struct Ctx {
    LAS unsigned char* lds; int tid, lane, wave, G, gw, NGW, bid;
};
#if defined(__HIP_DEVICE_COMPILE__)
#define ASSUME_GLOBAL(p) do { __builtin_assume(!__builtin_amdgcn_is_shared((const void*)(p))); __builtin_assume(!__builtin_amdgcn_is_private((const void*)(p))); } while (0)
#else
#define ASSUME_GLOBAL(p) do { } while (0)
#endif
__device__ __forceinline__ unsigned char* launder(unsigned char* p) { size_t z = 0; asm volatile("" : "+s"(z)); return p + z; }
__device__ __forceinline__ const float* launderf(const float* p) { size_t z = 0; asm volatile("" : "+s"(z)); return p + z; }
struct Bufs {
    bf16 *W1, *W2, *WA, *WB, *WO, *WUV, *VT, *KV, *KIDX, *RHO, *SGB, *HB, *PROJ, *CQN, *CKVN, *Q2, *OLAT, *YA, *YB, *MG; float *H, *RS, *RS2, *RSQ, *RSQ2, *PA;
    __device__ __forceinline__ explicit Bufs(unsigned char* ws0) {
        unsigned char* ws = launder(ws0);
        W1 = (bf16*)(ws + WS_W1); W2 = (bf16*)(ws + WS_W2); WA = (bf16*)(ws + WS_WA); WB = (bf16*)(ws + WS_WB); WO = (bf16*)(ws + WS_WO); WUV = (bf16*)(ws + WS_WUV); VT = (bf16*)(ws + WS_VT); KV = (bf16*)(ws + WS_KV); KIDX = (bf16*)(ws + WS_KIDX); RHO = (bf16*)(ws + WS_RHO); SGB = (bf16*)(ws + WS_SGB);
        H = (float*)(ws + WS_H); HB = (bf16*)(ws + WS_HB); RS = (float*)(ws + WS_RS); RS2 = (float*)(ws + WS_RS2); RSQ = (float*)(ws + WS_RSQ); RSQ2 = (float*)(ws + WS_RSQ2); PROJ = (bf16*)(ws + WS_PROJ); CQN = (bf16*)(ws + WS_CQN); CKVN = (bf16*)(ws + WS_CKVN);
        Q2 = (bf16*)(ws + WS_Q2); OLAT = (bf16*)(ws + WS_OLAT); YA = (bf16*)(ws + WS_YA); YB = (bf16*)(ws + WS_YB); PA = (float*)(ws + WS_PA); MG = (bf16*)(ws + WS_MG);
    }
};

__device__ __forceinline__ void p0_prologue(const Ctx& C) {
    const Bufs B(kargs()->ws);
    const KArgs& A = *kargs();
    LAS float* scr = (LAS float*)(C.lds + RING_OFF + C.wave * 16384);
    constexpr int I_T1 = (DM / 64) * (NP1 / 32), I_T2 = (512 / 64) * (512 / 32), I_T3 = (1024 / 64) * (DM / 32), I_T5 = (DM / 64) * (DM / 32), I_F = 16 * 8 * 8, I_UV = 16 * 8;
    constexpr int I_X = I_T1 + I_T2 + 2 * I_T3 + I_T5, NX = NLAYER * I_X;
    auto decode = [&](int it) -> XDesc {
        const int l = it / I_X; int r = it % I_X; XDesc d;
        if (r < I_T1) { const int nblk = NP1 / 32, kb = r / nblk, n0 = (r % nblk) * 32; int c0, nvalid = 32;
            if (n0 < 4096) c0 = n0; else if (n0 < 8192) { const int tt = (n0 - 4096) >> 8, wi = (n0 - 4096) & 255; c0 = (wi < 128 ? 4168 : 6216 - 128) + 128 * tt + wi; }
            else { c0 = n0 - 8192 + 4096; nvalid = (8264 - n0) < 0 ? 0 : ((8264 - n0) > 32 ? 32 : (8264 - n0)); }
            d = XDesc{A.w_in + (size_t)l * DM * NC_IN, A.norm_g + l * DM, B.W1 + ((size_t)l * NP1 + n0) * DM, NC_IN, kb * 64, c0, nvalid, DM}; return d; }
        r -= I_T1;
        if (r < I_T2) { const int nblk = 512 / 32, kb = r / nblk, nb = r % nblk;
            d = XDesc{A.w_iq + (size_t)l * 512 * 512, A.q_norm_g + l * 512, B.W2 + ((size_t)l * NQ2 + 4096 + nb * 32) * 512, 512, kb * 64, nb * 32, 32, 512}; return d; }
        r -= I_T2;
        if (r < 2 * I_T3) { const bool second = r >= I_T3; if (second) r -= I_T3; const int nblk = DM / 32, kb = r / nblk, nb = r % nblk;
            d = XDesc{(second ? A.w_proj_b : A.w_proj_a) + (size_t)l * 1024 * DM, nullptr, (second ? B.WB : B.WA) + ((size_t)l * DM + nb * 32) * 2048, DM, kb * 64, nb * 32, 32, 2048}; return d; }
        r -= 2 * I_T3;
        { const int nblk = DM / 32, kb = r / nblk, nb = r % nblk;
            d = XDesc{A.w_out + (size_t)l * DM * DM, nullptr, B.WO + ((size_t)l * DM + nb * 32) * DM, DM, kb * 64, nb * 32, 32, DM}; return d; }
    };
    {
        int it = C.gw;
        if (it < NX) {
            XDesc dA = decode(it), dB = dA, dC = dA; float vA[32], vB[32], vC[32];
            xpose_load(dA, vA, C.lane);
            if (it + C.NGW < NX) { dB = decode(it + C.NGW); xpose_load(dB, vB, C.lane); }
#define PRO_STEP(dc_, vc_, dn_, vn_) { if (it + 2 * C.NGW < NX) { dn_ = decode(it + 2 * C.NGW); xpose_load(dn_, vn_, C.lane); } xpose_store(dc_, vc_, scr, C.lane); it += C.NGW; if (it >= NX) break; }
            for (;;) {
                PRO_STEP(dA, vA, dC, vC)
                PRO_STEP(dB, vB, dA, vA)
                PRO_STEP(dC, vC, dB, vB)
            }
#undef PRO_STEP
        }
    }
    for (int it = C.gw; it < NLAYER * (I_F + I_UV); it += C.NGW) {
        const int l = it / (I_F + I_UV); int r = it % (I_F + I_UV);
        if (r >= I_F) { r -= I_F; const int h = r / 8, s = r % 8;
            const float* wsrc = A.w_uv + ((size_t)l * 16 + h) * 256 * 64; const int gg = C.lane >> 4, cc = C.lane & 15;
#pragma unroll
            for (int nt = 0; nt < 4; ++nt) { const float* p = wsrc + (size_t)(32 * s + 8 * gg) * 64 + 16 * nt + cc;
                v4u o; o.x = pkh(p[0 * 64], p[1 * 64]); o.y = pkh(p[2 * 64], p[3 * 64]); o.z = pkh(p[4 * 64], p[5 * 64]); o.w = pkh(p[6 * 64], p[7 * 64]);
                *(GAS v4u*)(B.WUV + ((((size_t)l * 16 + h) * 8 + s) * 4 + nt) * 512 + C.lane * 8) = o; }
            continue; }
        { const int h = r / 64, kb = (r / 8) % 8, rb = r % 8;
            fold_item(A.w_qb + (size_t)l * 512 * 1024, A.w_uk + (size_t)l * 16 * 64 * 256, A.q_norm_g + l * 512, B.W2 + (size_t)l * NQ2 * 512, h, kb, rb, scr, C.lane); }
    }
    for (int m = C.gw; m < MP; m += C.NGW) {
        const float* src = nullptr;
        if (m < 8192) src = A.x + (size_t)m * DM; else if (m < 8224) src = A.meta + (size_t)((m - 8192) % NMETA) * DM;
        float ss = 0.f;
#pragma unroll
        for (int j = 0; j < 8; ++j) { f32x4 v = src ? *(const f32x4*)(src + j * 256 + C.lane * 4) : (f32x4){0.f, 0.f, 0.f, 0.f};
            pg8::u32x2 w; w.x = pkh(v[0], v[1]); w.y = pkh(v[2], v[3]); *(pg8::u32x2*)(B.HB + (size_t)m * DM + j * 256 + C.lane * 4) = w;
            ss += (v[0] * v[0] + v[1] * v[1]) + (v[2] * v[2] + v[3] * v[3]); }
        ss = wave_sum(ss);
        if (C.lane < 32) B.RS[(size_t)m * 32 + C.lane] = (C.lane == 0) ? ss : 0.f;
        if (m >= 8192 && m < 8224) B.RS2[(size_t)(m - 8192) * 64 + C.lane] = (C.lane == 0) ? ss : 0.f;
        if (m >= NTOK) {
#pragma unroll
            for (int j = 0; j < 2; ++j) { *(v4u*)(B.YA + (size_t)m * YLD + j * 512 + C.lane * 8) = (v4u){0u, 0u, 0u, 0u}; *(v4u*)(B.YB + (size_t)m * YLD + j * 512 + C.lane * 8) = (v4u){0u, 0u, 0u, 0u}; }
        }
    }
}

template <int NP4>
__device__ __forceinline__ void rstd_table(const Ctx& C, const pg8::StaticOrder& S, const float* __restrict__ rs, float inv_dim) {
    LAS float* tbl = (LAS float*)(C.lds + RSTD_OFF);
    pg8::Unit u;
    for (int ui = 0; ui < 5 && S.next(ui, u); ++ui) {
        if (C.tid < 256) { const f32x4* p = (const f32x4*)(rs + (size_t)(u.pm * 256 + C.tid) * (NP4 * 4)); float s = 0.f;
#pragma unroll
            for (int j = 0; j < NP4; ++j) { const f32x4 v = p[j]; s += (v[0] + v[1]) + (v[2] + v[3]); }
            tbl[ui * 256 + C.tid] = rsqrtf(s * inv_dim + RMS_EPS); }
    }
    __syncthreads();
}

__device__ __forceinline__ void norm_tail(const Ctx& C, int l) {
    const Bufs B(kargs()->ws);
    const KArgs& A = *kargs();
    const int gw2 = (C.G == 256) ? C.gw - 64 * NWAVES : C.gw, ngw2 = (C.G == 256) ? C.NGW - 64 * NWAVES : C.NGW;
    if (gw2 < 0) return;
    for (int m = gw2; m < NTOK; m += ngw2) {
        const bf16* pr = B.PROJ + (size_t)m * NP1;
        { const pg8::u32x2 w = *(const pg8::u32x2*)(pr + PC_CKV + C.lane * 4); float v[4] = {pg8::bf_lo(w.x), pg8::bf_hi(w.x), pg8::bf_lo(w.y), pg8::bf_hi(w.y)};
          float ss = (v[0] * v[0] + v[1] * v[1]) + (v[2] * v[2] + v[3] * v[3]);
          ss = wave_sum(ss); const float r = rsqrtf(ss * (1.0f / 256.0f) + RMS_EPS);
          const f32x4 g = *(const f32x4*)(A.kv_norm_g + l * 256 + C.lane * 4);
          pg8::u32x2 o; o.x = pkh(v[0] * r * g[0], v[1] * r * g[1]); o.y = pkh(v[2] * r * g[2], v[3] * r * g[3]);
          *(pg8::u32x2*)(B.CKVN + (size_t)m * 256 + C.lane * 4) = o; }
    }
    for (int it = gw2; it < 2 * 65; it += ngw2) { const int b = it / 65, pos = (it % 65) * 64 + C.lane;
        if (pos < LTOK) { const bf16* vr = B.KV + (size_t)rowof(b, pos) * 256 + 128;
#pragma unroll 4
            for (int c8 = 0; c8 < 16; ++c8) { const v4u w = *(const v4u*)(vr + 8 * c8); bf16* o = B.VT + ((size_t)b * 128 + 8 * c8) * 4128 + pos;
                o[0 * 4128] = (bf16)(w.x & 0xffffu); o[1 * 4128] = (bf16)(w.x >> 16); o[2 * 4128] = (bf16)(w.y & 0xffffu); o[3 * 4128] = (bf16)(w.y >> 16);
                o[4 * 4128] = (bf16)(w.z & 0xffffu); o[5 * 4128] = (bf16)(w.z >> 16); o[6 * 4128] = (bf16)(w.w & 0xffffu); o[7 * 4128] = (bf16)(w.w >> 16); } } }
}

__device__ __forceinline__ unsigned f2key(float f) { const unsigned u = __float_as_uint(f); return (u & 0x80000000u) ? ~u : (u | 0x80000000u); }

__device__ __forceinline__ void final_phase(const Ctx& C) {
    const Bufs B(kargs()->ws);
    const KArgs& A = *kargs();
    for (int m = C.gw; m < 8192; m += C.NGW) {
        float s = (C.lane < 32) ? B.RS[(size_t)m * 32 + C.lane] : 0.f;
        s = wave_sum(s);
        const float r = rsqrtf(s * (1.0f / DM) + RMS_EPS);
#pragma unroll
        for (int j = 0; j < 8; ++j) { const pg8::u32x2 hw = *(const pg8::u32x2*)(B.HB + (size_t)m * DM + j * 256 + C.lane * 4); const f32x4 v = {pg8::bf_lo(hw.x), pg8::bf_hi(hw.x), pg8::bf_lo(hw.y), pg8::bf_hi(hw.y)}; const f32x4 g = *(const f32x4*)(A.final_g + j * 256 + C.lane * 4);
            *(f32x4*)(A.out + (size_t)m * DM + j * 256 + C.lane * 4) = v * r * g; }
    }
#if defined(MK_PROBE)
    if (MK_PROBE >= 0 && C.gw == 0) { VM_WAIT(); if (C.lane == 0) { float* o0 = A.out; o0[0] += (float)__hip_atomic_load((gu32*)(A.ws + WS_CTL) + 3, RLX_AGENT) * MK_PROBE_SCALE; } }
#endif
}


struct SkProj {
    bf16* P; bf16* KV; bf16* KIDX; int cb; const LAS float* tbl;
    __device__ __forceinline__ float operator()(int rloc, int c, float v) const { const int ac = cb + c; const bf16 o = (bf16)f2bf(v * tbl[rloc]);
        if (ac >= 1024 && ac < 1280) KV[(size_t)rloc * 256 + ac - 1024] = o; else if (ac >= 8192 && ac < 8256) KIDX[(size_t)rloc * 64 + ac - 8192] = o; else P[(size_t)rloc * NP1 + ac] = o;
        return v * tbl[rloc]; } };
struct SkQ2 { bf16* O; const LAS float* tbl; __device__ __forceinline__ float operator()(int rloc, int c, float v) const { O[(size_t)rloc * NQ2 + c] = (bf16)f2bf(v * tbl[rloc]); return 0.f; } };
struct SkPA { float* P; const bf16* G; int c0; __device__ __forceinline__ float operator()(int rloc, int c, float v) const { const int cg = c0 + c; P[(size_t)rloc * DM + c] = sigmoidf_(bf2f(G[(size_t)rloc * NP1 + 256 * (cg >> 7) + (cg & 127)])) * v; return 0.f; } };
struct SkMerge { bf16* O; const float* P; const bf16* G; int c0; __device__ __forceinline__ float operator()(int rloc, int c, float v) const { const int cg = c0 + c; O[(size_t)rloc * DM + c] = (bf16)f2bf(P[(size_t)rloc * DM + c] + sigmoidf_(bf2f(G[(size_t)rloc * NP1 + 256 * (cg >> 7) + (cg & 127) + 128])) * v); return 0.f; } };
struct SkRes { bf16* HB; __device__ __forceinline__ float operator()(int rloc, int c, float v) const { const float h = bf2f(HB[(size_t)rloc * DM + c]) + v; HB[(size_t)rloc * DM + c] = (bf16)f2bf(h); return h; } };
constexpr int MR = 8192;
typedef float f32x16 __attribute__((ext_vector_type(16)));
__device__ __forceinline__ void sk_glds16(const void* gsrc, unsigned lds_dst) { unsigned keep;
    asm volatile("s_mov_b32 %0, m0\n\ts_mov_b32 m0, %2\n\ts_nop 0\n\tglobal_load_lds_dwordx4 %1, off\n\ts_mov_b32 m0, %0" : "=&s"(keep) : "v"(gsrc), "s"(lds_dst) : "memory"); }
template <int NT, int GPI, class F>
__device__ __forceinline__ void skinny_unit(const Ctx& C, const bf16* __restrict__ A, int lda, const bf16* __restrict__ Bt, int ldb, int K, float* ss_out  , int ss_ld, int ss_col0, const F& epi) {
    const int lane = C.lane, w = C.wave, r32 = lane & 31, hh = lane >> 5;
    f32x16 acc[NT];
#pragma unroll
    for (int nt = 0; nt < NT; ++nt) acc[nt] = (f32x16){};
    const int kper = K >> 3, ngroups = kper >> 6;
    const unsigned stg = (unsigned)__builtin_amdgcn_readfirstlane((unsigned)(uintptr_t)(C.lds + RING_OFF) + (unsigned)w * 16384u);
    LAS unsigned char* stp = C.lds + RING_OFF + w * 16384;
    const int prow = lane >> 3, pch = lane & 7;
    const int foff = r32 * 128;
    const int fsw = (r32 >> 1) & 7;
#pragma unroll 1
    for (int g0 = 0; g0 < ngroups; ++g0) {
        const size_t kbyte = ((size_t)w * kper + (size_t)g0 * 64) * 2;
#pragma unroll
        for (int p = 0; p < 4; ++p) { const int row = 8 * p + prow; const int lg = pch ^ ((row >> 1) & 7);
            sk_glds16((const unsigned char*)A + (size_t)row * lda * 2 + kbyte + lg * 16, stg + p * 1024); }
#pragma unroll
        for (int nt = 0; nt < NT; ++nt)
#pragma unroll
            for (int p = 0; p < 4; ++p) { const int row = 8 * p + prow; const int lg = pch ^ ((row >> 1) & 7);
                sk_glds16((const unsigned char*)Bt + (size_t)(nt * 32 + row) * ldb * 2 + kbyte + lg * 16, stg + 4096 * (1 + nt) + p * 1024); }
        asm volatile("s_waitcnt vmcnt(0)" ::: "memory");
        bf16x8 a[4], bv[NT][4];
#pragma unroll
        for (int s = 0; s < 4; ++s) { const int o = foff + (((2 * s + hh) ^ fsw) << 4); a[s] = *(const LAS bf16x8*)(stp + o);
#pragma unroll
            for (int nt = 0; nt < NT; ++nt) bv[nt][s] = *(const LAS bf16x8*)(stp + 4096 * (1 + nt) + o); }
        __builtin_amdgcn_sched_barrier(0);
#pragma unroll
        for (int s = 0; s < 4; ++s)
#pragma unroll
            for (int nt = 0; nt < NT; ++nt) acc[nt] = __builtin_amdgcn_mfma_f32_32x32x16_bf16(a[s], bv[nt][s], acc[nt], 0, 0, 0);
        LDS_WAIT(); asm volatile("" ::: "memory");
    }
    LDS_WAIT(); __syncthreads();
    LAS float* part = (LAS float*)(C.lds + RING_OFF);
#pragma unroll
    for (int nt = 0; nt < NT; ++nt)
#pragma unroll
        for (int i = 0; i < 16; ++i) part[(w * NT * 16 + nt * 16 + i) * 64 + lane] = acc[nt][i];
    LDS_WAIT(); __syncthreads();
#pragma unroll
    for (int j = 0; j < 2 * NT; ++j) { const int e = (w + 8 * j) * 64 + lane;
        const int nti = w + 8 * j, nt = nti >> 4, i = nti & 15;
        float v = 0.f;
#pragma unroll
        for (int ww = 0; ww < 8; ++ww) v += part[ww * NT * 1024 + e];
        const int rloc = (i & 3) + 8 * (i >> 2) + 4 * hh, c = nt * 32 + r32;
        float sv = epi(rloc, c, v);
        if (ss_out != nullptr) { sv = sv * sv;
#pragma unroll
            for (int o = 1; o < 32; o <<= 1) sv += __shfl_xor(sv, o);
            if (r32 == 0) ss_out[(size_t)rloc * ss_ld + ss_col0 + nt] = sv; }
    }
    LDS_WAIT(); __syncthreads();
}
__device__ __forceinline__ void skinny_rstd(const Ctx& C, const float* __restrict__ rs, int np, float inv_dim, LAS float* tbl) {
    if (C.tid < 32) { float s = 0.f; const f32x4* p = (const f32x4*)(rs + (size_t)C.tid * np);
        for (int j = 0; j < np / 4; ++j) { const f32x4 v = p[j]; s += (v[0] + v[1]) + (v[2] + v[3]); }
        tbl[C.tid] = rsqrtf(s * inv_dim + RMS_EPS); }
    LDS_WAIT(); __syncthreads();
}

typedef short s16x4 __attribute__((ext_vector_type(4)));
typedef unsigned short u16x4 __attribute__((ext_vector_type(4)));
constexpr int DS_ISC = RING_OFF, DS_ISC_WORDS = 4128, DS_ISC_STRIDE = DS_ISC_WORDS * 4;
constexpr int DS_SEL = DS_ISC + 8 * DS_ISC_STRIDE;
constexpr int DS_BIAS = DS_SEL + 8 * 512;
constexpr int DS_QROW = DS_BIAS + 8192;
constexpr int DS_END = DS_QROW + 256;
constexpr size_t OL_BLOCK = (size_t)3 * 16 * 8 * 64 * 8;
static_assert(DS_END <= LDS_BYTES, "DSA LDS map");

__device__ __forceinline__ void glds16(const void* gsrc, unsigned lds_dst) { unsigned keep;
    asm volatile("s_mov_b32 %0, m0\n\ts_mov_b32 m0, %2\n\ts_nop 0\n\tglobal_load_lds_dwordx4 %1, off\n\ts_mov_b32 m0, %0" : "=&s"(keep) : "v"(gsrc), "s"(lds_dst) : "memory"); }
__device__ __forceinline__ float relu1(float x) { const int i = __float_as_int(x); return __int_as_float(i > 0 ? i : 0); }
__device__ __forceinline__ void glds16o(const void* base, unsigned voff, unsigned lds_dst) { unsigned keep;
    asm volatile("s_mov_b32 %0, m0\n\ts_mov_b32 m0, %3\n\ts_nop 0\n\tglobal_load_lds_dwordx4 %1, %2\n\ts_mov_b32 m0, %0" : "=&s"(keep) : "v"(voff), "s"(base), "s"(lds_dst) : "memory"); }
__device__ __forceinline__ s16x4 tr_read(LAS unsigned char* p) { typedef short v4i16_t __attribute__((ext_vector_type(4))); return __builtin_bit_cast(s16x4, __builtin_amdgcn_ds_read_tr16_b64_v4i16((LAS v4i16_t*)p)); }
__device__ __forceinline__ unsigned cvtpk(float lo, float hi) { typedef float f2_t __attribute__((ext_vector_type(2))); typedef __bf16 b2_t __attribute__((ext_vector_type(2))); f2_t v = {lo, hi}; b2_t b = __builtin_convertvector(v, b2_t); return __builtin_bit_cast(unsigned, b); }

#define DSA_LOCALS() const int w = C.wave; LAS unsigned* ISC = (LAS unsigned*)(C.lds + DS_ISC); LAS unsigned short* sel = (LAS unsigned short*)(C.lds + DS_SEL) + w * 256; const LAS float* biasl = (const LAS float*)(C.lds + DS_BIAS); (void)ISC; (void)sel; (void)biasl
#define RELANE() do { asm volatile("" : "+v"(lane)); asm volatile("" : "+s"(t0), "+s"(b)); } while (0)
__device__ __forceinline__ void dsa_step1(const Ctx& C, const Bufs& B, int b, int t0) {
    int lane = C.lane; RELANE(); DSA_LOCALS();
    PROBE_T0();
    {
        const int r32 = lane & 31, hh = lane >> 5;
        bf16x8 qa[2][4]; float wq[2][2][8];
        const int qi = 2 * ((r32 >> 2) & 1) + (r32 >> 4), hA = (r32 & 3) + 4 * ((r32 >> 3) & 1);
#pragma unroll
        for (int g = 0; g < 2; ++g) { const int row = rowof(b, t0 + 4 * g + qi);
#pragma unroll
            for (int s = 0; s < 4; ++s) qa[g][s] = *(const bf16x8*)(B.Q2 + (size_t)row * NQ2 + 4096 + hA * 64 + 16 * s + 8 * hh);
#pragma unroll
            for (int j = 0; j < 2; ++j) { const int rw = rowof(b, t0 + 4 * g + 2 * hh + j); const v4u ww = *(const v4u*)(B.PROJ + (size_t)rw * NP1 + PC_WIDX);
                const float sc = 0.35355339059327373f * 0.125f;
                wq[g][j][0] = pg8::bf_lo(ww.x) * sc; wq[g][j][1] = pg8::bf_hi(ww.x) * sc; wq[g][j][2] = pg8::bf_lo(ww.y) * sc; wq[g][j][3] = pg8::bf_hi(ww.y) * sc;
                wq[g][j][4] = pg8::bf_lo(ww.z) * sc; wq[g][j][5] = pg8::bf_hi(ww.z) * sc; wq[g][j][6] = pg8::bf_lo(ww.w) * sc; wq[g][j][7] = pg8::bf_hi(ww.w) * sc; } }
        PROBE_T1(40);
        const int nkeys = t0 + 8, nkt = (nkeys + 31) >> 5;
        bf16x8 kA[4], kB[4];
#define IDX_LOAD(dst, kt_) do { const int key_ = (kt_) * 32 + r32, kc_ = key_ < nkeys ? key_ : nkeys - 1; const bf16* kp_ = B.KIDX + (size_t)rowof(b, kc_) * 64 + 8 * hh; \
        asm volatile("global_load_dwordx4 %0, %4, off\n\tglobal_load_dwordx4 %1, %4, off offset:32\n\tglobal_load_dwordx4 %2, %4, off offset:64\n\tglobal_load_dwordx4 %3, %4, off offset:96" \
                     : "=&v"(dst[0]), "=&v"(dst[1]), "=&v"(dst[2]), "=&v"(dst[3]) : "v"(kp_) : "memory"); } while (0)
#define IDX_WAIT(cur) asm volatile("s_waitcnt vmcnt(12)" : "+v"(cur[0]), "+v"(cur[1]), "+v"(cur[2]), "+v"(cur[3]) :: "memory")
#define IDX_TILE(src, kt_) do { const int key_ = (kt_) * 32 + r32; \
        _Pragma("unroll") for (int g = 0; g < 2; ++g) { f32x16 acc = {}; \
            _Pragma("unroll") for (int s = 0; s < 4; ++s) acc = __builtin_amdgcn_mfma_f32_32x32x16_bf16(qa[g][s], src[s], acc, 0, 0, 0); \
            _Pragma("unroll") for (int j = 0; j < 2; ++j) { float isc = 0.f; \
                _Pragma("unroll") for (int h = 0; h < 8; ++h) isc += wq[g][j][h] * relu1(acc[8 * j + h]); \
                ISC[(4 * g + 2 * hh + j) * DS_ISC_WORDS + key_] = f2key(isc); } } } while (0)
        bf16x8 kC[4], kD[4];
        int kt = w;
        const int ktl = nkt - 1;
        if (kt < nkt) {
            __builtin_amdgcn_s_waitcnt(0x0F70);
            IDX_LOAD(kA, kt); IDX_LOAD(kB, (kt + 8 < nkt ? kt + 8 : ktl)); IDX_LOAD(kC, (kt + 16 < nkt ? kt + 16 : ktl));
#define IDX_STEP(cur, nxt) { IDX_LOAD(nxt, (kt + 24 < nkt ? kt + 24 : ktl)); IDX_WAIT(cur); __builtin_amdgcn_sched_barrier(0); IDX_TILE(cur, kt); __builtin_amdgcn_sched_barrier(0); kt += 8; if (kt >= nkt) break; }
#pragma unroll 1
            for (;;) {
                IDX_STEP(kA, kD)
                IDX_STEP(kB, kA)
                IDX_STEP(kC, kB)
                IDX_STEP(kD, kC)
            }
#undef IDX_STEP
            asm volatile("s_waitcnt vmcnt(0)" : "+v"(kA[0]), "+v"(kA[1]), "+v"(kA[2]), "+v"(kA[3]), "+v"(kB[0]), "+v"(kB[1]), "+v"(kB[2]), "+v"(kB[3]) :: "memory");
            asm volatile("" : "+v"(kC[0]), "+v"(kC[1]), "+v"(kC[2]), "+v"(kC[3]), "+v"(kD[0]), "+v"(kD[1]), "+v"(kD[2]), "+v"(kD[3]) :: "memory");
        }
#undef IDX_WAIT
#undef IDX_LOAD
#undef IDX_TILE
        PROBE_T1(41);
    }
}
__device__ __forceinline__ int dsa_step2(const Ctx& C, int b, int t0) {
    int lane = C.lane; RELANE(); DSA_LOCALS();
    const int t = t0 + w, n = t + 1;
    int cnt;
    if (n <= TOPK) { for (int j = lane; j < n; j += 64) sel[j] = (unsigned short)j; cnt = n; }
    else {
        const LAS unsigned* myrow = ISC + w * DS_ISC_WORDS;
        const int nI = (n + 255) >> 8;
        unsigned v[68];
#pragma unroll
        for (int i = 0; i < 17; ++i) { const pg8::u32x4 x = *(const LAS pg8::u32x4*)(myrow + 256 * i + 4 * lane);
#pragma unroll
            for (int e = 0; e < 4; ++e) v[4 * i + e] = (256 * i + 4 * lane + e <= t) ? x[e] : 0u; }
        unsigned T = 0u; bool exact = false;
#define DSA_COUNT(res, cand_) do { int c_ = 0; const unsigned t_ = (cand_); \
        _Pragma("unroll") for (int i = 0; i < 17; ++i) { if (i < nI) { unsigned long long m0_, m1_, m2_, m3_; \
            asm volatile("v_cmp_ge_u32_e64 %1, %5, %9\n\tv_cmp_ge_u32_e64 %2, %6, %9\n\tv_cmp_ge_u32_e64 %3, %7, %9\n\tv_cmp_ge_u32_e64 %4, %8, %9\n\t" \
                         "v_addc_co_u32_e64 %0, %1, 0, %0, %1\n\tv_addc_co_u32_e64 %0, %2, 0, %0, %2\n\tv_addc_co_u32_e64 %0, %3, 0, %0, %3\n\tv_addc_co_u32_e64 %0, %4, 0, %0, %4" \
                         : "+v"(c_), "=&s"(m0_), "=&s"(m1_), "=&s"(m2_), "=&s"(m3_) : "v"(v[4 * i]), "v"(v[4 * i + 1]), "v"(v[4 * i + 2]), "v"(v[4 * i + 3]), "v"(t_)); } } \
        int tot_ = 0; _Pragma("unroll") for (int bt = 0; bt < 7; ++bt) tot_ += __popcll(__ballot((c_ >> bt) & 1)) << bt; res = tot_; } while (0)
        {
            unsigned kmax = 0u, kmin = 0xffffffffu;
#pragma unroll
            for (int i = 0; i < 17; ++i) { if (i < nI) {
#pragma unroll
                for (int e = 0; e < 4; ++e) { const unsigned x = v[4 * i + e]; kmax = x > kmax ? x : kmax; const unsigned y = x ? x : 0xffffffffu; kmin = y < kmin ? y : kmin; } } }
#pragma unroll
            for (int o = 1; o < 64; o <<= 1) { const unsigned a = (unsigned)__shfl_xor((int)kmax, o), bq = (unsigned)__shfl_xor((int)kmin, o); kmax = a > kmax ? a : kmax; kmin = bq < kmin ? bq : kmin; }
#define DSA_K2F(k_) __uint_as_float(((k_) & 0x80000000u) ? ((k_) & 0x7fffffffu) : ~(k_))
            float lo = DSA_K2F(kmin), hi = DSA_K2F(kmax), flo = (float)(n - TOPK), fhi = (float)(1 - TOPK); int side = 0;
#pragma unroll 1
            for (int it = 0; it < 20 && !exact; ++it) {
                float x = (lo * fhi - hi * flo) / (fhi - flo);
                if (!(x > lo && x < hi)) x = 0.5f * (lo + hi);
                if (!(x > lo && x < hi)) break;
                const unsigned cand = f2key(x); int c;
                DSA_COUNT(c, cand);
                if (c == TOPK) { T = cand; exact = true; }
                else if (c > TOPK) { lo = x; flo = (float)(c - TOPK); if (side == 1) fhi *= 0.5f; side = 1; }
                else { hi = x; fhi = (float)(c - TOPK); if (side == -1) flo *= 0.5f; side = -1; }
            }
#undef DSA_K2F
        }
        if (!exact) {
            T = 0u;
#pragma unroll 1
            for (int bit = 31; bit >= 0; --bit) {
                const unsigned cand = T | (1u << bit); int c;
                DSA_COUNT(c, cand);
                if (c >= TOPK) { T = cand; if (c == TOPK) { exact = true; break; } }
            }
            if (!exact) { int c; DSA_COUNT(c, T); exact = (c == TOPK); }
        }
#undef DSA_COUNT
        int base = 0;
#pragma unroll
        for (int k = 0; k < 68; ++k) { const bool p = exact ? (v[k] >= T) : (v[k] > T); const unsigned long long m = __ballot(p);
            const int pos = base + (int)__builtin_amdgcn_mbcnt_hi((unsigned)(m >> 32), __builtin_amdgcn_mbcnt_lo((unsigned)m, 0u));
            if (p) sel[pos] = (unsigned short)(256 * (k >> 2) + 4 * lane + (k & 3));
            base += __popcll(m); }
        if (!exact) {
            int last = -1;
            while (base < TOPK) { int mi = 0x7fffffff;
#pragma unroll
                for (int k = 0; k < 68; ++k) { const int idx = 256 * (k >> 2) + 4 * lane + (k & 3); if (v[k] == T && idx > last && idx < mi) mi = idx; }
#pragma unroll
                for (int o = 1; o < 64; o <<= 1) { const int oth = __shfl_xor(mi, o); mi = oth < mi ? oth : mi; }
                if (lane == 0) sel[base] = (unsigned short)mi;
                last = mi; ++base; }
        }
        cnt = TOPK;
    }
    return cnt;
}
__device__ __forceinline__ void dsa_step3(const Ctx& C, const Bufs& B, int b, int t0, int cnt, int qslot) {
    int lane = C.lane; RELANE(); DSA_LOCALS(); const int t = t0 + w;
    {
        const int g = lane >> 4, c16 = lane & 15, rowq = rowof(b, t);
        bf16x8 qf[8];
#pragma unroll
        for (int s = 0; s < 8; ++s) qf[s] = *(const bf16x8*)(B.Q2 + (size_t)rowq * NQ2 + c16 * 256 + 32 * s + 8 * g);
        f32x4 O[16];
#pragma unroll
        for (int rt = 0; rt < 16; ++rt) O[rt] = (f32x4){0.f, 0.f, 0.f, 0.f};
        float m_ref = 0.f, lsum = 0.f;
        const int buf0 = DS_ISC + w * DS_ISC_STRIDE;
        const int npairs = (cnt + 31) >> 5;
        const int swz = (c16 & 7) << 1;
        const int trow = 4 * g + (c16 >> 2), tswz = (trow & 7) << 1, tp = c16 & 3;
        const int arow = (c16 & 7) * 1024 + (c16 >> 3) * 512, trowo = (trow & 7) * 1024 + (trow >> 3) * 512;
        const unsigned ldsb = (unsigned)(uintptr_t)(C.lds + buf0);
#define DSA_GATHER(c_) do { const unsigned bo_ = (unsigned)__builtin_amdgcn_readfirstlane(ldsb + ((c_) & 1) * 8192); \
        const pg8::u32x4 sp_ = *(const LAS pg8::u32x4*)(sel + 16 * (c_) + 8 * (lane >> 5)); const unsigned spw_[4] = {sp_.x, sp_.y, sp_.z, sp_.w}; \
        _Pragma("unroll") for (int p = 0; p < 8; ++p) { const int j = 16 * (c_) + 8 * (lane >> 5) + p; int pos = (int)((spw_[p >> 1] >> (16 * (p & 1))) & 0xffffu); pos = j < cnt ? pos : 0; \
            const int logical = (lane & 31) ^ (p << 1); \
            glds16o(B.CKVN, (unsigned)rowof(b, pos) * 512u + (unsigned)logical * 16u, bo_ + p * 1024); } } while (0)
        DSA_GATHER(0); DSA_GATHER(1);
#pragma unroll 1
        for (int kp = 0; kp < npairs; ++kp) {
            asm volatile("s_waitcnt vmcnt(0)" ::: "memory");
            bf16x8 a0[8], a1[8]; s16x4 v0[16], v1[16];
#pragma unroll
            for (int s = 0; s < 8; ++s) { const int off = arow + (((4 * s + g) ^ swz) << 4); a0[s] = *(const LAS bf16x8*)(C.lds + buf0 + off); a1[s] = *(const LAS bf16x8*)(C.lds + buf0 + 8192 + off); }
            const u16x4 p0 = *(const LAS u16x4*)(sel + 32 * kp + 4 * g), p1 = *(const LAS u16x4*)(sel + 32 * kp + 16 + 4 * g);
            __builtin_amdgcn_sched_barrier(0);
            f32x4 s0 = {0.f, 0.f, 0.f, 0.f}, s1 = {0.f, 0.f, 0.f, 0.f};
#pragma unroll
            for (int s = 0; s < 8; ++s) { s0 = __builtin_amdgcn_mfma_f32_16x16x32_bf16(a0[s], qf[s], s0, 0, 0, 0); s1 = __builtin_amdgcn_mfma_f32_16x16x32_bf16(a1[s], qf[s], s1, 0, 0, 0); }
            __builtin_amdgcn_sched_barrier(0);
#pragma unroll
            for (int rt = 0; rt < 16; ++rt) { const int off = trowo + (((2 * rt + (tp >> 1)) ^ tswz) << 4) + 8 * (tp & 1); v0[rt] = tr_read(C.lds + buf0 + off); v1[rt] = tr_read(C.lds + buf0 + 8192 + off); }
            __builtin_amdgcn_sched_barrier(0);
            LDS_WAIT(); asm volatile("" ::: "memory");
            if (kp + 1 < npairs) { DSA_GATHER(2 * kp + 2); DSA_GATHER(2 * kp + 3); }
            __builtin_amdgcn_sched_barrier(0);
            float x0[4], x1[4]; float mloc = -INFINITY;
#pragma unroll
            for (int i = 0; i < 4; ++i) { const int j0 = 32 * kp + 4 * g + i, j1 = j0 + 16; int d0 = t - (int)p0[i], d1 = t - (int)p1[i]; d0 = d0 < 0 ? 0 : (d0 > 127 ? 127 : d0); d1 = d1 < 0 ? 0 : (d1 > 127 ? 127 : d1);
                const float b0 = biasl[d0 * 16 + c16], b1 = biasl[d1 * 16 + c16];
                const float y0 = 0.125f * s0[i] + b0, y1 = 0.125f * s1[i] + b1;
                x0[i] = (j0 < cnt) ? y0 : -INFINITY; x1[i] = (j1 < cnt) ? y1 : -INFINITY;
                mloc = fmaxf(mloc, fmaxf(x0[i], x1[i])); }
            mloc = fmaxf(mloc, __shfl_xor(mloc, 16)); mloc = fmaxf(mloc, __shfl_xor(mloc, 32));
            if (kp == 0) m_ref = mloc;
            else if (__any(mloc > m_ref + 8.0f)) { const float mn = fmaxf(m_ref, mloc), al = __expf(m_ref - mn);
#pragma unroll
                for (int rt = 0; rt < 16; ++rt) O[rt] *= al;
                lsum *= al; m_ref = mn; }
            float pe0[4], pe1[4];
#pragma unroll
            for (int i = 0; i < 4; ++i) { pe0[i] = __expf(x0[i] - m_ref); pe1[i] = __expf(x1[i] - m_ref); lsum += pe0[i] + pe1[i]; }
            pg8::u32x4 pw; pw.x = cvtpk(pe0[0], pe0[1]); pw.y = cvtpk(pe0[2], pe0[3]); pw.z = cvtpk(pe1[0], pe1[1]); pw.w = cvtpk(pe1[2], pe1[3]);
            const bf16x8 pf = __builtin_bit_cast(bf16x8, pw);
#pragma unroll
            for (int rt = 0; rt < 16; ++rt) { const bf16x8 af = {v0[rt][0], v0[rt][1], v0[rt][2], v0[rt][3], v1[rt][0], v1[rt][1], v1[rt][2], v1[rt][3]};
                O[rt] = __builtin_amdgcn_mfma_f32_16x16x32_bf16(af, pf, O[rt], 0, 0, 0); }
            LDS_WAIT(); asm volatile("" ::: "memory");
        }
#undef DSA_GATHER
        lsum += __shfl_xor(lsum, 16); lsum += __shfl_xor(lsum, 32);
        const float inv = 1.0f / lsum;
#pragma unroll
        for (int rt = 0; rt < 16; ++rt) { const f32x4 o = O[rt] * inv; pg8::u32x2 wv; wv.x = cvtpk(o[0], o[1]); wv.y = cvtpk(o[2], o[3]);
            const int s_ = rt >> 1, gp = 2 * (rt & 1) + (g >> 1), jo = 4 * (g & 1);
            *(pg8::u32x2*)(B.OLAT + (size_t)C.bid * OL_BLOCK + ((((size_t)(qslot >> 4) * 16 + c16) * 8 + s_) * 64 + gp * 16 + (qslot & 15)) * 8 + jo) = wv; }
    }
}
__device__ __forceinline__ void dsa_wuv(const Ctx& C, const Bufs& B, int l, int nq) {
    const int lane = C.lane, w = C.wave, g = lane >> 4, c16 = lane & 15;
    const LAS int* qrow = (const LAS int*)(C.lds + DS_QROW);
    const int nmt = (nq + 15) >> 4;
#pragma unroll 1
    for (int hq = 0; hq < 2; ++hq) { const int h = 2 * w + hq;
        f32x4 Dv[3][4];
#pragma unroll
        for (int mt = 0; mt < 3; ++mt)
#pragma unroll
            for (int nt = 0; nt < 4; ++nt) Dv[mt][nt] = (f32x4){0.f, 0.f, 0.f, 0.f};
        const bf16* wb = B.WUV + (((size_t)l * 16 + h) * 32) * 512 + lane * 8;
        const bf16* ab = B.OLAT + (size_t)C.bid * OL_BLOCK + ((size_t)h * 8) * 512 + lane * 8;
        v4u zw[3][2];
        { const int slot = lane >> 2, d0 = (lane & 3) * 16;
#pragma unroll
          for (int mt = 0; mt < 3; ++mt) { const int q = mt * 16 + slot; const int row = qrow[q < nq ? q : 0];
#pragma unroll
              for (int hf = 0; hf < 2; ++hf) zw[mt][hf] = *(const v4u*)(B.PROJ + (size_t)row * NP1 + PC_ZB + h * 64 + d0 + 8 * hf); } }
        bf16x8 bwA[4], awA[3], bwB[4], awB[3];
#define WUV_LOAD(bw_, aw_, s_) do { _Pragma("unroll") for (int nt = 0; nt < 4; ++nt) bw_[nt] = *(const bf16x8*)(wb + ((s_) * 4 + nt) * 512); \
        _Pragma("unroll") for (int mt = 0; mt < 3; ++mt) { aw_[mt] = *(const bf16x8*)(ab + ((size_t)mt * 16 * 8 + (s_)) * 512);     } } while (0)
#define WUV_MMA(bw_, aw_) do { _Pragma("unroll") for (int mt = 0; mt < 3; ++mt) _Pragma("unroll") for (int nt = 0; nt < 4; ++nt) Dv[mt][nt] = __builtin_amdgcn_mfma_f32_16x16x32_bf16(aw_[mt], bw_[nt], Dv[mt][nt], 0, 0, 0); } while (0)
        WUV_LOAD(bwA, awA, 0);
#pragma unroll
        for (int s = 0; s < 8; s += 2) {
            WUV_LOAD(bwB, awB, s + 1);
            __builtin_amdgcn_sched_barrier(0);
            WUV_MMA(bwA, awA);
            __builtin_amdgcn_sched_barrier(0);
            if (s + 2 < 8) WUV_LOAD(bwA, awA, s + 2);
            __builtin_amdgcn_sched_barrier(0);
            WUV_MMA(bwB, awB);
            __builtin_amdgcn_sched_barrier(0);
        }
#undef WUV_LOAD
#undef WUV_MMA
        LAS float* stg = (LAS float*)(C.lds + RING_OFF + w * 4608);
#pragma unroll
        for (int mt = 0; mt < 3; ++mt) { if (mt < nmt) {
#pragma unroll
            for (int nt = 0; nt < 4; ++nt)
#pragma unroll
                for (int i = 0; i < 4; ++i) stg[(4 * g + i) * 68 + 16 * nt + c16] = Dv[mt][nt][i];
            LDS_WAIT(); asm volatile("" ::: "memory");
            const int slot = lane >> 2, q = mt * 16 + slot, d0 = (lane & 3) * 16;
            if (q < nq) { const int row = qrow[q]; const v4u zw_[2] = {zw[mt][0], zw[mt][1]};
                bf16* op = B.YB + (size_t)row * YLD + h * 64 + d0;
#pragma unroll
                for (int hf = 0; hf < 2; ++hf) { const v4u zw = zw_[hf];
                    const f32x4 xa = *(const LAS f32x4*)(stg + slot * 68 + d0 + 8 * hf), xb = *(const LAS f32x4*)(stg + slot * 68 + d0 + 8 * hf + 4);
                    v4u o; o.x = pk2(xa[0] * siluf_(pg8::bf_lo(zw.x)), xa[1] * siluf_(pg8::bf_hi(zw.x))); o.y = pk2(xa[2] * siluf_(pg8::bf_lo(zw.y)), xa[3] * siluf_(pg8::bf_hi(zw.y)));
                    o.z = pk2(xb[0] * siluf_(pg8::bf_lo(zw.z)), xb[1] * siluf_(pg8::bf_hi(zw.z))); o.w = pk2(xb[2] * siluf_(pg8::bf_lo(zw.w)), xb[3] * siluf_(pg8::bf_hi(zw.w)));
                    *(v4u*)(op + 8 * hf) = o; } }
            LDS_WAIT(); asm volatile("" ::: "memory"); } }
    }
}
#ifndef MK_DSUB
#define MK_DSUB 0
#endif
__device__ __forceinline__ void dsa_unit(const Ctx& C, const Bufs& B, int l, int b, int t0, int uidx) {
    { PROBE_T0(); for (int rep = 0; rep < ((MK_DSUB & 1) ? 2 : 1); ++rep) { dsa_step1(C, B, b, t0); LDS_WAIT(); PROBE_T1(10); __syncthreads(); } PROBE_T1(0); }
    int cnt = 0;
    { PROBE_T0(); for (int rep = 0; rep < ((MK_DSUB & 2) ? 2 : 1); ++rep) { cnt = dsa_step2(C, b, t0); LDS_WAIT(); asm volatile("" ::: "memory"); } PROBE_T1(1); }
    if (C.lane == 0) ((LAS int*)(C.lds + DS_QROW))[uidx * 8 + C.wave] = rowof(b, t0 + C.wave);
    { PROBE_T0(); for (int rep = 0; rep < ((MK_DSUB & 4) ? 2 : 1); ++rep) { dsa_step3(C, B, b, t0, cnt, uidx * 8 + C.wave); } PROBE_T1(2); }
}
#undef RELANE
#undef DSA_LOCALS

__device__ __forceinline__ void dsa_phase(const Ctx& C, int l) {
    const Bufs B(kargs()->ws);
    const KArgs& A = *kargs();
    for (int i = C.tid; i < 128 * 16; i += NWAVES * 64) { const int dd = i >> 4, h = i & 15; ((LAS float*)(C.lds + DS_BIAS))[i] = A.bias_table[t5_bucket(dd) * 32 + 16 + h]; }
    __syncthreads();
    gu32* qctr = (gu32*)(A.ws + WS_CTL) + CW_DSAQ + l * 128;
    LAS int* qslot = (LAS int*)(C.lds + DS_QROW) + 56;
    int nu = 0, myb = C.bid & 1; bool other = false;
    int s_next = 0;
#define DSA_GRAB_ISSUE() do { if (C.tid == 0) s_next = (int)__hip_atomic_fetch_add(qctr + myb * 64, 1u, __ATOMIC_RELAXED, __HIP_MEMORY_SCOPE_AGENT); } while (0)
#define DSA_GRAB_FINISH() do { if (C.tid == 0) { int s_ = s_next; \
        if (s_ >= 514 && !other) { s_ = (int)__hip_atomic_fetch_add(qctr + (myb ^ 1) * 64, 1u, __ATOMIC_RELAXED, __HIP_MEMORY_SCOPE_AGENT); s_ = s_ < 514 ? s_ + 1024 : -1; } \
        else if (s_ >= 514) s_ = -1; \
        qslot[0] = s_; } } while (0)
    DSA_GRAB_ISSUE(); DSA_GRAB_FINISH();
    LDS_WAIT(); __syncthreads();
    for (;;) {
        int s = qslot[0];
        const bool done = s < 0;
        if ((done && nu > 0) || nu == 6) {
            VM_WAIT(); LDS_WAIT(); __syncthreads(); { PROBE_T0(); dsa_wuv(C, B, l, nu * 8); PROBE_T1(3); } __syncthreads(); nu = 0; }
        if (done) break;
        int b = myb;
        if (s >= 1024) { s -= 1024; if (!other) { other = true; myb ^= 1; } b = myb; }
        DSA_GRAB_ISSUE();
        dsa_unit(C, B, l, b, 8 * (513 - s), nu); ++nu;
        DSA_GRAB_FINISH();
        { PROBE_T0(); LDS_WAIT(); __syncthreads(); PROBE_T1(7); }
    }
#undef DSA_GRAB_ISSUE
#undef DSA_GRAB_FINISH
    __syncthreads();
}

constexpr int VT_PITCH = 4128;
constexpr int SW_BIAS = RING_OFF;
constexpr int SW_WS = SW_BIAS + 8192;
constexpr int SW_STG = SW_WS + 1024;

constexpr int SW_Q = SW_STG, SW_WAVE = 16384, SW_SLOT = 4096;
__device__ __forceinline__ void swa_item(const Ctx& C, const Bufs& B, const float* __restrict__ sinks, int b, int head, int p0, bool meta) {
    const int lane = C.lane, r32 = lane & 31, hh = lane >> 5, g = head >> 3;
    const LAS float* biasl = (const LAS float*)(C.lds + SW_BIAS);
    LAS float* wsf = (LAS float*)(C.lds + SW_WS) + C.wave * 32;
    LAS unsigned char* wl = C.lds + SW_Q + C.wave * SW_WAVE;
    const unsigned wlb = (unsigned)__builtin_amdgcn_readfirstlane((unsigned)(uintptr_t)(C.lds + SW_Q) + (unsigned)C.wave * SW_WAVE);
    const int tq = p0 + r32;
    const int ntile = meta ? 1 : 6;
    PROBE_T0();
    const int prow = lane >> 3, pch = lane & 7, vrow = lane >> 2, vch = lane & 3;
#define SW_DMA_K(kt_, slot_) do { const int k0_ = ((kt_) == 0) ? 0 : p0 - 128 + 32 * ((kt_) - 1); \
        _Pragma("unroll") for (int p = 0; p < 4; ++p) { const int r_ = 8 * p + prow; int kp_ = k0_ + r_; kp_ = kp_ < 0 ? 0 : kp_; \
            glds16o(B.KV, (unsigned)rowof(b, kp_) * 512u + (unsigned)(g * 128 + ((pch ^ ((r_ >> 1) & 7)) << 4)), wlb + 4096u + (unsigned)(slot_) * SW_SLOT + p * 1024); } } while (0)
#define SW_DMA_V(kt_, slot_) do { const int k0_ = ((kt_) == 0) ? 0 : p0 - 128 + 32 * ((kt_) - 1); \
        _Pragma("unroll") for (int p = 0; p < 4; ++p) { const int r_ = 16 * p + vrow; int ks_ = k0_ + 8 * (vch ^ ((r_ >> 2) & 3)); ks_ = ks_ < 0 ? 0 : ks_; \
            glds16o(B.VT, (unsigned)((b * 128 + g * 64 + r_) * VT_PITCH + ks_) * 2u, wlb + 4096u + (unsigned)(slot_) * SW_SLOT + p * 1024); } } while (0)
    {
#pragma unroll
        for (int p = 0; p < 4; ++p) { const int r_ = 8 * p + prow; int tqq = p0 + r_; if (meta) tqq = tqq < NMETA ? tqq : NMETA - 1;
            glds16o(B.PROJ, ((unsigned)rowof(b, tqq) * (unsigned)NP1 + (unsigned)(PC_QA + head * 64)) * 2u + (unsigned)((pch ^ ((r_ >> 1) & 7)) << 4), wlb + p * 1024); }
    }
    SW_DMA_K(0, 0);
    if (!meta) { SW_DMA_K(1, 1); SW_DMA_K(2, 2); }
    const int foff = r32 * 128, fsw = (r32 >> 1) & 7;
    bf16x8 qf[4];
    if (meta) asm volatile("s_waitcnt vmcnt(0)" ::: "memory"); else asm volatile("s_waitcnt vmcnt(8)" ::: "memory");
#pragma unroll
    for (int s = 0; s < 4; ++s) qf[s] = *(const LAS bf16x8*)(wl + foff + (((2 * s + hh) ^ fsw) << 4));
    f32x16 S[6];
#pragma unroll
    for (int kt = 0; kt < 6; ++kt) {
        if (kt < ntile) {
            if (meta || kt >= 4) { if (kt == 4) asm volatile("s_waitcnt vmcnt(4)" ::: "memory"); else asm volatile("s_waitcnt vmcnt(0)" ::: "memory"); }
            else asm volatile("s_waitcnt vmcnt(8)" ::: "memory");
            bf16x8 kf[4];
#pragma unroll
            for (int s = 0; s < 4; ++s) kf[s] = *(const LAS bf16x8*)(wl + 4096 + (kt % 3) * SW_SLOT + foff + (((2 * s + hh) ^ fsw) << 4));
            __builtin_amdgcn_sched_barrier(0);
            f32x16 acc = {};
#pragma unroll
            for (int s = 0; s < 4; ++s) acc = __builtin_amdgcn_mfma_f32_32x32x16_bf16(kf[s], qf[s], acc, 0, 0, 0);
            S[kt] = acc;
            LDS_WAIT(); asm volatile("" ::: "memory");
            if (kt + 3 < ntile) SW_DMA_K(kt + 3, kt % 3);
        } else S[kt] = (f32x16){-INFINITY, -INFINITY, -INFINITY, -INFINITY, -INFINITY, -INFINITY, -INFINITY, -INFINITY, -INFINITY, -INFINITY, -INFINITY, -INFINITY, -INFINITY, -INFINITY, -INFINITY, -INFINITY};
    }
    PROBE_T1(50);
    SW_DMA_V(0, 0);
    if (!meta) { SW_DMA_V(1, 1); SW_DMA_V(2, 2); }
#pragma unroll
    for (int kt = 0; kt < 6; ++kt) {
        if (kt < ntile) {
            const int k0 = (kt == 0) ? 0 : p0 - 128 + 32 * (kt - 1);
            float bz[16];
#pragma unroll
            for (int i = 0; i < 16; ++i) { const int kp = k0 + (i & 3) + 8 * (i >> 2) + 4 * hh; int d = tq - kp; d = d < 0 ? 0 : (d > 127 ? 127 : d); bz[i] = biasl[head * 128 + d]; }
#pragma unroll
            for (int i = 0; i < 16; ++i) { const int kp = k0 + (i & 3) + 8 * (i >> 2) + 4 * hh; const int d = tq - kp;
                const bool ok = (kt == 0) ? (kp < NMETA && d >= 0) : (kp >= NMETA && d >= 0 && d < 128);
                const float x = 0.125f * S[kt][i] + bz[i];
                S[kt][i] = ok ? x : -INFINITY; }
        }
    }
    const float sink = sinks[head];
    float mx = sink;
#pragma unroll
    for (int kt = 0; kt < 6; ++kt)
#pragma unroll
        for (int i = 0; i < 16; ++i) mx = fmaxf(mx, S[kt][i]);
    mx = fmaxf(mx, __shfl_xor(mx, 32));
    float sum = 0.f;
#pragma unroll
    for (int kt = 0; kt < 6; ++kt)
#pragma unroll
        for (int i = 0; i < 16; ++i) { const float p = __expf(S[kt][i] - mx); S[kt][i] = p; sum += p; }
    sum += __shfl_xor(sum, 32);
    sum += __expf(sink - mx);
    if (hh == 0) wsf[r32] = sum;
    PROBE_T1(51);
    f32x16 O0 = {}, O1 = {};
#pragma unroll
    for (int kt = 0; kt < 6; ++kt) {
        if (kt < ntile) {
            if (meta || kt >= 4) { if (kt == 4) asm volatile("s_waitcnt vmcnt(4)" ::: "memory"); else asm volatile("s_waitcnt vmcnt(0)" ::: "memory"); }
            else asm volatile("s_waitcnt vmcnt(8)" ::: "memory");
            pg8::u32x2 vl[2][2], vh[2][2];
#pragma unroll
            for (int s2 = 0; s2 < 2; ++s2)
#pragma unroll
                for (int dt = 0; dt < 2; ++dt) { const int r_ = 32 * dt + r32; const LAS unsigned char* vp = wl + 4096 + (kt % 3) * SW_SLOT + r_ * 64 + 8 * hh; const int sw_ = (r_ >> 2) & 3;
                    vl[s2][dt] = *(const LAS pg8::u32x2*)(vp + (((2 * s2) ^ sw_) << 4)); vh[s2][dt] = *(const LAS pg8::u32x2*)(vp + (((2 * s2 + 1) ^ sw_) << 4)); }
            __builtin_amdgcn_sched_barrier(0);
#pragma unroll
            for (int s2 = 0; s2 < 2; ++s2) {
                pg8::u32x4 pw; pw.x = cvtpk(S[kt][8 * s2 + 0], S[kt][8 * s2 + 1]); pw.y = cvtpk(S[kt][8 * s2 + 2], S[kt][8 * s2 + 3]); pw.z = cvtpk(S[kt][8 * s2 + 4], S[kt][8 * s2 + 5]); pw.w = cvtpk(S[kt][8 * s2 + 6], S[kt][8 * s2 + 7]);
                const bf16x8 pf = __builtin_bit_cast(bf16x8, pw);
#pragma unroll
                for (int dt = 0; dt < 2; ++dt) { const pg8::u32x4 vw = {vl[s2][dt].x, vl[s2][dt].y, vh[s2][dt].x, vh[s2][dt].y}; const bf16x8 vf = __builtin_bit_cast(bf16x8, vw);
                    if (dt == 0) O0 = __builtin_amdgcn_mfma_f32_32x32x16_bf16(pf, vf, O0, 0, 0, 0); else O1 = __builtin_amdgcn_mfma_f32_32x32x16_bf16(pf, vf, O1, 0, 0, 0); }
            }
            LDS_WAIT(); asm volatile("" ::: "memory");
            if (kt + 3 < ntile) SW_DMA_V(kt + 3, kt % 3);
            __builtin_amdgcn_sched_barrier(0);
        }
    }
#undef SW_DMA_K
#undef SW_DMA_V
    PROBE_T1(52);
    LDS_WAIT(); asm volatile("" ::: "memory");
    LAS float* stg = (LAS float*)(wl + 4096);
#pragma unroll
    for (int i = 0; i < 16; ++i) { const int q = (i & 3) + 8 * (i >> 2) + 4 * hh; stg[q * 68 + r32] = O0[i]; stg[q * 68 + 32 + r32] = O1[i]; }
    LDS_WAIT(); asm volatile("" ::: "memory");
    { const int q = lane >> 1, d0 = (lane & 1) * 32, t = p0 + q;
      if (!meta || t < NMETA) { const int row = rowof(b, t); const float inv = 1.0f / wsf[q];
          const bf16* zp = B.PROJ + (size_t)row * NP1 + PC_ZA + head * 64 + d0; bf16* op = B.YA + (size_t)row * YLD + head * 64 + d0;
#pragma unroll
          for (int hf = 0; hf < 4; ++hf) { const v4u zw = *(const v4u*)(zp + 8 * hf);
              const f32x4 xa = *(const LAS f32x4*)(stg + q * 68 + d0 + 8 * hf) * inv, xb = *(const LAS f32x4*)(stg + q * 68 + d0 + 8 * hf + 4) * inv;
              v4u o; o.x = pk2(xa[0] * siluf_(pg8::bf_lo(zw.x)), xa[1] * siluf_(pg8::bf_hi(zw.x))); o.y = pk2(xa[2] * siluf_(pg8::bf_lo(zw.y)), xa[3] * siluf_(pg8::bf_hi(zw.y)));
              o.z = pk2(xb[0] * siluf_(pg8::bf_lo(zw.z)), xb[1] * siluf_(pg8::bf_hi(zw.z))); o.w = pk2(xb[2] * siluf_(pg8::bf_lo(zw.w)), xb[3] * siluf_(pg8::bf_hi(zw.w)));
              *(v4u*)(op + 8 * hf) = o; } } }
    LDS_WAIT(); asm volatile("" ::: "memory");
}

__device__ __forceinline__ void swa_phase(const Ctx& C, int l) {
    const Bufs B(kargs()->ws);
    const KArgs& A = *kargs();
    __syncthreads();
    for (int i = C.tid; i < 128 * 16; i += NWAVES * 64) { const int h = i >> 7, d = i & 127; ((LAS float*)(C.lds + SW_BIAS))[i] = A.bias_table[t5_bucket(d) * 32 + h]; }
    __syncthreads();
    const float* sinks = A.sinks + l * 16;
    gu32* qctr = (gu32*)(A.ws + WS_CTL) + CW_SWAQ + l * 64;
    LAS int* qslot = (LAS int*)(C.lds + SW_WS) + 8 * 32;
    for (;;) {
        if (C.tid == 0) qslot[0] = (int)__hip_atomic_fetch_add(qctr, 8u, __ATOMIC_RELAXED, __HIP_MEMORY_SCOPE_AGENT);
        LDS_WAIT(); __syncthreads();
        const int base = qslot[0];
        __syncthreads();
        if (base >= 4096 + 32) break;
        const int it = base + C.wave;
        if (it < 4096) { const int blk = it & 127, head = (it >> 7) & 15, b = it >> 11; swa_item(C, B, sinks, b, head, NMETA + 32 * blk, false); }
        else if (it < 4096 + 32) { const int r = it - 4096, head = r & 15, b = r >> 4; swa_item(C, B, sinks, b, head, 0, true); }
    }
    __syncthreads();
}


constexpr int PH_PER_LAYER = 5, N_PHASES = 1 + NLAYER * PH_PER_LAYER + 1;
#ifndef MK_DUP
#define MK_DUP 0
#endif
#ifndef MK_NAIVE_SWA
#define MK_NAIVE_SWA 0
#endif
#ifndef MK_NAIVE_DSA
#define MK_NAIVE_DSA 0
#endif
#ifndef MK_ONE_LAUNCH
#define MK_ONE_LAUNCH 1
#endif

__global__ void __launch_bounds__(NWAVES * 64, 2) fwd_kernel(Args args) {
    extern __shared__ __attribute__((aligned(16))) unsigned char lds[];
    Ctx C;
    C.lds = (LAS unsigned char*)lds; C.tid = threadIdx.x; C.lane = C.tid & 63; C.wave = __builtin_amdgcn_readfirstlane(C.tid >> 6);
    const int wave0 = C.wave;
    C.G = gridDim.x; C.bid = blockIdx.x; C.gw = blockIdx.x * NWAVES + C.wave; C.NGW = C.G * NWAVES;
    unsigned char* ws = args.ws;
    gu32* ctl = (gu32*)(ws + WS_CTL);
    for (int u = C.tid; u < RING_OFF / 4; u += NWAVES * 64) ((LAS unsigned*)(C.lds + LDSCTL_OFF))[u] = 0u;
    __syncthreads();
    volatile LAS unsigned* MISC = (volatile LAS unsigned*)(C.lds + MISC_OFF);
    XcdBarrier bar; bar.bar = (unsigned*)(ctl + CW_BAR); bar.x = 0; bar.st = nullptr;
    const int lo = args.ph_lo, hi = args.ph_hi;
    const bool one = (hi - lo) > 1;
    if (one) bar = xcd_barrier_post((unsigned*)(ctl + CW_BAR), MISC + 8);
#define IN(k) (lo <= (k) && (k) < hi)
#define PHASE_BEGIN() do { int l_ = (int)__builtin_amdgcn_mbcnt_hi(~0u, __builtin_amdgcn_mbcnt_lo(~0u, 0u)); asm volatile("" : "+v"(l_)); int b_ = blockIdx.x; asm volatile("" : "+s"(b_)); \
    int w_ = wave0; asm volatile("" : "+s"(w_)); C.wave = w_; C.lane = l_; C.tid = w_ * 64 + l_; C.bid = b_; C.gw = b_ * NWAVES + w_; } while (0)
#define SEAM(k) do { if (IN((k) + 1)) { PROBE_T0(); XcdBarrier b2_ = bar; b2_.bar = (unsigned*)launder((unsigned char*)bar.bar);     \
    xcd_barrier(b2_, C.wave == 0 && (int)__builtin_amdgcn_mbcnt_hi(~0u, __builtin_amdgcn_mbcnt_lo(~0u, 0u)) == 0); PROBE_T1(29); PROBE_T1(60 + ((k) == 0 ? 5 : ((k) - 1) % PH_PER_LAYER)); if (MK_DUP & 256) xcd_barrier(b2_, C.wave == 0 && (int)__builtin_amdgcn_mbcnt_hi(~0u, __builtin_amdgcn_mbcnt_lo(~0u, 0u)) == 0); } } while (0)
    LAS unsigned char* ring = C.lds + RING_OFF;

    if (IN(0)) { PROBE_T0(); PHASE_BEGIN(); p0_prologue(C); PROBE_T1(20); if (MK_DUP & 128) { PHASE_BEGIN(); p0_prologue(C); } SEAM(0); }
    for (int l = 0; l < NLAYER; ++l) {
        const int p = 1 + l * PH_PER_LAYER;
        if (IN(p)) {
            PHASE_BEGIN(); const Bufs B(kargs()->ws);
            const bf16* W1l = B.W1 + (size_t)l * NP1 * DM;
            pg8::Gemm g{B.HB, W1l, MR, 8192, DM}; pg8::StaticOrder S; S.init(MR, 8192, C.G, C.bid);
            rstd_table<8>(C, S, B.RS, 1.0f / DM);
            pg8::EpiProjT<true> E{B.PROJ, NP1, (const LAS float*)(C.lds + RSTD_OFF), B.KV, B.RSQ, B.RHO, B.SGB};
            { PROBE_T0(); pg8::gemm_phase<pg8::EpiProjT<true>, pg8::StaticOrder, true, true>(ring, g, S, E, C.tid); PROBE_T1(21); }
            PHASE_BEGIN();
            LAS float* tbl = (LAS float*)(C.lds + RSTD_OFF);
            PROBE_T0();
            for (int u = C.bid; u < 256 + 259; u += C.G) {
                if (u < 256) { const int row0 = 32 * u; skinny_rstd(C, B.RS + (size_t)row0 * 32, 32, 1.0f / DM, tbl);
                    skinny_unit<3, 1>(C, B.HB + (size_t)row0 * DM, DM, W1l + (size_t)8192 * DM, DM, DM, nullptr, 0, 0, SkProj{B.PROJ + (size_t)row0 * NP1, B.KV + (size_t)row0 * 256, B.KIDX + (size_t)row0 * 64, 8192, tbl}); }
                else { const int gc = u - 256; skinny_rstd(C, B.RS2, 64, 1.0f / DM, tbl);
                    const SkProj E2{B.PROJ + (size_t)MR * NP1, B.KV + (size_t)MR * 256, B.KIDX + (size_t)MR * 64, gc * 32, tbl};
                    const bool sqc = gc >= 72 && gc < 88;
                    skinny_unit<1, 4>(C, B.HB + (size_t)MR * DM, DM, W1l + (size_t)gc * 32 * DM, DM, DM, sqc ? B.RSQ2 : nullptr, 16, gc - 72, E2); }
            }
            PROBE_T1(22);
            SEAM(p);
        }
        if (IN(p + 1)) {
            PHASE_BEGIN(); const Bufs B(kargs()->ws);
            const bf16* W2l = B.W2 + (size_t)l * NQ2 * 512;
            pg8::Gemm g{B.PROJ + PC_CQ, W2l, MR, NQ2, 512, nullptr, nullptr, NP1}; pg8::StaticOrder S; S.init(MR, NQ2, C.G, C.bid);
            rstd_table<2>(C, S, B.RSQ, 1.0f / 512.0f);
            pg8::EpiProjT<false> E{B.Q2, NQ2, (const LAS float*)(C.lds + RSTD_OFF), nullptr, nullptr, nullptr, nullptr};
            PROBE_T0();
            pg8::gemm_phase<pg8::EpiProjT<false>, pg8::StaticOrder, true, true>(ring, g, S, E, C.tid);
            PHASE_BEGIN();
            { LAS float* tbl = (LAS float*)(C.lds + RSTD_OFF);
              const int sb = (C.G == 256) ? C.bid - 64 : C.bid;
              for (int u = sb; u >= 0 && u < 48; u += C.G) { skinny_rstd(C, B.RSQ2, 16, 1.0f / 512.0f, tbl);
                skinny_unit<3, 1>(C, B.PROJ + (size_t)MR * NP1 + PC_CQ, NP1, W2l + (size_t)u * 96 * 512, 512, 512, nullptr, 0, 0, SkQ2{B.Q2 + (size_t)MR * NQ2 + u * 96, tbl}); } }
            PHASE_BEGIN(); norm_tail(C, l);
            PROBE_T1(24);
            SEAM(p + 1);
        }
        if (IN(p + 2)) {
            { PROBE_T0(); PHASE_BEGIN(); dsa_phase(C, l); PROBE_T1(4); }
            if (MK_DUP & 16) { PHASE_BEGIN(); dsa_phase(C, l); }
            { PROBE_T0(); PHASE_BEGIN(); swa_phase(C, l); PROBE_T1(5); }
            SEAM(p + 2);
        }
        if (IN(p + 3)) {
            PHASE_BEGIN(); const Bufs B(kargs()->ws);
            const bf16* WABl = B.WA + (size_t)l * DM * 2048;
            pg8::Gemm g{B.YA, WABl, MR, DM, 2048, nullptr, nullptr, 0}; pg8::StaticOrder S; S.init(MR, DM, C.G, C.bid);
            pg8::EpiG4m E{B.MG, B.RHO, B.SGB};
            PROBE_T0();
            pg8::gemm_phase<pg8::EpiG4m, pg8::StaticOrder, true, true>(ring, g, S, E, C.tid);
            PROBE_T1(35);
            PHASE_BEGIN();
            for (int u = C.bid; u < 64; u += C.G) {
                skinny_unit<1, 2>(C, B.YA + (size_t)MR * YLD, YLD, WABl + (size_t)u * 32 * 2048, 2048, 1024, nullptr, 0, 0, SkPA{B.PA + (size_t)MR * DM + u * 32, B.PROJ + (size_t)MR * NP1 + 4096, u * 32});
                skinny_unit<1, 2>(C, B.YB + (size_t)MR * YLD, YLD, WABl + 1024 + (size_t)u * 32 * 2048, 2048, 1024, nullptr, 0, 0, SkMerge{B.MG + (size_t)MR * DM + u * 32, B.PA + (size_t)MR * DM + u * 32, B.PROJ + (size_t)MR * NP1 + 4096, u * 32}); }
            PROBE_T1(25);
            SEAM(p + 3);
        }
        if (MK_PROBE >= 0 && l == NLAYER - 1 && C.bid == MK_PROBE_BLOCK && C.wave == 0 && C.lane == 0) __hip_atomic_store((gu32*)(kargs()->ws + WS_CTL) + 3, ((volatile LAS unsigned*)(C.lds + MISC_OFF + 64))[0], RLX_AGENT);
        if (IN(p + 4)) {
            PHASE_BEGIN(); const Bufs B(kargs()->ws);
            const bf16* WOl = B.WO + (size_t)l * DM * DM;
            pg8::Gemm g{B.MG, WOl, MR, DM, DM}; pg8::StaticOrder S; S.init(MR, DM, C.G, C.bid);
            pg8::EpiRes E{B.HB, B.RS};
            PROBE_T0();
            pg8::gemm_phase<pg8::EpiRes, pg8::StaticOrder, true, true>(ring, g, S, E, C.tid);
            PROBE_T1(37);
            PHASE_BEGIN();
            for (int u = C.bid; u < 64; u += C.G) skinny_unit<1, 4>(C, B.MG + (size_t)MR * DM, DM, WOl + (size_t)u * 32 * DM, DM, DM, B.RS2, 64, u, SkRes{B.HB + (size_t)MR * DM + u * 32});
            PROBE_T1(27);
            SEAM(p + 4);
        }
    }
    if (IN(N_PHASES - 1)) { PHASE_BEGIN(); final_phase(C); }
#undef IN
#undef SEAM
}

extern "C" void kernel_launch(void* const* d_in, const int* in_sizes, int n_in, void* d_out, int out_size, void* d_ws, size_t ws_size, hipStream_t stream) {
    static int grid = 0;
    if (grid == 0) {
        if (n_in != 16 || ws_size < WS_END) { fprintf(stderr, "kernel_launch: unexpected inputs (n_in %d, ws %zu, need %zu)\n", n_in, ws_size, (size_t)WS_END); grid = -1; return; }
        int dev = 0, cus = 0;
        if (hipGetDevice(&dev) != hipSuccess || hipDeviceGetAttribute(&cus, hipDeviceAttributeMultiprocessorCount, dev) != hipSuccess) { grid = -1; return; }
        if (hipFuncSetAttribute((const void*)fwd_kernel, hipFuncAttributeMaxDynamicSharedMemorySize, LDS_BYTES) != hipSuccess) { fprintf(stderr, "kernel_launch: hipFuncSetAttribute failed\n"); grid = -1; return; }
        int per_cu = 0;
        if (hipOccupancyMaxActiveBlocksPerMultiprocessor(&per_cu, (const void*)fwd_kernel, NWAVES * 64, LDS_BYTES) != hipSuccess || per_cu < 1) fprintf(stderr, "kernel_launch: occupancy query says %d\n", per_cu);
        (void)hipGetLastError();
        grid = cus;
    }
    if (grid < 0) return;
    if (hipMemsetAsync((char*)d_ws + WS_CTL, 0, CTL_ZERO_BYTES, stream) != hipSuccess) return;
    Args a{};
    a.x = (const float*)d_in[0]; a.meta = (const float*)d_in[1]; a.bias_table = (const float*)d_in[2]; a.norm_g = (const float*)d_in[3]; a.w_in = (const float*)d_in[4];
    a.q_norm_g = (const float*)d_in[5]; a.kv_norm_g = (const float*)d_in[6]; a.w_qb = (const float*)d_in[7]; a.w_iq = (const float*)d_in[8]; a.w_uk = (const float*)d_in[9];
    a.w_uv = (const float*)d_in[10]; a.sinks = (const float*)d_in[11]; a.w_proj_a = (const float*)d_in[12]; a.w_proj_b = (const float*)d_in[13]; a.w_out = (const float*)d_in[14];
    a.final_g = (const float*)d_in[15]; a.out = (float*)d_out; a.ws = (unsigned char*)d_ws;
#if MK_ONE_LAUNCH
    a.ph_lo = 0; a.ph_hi = N_PHASES;
    hipLaunchKernelGGL(fwd_kernel, dim3(grid), dim3(NWAVES * 64), LDS_BYTES, stream, a);
#else
    for (int p = 0; p < N_PHASES; ++p) { a.ph_lo = p; a.ph_hi = p + 1; hipLaunchKernelGGL(fwd_kernel, dim3(grid), dim3(NWAVES * 64), LDS_BYTES, stream, a); }
#endif
}
```

```cpp
#include <hip/hip_runtime.h>
#include <cstdio>
#include <cstdint>
namespace pg8 {
#define PG8_LAS __attribute__((address_space(3)))
typedef unsigned short bf16_t;
typedef short bf16x8 __attribute__((ext_vector_type(8)));
typedef float f32x4 __attribute__((ext_vector_type(4)));
typedef unsigned u32x4 __attribute__((ext_vector_type(4)));
constexpr int BM = 256, BK = 64, HALF = 128, HTB = HALF * BK * 2  , STAGE_BYTES = 8 * HTB, NXCD = 8, WGM = 8;

__host__ __device__ __forceinline__ int lds_byte(int r, int c) { const int st = (r >> 4) * 2 + (c >> 5), rr = r & 15, cc = c & 31, ob = rr * 64 + cc * 2; return st * 1024 + (ob ^ (((ob >> 9) & 1) << 5)); }
__host__ __device__ __forceinline__ void stage_rc(int b, int& R, int& C) { const int st = b / 1024, sb = b % 1024, swz = sb ^ (((sb >> 9) & 1) << 5); R = (st >> 1) * 16 + swz / 64; C = (st & 1) * 32 + (swz % 64) / 2; }
__host__ __device__ __forceinline__ int perm32(int rho) { const int n = rho >> 4, i = rho & 15; return 8 * (i >> 2) + 4 * n + (i & 3); }

struct Unit { int pm, pn, sel; };
struct Gemm { const bf16_t* A; const bf16_t* Bt; int M, N, K; const bf16_t* A2; const bf16_t* Bt2; int lda; };

struct StaticOrder {
    int nM, nN, nwg, G, c;
    __host__ __device__ void init(int M, int N, int G_, int c_) { nM = M / BM; nN = N / BM; nwg = nM * nN; G = G_; c = c_; }
    __host__ __device__ bool next(int i, Unit& u) const {
        const long L = (long)i * G + c; if (L >= nwg) return false;
        int wgid = (int)L; { const int q = nwg / NXCD, r = nwg % NXCD, xcd = wgid % NXCD, off = wgid / NXCD; wgid = (xcd < r ? xcd * (q + 1) : r * (q + 1) + (xcd - r) * q) + off; }
        const int nig = WGM * nN, gid = wgid / nig, fm = gid * WGM, gsz = (nM - fm) < WGM ? (nM - fm) : WGM;
        u.pm = fm + ((wgid % nig) % gsz); u.pn = (wgid % nig) / gsz; u.sel = 0; return true;
    }
    __device__ __forceinline__ void a_ready(const Unit&) const {}
    __device__ __forceinline__ void done(const Unit&) const {}
};

__device__ __forceinline__ unsigned cvt_pk_bf16(float lo, float hi) { unsigned r; asm volatile("v_cvt_pk_bf16_f32 %0, %1, %2" : "=v"(r) : "v"(lo), "v"(hi)); return r; }
typedef float f32x2 __attribute__((ext_vector_type(2)));
__device__ __forceinline__ f32x2 gelu_pk(f32x2 v) {
    const f32x2 av = __builtin_elementwise_abs(v), d = av * 0.2316418882f + 1.0f;
    f32x2 t; t.x = __builtin_amdgcn_rcpf(d.x); t.y = __builtin_amdgcn_rcpf(d.y);
    f32x2 q = t * 0.5307027145f + (-0.7265760135f); q = q * t + 0.7107068705f; q = q * t + (-0.142248368f); q = q * t + 0.127414796f; q = q * t;
    const f32x2 s = (v * v) * (-0.72134752044f);
    f32x2 e; e.x = __builtin_amdgcn_exp2f(s.x); e.y = __builtin_amdgcn_exp2f(s.y);
    const f32x2 m = v * (q * e), r = v - m;
    f32x2 o; o.x = v.x < 0.f ? m.x : r.x; o.y = v.y < 0.f ? m.y : r.y; return o;
}

template <int ACT  > struct EpiBf16 {
    static constexpr bool PERM = true, AFTER_DRAIN = false; static_assert(ACT == 0 || ACT == 1, "EpiBf16: ACT is 0 (none) or 1 (gelu_pk)");
    bf16_t* O; int ldc; const float* bias; int split_cols; size_t split_stride; float scale0;
    __device__ __forceinline__ void operator()(const f32x4 (&acc)[2][2][4][2], const Unit& u, int ui, int wr, int wc, int fr, int fq) const {
        const int row0 = u.pm * BM + wr * 64 + fr; int colt = u.pn * BM; bf16_t* base = O;
        float sc = 1.f; if (split_cols) { const int t = colt / split_cols; base += (size_t)t * split_stride; colt -= t * split_cols; if (t == 0) sc = scale0; }
        const int col0 = colt + wc * 32 + 8 * fq, bcol0 = u.pn * BM + wc * 32 + 8 * fq;
        f32x4 bv[2][2];
#pragma unroll
        for (int bj = 0; bj < 2; ++bj)
#pragma unroll
            for (int n = 0; n < 2; ++n) bv[bj][n] = bias ? *(const f32x4*)(bias + bcol0 + bj * HALF + 4 * n) : (f32x4){0.f, 0.f, 0.f, 0.f};
#pragma unroll
        for (int ai = 0; ai < 2; ++ai)
#pragma unroll
            for (int m = 0; m < 4; ++m) { bf16_t* rowp = base + (size_t)(row0 + ai * HALF + m * 16) * ldc + col0;
#pragma unroll
                for (int bj = 0; bj < 2; ++bj) { f32x4 v0 = acc[ai][bj][m][0] + bv[bj][0], v1 = acc[ai][bj][m][1] + bv[bj][1];
                    if (ACT == 1) { f32x2 a = gelu_pk((f32x2){v0[0], v0[1]}), b = gelu_pk((f32x2){v0[2], v0[3]}), c = gelu_pk((f32x2){v1[0], v1[1]}), d = gelu_pk((f32x2){v1[2], v1[3]});
                        v0 = (f32x4){a.x, a.y, b.x, b.y}; v1 = (f32x4){c.x, c.y, d.x, d.y}; }
                    v0 = v0 * sc; v1 = v1 * sc; u32x4 w; w.x = cvt_pk_bf16(v0[0], v0[1]); w.y = cvt_pk_bf16(v0[2], v0[3]); w.z = cvt_pk_bf16(v1[0], v1[1]); w.w = cvt_pk_bf16(v1[2], v1[3]);
                    *(u32x4*)(rowp + bj * HALF) = w; } }
    }
};

template <class T, class = void> struct pg8_has_midk { static constexpr bool value = false; };
template <class T> struct pg8_has_midk<T, decltype((void)T::MIDK)> { static constexpr bool value = T::MIDK; };
template <class Epi, class Sched, bool ALIGN_EPI = false, bool SP2 = false>
__device__ __forceinline__ void gemm_phase(PG8_LAS unsigned char* lds, const Gemm g, const Sched& S, const Epi& E, int tid_in) {
    int tid_ = tid_in; asm volatile("" : "+v"(tid_));
    const int tid = tid_, wid = __builtin_amdgcn_readfirstlane(tid >> 6), lane = tid & 63, wr = wid >> 2, wc = wid & 3, fr = lane & 15, fq = lane >> 4;
    const int K = g.K, nt = K / BK, lda = g.lda ? g.lda : K;
    unsigned voffA[2], voffB[2];
#pragma unroll
    for (int i = 0; i < 2; ++i) { int R, C; stage_rc(tid * 16 + i * 8192, R, C); const int Rb = Epi::PERM ? ((R & ~31) + perm32(R & 31)) : R;
        voffA[i] = (unsigned)(R * lda + C) * 2u; voffB[i] = (unsigned)(Rb * K + C) * 2u; }
    const size_t kstep = (size_t)(BK * 2);
    const size_t hstepA = (size_t)HALF * lda * 2, tstepA = 2 * hstepA;
    const size_t hstep = (size_t)HALF * K * 2;
    const size_t tstep = 2 * hstep;
    const unsigned ldsw = (unsigned)wid * 1024u;
    const int aoff = lds_byte(wr * 64 + fr, fq * 8), boff = lds_byte(wc * 32 + fr, fq * 8);
#define PG8_SA(b, h) (((b) * 2 + (h)) * HTB)
#define PG8_SB(b, h) ((4 + (b) * 2 + (h)) * HTB)
#define PG8_STAGE(bufoff, gbase, voff) do { _Pragma("unroll") for (int _i = 0; _i < 2; ++_i) \
        __builtin_amdgcn_global_load_lds((const unsigned*)((const char*)(gbase) + (voff)[_i]), (PG8_LAS unsigned*)(lds + (bufoff) + ldsw + _i * 8192), 16, 0, 0); } while (0)
#define PG8_LDA(dst, b, h) do { _Pragma("unroll") for (int m = 0; m < 4; ++m) _Pragma("unroll") for (int k = 0; k < 2; ++k) dst[m][k] = *(const PG8_LAS bf16x8*)(lds + PG8_SA(b, h) + aoff + m * 2048 + k * 1024); } while (0)
#define PG8_LDB(dst, b, h) do { _Pragma("unroll") for (int n = 0; n < 2; ++n) _Pragma("unroll") for (int k = 0; k < 2; ++k) dst[n][k] = *(const PG8_LAS bf16x8*)(lds + PG8_SB(b, h) + boff + n * 2048 + k * 1024); } while (0)
#define PG8_MMA(ai, bj, At, Bt) do { __builtin_amdgcn_s_setprio(1); _Pragma("unroll") for (int m = 0; m < 4; ++m) _Pragma("unroll") for (int n = 0; n < 2; ++n) _Pragma("unroll") for (int k = 0; k < 2; ++k) \
        acc[ai][bj][m][n] = __builtin_amdgcn_mfma_f32_16x16x32_bf16(Bt[n][k], At[m][k], acc[ai][bj][m][n], 0, 0, 0); __builtin_amdgcn_s_setprio(0); } while (0)
#define PG8_WAIT_V(n) asm volatile("s_waitcnt vmcnt(" #n ")" ::: "memory")
#define PG8_WAIT_L(n) asm volatile("s_waitcnt lgkmcnt(" #n ")" ::: "memory")
#define PG8_BAR __builtin_amdgcn_s_barrier()
#define PG8_SCHED __builtin_amdgcn_sched_barrier(0)
    Unit cur, nxt; int ui = 0;
    if (!S.next(0, cur)) return;
    f32x4 acc[2][2][4][2];
#pragma unroll
    for (int a = 0; a < 2; ++a)
#pragma unroll
        for (int b = 0; b < 2; ++b)
#pragma unroll
            for (int m = 0; m < 4; ++m)
#pragma unroll
                for (int n = 0; n < 2; ++n) acc[a][b][m][n] = (f32x4){0.f, 0.f, 0.f, 0.f};
    bf16x8 At[4][2], B0[2][2], B1[2][2];
    const char* cA = (const char*)(cur.sel ? g.A2 : g.A) + (size_t)cur.pm * tstepA; const char* cB = (const char*)(cur.sel ? g.Bt2 : g.Bt) + (size_t)cur.pn * tstep;
    S.a_ready(cur);
    if constexpr (SP2) {
        PG8_STAGE(PG8_SB(0, 0), cB, voffB); PG8_STAGE(PG8_SB(0, 1), cB + hstep, voffB); PG8_STAGE(PG8_SA(0, 0), cA, voffA); PG8_STAGE(PG8_SA(0, 1), cA + hstepA, voffA);
        if (wr == 1) PG8_BAR;
        PG8_WAIT_V(2); PG8_BAR;
        PG8_STAGE(PG8_SB(1, 0), cB + kstep, voffB); PG8_STAGE(PG8_SA(1, 0), cA + kstep, voffA); PG8_STAGE(PG8_SB(1, 1), cB + hstep + kstep, voffB);
        PG8_WAIT_V(6); PG8_BAR;
    } else {
        PG8_STAGE(PG8_SB(0, 0), cB, voffB); PG8_STAGE(PG8_SA(0, 0), cA, voffA); PG8_STAGE(PG8_SB(0, 1), cB + hstep, voffB); PG8_STAGE(PG8_SA(0, 1), cA + hstepA, voffA);
        if (wr == 1) PG8_BAR;
        PG8_WAIT_V(4); PG8_BAR;
        PG8_STAGE(PG8_SB(1, 0), cB + kstep, voffB); PG8_STAGE(PG8_SA(1, 0), cA + kstep, voffA); PG8_STAGE(PG8_SB(1, 1), cB + hstep + kstep, voffB);
        PG8_WAIT_V(6); PG8_BAR;
    }
    for (;;) {
        const bool has_next = S.next(ui + 1, nxt);
        const char* nA = has_next ? (const char*)(nxt.sel ? g.A2 : g.A) + (size_t)nxt.pm * tstepA : cA; const char* nB = has_next ? (const char*)(nxt.sel ? g.Bt2 : g.Bt) + (size_t)nxt.pn * tstep : cB;
        for (int t = 0; t < nt; t += 2) {
            if constexpr (pg8_has_midk<Epi>::value) { if (t == (nt >> 1)) E.midk(acc, cur, wr, wc, fr, fq); }
            const bool last = (t == nt - 2);
            const char* a1 = cA + (size_t)(t + 1) * kstep;
            const char* a2 = last ? nA : cA + (size_t)(t + 2) * kstep; const char* b2 = last ? nB : cB + (size_t)(t + 2) * kstep;
            const char* a3 = a2 + kstep; const char* b3 = b2 + kstep;
            if (last && has_next) S.a_ready(nxt);
            if constexpr (SP2) {
            PG8_LDB(B0, 0, 0); PG8_LDB(B1, 0, 1); PG8_SCHED; PG8_LDA(At, 0, 0); PG8_STAGE(PG8_SA(1, 1), a1 + hstepA, voffA);
            PG8_WAIT_V(8); PG8_WAIT_L(0); PG8_BAR; PG8_MMA(0, 0, At, B0); PG8_MMA(0, 1, At, B1); PG8_BAR; PG8_SCHED;
            PG8_LDA(At, 0, 1); PG8_STAGE(PG8_SB(0, 0), b2, voffB); PG8_STAGE(PG8_SB(0, 1), b2 + hstep, voffB); PG8_STAGE(PG8_SA(0, 0), a2, voffA);
            PG8_WAIT_V(8); PG8_WAIT_L(0); PG8_BAR; PG8_MMA(1, 0, At, B0); PG8_MMA(1, 1, At, B1); PG8_BAR; PG8_SCHED;
            PG8_LDB(B0, 1, 0); PG8_LDB(B1, 1, 1); PG8_SCHED; PG8_LDA(At, 1, 0); PG8_STAGE(PG8_SA(0, 1), a2 + hstepA, voffA);
            PG8_WAIT_V(8); PG8_WAIT_L(0); PG8_BAR; PG8_MMA(0, 0, At, B0); PG8_MMA(0, 1, At, B1); PG8_BAR; PG8_SCHED;
            PG8_LDA(At, 1, 1); PG8_STAGE(PG8_SB(1, 0), b3, voffB); PG8_STAGE(PG8_SB(1, 1), b3 + hstep, voffB); PG8_STAGE(PG8_SA(1, 0), a3, voffA);
            PG8_WAIT_V(8); PG8_WAIT_L(0); PG8_BAR; PG8_MMA(1, 0, At, B0); PG8_MMA(1, 1, At, B1); PG8_BAR; PG8_SCHED;
            } else {
            PG8_LDB(B0, 0, 0); PG8_SCHED; PG8_LDA(At, 0, 0); PG8_STAGE(PG8_SA(1, 1), a1 + hstepA, voffA);
            PG8_WAIT_L(8); PG8_BAR; PG8_WAIT_L(0); PG8_MMA(0, 0, At, B0); PG8_BAR; PG8_SCHED;
            PG8_LDB(B1, 0, 1); PG8_STAGE(PG8_SB(0, 0), b2, voffB);
            PG8_BAR; PG8_WAIT_L(0); PG8_MMA(0, 1, At, B1); PG8_BAR;
            PG8_LDA(At, 0, 1); PG8_STAGE(PG8_SA(0, 0), a2, voffA);
            PG8_BAR; PG8_WAIT_L(0); PG8_MMA(1, 0, At, B0); PG8_BAR; PG8_SCHED;
            PG8_STAGE(PG8_SB(0, 1), b2 + hstep, voffB);
            PG8_WAIT_V(6); PG8_BAR; PG8_MMA(1, 1, At, B1); PG8_BAR;
            PG8_LDB(B0, 1, 0); PG8_SCHED; PG8_LDA(At, 1, 0); PG8_STAGE(PG8_SA(0, 1), a2 + hstepA, voffA);
            PG8_WAIT_L(8); PG8_BAR; PG8_WAIT_L(0); PG8_MMA(0, 0, At, B0); PG8_BAR; PG8_SCHED;
            PG8_LDB(B1, 1, 1); PG8_STAGE(PG8_SB(1, 0), b3, voffB);
            PG8_BAR; PG8_WAIT_L(0); PG8_MMA(0, 1, At, B1); PG8_BAR;
            PG8_LDA(At, 1, 1); PG8_STAGE(PG8_SA(1, 0), a3, voffA);
            PG8_BAR; PG8_WAIT_L(0); PG8_MMA(1, 0, At, B0); PG8_BAR; PG8_SCHED;
            PG8_STAGE(PG8_SB(1, 1), b3 + hstep, voffB);
            PG8_WAIT_V(6); PG8_BAR; PG8_MMA(1, 1, At, B1); PG8_BAR;
            }
        }
        if constexpr (ALIGN_EPI) { if (wr == 0) PG8_BAR; }
        if constexpr (!Epi::AFTER_DRAIN) { E(acc, cur, ui, wr, wc, fr, fq); S.done(cur); }
        if (!has_next) break;
#pragma unroll
        for (int a = 0; a < 2; ++a)
#pragma unroll
            for (int b = 0; b < 2; ++b)
#pragma unroll
                for (int m = 0; m < 4; ++m)
#pragma unroll
                    for (int n = 0; n < 2; ++n) acc[a][b][m][n] = (f32x4){0.f, 0.f, 0.f, 0.f};
        cur = nxt; cA = nA; cB = nB; ++ui;
        if constexpr (ALIGN_EPI) { if (wr == 1) PG8_BAR; }
    }
    PG8_WAIT_V(0);
    if constexpr (!ALIGN_EPI) { if (wr == 0) PG8_BAR; }
    PG8_BAR;
    if constexpr (Epi::AFTER_DRAIN) { E.fused(acc, cur, wr, wc, fr, fq, lds, wid, lane); S.done(cur); }
#undef PG8_SA
#undef PG8_SB
#undef PG8_STAGE
#undef PG8_LDA
#undef PG8_LDB
#undef PG8_MMA
#undef PG8_WAIT_V
#undef PG8_WAIT_L
#undef PG8_BAR
#undef PG8_SCHED
}
}
namespace pg8 {
__device__ __forceinline__ float bf_lo(unsigned w) { return __uint_as_float(w << 16); }
__device__ __forceinline__ float bf_hi(unsigned w) { return __uint_as_float(w & 0xffff0000u); }
__device__ __forceinline__ float sigm(float x) { return 1.0f / (1.0f + __expf(-x)); }
typedef unsigned u32x2 __attribute__((ext_vector_type(2)));

template <bool G1>
struct EpiProjT {
    static constexpr bool PERM = true, AFTER_DRAIN = false;
    bf16_t* O; int ldc; const PG8_LAS float* rstd; bf16_t* KV; float* RSQ; bf16_t* RHO; bf16_t* SGB;
    static constexpr int kvtile = 4, sqtile = 9, gtile = 16;
    __device__ __forceinline__ void operator()(const f32x4 (&acc)[2][2][4][2], const Unit& u, int ui, int wr, int wc, int fr, int fq) const {
        const int rt0 = wr * 64 + fr, col0 = u.pn * BM + wc * 32 + 8 * fq;
        const bool sq = G1 && (u.pn == sqtile || u.pn == sqtile + 1);
#pragma unroll
        for (int ai = 0; ai < 2; ++ai)
#pragma unroll
            for (int m = 0; m < 4; ++m) { const int rt = rt0 + ai * HALF + m * 16; const float s = rstd[ui * 256 + rt];
                bf16_t* rowp = O + (size_t)(u.pm * BM + rt) * ldc + col0;
                if constexpr (G1) { if (u.pn == kvtile) rowp = KV + (size_t)(u.pm * BM + rt) * 256 + wc * 32 + 8 * fq; }
                float ss = 0.f;
                if constexpr (G1) { if (u.pn >= gtile) {
                    const f32x4 a0 = acc[ai][0][m][0] * s, a1 = acc[ai][0][m][1] * s, b0 = acc[ai][1][m][0] * s, b1 = acc[ai][1][m][1] * s;
                    float ea[8], eb[8], rh[8], sb[8];
#pragma unroll
                    for (int j = 0; j < 4; ++j) { ea[j] = 1.0f + __expf(-a0[j]); ea[4 + j] = 1.0f + __expf(-a1[j]); eb[j] = 1.0f + __expf(-b0[j]); eb[4 + j] = 1.0f + __expf(-b1[j]); }
#pragma unroll
                    for (int j = 0; j < 8; ++j) { const float ia = __builtin_amdgcn_rcpf(ea[j]); rh[j] = eb[j] * ia; sb[j] = __builtin_amdgcn_rcpf(eb[j]); }
                    const size_t go = (size_t)(u.pm * BM + rt) * 2048 + (u.pn - gtile) * 128 + wc * 32 + 8 * fq;
                    u32x4 wr_, ws_; wr_.x = cvt_pk_bf16(rh[0], rh[1]); wr_.y = cvt_pk_bf16(rh[2], rh[3]); wr_.z = cvt_pk_bf16(rh[4], rh[5]); wr_.w = cvt_pk_bf16(rh[6], rh[7]);
                    ws_.x = cvt_pk_bf16(sb[0], sb[1]); ws_.y = cvt_pk_bf16(sb[2], sb[3]); ws_.z = cvt_pk_bf16(sb[4], sb[5]); ws_.w = cvt_pk_bf16(sb[6], sb[7]);
                    *(u32x4*)(RHO + go) = wr_; *(u32x4*)(SGB + go) = ws_;
                    continue; } }
#pragma unroll
                for (int bj = 0; bj < 2; ++bj) { const f32x4 v0 = acc[ai][bj][m][0] * s, v1 = acc[ai][bj][m][1] * s;
                    ss += (v0[0] * v0[0] + v0[1] * v0[1]) + (v0[2] * v0[2] + v0[3] * v0[3]) + (v1[0] * v1[0] + v1[1] * v1[1]) + (v1[2] * v1[2] + v1[3] * v1[3]);
                    u32x4 w; w.x = cvt_pk_bf16(v0[0], v0[1]); w.y = cvt_pk_bf16(v0[2], v0[3]); w.z = cvt_pk_bf16(v1[0], v1[1]); w.w = cvt_pk_bf16(v1[2], v1[3]);
                    *(u32x4*)(rowp + bj * HALF) = w; }
                if constexpr (G1) if (sq) { ss += __shfl_xor(ss, 16); ss += __shfl_xor(ss, 32); if (fq == 0) RSQ[(size_t)(u.pm * BM + rt) * 8 + (u.pn - sqtile) * 4 + wc] = ss; } }
    }
};
struct EpiPA {
    static constexpr bool PERM = false, AFTER_DRAIN = false;
    float* P; const bf16_t* G; int ldg;
    __device__ __forceinline__ void operator()(const f32x4 (&acc)[2][2][4][2], const Unit& u, int ui, int wr, int wc, int fr, int fq) const {
        const int col0 = u.pn * BM + wc * 32 + 4 * fq;
#pragma unroll
        for (int ai = 0; ai < 2; ++ai)
#pragma unroll
            for (int m = 0; m < 4; ++m) { const int row = u.pm * BM + ai * HALF + wr * 64 + m * 16 + fr;
#pragma unroll
                for (int bj = 0; bj < 2; ++bj)
#pragma unroll
                    for (int n = 0; n < 2; ++n) { const int c = col0 + bj * HALF + n * 16; const u32x2 g = *(const u32x2*)(G + (size_t)row * ldg + c);
                        f32x4 v = acc[ai][bj][m][n]; v[0] *= sigm(bf_lo(g.x)); v[1] *= sigm(bf_hi(g.x)); v[2] *= sigm(bf_lo(g.y)); v[3] *= sigm(bf_hi(g.y));
                        *(f32x4*)(P + (size_t)row * 2048 + c) = v; } }
    }
};
struct EpiMerge {
    static constexpr bool PERM = true, AFTER_DRAIN = false;
    bf16_t* O; const float* P; const bf16_t* G; int ldg;
    __device__ __forceinline__ void operator()(const f32x4 (&acc)[2][2][4][2], const Unit& u, int ui, int wr, int wc, int fr, int fq) const {
        const int col0 = u.pn * BM + wc * 32 + 8 * fq;
#pragma unroll
        for (int ai = 0; ai < 2; ++ai)
#pragma unroll
            for (int m = 0; m < 4; ++m) { const int row = u.pm * BM + ai * HALF + wr * 64 + m * 16 + fr;
#pragma unroll
                for (int bj = 0; bj < 2; ++bj) { const int c = col0 + bj * HALF; const u32x4 g = *(const u32x4*)(G + (size_t)row * ldg + c);
                    const f32x4 p0 = *(const f32x4*)(P + (size_t)row * 2048 + c), p1 = *(const f32x4*)(P + (size_t)row * 2048 + c + 4);
                    f32x4 v0 = acc[ai][bj][m][0], v1 = acc[ai][bj][m][1];
                    v0[0] = p0[0] + sigm(bf_lo(g.x)) * v0[0]; v0[1] = p0[1] + sigm(bf_hi(g.x)) * v0[1]; v0[2] = p0[2] + sigm(bf_lo(g.y)) * v0[2]; v0[3] = p0[3] + sigm(bf_hi(g.y)) * v0[3];
                    v1[0] = p1[0] + sigm(bf_lo(g.z)) * v1[0]; v1[1] = p1[1] + sigm(bf_hi(g.z)) * v1[1]; v1[2] = p1[2] + sigm(bf_lo(g.w)) * v1[2]; v1[3] = p1[3] + sigm(bf_hi(g.w)) * v1[3];
                    u32x4 w; w.x = cvt_pk_bf16(v0[0], v0[1]); w.y = cvt_pk_bf16(v0[2], v0[3]); w.z = cvt_pk_bf16(v1[0], v1[1]); w.w = cvt_pk_bf16(v1[2], v1[3]);
                    *(u32x4*)(O + (size_t)row * 2048 + c) = w; } }
    }
};
struct EpiG4 {
    static constexpr bool PERM = true, AFTER_DRAIN = false;
    bf16_t* O; float* P; const bf16_t* GA; const bf16_t* GB; int ldg;
    __device__ __forceinline__ void operator()(const f32x4 (&acc)[2][2][4][2], const Unit& u, int ui, int wr, int wc, int fr, int fq) const {
        const int col0 = u.pn * BM + wc * 32 + 8 * fq;
        const bf16_t* G = u.sel ? GB : GA;
#pragma unroll
        for (int ai = 0; ai < 2; ++ai)
#pragma unroll
            for (int m = 0; m < 4; ++m) { const int row = u.pm * BM + ai * HALF + wr * 64 + m * 16 + fr;
#pragma unroll
                for (int bj = 0; bj < 2; ++bj) { const int c = col0 + bj * HALF; const u32x4 g = *(const u32x4*)(G + (size_t)row * ldg + c);
                    f32x4 v0 = acc[ai][bj][m][0], v1 = acc[ai][bj][m][1];
                    v0[0] *= sigm(bf_lo(g.x)); v0[1] *= sigm(bf_hi(g.x)); v0[2] *= sigm(bf_lo(g.y)); v0[3] *= sigm(bf_hi(g.y));
                    v1[0] *= sigm(bf_lo(g.z)); v1[1] *= sigm(bf_hi(g.z)); v1[2] *= sigm(bf_lo(g.w)); v1[3] *= sigm(bf_hi(g.w));
                    float* pp = P + (size_t)row * 2048 + c;
                    if (u.sel == 0) { *(f32x4*)pp = v0; *(f32x4*)(pp + 4) = v1; }
                    else { v0 += *(const f32x4*)pp; v1 += *(const f32x4*)(pp + 4);
                        u32x4 w; w.x = cvt_pk_bf16(v0[0], v0[1]); w.y = cvt_pk_bf16(v0[2], v0[3]); w.z = cvt_pk_bf16(v1[0], v1[1]); w.w = cvt_pk_bf16(v1[2], v1[3]);
                        *(u32x4*)(O + (size_t)row * 2048 + c) = w; } } }
    }
};
struct EpiG4m {
    static constexpr bool PERM = true, AFTER_DRAIN = false, MIDK = true;
    bf16_t* O; const bf16_t* RHO; const bf16_t* SGB;
    __device__ __forceinline__ void scale(f32x4 (&acc)[2][2][4][2], const bf16_t* T, const Unit& u, int wr, int wc, int fr, int fq) const {
        const int col0 = u.pn * BM + wc * 32 + 8 * fq;
        u32x4 gv[2][4][2];
#pragma unroll
        for (int ai = 0; ai < 2; ++ai)
#pragma unroll
            for (int m = 0; m < 4; ++m)
#pragma unroll
                for (int bj = 0; bj < 2; ++bj) gv[ai][m][bj] = *(const u32x4*)(T + (size_t)(u.pm * BM + ai * HALF + wr * 64 + m * 16 + fr) * 2048 + col0 + bj * HALF);
        __builtin_amdgcn_sched_barrier(0);
#pragma unroll
        for (int ai = 0; ai < 2; ++ai)
#pragma unroll
            for (int m = 0; m < 4; ++m)
#pragma unroll
                for (int bj = 0; bj < 2; ++bj) { const u32x4 g = gv[ai][m][bj]; f32x4& v0 = acc[ai][bj][m][0]; f32x4& v1 = acc[ai][bj][m][1];
                    v0[0] *= bf_lo(g.x); v0[1] *= bf_hi(g.x); v0[2] *= bf_lo(g.y); v0[3] *= bf_hi(g.y); v1[0] *= bf_lo(g.z); v1[1] *= bf_hi(g.z); v1[2] *= bf_lo(g.w); v1[3] *= bf_hi(g.w); }
    }
    __device__ __forceinline__ void midk(f32x4 (&acc)[2][2][4][2], const Unit& u, int wr, int wc, int fr, int fq) const {
        asm volatile("" : "+v"(fr), "+v"(fq));
        scale(acc, RHO, u, wr, wc, fr, fq);
    }
    __device__ __forceinline__ void operator()(const f32x4 (&acc_)[2][2][4][2], const Unit& u, int ui, int wr, int wc, int fr, int fq) const {
        f32x4 acc[2][2][4][2];
#pragma unroll
        for (int a = 0; a < 2; ++a)
#pragma unroll
            for (int b = 0; b < 2; ++b)
#pragma unroll
                for (int m = 0; m < 4; ++m)
#pragma unroll
                    for (int n = 0; n < 2; ++n) acc[a][b][m][n] = acc_[a][b][m][n];
        scale(acc, SGB, u, wr, wc, fr, fq);
        const int col0 = u.pn * BM + wc * 32 + 8 * fq;
#pragma unroll
        for (int ai = 0; ai < 2; ++ai)
#pragma unroll
            for (int m = 0; m < 4; ++m) { const int row = u.pm * BM + ai * HALF + wr * 64 + m * 16 + fr;
#pragma unroll
                for (int bj = 0; bj < 2; ++bj) { const f32x4 v0 = acc[ai][bj][m][0], v1 = acc[ai][bj][m][1];
                    u32x4 w; w.x = cvt_pk_bf16(v0[0], v0[1]); w.y = cvt_pk_bf16(v0[2], v0[3]); w.z = cvt_pk_bf16(v1[0], v1[1]); w.w = cvt_pk_bf16(v1[2], v1[3]);
                    *(u32x4*)(O + (size_t)row * 2048 + col0 + bj * HALF) = w; } }
    }
};
struct DualOrder : StaticOrder {
    __host__ __device__ bool next(int i, Unit& u) const { if (!StaticOrder::next(i >> 1, u)) return false; u.sel = i & 1; return true; }
};
struct EpiRes {
    static constexpr bool PERM = false, AFTER_DRAIN = false;
    bf16_t* HB; float* RS;
    __device__ __forceinline__ void operator()(const f32x4 (&acc)[2][2][4][2], const Unit& u, int ui, int wr, int wc, int fr, int fq) const {
        const int col0 = u.pn * BM + wc * 32 + 4 * fq;
        u32x2 ho[2][4][2][2];
#pragma unroll
        for (int ai = 0; ai < 2; ++ai)
#pragma unroll
            for (int m = 0; m < 4; ++m) { const int row = u.pm * BM + ai * HALF + wr * 64 + m * 16 + fr;
#pragma unroll
                for (int bj = 0; bj < 2; ++bj)
#pragma unroll
                    for (int n = 0; n < 2; ++n) ho[ai][m][bj][n] = *(const u32x2*)(HB + (size_t)row * 2048 + col0 + bj * HALF + n * 16); }
        __builtin_amdgcn_sched_barrier(0);
#pragma unroll
        for (int ai = 0; ai < 2; ++ai)
#pragma unroll
            for (int m = 0; m < 4; ++m) { const int row = u.pm * BM + ai * HALF + wr * 64 + m * 16 + fr; float ss = 0.f;
#pragma unroll
                for (int bj = 0; bj < 2; ++bj)
#pragma unroll
                    for (int n = 0; n < 2; ++n) { const size_t off = (size_t)row * 2048 + col0 + bj * HALF + n * 16;
                        const u32x2 h0 = ho[ai][m][bj][n];
                        f32x4 hv = {bf_lo(h0.x), bf_hi(h0.x), bf_lo(h0.y), bf_hi(h0.y)}; hv += acc[ai][bj][m][n];
                        u32x2 w; w.x = cvt_pk_bf16(hv[0], hv[1]); w.y = cvt_pk_bf16(hv[2], hv[3]); *(u32x2*)(HB + off) = w;
                        ss += (hv[0] * hv[0] + hv[1] * hv[1]) + (hv[2] * hv[2] + hv[3] * hv[3]); }
                ss += __shfl_xor(ss, 16); ss += __shfl_xor(ss, 32);
                if (fq == 0) RS[(size_t)row * 32 + u.pn * 4 + wc] = ss; }
    }
};
}

#define GAS __attribute__((address_space(1)))
#define LAS __attribute__((address_space(3)))
typedef unsigned short bf16;
typedef unsigned v4u __attribute__((ext_vector_type(4)));
typedef float f32x4 __attribute__((ext_vector_type(4)));
typedef short bf16x8 __attribute__((ext_vector_type(8)));
typedef GAS unsigned gu32;
typedef GAS unsigned long long gu64;
#define RLX_AGENT __ATOMIC_RELAXED, __HIP_MEMORY_SCOPE_AGENT
#define LDS_WAIT() asm volatile("s_waitcnt lgkmcnt(0)" ::: "memory")
#define VM_WAIT() asm volatile("s_waitcnt vmcnt(0)" ::: "memory")
__device__ __forceinline__ unsigned long long rt() { return __builtin_amdgcn_s_memrealtime(); }
__device__ __forceinline__ unsigned f2bf(float f) { unsigned u = __builtin_bit_cast(unsigned, f); return (u + 0x7fffu + ((u >> 16) & 1u)) >> 16; }
__device__ __forceinline__ unsigned pk2(float lo, float hi) { return f2bf(lo) | (f2bf(hi) << 16); }

#define XB_TMO      128
#define XB_XCNT(j)  (256  + 64 * (j))
#define XB_XSUB(j)  (1280 + 64 * (j))
#define XB_XGEN(j)  (2304 + 64 * (j))
#define XB_TOP      3328
#define XB_TOPGEN   3392
#define XCD_BAR_WORDS 3456
#define XB_SPIN_CAP (1u << 18)

__device__ __forceinline__ unsigned xb_ld(unsigned* p)              { return __hip_atomic_load(p, __ATOMIC_RELAXED, __HIP_MEMORY_SCOPE_AGENT); }
__device__ __forceinline__ unsigned xb_add(unsigned* p, unsigned v) { return __hip_atomic_fetch_add(p, v, __ATOMIC_RELAXED, __HIP_MEMORY_SCOPE_AGENT); }
__device__ __forceinline__ unsigned xb_xcc_id() { return (unsigned)__builtin_amdgcn_s_getreg((3 << 11) | 20) & 0xFu; }
#define XB_SPIN(cond, bar) do { unsigned _sp = 0; while (cond) { __builtin_amdgcn_s_sleep(1); \
    if ((++_sp & 255u) == 0u) { if (xb_ld(&(bar)[XB_TMO])) break; if (_sp > XB_SPIN_CAP) { atomicAdd(&(bar)[XB_TMO], 1u); break; } } } } while (0)

struct XcdBarrier {
    unsigned* bar; unsigned x;
    volatile LAS unsigned* st;
};

__device__ __forceinline__ XcdBarrier xcd_barrier_post(unsigned* bar, volatile LAS unsigned* st) {
    XcdBarrier b; b.bar = bar; b.x = xb_xcc_id(); b.st = st;
    if (threadIdx.x == 0) (void)xb_add(&bar[XB_XCNT(b.x)], 1u);
    return b;
}
__device__ __forceinline__ void xcd_barrier_complete(unsigned* bar, unsigned x, unsigned& nloc, unsigned& nx) {
    const unsigned G = gridDim.x * gridDim.y * gridDim.z;
    unsigned sum, cnt, mine, sp = 0u;
    for (;;) {
        sum = 0u; cnt = 0u; mine = 0u;
#pragma unroll
        for (unsigned j = 0; j < 16; ++j) { const unsigned c = xb_ld(&bar[XB_XCNT(j)]); sum += c; cnt += (c > 0u) ? 1u : 0u; mine = (j == x) ? c : mine; }
        if (sum == G) break;
        __builtin_amdgcn_s_sleep(1);
        if ((++sp & 255u) == 0u) { if (xb_ld(&bar[XB_TMO])) break; if (sp > XB_SPIN_CAP) { atomicAdd(&bar[XB_TMO], 1u); break; } }
    }
    nloc = mine > 0u ? mine : 1u; nx = cnt > 0u ? cnt : 1u;
}

__device__ __forceinline__ void xcd_barrier(const XcdBarrier& b, bool thread0) {
    asm volatile("s_waitcnt vmcnt(0)" ::: "memory");
    __syncthreads();
    if (thread0) {
        unsigned* bar = b.bar;
        __builtin_amdgcn_s_waitcnt(0);
        unsigned nloc = b.st[0], nx = b.st[1];
        if (nloc == 0u) { xcd_barrier_complete(bar, b.x, nloc, nx); b.st[0] = nloc; b.st[1] = nx; }
        const unsigned old = xb_add(&bar[XB_XSUB(b.x)], 1u);
        const unsigned gen = old / nloc;
        if (old + 1u == (gen + 1u) * nloc) {
            __builtin_amdgcn_fence(__ATOMIC_RELEASE, "agent");
            asm volatile("s_waitcnt vmcnt(0)" ::: "memory");
            const unsigned og = xb_add(&bar[XB_TOP], 1u);
            const unsigned tg = og / nx;
            if (og + 1u == (tg + 1u) * nx) xb_add(&bar[XB_TOPGEN], 1u);
            else XB_SPIN(xb_ld(&bar[XB_TOPGEN]) == tg, bar);
            __builtin_amdgcn_fence(__ATOMIC_ACQUIRE, "agent");
            xb_add(&bar[XB_XGEN(b.x)], 1u);
            asm volatile("s_waitcnt vmcnt(0)" ::: "memory");
        } else {
            XB_SPIN(xb_ld(&bar[XB_XGEN(b.x)]) == gen, bar);
            __builtin_amdgcn_fence(__ATOMIC_ACQUIRE, "agent");
            asm volatile("s_waitcnt vmcnt(0)" ::: "memory");
        }
    }
    __syncthreads();
}
#ifndef MK_PROBE
#define MK_PROBE (-1)
#endif
#ifndef MK_PROBE_BLOCK
#define MK_PROBE_BLOCK 0
#endif
#ifndef MK_PROBE_SCALE
#define MK_PROBE_SCALE 2e-6f
#endif
#define PROBE_T0() unsigned pt0_ = 0; if (MK_PROBE >= 0) { pt0_ = (unsigned)__builtin_amdgcn_readfirstlane((int)(unsigned)__builtin_amdgcn_s_memtime()); asm volatile("s_waitcnt lgkmcnt(0)" ::: "memory"); }
#define PROBE_T1(id) do { if (MK_PROBE == (id)) { const unsigned pt1_ = (unsigned)__builtin_amdgcn_readfirstlane((int)(unsigned)__builtin_amdgcn_s_memtime()); asm volatile("s_waitcnt lgkmcnt(0)" ::: "memory"); \
    if (C.bid == MK_PROBE_BLOCK && C.wave == 0 && C.lane == 0) { volatile LAS unsigned* pw_ = (volatile LAS unsigned*)(C.lds + MISC_OFF + 64); pw_[0] = pw_[0] + (unsigned)(pt1_ - pt0_); } } } while (0)
constexpr int NWAVES = 8;
constexpr int NLAYER = 4, DM = 2048, NBATCH = 2, SEQ = 4096, NMETA = 16, LTOK = SEQ + NMETA, NTOK = NBATCH * LTOK;
constexpr int MP = 8448;
constexpr int NP1 = 8448;
constexpr int NC_IN = 8264;
constexpr int PC_QA = 0, PC_KA = 1024, PC_VA = 1152, PC_ZA = 1280, PC_CQ = 2304, PC_CKV = 2816, PC_ZB = 3072, PC_GA = 4096, PC_GB = 6144, PC_KIDX = 8192, PC_WIDX = 8256;
constexpr int NQ2 = 4608;
constexpr int TOPK = 256;
constexpr int YLD = 2048;
constexpr float RMS_EPS = 1e-6f;

__device__ __forceinline__ int rowof(int b, int t) { return t < NMETA ? 8192 + b * NMETA + t : b * SEQ + (t - NMETA); }
__device__ __forceinline__ int t5_bucket(int d) {
    const int n = d < 0 ? 0 : d;
    if (n < 16) return n;
    return 16 + (n >= 19) + (n >= 21) + (n >= 24) + (n >= 27) + (n >= 31) + (n >= 35) + (n >= 40) + (n >= 46) + (n >= 52) + (n >= 59) + (n >= 67) + (n >= 77) + (n >= 87) + (n >= 99) + (n >= 113);
}
__device__ __forceinline__ float bf2f(bf16 v) { return __uint_as_float((unsigned)v << 16); }
__device__ __forceinline__ float sigmoidf_(float x) { return 1.0f / (1.0f + __expf(-x)); }
__device__ __forceinline__ float siluf_(float x) { return x / (1.0f + __expf(-x)); }
__device__ __forceinline__ float wave_sum(float v) {
#pragma unroll
    for (int o = 1; o < 64; o <<= 1) v += __shfl_xor(v, o);
    return v;
}
__device__ __forceinline__ float wave_max(float v) {
#pragma unroll
    for (int o = 1; o < 64; o <<= 1) v = fmaxf(v, __shfl_xor(v, o));
    return v;
}
__device__ __forceinline__ int wave_sum_i(int v) {
#pragma unroll
    for (int o = 1; o < 64; o <<= 1) v += __shfl_xor(v, o);
    return v;
}

constexpr size_t MiB = 1u << 20;
constexpr size_t WS_CTL = 0, CTL_ZERO_BYTES = 1 * MiB;
constexpr size_t SZ_W1 = (size_t)NLAYER * NP1 * DM * 2, SZ_W2 = (size_t)NLAYER * NQ2 * 512 * 2, SZ_WA = (size_t)NLAYER * DM * 1024 * 2, SZ_WO = (size_t)NLAYER * DM * DM * 2;
constexpr size_t al(size_t x) { return (x + 4095) / 4096 * 4096; }
constexpr size_t WS_W1 = 1 * MiB, WS_W2 = WS_W1 + al(SZ_W1), WS_WA = WS_W2 + al(SZ_W2), WS_WB = WS_WA + 1024 * 2, WS_WO = WS_WA + al(2 * SZ_WA);
constexpr size_t SZ_WUV = (size_t)NLAYER * 16 * 64 * 256 * 2;
constexpr size_t WS_WUV = WS_WO + al(SZ_WO);
constexpr size_t WS_VT = WS_WUV + al(SZ_WUV);
constexpr size_t WS_KV = WS_VT + al((size_t)2 * 128 * 4128 * 2), WS_KIDX = WS_KV + al((size_t)MP * 256 * 2);
constexpr size_t WS_H = WS_KIDX + al((size_t)MP * 64 * 2), WS_HB = WS_H + al((size_t)MP * DM * 4), WS_RS = WS_HB + al((size_t)MP * DM * 2);
constexpr size_t WS_RS2 = WS_RS + al((size_t)MP * 32 * 4);
constexpr size_t WS_RSQ = WS_RS2 + al((size_t)32 * 64 * 4), WS_RSQ2 = WS_RSQ + al((size_t)MP * 8 * 4);
constexpr size_t WS_PROJ = WS_RSQ2 + al((size_t)32 * 16 * 4), WS_CQN = WS_PROJ + al((size_t)MP * NP1 * 2), WS_CKVN = WS_CQN + al((size_t)MP * 512 * 2);
constexpr size_t WS_Q2 = WS_CKVN + al((size_t)MP * 256 * 2), WS_OLAT = WS_Q2 + al((size_t)MP * NQ2 * 2), WS_YA = WS_OLAT + al((size_t)256 * 3 * 16 * 8 * 64 * 8 * 2);
constexpr size_t WS_YB = WS_YA + 1024 * 2, WS_PA = WS_YA + al((size_t)MP * 2048 * 2),
 WS_MG = WS_PA + al((size_t)MP * DM * 4), WS_RHO = WS_MG + al((size_t)MP * DM * 2), WS_SGB = WS_RHO + al((size_t)MP * DM * 2), WS_END = WS_SGB + al((size_t)MP * DM * 2);
constexpr int CW_TMO = 0, CW_CODE = 1, CW_BAR = 4096, CW_DSAQ = 16384, CW_SWAQ = 20480;

constexpr int LDSCTL_OFF = 0, MISC_OFF = LDSCTL_OFF + 320;
constexpr int RSTD_OFF = 512;
constexpr int RING_OFF = 8192, RING_BYTES = 131072;
constexpr int LDS_BYTES = 163840;
static_assert(RSTD_OFF + 5 * 256 * 4 <= RING_OFF, "LDS map");

struct Args {
    const float* x; const float* meta; const float* bias_table; const float* norm_g; const float* w_in; const float* q_norm_g; const float* kv_norm_g; const float* w_qb; const float* w_iq;
    const float* w_uk; const float* w_uv; const float* sinks; const float* w_proj_a; const float* w_proj_b; const float* w_out; const float* final_g;
    float* out; unsigned char* ws; int ph_lo, ph_hi;
};

__device__ __forceinline__ unsigned pkh(float lo, float hi) { typedef float f2_t __attribute__((ext_vector_type(2))); typedef __bf16 b2_t __attribute__((ext_vector_type(2))); f2_t v = {lo, hi}; b2_t b = __builtin_convertvector(v, b2_t); return __builtin_bit_cast(unsigned, b); }
struct XDesc { const float* W; const float* scale; bf16* out; int ldw, k0, c0, nvalid, K; };
__device__ __forceinline__ void xpose_load(const XDesc& d, float (&v)[32], int lane) {
    asm volatile("" : "+v"(lane));
    const int c = lane & 31, cc = (c < d.nvalid) ? c : 0; const float* p = d.W + (size_t)(d.k0 + (lane >> 5)) * d.ldw + d.c0 + cc;
    const float keep = (c < d.nvalid) ? 1.f : 0.f;
#pragma unroll
    for (int i = 0; i < 32; ++i) v[i] = p[(size_t)(2 * i) * d.ldw];
#pragma unroll
    for (int i = 0; i < 32; ++i) v[i] *= keep;
    if (d.scale) {
#pragma unroll
        for (int i = 0; i < 32; ++i) v[i] *= d.scale[d.k0 + 2 * i + (lane >> 5)];
    }
}
__device__ __forceinline__ void xpose_store(const XDesc& d, const float (&v)[32], LAS float* scr, int lane) {
    asm volatile("" : "+v"(lane));
    const int c = lane & 31;
#pragma unroll
    for (int i = 0; i < 32; ++i) scr[(2 * i + (lane >> 5)) * 33 + c] = v[i];
    LDS_WAIT(); asm volatile("" ::: "memory");
    const int cc = lane & 7;
#pragma unroll
    for (int j = 0; j < 4; ++j) { const int n = (lane >> 3) + 8 * j; const LAS float* s = scr + (8 * cc) * 33 + n;
        v4u o; o.x = pkh(s[0 * 33], s[1 * 33]); o.y = pkh(s[2 * 33], s[3 * 33]); o.z = pkh(s[4 * 33], s[5 * 33]); o.w = pkh(s[6 * 33], s[7 * 33]);
        *(GAS v4u*)(d.out + (size_t)n * d.K + d.k0 + 8 * cc) = o; }
    LDS_WAIT(); asm volatile("" ::: "memory");
}
__device__ __forceinline__ void fold_item(const float* __restrict__ wqb, const float* __restrict__ wuk, const float* __restrict__ gq, bf16* W2l, int h, int kb, int rb, LAS float* scr, int lane) {
    const int rr = lane & 31, r = rb * 32 + rr;
    float uk[64];
#pragma unroll
    for (int d = 0; d < 64; ++d) uk[d] = wuk[((size_t)h * 64 + d) * 256 + r];
    for (int i = 0; i < 32; ++i) { const int kk = 2 * i + (lane >> 5), k = kb * 64 + kk; const f32x4* qp = (const f32x4*)(wqb + (size_t)k * 1024 + h * 64); float a = 0.f;
#pragma unroll
        for (int d4 = 0; d4 < 16; ++d4) { const f32x4 q = qp[d4]; a = fmaf(q[0], uk[4 * d4], a); a = fmaf(q[1], uk[4 * d4 + 1], a); a = fmaf(q[2], uk[4 * d4 + 2], a); a = fmaf(q[3], uk[4 * d4 + 3], a); }
        scr[kk * 33 + rr] = a * gq[k]; }
    LDS_WAIT(); asm volatile("" ::: "memory");
    const int cc = lane & 7; bf16* out = W2l + (size_t)(h * 256 + rb * 32) * 512;
#pragma unroll
    for (int j = 0; j < 4; ++j) { const int n = (lane >> 3) + 8 * j; const LAS float* s = scr + (8 * cc) * 33 + n;
        v4u o; o.x = pkh(s[0 * 33], s[1 * 33]); o.y = pkh(s[2 * 33], s[3 * 33]); o.z = pkh(s[4 * 33], s[5 * 33]); o.w = pkh(s[6 * 33], s[7 * 33]);
        *(GAS v4u*)(out + (size_t)n * 512 + kb * 64 + 8 * cc) = o; }
    LDS_WAIT(); asm volatile("" ::: "memory");
}

typedef const __attribute__((address_space(4))) Args KArgs;
__device__ __forceinline__ KArgs* kargs() { size_t z = 0; asm volatile("" : "+s"(z)); return (KArgs*)((const __attribute__((address_space(4))) unsigned char*)__builtin_amdgcn_kernarg_segment_ptr() + z); }
struct Ctx {
    LAS unsigned char* lds; int tid, lane, wave, G, gw, NGW, bid;
};
#if defined(__HIP_DEVICE_COMPILE__)
#define ASSUME_GLOBAL(p) do { __builtin_assume(!__builtin_amdgcn_is_shared((const void*)(p))); __builtin_assume(!__builtin_amdgcn_is_private((const void*)(p))); } while (0)
#else
#define ASSUME_GLOBAL(p) do { } while (0)
#endif
__device__ __forceinline__ unsigned char* launder(unsigned char* p) { size_t z = 0; asm volatile("" : "+s"(z)); return p + z; }
__device__ __forceinline__ const float* launderf(const float* p) { size_t z = 0; asm volatile("" : "+s"(z)); return p + z; }
struct Bufs {
    bf16 *W1, *W2, *WA, *WB, *WO, *WUV, *VT, *KV, *KIDX, *RHO, *SGB, *HB, *PROJ, *CQN, *CKVN, *Q2, *OLAT, *YA, *YB, *MG; float *H, *RS, *RS2, *RSQ, *RSQ2, *PA;
    __device__ __forceinline__ explicit Bufs(unsigned char* ws0) {
        unsigned char* ws = launder(ws0);
        W1 = (bf16*)(ws + WS_W1); W2 = (bf16*)(ws + WS_W2); WA = (bf16*)(ws + WS_WA); WB = (bf16*)(ws + WS_WB); WO = (bf16*)(ws + WS_WO); WUV = (bf16*)(ws + WS_WUV); VT = (bf16*)(ws + WS_VT); KV = (bf16*)(ws + WS_KV); KIDX = (bf16*)(ws + WS_KIDX); RHO = (bf16*)(ws + WS_RHO); SGB = (bf16*)(ws + WS_SGB);
        H = (float*)(ws + WS_H); HB = (bf16*)(ws + WS_HB); RS = (float*)(ws + WS_RS); RS2 = (float*)(ws + WS_RS2); RSQ = (float*)(ws + WS_RSQ); RSQ2 = (float*)(ws + WS_RSQ2); PROJ = (bf16*)(ws + WS_PROJ); CQN = (bf16*)(ws + WS_CQN); CKVN = (bf16*)(ws + WS_CKVN);
        Q2 = (bf16*)(ws + WS_Q2); OLAT = (bf16*)(ws + WS_OLAT); YA = (bf16*)(ws + WS_YA); YB = (bf16*)(ws + WS_YB); PA = (float*)(ws + WS_PA); MG = (bf16*)(ws + WS_MG);
    }
};

__device__ __forceinline__ void p0_prologue(const Ctx& C) {
    const Bufs B(kargs()->ws);
    const KArgs& A = *kargs();
    LAS float* scr = (LAS float*)(C.lds + RING_OFF + C.wave * 16384);
    constexpr int I_T1 = (DM / 64) * (NP1 / 32), I_T2 = (512 / 64) * (512 / 32), I_T3 = (1024 / 64) * (DM / 32), I_T5 = (DM / 64) * (DM / 32), I_F = 16 * 8 * 8, I_UV = 16 * 8;
    constexpr int I_X = I_T1 + I_T2 + 2 * I_T3 + I_T5, NX = NLAYER * I_X;
    auto decode = [&](int it) -> XDesc {
        const int l = it / I_X; int r = it % I_X; XDesc d;
        if (r < I_T1) { const int nblk = NP1 / 32, kb = r / nblk, n0 = (r % nblk) * 32; int c0, nvalid = 32;
            if (n0 < 4096) c0 = n0; else if (n0 < 8192) { const int tt = (n0 - 4096) >> 8, wi = (n0 - 4096) & 255; c0 = (wi < 128 ? 4168 : 6216 - 128) + 128 * tt + wi; }
            else { c0 = n0 - 8192 + 4096; nvalid = (8264 - n0) < 0 ? 0 : ((8264 - n0) > 32 ? 32 : (8264 - n0)); }
            d = XDesc{A.w_in + (size_t)l * DM * NC_IN, A.norm_g + l * DM, B.W1 + ((size_t)l * NP1 + n0) * DM, NC_IN, kb * 64, c0, nvalid, DM}; return d; }
        r -= I_T1;
        if (r < I_T2) { const int nblk = 512 / 32, kb = r / nblk, nb = r % nblk;
            d = XDesc{A.w_iq + (size_t)l * 512 * 512, A.q_norm_g + l * 512, B.W2 + ((size_t)l * NQ2 + 4096 + nb * 32) * 512, 512, kb * 64, nb * 32, 32, 512}; return d; }
        r -= I_T2;
        if (r < 2 * I_T3) { const bool second = r >= I_T3; if (second) r -= I_T3; const int nblk = DM / 32, kb = r / nblk, nb = r % nblk;
            d = XDesc{(second ? A.w_proj_b : A.w_proj_a) + (size_t)l * 1024 * DM, nullptr, (second ? B.WB : B.WA) + ((size_t)l * DM + nb * 32) * 2048, DM, kb * 64, nb * 32, 32, 2048}; return d; }
        r -= 2 * I_T3;
        { const int nblk = DM / 32, kb = r / nblk, nb = r % nblk;
            d = XDesc{A.w_out + (size_t)l * DM * DM, nullptr, B.WO + ((size_t)l * DM + nb * 32) * DM, DM, kb * 64, nb * 32, 32, DM}; return d; }
    };
    {
        int it = C.gw;
        if (it < NX) {
            XDesc dA = decode(it), dB = dA, dC = dA; float vA[32], vB[32], vC[32];
            xpose_load(dA, vA, C.lane);
            if (it + C.NGW < NX) { dB = decode(it + C.NGW); xpose_load(dB, vB, C.lane); }
#define PRO_STEP(dc_, vc_, dn_, vn_) { if (it + 2 * C.NGW < NX) { dn_ = decode(it + 2 * C.NGW); xpose_load(dn_, vn_, C.lane); } xpose_store(dc_, vc_, scr, C.lane); it += C.NGW; if (it >= NX) break; }
            for (;;) {
                PRO_STEP(dA, vA, dC, vC)
                PRO_STEP(dB, vB, dA, vA)
                PRO_STEP(dC, vC, dB, vB)
            }
#undef PRO_STEP
        }
    }
    for (int it = C.gw; it < NLAYER * (I_F + I_UV); it += C.NGW) {
        const int l = it / (I_F + I_UV); int r = it % (I_F + I_UV);
        if (r >= I_F) { r -= I_F; const int h = r / 8, s = r % 8;
            const float* wsrc = A.w_uv + ((size_t)l * 16 + h) * 256 * 64; const int gg = C.lane >> 4, cc = C.lane & 15;
#pragma unroll
            for (int nt = 0; nt < 4; ++nt) { const float* p = wsrc + (size_t)(32 * s + 8 * gg) * 64 + 16 * nt + cc;
                v4u o; o.x = pkh(p[0 * 64], p[1 * 64]); o.y = pkh(p[2 * 64], p[3 * 64]); o.z = pkh(p[4 * 64], p[5 * 64]); o.w = pkh(p[6 * 64], p[7 * 64]);
                *(GAS v4u*)(B.WUV + ((((size_t)l * 16 + h) * 8 + s) * 4 + nt) * 512 + C.lane * 8) = o; }
            continue; }
        { const int h = r / 64, kb = (r / 8) % 8, rb = r % 8;
            fold_item(A.w_qb + (size_t)l * 512 * 1024, A.w_uk + (size_t)l * 16 * 64 * 256, A.q_norm_g + l * 512, B.W2 + (size_t)l * NQ2 * 512, h, kb, rb, scr, C.lane); }
    }
    for (int m = C.gw; m < MP; m += C.NGW) {
        const float* src = nullptr;
        if (m < 8192) src = A.x + (size_t)m * DM; else if (m < 8224) src = A.meta + (size_t)((m - 8192) % NMETA) * DM;
        float ss = 0.f;
#pragma unroll
        for (int j = 0; j < 8; ++j) { f32x4 v = src ? *(const f32x4*)(src + j * 256 + C.lane * 4) : (f32x4){0.f, 0.f, 0.f, 0.f};
            pg8::u32x2 w; w.x = pkh(v[0], v[1]); w.y = pkh(v[2], v[3]); *(pg8::u32x2*)(B.HB + (size_t)m * DM + j * 256 + C.lane * 4) = w;
            ss += (v[0] * v[0] + v[1] * v[1]) + (v[2] * v[2] + v[3] * v[3]); }
        ss = wave_sum(ss);
        if (C.lane < 32) B.RS[(size_t)m * 32 + C.lane] = (C.lane == 0) ? ss : 0.f;
        if (m >= 8192 && m < 8224) B.RS2[(size_t)(m - 8192) * 64 + C.lane] = (C.lane == 0) ? ss : 0.f;
        if (m >= NTOK) {
#pragma unroll
            for (int j = 0; j < 2; ++j) { *(v4u*)(B.YA + (size_t)m * YLD + j * 512 + C.lane * 8) = (v4u){0u, 0u, 0u, 0u}; *(v4u*)(B.YB + (size_t)m * YLD + j * 512 + C.lane * 8) = (v4u){0u, 0u, 0u, 0u}; }
        }
    }
    if (C.gw < 2) { bf16* kp = B.KIDX + (size_t)(C.gw * 129 + 128) * 2048;
#pragma unroll
        for (int i = 0; i < 2; ++i) { const int q = C.lane + 64 * i, s = q >> 5, hh = (q >> 4) & 1, n = 16 + (q & 15); *(v4u*)(kp + s * 512 + (hh * 32 + n) * 8) = (v4u){0u, 0u, 0u, 0u}; } }
}

template <int NP4>
__device__ __forceinline__ void rstd_table(const Ctx& C, const pg8::StaticOrder& S, const float* __restrict__ rs, float inv_dim) {
    LAS float* tbl = (LAS float*)(C.lds + RSTD_OFF);
    pg8::Unit u;
    for (int ui = 0; ui < 5 && S.next(ui, u); ++ui) {
        if (C.tid < 256) { const f32x4* p = (const f32x4*)(rs + (size_t)(u.pm * 256 + C.tid) * (NP4 * 4)); float s = 0.f;
#pragma unroll
            for (int j = 0; j < NP4; ++j) { const f32x4 v = p[j]; s += (v[0] + v[1]) + (v[2] + v[3]); }
            tbl[ui * 256 + C.tid] = rsqrtf(s * inv_dim + RMS_EPS); }
    }
    __syncthreads();
}

__device__ __forceinline__ void norm_tail(const Ctx& C, int l) {
    const Bufs B(kargs()->ws);
    const KArgs& A = *kargs();
    const int gw2 = (C.G == 256) ? C.gw - 64 * NWAVES : C.gw, ngw2 = (C.G == 256) ? C.NGW - 64 * NWAVES : C.NGW;
    if (gw2 < 0) return;
    for (int m = gw2; m < NTOK; m += ngw2) {
        const bf16* pr = B.PROJ + (size_t)m * NP1;
        { const pg8::u32x2 w = *(const pg8::u32x2*)(pr + PC_CKV + C.lane * 4); float v[4] = {pg8::bf_lo(w.x), pg8::bf_hi(w.x), pg8::bf_lo(w.y), pg8::bf_hi(w.y)};
          float ss = (v[0] * v[0] + v[1] * v[1]) + (v[2] * v[2] + v[3] * v[3]);
          ss = wave_sum(ss); const float r = rsqrtf(ss * (1.0f / 256.0f) + RMS_EPS);
          const f32x4 g = *(const f32x4*)(A.kv_norm_g + l * 256 + C.lane * 4);
          pg8::u32x2 o; o.x = pkh(v[0] * r * g[0], v[1] * r * g[1]); o.y = pkh(v[2] * r * g[2], v[3] * r * g[3]);
          *(pg8::u32x2*)(B.CKVN + (size_t)m * 256 + C.lane * 4) = o; }
    }
    for (int it = gw2; it < 2 * 65; it += ngw2) { const int b = it / 65, pos = (it % 65) * 64 + C.lane;
        if (pos < LTOK) { const bf16* vr = B.KV + (size_t)rowof(b, pos) * 256 + 128;
#pragma unroll 4
            for (int c8 = 0; c8 < 16; ++c8) { const v4u w = *(const v4u*)(vr + 8 * c8); bf16* o = B.VT + ((size_t)b * 128 + 8 * c8) * 4128 + pos;
                o[0 * 4128] = (bf16)(w.x & 0xffffu); o[1 * 4128] = (bf16)(w.x >> 16); o[2 * 4128] = (bf16)(w.y & 0xffffu); o[3 * 4128] = (bf16)(w.y >> 16);
                o[4 * 4128] = (bf16)(w.z & 0xffffu); o[5 * 4128] = (bf16)(w.z >> 16); o[6 * 4128] = (bf16)(w.w & 0xffffu); o[7 * 4128] = (bf16)(w.w >> 16); } } }
}

__device__ __forceinline__ unsigned f2key(float f) { const unsigned u = __float_as_uint(f); return (u & 0x80000000u) ? ~u : (u | 0x80000000u); }

__device__ __forceinline__ void final_phase(const Ctx& C) {
    const Bufs B(kargs()->ws);
    const KArgs& A = *kargs();
    for (int m = C.gw; m < 8192; m += C.NGW) {
        float s = (C.lane < 32) ? B.RS[(size_t)m * 32 + C.lane] : 0.f;
        s = wave_sum(s);
        const float r = rsqrtf(s * (1.0f / DM) + RMS_EPS);
#pragma unroll
        for (int j = 0; j < 8; ++j) { const pg8::u32x2 hw = *(const pg8::u32x2*)(B.HB + (size_t)m * DM + j * 256 + C.lane * 4); const f32x4 v = {pg8::bf_lo(hw.x), pg8::bf_hi(hw.x), pg8::bf_lo(hw.y), pg8::bf_hi(hw.y)}; const f32x4 g = *(const f32x4*)(A.final_g + j * 256 + C.lane * 4);
            *(f32x4*)(A.out + (size_t)m * DM + j * 256 + C.lane * 4) = v * r * g; }
    }
#if defined(MK_PROBE)
    if (MK_PROBE >= 0 && C.gw == 0) { VM_WAIT(); if (C.lane == 0) { float* o0 = A.out; o0[0] += (float)__hip_atomic_load((gu32*)(A.ws + WS_CTL) + 3, RLX_AGENT) * MK_PROBE_SCALE; } }
#endif
}


struct SkProj {
    bf16* P; bf16* KV; bf16* KIDX; int cb; const LAS float* tbl; int kr0;
    __device__ __forceinline__ float operator()(int rloc, int c, float v) const { const int ac = cb + c; const bf16 o = (bf16)f2bf(v * tbl[rloc]);
        if (ac >= 1024 && ac < 1280) KV[(size_t)rloc * 256 + ac - 1024] = o;
        else if (ac >= 8192 && ac < 8256) { const int m = kr0 + rloc, bb = m < 8192 ? (m >> 12) : ((m - 8192) >> 4), pos = m < 8192 ? (m & 4095) + NMETA : ((m - 8192) & 15), k = ac - 8192;
            KIDX[((size_t)(bb * 129 + (pos >> 5)) * 4 + (k >> 4)) * 512 + (((k >> 3) & 1) * 32 + (pos & 31)) * 8 + (k & 7)] = o; }
        else P[(size_t)rloc * NP1 + ac] = o;
        return v * tbl[rloc]; } };
struct SkQ2 { bf16* O; const LAS float* tbl; __device__ __forceinline__ float operator()(int rloc, int c, float v) const { O[(size_t)rloc * NQ2 + c] = (bf16)f2bf(v * tbl[rloc]); return 0.f; } };
struct SkPA { float* P; const bf16* G; int c0; __device__ __forceinline__ float operator()(int rloc, int c, float v) const { const int cg = c0 + c; P[(size_t)rloc * DM + c] = sigmoidf_(bf2f(G[(size_t)rloc * NP1 + 256 * (cg >> 7) + (cg & 127)])) * v; return 0.f; } };
struct SkMerge { bf16* O; const float* P; const bf16* G; int c0; __device__ __forceinline__ float operator()(int rloc, int c, float v) const { const int cg = c0 + c; O[(size_t)rloc * DM + c] = (bf16)f2bf(P[(size_t)rloc * DM + c] + sigmoidf_(bf2f(G[(size_t)rloc * NP1 + 256 * (cg >> 7) + (cg & 127) + 128])) * v); return 0.f; } };
struct SkRes { bf16* HB; __device__ __forceinline__ float operator()(int rloc, int c, float v) const { const float h = bf2f(HB[(size_t)rloc * DM + c]) + v; HB[(size_t)rloc * DM + c] = (bf16)f2bf(h); return h; } };
constexpr int MR = 8192;
typedef float f32x16 __attribute__((ext_vector_type(16)));
__device__ __forceinline__ void sk_glds16(const void* gsrc, unsigned lds_dst) { unsigned keep;
    asm volatile("s_mov_b32 %0, m0\n\ts_mov_b32 m0, %2\n\ts_nop 0\n\tglobal_load_lds_dwordx4 %1, off\n\ts_mov_b32 m0, %0" : "=&s"(keep) : "v"(gsrc), "s"(lds_dst) : "memory"); }
template <int NT, int GPI, class F>
__device__ __forceinline__ void skinny_unit(const Ctx& C, const bf16* __restrict__ A, int lda, const bf16* __restrict__ Bt, int ldb, int K, float* ss_out  , int ss_ld, int ss_col0, const F& epi) {
    const int lane = C.lane, w = C.wave, r32 = lane & 31, hh = lane >> 5;
    f32x16 acc[NT];
#pragma unroll
    for (int nt = 0; nt < NT; ++nt) acc[nt] = (f32x16){};
    const int kper = K >> 3, ngroups = kper >> 6;
    const unsigned stg = (unsigned)__builtin_amdgcn_readfirstlane((unsigned)(uintptr_t)(C.lds + RING_OFF) + (unsigned)w * 16384u);
    LAS unsigned char* stp = C.lds + RING_OFF + w * 16384;
    const int prow = lane >> 3, pch = lane & 7;
    const int foff = r32 * 128;
    const int fsw = (r32 >> 1) & 7;
#pragma unroll 1
    for (int g0 = 0; g0 < ngroups; ++g0) {
        const size_t kbyte = ((size_t)w * kper + (size_t)g0 * 64) * 2;
#pragma unroll
        for (int p = 0; p < 4; ++p) { const int row = 8 * p + prow; const int lg = pch ^ ((row >> 1) & 7);
            sk_glds16((const unsigned char*)A + (size_t)row * lda * 2 + kbyte + lg * 16, stg + p * 1024); }
#pragma unroll
        for (int nt = 0; nt < NT; ++nt)
#pragma unroll
            for (int p = 0; p < 4; ++p) { const int row = 8 * p + prow; const int lg = pch ^ ((row >> 1) & 7);
                sk_glds16((const unsigned char*)Bt + (size_t)(nt * 32 + row) * ldb * 2 + kbyte + lg * 16, stg + 4096 * (1 + nt) + p * 1024); }
        asm volatile("s_waitcnt vmcnt(0)" ::: "memory");
        bf16x8 a[4], bv[NT][4];
#pragma unroll
        for (int s = 0; s < 4; ++s) { const int o = foff + (((2 * s + hh) ^ fsw) << 4); a[s] = *(const LAS bf16x8*)(stp + o);
#pragma unroll
            for (int nt = 0; nt < NT; ++nt) bv[nt][s] = *(const LAS bf16x8*)(stp + 4096 * (1 + nt) + o); }
        __builtin_amdgcn_sched_barrier(0);
#pragma unroll
        for (int s = 0; s < 4; ++s)
#pragma unroll
            for (int nt = 0; nt < NT; ++nt) acc[nt] = __builtin_amdgcn_mfma_f32_32x32x16_bf16(a[s], bv[nt][s], acc[nt], 0, 0, 0);
        LDS_WAIT(); asm volatile("" ::: "memory");
    }
    LDS_WAIT(); __syncthreads();
    LAS float* part = (LAS float*)(C.lds + RING_OFF);
#pragma unroll
    for (int nt = 0; nt < NT; ++nt)
#pragma unroll
        for (int i = 0; i < 16; ++i) part[(w * NT * 16 + nt * 16 + i) * 64 + lane] = acc[nt][i];
    LDS_WAIT(); __syncthreads();
    int lane_e = lane; asm volatile("" : "+v"(lane_e));
    const int r32e = lane_e & 31, hhe = lane_e >> 5;
#pragma unroll
    for (int j = 0; j < 2 * NT; ++j) { const int e = (w + 8 * j) * 64 + lane;
        const int nti = w + 8 * j, nt = nti >> 4, i = nti & 15;
        float v = 0.f;
#pragma unroll
        for (int ww = 0; ww < 8; ++ww) v += part[ww * NT * 1024 + e];
        const int rloc = (i & 3) + 8 * (i >> 2) + 4 * hhe, c = nt * 32 + r32e;
        float sv = epi(rloc, c, v);
        if (ss_out != nullptr) { sv = sv * sv;
#pragma unroll
            for (int o = 1; o < 32; o <<= 1) sv += __shfl_xor(sv, o);
            if (r32e == 0) ss_out[(size_t)rloc * ss_ld + ss_col0 + nt] = sv; }
        __builtin_amdgcn_sched_barrier(0);
    }
    LDS_WAIT(); __syncthreads();
}
__device__ __forceinline__ void skinny_rstd(const Ctx& C, const float* __restrict__ rs, int np, float inv_dim, LAS float* tbl) {
    if (C.tid < 32) { float s = 0.f; const f32x4* p = (const f32x4*)(rs + (size_t)C.tid * np);
        for (int j = 0; j < np / 4; ++j) { const f32x4 v = p[j]; s += (v[0] + v[1]) + (v[2] + v[3]); }
        tbl[C.tid] = rsqrtf(s * inv_dim + RMS_EPS); }
    LDS_WAIT(); __syncthreads();
}

typedef short s16x4 __attribute__((ext_vector_type(4)));
typedef unsigned short u16x4 __attribute__((ext_vector_type(4)));
constexpr int DS_ISC = RING_OFF, DS_ISC_WORDS = 4128, DS_ISC_STRIDE = DS_ISC_WORDS * 4;
constexpr int DS_SEL = DS_ISC + 8 * DS_ISC_STRIDE;
constexpr int DS_BIAS = DS_SEL + 8 * 512;
constexpr int DS_QROW = DS_BIAS + 8192;
constexpr int DS_END = DS_QROW + 256;
constexpr size_t OL_BLOCK = (size_t)3 * 16 * 8 * 64 * 8;
static_assert(DS_END <= LDS_BYTES, "DSA LDS map");

__device__ __forceinline__ void glds16(const void* gsrc, unsigned lds_dst) { unsigned keep;
    asm volatile("s_mov_b32 %0, m0\n\ts_mov_b32 m0, %2\n\ts_nop 0\n\tglobal_load_lds_dwordx4 %1, off\n\ts_mov_b32 m0, %0" : "=&s"(keep) : "v"(gsrc), "s"(lds_dst) : "memory"); }
__device__ __forceinline__ float relu1(float x) { const int i = __float_as_int(x); return __int_as_float(i > 0 ? i : 0); }
__device__ __forceinline__ void glds16o(const void* base, unsigned voff, unsigned lds_dst) { unsigned keep;
    asm volatile("s_mov_b32 %0, m0\n\ts_mov_b32 m0, %3\n\ts_nop 0\n\tglobal_load_lds_dwordx4 %1, %2\n\ts_mov_b32 m0, %0" : "=&s"(keep) : "v"(voff), "s"(base), "s"(lds_dst) : "memory"); }
__device__ __forceinline__ s16x4 tr_read(LAS unsigned char* p) { typedef short v4i16_t __attribute__((ext_vector_type(4))); return __builtin_bit_cast(s16x4, __builtin_amdgcn_ds_read_tr16_b64_v4i16((LAS v4i16_t*)p)); }
__device__ __forceinline__ unsigned cvtpk(float lo, float hi) { typedef float f2_t __attribute__((ext_vector_type(2))); typedef __bf16 b2_t __attribute__((ext_vector_type(2))); f2_t v = {lo, hi}; b2_t b = __builtin_convertvector(v, b2_t); return __builtin_bit_cast(unsigned, b); }

#define DSA_LOCALS() const int w = C.wave; LAS unsigned* ISC = (LAS unsigned*)(C.lds + DS_ISC); LAS unsigned short* sel = (LAS unsigned short*)(C.lds + DS_SEL) + w * 256; const LAS float* biasl = (const LAS float*)(C.lds + DS_BIAS); (void)ISC; (void)sel; (void)biasl
#define RELANE() do { asm volatile("" : "+v"(lane)); asm volatile("" : "+s"(t0), "+s"(b)); } while (0)
__device__ __forceinline__ void dsa_step1(const Ctx& C, const Bufs& B, int b, int t0) {
    int lane = C.lane; RELANE(); DSA_LOCALS();
    PROBE_T0();
    {
        const int r32 = lane & 31, hh = lane >> 5;
        bf16x8 qa[2][4]; float wq[2][2][8];
        const int qi = 2 * ((r32 >> 2) & 1) + (r32 >> 4), hA = (r32 & 3) + 4 * ((r32 >> 3) & 1);
#pragma unroll
        for (int g = 0; g < 2; ++g) { const int row = rowof(b, t0 + 4 * g + qi);
#pragma unroll
            for (int s = 0; s < 4; ++s) qa[g][s] = *(const bf16x8*)(B.Q2 + (size_t)row * NQ2 + 4096 + hA * 64 + 16 * s + 8 * hh);
#pragma unroll
            for (int j = 0; j < 2; ++j) { const int rw = rowof(b, t0 + 4 * g + 2 * hh + j); const v4u ww = *(const v4u*)(B.PROJ + (size_t)rw * NP1 + PC_WIDX);
                const float sc = 0.35355339059327373f * 0.125f;
                wq[g][j][0] = pg8::bf_lo(ww.x) * sc; wq[g][j][1] = pg8::bf_hi(ww.x) * sc; wq[g][j][2] = pg8::bf_lo(ww.y) * sc; wq[g][j][3] = pg8::bf_hi(ww.y) * sc;
                wq[g][j][4] = pg8::bf_lo(ww.z) * sc; wq[g][j][5] = pg8::bf_hi(ww.z) * sc; wq[g][j][6] = pg8::bf_lo(ww.w) * sc; wq[g][j][7] = pg8::bf_hi(ww.w) * sc; } }
        PROBE_T1(40);
        const int nkeys = t0 + 8, nkt = (nkeys + 31) >> 5;
        bf16x8 kA[4], kB[4];
#define IDX_LOAD(dst, kt_) do { const bf16* kp_ = B.KIDX + (size_t)(b * 129 + (kt_)) * 2048 + 8 * lane; \
        asm volatile("global_load_dwordx4 %0, %4, off\n\tglobal_load_dwordx4 %1, %4, off offset:1024\n\tglobal_load_dwordx4 %2, %4, off offset:2048\n\tglobal_load_dwordx4 %3, %4, off offset:3072" \
                     : "=&v"(dst[0]), "=&v"(dst[1]), "=&v"(dst[2]), "=&v"(dst[3]) : "v"(kp_) : "memory"); } while (0)
#define IDX_WAIT(cur) asm volatile("s_waitcnt vmcnt(12)" : "+v"(cur[0]), "+v"(cur[1]), "+v"(cur[2]), "+v"(cur[3]) :: "memory")
#define IDX_TILE(src, kt_) do { const int key_ = (kt_) * 32 + r32; \
        _Pragma("unroll") for (int g = 0; g < 2; ++g) { f32x16 acc = {}; \
            _Pragma("unroll") for (int s = 0; s < 4; ++s) acc = __builtin_amdgcn_mfma_f32_32x32x16_bf16(qa[g][s], src[s], acc, 0, 0, 0); \
            _Pragma("unroll") for (int j = 0; j < 2; ++j) { float isc = 0.f; \
                _Pragma("unroll") for (int h = 0; h < 8; ++h) isc += wq[g][j][h] * relu1(acc[8 * j + h]); \
                ISC[(4 * g + 2 * hh + j) * DS_ISC_WORDS + key_] = f2key(isc); } } } while (0)
        bf16x8 kC[4], kD[4];
        int kt = w;
        const int ktl = nkt - 1;
        if (kt < nkt) {
            __builtin_amdgcn_s_waitcnt(0x0F70);
            IDX_LOAD(kA, kt); IDX_LOAD(kB, (kt + 8 < nkt ? kt + 8 : ktl)); IDX_LOAD(kC, (kt + 16 < nkt ? kt + 16 : ktl));
#define IDX_STEP(cur, nxt) { IDX_LOAD(nxt, (kt + 24 < nkt ? kt + 24 : ktl)); IDX_WAIT(cur); __builtin_amdgcn_sched_barrier(0); IDX_TILE(cur, kt); __builtin_amdgcn_sched_barrier(0); kt += 8; if (kt >= nkt) break; }
#pragma unroll 1
            for (;;) {
                IDX_STEP(kA, kD)
                IDX_STEP(kB, kA)
                IDX_STEP(kC, kB)
                IDX_STEP(kD, kC)
            }
#undef IDX_STEP
            asm volatile("s_waitcnt vmcnt(0)" : "+v"(kA[0]), "+v"(kA[1]), "+v"(kA[2]), "+v"(kA[3]), "+v"(kB[0]), "+v"(kB[1]), "+v"(kB[2]), "+v"(kB[3]) :: "memory");
            asm volatile("" : "+v"(kC[0]), "+v"(kC[1]), "+v"(kC[2]), "+v"(kC[3]), "+v"(kD[0]), "+v"(kD[1]), "+v"(kD[2]), "+v"(kD[3]) :: "memory");
        }
#undef IDX_WAIT
#undef IDX_LOAD
#undef IDX_TILE
        PROBE_T1(41);
    }
}
__device__ __forceinline__ int dsa_step2(const Ctx& C, int b, int t0) {
    int lane = C.lane; RELANE(); DSA_LOCALS();
    const int t = t0 + w, n = t + 1;
    int cnt;
    if (n <= TOPK) { for (int j = lane; j < n; j += 64) sel[j] = (unsigned short)j; cnt = n; }
    else {
        const LAS unsigned* myrow = ISC + w * DS_ISC_WORDS;
        const int nI = (n + 255) >> 8;
        unsigned v[68];
#pragma unroll
        for (int i = 0; i < 17; ++i) { const pg8::u32x4 x = *(const LAS pg8::u32x4*)(myrow + 256 * i + 4 * lane);
#pragma unroll
            for (int e = 0; e < 4; ++e) v[4 * i + e] = (256 * i + 4 * lane + e <= t) ? x[e] : 0u; }
        unsigned T = 0u; bool exact = false;
#define DSA_COUNT(res, cand_) do { int c_ = 0; const unsigned t_ = (cand_); \
        _Pragma("unroll") for (int i = 0; i < 17; ++i) { if (i < nI) { unsigned long long m0_, m1_, m2_, m3_; \
            asm volatile("v_cmp_ge_u32_e64 %1, %5, %9\n\tv_cmp_ge_u32_e64 %2, %6, %9\n\tv_cmp_ge_u32_e64 %3, %7, %9\n\tv_cmp_ge_u32_e64 %4, %8, %9\n\t" \
                         "v_addc_co_u32_e64 %0, %1, 0, %0, %1\n\tv_addc_co_u32_e64 %0, %2, 0, %0, %2\n\tv_addc_co_u32_e64 %0, %3, 0, %0, %3\n\tv_addc_co_u32_e64 %0, %4, 0, %0, %4" \
                         : "+v"(c_), "=&s"(m0_), "=&s"(m1_), "=&s"(m2_), "=&s"(m3_) : "v"(v[4 * i]), "v"(v[4 * i + 1]), "v"(v[4 * i + 2]), "v"(v[4 * i + 3]), "v"(t_)); } } \
        int tot_ = 0; _Pragma("unroll") for (int bt = 0; bt < 7; ++bt) tot_ += __popcll(__ballot((c_ >> bt) & 1)) << bt; res = tot_; } while (0)
        {
            unsigned kmax = 0u, kmin = 0xffffffffu;
#pragma unroll
            for (int i = 0; i < 17; ++i) { if (i < nI) {
#pragma unroll
                for (int e = 0; e < 4; ++e) { const unsigned x = v[4 * i + e]; kmax = x > kmax ? x : kmax; const unsigned y = x ? x : 0xffffffffu; kmin = y < kmin ? y : kmin; } } }
#pragma unroll
            for (int o = 1; o < 64; o <<= 1) { const unsigned a = (unsigned)__shfl_xor((int)kmax, o), bq = (unsigned)__shfl_xor((int)kmin, o); kmax = a > kmax ? a : kmax; kmin = bq < kmin ? bq : kmin; }
#define DSA_K2F(k_) __uint_as_float(((k_) & 0x80000000u) ? ((k_) & 0x7fffffffu) : ~(k_))
            float lo = DSA_K2F(kmin), hi = DSA_K2F(kmax), flo = (float)(n - TOPK), fhi = (float)(1 - TOPK); int side = 0;
#pragma unroll 1
            for (int it = 0; it < 20 && !exact; ++it) {
                float x = (lo * fhi - hi * flo) / (fhi - flo);
                if (!(x > lo && x < hi)) x = 0.5f * (lo + hi);
                if (!(x > lo && x < hi)) break;
                const unsigned cand = f2key(x); int c;
                DSA_COUNT(c, cand);
                if (c == TOPK) { T = cand; exact = true; }
                else if (c > TOPK) { lo = x; flo = (float)(c - TOPK); if (side == 1) fhi *= 0.5f; side = 1; }
                else { hi = x; fhi = (float)(c - TOPK); if (side == -1) flo *= 0.5f; side = -1; }
            }
#undef DSA_K2F
        }
        if (!exact) {
            T = 0u;
#pragma unroll 1
            for (int bit = 31; bit >= 0; --bit) {
                const unsigned cand = T | (1u << bit); int c;
                DSA_COUNT(c, cand);
                if (c >= TOPK) { T = cand; if (c == TOPK) { exact = true; break; } }
            }
            if (!exact) { int c; DSA_COUNT(c, T); exact = (c == TOPK); }
        }
#undef DSA_COUNT
        int base = 0;
#pragma unroll
        for (int k = 0; k < 68; ++k) { const bool p = exact ? (v[k] >= T) : (v[k] > T); const unsigned long long m = __ballot(p);
            const int pos = base + (int)__builtin_amdgcn_mbcnt_hi((unsigned)(m >> 32), __builtin_amdgcn_mbcnt_lo((unsigned)m, 0u));
            if (p) sel[pos] = (unsigned short)(256 * (k >> 2) + 4 * lane + (k & 3));
            base += __popcll(m); }
        if (!exact) {
            int last = -1;
            while (base < TOPK) { int mi = 0x7fffffff;
#pragma unroll
                for (int k = 0; k < 68; ++k) { const int idx = 256 * (k >> 2) + 4 * lane + (k & 3); if (v[k] == T && idx > last && idx < mi) mi = idx; }
#pragma unroll
                for (int o = 1; o < 64; o <<= 1) { const int oth = __shfl_xor(mi, o); mi = oth < mi ? oth : mi; }
                if (lane == 0) sel[base] = (unsigned short)mi;
                last = mi; ++base; }
        }
        cnt = TOPK;
    }
    return cnt;
}
__device__ __forceinline__ void dsa_step3(const Ctx& C, const Bufs& B, int b, int t0, int cnt, int qslot) {
    int lane = C.lane; RELANE(); DSA_LOCALS(); const int t = t0 + w;
    {
        const int g = lane >> 4, c16 = lane & 15, rowq = rowof(b, t);
        bf16x8 qf[8];
#pragma unroll
        for (int s = 0; s < 8; ++s) qf[s] = *(const bf16x8*)(B.Q2 + (size_t)rowq * NQ2 + c16 * 256 + 32 * s + 8 * g);
        f32x4 O[16];
#pragma unroll
        for (int rt = 0; rt < 16; ++rt) O[rt] = (f32x4){0.f, 0.f, 0.f, 0.f};
        float m_ref = 0.f, lsum = 0.f;
        const int buf0 = DS_ISC + w * DS_ISC_STRIDE;
        const int npairs = (cnt + 31) >> 5;
        const int swz = (c16 & 7) << 1;
        const int trow = 4 * g + (c16 >> 2), tswz = (trow & 7) << 1, tp = c16 & 3;
        const int arow = (c16 & 7) * 1024 + (c16 >> 3) * 512, trowo = (trow & 7) * 1024 + (trow >> 3) * 512;
        const unsigned ldsb = (unsigned)(uintptr_t)(C.lds + buf0);
#define DSA_GATHER(c_) do { const unsigned bo_ = (unsigned)__builtin_amdgcn_readfirstlane(ldsb + ((c_) & 1) * 8192); \
        const pg8::u32x4 sp_ = *(const LAS pg8::u32x4*)(sel + 16 * (c_) + 8 * (lane >> 5)); const unsigned spw_[4] = {sp_.x, sp_.y, sp_.z, sp_.w}; \
        _Pragma("unroll") for (int p = 0; p < 8; ++p) { const int j = 16 * (c_) + 8 * (lane >> 5) + p; int pos = (int)((spw_[p >> 1] >> (16 * (p & 1))) & 0xffffu); pos = j < cnt ? pos : 0; \
            const int logical = (lane & 31) ^ (p << 1); \
            glds16o(B.CKVN, (unsigned)rowof(b, pos) * 512u + (unsigned)logical * 16u, bo_ + p * 1024); } } while (0)
        DSA_GATHER(0); DSA_GATHER(1);
#pragma unroll 1
        for (int kp = 0; kp < npairs; ++kp) {
            asm volatile("s_waitcnt vmcnt(0)" ::: "memory");
            bf16x8 a0[8], a1[8]; s16x4 v0[16], v1[16];
#pragma unroll
            for (int s = 0; s < 8; ++s) { const int off = arow + (((4 * s + g) ^ swz) << 4); a0[s] = *(const LAS bf16x8*)(C.lds + buf0 + off); a1[s] = *(const LAS bf16x8*)(C.lds + buf0 + 8192 + off); }
            const u16x4 p0 = *(const LAS u16x4*)(sel + 32 * kp + 4 * g), p1 = *(const LAS u16x4*)(sel + 32 * kp + 16 + 4 * g);
            __builtin_amdgcn_sched_barrier(0);
            f32x4 s0 = {0.f, 0.f, 0.f, 0.f}, s1 = {0.f, 0.f, 0.f, 0.f};
#pragma unroll
            for (int s = 0; s < 8; ++s) { s0 = __builtin_amdgcn_mfma_f32_16x16x32_bf16(a0[s], qf[s], s0, 0, 0, 0); s1 = __builtin_amdgcn_mfma_f32_16x16x32_bf16(a1[s], qf[s], s1, 0, 0, 0); }
            __builtin_amdgcn_sched_barrier(0);
#pragma unroll
            for (int rt = 0; rt < 16; ++rt) { const int off = trowo + (((2 * rt + (tp >> 1)) ^ tswz) << 4) + 8 * (tp & 1); v0[rt] = tr_read(C.lds + buf0 + off); v1[rt] = tr_read(C.lds + buf0 + 8192 + off); }
            __builtin_amdgcn_sched_barrier(0);
            LDS_WAIT(); asm volatile("" ::: "memory");
            if (kp + 1 < npairs) { DSA_GATHER(2 * kp + 2); DSA_GATHER(2 * kp + 3); }
            __builtin_amdgcn_sched_barrier(0);
            float x0[4], x1[4]; float mloc = -INFINITY;
#pragma unroll
            for (int i = 0; i < 4; ++i) { const int j0 = 32 * kp + 4 * g + i, j1 = j0 + 16; int d0 = t - (int)p0[i], d1 = t - (int)p1[i]; d0 = d0 < 0 ? 0 : (d0 > 127 ? 127 : d0); d1 = d1 < 0 ? 0 : (d1 > 127 ? 127 : d1);
                const float b0 = biasl[d0 * 16 + c16], b1 = biasl[d1 * 16 + c16];
                const float y0 = 0.125f * s0[i] + b0, y1 = 0.125f * s1[i] + b1;
                x0[i] = (j0 < cnt) ? y0 : -INFINITY; x1[i] = (j1 < cnt) ? y1 : -INFINITY;
                mloc = fmaxf(mloc, fmaxf(x0[i], x1[i])); }
            mloc = fmaxf(mloc, __shfl_xor(mloc, 16)); mloc = fmaxf(mloc, __shfl_xor(mloc, 32));
            if (kp == 0) m_ref = mloc;
            else if (__any(mloc > m_ref + 8.0f)) { const float mn = fmaxf(m_ref, mloc), al = __expf(m_ref - mn);
#pragma unroll
                for (int rt = 0; rt < 16; ++rt) O[rt] *= al;
                lsum *= al; m_ref = mn; }
            float pe0[4], pe1[4];
#pragma unroll
            for (int i = 0; i < 4; ++i) { pe0[i] = __expf(x0[i] - m_ref); pe1[i] = __expf(x1[i] - m_ref); lsum += pe0[i] + pe1[i]; }
            pg8::u32x4 pw; pw.x = cvtpk(pe0[0], pe0[1]); pw.y = cvtpk(pe0[2], pe0[3]); pw.z = cvtpk(pe1[0], pe1[1]); pw.w = cvtpk(pe1[2], pe1[3]);
            const bf16x8 pf = __builtin_bit_cast(bf16x8, pw);
#pragma unroll
            for (int rt = 0; rt < 16; ++rt) { const bf16x8 af = {v0[rt][0], v0[rt][1], v0[rt][2], v0[rt][3], v1[rt][0], v1[rt][1], v1[rt][2], v1[rt][3]};
                O[rt] = __builtin_amdgcn_mfma_f32_16x16x32_bf16(af, pf, O[rt], 0, 0, 0); }
            LDS_WAIT(); asm volatile("" ::: "memory");
        }
#undef DSA_GATHER
        lsum += __shfl_xor(lsum, 16); lsum += __shfl_xor(lsum, 32);
        const float inv = 1.0f / lsum;
#pragma unroll
        for (int rt = 0; rt < 16; ++rt) { const f32x4 o = O[rt] * inv; pg8::u32x2 wv; wv.x = cvtpk(o[0], o[1]); wv.y = cvtpk(o[2], o[3]);
            const int s_ = rt >> 1, gp = 2 * (rt & 1) + (g >> 1), jo = 4 * (g & 1);
            *(pg8::u32x2*)(B.OLAT + (size_t)C.bid * OL_BLOCK + ((((size_t)(qslot >> 4) * 16 + c16) * 8 + s_) * 64 + gp * 16 + (qslot & 15)) * 8 + jo) = wv; }
    }
}
__device__ __forceinline__ void dsa_wuv(const Ctx& C, const Bufs& B, int l, int nq) {
    const int lane = C.lane, w = C.wave, g = lane >> 4, c16 = lane & 15;
    const LAS int* qrow = (const LAS int*)(C.lds + DS_QROW);
    const int nmt = (nq + 15) >> 4;
#pragma unroll 1
    for (int hq = 0; hq < 2; ++hq) { const int h = 2 * w + hq;
        f32x4 Dv[3][4];
#pragma unroll
        for (int mt = 0; mt < 3; ++mt)
#pragma unroll
            for (int nt = 0; nt < 4; ++nt) Dv[mt][nt] = (f32x4){0.f, 0.f, 0.f, 0.f};
        const bf16* wb = B.WUV + (((size_t)l * 16 + h) * 32) * 512 + lane * 8;
        const bf16* ab = B.OLAT + (size_t)C.bid * OL_BLOCK + ((size_t)h * 8) * 512 + lane * 8;
        v4u zw[3][2];
        { const int slot = lane >> 2, d0 = (lane & 3) * 16;
#pragma unroll
          for (int mt = 0; mt < 3; ++mt) { const int q = mt * 16 + slot; const int row = qrow[q < nq ? q : 0];
#pragma unroll
              for (int hf = 0; hf < 2; ++hf) zw[mt][hf] = *(const v4u*)(B.PROJ + (size_t)row * NP1 + PC_ZB + h * 64 + d0 + 8 * hf); } }
        bf16x8 bwA[4], awA[3], bwB[4], awB[3];
#define WUV_LOAD(bw_, aw_, s_) do { _Pragma("unroll") for (int nt = 0; nt < 4; ++nt) bw_[nt] = *(const bf16x8*)(wb + ((s_) * 4 + nt) * 512); \
        _Pragma("unroll") for (int mt = 0; mt < 3; ++mt) { aw_[mt] = *(const bf16x8*)(ab + ((size_t)mt * 16 * 8 + (s_)) * 512);     } } while (0)
#define WUV_MMA(bw_, aw_) do { _Pragma("unroll") for (int mt = 0; mt < 3; ++mt) _Pragma("unroll") for (int nt = 0; nt < 4; ++nt) Dv[mt][nt] = __builtin_amdgcn_mfma_f32_16x16x32_bf16(aw_[mt], bw_[nt], Dv[mt][nt], 0, 0, 0); } while (0)
        WUV_LOAD(bwA, awA, 0);
#pragma unroll
        for (int s = 0; s < 8; s += 2) {
            WUV_LOAD(bwB, awB, s + 1);
            __builtin_amdgcn_sched_barrier(0);
            WUV_MMA(bwA, awA);
            __builtin_amdgcn_sched_barrier(0);
            if (s + 2 < 8) WUV_LOAD(bwA, awA, s + 2);
            __builtin_amdgcn_sched_barrier(0);
            WUV_MMA(bwB, awB);
            __builtin_amdgcn_sched_barrier(0);
        }
#undef WUV_LOAD
#undef WUV_MMA
        LAS float* stg = (LAS float*)(C.lds + RING_OFF + w * 4608);
#pragma unroll
        for (int mt = 0; mt < 3; ++mt) { if (mt < nmt) {
#pragma unroll
            for (int nt = 0; nt < 4; ++nt)
#pragma unroll
                for (int i = 0; i < 4; ++i) stg[(4 * g + i) * 68 + 16 * nt + c16] = Dv[mt][nt][i];
            LDS_WAIT(); asm volatile("" ::: "memory");
            const int slot = lane >> 2, q = mt * 16 + slot, d0 = (lane & 3) * 16;
            if (q < nq) { const int row = qrow[q]; const v4u zw_[2] = {zw[mt][0], zw[mt][1]};
                bf16* op = B.YB + (size_t)row * YLD + h * 64 + d0;
#pragma unroll
                for (int hf = 0; hf < 2; ++hf) { const v4u zw = zw_[hf];
                    const f32x4 xa = *(const LAS f32x4*)(stg + slot * 68 + d0 + 8 * hf), xb = *(const LAS f32x4*)(stg + slot * 68 + d0 + 8 * hf + 4);
                    v4u o; o.x = pk2(xa[0] * siluf_(pg8::bf_lo(zw.x)), xa[1] * siluf_(pg8::bf_hi(zw.x))); o.y = pk2(xa[2] * siluf_(pg8::bf_lo(zw.y)), xa[3] * siluf_(pg8::bf_hi(zw.y)));
                    o.z = pk2(xb[0] * siluf_(pg8::bf_lo(zw.z)), xb[1] * siluf_(pg8::bf_hi(zw.z))); o.w = pk2(xb[2] * siluf_(pg8::bf_lo(zw.w)), xb[3] * siluf_(pg8::bf_hi(zw.w)));
                    *(v4u*)(op + 8 * hf) = o; } }
            LDS_WAIT(); asm volatile("" ::: "memory"); } }
    }
}
#ifndef MK_DSUB
#define MK_DSUB 0
#endif
__device__ __forceinline__ void dsa_unit(const Ctx& C, const Bufs& B, int l, int b, int t0, int uidx) {
    { PROBE_T0(); for (int rep = 0; rep < ((MK_DSUB & 1) ? 2 : 1); ++rep) { dsa_step1(C, B, b, t0); LDS_WAIT(); PROBE_T1(10); __syncthreads(); } PROBE_T1(0); }
    int cnt = 0;
    { PROBE_T0(); for (int rep = 0; rep < ((MK_DSUB & 2) ? 2 : 1); ++rep) { cnt = dsa_step2(C, b, t0); LDS_WAIT(); asm volatile("" ::: "memory"); } PROBE_T1(1); }
    if (C.lane == 0) ((LAS int*)(C.lds + DS_QROW))[uidx * 8 + C.wave] = rowof(b, t0 + C.wave);
    { PROBE_T0(); for (int rep = 0; rep < ((MK_DSUB & 4) ? 2 : 1); ++rep) { dsa_step3(C, B, b, t0, cnt, uidx * 8 + C.wave); } PROBE_T1(2); }
}
#undef RELANE
#undef DSA_LOCALS

__device__ __forceinline__ void dsa_phase(const Ctx& C, int l) {
    const Bufs B(kargs()->ws);
    const KArgs& A = *kargs();
    for (int i = C.tid; i < 128 * 16; i += NWAVES * 64) { const int dd = i >> 4, h = i & 15; ((LAS float*)(C.lds + DS_BIAS))[i] = A.bias_table[t5_bucket(dd) * 32 + 16 + h]; }
    __syncthreads();
    gu32* qctr = (gu32*)(A.ws + WS_CTL) + CW_DSAQ + l * 128;
    LAS int* qslot = (LAS int*)(C.lds + DS_QROW) + 56;
    int nu = 0, myb = C.bid & 1; bool other = false;
    int s_next = 0;
#define DSA_GRAB_ISSUE() do { if (C.tid == 0) s_next = (int)__hip_atomic_fetch_add(qctr + myb * 64, 1u, __ATOMIC_RELAXED, __HIP_MEMORY_SCOPE_AGENT); } while (0)
#define DSA_GRAB_FINISH() do { if (C.tid == 0) { int s_ = s_next; \
        if (s_ >= 514 && !other) { s_ = (int)__hip_atomic_fetch_add(qctr + (myb ^ 1) * 64, 1u, __ATOMIC_RELAXED, __HIP_MEMORY_SCOPE_AGENT); s_ = s_ < 514 ? s_ + 1024 : -1; } \
        else if (s_ >= 514) s_ = -1; \
        qslot[0] = s_; } } while (0)
    DSA_GRAB_ISSUE(); DSA_GRAB_FINISH();
    LDS_WAIT(); __syncthreads();
    for (;;) {
        int s = qslot[0];
        const bool done = s < 0;
        if ((done && nu > 0) || nu == 6) {
            VM_WAIT(); LDS_WAIT(); __syncthreads(); { PROBE_T0(); dsa_wuv(C, B, l, nu * 8); PROBE_T1(3); } __syncthreads(); nu = 0; }
        if (done) break;
        int b = myb;
        if (s >= 1024) { s -= 1024; if (!other) { other = true; myb ^= 1; } b = myb; }
        DSA_GRAB_ISSUE();
        dsa_unit(C, B, l, b, 8 * (513 - s), nu); ++nu;
        DSA_GRAB_FINISH();
        { PROBE_T0(); LDS_WAIT(); __syncthreads(); PROBE_T1(7); }
    }
#undef DSA_GRAB_ISSUE
#undef DSA_GRAB_FINISH
    __syncthreads();
}

constexpr int VT_PITCH = 4128;
constexpr int SW_BIAS = RING_OFF;
constexpr int SW_WS = SW_BIAS + 8192;
constexpr int SW_STG = SW_WS + 1024;

constexpr int SW_Q = SW_STG, SW_WAVE = 16384, SW_SLOT = 4096;
__device__ __forceinline__ void swa_item(const Ctx& C, const Bufs& B, const float* __restrict__ sinks, int b, int head, int p0, bool meta) {
    const int lane = C.lane, r32 = lane & 31, hh = lane >> 5, g = head >> 3;
    const LAS float* biasl = (const LAS float*)(C.lds + SW_BIAS);
    LAS float* wsf = (LAS float*)(C.lds + SW_WS) + C.wave * 32;
    LAS unsigned char* wl = C.lds + SW_Q + C.wave * SW_WAVE;
    const unsigned wlb = (unsigned)__builtin_amdgcn_readfirstlane((unsigned)(uintptr_t)(C.lds + SW_Q) + (unsigned)C.wave * SW_WAVE);
    const int tq = p0 + r32;
    const int ntile = meta ? 1 : 6;
    PROBE_T0();
    const int prow = lane >> 3, pch = lane & 7, vrow = lane >> 2, vch = lane & 3;
#define SW_DMA_K(kt_, slot_) do { const int k0_ = ((kt_) == 0) ? 0 : p0 - 128 + 32 * ((kt_) - 1); \
        _Pragma("unroll") for (int p = 0; p < 4; ++p) { const int r_ = 8 * p + prow; int kp_ = k0_ + r_; kp_ = kp_ < 0 ? 0 : kp_; \
            glds16o(B.KV, (unsigned)rowof(b, kp_) * 512u + (unsigned)(g * 128 + ((pch ^ ((r_ >> 1) & 7)) << 4)), wlb + 4096u + (unsigned)(slot_) * SW_SLOT + p * 1024); } } while (0)
#define SW_DMA_V(kt_, slot_) do { const int k0_ = ((kt_) == 0) ? 0 : p0 - 128 + 32 * ((kt_) - 1); \
        _Pragma("unroll") for (int p = 0; p < 4; ++p) { const int r_ = 16 * p + vrow; int ks_ = k0_ + 8 * (vch ^ ((r_ >> 2) & 3)); ks_ = ks_ < 0 ? 0 : ks_; \
            glds16o(B.VT, (unsigned)((b * 128 + g * 64 + r_) * VT_PITCH + ks_) * 2u, wlb + 4096u + (unsigned)(slot_) * SW_SLOT + p * 1024); } } while (0)
    {
#pragma unroll
        for (int p = 0; p < 4; ++p) { const int r_ = 8 * p + prow; int tqq = p0 + r_; if (meta) tqq = tqq < NMETA ? tqq : NMETA - 1;
            glds16o(B.PROJ, ((unsigned)rowof(b, tqq) * (unsigned)NP1 + (unsigned)(PC_QA + head * 64)) * 2u + (unsigned)((pch ^ ((r_ >> 1) & 7)) << 4), wlb + p * 1024); }
    }
    SW_DMA_K(0, 0);
    if (!meta) { SW_DMA_K(1, 1); SW_DMA_K(2, 2); }
    const int foff = r32 * 128, fsw = (r32 >> 1) & 7;
    bf16x8 qf[4];
    if (meta) asm volatile("s_waitcnt vmcnt(0)" ::: "memory"); else asm volatile("s_waitcnt vmcnt(8)" ::: "memory");
#pragma unroll
    for (int s = 0; s < 4; ++s) qf[s] = *(const LAS bf16x8*)(wl + foff + (((2 * s + hh) ^ fsw) << 4));
    f32x16 S[6];
#pragma unroll
    for (int kt = 0; kt < 6; ++kt) {
        if (kt < ntile) {
            if (meta || kt >= 4) { if (kt == 4) asm volatile("s_waitcnt vmcnt(4)" ::: "memory"); else asm volatile("s_waitcnt vmcnt(0)" ::: "memory"); }
            else asm volatile("s_waitcnt vmcnt(8)" ::: "memory");
            bf16x8 kf[4];
#pragma unroll
            for (int s = 0; s < 4; ++s) kf[s] = *(const LAS bf16x8*)(wl + 4096 + (kt % 3) * SW_SLOT + foff + (((2 * s + hh) ^ fsw) << 4));
            __builtin_amdgcn_sched_barrier(0);
            f32x16 acc = {};
#pragma unroll
            for (int s = 0; s < 4; ++s) acc = __builtin_amdgcn_mfma_f32_32x32x16_bf16(kf[s], qf[s], acc, 0, 0, 0);
            S[kt] = acc;
            LDS_WAIT(); asm volatile("" ::: "memory");
            if (kt + 3 < ntile) SW_DMA_K(kt + 3, kt % 3);
        } else S[kt] = (f32x16){-INFINITY, -INFINITY, -INFINITY, -INFINITY, -INFINITY, -INFINITY, -INFINITY, -INFINITY, -INFINITY, -INFINITY, -INFINITY, -INFINITY, -INFINITY, -INFINITY, -INFINITY, -INFINITY};
    }
    PROBE_T1(50);
    SW_DMA_V(0, 0);
    if (!meta) { SW_DMA_V(1, 1); SW_DMA_V(2, 2); }
#pragma unroll
    for (int kt = 0; kt < 6; ++kt) {
        if (kt < ntile) {
            const int k0 = (kt == 0) ? 0 : p0 - 128 + 32 * (kt - 1);
            float bz[16];
#pragma unroll
            for (int i = 0; i < 16; ++i) { const int kp = k0 + (i & 3) + 8 * (i >> 2) + 4 * hh; int d = tq - kp; d = d < 0 ? 0 : (d > 127 ? 127 : d); bz[i] = biasl[head * 128 + d]; }
#pragma unroll
            for (int i = 0; i < 16; ++i) { const int kp = k0 + (i & 3) + 8 * (i >> 2) + 4 * hh; const int d = tq - kp;
                const bool ok = (kt == 0) ? (kp < NMETA && d >= 0) : (kp >= NMETA && d >= 0 && d < 128);
                const float x = 0.125f * S[kt][i] + bz[i];
                S[kt][i] = ok ? x : -INFINITY; }
        }
    }
    const float sink = sinks[head];
    float mx = sink;
#pragma unroll
    for (int kt = 0; kt < 6; ++kt)
#pragma unroll
        for (int i = 0; i < 16; ++i) mx = fmaxf(mx, S[kt][i]);
    mx = fmaxf(mx, __shfl_xor(mx, 32));
    float sum = 0.f;
#pragma unroll
    for (int kt = 0; kt < 6; ++kt)
#pragma unroll
        for (int i = 0; i < 16; ++i) { const float p = __expf(S[kt][i] - mx); S[kt][i] = p; sum += p; }
    sum += __shfl_xor(sum, 32);
    sum += __expf(sink - mx);
    if (hh == 0) wsf[r32] = sum;
    PROBE_T1(51);
    f32x16 O0 = {}, O1 = {};
#pragma unroll
    for (int kt = 0; kt < 6; ++kt) {
        if (kt < ntile) {
            if (meta || kt >= 4) { if (kt == 4) asm volatile("s_waitcnt vmcnt(4)" ::: "memory"); else asm volatile("s_waitcnt vmcnt(0)" ::: "memory"); }
            else asm volatile("s_waitcnt vmcnt(8)" ::: "memory");
            pg8::u32x2 vl[2][2], vh[2][2];
#pragma unroll
            for (int s2 = 0; s2 < 2; ++s2)
#pragma unroll
                for (int dt = 0; dt < 2; ++dt) { const int r_ = 32 * dt + r32; const LAS unsigned char* vp = wl + 4096 + (kt % 3) * SW_SLOT + r_ * 64 + 8 * hh; const int sw_ = (r_ >> 2) & 3;
                    vl[s2][dt] = *(const LAS pg8::u32x2*)(vp + (((2 * s2) ^ sw_) << 4)); vh[s2][dt] = *(const LAS pg8::u32x2*)(vp + (((2 * s2 + 1) ^ sw_) << 4)); }
            __builtin_amdgcn_sched_barrier(0);
#pragma unroll
            for (int s2 = 0; s2 < 2; ++s2) {
                pg8::u32x4 pw; pw.x = cvtpk(S[kt][8 * s2 + 0], S[kt][8 * s2 + 1]); pw.y = cvtpk(S[kt][8 * s2 + 2], S[kt][8 * s2 + 3]); pw.z = cvtpk(S[kt][8 * s2 + 4], S[kt][8 * s2 + 5]); pw.w = cvtpk(S[kt][8 * s2 + 6], S[kt][8 * s2 + 7]);
                const bf16x8 pf = __builtin_bit_cast(bf16x8, pw);
#pragma unroll
                for (int dt = 0; dt < 2; ++dt) { const pg8::u32x4 vw = {vl[s2][dt].x, vl[s2][dt].y, vh[s2][dt].x, vh[s2][dt].y}; const bf16x8 vf = __builtin_bit_cast(bf16x8, vw);
                    if (dt == 0) O0 = __builtin_amdgcn_mfma_f32_32x32x16_bf16(pf, vf, O0, 0, 0, 0); else O1 = __builtin_amdgcn_mfma_f32_32x32x16_bf16(pf, vf, O1, 0, 0, 0); }
            }
            LDS_WAIT(); asm volatile("" ::: "memory");
            if (kt + 3 < ntile) SW_DMA_V(kt + 3, kt % 3);
            __builtin_amdgcn_sched_barrier(0);
        }
    }
#undef SW_DMA_K
#undef SW_DMA_V
    PROBE_T1(52);
    LDS_WAIT(); asm volatile("" ::: "memory");
    LAS float* stg = (LAS float*)(wl + 4096);
#pragma unroll
    for (int i = 0; i < 16; ++i) { const int q = (i & 3) + 8 * (i >> 2) + 4 * hh; stg[q * 68 + r32] = O0[i]; stg[q * 68 + 32 + r32] = O1[i]; }
    LDS_WAIT(); asm volatile("" ::: "memory");
    { const int q = lane >> 1, d0 = (lane & 1) * 32, t = p0 + q;
      if (!meta || t < NMETA) { const int row = rowof(b, t); const float inv = 1.0f / wsf[q];
          const bf16* zp = B.PROJ + (size_t)row * NP1 + PC_ZA + head * 64 + d0; bf16* op = B.YA + (size_t)row * YLD + head * 64 + d0;
#pragma unroll
          for (int hf = 0; hf < 4; ++hf) { const v4u zw = *(const v4u*)(zp + 8 * hf);
              const f32x4 xa = *(const LAS f32x4*)(stg + q * 68 + d0 + 8 * hf) * inv, xb = *(const LAS f32x4*)(stg + q * 68 + d0 + 8 * hf + 4) * inv;
              v4u o; o.x = pk2(xa[0] * siluf_(pg8::bf_lo(zw.x)), xa[1] * siluf_(pg8::bf_hi(zw.x))); o.y = pk2(xa[2] * siluf_(pg8::bf_lo(zw.y)), xa[3] * siluf_(pg8::bf_hi(zw.y)));
              o.z = pk2(xb[0] * siluf_(pg8::bf_lo(zw.z)), xb[1] * siluf_(pg8::bf_hi(zw.z))); o.w = pk2(xb[2] * siluf_(pg8::bf_lo(zw.w)), xb[3] * siluf_(pg8::bf_hi(zw.w)));
              *(v4u*)(op + 8 * hf) = o; } } }
    LDS_WAIT(); asm volatile("" ::: "memory");
}

__device__ __forceinline__ void swa_phase(const Ctx& C, int l) {
    const Bufs B(kargs()->ws);
    const KArgs& A = *kargs();
    __syncthreads();
    for (int i = C.tid; i < 128 * 16; i += NWAVES * 64) { const int h = i >> 7, d = i & 127; ((LAS float*)(C.lds + SW_BIAS))[i] = A.bias_table[t5_bucket(d) * 32 + h]; }
    __syncthreads();
    const float* sinks = A.sinks + l * 16;
    gu32* qctr = (gu32*)(A.ws + WS_CTL) + CW_SWAQ + l * 64;
    LAS int* qslot = (LAS int*)(C.lds + SW_WS) + 8 * 32;
    for (;;) {
        if (C.tid == 0) qslot[0] = (int)__hip_atomic_fetch_add(qctr, 8u, __ATOMIC_RELAXED, __HIP_MEMORY_SCOPE_AGENT);
        LDS_WAIT(); __syncthreads();
        const int base = qslot[0];
        __syncthreads();
        if (base >= 4096 + 32) break;
        const int it = base + C.wave;
        if (it < 4096) { const int blk = it & 127, head = (it >> 7) & 15, b = it >> 11; swa_item(C, B, sinks, b, head, NMETA + 32 * blk, false); }
        else if (it < 4096 + 32) { const int r = it - 4096, head = r & 15, b = r >> 4; swa_item(C, B, sinks, b, head, 0, true); }
    }
    __syncthreads();
}


constexpr int PH_PER_LAYER = 5, N_PHASES = 1 + NLAYER * PH_PER_LAYER + 1;
#ifndef MK_DUP
#define MK_DUP 0
#endif
#ifndef MK_NAIVE_SWA
#define MK_NAIVE_SWA 0
#endif
#ifndef MK_NAIVE_DSA
#define MK_NAIVE_DSA 0
#endif
#ifndef MK_ONE_LAUNCH
#define MK_ONE_LAUNCH 1
#endif

__device__ __forceinline__ int lane_id_fresh() { int l; asm volatile("v_mbcnt_lo_u32_b32 %0, -1, 0\n\tv_mbcnt_hi_u32_b32 %0, -1, %0" : "=v"(l)); return l; }
__global__ void __launch_bounds__(NWAVES * 64, 2) fwd_kernel(Args args) {
    extern __shared__ __attribute__((aligned(16))) unsigned char lds[];
    Ctx C;
    C.lds = (LAS unsigned char*)lds; C.tid = threadIdx.x; C.lane = C.tid & 63; C.wave = __builtin_amdgcn_readfirstlane(C.tid >> 6);
    const int wave0 = C.wave;
    C.G = gridDim.x; C.bid = blockIdx.x; C.gw = blockIdx.x * NWAVES + C.wave; C.NGW = C.G * NWAVES;
    unsigned char* ws = args.ws;
    gu32* ctl = (gu32*)(ws + WS_CTL);
    for (int u = C.tid; u < RING_OFF / 4; u += NWAVES * 64) ((LAS unsigned*)(C.lds + LDSCTL_OFF))[u] = 0u;
    __syncthreads();
    volatile LAS unsigned* MISC = (volatile LAS unsigned*)(C.lds + MISC_OFF);
    XcdBarrier bar; bar.bar = (unsigned*)(ctl + CW_BAR); bar.x = 0; bar.st = nullptr;
    const int lo = args.ph_lo, hi = args.ph_hi;
    const bool one = (hi - lo) > 1;
    if (one) bar = xcd_barrier_post((unsigned*)(ctl + CW_BAR), MISC + 8);
#define IN(k) (lo <= (k) && (k) < hi)
#define PHASE_BEGIN() do { int l_ = lane_id_fresh(); int b_ = blockIdx.x; asm volatile("" : "+s"(b_)); \
    int w_ = wave0; asm volatile("" : "+s"(w_)); C.wave = w_; C.lane = l_; C.tid = w_ * 64 + l_; C.bid = b_; C.gw = b_ * NWAVES + w_; } while (0)
#define SEAM(k) do { if (IN((k) + 1)) { PROBE_T0(); XcdBarrier b2_ = bar; b2_.bar = (unsigned*)launder((unsigned char*)bar.bar);     \
    xcd_barrier(b2_, C.wave == 0 && lane_id_fresh() == 0); PROBE_T1(29); PROBE_T1(60 + ((k) == 0 ? 5 : ((k) - 1) % PH_PER_LAYER)); if (MK_DUP & 256) xcd_barrier(b2_, C.wave == 0 && lane_id_fresh() == 0); } } while (0)
    LAS unsigned char* ring = C.lds + RING_OFF;

    if (IN(0)) { PROBE_T0(); PHASE_BEGIN(); p0_prologue(C); PROBE_T1(20); if (MK_DUP & 128) { PHASE_BEGIN(); p0_prologue(C); } SEAM(0); }
    for (int l = 0; l < NLAYER; ++l) {
        const int p = 1 + l * PH_PER_LAYER;
        if (IN(p)) {
            PHASE_BEGIN(); const Bufs B(kargs()->ws);
            const bf16* W1l = B.W1 + (size_t)l * NP1 * DM;
            pg8::Gemm g{B.HB, W1l, MR, 8192, DM}; pg8::StaticOrder S; S.init(MR, 8192, C.G, C.bid);
            rstd_table<8>(C, S, B.RS, 1.0f / DM);
            pg8::EpiProjT<true> E{B.PROJ, NP1, (const LAS float*)(C.lds + RSTD_OFF), B.KV, B.RSQ, B.RHO, B.SGB};
            { PROBE_T0(); pg8::gemm_phase<pg8::EpiProjT<true>, pg8::StaticOrder, true, true>(ring, g, S, E, C.tid); PROBE_T1(21); }
            PHASE_BEGIN();
            LAS float* tbl = (LAS float*)(C.lds + RSTD_OFF);
            PROBE_T0();
            for (int u = C.bid; u < 256 + 259; u += C.G) {
                if (u < 256) { const int row0 = 32 * u; skinny_rstd(C, B.RS + (size_t)row0 * 32, 32, 1.0f / DM, tbl);
                    skinny_unit<3, 1>(C, B.HB + (size_t)row0 * DM, DM, W1l + (size_t)8192 * DM, DM, DM, nullptr, 0, 0, SkProj{B.PROJ + (size_t)row0 * NP1, B.KV + (size_t)row0 * 256, B.KIDX, 8192, tbl, row0}); }
                else { const int gc = u - 256; skinny_rstd(C, B.RS2, 64, 1.0f / DM, tbl);
                    const SkProj E2{B.PROJ + (size_t)MR * NP1, B.KV + (size_t)MR * 256, B.KIDX, gc * 32, tbl, MR};
                    const bool sqc = gc >= 72 && gc < 88;
                    skinny_unit<1, 4>(C, B.HB + (size_t)MR * DM, DM, W1l + (size_t)gc * 32 * DM, DM, DM, sqc ? B.RSQ2 : nullptr, 16, gc - 72, E2); }
            }
            PROBE_T1(22);
            SEAM(p);
        }
        if (IN(p + 1)) {
            PHASE_BEGIN(); const Bufs B(kargs()->ws);
            const bf16* W2l = B.W2 + (size_t)l * NQ2 * 512;
            pg8::Gemm g{B.PROJ + PC_CQ, W2l, MR, NQ2, 512, nullptr, nullptr, NP1}; pg8::StaticOrder S; S.init(MR, NQ2, C.G, C.bid);
            rstd_table<2>(C, S, B.RSQ, 1.0f / 512.0f);
            pg8::EpiProjT<false> E{B.Q2, NQ2, (const LAS float*)(C.lds + RSTD_OFF), nullptr, nullptr, nullptr, nullptr};
            PROBE_T0();
            pg8::gemm_phase<pg8::EpiProjT<false>, pg8::StaticOrder, true, true>(ring, g, S, E, C.tid);
            PHASE_BEGIN();
            { LAS float* tbl = (LAS float*)(C.lds + RSTD_OFF);
              const int sb = (C.G == 256) ? C.bid - 64 : C.bid;
              for (int u = sb; u >= 0 && u < 48; u += C.G) { skinny_rstd(C, B.RSQ2, 16, 1.0f / 512.0f, tbl);
                skinny_unit<3, 1>(C, B.PROJ + (size_t)MR * NP1 + PC_CQ, NP1, W2l + (size_t)u * 96 * 512, 512, 512, nullptr, 0, 0, SkQ2{B.Q2 + (size_t)MR * NQ2 + u * 96, tbl}); } }
            PHASE_BEGIN(); norm_tail(C, l);
            PROBE_T1(24);
            SEAM(p + 1);
        }
        if (IN(p + 2)) {
            { PROBE_T0(); PHASE_BEGIN(); dsa_phase(C, l); PROBE_T1(4); }
            if (MK_DUP & 16) { PHASE_BEGIN(); dsa_phase(C, l); }
            { PROBE_T0(); PHASE_BEGIN(); swa_phase(C, l); PROBE_T1(5); }
            SEAM(p + 2);
        }
        if (IN(p + 3)) {
            PHASE_BEGIN(); const Bufs B(kargs()->ws);
            const bf16* WABl = B.WA + (size_t)l * DM * 2048;
            pg8::Gemm g{B.YA, WABl, MR, DM, 2048, nullptr, nullptr, 0}; pg8::StaticOrder S; S.init(MR, DM, C.G, C.bid);
            pg8::EpiG4m E{B.MG, B.RHO, B.SGB};
            PROBE_T0();
            pg8::gemm_phase<pg8::EpiG4m, pg8::StaticOrder, true, true>(ring, g, S, E, C.tid);
            PROBE_T1(35);
            PHASE_BEGIN();
            for (int u = C.bid; u < 64; u += C.G) {
                skinny_unit<1, 2>(C, B.YA + (size_t)MR * YLD, YLD, WABl + (size_t)u * 32 * 2048, 2048, 1024, nullptr, 0, 0, SkPA{B.PA + (size_t)MR * DM + u * 32, B.PROJ + (size_t)MR * NP1 + 4096, u * 32});
                skinny_unit<1, 2>(C, B.YB + (size_t)MR * YLD, YLD, WABl + 1024 + (size_t)u * 32 * 2048, 2048, 1024, nullptr, 0, 0, SkMerge{B.MG + (size_t)MR * DM + u * 32, B.PA + (size_t)MR * DM + u * 32, B.PROJ + (size_t)MR * NP1 + 4096, u * 32}); }
            PROBE_T1(25);
            SEAM(p + 3);
        }
        if (MK_PROBE >= 0 && l == NLAYER - 1 && C.bid == MK_PROBE_BLOCK && C.wave == 0 && C.lane == 0) __hip_atomic_store((gu32*)(kargs()->ws + WS_CTL) + 3, ((volatile LAS unsigned*)(C.lds + MISC_OFF + 64))[0], RLX_AGENT);
        if (IN(p + 4)) {
            PHASE_BEGIN(); const Bufs B(kargs()->ws);
            const bf16* WOl = B.WO + (size_t)l * DM * DM;
            pg8::Gemm g{B.MG, WOl, MR, DM, DM}; pg8::StaticOrder S; S.init(MR, DM, C.G, C.bid);
            pg8::EpiRes E{B.HB, B.RS};
            PROBE_T0();
            pg8::gemm_phase<pg8::EpiRes, pg8::StaticOrder, true, true>(ring, g, S, E, C.tid);
            PROBE_T1(37);
            PHASE_BEGIN();
            for (int u = C.bid; u < 64; u += C.G) skinny_unit<1, 4>(C, B.MG + (size_t)MR * DM, DM, WOl + (size_t)u * 32 * DM, DM, DM, B.RS2, 64, u, SkRes{B.HB + (size_t)MR * DM + u * 32});
            PROBE_T1(27);
            SEAM(p + 4);
        }
    }
    if (IN(N_PHASES - 1)) { PHASE_BEGIN(); final_phase(C); }
#undef IN
#undef SEAM
}

extern "C" void kernel_launch(void* const* d_in, const int* in_sizes, int n_in, void* d_out, int out_size, void* d_ws, size_t ws_size, hipStream_t stream) {
    static int grid = 0;
    if (grid == 0) {
        if (n_in != 16 || ws_size < WS_END) { fprintf(stderr, "kernel_launch: unexpected inputs (n_in %d, ws %zu, need %zu)\n", n_in, ws_size, (size_t)WS_END); grid = -1; return; }
        int dev = 0, cus = 0;
        if (hipGetDevice(&dev) != hipSuccess || hipDeviceGetAttribute(&cus, hipDeviceAttributeMultiprocessorCount, dev) != hipSuccess) { grid = -1; return; }
        if (hipFuncSetAttribute((const void*)fwd_kernel, hipFuncAttributeMaxDynamicSharedMemorySize, LDS_BYTES) != hipSuccess) { fprintf(stderr, "kernel_launch: hipFuncSetAttribute failed\n"); grid = -1; return; }
        int per_cu = 0;
        if (hipOccupancyMaxActiveBlocksPerMultiprocessor(&per_cu, (const void*)fwd_kernel, NWAVES * 64, LDS_BYTES) != hipSuccess || per_cu < 1) fprintf(stderr, "kernel_launch: occupancy query says %d\n", per_cu);
        (void)hipGetLastError();
        grid = cus;
    }
    if (grid < 0) return;
    if (hipMemsetAsync((char*)d_ws + WS_CTL, 0, CTL_ZERO_BYTES, stream) != hipSuccess) return;
    Args a{};
    a.x = (const float*)d_in[0]; a.meta = (const float*)d_in[1]; a.bias_table = (const float*)d_in[2]; a.norm_g = (const float*)d_in[3]; a.w_in = (const float*)d_in[4];
    a.q_norm_g = (const float*)d_in[5]; a.kv_norm_g = (const float*)d_in[6]; a.w_qb = (const float*)d_in[7]; a.w_iq = (const float*)d_in[8]; a.w_uk = (const float*)d_in[9];
    a.w_uv = (const float*)d_in[10]; a.sinks = (const float*)d_in[11]; a.w_proj_a = (const float*)d_in[12]; a.w_proj_b = (const float*)d_in[13]; a.w_out = (const float*)d_in[14];
    a.final_g = (const float*)d_in[15]; a.out = (float*)d_out; a.ws = (unsigned char*)d_ws;
#if MK_ONE_LAUNCH
    a.ph_lo = 0; a.ph_hi = N_PHASES;
    hipLaunchKernelGGL(fwd_kernel, dim3(grid), dim3(NWAVES * 64), LDS_BYTES, stream, a);
#else
    for (int p = 0; p < N_PHASES; ++p) { a.ph_lo = p; a.ph_hi = p + 1; hipLaunchKernelGGL(fwd_kernel, dim3(grid), dim3(NWAVES * 64), LDS_BYTES, stream, a); }
#endif
}
```

```cpp
#include <hip/hip_runtime.h>
#include <cstdio>
#include <cstdint>
namespace pg8 {
#define PG8_LAS __attribute__((address_space(3)))
typedef unsigned short bf16_t;
typedef short bf16x8 __attribute__((ext_vector_type(8)));
typedef float f32x4 __attribute__((ext_vector_type(4)));
typedef unsigned u32x4 __attribute__((ext_vector_type(4)));
constexpr int BM = 256, BK = 64, HALF = 128, HTB = HALF * BK * 2  , STAGE_BYTES = 8 * HTB, NXCD = 8, WGM = 8;

__host__ __device__ __forceinline__ int lds_byte(int r, int c) { const int st = (r >> 4) * 2 + (c >> 5), rr = r & 15, cc = c & 31, ob = rr * 64 + cc * 2; return st * 1024 + (ob ^ (((ob >> 9) & 1) << 5)); }
__host__ __device__ __forceinline__ void stage_rc(int b, int& R, int& C) { const int st = b / 1024, sb = b % 1024, swz = sb ^ (((sb >> 9) & 1) << 5); R = (st >> 1) * 16 + swz / 64; C = (st & 1) * 32 + (swz % 64) / 2; }
__host__ __device__ __forceinline__ int perm32(int rho) { const int n = rho >> 4, i = rho & 15; return 8 * (i >> 2) + 4 * n + (i & 3); }

struct Unit { int pm, pn, sel; };
struct Gemm { const bf16_t* A; const bf16_t* Bt; int M, N, K; const bf16_t* A2; const bf16_t* Bt2; int lda; };

struct StaticOrder {
    int nM, nN, nwg, G, c;
    __host__ __device__ void init(int M, int N, int G_, int c_) { nM = M / BM; nN = N / BM; nwg = nM * nN; G = G_; c = c_; }
    __host__ __device__ bool next(int i, Unit& u) const {
        const long L = (long)i * G + c; if (L >= nwg) return false;
        int wgid = (int)L; { const int q = nwg / NXCD, r = nwg % NXCD, xcd = wgid % NXCD, off = wgid / NXCD; wgid = (xcd < r ? xcd * (q + 1) : r * (q + 1) + (xcd - r) * q) + off; }
        const int nig = WGM * nN, gid = wgid / nig, fm = gid * WGM, gsz = (nM - fm) < WGM ? (nM - fm) : WGM;
        u.pm = fm + ((wgid % nig) % gsz); u.pn = (wgid % nig) / gsz; u.sel = 0; return true;
    }
    __device__ __forceinline__ void a_ready(const Unit&) const {}
    __device__ __forceinline__ void done(const Unit&) const {}
};

__device__ __forceinline__ unsigned cvt_pk_bf16(float lo, float hi) { unsigned r; asm volatile("v_cvt_pk_bf16_f32 %0, %1, %2" : "=v"(r) : "v"(lo), "v"(hi)); return r; }
typedef float f32x2 __attribute__((ext_vector_type(2)));
__device__ __forceinline__ f32x2 gelu_pk(f32x2 v) {
    const f32x2 av = __builtin_elementwise_abs(v), d = av * 0.2316418882f + 1.0f;
    f32x2 t; t.x = __builtin_amdgcn_rcpf(d.x); t.y = __builtin_amdgcn_rcpf(d.y);
    f32x2 q = t * 0.5307027145f + (-0.7265760135f); q = q * t + 0.7107068705f; q = q * t + (-0.142248368f); q = q * t + 0.127414796f; q = q * t;
    const f32x2 s = (v * v) * (-0.72134752044f);
    f32x2 e; e.x = __builtin_amdgcn_exp2f(s.x); e.y = __builtin_amdgcn_exp2f(s.y);
    const f32x2 m = v * (q * e), r = v - m;
    f32x2 o; o.x = v.x < 0.f ? m.x : r.x; o.y = v.y < 0.f ? m.y : r.y; return o;
}

template <int ACT  > struct EpiBf16 {
    static constexpr bool PERM = true, AFTER_DRAIN = false; static_assert(ACT == 0 || ACT == 1, "EpiBf16: ACT is 0 (none) or 1 (gelu_pk)");
    bf16_t* O; int ldc; const float* bias; int split_cols; size_t split_stride; float scale0;
    __device__ __forceinline__ void operator()(const f32x4 (&acc)[2][2][4][2], const Unit& u, int ui, int wr, int wc, int fr, int fq) const {
        const int row0 = u.pm * BM + wr * 64 + fr; int colt = u.pn * BM; bf16_t* base = O;
        float sc = 1.f; if (split_cols) { const int t = colt / split_cols; base += (size_t)t * split_stride; colt -= t * split_cols; if (t == 0) sc = scale0; }
        const int col0 = colt + wc * 32 + 8 * fq, bcol0 = u.pn * BM + wc * 32 + 8 * fq;
        f32x4 bv[2][2];
#pragma unroll
        for (int bj = 0; bj < 2; ++bj)
#pragma unroll
            for (int n = 0; n < 2; ++n) bv[bj][n] = bias ? *(const f32x4*)(bias + bcol0 + bj * HALF + 4 * n) : (f32x4){0.f, 0.f, 0.f, 0.f};
#pragma unroll
        for (int ai = 0; ai < 2; ++ai)
#pragma unroll
            for (int m = 0; m < 4; ++m) { bf16_t* rowp = base + (size_t)(row0 + ai * HALF + m * 16) * ldc + col0;
#pragma unroll
                for (int bj = 0; bj < 2; ++bj) { f32x4 v0 = acc[ai][bj][m][0] + bv[bj][0], v1 = acc[ai][bj][m][1] + bv[bj][1];
                    if (ACT == 1) { f32x2 a = gelu_pk((f32x2){v0[0], v0[1]}), b = gelu_pk((f32x2){v0[2], v0[3]}), c = gelu_pk((f32x2){v1[0], v1[1]}), d = gelu_pk((f32x2){v1[2], v1[3]});
                        v0 = (f32x4){a.x, a.y, b.x, b.y}; v1 = (f32x4){c.x, c.y, d.x, d.y}; }
                    v0 = v0 * sc; v1 = v1 * sc; u32x4 w; w.x = cvt_pk_bf16(v0[0], v0[1]); w.y = cvt_pk_bf16(v0[2], v0[3]); w.z = cvt_pk_bf16(v1[0], v1[1]); w.w = cvt_pk_bf16(v1[2], v1[3]);
                    *(u32x4*)(rowp + bj * HALF) = w; } }
    }
};

template <class T, class = void> struct pg8_has_midk { static constexpr bool value = false; };
template <class T> struct pg8_has_midk<T, decltype((void)T::MIDK)> { static constexpr bool value = T::MIDK; };
template <class Epi, class Sched, bool ALIGN_EPI = false, bool SP2 = false>
__device__ __forceinline__ void gemm_phase(PG8_LAS unsigned char* lds, const Gemm g, const Sched& S, const Epi& E, int tid_in) {
    int tid_ = tid_in; asm volatile("" : "+v"(tid_));
    const int tid = tid_, wid = __builtin_amdgcn_readfirstlane(tid >> 6), lane = tid & 63, wr = wid >> 2, wc = wid & 3, fr = lane & 15, fq = lane >> 4;
    const int K = g.K, nt = K / BK, lda = g.lda ? g.lda : K;
    unsigned voffA[2], voffB[2];
#pragma unroll
    for (int i = 0; i < 2; ++i) { int R, C; stage_rc(tid * 16 + i * 8192, R, C); const int Rb = Epi::PERM ? ((R & ~31) + perm32(R & 31)) : R;
        voffA[i] = (unsigned)(R * lda + C) * 2u; voffB[i] = (unsigned)(Rb * K + C) * 2u; }
    const size_t kstep = (size_t)(BK * 2);
    const size_t hstepA = (size_t)HALF * lda * 2, tstepA = 2 * hstepA;
    const size_t hstep = (size_t)HALF * K * 2;
    const size_t tstep = 2 * hstep;
    const unsigned ldsw = (unsigned)wid * 1024u;
    const int aoff = lds_byte(wr * 64 + fr, fq * 8), boff = lds_byte(wc * 32 + fr, fq * 8);
#define PG8_SA(b, h) (((b) * 2 + (h)) * HTB)
#define PG8_SB(b, h) ((4 + (b) * 2 + (h)) * HTB)
#define PG8_STAGE(bufoff, gbase, voff) do { _Pragma("unroll") for (int _i = 0; _i < 2; ++_i) \
        __builtin_amdgcn_global_load_lds((const unsigned*)((const char*)(gbase) + (voff)[_i]), (PG8_LAS unsigned*)(lds + (bufoff) + ldsw + _i * 8192), 16, 0, 0); } while (0)
#define PG8_LDA(dst, b, h) do { _Pragma("unroll") for (int m = 0; m < 4; ++m) _Pragma("unroll") for (int k = 0; k < 2; ++k) dst[m][k] = *(const PG8_LAS bf16x8*)(lds + PG8_SA(b, h) + aoff + m * 2048 + k * 1024); } while (0)
#define PG8_LDB(dst, b, h) do { _Pragma("unroll") for (int n = 0; n < 2; ++n) _Pragma("unroll") for (int k = 0; k < 2; ++k) dst[n][k] = *(const PG8_LAS bf16x8*)(lds + PG8_SB(b, h) + boff + n * 2048 + k * 1024); } while (0)
#define PG8_MMA(ai, bj, At, Bt) do { __builtin_amdgcn_s_setprio(1); _Pragma("unroll") for (int m = 0; m < 4; ++m) _Pragma("unroll") for (int n = 0; n < 2; ++n) _Pragma("unroll") for (int k = 0; k < 2; ++k) \
        acc[ai][bj][m][n] = __builtin_amdgcn_mfma_f32_16x16x32_bf16(Bt[n][k], At[m][k], acc[ai][bj][m][n], 0, 0, 0); __builtin_amdgcn_s_setprio(0); } while (0)
#define PG8_WAIT_V(n) asm volatile("s_waitcnt vmcnt(" #n ")" ::: "memory")
#define PG8_WAIT_L(n) asm volatile("s_waitcnt lgkmcnt(" #n ")" ::: "memory")
#define PG8_BAR __builtin_amdgcn_s_barrier()
#define PG8_SCHED __builtin_amdgcn_sched_barrier(0)
    Unit cur, nxt; int ui = 0;
    if (!S.next(0, cur)) return;
    f32x4 acc[2][2][4][2];
#pragma unroll
    for (int a = 0; a < 2; ++a)
#pragma unroll
        for (int b = 0; b < 2; ++b)
#pragma unroll
            for (int m = 0; m < 4; ++m)
#pragma unroll
                for (int n = 0; n < 2; ++n) acc[a][b][m][n] = (f32x4){0.f, 0.f, 0.f, 0.f};
    bf16x8 At[4][2], B0[2][2], B1[2][2];
    const char* cA = (const char*)(cur.sel ? g.A2 : g.A) + (size_t)cur.pm * tstepA; const char* cB = (const char*)(cur.sel ? g.Bt2 : g.Bt) + (size_t)cur.pn * tstep;
    S.a_ready(cur);
    if constexpr (SP2) {
        PG8_STAGE(PG8_SB(0, 0), cB, voffB); PG8_STAGE(PG8_SB(0, 1), cB + hstep, voffB); PG8_STAGE(PG8_SA(0, 0), cA, voffA); PG8_STAGE(PG8_SA(0, 1), cA + hstepA, voffA);
        if (wr == 1) PG8_BAR;
        PG8_WAIT_V(2); PG8_BAR;
        PG8_STAGE(PG8_SB(1, 0), cB + kstep, voffB); PG8_STAGE(PG8_SA(1, 0), cA + kstep, voffA); PG8_STAGE(PG8_SB(1, 1), cB + hstep + kstep, voffB);
        PG8_WAIT_V(6); PG8_BAR;
    } else {
        PG8_STAGE(PG8_SB(0, 0), cB, voffB); PG8_STAGE(PG8_SA(0, 0), cA, voffA); PG8_STAGE(PG8_SB(0, 1), cB + hstep, voffB); PG8_STAGE(PG8_SA(0, 1), cA + hstepA, voffA);
        if (wr == 1) PG8_BAR;
        PG8_WAIT_V(4); PG8_BAR;
        PG8_STAGE(PG8_SB(1, 0), cB + kstep, voffB); PG8_STAGE(PG8_SA(1, 0), cA + kstep, voffA); PG8_STAGE(PG8_SB(1, 1), cB + hstep + kstep, voffB);
        PG8_WAIT_V(6); PG8_BAR;
    }
    for (;;) {
        const bool has_next = S.next(ui + 1, nxt);
        const char* nA = has_next ? (const char*)(nxt.sel ? g.A2 : g.A) + (size_t)nxt.pm * tstepA : cA; const char* nB = has_next ? (const char*)(nxt.sel ? g.Bt2 : g.Bt) + (size_t)nxt.pn * tstep : cB;
        for (int t = 0; t < nt; t += 2) {
            if constexpr (pg8_has_midk<Epi>::value) { if (t == (nt >> 1)) E.midk(acc, cur, wr, wc, fr, fq); }
            const bool last = (t == nt - 2);
            const char* a1 = cA + (size_t)(t + 1) * kstep;
            const char* a2 = last ? nA : cA + (size_t)(t + 2) * kstep; const char* b2 = last ? nB : cB + (size_t)(t + 2) * kstep;
            const char* a3 = a2 + kstep; const char* b3 = b2 + kstep;
            if (last && has_next) S.a_ready(nxt);
            if constexpr (SP2) {
            PG8_LDB(B0, 0, 0); PG8_LDB(B1, 0, 1); PG8_SCHED; PG8_LDA(At, 0, 0); PG8_STAGE(PG8_SA(1, 1), a1 + hstepA, voffA);
            PG8_WAIT_V(8); PG8_WAIT_L(0); PG8_BAR; PG8_MMA(0, 0, At, B0); PG8_MMA(0, 1, At, B1); PG8_BAR; PG8_SCHED;
            PG8_LDA(At, 0, 1); PG8_STAGE(PG8_SB(0, 0), b2, voffB); PG8_STAGE(PG8_SB(0, 1), b2 + hstep, voffB); PG8_STAGE(PG8_SA(0, 0), a2, voffA);
            PG8_WAIT_V(8); PG8_WAIT_L(0); PG8_BAR; PG8_MMA(1, 0, At, B0); PG8_MMA(1, 1, At, B1); PG8_BAR; PG8_SCHED;
            PG8_LDB(B0, 1, 0); PG8_LDB(B1, 1, 1); PG8_SCHED; PG8_LDA(At, 1, 0); PG8_STAGE(PG8_SA(0, 1), a2 + hstepA, voffA);
            PG8_WAIT_V(8); PG8_WAIT_L(0); PG8_BAR; PG8_MMA(0, 0, At, B0); PG8_MMA(0, 1, At, B1); PG8_BAR; PG8_SCHED;
            PG8_LDA(At, 1, 1); PG8_STAGE(PG8_SB(1, 0), b3, voffB); PG8_STAGE(PG8_SB(1, 1), b3 + hstep, voffB); PG8_STAGE(PG8_SA(1, 0), a3, voffA);
            PG8_WAIT_V(8); PG8_WAIT_L(0); PG8_BAR; PG8_MMA(1, 0, At, B0); PG8_MMA(1, 1, At, B1); PG8_BAR; PG8_SCHED;
            } else {
            PG8_LDB(B0, 0, 0); PG8_SCHED; PG8_LDA(At, 0, 0); PG8_STAGE(PG8_SA(1, 1), a1 + hstepA, voffA);
            PG8_WAIT_L(8); PG8_BAR; PG8_WAIT_L(0); PG8_MMA(0, 0, At, B0); PG8_BAR; PG8_SCHED;
            PG8_LDB(B1, 0, 1); PG8_STAGE(PG8_SB(0, 0), b2, voffB);
            PG8_BAR; PG8_WAIT_L(0); PG8_MMA(0, 1, At, B1); PG8_BAR;
            PG8_LDA(At, 0, 1); PG8_STAGE(PG8_SA(0, 0), a2, voffA);
            PG8_BAR; PG8_WAIT_L(0); PG8_MMA(1, 0, At, B0); PG8_BAR; PG8_SCHED;
            PG8_STAGE(PG8_SB(0, 1), b2 + hstep, voffB);
            PG8_WAIT_V(6); PG8_BAR; PG8_MMA(1, 1, At, B1); PG8_BAR;
            PG8_LDB(B0, 1, 0); PG8_SCHED; PG8_LDA(At, 1, 0); PG8_STAGE(PG8_SA(0, 1), a2 + hstepA, voffA);
            PG8_WAIT_L(8); PG8_BAR; PG8_WAIT_L(0); PG8_MMA(0, 0, At, B0); PG8_BAR; PG8_SCHED;
            PG8_LDB(B1, 1, 1); PG8_STAGE(PG8_SB(1, 0), b3, voffB);
            PG8_BAR; PG8_WAIT_L(0); PG8_MMA(0, 1, At, B1); PG8_BAR;
            PG8_LDA(At, 1, 1); PG8_STAGE(PG8_SA(1, 0), a3, voffA);
            PG8_BAR; PG8_WAIT_L(0); PG8_MMA(1, 0, At, B0); PG8_BAR; PG8_SCHED;
            PG8_STAGE(PG8_SB(1, 1), b3 + hstep, voffB);
            PG8_WAIT_V(6); PG8_BAR; PG8_MMA(1, 1, At, B1); PG8_BAR;
            }
        }
        if constexpr (ALIGN_EPI) { if (wr == 0) PG8_BAR; }
        if constexpr (!Epi::AFTER_DRAIN) { E(acc, cur, ui, wr, wc, fr, fq); S.done(cur); }
        if (!has_next) break;
#pragma unroll
        for (int a = 0; a < 2; ++a)
#pragma unroll
            for (int b = 0; b < 2; ++b)
#pragma unroll
                for (int m = 0; m < 4; ++m)
#pragma unroll
                    for (int n = 0; n < 2; ++n) acc[a][b][m][n] = (f32x4){0.f, 0.f, 0.f, 0.f};
        cur = nxt; cA = nA; cB = nB; ++ui;
        if constexpr (ALIGN_EPI) { if (wr == 1) PG8_BAR; }
    }
    PG8_WAIT_V(0);
    if constexpr (!ALIGN_EPI) { if (wr == 0) PG8_BAR; }
    PG8_BAR;
    if constexpr (Epi::AFTER_DRAIN) { E.fused(acc, cur, wr, wc, fr, fq, lds, wid, lane); S.done(cur); }
#undef PG8_SA
#undef PG8_SB
#undef PG8_STAGE
#undef PG8_LDA
#undef PG8_LDB
#undef PG8_MMA
#undef PG8_WAIT_V
#undef PG8_WAIT_L
#undef PG8_BAR
#undef PG8_SCHED
}
}
namespace pg8 {
__device__ __forceinline__ float bf_lo(unsigned w) { return __uint_as_float(w << 16); }
__device__ __forceinline__ float bf_hi(unsigned w) { return __uint_as_float(w & 0xffff0000u); }
__device__ __forceinline__ float sigm(float x) { return 1.0f / (1.0f + __expf(-x)); }
typedef unsigned u32x2 __attribute__((ext_vector_type(2)));

template <bool G1>
struct EpiProjT {
    static constexpr bool PERM = true, AFTER_DRAIN = false;
    bf16_t* O; int ldc; const PG8_LAS float* rstd; bf16_t* KV; float* RSQ; bf16_t* RHO; bf16_t* SGB; bf16_t* VT;
    static constexpr int kvtile = 4, sqtile = 9, gtile = 16;
    __device__ __forceinline__ void operator()(const f32x4 (&acc)[2][2][4][2], const Unit& u, int ui, int wr, int wc, int fr, int fq) const {
        const int rt0 = wr * 64 + fr, col0 = u.pn * BM + wc * 32 + 8 * fq;
        const bool sq = G1 && (u.pn == sqtile || u.pn == sqtile + 1);
#pragma unroll
        for (int ai = 0; ai < 2; ++ai)
#pragma unroll
            for (int m = 0; m < 4; ++m) { const int rt = rt0 + ai * HALF + m * 16; const float s = rstd[ui * 256 + rt];
                bf16_t* rowp = O + (size_t)(u.pm * BM + rt) * ldc + col0;
                if constexpr (G1) { if (u.pn == kvtile) rowp = KV + (size_t)(u.pm * BM + rt) * 256 + wc * 32 + 8 * fq; }
                float ss = 0.f;
                if constexpr (G1) { if (u.pn >= gtile) {
                    const f32x4 a0 = acc[ai][0][m][0] * s, a1 = acc[ai][0][m][1] * s, b0 = acc[ai][1][m][0] * s, b1 = acc[ai][1][m][1] * s;
                    float ea[8], eb[8], rh[8], sb[8];
#pragma unroll
                    for (int j = 0; j < 4; ++j) { ea[j] = 1.0f + __expf(-a0[j]); ea[4 + j] = 1.0f + __expf(-a1[j]); eb[j] = 1.0f + __expf(-b0[j]); eb[4 + j] = 1.0f + __expf(-b1[j]); }
#pragma unroll
                    for (int j = 0; j < 8; ++j) { const float ia = __builtin_amdgcn_rcpf(ea[j]); rh[j] = eb[j] * ia; sb[j] = __builtin_amdgcn_rcpf(eb[j]); }
                    const size_t go = (size_t)(u.pm * BM + rt) * 2048 + (u.pn - gtile) * 128 + wc * 32 + 8 * fq;
                    u32x4 wr_, ws_; wr_.x = cvt_pk_bf16(rh[0], rh[1]); wr_.y = cvt_pk_bf16(rh[2], rh[3]); wr_.z = cvt_pk_bf16(rh[4], rh[5]); wr_.w = cvt_pk_bf16(rh[6], rh[7]);
                    ws_.x = cvt_pk_bf16(sb[0], sb[1]); ws_.y = cvt_pk_bf16(sb[2], sb[3]); ws_.z = cvt_pk_bf16(sb[4], sb[5]); ws_.w = cvt_pk_bf16(sb[6], sb[7]);
                    *(u32x4*)(RHO + go) = wr_; *(u32x4*)(SGB + go) = ws_;
                    continue; } }
#pragma unroll
                for (int bj = 0; bj < 2; ++bj) { const f32x4 v0 = acc[ai][bj][m][0] * s, v1 = acc[ai][bj][m][1] * s;
                    ss += (v0[0] * v0[0] + v0[1] * v0[1]) + (v0[2] * v0[2] + v0[3] * v0[3]) + (v1[0] * v1[0] + v1[1] * v1[1]) + (v1[2] * v1[2] + v1[3] * v1[3]);
                    u32x4 w; w.x = cvt_pk_bf16(v0[0], v0[1]); w.y = cvt_pk_bf16(v0[2], v0[3]); w.z = cvt_pk_bf16(v1[0], v1[1]); w.w = cvt_pk_bf16(v1[2], v1[3]);
                    *(u32x4*)(rowp + bj * HALF) = w;
                    if constexpr (G1) { if (bj == 1 && u.pn == kvtile) {
                        const int row = u.pm * BM + rt; bf16_t* vt = VT + ((size_t)(row >> 12) * 128 + wc * 32 + 8 * fq) * 4128 + (row & 4095) + 16;
                        vt[0 * 4128] = (bf16_t)(w.x & 0xffffu); vt[1 * 4128] = (bf16_t)(w.x >> 16); vt[2 * 4128] = (bf16_t)(w.y & 0xffffu); vt[3 * 4128] = (bf16_t)(w.y >> 16);
                        vt[4 * 4128] = (bf16_t)(w.z & 0xffffu); vt[5 * 4128] = (bf16_t)(w.z >> 16); vt[6 * 4128] = (bf16_t)(w.w & 0xffffu); vt[7 * 4128] = (bf16_t)(w.w >> 16); } } }
                if constexpr (G1) if (sq) { ss += __shfl_xor(ss, 16); ss += __shfl_xor(ss, 32); if (fq == 0) RSQ[(size_t)(u.pm * BM + rt) * 8 + (u.pn - sqtile) * 4 + wc] = ss; } }
    }
};
struct EpiPA {
    static constexpr bool PERM = false, AFTER_DRAIN = false;
    float* P; const bf16_t* G; int ldg;
    __device__ __forceinline__ void operator()(const f32x4 (&acc)[2][2][4][2], const Unit& u, int ui, int wr, int wc, int fr, int fq) const {
        const int col0 = u.pn * BM + wc * 32 + 4 * fq;
#pragma unroll
        for (int ai = 0; ai < 2; ++ai)
#pragma unroll
            for (int m = 0; m < 4; ++m) { const int row = u.pm * BM + ai * HALF + wr * 64 + m * 16 + fr;
#pragma unroll
                for (int bj = 0; bj < 2; ++bj)
#pragma unroll
                    for (int n = 0; n < 2; ++n) { const int c = col0 + bj * HALF + n * 16; const u32x2 g = *(const u32x2*)(G + (size_t)row * ldg + c);
                        f32x4 v = acc[ai][bj][m][n]; v[0] *= sigm(bf_lo(g.x)); v[1] *= sigm(bf_hi(g.x)); v[2] *= sigm(bf_lo(g.y)); v[3] *= sigm(bf_hi(g.y));
                        *(f32x4*)(P + (size_t)row * 2048 + c) = v; } }
    }
};
struct EpiMerge {
    static constexpr bool PERM = true, AFTER_DRAIN = false;
    bf16_t* O; const float* P; const bf16_t* G; int ldg;
    __device__ __forceinline__ void operator()(const f32x4 (&acc)[2][2][4][2], const Unit& u, int ui, int wr, int wc, int fr, int fq) const {
        const int col0 = u.pn * BM + wc * 32 + 8 * fq;
#pragma unroll
        for (int ai = 0; ai < 2; ++ai)
#pragma unroll
            for (int m = 0; m < 4; ++m) { const int row = u.pm * BM + ai * HALF + wr * 64 + m * 16 + fr;
#pragma unroll
                for (int bj = 0; bj < 2; ++bj) { const int c = col0 + bj * HALF; const u32x4 g = *(const u32x4*)(G + (size_t)row * ldg + c);
                    const f32x4 p0 = *(const f32x4*)(P + (size_t)row * 2048 + c), p1 = *(const f32x4*)(P + (size_t)row * 2048 + c + 4);
                    f32x4 v0 = acc[ai][bj][m][0], v1 = acc[ai][bj][m][1];
                    v0[0] = p0[0] + sigm(bf_lo(g.x)) * v0[0]; v0[1] = p0[1] + sigm(bf_hi(g.x)) * v0[1]; v0[2] = p0[2] + sigm(bf_lo(g.y)) * v0[2]; v0[3] = p0[3] + sigm(bf_hi(g.y)) * v0[3];
                    v1[0] = p1[0] + sigm(bf_lo(g.z)) * v1[0]; v1[1] = p1[1] + sigm(bf_hi(g.z)) * v1[1]; v1[2] = p1[2] + sigm(bf_lo(g.w)) * v1[2]; v1[3] = p1[3] + sigm(bf_hi(g.w)) * v1[3];
                    u32x4 w; w.x = cvt_pk_bf16(v0[0], v0[1]); w.y = cvt_pk_bf16(v0[2], v0[3]); w.z = cvt_pk_bf16(v1[0], v1[1]); w.w = cvt_pk_bf16(v1[2], v1[3]);
                    *(u32x4*)(O + (size_t)row * 2048 + c) = w; } }
    }
};
struct EpiG4 {
    static constexpr bool PERM = true, AFTER_DRAIN = false;
    bf16_t* O; float* P; const bf16_t* GA; const bf16_t* GB; int ldg;
    __device__ __forceinline__ void operator()(const f32x4 (&acc)[2][2][4][2], const Unit& u, int ui, int wr, int wc, int fr, int fq) const {
        const int col0 = u.pn * BM + wc * 32 + 8 * fq;
        const bf16_t* G = u.sel ? GB : GA;
#pragma unroll
        for (int ai = 0; ai < 2; ++ai)
#pragma unroll
            for (int m = 0; m < 4; ++m) { const int row = u.pm * BM + ai * HALF + wr * 64 + m * 16 + fr;
#pragma unroll
                for (int bj = 0; bj < 2; ++bj) { const int c = col0 + bj * HALF; const u32x4 g = *(const u32x4*)(G + (size_t)row * ldg + c);
                    f32x4 v0 = acc[ai][bj][m][0], v1 = acc[ai][bj][m][1];
                    v0[0] *= sigm(bf_lo(g.x)); v0[1] *= sigm(bf_hi(g.x)); v0[2] *= sigm(bf_lo(g.y)); v0[3] *= sigm(bf_hi(g.y));
                    v1[0] *= sigm(bf_lo(g.z)); v1[1] *= sigm(bf_hi(g.z)); v1[2] *= sigm(bf_lo(g.w)); v1[3] *= sigm(bf_hi(g.w));
                    float* pp = P + (size_t)row * 2048 + c;
                    if (u.sel == 0) { *(f32x4*)pp = v0; *(f32x4*)(pp + 4) = v1; }
                    else { v0 += *(const f32x4*)pp; v1 += *(const f32x4*)(pp + 4);
                        u32x4 w; w.x = cvt_pk_bf16(v0[0], v0[1]); w.y = cvt_pk_bf16(v0[2], v0[3]); w.z = cvt_pk_bf16(v1[0], v1[1]); w.w = cvt_pk_bf16(v1[2], v1[3]);
                        *(u32x4*)(O + (size_t)row * 2048 + c) = w; } } }
    }
};
struct EpiG4m {
    static constexpr bool PERM = true, AFTER_DRAIN = false, MIDK = true;
    bf16_t* O; const bf16_t* RHO; const bf16_t* SGB;
    __device__ __forceinline__ void scale(f32x4 (&acc)[2][2][4][2], const bf16_t* T, const Unit& u, int wr, int wc, int fr, int fq) const {
        const int col0 = u.pn * BM + wc * 32 + 8 * fq;
        u32x4 gv[2][4][2];
#pragma unroll
        for (int ai = 0; ai < 2; ++ai)
#pragma unroll
            for (int m = 0; m < 4; ++m)
#pragma unroll
                for (int bj = 0; bj < 2; ++bj) gv[ai][m][bj] = *(const u32x4*)(T + (size_t)(u.pm * BM + ai * HALF + wr * 64 + m * 16 + fr) * 2048 + col0 + bj * HALF);
        __builtin_amdgcn_sched_barrier(0);
#pragma unroll
        for (int ai = 0; ai < 2; ++ai)
#pragma unroll
            for (int m = 0; m < 4; ++m)
#pragma unroll
                for (int bj = 0; bj < 2; ++bj) { const u32x4 g = gv[ai][m][bj]; f32x4& v0 = acc[ai][bj][m][0]; f32x4& v1 = acc[ai][bj][m][1];
                    v0[0] *= bf_lo(g.x); v0[1] *= bf_hi(g.x); v0[2] *= bf_lo(g.y); v0[3] *= bf_hi(g.y); v1[0] *= bf_lo(g.z); v1[1] *= bf_hi(g.z); v1[2] *= bf_lo(g.w); v1[3] *= bf_hi(g.w); }
    }
    __device__ __forceinline__ void midk(f32x4 (&acc)[2][2][4][2], const Unit& u, int wr, int wc, int fr, int fq) const {
        asm volatile("" : "+v"(fr), "+v"(fq));
        scale(acc, RHO, u, wr, wc, fr, fq);
    }
    __device__ __forceinline__ void operator()(const f32x4 (&acc_)[2][2][4][2], const Unit& u, int ui, int wr, int wc, int fr, int fq) const {
        f32x4 acc[2][2][4][2];
#pragma unroll
        for (int a = 0; a < 2; ++a)
#pragma unroll
            for (int b = 0; b < 2; ++b)
#pragma unroll
                for (int m = 0; m < 4; ++m)
#pragma unroll
                    for (int n = 0; n < 2; ++n) acc[a][b][m][n] = acc_[a][b][m][n];
        scale(acc, SGB, u, wr, wc, fr, fq);
        const int col0 = u.pn * BM + wc * 32 + 8 * fq;
#pragma unroll
        for (int ai = 0; ai < 2; ++ai)
#pragma unroll
            for (int m = 0; m < 4; ++m) { const int row = u.pm * BM + ai * HALF + wr * 64 + m * 16 + fr;
#pragma unroll
                for (int bj = 0; bj < 2; ++bj) { const f32x4 v0 = acc[ai][bj][m][0], v1 = acc[ai][bj][m][1];
                    u32x4 w; w.x = cvt_pk_bf16(v0[0], v0[1]); w.y = cvt_pk_bf16(v0[2], v0[3]); w.z = cvt_pk_bf16(v1[0], v1[1]); w.w = cvt_pk_bf16(v1[2], v1[3]);
                    *(u32x4*)(O + (size_t)row * 2048 + col0 + bj * HALF) = w; } }
    }
};
struct DualOrder : StaticOrder {
    __host__ __device__ bool next(int i, Unit& u) const { if (!StaticOrder::next(i >> 1, u)) return false; u.sel = i & 1; return true; }
};
struct EpiRes {
    static constexpr bool PERM = false, AFTER_DRAIN = false;
    bf16_t* HB; float* RS;
    __device__ __forceinline__ void operator()(const f32x4 (&acc)[2][2][4][2], const Unit& u, int ui, int wr, int wc, int fr, int fq) const {
        const int col0 = u.pn * BM + wc * 32 + 4 * fq;
        u32x2 ho[2][4][2][2];
#pragma unroll
        for (int ai = 0; ai < 2; ++ai)
#pragma unroll
            for (int m = 0; m < 4; ++m) { const int row = u.pm * BM + ai * HALF + wr * 64 + m * 16 + fr;
#pragma unroll
                for (int bj = 0; bj < 2; ++bj)
#pragma unroll
                    for (int n = 0; n < 2; ++n) ho[ai][m][bj][n] = *(const u32x2*)(HB + (size_t)row * 2048 + col0 + bj * HALF + n * 16); }
        __builtin_amdgcn_sched_barrier(0);
#pragma unroll
        for (int ai = 0; ai < 2; ++ai)
#pragma unroll
            for (int m = 0; m < 4; ++m) { const int row = u.pm * BM + ai * HALF + wr * 64 + m * 16 + fr; float ss = 0.f;
#pragma unroll
                for (int bj = 0; bj < 2; ++bj)
#pragma unroll
                    for (int n = 0; n < 2; ++n) { const size_t off = (size_t)row * 2048 + col0 + bj * HALF + n * 16;
                        const u32x2 h0 = ho[ai][m][bj][n];
                        f32x4 hv = {bf_lo(h0.x), bf_hi(h0.x), bf_lo(h0.y), bf_hi(h0.y)}; hv += acc[ai][bj][m][n];
                        u32x2 w; w.x = cvt_pk_bf16(hv[0], hv[1]); w.y = cvt_pk_bf16(hv[2], hv[3]); *(u32x2*)(HB + off) = w;
                        ss += (hv[0] * hv[0] + hv[1] * hv[1]) + (hv[2] * hv[2] + hv[3] * hv[3]); }
                ss += __shfl_xor(ss, 16); ss += __shfl_xor(ss, 32);
                if (fq == 0) RS[(size_t)row * 32 + u.pn * 4 + wc] = ss; }
    }
};
}

#define GAS __attribute__((address_space(1)))
#define LAS __attribute__((address_space(3)))
typedef unsigned short bf16;
typedef unsigned v4u __attribute__((ext_vector_type(4)));
typedef float f32x4 __attribute__((ext_vector_type(4)));
typedef short bf16x8 __attribute__((ext_vector_type(8)));
typedef GAS unsigned gu32;
typedef GAS unsigned long long gu64;
#define RLX_AGENT __ATOMIC_RELAXED, __HIP_MEMORY_SCOPE_AGENT
#define LDS_WAIT() asm volatile("s_waitcnt lgkmcnt(0)" ::: "memory")
#define VM_WAIT() asm volatile("s_waitcnt vmcnt(0)" ::: "memory")
__device__ __forceinline__ unsigned long long rt() { return __builtin_amdgcn_s_memrealtime(); }
__device__ __forceinline__ unsigned f2bf(float f) { unsigned u = __builtin_bit_cast(unsigned, f); return (u + 0x7fffu + ((u >> 16) & 1u)) >> 16; }
__device__ __forceinline__ unsigned pk2(float lo, float hi) { return f2bf(lo) | (f2bf(hi) << 16); }

#define XB_TMO      128
#define XB_XCNT(j)  (256  + 64 * (j))
#define XB_XSUB(j)  (1280 + 64 * (j))
#define XB_XGEN(j)  (2304 + 64 * (j))
#define XB_TOP      3328
#define XB_TOPGEN   3392
#define XCD_BAR_WORDS 3456
#define XB_SPIN_CAP (1u << 18)

__device__ __forceinline__ unsigned xb_ld(unsigned* p)              { return __hip_atomic_load(p, __ATOMIC_RELAXED, __HIP_MEMORY_SCOPE_AGENT); }
__device__ __forceinline__ unsigned xb_add(unsigned* p, unsigned v) { return __hip_atomic_fetch_add(p, v, __ATOMIC_RELAXED, __HIP_MEMORY_SCOPE_AGENT); }
__device__ __forceinline__ unsigned xb_xcc_id() { return (unsigned)__builtin_amdgcn_s_getreg((3 << 11) | 20) & 0xFu; }
#define XB_SPIN(cond, bar) do { unsigned _sp = 0; while (cond) { __builtin_amdgcn_s_sleep(1); \
    if ((++_sp & 255u) == 0u) { if (xb_ld(&(bar)[XB_TMO])) break; if (_sp > XB_SPIN_CAP) { atomicAdd(&(bar)[XB_TMO], 1u); break; } } } } while (0)

struct XcdBarrier {
    unsigned* bar; unsigned x;
    volatile LAS unsigned* st;
};

__device__ __forceinline__ XcdBarrier xcd_barrier_post(unsigned* bar, volatile LAS unsigned* st) {
    XcdBarrier b; b.bar = bar; b.x = xb_xcc_id(); b.st = st;
    if (threadIdx.x == 0) (void)xb_add(&bar[XB_XCNT(b.x)], 1u);
    return b;
}
__device__ __forceinline__ void xcd_barrier_complete(unsigned* bar, unsigned x, unsigned& nloc, unsigned& nx) {
    const unsigned G = gridDim.x * gridDim.y * gridDim.z;
    unsigned sum, cnt, mine, sp = 0u;
    for (;;) {
        sum = 0u; cnt = 0u; mine = 0u;
#pragma unroll
        for (unsigned j = 0; j < 16; ++j) { const unsigned c = xb_ld(&bar[XB_XCNT(j)]); sum += c; cnt += (c > 0u) ? 1u : 0u; mine = (j == x) ? c : mine; }
        if (sum == G) break;
        __builtin_amdgcn_s_sleep(1);
        if ((++sp & 255u) == 0u) { if (xb_ld(&bar[XB_TMO])) break; if (sp > XB_SPIN_CAP) { atomicAdd(&bar[XB_TMO], 1u); break; } }
    }
    nloc = mine > 0u ? mine : 1u; nx = cnt > 0u ? cnt : 1u;
}

__device__ __forceinline__ void xcd_barrier(const XcdBarrier& b, bool thread0) {
    asm volatile("s_waitcnt vmcnt(0)" ::: "memory");
    __syncthreads();
    if (thread0) {
        unsigned* bar = b.bar;
        __builtin_amdgcn_s_waitcnt(0);
        unsigned nloc = b.st[0], nx = b.st[1];
        if (nloc == 0u) { xcd_barrier_complete(bar, b.x, nloc, nx); b.st[0] = nloc; b.st[1] = nx; }
        const unsigned old = xb_add(&bar[XB_XSUB(b.x)], 1u);
        const unsigned gen = old / nloc;
        if (old + 1u == (gen + 1u) * nloc) {
            __builtin_amdgcn_fence(__ATOMIC_RELEASE, "agent");
            asm volatile("s_waitcnt vmcnt(0)" ::: "memory");
            const unsigned og = xb_add(&bar[XB_TOP], 1u);
            const unsigned tg = og / nx;
            if (og + 1u == (tg + 1u) * nx) xb_add(&bar[XB_TOPGEN], 1u);
            else XB_SPIN(xb_ld(&bar[XB_TOPGEN]) == tg, bar);
            __builtin_amdgcn_fence(__ATOMIC_ACQUIRE, "agent");
            xb_add(&bar[XB_XGEN(b.x)], 1u);
            asm volatile("s_waitcnt vmcnt(0)" ::: "memory");
        } else {
            XB_SPIN(xb_ld(&bar[XB_XGEN(b.x)]) == gen, bar);
            __builtin_amdgcn_fence(__ATOMIC_ACQUIRE, "agent");
            asm volatile("s_waitcnt vmcnt(0)" ::: "memory");
        }
    }
    __syncthreads();
}
#ifndef MK_PROBE
#define MK_PROBE (-1)
#endif
#ifndef MK_PROBE_BLOCK
#define MK_PROBE_BLOCK 0
#endif
#ifndef MK_PROBE_SCALE
#define MK_PROBE_SCALE 2e-6f
#endif
#define PROBE_T0() unsigned pt0_ = 0; if (MK_PROBE >= 0) { pt0_ = (unsigned)__builtin_amdgcn_readfirstlane((int)(unsigned)__builtin_amdgcn_s_memtime()); asm volatile("s_waitcnt lgkmcnt(0)" ::: "memory"); }
#define PROBE_T1(id) do { if (MK_PROBE == (id)) { const unsigned pt1_ = (unsigned)__builtin_amdgcn_readfirstlane((int)(unsigned)__builtin_amdgcn_s_memtime()); asm volatile("s_waitcnt lgkmcnt(0)" ::: "memory"); \
    if (C.bid == MK_PROBE_BLOCK && C.wave == 0 && C.lane == 0) { volatile LAS unsigned* pw_ = (volatile LAS unsigned*)(C.lds + MISC_OFF + 64); pw_[0] = pw_[0] + (unsigned)(pt1_ - pt0_); } } } while (0)
constexpr int NWAVES = 8;
constexpr int NLAYER = 4, DM = 2048, NBATCH = 2, SEQ = 4096, NMETA = 16, LTOK = SEQ + NMETA, NTOK = NBATCH * LTOK;
constexpr int MP = 8448;
constexpr int NP1 = 8448;
constexpr int NC_IN = 8264;
constexpr int PC_QA = 0, PC_KA = 1024, PC_VA = 1152, PC_ZA = 1280, PC_CQ = 2304, PC_CKV = 2816, PC_ZB = 3072, PC_GA = 4096, PC_GB = 6144, PC_KIDX = 8192, PC_WIDX = 8256;
constexpr int NQ2 = 4608;
constexpr int TOPK = 256;
constexpr int YLD = 2048;
constexpr float RMS_EPS = 1e-6f;

__device__ __forceinline__ int rowof(int b, int t) { return t < NMETA ? 8192 + b * NMETA + t : b * SEQ + (t - NMETA); }
__device__ __forceinline__ int t5_bucket(int d) {
    const int n = d < 0 ? 0 : d;
    if (n < 16) return n;
    return 16 + (n >= 19) + (n >= 21) + (n >= 24) + (n >= 27) + (n >= 31) + (n >= 35) + (n >= 40) + (n >= 46) + (n >= 52) + (n >= 59) + (n >= 67) + (n >= 77) + (n >= 87) + (n >= 99) + (n >= 113);
}
__device__ __forceinline__ float bf2f(bf16 v) { return __uint_as_float((unsigned)v << 16); }
__device__ __forceinline__ float sigmoidf_(float x) { return 1.0f / (1.0f + __expf(-x)); }
__device__ __forceinline__ float siluf_(float x) { return x / (1.0f + __expf(-x)); }
__device__ __forceinline__ float wave_sum(float v) {
#pragma unroll
    for (int o = 1; o < 64; o <<= 1) v += __shfl_xor(v, o);
    return v;
}
__device__ __forceinline__ float wave_max(float v) {
#pragma unroll
    for (int o = 1; o < 64; o <<= 1) v = fmaxf(v, __shfl_xor(v, o));
    return v;
}
__device__ __forceinline__ int wave_sum_i(int v) {
#pragma unroll
    for (int o = 1; o < 64; o <<= 1) v += __shfl_xor(v, o);
    return v;
}

constexpr size_t MiB = 1u << 20;
constexpr size_t WS_CTL = 0, CTL_ZERO_BYTES = 1 * MiB;
constexpr size_t SZ_W1 = (size_t)NLAYER * NP1 * DM * 2, SZ_W2 = (size_t)NLAYER * NQ2 * 512 * 2, SZ_WA = (size_t)NLAYER * DM * 1024 * 2, SZ_WO = (size_t)NLAYER * DM * DM * 2;
constexpr size_t al(size_t x) { return (x + 4095) / 4096 * 4096; }
constexpr size_t WS_W1 = 1 * MiB, WS_W2 = WS_W1 + al(SZ_W1), WS_WA = WS_W2 + al(SZ_W2), WS_WB = WS_WA + 1024 * 2, WS_WO = WS_WA + al(2 * SZ_WA);
constexpr size_t SZ_WUV = (size_t)NLAYER * 16 * 64 * 256 * 2;
constexpr size_t WS_WUV = WS_WO + al(SZ_WO);
constexpr size_t WS_VT = WS_WUV + al(SZ_WUV);
constexpr size_t WS_KV = WS_VT + al((size_t)2 * 128 * 4128 * 2), WS_KIDX = WS_KV + al((size_t)MP * 256 * 2);
constexpr size_t WS_H = WS_KIDX + al((size_t)MP * 64 * 2), WS_HB = WS_H + al((size_t)MP * DM * 4), WS_RS = WS_HB + al((size_t)MP * DM * 2);
constexpr size_t WS_RS2 = WS_RS + al((size_t)MP * 32 * 4);
constexpr size_t WS_RSQ = WS_RS2 + al((size_t)32 * 64 * 4), WS_RSQ2 = WS_RSQ + al((size_t)MP * 8 * 4);
constexpr size_t WS_PROJ = WS_RSQ2 + al((size_t)32 * 16 * 4), WS_CQN = WS_PROJ + al((size_t)MP * NP1 * 2), WS_CKVN = WS_CQN + al((size_t)MP * 512 * 2);
constexpr size_t WS_Q2 = WS_CKVN + al((size_t)MP * 256 * 2), WS_OLAT = WS_Q2 + al((size_t)MP * NQ2 * 2), WS_YA = WS_OLAT + al((size_t)256 * 3 * 16 * 8 * 64 * 8 * 2);
constexpr size_t WS_YB = WS_YA + 1024 * 2, WS_PA = WS_YA + al((size_t)MP * 2048 * 2),
 WS_MG = WS_PA + al((size_t)MP * DM * 4), WS_RHO = WS_MG + al((size_t)MP * DM * 2), WS_SGB = WS_RHO + al((size_t)MP * DM * 2), WS_W1K = WS_SGB + al((size_t)MP * DM * 2), WS_END = WS_W1K + al((size_t)NLAYER * 32 * 3 * 4 * 512 * 2);
constexpr int CW_TMO = 0, CW_CODE = 1, CW_BAR = 4096, CW_DSAQ = 16384, CW_SWAQ = 20480;

constexpr int LDSCTL_OFF = 0, MISC_OFF = LDSCTL_OFF + 320;
constexpr int RSTD_OFF = 512;
constexpr int RING_OFF = 8192, RING_BYTES = 131072;
constexpr int LDS_BYTES = 163840;
static_assert(RSTD_OFF + 5 * 256 * 4 <= RING_OFF, "LDS map");

struct Args {
    const float* x; const float* meta; const float* bias_table; const float* norm_g; const float* w_in; const float* q_norm_g; const float* kv_norm_g; const float* w_qb; const float* w_iq;
    const float* w_uk; const float* w_uv; const float* sinks; const float* w_proj_a; const float* w_proj_b; const float* w_out; const float* final_g;
    float* out; unsigned char* ws; int ph_lo, ph_hi;
};

__device__ __forceinline__ unsigned pkh(float lo, float hi) { typedef float f2_t __attribute__((ext_vector_type(2))); typedef __bf16 b2_t __attribute__((ext_vector_type(2))); f2_t v = {lo, hi}; b2_t b = __builtin_convertvector(v, b2_t); return __builtin_bit_cast(unsigned, b); }
struct XDesc { const float* W; const float* scale; bf16* out; int ldw, k0, c0, nvalid, K; };
__device__ __forceinline__ void xpose_load(const XDesc& d, float (&v)[32], int lane) {
    asm volatile("" : "+v"(lane));
    const int c = lane & 31, cc = (c < d.nvalid) ? c : 0; const float* p = d.W + (size_t)(d.k0 + (lane >> 5)) * d.ldw + d.c0 + cc;
    const float keep = (c < d.nvalid) ? 1.f : 0.f;
#pragma unroll
    for (int i = 0; i < 32; ++i) v[i] = p[(size_t)(2 * i) * d.ldw];
#pragma unroll
    for (int i = 0; i < 32; ++i) v[i] *= keep;
    if (d.scale) {
#pragma unroll
        for (int i = 0; i < 32; ++i) v[i] *= d.scale[d.k0 + 2 * i + (lane >> 5)];
    }
}
__device__ __forceinline__ void xpose_store(const XDesc& d, const float (&v)[32], LAS float* scr, int lane) {
    asm volatile("" : "+v"(lane));
    const int c = lane & 31;
#pragma unroll
    for (int i = 0; i < 32; ++i) scr[(2 * i + (lane >> 5)) * 33 + c] = v[i];
    LDS_WAIT(); asm volatile("" ::: "memory");
    const int cc = lane & 7;
#pragma unroll
    for (int j = 0; j < 4; ++j) { const int n = (lane >> 3) + 8 * j; const LAS float* s = scr + (8 * cc) * 33 + n;
        v4u o; o.x = pkh(s[0 * 33], s[1 * 33]); o.y = pkh(s[2 * 33], s[3 * 33]); o.z = pkh(s[4 * 33], s[5 * 33]); o.w = pkh(s[6 * 33], s[7 * 33]);
        *(GAS v4u*)(d.out + (size_t)n * d.K + d.k0 + 8 * cc) = o; }
    LDS_WAIT(); asm volatile("" ::: "memory");
}
__device__ __forceinline__ void fold_split(const float (&x)[8], bf16x8& hi, bf16x8& lo) {
    unsigned hw[4], lw[4];
#pragma unroll
    for (int j = 0; j < 4; ++j) { hw[j] = pkh(x[2 * j], x[2 * j + 1]);
        const float r0 = x[2 * j] - __uint_as_float(hw[j] << 16), r1 = x[2 * j + 1] - __uint_as_float(hw[j] & 0xffff0000u); lw[j] = pkh(r0, r1); }
    const v4u h4 = {hw[0], hw[1], hw[2], hw[3]}, l4 = {lw[0], lw[1], lw[2], lw[3]};
    hi = __builtin_bit_cast(bf16x8, h4); lo = __builtin_bit_cast(bf16x8, l4);
}
__device__ __forceinline__ void fold_item(const float* __restrict__ wqb, const float* __restrict__ wuk, const float* __restrict__ gq, bf16* W2l, int h, int kb, int rb, LAS float* scr, int lane) {
    asm volatile("" : "+v"(lane));
    (void)scr;
    const int n = lane & 31, hh = lane >> 5;
    f32x4 av[2][4][2]; float bvv[4][8]; f32x4 gv[2][4];
#pragma unroll
    for (int mt = 0; mt < 2; ++mt)
#pragma unroll
        for (int s = 0; s < 4; ++s) { const float* p = wqb + (size_t)(kb * 64 + mt * 32 + n) * 1024 + h * 64 + 16 * s + 8 * hh; av[mt][s][0] = *(const f32x4*)p; av[mt][s][1] = *(const f32x4*)(p + 4); }
#pragma unroll
    for (int s = 0; s < 4; ++s)
#pragma unroll
        for (int j = 0; j < 8; ++j) bvv[s][j] = wuk[((size_t)h * 64 + 16 * s + 8 * hh + j) * 256 + rb * 32 + n];
#pragma unroll
    for (int mt = 0; mt < 2; ++mt)
#pragma unroll
        for (int q = 0; q < 4; ++q) gv[mt][q] = *(const f32x4*)(gq + kb * 64 + mt * 32 + 8 * q + 4 * hh);
    typedef float f32x16_ __attribute__((ext_vector_type(16)));
    f32x16_ acc[2] = {};
#pragma unroll
    for (int s = 0; s < 4; ++s) { bf16x8 bh, bl; fold_split(bvv[s], bh, bl);
#pragma unroll
        for (int mt = 0; mt < 2; ++mt) { const float x[8] = {av[mt][s][0][0], av[mt][s][0][1], av[mt][s][0][2], av[mt][s][0][3], av[mt][s][1][0], av[mt][s][1][1], av[mt][s][1][2], av[mt][s][1][3]};
            bf16x8 ah, al; fold_split(x, ah, al);
            acc[mt] = __builtin_amdgcn_mfma_f32_32x32x16_bf16(al, bh, acc[mt], 0, 0, 0);
            acc[mt] = __builtin_amdgcn_mfma_f32_32x32x16_bf16(ah, bl, acc[mt], 0, 0, 0);
            acc[mt] = __builtin_amdgcn_mfma_f32_32x32x16_bf16(ah, bh, acc[mt], 0, 0, 0); } }
    bf16* out = W2l + (size_t)(h * 256 + rb * 32 + n) * 512 + kb * 64 + 4 * hh;
#pragma unroll
    for (int mt = 0; mt < 2; ++mt)
#pragma unroll
        for (int q = 0; q < 4; ++q) { const f32x4 g = gv[mt][q]; pg8::u32x2 o;
            o.x = pkh(acc[mt][4 * q] * g[0], acc[mt][4 * q + 1] * g[1]); o.y = pkh(acc[mt][4 * q + 2] * g[2], acc[mt][4 * q + 3] * g[3]);
            *(pg8::u32x2*)(out + mt * 32 + 8 * q) = o; }
}

typedef const __attribute__((address_space(4))) Args KArgs;
__device__ __forceinline__ KArgs* kargs() { size_t z = 0; asm volatile("" : "+s"(z)); return (KArgs*)((const __attribute__((address_space(4))) unsigned char*)__builtin_amdgcn_kernarg_segment_ptr() + z); }
struct Ctx {
    LAS unsigned char* lds; int tid, lane, wave, G, gw, NGW, bid;
};
#if defined(__HIP_DEVICE_COMPILE__)
#define ASSUME_GLOBAL(p) do { __builtin_assume(!__builtin_amdgcn_is_shared((const void*)(p))); __builtin_assume(!__builtin_amdgcn_is_private((const void*)(p))); } while (0)
#else
#define ASSUME_GLOBAL(p) do { } while (0)
#endif
__device__ __forceinline__ unsigned char* launder(unsigned char* p) { size_t z = 0; asm volatile("" : "+s"(z)); return p + z; }
__device__ __forceinline__ const float* launderf(const float* p) { size_t z = 0; asm volatile("" : "+s"(z)); return p + z; }
struct Bufs {
    bf16 *W1K, *W1, *W2, *WA, *WB, *WO, *WUV, *VT, *KV, *KIDX, *RHO, *SGB, *HB, *PROJ, *CQN, *CKVN, *Q2, *OLAT, *YA, *YB, *MG; float *H, *RS, *RS2, *RSQ, *RSQ2, *PA;
    __device__ __forceinline__ explicit Bufs(unsigned char* ws0) {
        unsigned char* ws = launder(ws0);
        W1K = (bf16*)(ws + WS_W1K); W1 = (bf16*)(ws + WS_W1); W2 = (bf16*)(ws + WS_W2); WA = (bf16*)(ws + WS_WA); WB = (bf16*)(ws + WS_WB); WO = (bf16*)(ws + WS_WO); WUV = (bf16*)(ws + WS_WUV); VT = (bf16*)(ws + WS_VT); KV = (bf16*)(ws + WS_KV); KIDX = (bf16*)(ws + WS_KIDX); RHO = (bf16*)(ws + WS_RHO); SGB = (bf16*)(ws + WS_SGB);
        H = (float*)(ws + WS_H); HB = (bf16*)(ws + WS_HB); RS = (float*)(ws + WS_RS); RS2 = (float*)(ws + WS_RS2); RSQ = (float*)(ws + WS_RSQ); RSQ2 = (float*)(ws + WS_RSQ2); PROJ = (bf16*)(ws + WS_PROJ); CQN = (bf16*)(ws + WS_CQN); CKVN = (bf16*)(ws + WS_CKVN);
        Q2 = (bf16*)(ws + WS_Q2); OLAT = (bf16*)(ws + WS_OLAT); YA = (bf16*)(ws + WS_YA); YB = (bf16*)(ws + WS_YB); PA = (float*)(ws + WS_PA); MG = (bf16*)(ws + WS_MG);
    }
};

__device__ __forceinline__ void p0_prologue(const Ctx& C) {
    const Bufs B(kargs()->ws);
    const KArgs& A = *kargs();
    LAS float* scr = (LAS float*)(C.lds + RING_OFF + C.wave * 16384);
    constexpr int I_T1 = (DM / 64) * (NP1 / 32), I_T2 = (512 / 64) * (512 / 32), I_T3 = (1024 / 64) * (DM / 32), I_T5 = (DM / 64) * (DM / 32), I_F = 16 * 8 * 8, I_UV = 16 * 8;
    constexpr int I_X = I_T1 + I_T2 + 2 * I_T3 + I_T5, NX = NLAYER * I_X;
    auto decode = [&](int it) -> XDesc {
        const int l = it / I_X; int r = it % I_X; XDesc d;
        if (r < I_T1) { const int nblk = NP1 / 32, kb = r / nblk, n0 = (r % nblk) * 32; int c0, nvalid = 32;
            if (n0 < 4096) c0 = n0; else if (n0 < 8192) { const int tt = (n0 - 4096) >> 8, wi = (n0 - 4096) & 255; c0 = (wi < 128 ? 4168 : 6216 - 128) + 128 * tt + wi; }
            else { c0 = n0 - 8192 + 4096; nvalid = (8264 - n0) < 0 ? 0 : ((8264 - n0) > 32 ? 32 : (8264 - n0)); }
            d = XDesc{A.w_in + (size_t)l * DM * NC_IN, A.norm_g + l * DM, B.W1 + ((size_t)l * NP1 + n0) * DM, NC_IN, kb * 64, c0, nvalid, DM}; return d; }
        r -= I_T1;
        if (r < I_T2) { const int nblk = 512 / 32, kb = r / nblk, nb = r % nblk;
            d = XDesc{A.w_iq + (size_t)l * 512 * 512, A.q_norm_g + l * 512, B.W2 + ((size_t)l * NQ2 + 4096 + nb * 32) * 512, 512, kb * 64, nb * 32, 32, 512}; return d; }
        r -= I_T2;
        if (r < 2 * I_T3) { const bool second = r >= I_T3; if (second) r -= I_T3; const int nblk = DM / 32, kb = r / nblk, nb = r % nblk;
            d = XDesc{(second ? A.w_proj_b : A.w_proj_a) + (size_t)l * 1024 * DM, nullptr, (second ? B.WB : B.WA) + ((size_t)l * DM + nb * 32) * 2048, DM, kb * 64, nb * 32, 32, 2048}; return d; }
        r -= 2 * I_T3;
        { const int nblk = DM / 32, kb = r / nblk, nb = r % nblk;
            d = XDesc{A.w_out + (size_t)l * DM * DM, nullptr, B.WO + ((size_t)l * DM + nb * 32) * DM, DM, kb * 64, nb * 32, 32, DM}; return d; }
    };
    {
        int it = C.gw;
        if (it < NX) {
            XDesc dA = decode(it), dB = dA, dC = dA; float vA[32], vB[32], vC[32];
            xpose_load(dA, vA, C.lane);
            if (it + C.NGW < NX) { dB = decode(it + C.NGW); xpose_load(dB, vB, C.lane); }
#define PRO_STEP(dc_, vc_, dn_, vn_) { if (it + 2 * C.NGW < NX) { dn_ = decode(it + 2 * C.NGW); xpose_load(dn_, vn_, C.lane); } xpose_store(dc_, vc_, scr, C.lane); it += C.NGW; if (it >= NX) break; }
            for (;;) {
                PRO_STEP(dA, vA, dC, vC)
                PRO_STEP(dB, vB, dA, vA)
                PRO_STEP(dC, vC, dB, vB)
            }
#undef PRO_STEP
        }
    }
    for (int it = C.NGW - 1 - C.gw; it < NLAYER * I_UV; it += C.NGW) {
        const int l = it / I_UV, r = it % I_UV, h = r / 8, s = r % 8;
        const float* wsrc = A.w_uv + ((size_t)l * 16 + h) * 256 * 64; const int gg = C.lane >> 4, cc = C.lane & 15;
#pragma unroll
        for (int nt = 0; nt < 4; ++nt) { const float* p = wsrc + (size_t)(32 * s + 8 * gg) * 64 + 16 * nt + cc;
            v4u o; o.x = pkh(p[0 * 64], p[1 * 64]); o.y = pkh(p[2 * 64], p[3 * 64]); o.z = pkh(p[4 * 64], p[5 * 64]); o.w = pkh(p[6 * 64], p[7 * 64]);
            *(GAS v4u*)(B.WUV + ((((size_t)l * 16 + h) * 8 + s) * 4 + nt) * 512 + C.lane * 8) = o; }
    }
    for (int it = C.NGW - 1 - 512 - C.gw; it >= 0 && it < NLAYER * 96; it += C.NGW) {
        const int l = it / 96, r = it % 96, gk = r / 3, nt = r % 3, n = C.lane & 31, hh = C.lane >> 5, col = nt * 32 + n;
        const float* wsrc = A.w_in + (size_t)l * DM * NC_IN + 4096 + (col < 72 ? col : 0); const float* gsrc = A.norm_g + l * DM; const float keep = col < 72 ? 1.f : 0.f;
#pragma unroll
        for (int s = 0; s < 4; ++s) { const int k0 = gk * 64 + s * 16 + hh * 8; float x[8];
#pragma unroll
            for (int e = 0; e < 8; ++e) x[e] = wsrc[(size_t)(k0 + e) * NC_IN] * gsrc[k0 + e] * keep;
            v4u o; o.x = pkh(x[0], x[1]); o.y = pkh(x[2], x[3]); o.z = pkh(x[4], x[5]); o.w = pkh(x[6], x[7]);
            *(GAS v4u*)(B.W1K + ((((size_t)l * 32 + gk) * 3 + nt) * 4 + s) * 512 + C.lane * 8) = o; }
    }
    for (int it = C.gw; it < NLAYER * I_F; it += C.NGW) {
        const int l = it / I_F, r = it % I_F, h = r / 64, kb = (r / 8) % 8, rb = r % 8;
        fold_item(A.w_qb + (size_t)l * 512 * 1024, A.w_uk + (size_t)l * 16 * 64 * 256, A.q_norm_g + l * 512, B.W2 + (size_t)l * NQ2 * 512, h, kb, rb, scr, C.lane);
    }
    for (int m0 = C.gw; m0 < MP; m0 += 3 * C.NGW) {
        f32x4 vv[3][8];
#pragma unroll
        for (int r = 0; r < 3; ++r) { const int m = m0 + r * C.NGW;
            const float* src = A.x;
            if (m < 8192) src = A.x + (size_t)m * DM; else if (m < 8224) src = A.meta + (size_t)((m - 8192) % NMETA) * DM;
#pragma unroll
            for (int j = 0; j < 8; ++j) vv[r][j] = *(const f32x4*)(src + j * 256 + C.lane * 4); }
        __builtin_amdgcn_sched_barrier(0);
#pragma unroll
        for (int r = 0; r < 3; ++r) { const int m = m0 + r * C.NGW;
            if (m < MP) { const bool keep = m < 8224; float ss = 0.f;
#pragma unroll
                for (int j = 0; j < 8; ++j) { const f32x4 v = keep ? vv[r][j] : (f32x4){0.f, 0.f, 0.f, 0.f};
                    pg8::u32x2 w; w.x = pkh(v[0], v[1]); w.y = pkh(v[2], v[3]); *(pg8::u32x2*)(B.HB + (size_t)m * DM + j * 256 + C.lane * 4) = w;
                    ss += (v[0] * v[0] + v[1] * v[1]) + (v[2] * v[2] + v[3] * v[3]); }
                ss = wave_sum(ss);
                if (C.lane < 32) B.RS[(size_t)m * 32 + C.lane] = (C.lane == 0) ? ss : 0.f;
                if (m >= 8192 && m < 8224) B.RS2[(size_t)(m - 8192) * 64 + C.lane] = (C.lane == 0) ? ss : 0.f;
                if (m >= NTOK) {
#pragma unroll
                    for (int j = 0; j < 2; ++j) { *(v4u*)(B.YA + (size_t)m * YLD + j * 512 + C.lane * 8) = (v4u){0u, 0u, 0u, 0u}; *(v4u*)(B.YB + (size_t)m * YLD + j * 512 + C.lane * 8) = (v4u){0u, 0u, 0u, 0u}; }
                } } }
    }
    if (C.gw < 2) { bf16* kp = B.KIDX + (size_t)(C.gw * 129 + 128) * 2048;
#pragma unroll
        for (int i = 0; i < 2; ++i) { const int q = C.lane + 64 * i, s = q >> 5, hh = (q >> 4) & 1, n = 16 + (q & 15); *(v4u*)(kp + s * 512 + (hh * 32 + n) * 8) = (v4u){0u, 0u, 0u, 0u}; } }
}

template <int NP4>
__device__ __forceinline__ void rstd_table(const Ctx& C, const pg8::StaticOrder& S, const float* __restrict__ rs, float inv_dim) {
    LAS float* tbl = (LAS float*)(C.lds + RSTD_OFF);
    const int hf = C.wave >> 2, rr = C.tid & 255;
    pg8::Unit u0, u1, u2;
    const int i0 = hf, i1 = 2 + hf, i2 = 4 + hf;
    const bool v0 = S.next(i0, u0), v1 = S.next(i1, u1), v2 = (i2 < 5) && S.next(i2, u2);
    f32x4 x0[NP4], x1[NP4];
    { const f32x4* p0 = (const f32x4*)(rs + (size_t)((v0 ? u0.pm : 0) * 256 + rr) * (NP4 * 4)); const f32x4* p1 = (const f32x4*)(rs + (size_t)((v1 ? u1.pm : 0) * 256 + rr) * (NP4 * 4));
#pragma unroll
      for (int j = 0; j < NP4; ++j) { x0[j] = p0[j]; x1[j] = p1[j]; } }
    { float s0 = 0.f, s1 = 0.f;
#pragma unroll
      for (int j = 0; j < NP4; ++j) { s0 += (x0[j][0] + x0[j][1]) + (x0[j][2] + x0[j][3]); s1 += (x1[j][0] + x1[j][1]) + (x1[j][2] + x1[j][3]); }
      if (v0) tbl[i0 * 256 + rr] = rsqrtf(s0 * inv_dim + RMS_EPS);
      if (v1) tbl[i1 * 256 + rr] = rsqrtf(s1 * inv_dim + RMS_EPS); }
    if (v2) { const f32x4* p = (const f32x4*)(rs + (size_t)(u2.pm * 256 + rr) * (NP4 * 4)); float s = 0.f;
#pragma unroll
        for (int j = 0; j < NP4; ++j) { const f32x4 v = p[j]; s += (v[0] + v[1]) + (v[2] + v[3]); }
        tbl[i2 * 256 + rr] = rsqrtf(s * inv_dim + RMS_EPS); }
    __syncthreads();
}

__device__ __forceinline__ void norm_tail(const Ctx& C, int l) {
    const Bufs B(kargs()->ws);
    const KArgs& A = *kargs();
    const int gw2 = (C.G == 256) ? C.gw - 64 * NWAVES : C.gw, ngw2 = (C.G == 256) ? C.NGW - 64 * NWAVES : C.NGW;
    if (gw2 < 0) return;
    {
        const f32x4 g = *(const f32x4*)(A.kv_norm_g + l * 256 + C.lane * 4);
        for (int m0 = gw2; m0 < NTOK; m0 += 6 * ngw2) {
            pg8::u32x2 wv[6];
#pragma unroll
            for (int j = 0; j < 6; ++j) { const int m = m0 + j * ngw2; wv[j] = *(const pg8::u32x2*)(B.PROJ + (size_t)(m < NTOK ? m : m0) * NP1 + PC_CKV + C.lane * 4); }
#pragma unroll
            for (int j = 0; j < 6; ++j) { const int m = m0 + j * ngw2; const pg8::u32x2 w = wv[j];
                float v[4] = {pg8::bf_lo(w.x), pg8::bf_hi(w.x), pg8::bf_lo(w.y), pg8::bf_hi(w.y)};
                float ss = (v[0] * v[0] + v[1] * v[1]) + (v[2] * v[2] + v[3] * v[3]);
                ss = wave_sum(ss); const float r = rsqrtf(ss * (1.0f / 256.0f) + RMS_EPS);
                pg8::u32x2 o; o.x = pkh(v[0] * r * g[0], v[1] * r * g[1]); o.y = pkh(v[2] * r * g[2], v[3] * r * g[3]);
                if (m < NTOK) *(pg8::u32x2*)(B.CKVN + (size_t)m * 256 + C.lane * 4) = o; }
        }
    }
}

__device__ __forceinline__ unsigned f2key(float f) { const unsigned u = __float_as_uint(f); return (u & 0x80000000u) ? ~u : (u | 0x80000000u); }

__device__ __forceinline__ void final_phase(const Ctx& C) {
    const Bufs B(kargs()->ws);
    const KArgs& A = *kargs();
    for (int m0 = C.gw; m0 < 8192; m0 += 4 * C.NGW) {
        float sv[4]; pg8::u32x2 hv[4][8];
#pragma unroll
        for (int r = 0; r < 4; ++r) { const int m = m0 + r * C.NGW, mc = m < 8192 ? m : m0;
            sv[r] = (C.lane < 32) ? B.RS[(size_t)mc * 32 + C.lane] : 0.f;
#pragma unroll
            for (int j = 0; j < 8; ++j) hv[r][j] = *(const pg8::u32x2*)(B.HB + (size_t)mc * DM + j * 256 + C.lane * 4); }
        __builtin_amdgcn_sched_barrier(0);
#pragma unroll
        for (int r = 0; r < 4; ++r) { const int m = m0 + r * C.NGW;
            const float s = wave_sum(sv[r]);
            const float rs = rsqrtf(s * (1.0f / DM) + RMS_EPS);
            if (m < 8192) {
#pragma unroll
                for (int j = 0; j < 8; ++j) { const pg8::u32x2 hw = hv[r][j]; const f32x4 v = {pg8::bf_lo(hw.x), pg8::bf_hi(hw.x), pg8::bf_lo(hw.y), pg8::bf_hi(hw.y)}; const f32x4 g = *(const f32x4*)(A.final_g + j * 256 + C.lane * 4);
                    *(f32x4*)(A.out + (size_t)m * DM + j * 256 + C.lane * 4) = v * rs * g; } } }
    }
#if defined(MK_PROBE)
    if (MK_PROBE >= 0 && C.gw == 0) { VM_WAIT(); if (C.lane == 0) { float* o0 = A.out; o0[0] += (float)__hip_atomic_load((gu32*)(A.ws + WS_CTL) + 3, RLX_AGENT) * MK_PROBE_SCALE; } }
#endif
}


struct SkProj {
    bf16* P; bf16* KV; bf16* KIDX; int cb; const LAS float* tbl; int kr0; bf16* VT;
    __device__ __forceinline__ float operator()(int rloc, int c, float v) const { const int ac = cb + c; const bf16 o = (bf16)f2bf(v * tbl[rloc]);
        if (ac >= 1024 && ac < 1280) { KV[(size_t)rloc * 256 + ac - 1024] = o;
            if (ac >= 1152 && kr0 >= 8192) { const int mm = kr0 + rloc - 8192; VT[((size_t)(mm >> 4) * 128 + ac - 1152) * 4128 + (mm & 15)] = o; } }
        else if (ac >= 8192 && ac < 8256) { const int m = kr0 + rloc, bb = m < 8192 ? (m >> 12) : ((m - 8192) >> 4), pos = m < 8192 ? (m & 4095) + NMETA : ((m - 8192) & 15), k = ac - 8192;
            KIDX[((size_t)(bb * 129 + (pos >> 5)) * 4 + (k >> 4)) * 512 + (((k >> 3) & 1) * 32 + (pos & 31)) * 8 + (k & 7)] = o; }
        else P[(size_t)rloc * NP1 + ac] = o;
        return v * tbl[rloc]; } };
struct SkQ2 { bf16* O; const LAS float* tbl; __device__ __forceinline__ float operator()(int rloc, int c, float v) const { O[(size_t)rloc * NQ2 + c] = (bf16)f2bf(v * tbl[rloc]); return 0.f; } };
struct SkMerge2 { static constexpr bool SPLIT = true; bf16* O; const bf16* G; int c0;
    __device__ __forceinline__ float operator()(int, int, float) const { return 0.f; }
    __device__ __forceinline__ float split(int rloc, int c, float va, float vb) const { const int cg = c0 + c; const bf16* gp = G + (size_t)rloc * NP1 + 256 * (cg >> 7) + (cg & 127);
        O[(size_t)rloc * DM + c] = (bf16)f2bf(sigmoidf_(bf2f(gp[0])) * va + sigmoidf_(bf2f(gp[128])) * vb); return 0.f; } };
struct SkPA { float* P; const bf16* G; int c0; __device__ __forceinline__ float operator()(int rloc, int c, float v) const { const int cg = c0 + c; P[(size_t)rloc * DM + c] = sigmoidf_(bf2f(G[(size_t)rloc * NP1 + 256 * (cg >> 7) + (cg & 127)])) * v; return 0.f; } };
struct SkMerge { bf16* O; const float* P; const bf16* G; int c0; __device__ __forceinline__ float operator()(int rloc, int c, float v) const { const int cg = c0 + c; O[(size_t)rloc * DM + c] = (bf16)f2bf(P[(size_t)rloc * DM + c] + sigmoidf_(bf2f(G[(size_t)rloc * NP1 + 256 * (cg >> 7) + (cg & 127) + 128])) * v); return 0.f; } };
struct SkRes { bf16* HB; __device__ __forceinline__ float operator()(int rloc, int c, float v) const { const float h = bf2f(HB[(size_t)rloc * DM + c]) + v; HB[(size_t)rloc * DM + c] = (bf16)f2bf(h); return h; } };
constexpr int MR = 8192;
typedef float f32x16 __attribute__((ext_vector_type(16)));
__device__ __forceinline__ void sk_glds16(const void* gsrc, unsigned lds_dst) { unsigned keep;
    asm volatile("s_mov_b32 %0, m0\n\ts_mov_b32 m0, %2\n\ts_nop 0\n\tglobal_load_lds_dwordx4 %1, off\n\ts_mov_b32 m0, %0" : "=&s"(keep) : "v"(gsrc), "s"(lds_dst) : "memory"); }
template <class F, class = void> struct sk_has_split { static constexpr bool value = false; };
template <class F> struct sk_has_split<F, decltype((void)F::SPLIT)> { static constexpr bool value = F::SPLIT; };
template <int NT, int GPI, class F>
__device__ __forceinline__ void skinny_unit(const Ctx& C, const bf16* __restrict__ A, int lda, const bf16* __restrict__ Bt, int ldb, int K, float* ss_out  , int ss_ld, int ss_col0, const F& epi) {
    const int lane = C.lane, w = C.wave, r32 = lane & 31, hh = lane >> 5;
    f32x16 acc[NT];
#pragma unroll
    for (int nt = 0; nt < NT; ++nt) acc[nt] = (f32x16){};
    const int kper = K >> 3, ngroups = kper >> 6;
    const unsigned stg = (unsigned)__builtin_amdgcn_readfirstlane((unsigned)(uintptr_t)(C.lds + RING_OFF) + (unsigned)w * 16384u);
    LAS unsigned char* stp = C.lds + RING_OFF + w * 16384;
    const int prow = lane >> 3, pch = lane & 7;
    const int foff = r32 * 128;
    const int fsw = (r32 >> 1) & 7;
    constexpr int GI = (4 / (1 + NT)) < GPI ? (4 / (1 + NT)) : GPI;
    if constexpr (NT == 3 && GPI == 2) {
        const size_t kb0 = (size_t)w * kper * 2;
#pragma unroll
        for (int g = 0; g < 4; ++g)
#pragma unroll
            for (int p = 0; p < 4; ++p) { const int row = 8 * p + prow; const int lg = pch ^ ((row >> 1) & 7);
                sk_glds16((const unsigned char*)A + (size_t)row * lda * 2 + kb0 + g * 128 + lg * 16, stg + g * 4096 + p * 1024); }
        size_t zo = 0; asm volatile("" : "+s"(zo));
        const bf16* bp = Bt + zo + (size_t)(4 * w) * 12 * 512 + lane * 8;
        bf16x8 b0[3][4], b1[3][4];
#define SK_LOADB(dst_, g_) do { _Pragma("unroll") for (int nt = 0; nt < 3; ++nt) _Pragma("unroll") for (int s = 0; s < 4; ++s) dst_[nt][s] = *(const bf16x8*)(bp + (((g_) * 3 + nt) * 4 + s) * 512); } while (0)
#define SK_MMA(src_, g_) do { bf16x8 a[4]; _Pragma("unroll") for (int s = 0; s < 4; ++s) a[s] = *(const LAS bf16x8*)(stp + (g_) * 4096 + foff + (((2 * s + hh) ^ fsw) << 4)); \
        _Pragma("unroll") for (int s = 0; s < 4; ++s) _Pragma("unroll") for (int nt = 0; nt < 3; ++nt) acc[nt] = __builtin_amdgcn_mfma_f32_32x32x16_bf16(a[s], src_[nt][s], acc[nt], 0, 0, 0); } while (0)
        SK_LOADB(b0, 0); SK_LOADB(b1, 1);
        asm volatile("s_waitcnt vmcnt(0)" ::: "memory");
        __builtin_amdgcn_sched_barrier(0);
        SK_MMA(b0, 0);
        __builtin_amdgcn_sched_barrier(0);
        SK_LOADB(b0, 2);
        __builtin_amdgcn_sched_barrier(0);
        SK_MMA(b1, 1);
        __builtin_amdgcn_sched_barrier(0);
        SK_LOADB(b1, 3);
        __builtin_amdgcn_sched_barrier(0);
        SK_MMA(b0, 2);
        SK_MMA(b1, 3);
#undef SK_LOADB
#undef SK_MMA
        LDS_WAIT(); asm volatile("" ::: "memory");
    } else
#pragma unroll 1
    for (int g0 = 0; g0 < ngroups; g0 += GI) {
#pragma unroll
        for (int gi = 0; gi < GI; ++gi) {
            const size_t kbyte = ((size_t)w * kper + (size_t)(g0 + gi) * 64) * 2; const unsigned sg = stg + gi * (1 + NT) * 4096;
#pragma unroll
            for (int p = 0; p < 4; ++p) { const int row = 8 * p + prow; const int lg = pch ^ ((row >> 1) & 7);
                sk_glds16((const unsigned char*)A + (size_t)row * lda * 2 + kbyte + lg * 16, sg + p * 1024); }
#pragma unroll
            for (int nt = 0; nt < NT; ++nt)
#pragma unroll
                for (int p = 0; p < 4; ++p) { const int row = 8 * p + prow; const int lg = pch ^ ((row >> 1) & 7);
                    sk_glds16((const unsigned char*)Bt + (size_t)(nt * 32 + row) * ldb * 2 + kbyte + lg * 16, sg + 4096 * (1 + nt) + p * 1024); }
        }
        asm volatile("s_waitcnt vmcnt(0)" ::: "memory");
#pragma unroll
        for (int gi = 0; gi < GI; ++gi) {
            LAS unsigned char* sp = stp + gi * (1 + NT) * 4096;
            bf16x8 a[4], bv[NT][4];
#pragma unroll
            for (int s = 0; s < 4; ++s) { const int o = foff + (((2 * s + hh) ^ fsw) << 4); a[s] = *(const LAS bf16x8*)(sp + o);
#pragma unroll
                for (int nt = 0; nt < NT; ++nt) bv[nt][s] = *(const LAS bf16x8*)(sp + 4096 * (1 + nt) + o); }
            __builtin_amdgcn_sched_barrier(0);
#pragma unroll
            for (int s = 0; s < 4; ++s)
#pragma unroll
                for (int nt = 0; nt < NT; ++nt) acc[nt] = __builtin_amdgcn_mfma_f32_32x32x16_bf16(a[s], bv[nt][s], acc[nt], 0, 0, 0);
        }
        LDS_WAIT(); asm volatile("" ::: "memory");
    }
    LDS_WAIT(); __syncthreads();
    LAS float* part = (LAS float*)(C.lds + RING_OFF);
#pragma unroll
    for (int nt = 0; nt < NT; ++nt)
#pragma unroll
        for (int i = 0; i < 16; ++i) part[(w * NT * 16 + nt * 16 + i) * 64 + lane] = acc[nt][i];
    LDS_WAIT(); __syncthreads();
    int lane_e = lane; asm volatile("" : "+v"(lane_e));
    const int r32e = lane_e & 31, hhe = lane_e >> 5;
#pragma unroll
    for (int j = 0; j < 2 * NT; ++j) { const int e = (w + 8 * j) * 64 + lane;
        const int nti = w + 8 * j, nt = nti >> 4, i = nti & 15;
        float v = 0.f, vhi = 0.f;
#pragma unroll
        for (int ww = 0; ww < 4; ++ww) v += part[ww * NT * 1024 + e];
#pragma unroll
        for (int ww = 4; ww < 8; ++ww) vhi += part[ww * NT * 1024 + e];
        const int rloc = (i & 3) + 8 * (i >> 2) + 4 * hhe, c = nt * 32 + r32e;
        float sv;
        if constexpr (sk_has_split<F>::value) sv = epi.split(rloc, c, v, vhi); else sv = epi(rloc, c, v + vhi);
        if (ss_out != nullptr) { sv = sv * sv;
#pragma unroll
            for (int o = 1; o < 32; o <<= 1) sv += __shfl_xor(sv, o);
            if (r32e == 0) ss_out[(size_t)rloc * ss_ld + ss_col0 + nt] = sv; }
        __builtin_amdgcn_sched_barrier(0);
    }
    LDS_WAIT(); __syncthreads();
}
__device__ __forceinline__ void skinny_rstd(const Ctx& C, const float* __restrict__ rs, int np, float inv_dim, LAS float* tbl) {
    if (C.tid < 32) { float s = 0.f; const f32x4* p = (const f32x4*)(rs + (size_t)C.tid * np);
        for (int j = 0; j < np / 4; ++j) { const f32x4 v = p[j]; s += (v[0] + v[1]) + (v[2] + v[3]); }
        tbl[C.tid] = rsqrtf(s * inv_dim + RMS_EPS); }
    LDS_WAIT(); __syncthreads();
}

typedef short s16x4 __attribute__((ext_vector_type(4)));
typedef unsigned short u16x4 __attribute__((ext_vector_type(4)));
constexpr int DS_ISC = RING_OFF, DS_ISC_WORDS = 4128, DS_ISC_STRIDE = DS_ISC_WORDS * 4;
constexpr int DS_SEL = DS_ISC + 8 * DS_ISC_STRIDE;
constexpr int DS_SELR = DS_SEL + 8 * 512;
constexpr int DS_BIAS = DS_SELR + 8 * 512;
constexpr int DS_QROW = DS_BIAS + 8192;
constexpr int DS_END = DS_QROW + 256;
constexpr size_t OL_BLOCK = (size_t)3 * 16 * 8 * 64 * 8;
static_assert(DS_END <= LDS_BYTES, "DSA LDS map");

__device__ __forceinline__ void glds16(const void* gsrc, unsigned lds_dst) { unsigned keep;
    asm volatile("s_mov_b32 %0, m0\n\ts_mov_b32 m0, %2\n\ts_nop 0\n\tglobal_load_lds_dwordx4 %1, off\n\ts_mov_b32 m0, %0" : "=&s"(keep) : "v"(gsrc), "s"(lds_dst) : "memory"); }
__device__ __forceinline__ float relu1(float x) { const int i = __float_as_int(x); return __int_as_float(i > 0 ? i : 0); }
__device__ __forceinline__ void glds16o(const void* base, unsigned voff, unsigned lds_dst) { unsigned keep;
    asm volatile("s_mov_b32 %0, m0\n\ts_mov_b32 m0, %3\n\ts_nop 0\n\tglobal_load_lds_dwordx4 %1, %2\n\ts_mov_b32 m0, %0" : "=&s"(keep) : "v"(voff), "s"(base), "s"(lds_dst) : "memory"); }
__device__ __forceinline__ s16x4 tr_read(LAS unsigned char* p) { typedef short v4i16_t __attribute__((ext_vector_type(4))); return __builtin_bit_cast(s16x4, __builtin_amdgcn_ds_read_tr16_b64_v4i16((LAS v4i16_t*)p)); }
__device__ __forceinline__ unsigned cvtpk(float lo, float hi) { typedef float f2_t __attribute__((ext_vector_type(2))); typedef __bf16 b2_t __attribute__((ext_vector_type(2))); f2_t v = {lo, hi}; b2_t b = __builtin_convertvector(v, b2_t); return __builtin_bit_cast(unsigned, b); }

#define DSA_LOCALS() const int w = C.wave; LAS unsigned* ISC = (LAS unsigned*)(C.lds + DS_ISC); LAS unsigned short* sel = (LAS unsigned short*)(C.lds + DS_SEL) + w * 256; const LAS float* biasl = (const LAS float*)(C.lds + DS_BIAS); (void)ISC; (void)sel; (void)biasl
#define RELANE() do { asm volatile("" : "+v"(lane)); asm volatile("" : "+s"(t0), "+s"(b)); } while (0)
__device__ __forceinline__ void dsa_step1(const Ctx& C, const Bufs& B, int b, int t0) {
    int lane = C.lane; RELANE(); DSA_LOCALS();
    PROBE_T0();
    {
        const int r32 = lane & 31, hh = lane >> 5;
        bf16x8 qa[2][4]; float wq[2][2][8];
        const int qi = 2 * ((r32 >> 2) & 1) + (r32 >> 4), hA = (r32 & 3) + 4 * ((r32 >> 3) & 1);
#pragma unroll
        for (int g = 0; g < 2; ++g) { const int row = rowof(b, t0 + 4 * g + qi);
#pragma unroll
            for (int s = 0; s < 4; ++s) qa[g][s] = *(const bf16x8*)(B.Q2 + (size_t)row * NQ2 + 4096 + hA * 64 + 16 * s + 8 * hh);
#pragma unroll
            for (int j = 0; j < 2; ++j) { const int rw = rowof(b, t0 + 4 * g + 2 * hh + j); const v4u ww = *(const v4u*)(B.PROJ + (size_t)rw * NP1 + PC_WIDX);
                const float sc = 0.35355339059327373f * 0.125f;
                wq[g][j][0] = pg8::bf_lo(ww.x) * sc; wq[g][j][1] = pg8::bf_hi(ww.x) * sc; wq[g][j][2] = pg8::bf_lo(ww.y) * sc; wq[g][j][3] = pg8::bf_hi(ww.y) * sc;
                wq[g][j][4] = pg8::bf_lo(ww.z) * sc; wq[g][j][5] = pg8::bf_hi(ww.z) * sc; wq[g][j][6] = pg8::bf_lo(ww.w) * sc; wq[g][j][7] = pg8::bf_hi(ww.w) * sc; } }
        PROBE_T1(40);
        const int nkeys = t0 + 8, nkt = (nkeys + 31) >> 5;
        bf16x8 kA[4], kB[4];
#define IDX_LOAD(dst, kt_) do { const bf16* kp_ = B.KIDX + (size_t)(b * 129 + (kt_)) * 2048 + 8 * lane; \
        asm volatile("global_load_dwordx4 %0, %4, off\n\tglobal_load_dwordx4 %1, %4, off offset:1024\n\tglobal_load_dwordx4 %2, %4, off offset:2048\n\tglobal_load_dwordx4 %3, %4, off offset:3072" \
                     : "=&v"(dst[0]), "=&v"(dst[1]), "=&v"(dst[2]), "=&v"(dst[3]) : "v"(kp_) : "memory"); } while (0)
#define IDX_WAIT(cur) asm volatile("s_waitcnt vmcnt(12)" : "+v"(cur[0]), "+v"(cur[1]), "+v"(cur[2]), "+v"(cur[3]) :: "memory")
#define IDX_TILE(src, kt_) do { const int key_ = (kt_) * 32 + r32; \
        _Pragma("unroll") for (int g = 0; g < 2; ++g) { f32x16 acc = {}; \
            _Pragma("unroll") for (int s = 0; s < 4; ++s) acc = __builtin_amdgcn_mfma_f32_32x32x16_bf16(qa[g][s], src[s], acc, 0, 0, 0); \
            _Pragma("unroll") for (int j = 0; j < 2; ++j) { pg8::f32x2 i2 = {0.f, 0.f};     \
                _Pragma("unroll") for (int h = 0; h < 8; h += 2) { const pg8::f32x2 r2 = {relu1(acc[8 * j + h]), relu1(acc[8 * j + h + 1])}, w2 = {wq[g][j][h], wq[g][j][h + 1]}; i2 = __builtin_elementwise_fma(r2, w2, i2); } \
                const float isc = i2[0] + i2[1]; \
                ISC[(4 * g + 2 * hh + j) * DS_ISC_WORDS + key_] = f2key(isc); } } } while (0)
        bf16x8 kC[4], kD[4];
        int kt = w;
        const int ktl = nkt - 1;
        if (kt < nkt) {
            __builtin_amdgcn_s_waitcnt(0x0F70);
            IDX_LOAD(kA, kt); IDX_LOAD(kB, (kt + 8 < nkt ? kt + 8 : ktl)); IDX_LOAD(kC, (kt + 16 < nkt ? kt + 16 : ktl));
#define IDX_STEP(cur, nxt) { IDX_LOAD(nxt, (kt + 24 < nkt ? kt + 24 : ktl)); IDX_WAIT(cur); __builtin_amdgcn_sched_barrier(0); IDX_TILE(cur, kt); __builtin_amdgcn_sched_barrier(0); kt += 8; if (kt >= nkt) break; }
#pragma unroll 1
            for (;;) {
                IDX_STEP(kA, kD)
                IDX_STEP(kB, kA)
                IDX_STEP(kC, kB)
                IDX_STEP(kD, kC)
            }
#undef IDX_STEP
            asm volatile("s_waitcnt vmcnt(0)" : "+v"(kA[0]), "+v"(kA[1]), "+v"(kA[2]), "+v"(kA[3]), "+v"(kB[0]), "+v"(kB[1]), "+v"(kB[2]), "+v"(kB[3]) :: "memory");
            asm volatile("" : "+v"(kC[0]), "+v"(kC[1]), "+v"(kC[2]), "+v"(kC[3]), "+v"(kD[0]), "+v"(kD[1]), "+v"(kD[2]), "+v"(kD[3]) :: "memory");
        }
#undef IDX_WAIT
#undef IDX_LOAD
#undef IDX_TILE
        PROBE_T1(41);
    }
}
#define DSA_DPP(v_, ctrl_, rmask_, ident_) __builtin_amdgcn_update_dpp((ident_), (v_), (ctrl_), (rmask_), 0xf, false)
__device__ __forceinline__ unsigned wave_umax_dpp(unsigned v) { unsigned t;
    t = (unsigned)DSA_DPP((int)v, 0x111, 0xf, 0); v = t > v ? t : v; t = (unsigned)DSA_DPP((int)v, 0x112, 0xf, 0); v = t > v ? t : v; t = (unsigned)DSA_DPP((int)v, 0x114, 0xf, 0); v = t > v ? t : v; t = (unsigned)DSA_DPP((int)v, 0x118, 0xf, 0); v = t > v ? t : v;
    t = (unsigned)DSA_DPP((int)v, 0x142, 0xa, 0); v = t > v ? t : v; t = (unsigned)DSA_DPP((int)v, 0x143, 0xc, 0); v = t > v ? t : v;
    return (unsigned)__builtin_amdgcn_readlane((int)v, 63); }
__device__ __forceinline__ unsigned wave_umin_dpp(unsigned v) { return ~wave_umax_dpp(~v); }
__device__ __forceinline__ float wave_fadd_dpp(float v) {
    v += __int_as_float(DSA_DPP(__float_as_int(v), 0x111, 0xf, 0)); v += __int_as_float(DSA_DPP(__float_as_int(v), 0x112, 0xf, 0)); v += __int_as_float(DSA_DPP(__float_as_int(v), 0x114, 0xf, 0)); v += __int_as_float(DSA_DPP(__float_as_int(v), 0x118, 0xf, 0));
    v += __int_as_float(DSA_DPP(__float_as_int(v), 0x142, 0xa, 0)); v += __int_as_float(DSA_DPP(__float_as_int(v), 0x143, 0xc, 0));
    return __int_as_float(__builtin_amdgcn_readlane(__float_as_int(v), 63)); }
__device__ __forceinline__ float xmax16(float x) { const auto r = __builtin_amdgcn_permlane16_swap(__float_as_uint(x), __float_as_uint(x), false, false); return fmaxf(__uint_as_float(r[0]), __uint_as_float(r[1])); }
__device__ __forceinline__ float xmax32(float x) { const auto r = __builtin_amdgcn_permlane32_swap(__float_as_uint(x), __float_as_uint(x), false, false); return fmaxf(__uint_as_float(r[0]), __uint_as_float(r[1])); }
__device__ __forceinline__ float xadd16(float x) { const auto r = __builtin_amdgcn_permlane16_swap(__float_as_uint(x), __float_as_uint(x), false, false); return __uint_as_float(r[0]) + __uint_as_float(r[1]); }
__device__ __forceinline__ float xadd32(float x) { const auto r = __builtin_amdgcn_permlane32_swap(__float_as_uint(x), __float_as_uint(x), false, false); return __uint_as_float(r[0]) + __uint_as_float(r[1]); }
__device__ __forceinline__ int dsa_step2(const Ctx& C, int b, int t0) {
    int lane = C.lane; RELANE(); DSA_LOCALS();
    const int t = t0 + w, n = t + 1;
    int cnt;
    if (n <= TOPK) { for (int j = lane; j < n; j += 64) sel[j] = (unsigned short)j; cnt = n; }
    else {
        const LAS unsigned* myrow = ISC + w * DS_ISC_WORDS;
        const int nI = (n + 255) >> 8;
        unsigned v[68];
#pragma unroll
        for (int i = 0; i < 17; ++i) { const pg8::u32x4 x = *(const LAS pg8::u32x4*)(myrow + 256 * i + 4 * lane);
#pragma unroll
            for (int e = 0; e < 4; ++e) v[4 * i + e] = (256 * i + 4 * lane + e <= t) ? x[e] : 0u; }
        unsigned T = 0u; bool exact = false;
#define DSA_COUNT(res, cand_) do { int c_ = 0; const unsigned t_ = (cand_); \
        _Pragma("unroll") for (int i = 0; i < 17; ++i) { if (i < nI) { unsigned long long m0_, m1_, m2_, m3_; \
            asm volatile("v_cmp_ge_u32_e64 %1, %5, %9\n\tv_cmp_ge_u32_e64 %2, %6, %9\n\tv_cmp_ge_u32_e64 %3, %7, %9\n\tv_cmp_ge_u32_e64 %4, %8, %9\n\t" \
                         "v_addc_co_u32_e64 %0, %1, 0, %0, %1\n\tv_addc_co_u32_e64 %0, %2, 0, %0, %2\n\tv_addc_co_u32_e64 %0, %3, 0, %0, %3\n\tv_addc_co_u32_e64 %0, %4, 0, %0, %4" \
                         : "+v"(c_), "=&s"(m0_), "=&s"(m1_), "=&s"(m2_), "=&s"(m3_) : "v"(v[4 * i]), "v"(v[4 * i + 1]), "v"(v[4 * i + 2]), "v"(v[4 * i + 3]), "v"(t_)); } } \
        int tot_ = 0; _Pragma("unroll") for (int bt = 0; bt < 7; ++bt) tot_ += __popcll(__ballot((c_ >> bt) & 1)) << bt; res = tot_; } while (0)
        {
            unsigned kmax = 0u, kmin = 0xfffffffeu;
#pragma unroll
            for (int i = 0; i < 17; ++i) { if (i < nI) {
#pragma unroll
                for (int e = 0; e < 4; e += 2) { const unsigned x0 = v[4 * i + e], x1 = v[4 * i + e + 1]; const unsigned mx = x0 > x1 ? x0 : x1; kmax = mx > kmax ? mx : kmax;
                    const unsigned y0 = x0 - 1u, y1 = x1 - 1u, mn = y0 < y1 ? y0 : y1; kmin = mn < kmin ? mn : kmin; } } }
            kmin += 1u;
            kmax = wave_umax_dpp(kmax); kmin = wave_umin_dpp(kmin);
#define DSA_K2F(k_) __uint_as_float(((k_) & 0x80000000u) ? ((k_) & 0x7fffffffu) : ~(k_))
            float lo = DSA_K2F(kmin), hi = DSA_K2F(kmax), flo = (float)(n - TOPK), fhi = (float)(1 - TOPK); int side = 0;
            float x0, dens;
            { float s1 = 0.f, s2 = 0.f;
#pragma unroll
              for (int e = 0; e < 4; ++e) { const float f = DSA_K2F(v[e]); s1 += f; s2 = fmaf(f, f, s2); }
              s1 = wave_fadd_dpp(s1); s2 = wave_fadd_dpp(s2);
              const float mu = s1 * (1.0f / 256.0f), var = fmaxf(s2 * (1.0f / 256.0f) - mu * mu, 1e-30f), sd = sqrtf(var);
              const float q = fmaxf(1.0f - (float)TOPK / (float)n, 0.03f), r = q - 0.5f, t2 = r * r;
              const float zn = (((((-3.969683028665376e+01f * t2 + 2.209460984245205e+02f) * t2 - 2.759285104469687e+02f) * t2 + 1.383577518672690e+02f) * t2 - 3.066479806614716e+01f) * t2 + 2.506628277459239e+00f) * r;
              const float zd = ((((-5.447609879822406e+01f * t2 + 1.615858368580409e+02f) * t2 - 1.556989798598866e+02f) * t2 + 6.680131188771972e+01f) * t2 - 1.328068155288572e+01f) * t2 + 1.0f;
              const float z = zn / zd;
              x0 = mu + z * sd; dens = (float)n * __expf(-0.5f * z * z) * 0.3989422804f / sd; }
            float xl = 0.f; int cl = TOPK;
#pragma unroll 1
            for (int it = 0; it < 22 && !exact; ++it) {
                float x = (lo * fhi - hi * flo) / (fhi - flo);
                if (it == 0) x = x0; else if (it == 1) x = xl + 1.5f * (float)(cl - TOPK) / dens;
                if (!(x > lo && x < hi)) x = (it < 2) ? (lo * fhi - hi * flo) / (fhi - flo) : x;
                if (!(x > lo && x < hi)) x = 0.5f * (lo + hi);
                if (!(x > lo && x < hi)) break;
                const unsigned cand = f2key(x); int c;
                DSA_COUNT(c, cand);
                xl = x; cl = c;
                if (c == TOPK) { T = cand; exact = true; }
                else if (c > TOPK) { lo = x; flo = (float)(c - TOPK); if (side == 1) fhi *= 0.5f; side = 1; }
                else { hi = x; fhi = (float)(c - TOPK); if (side == -1) flo *= 0.5f; side = -1; }
            }
#undef DSA_K2F
        }
        if (!exact) {
            T = 0u;
#pragma unroll 1
            for (int bit = 31; bit >= 0; --bit) {
                const unsigned cand = T | (1u << bit); int c;
                DSA_COUNT(c, cand);
                if (c >= TOPK) { T = cand; if (c == TOPK) { exact = true; break; } }
            }
            if (!exact) { int c; DSA_COUNT(c, T); exact = (c == TOPK); }
        }
#undef DSA_COUNT
        int base = 0;
#pragma unroll
        for (int k = 0; k < 68; ++k) { const bool p = exact ? (v[k] >= T) : (v[k] > T); const unsigned long long m = __ballot(p);
            const int pos = (int)__builtin_amdgcn_mbcnt_hi((unsigned)(m >> 32), __builtin_amdgcn_mbcnt_lo((unsigned)m, (unsigned)base));
            if (p) sel[pos] = (unsigned short)(256 * (k >> 2) + 4 * lane + (k & 3));
            base += __popcll(m); }
        if (!exact) {
            int last = -1;
            while (base < TOPK) { int mi = 0x7fffffff;
#pragma unroll
                for (int k = 0; k < 68; ++k) { const int idx = 256 * (k >> 2) + 4 * lane + (k & 3); if (v[k] == T && idx > last && idx < mi) mi = idx; }
#pragma unroll
                for (int o = 1; o < 64; o <<= 1) { const int oth = __shfl_xor(mi, o); mi = oth < mi ? oth : mi; }
                if (lane == 0) sel[base] = (unsigned short)mi;
                last = mi; ++base; }
        }
        cnt = TOPK;
    }
    { LDS_WAIT(); asm volatile("" ::: "memory");
      LAS unsigned short* selr = (LAS unsigned short*)(C.lds + DS_SELR) + w * 256;
      const u16x4 p4 = *(const LAS u16x4*)(sel + 4 * lane); u16x4 r4;
#pragma unroll
      for (int e = 0; e < 4; ++e) { const int pos = (int)p4[e]; r4[e] = (unsigned short)((4 * lane + e < cnt) ? rowof(b, pos) : 0); }
      *(LAS u16x4*)(selr + 4 * lane) = r4; }
    return cnt;
}
__device__ __forceinline__ void dsa_step3(const Ctx& C, const Bufs& B, int b, int t0, int cnt, int qslot) {
    int lane = C.lane; RELANE(); DSA_LOCALS(); const int t = t0 + w;
    {
        const int g = lane >> 4, c16 = lane & 15, rowq = rowof(b, t);
        bf16x8 qf[8];
#pragma unroll
        for (int s = 0; s < 8; ++s) qf[s] = *(const bf16x8*)(B.Q2 + (size_t)rowq * NQ2 + c16 * 256 + 32 * s + 8 * g);
        f32x4 O[16];
#pragma unroll
        for (int rt = 0; rt < 16; ++rt) O[rt] = (f32x4){0.f, 0.f, 0.f, 0.f};
        float m_ref = 0.f, lsum = 0.f;
        const int buf0 = DS_ISC + w * DS_ISC_STRIDE;
        const int npairs = (cnt + 31) >> 5;
        const int swz = (c16 & 7) << 1;
        const int trow = 4 * g + (c16 >> 2), tswz = (trow & 7) << 1, tp = c16 & 3;
        const int arow = (c16 & 7) * 1024 + (c16 >> 3) * 512, trowo = (trow & 7) * 1024 + (trow >> 3) * 512;
        const unsigned ldsb = (unsigned)(uintptr_t)(C.lds + buf0);
        const LAS unsigned short* selr = (const LAS unsigned short*)(C.lds + DS_SELR) + w * 256; const unsigned l4 = (unsigned)(lane & 31) << 4;
#define DSA_GATHER(c_) do { const unsigned bo_ = (unsigned)__builtin_amdgcn_readfirstlane(ldsb + ((c_) & 1) * 8192); \
        const pg8::u32x4 sp_ = *(const LAS pg8::u32x4*)(selr + 16 * (c_) + 8 * (lane >> 5)); const unsigned spw_[4] = {sp_.x, sp_.y, sp_.z, sp_.w}; \
        _Pragma("unroll") for (int p = 0; p < 8; ++p) { const unsigned row_ = (p & 1) ? (spw_[p >> 1] >> 16) : (spw_[p >> 1] & 0xffffu); \
            glds16o(B.CKVN, ((row_ << 9) | l4) ^ (unsigned)(p << 5), bo_ + p * 1024); } } while (0)
        DSA_GATHER(0); DSA_GATHER(1);
#pragma unroll 1
        for (int kp = 0; kp < npairs; ++kp) {
            asm volatile("s_waitcnt vmcnt(0)" ::: "memory");
            bf16x8 a0[8], a1[8]; s16x4 v0[16], v1[16];
#pragma unroll
            for (int s = 0; s < 8; ++s) { const int off = arow + (((4 * s + g) ^ swz) << 4); a0[s] = *(const LAS bf16x8*)(C.lds + buf0 + off); a1[s] = *(const LAS bf16x8*)(C.lds + buf0 + 8192 + off); }
            const u16x4 p0 = *(const LAS u16x4*)(sel + 32 * kp + 4 * g), p1 = *(const LAS u16x4*)(sel + 32 * kp + 16 + 4 * g);
            __builtin_amdgcn_sched_barrier(0);
            f32x4 s0 = {0.f, 0.f, 0.f, 0.f}, s1 = {0.f, 0.f, 0.f, 0.f};
#pragma unroll
            for (int s = 0; s < 8; ++s) { s0 = __builtin_amdgcn_mfma_f32_16x16x32_bf16(a0[s], qf[s], s0, 0, 0, 0); s1 = __builtin_amdgcn_mfma_f32_16x16x32_bf16(a1[s], qf[s], s1, 0, 0, 0); }
            __builtin_amdgcn_sched_barrier(0);
#pragma unroll
            for (int rt = 0; rt < 16; ++rt) { const int off = trowo + (((2 * rt + (tp >> 1)) ^ tswz) << 4) + 8 * (tp & 1); v0[rt] = tr_read(C.lds + buf0 + off); v1[rt] = tr_read(C.lds + buf0 + 8192 + off); }
            __builtin_amdgcn_sched_barrier(0);
            LDS_WAIT(); asm volatile("" ::: "memory");
            if (kp + 1 < npairs) { DSA_GATHER(2 * kp + 2); DSA_GATHER(2 * kp + 3); }
            __builtin_amdgcn_sched_barrier(0);
            float x0[4], x1[4]; float mloc = -INFINITY;
#pragma unroll
            for (int i = 0; i < 4; ++i) { const int j0 = 32 * kp + 4 * g + i, j1 = j0 + 16; int d0 = t - (int)p0[i], d1 = t - (int)p1[i]; d0 = d0 < 0 ? 0 : (d0 > 127 ? 127 : d0); d1 = d1 < 0 ? 0 : (d1 > 127 ? 127 : d1);
                const float b0 = biasl[d0 * 16 + c16], b1 = biasl[d1 * 16 + c16];
                const float y0 = 0.125f * s0[i] + b0, y1 = 0.125f * s1[i] + b1;
                x0[i] = (j0 < cnt) ? y0 : -INFINITY; x1[i] = (j1 < cnt) ? y1 : -INFINITY;
                mloc = fmaxf(mloc, fmaxf(x0[i], x1[i])); }
            mloc = xmax32(xmax16(mloc));
            if (kp == 0) m_ref = mloc;
            else if (__any(mloc > m_ref + 8.0f)) { const float mn = fmaxf(m_ref, mloc), al = __expf(m_ref - mn);
#pragma unroll
                for (int rt = 0; rt < 16; ++rt) O[rt] *= al;
                lsum *= al; m_ref = mn; }
            float pe0[4], pe1[4];
#pragma unroll
            for (int i = 0; i < 4; ++i) { pe0[i] = __expf(x0[i] - m_ref); pe1[i] = __expf(x1[i] - m_ref); lsum += pe0[i] + pe1[i]; }
            pg8::u32x4 pw; pw.x = cvtpk(pe0[0], pe0[1]); pw.y = cvtpk(pe0[2], pe0[3]); pw.z = cvtpk(pe1[0], pe1[1]); pw.w = cvtpk(pe1[2], pe1[3]);
            const bf16x8 pf = __builtin_bit_cast(bf16x8, pw);
#pragma unroll
            for (int rt = 0; rt < 16; ++rt) { const bf16x8 af = {v0[rt][0], v0[rt][1], v0[rt][2], v0[rt][3], v1[rt][0], v1[rt][1], v1[rt][2], v1[rt][3]};
                O[rt] = __builtin_amdgcn_mfma_f32_16x16x32_bf16(af, pf, O[rt], 0, 0, 0); }
            LDS_WAIT(); asm volatile("" ::: "memory");
        }
#undef DSA_GATHER
        lsum = xadd32(xadd16(lsum));
        const float inv = 1.0f / lsum;
#pragma unroll
        for (int rt = 0; rt < 16; ++rt) { const f32x4 o = O[rt] * inv; pg8::u32x2 wv; wv.x = cvtpk(o[0], o[1]); wv.y = cvtpk(o[2], o[3]);
            const int s_ = rt >> 1, gp = 2 * (rt & 1) + (g >> 1), jo = 4 * (g & 1);
            *(pg8::u32x2*)(B.OLAT + (size_t)C.bid * OL_BLOCK + ((((size_t)(qslot >> 4) * 16 + c16) * 8 + s_) * 64 + gp * 16 + (qslot & 15)) * 8 + jo) = wv; }
    }
}
__device__ __forceinline__ void dsa_wuv(const Ctx& C, const Bufs& B, int l, int nq) {
    const int lane = C.lane, w = C.wave, g = lane >> 4, c16 = lane & 15;
    const LAS int* qrow = (const LAS int*)(C.lds + DS_QROW);
    const int nmt = (nq + 15) >> 4;
#pragma unroll 1
    for (int hq = 0; hq < 2; ++hq) { const int h = 2 * w + hq;
        f32x4 Dv[3][4];
#pragma unroll
        for (int mt = 0; mt < 3; ++mt)
#pragma unroll
            for (int nt = 0; nt < 4; ++nt) Dv[mt][nt] = (f32x4){0.f, 0.f, 0.f, 0.f};
        const bf16* wb = B.WUV + (((size_t)l * 16 + h) * 32) * 512 + lane * 8;
        const bf16* ab = B.OLAT + (size_t)C.bid * OL_BLOCK + ((size_t)h * 8) * 512 + lane * 8;
        v4u zw[3][2];
        { const int slot = lane >> 2, d0 = (lane & 3) * 16;
#pragma unroll
          for (int mt = 0; mt < 3; ++mt) { const int q = mt * 16 + slot; const int row = qrow[q < nq ? q : 0];
#pragma unroll
              for (int hf = 0; hf < 2; ++hf) zw[mt][hf] = *(const v4u*)(B.PROJ + (size_t)row * NP1 + PC_ZB + h * 64 + d0 + 8 * hf); } }
        bf16x8 bw[4][4], aw[4][3];
#define WUV_LOAD(set_, s_) do { _Pragma("unroll") for (int nt = 0; nt < 4; ++nt) bw[set_][nt] = *(const bf16x8*)(wb + ((s_) * 4 + nt) * 512); \
        _Pragma("unroll") for (int mt = 0; mt < 3; ++mt) { aw[set_][mt] = *(const bf16x8*)(ab + ((size_t)mt * 16 * 8 + (s_)) * 512);     } } while (0)
#define WUV_MMA(set_) do { _Pragma("unroll") for (int mt = 0; mt < 3; ++mt) _Pragma("unroll") for (int nt = 0; nt < 4; ++nt) Dv[mt][nt] = __builtin_amdgcn_mfma_f32_16x16x32_bf16(aw[set_][mt], bw[set_][nt], Dv[mt][nt], 0, 0, 0); } while (0)
        WUV_LOAD(0, 0); WUV_LOAD(1, 1); WUV_LOAD(2, 2); WUV_LOAD(3, 3);
#pragma unroll
        for (int s = 0; s < 8; ++s) {
            __builtin_amdgcn_sched_barrier(0);
            WUV_MMA(s & 3);
            __builtin_amdgcn_sched_barrier(0);
            if (s + 4 < 8) WUV_LOAD(s & 3, s + 4);
        }
        __builtin_amdgcn_sched_barrier(0);
#undef WUV_LOAD
#undef WUV_MMA
        LAS float* stg = (LAS float*)(C.lds + RING_OFF + w * 4608);
#pragma unroll
        for (int mt = 0; mt < 3; ++mt) { if (mt < nmt) {
#pragma unroll
            for (int nt = 0; nt < 4; ++nt)
#pragma unroll
                for (int i = 0; i < 4; ++i) stg[(4 * g + i) * 68 + 16 * nt + c16] = Dv[mt][nt][i];
            LDS_WAIT(); asm volatile("" ::: "memory");
            const int slot = lane >> 2, q = mt * 16 + slot, d0 = (lane & 3) * 16;
            if (q < nq) { const int row = qrow[q]; const v4u zw_[2] = {zw[mt][0], zw[mt][1]};
                bf16* op = B.YB + (size_t)row * YLD + h * 64 + d0;
#pragma unroll
                for (int hf = 0; hf < 2; ++hf) { const v4u zw = zw_[hf];
                    const f32x4 xa = *(const LAS f32x4*)(stg + slot * 68 + d0 + 8 * hf), xb = *(const LAS f32x4*)(stg + slot * 68 + d0 + 8 * hf + 4);
                    v4u o; o.x = pk2(xa[0] * siluf_(pg8::bf_lo(zw.x)), xa[1] * siluf_(pg8::bf_hi(zw.x))); o.y = pk2(xa[2] * siluf_(pg8::bf_lo(zw.y)), xa[3] * siluf_(pg8::bf_hi(zw.y)));
                    o.z = pk2(xb[0] * siluf_(pg8::bf_lo(zw.z)), xb[1] * siluf_(pg8::bf_hi(zw.z))); o.w = pk2(xb[2] * siluf_(pg8::bf_lo(zw.w)), xb[3] * siluf_(pg8::bf_hi(zw.w)));
                    *(v4u*)(op + 8 * hf) = o; } }
            LDS_WAIT(); asm volatile("" ::: "memory"); } }
    }
}
#ifndef MK_DSUB
#define MK_DSUB 0
#endif
__device__ __forceinline__ void dsa_unit(const Ctx& C, const Bufs& B, int l, int b, int t0, int uidx) {
    { PROBE_T0(); for (int rep = 0; rep < ((MK_DSUB & 1) ? 2 : 1); ++rep) { dsa_step1(C, B, b, t0); LDS_WAIT(); PROBE_T1(10); __syncthreads(); } PROBE_T1(0); }
    int cnt = 0;
    { PROBE_T0(); for (int rep = 0; rep < ((MK_DSUB & 2) ? 2 : 1); ++rep) { cnt = dsa_step2(C, b, t0); LDS_WAIT(); asm volatile("" ::: "memory"); } PROBE_T1(1); }
    if (C.lane == 0) ((LAS int*)(C.lds + DS_QROW))[uidx * 8 + C.wave] = rowof(b, t0 + C.wave);
    { PROBE_T0(); for (int rep = 0; rep < ((MK_DSUB & 4) ? 2 : 1); ++rep) { dsa_step3(C, B, b, t0, cnt, uidx * 8 + C.wave); } PROBE_T1(2); }
}
#undef RELANE
#undef DSA_LOCALS

__device__ __forceinline__ void dsa_phase(const Ctx& C, int l) {
    const Bufs B(kargs()->ws);
    const KArgs& A = *kargs();
    gu32* qctr = (gu32*)(A.ws + WS_CTL) + CW_DSAQ + l * 128;
    LAS int* qslot = (LAS int*)(C.lds + DS_QROW) + 56;
    int nu = 0, myb = C.bid & 1; bool other = false;
    int s_next = 0;
#define DSA_GRAB_ISSUE() do { if (C.tid == 0) s_next = (int)__hip_atomic_fetch_add(qctr + myb * 64, 1u, __ATOMIC_RELAXED, __HIP_MEMORY_SCOPE_AGENT); } while (0)
#define DSA_GRAB_FINISH() do { if (C.tid == 0) { int s_ = s_next; \
        if (s_ >= 514 && !other) { s_ = (int)__hip_atomic_fetch_add(qctr + (myb ^ 1) * 64, 1u, __ATOMIC_RELAXED, __HIP_MEMORY_SCOPE_AGENT); s_ = s_ < 514 ? s_ + 1024 : -1; } \
        else if (s_ >= 514) s_ = -1; \
        qslot[0] = s_; } } while (0)
    DSA_GRAB_ISSUE();
    for (int i = C.tid; i < 128 * 16; i += NWAVES * 64) { const int dd = i >> 4, h = i & 15; ((LAS float*)(C.lds + DS_BIAS))[i] = A.bias_table[t5_bucket(dd) * 32 + 16 + h]; }
    __syncthreads();
    DSA_GRAB_FINISH();
    LDS_WAIT(); __syncthreads();
    for (;;) {
        int s = qslot[0];
        const bool done = s < 0;
        if ((done && nu > 0) || nu == 6) {
            VM_WAIT(); LDS_WAIT(); __syncthreads(); { PROBE_T0(); dsa_wuv(C, B, l, nu * 8); PROBE_T1(3); } __syncthreads(); nu = 0; }
        if (done) break;
        int b = myb;
        if (s >= 1024) { s -= 1024; if (!other) { other = true; myb ^= 1; } b = myb; }
        DSA_GRAB_ISSUE();
        dsa_unit(C, B, l, b, 8 * (513 - s), nu); ++nu;
        DSA_GRAB_FINISH();
        { PROBE_T0(); LDS_WAIT(); __syncthreads(); PROBE_T1(7); }
    }
#undef DSA_GRAB_ISSUE
#undef DSA_GRAB_FINISH
    __syncthreads();
}

constexpr int VT_PITCH = 4128;
constexpr int SW_BIAS = RING_OFF;
constexpr int SW_WS = SW_BIAS + 8192;
constexpr int SW_STG = SW_WS + 1024;

constexpr int SW_Q = SW_STG, SW_WAVE = 16384, SW_SLOT = 4096;
__device__ __forceinline__ void swa_item(const Ctx& C, const Bufs& B, const float* __restrict__ sinks, int b, int head, int p0, bool meta) {
    const int lane = C.lane, r32 = lane & 31, hh = lane >> 5, g = head >> 3;
    const LAS float* biasl = (const LAS float*)(C.lds + SW_BIAS);
    LAS float* wsf = (LAS float*)(C.lds + SW_WS) + C.wave * 32;
    LAS unsigned char* wl = C.lds + SW_Q + C.wave * SW_WAVE;
    const unsigned wlb = (unsigned)__builtin_amdgcn_readfirstlane((unsigned)(uintptr_t)(C.lds + SW_Q) + (unsigned)C.wave * SW_WAVE);
    const int tq = p0 + r32;
    const int ntile = meta ? 1 : 6;
    PROBE_T0();
    const int prow = lane >> 3, pch = lane & 7, vrow = lane >> 2, vch = lane & 3;
#define SW_DMA_K(kt_, slot_) do { const int k0_ = ((kt_) == 0) ? 0 : p0 - 128 + 32 * ((kt_) - 1); \
        _Pragma("unroll") for (int p = 0; p < 4; ++p) { const int r_ = 8 * p + prow; int kp_ = k0_ + r_; kp_ = kp_ < 0 ? 0 : kp_; \
            glds16o(B.KV, (unsigned)rowof(b, kp_) * 512u + (unsigned)(g * 128 + ((pch ^ ((r_ >> 1) & 7)) << 4)), wlb + 4096u + (unsigned)(slot_) * SW_SLOT + p * 1024); } } while (0)
#define SW_DMA_V(kt_, slot_) do { const int k0_ = ((kt_) == 0) ? 0 : p0 - 128 + 32 * ((kt_) - 1); \
        _Pragma("unroll") for (int p = 0; p < 4; ++p) { const int r_ = 16 * p + vrow; int ks_ = k0_ + 8 * (vch ^ ((r_ >> 2) & 3)); ks_ = ks_ < 0 ? 0 : ks_; \
            glds16o(B.VT, (unsigned)((b * 128 + g * 64 + r_) * VT_PITCH + ks_) * 2u, wlb + 4096u + (unsigned)(slot_) * SW_SLOT + p * 1024); } } while (0)
    {
#pragma unroll
        for (int p = 0; p < 4; ++p) { const int r_ = 8 * p + prow; int tqq = p0 + r_; if (meta) tqq = tqq < NMETA ? tqq : NMETA - 1;
            glds16o(B.PROJ, ((unsigned)rowof(b, tqq) * (unsigned)NP1 + (unsigned)(PC_QA + head * 64)) * 2u + (unsigned)((pch ^ ((r_ >> 1) & 7)) << 4), wlb + p * 1024); }
    }
    SW_DMA_K(0, 0);
    if (!meta) { SW_DMA_K(1, 1); SW_DMA_K(2, 2); }
    const int foff = r32 * 128, fsw = (r32 >> 1) & 7;
    bf16x8 qf[4];
    if (meta) asm volatile("s_waitcnt vmcnt(0)" ::: "memory"); else asm volatile("s_waitcnt vmcnt(8)" ::: "memory");
#pragma unroll
    for (int s = 0; s < 4; ++s) qf[s] = *(const LAS bf16x8*)(wl + foff + (((2 * s + hh) ^ fsw) << 4));
    f32x16 S[6];
#pragma unroll
    for (int kt = 0; kt < 6; ++kt) {
        if (kt < ntile) {
            if (meta || kt >= 4) { if (kt == 4) asm volatile("s_waitcnt vmcnt(4)" ::: "memory"); else asm volatile("s_waitcnt vmcnt(0)" ::: "memory"); }
            else asm volatile("s_waitcnt vmcnt(8)" ::: "memory");
            bf16x8 kf[4];
#pragma unroll
            for (int s = 0; s < 4; ++s) kf[s] = *(const LAS bf16x8*)(wl + 4096 + (kt % 3) * SW_SLOT + foff + (((2 * s + hh) ^ fsw) << 4));
            __builtin_amdgcn_sched_barrier(0);
            f32x16 acc = {};
#pragma unroll
            for (int s = 0; s < 4; ++s) acc = __builtin_amdgcn_mfma_f32_32x32x16_bf16(kf[s], qf[s], acc, 0, 0, 0);
            S[kt] = acc;
            LDS_WAIT(); asm volatile("" ::: "memory");
            if (kt + 3 < ntile) SW_DMA_K(kt + 3, kt % 3);
        } else S[kt] = (f32x16){-INFINITY, -INFINITY, -INFINITY, -INFINITY, -INFINITY, -INFINITY, -INFINITY, -INFINITY, -INFINITY, -INFINITY, -INFINITY, -INFINITY, -INFINITY, -INFINITY, -INFINITY, -INFINITY};
    }
    PROBE_T1(50);
    SW_DMA_V(0, 0);
    if (!meta) { SW_DMA_V(1, 1); SW_DMA_V(2, 2); }
#pragma unroll
    for (int kt = 0; kt < 6; ++kt) {
        if (kt < ntile) {
            const int k0 = (kt == 0) ? 0 : p0 - 128 + 32 * (kt - 1);
            float bz[16];
#pragma unroll
            for (int i = 0; i < 16; ++i) { const int kp = k0 + (i & 3) + 8 * (i >> 2) + 4 * hh; int d = tq - kp; d = d < 0 ? 0 : (d > 127 ? 127 : d); bz[i] = biasl[head * 128 + d]; }
#pragma unroll
            for (int i = 0; i < 16; ++i) { const int kp = k0 + (i & 3) + 8 * (i >> 2) + 4 * hh; const int d = tq - kp;
                const bool ok = (kt == 0) ? (kp < NMETA && d >= 0) : (kp >= NMETA && d >= 0 && d < 128);
                const float x = 0.125f * S[kt][i] + bz[i];
                S[kt][i] = ok ? x : -INFINITY; }
        }
    }
    const float sink = sinks[head];
    float mx = sink;
#pragma unroll
    for (int kt = 0; kt < 6; ++kt)
#pragma unroll
        for (int i = 0; i < 16; ++i) mx = fmaxf(mx, S[kt][i]);
    mx = fmaxf(mx, __shfl_xor(mx, 32));
    float sum = 0.f;
#pragma unroll
    for (int kt = 0; kt < 6; ++kt)
#pragma unroll
        for (int i = 0; i < 16; ++i) { const float p = __expf(S[kt][i] - mx); S[kt][i] = p; sum += p; }
    sum += __shfl_xor(sum, 32);
    sum += __expf(sink - mx);
    if (hh == 0) wsf[r32] = sum;
    PROBE_T1(51);
    f32x16 O0 = {}, O1 = {};
#pragma unroll
    for (int kt = 0; kt < 6; ++kt) {
        if (kt < ntile) {
            if (meta || kt >= 4) { if (kt == 4) asm volatile("s_waitcnt vmcnt(4)" ::: "memory"); else asm volatile("s_waitcnt vmcnt(0)" ::: "memory"); }
            else asm volatile("s_waitcnt vmcnt(8)" ::: "memory");
            pg8::u32x2 vl[2][2], vh[2][2];
#pragma unroll
            for (int s2 = 0; s2 < 2; ++s2)
#pragma unroll
                for (int dt = 0; dt < 2; ++dt) { const int r_ = 32 * dt + r32; const LAS unsigned char* vp = wl + 4096 + (kt % 3) * SW_SLOT + r_ * 64 + 8 * hh; const int sw_ = (r_ >> 2) & 3;
                    vl[s2][dt] = *(const LAS pg8::u32x2*)(vp + (((2 * s2) ^ sw_) << 4)); vh[s2][dt] = *(const LAS pg8::u32x2*)(vp + (((2 * s2 + 1) ^ sw_) << 4)); }
            __builtin_amdgcn_sched_barrier(0);
#pragma unroll
            for (int s2 = 0; s2 < 2; ++s2) {
                pg8::u32x4 pw; pw.x = cvtpk(S[kt][8 * s2 + 0], S[kt][8 * s2 + 1]); pw.y = cvtpk(S[kt][8 * s2 + 2], S[kt][8 * s2 + 3]); pw.z = cvtpk(S[kt][8 * s2 + 4], S[kt][8 * s2 + 5]); pw.w = cvtpk(S[kt][8 * s2 + 6], S[kt][8 * s2 + 7]);
                const bf16x8 pf = __builtin_bit_cast(bf16x8, pw);
#pragma unroll
                for (int dt = 0; dt < 2; ++dt) { const pg8::u32x4 vw = {vl[s2][dt].x, vl[s2][dt].y, vh[s2][dt].x, vh[s2][dt].y}; const bf16x8 vf = __builtin_bit_cast(bf16x8, vw);
                    if (dt == 0) O0 = __builtin_amdgcn_mfma_f32_32x32x16_bf16(pf, vf, O0, 0, 0, 0); else O1 = __builtin_amdgcn_mfma_f32_32x32x16_bf16(pf, vf, O1, 0, 0, 0); }
            }
            LDS_WAIT(); asm volatile("" ::: "memory");
            if (kt + 3 < ntile) SW_DMA_V(kt + 3, kt % 3);
            __builtin_amdgcn_sched_barrier(0);
        }
    }
#undef SW_DMA_K
#undef SW_DMA_V
    PROBE_T1(52);
    LDS_WAIT(); asm volatile("" ::: "memory");
    LAS float* stg = (LAS float*)(wl + 4096);
#pragma unroll
    for (int i = 0; i < 16; ++i) { const int q = (i & 3) + 8 * (i >> 2) + 4 * hh; stg[q * 68 + r32] = O0[i]; stg[q * 68 + 32 + r32] = O1[i]; }
    LDS_WAIT(); asm volatile("" ::: "memory");
    { const int q = lane >> 1, d0 = (lane & 1) * 32, t = p0 + q;
      if (!meta || t < NMETA) { const int row = rowof(b, t); const float inv = 1.0f / wsf[q];
          const bf16* zp = B.PROJ + (size_t)row * NP1 + PC_ZA + head * 64 + d0; bf16* op = B.YA + (size_t)row * YLD + head * 64 + d0;
#pragma unroll
          for (int hf = 0; hf < 4; ++hf) { const v4u zw = *(const v4u*)(zp + 8 * hf);
              const f32x4 xa = *(const LAS f32x4*)(stg + q * 68 + d0 + 8 * hf) * inv, xb = *(const LAS f32x4*)(stg + q * 68 + d0 + 8 * hf + 4) * inv;
              v4u o; o.x = pk2(xa[0] * siluf_(pg8::bf_lo(zw.x)), xa[1] * siluf_(pg8::bf_hi(zw.x))); o.y = pk2(xa[2] * siluf_(pg8::bf_lo(zw.y)), xa[3] * siluf_(pg8::bf_hi(zw.y)));
              o.z = pk2(xb[0] * siluf_(pg8::bf_lo(zw.z)), xb[1] * siluf_(pg8::bf_hi(zw.z))); o.w = pk2(xb[2] * siluf_(pg8::bf_lo(zw.w)), xb[3] * siluf_(pg8::bf_hi(zw.w)));
              *(v4u*)(op + 8 * hf) = o; } } }
    LDS_WAIT(); asm volatile("" ::: "memory");
}

__device__ __forceinline__ void swa_phase(const Ctx& C, int l) {
    const Bufs B(kargs()->ws);
    const KArgs& A = *kargs();
    const float* sinks = A.sinks + l * 16;
    gu32* qctr = (gu32*)(A.ws + WS_CTL) + CW_SWAQ + l * 64;
    LAS int* qslot = (LAS int*)(C.lds + SW_WS) + 8 * 32;
    int g0 = 0; if (C.tid == 0) g0 = (int)__hip_atomic_fetch_add(qctr, 8u, __ATOMIC_RELAXED, __HIP_MEMORY_SCOPE_AGENT);
    __syncthreads();
    for (int i = C.tid; i < 128 * 16; i += NWAVES * 64) { const int h = i >> 7, d = i & 127; ((LAS float*)(C.lds + SW_BIAS))[i] = A.bias_table[t5_bucket(d) * 32 + h]; }
    for (int ng = 0;; ++ng) {
        if (C.tid == 0) qslot[0] = (ng == 0) ? g0 : (int)__hip_atomic_fetch_add(qctr, 8u, __ATOMIC_RELAXED, __HIP_MEMORY_SCOPE_AGENT);
        LDS_WAIT(); __syncthreads();
        const int base = qslot[0];
        __syncthreads();
        if (base >= 4096 + 32) break;
        const int it = base + C.wave;
        if (it < 4096) { const int blk = it & 127, head = (it >> 7) & 15, b = it >> 11; swa_item(C, B, sinks, b, head, NMETA + 32 * blk, false); }
        else if (it < 4096 + 32) { const int r = it - 4096, head = r & 15, b = r >> 4; swa_item(C, B, sinks, b, head, 0, true); }
    }
    __syncthreads();
}


constexpr int PH_PER_LAYER = 5, N_PHASES = 1 + NLAYER * PH_PER_LAYER + 1;
#ifndef MK_DUP
#define MK_DUP 0
#endif
#ifndef MK_NAIVE_SWA
#define MK_NAIVE_SWA 0
#endif
#ifndef MK_NAIVE_DSA
#define MK_NAIVE_DSA 0
#endif
#ifndef MK_ONE_LAUNCH
#define MK_ONE_LAUNCH 1
#endif

__device__ __forceinline__ int lane_id_fresh() { int l; asm volatile("v_mbcnt_lo_u32_b32 %0, -1, 0\n\tv_mbcnt_hi_u32_b32 %0, -1, %0" : "=v"(l)); return l; }
__global__ void __launch_bounds__(NWAVES * 64, 2) fwd_kernel(Args args) {
    extern __shared__ __attribute__((aligned(16))) unsigned char lds[];
    Ctx C;
    C.lds = (LAS unsigned char*)lds; C.tid = threadIdx.x; C.lane = C.tid & 63; C.wave = __builtin_amdgcn_readfirstlane(C.tid >> 6);
    const int wave0 = C.wave;
    C.G = gridDim.x; C.bid = blockIdx.x; C.gw = blockIdx.x * NWAVES + C.wave; C.NGW = C.G * NWAVES;
    unsigned char* ws = args.ws;
    gu32* ctl = (gu32*)(ws + WS_CTL);
    for (int u = C.tid; u < RING_OFF / 4; u += NWAVES * 64) ((LAS unsigned*)(C.lds + LDSCTL_OFF))[u] = 0u;
    __syncthreads();
    volatile LAS unsigned* MISC = (volatile LAS unsigned*)(C.lds + MISC_OFF);
    XcdBarrier bar; bar.bar = (unsigned*)(ctl + CW_BAR); bar.x = 0; bar.st = nullptr;
    const int lo = args.ph_lo, hi = args.ph_hi;
    const bool one = (hi - lo) > 1;
    if (one) bar = xcd_barrier_post((unsigned*)(ctl + CW_BAR), MISC + 8);
#define IN(k) (lo <= (k) && (k) < hi)
#define PHASE_BEGIN() do { int l_ = lane_id_fresh(); int b_ = blockIdx.x; asm volatile("" : "+s"(b_)); \
    int w_ = wave0; asm volatile("" : "+s"(w_)); C.wave = w_; C.lane = l_; C.tid = w_ * 64 + l_; C.bid = b_; C.gw = b_ * NWAVES + w_; } while (0)
#define SEAM(k) do { if (IN((k) + 1)) { PROBE_T0(); XcdBarrier b2_ = bar; b2_.bar = (unsigned*)launder((unsigned char*)bar.bar);     \
    xcd_barrier(b2_, C.wave == 0 && lane_id_fresh() == 0); PROBE_T1(29); PROBE_T1(60 + ((k) == 0 ? 5 : ((k) - 1) % PH_PER_LAYER)); if (MK_DUP & 256) xcd_barrier(b2_, C.wave == 0 && lane_id_fresh() == 0); } } while (0)
    LAS unsigned char* ring = C.lds + RING_OFF;

    if (IN(0)) { PROBE_T0(); PHASE_BEGIN(); p0_prologue(C); PROBE_T1(20); if (MK_DUP & 128) { PHASE_BEGIN(); p0_prologue(C); } SEAM(0); }
    for (int l = 0; l < NLAYER; ++l) {
        const int p = 1 + l * PH_PER_LAYER;
        if (IN(p)) {
            PHASE_BEGIN(); const Bufs B(kargs()->ws);
            const bf16* W1l = B.W1 + (size_t)l * NP1 * DM;
            pg8::Gemm g{B.HB, W1l, MR, 8192, DM}; pg8::StaticOrder S; S.init(MR, 8192, C.G, C.bid);
            rstd_table<8>(C, S, B.RS, 1.0f / DM);
            pg8::EpiProjT<true> E{B.PROJ, NP1, (const LAS float*)(C.lds + RSTD_OFF), B.KV, B.RSQ, B.RHO, B.SGB, B.VT};
            { PROBE_T0(); pg8::gemm_phase<pg8::EpiProjT<true>, pg8::StaticOrder, true, true>(ring, g, S, E, C.tid); PROBE_T1(21); }
            PHASE_BEGIN();
            LAS float* tbl = (LAS float*)(C.lds + RSTD_OFF);
            PROBE_T0();
            const int nside = (C.G == 256) ? 256 + 256 : 256 + 259;
            for (int u = C.bid; u < nside; u += C.G) {
                if (u < 256) { const int row0 = 32 * u; skinny_rstd(C, B.RS + (size_t)row0 * 32, 32, 1.0f / DM, tbl);
                    skinny_unit<3, 2>(C, B.HB + (size_t)row0 * DM, DM, B.W1K + (size_t)l * 32 * 3 * 4 * 512, DM, DM, nullptr, 0, 0, SkProj{B.PROJ + (size_t)row0 * NP1, B.KV + (size_t)row0 * 256, B.KIDX, 8192, tbl, row0, B.VT}); }
                else { const int gc = u - 256; skinny_rstd(C, B.RS2, 64, 1.0f / DM, tbl);
                    const SkProj E2{B.PROJ + (size_t)MR * NP1, B.KV + (size_t)MR * 256, B.KIDX, gc * 32, tbl, MR, B.VT};
                    const bool sqc = gc >= 72 && gc < 88;
                    skinny_unit<1, 4>(C, B.HB + (size_t)MR * DM, DM, W1l + (size_t)gc * 32 * DM, DM, DM, sqc ? B.RSQ2 : nullptr, 16, gc - 72, E2); }
            }
            PROBE_T1(22);
            SEAM(p);
        }
        if (IN(p + 1)) {
            PHASE_BEGIN(); const Bufs B(kargs()->ws);
            const bf16* W2l = B.W2 + (size_t)l * NQ2 * 512;
            pg8::Gemm g{B.PROJ + PC_CQ, W2l, MR, NQ2, 512, nullptr, nullptr, NP1}; pg8::StaticOrder S; S.init(MR, NQ2, C.G, C.bid);
            rstd_table<2>(C, S, B.RSQ, 1.0f / 512.0f);
            pg8::EpiProjT<false> E{B.Q2, NQ2, (const LAS float*)(C.lds + RSTD_OFF), nullptr, nullptr, nullptr, nullptr, nullptr};
            PROBE_T0();
            pg8::gemm_phase<pg8::EpiProjT<false>, pg8::StaticOrder, true, true>(ring, g, S, E, C.tid);
            PHASE_BEGIN();
            { LAS float* tbl = (LAS float*)(C.lds + RSTD_OFF);
              const int sb = (C.G == 256) ? C.bid - 64 : C.bid;
              for (int u = sb; u >= 0 && u < 48; u += C.G) { skinny_rstd(C, B.RSQ2, 16, 1.0f / 512.0f, tbl);
                skinny_unit<3, 1>(C, B.PROJ + (size_t)MR * NP1 + PC_CQ, NP1, W2l + (size_t)u * 96 * 512, 512, 512, nullptr, 0, 0, SkQ2{B.Q2 + (size_t)MR * NQ2 + u * 96, tbl}); }
              if (C.G == 256 && sb >= 48 && sb < 51) { const int gc = 256 + sb - 48; const bf16* W1l = B.W1 + (size_t)l * NP1 * DM;
                skinny_rstd(C, B.RS2, 64, 1.0f / DM, tbl);
                skinny_unit<1, 4>(C, B.HB + (size_t)MR * DM, DM, W1l + (size_t)gc * 32 * DM, DM, DM, nullptr, 16, 0, SkProj{B.PROJ + (size_t)MR * NP1, B.KV + (size_t)MR * 256, B.KIDX, gc * 32, tbl, MR, B.VT}); } }
            PHASE_BEGIN(); norm_tail(C, l);
            PROBE_T1(24);
            SEAM(p + 1);
        }
        if (IN(p + 2)) {
            { PROBE_T0(); PHASE_BEGIN(); dsa_phase(C, l); PROBE_T1(4); }
            if (MK_DUP & 16) { PHASE_BEGIN(); dsa_phase(C, l); }
            { PROBE_T0(); PHASE_BEGIN(); swa_phase(C, l); PROBE_T1(5); }
            SEAM(p + 2);
        }
        if (IN(p + 3)) {
            PHASE_BEGIN(); const Bufs B(kargs()->ws);
            const bf16* WABl = B.WA + (size_t)l * DM * 2048;
            pg8::Gemm g{B.YA, WABl, MR, DM, 2048, nullptr, nullptr, 0}; pg8::StaticOrder S; S.init(MR, DM, C.G, C.bid);
            pg8::EpiG4m E{B.MG, B.RHO, B.SGB};
            PROBE_T0();
            pg8::gemm_phase<pg8::EpiG4m, pg8::StaticOrder, true, true>(ring, g, S, E, C.tid);
            PROBE_T1(35);
            PHASE_BEGIN();
            for (int u = C.bid; u < 64; u += C.G) {
                skinny_unit<1, 2>(C, B.YA + (size_t)MR * YLD, YLD, WABl + (size_t)u * 32 * 2048, 2048, 2048, nullptr, 0, 0, SkMerge2{B.MG + (size_t)MR * DM + u * 32, B.PROJ + (size_t)MR * NP1 + 4096, u * 32}); }
            PROBE_T1(25);
            SEAM(p + 3);
        }
        if (MK_PROBE >= 0 && l == NLAYER - 1 && C.bid == MK_PROBE_BLOCK && C.wave == 0 && C.lane == 0) __hip_atomic_store((gu32*)(kargs()->ws + WS_CTL) + 3, ((volatile LAS unsigned*)(C.lds + MISC_OFF + 64))[0], RLX_AGENT);
        if (IN(p + 4)) {
            PHASE_BEGIN(); const Bufs B(kargs()->ws);
            const bf16* WOl = B.WO + (size_t)l * DM * DM;
            pg8::Gemm g{B.MG, WOl, MR, DM, DM}; pg8::StaticOrder S; S.init(MR, DM, C.G, C.bid);
            pg8::EpiRes E{B.HB, B.RS};
            PROBE_T0();
            pg8::gemm_phase<pg8::EpiRes, pg8::StaticOrder, true, true>(ring, g, S, E, C.tid);
            PROBE_T1(37);
            PHASE_BEGIN();
            for (int u = C.bid; u < 64; u += C.G) skinny_unit<1, 4>(C, B.MG + (size_t)MR * DM, DM, WOl + (size_t)u * 32 * DM, DM, DM, B.RS2, 64, u, SkRes{B.HB + (size_t)MR * DM + u * 32});
            PROBE_T1(27);
            SEAM(p + 4);
        }
    }
    if (IN(N_PHASES - 1)) { PHASE_BEGIN(); final_phase(C); }
#undef IN
#undef SEAM
}

extern "C" void kernel_launch(void* const* d_in, const int* in_sizes, int n_in, void* d_out, int out_size, void* d_ws, size_t ws_size, hipStream_t stream) {
    static int grid = 0;
    if (grid == 0) {
        if (n_in != 16 || ws_size < WS_END) { fprintf(stderr, "kernel_launch: unexpected inputs (n_in %d, ws %zu, need %zu)\n", n_in, ws_size, (size_t)WS_END); grid = -1; return; }
        int dev = 0, cus = 0;
        if (hipGetDevice(&dev) != hipSuccess || hipDeviceGetAttribute(&cus, hipDeviceAttributeMultiprocessorCount, dev) != hipSuccess) { grid = -1; return; }
        if (hipFuncSetAttribute((const void*)fwd_kernel, hipFuncAttributeMaxDynamicSharedMemorySize, LDS_BYTES) != hipSuccess) { fprintf(stderr, "kernel_launch: hipFuncSetAttribute failed\n"); grid = -1; return; }
        int per_cu = 0;
        if (hipOccupancyMaxActiveBlocksPerMultiprocessor(&per_cu, (const void*)fwd_kernel, NWAVES * 64, LDS_BYTES) != hipSuccess || per_cu < 1) fprintf(stderr, "kernel_launch: occupancy query says %d\n", per_cu);
        (void)hipGetLastError();
        grid = cus;
    }
    if (grid < 0) return;
    if (hipMemsetAsync((char*)d_ws + WS_CTL, 0, CTL_ZERO_BYTES, stream) != hipSuccess) return;
    Args a{};
    a.x = (const float*)d_in[0]; a.meta = (const float*)d_in[1]; a.bias_table = (const float*)d_in[2]; a.norm_g = (const float*)d_in[3]; a.w_in = (const float*)d_in[4];
    a.q_norm_g = (const float*)d_in[5]; a.kv_norm_g = (const float*)d_in[6]; a.w_qb = (const float*)d_in[7]; a.w_iq = (const float*)d_in[8]; a.w_uk = (const float*)d_in[9];
    a.w_uv = (const float*)d_in[10]; a.sinks = (const float*)d_in[11]; a.w_proj_a = (const float*)d_in[12]; a.w_proj_b = (const float*)d_in[13]; a.w_out = (const float*)d_in[14];
    a.final_g = (const float*)d_in[15]; a.out = (float*)d_out; a.ws = (unsigned char*)d_ws;
#if MK_ONE_LAUNCH
    a.ph_lo = 0; a.ph_hi = N_PHASES;
    hipLaunchKernelGGL(fwd_kernel, dim3(grid), dim3(NWAVES * 64), LDS_BYTES, stream, a);
#else
    for (int p = 0; p < N_PHASES; ++p) { a.ph_lo = p; a.ph_hi = p + 1; hipLaunchKernelGGL(fwd_kernel, dim3(grid), dim3(NWAVES * 64), LDS_BYTES, stream, a); }
#endif
}
```

```cpp
#include <hip/hip_runtime.h>
#include <cstdio>
#include <cstdint>
namespace pg8 {
#define PG8_LAS __attribute__((address_space(3)))
typedef unsigned short bf16_t;
typedef short bf16x8 __attribute__((ext_vector_type(8)));
typedef float f32x4 __attribute__((ext_vector_type(4)));
typedef unsigned u32x4 __attribute__((ext_vector_type(4)));
constexpr int BM = 256, BK = 64, HALF = 128, HTB = HALF * BK * 2  , STAGE_BYTES = 8 * HTB, NXCD = 8, WGM = 8;

__host__ __device__ __forceinline__ int lds_byte(int r, int c) { const int st = (r >> 4) * 2 + (c >> 5), rr = r & 15, cc = c & 31, ob = rr * 64 + cc * 2; return st * 1024 + (ob ^ (((ob >> 9) & 1) << 5)); }
__host__ __device__ __forceinline__ void stage_rc(int b, int& R, int& C) { const int st = b / 1024, sb = b % 1024, swz = sb ^ (((sb >> 9) & 1) << 5); R = (st >> 1) * 16 + swz / 64; C = (st & 1) * 32 + (swz % 64) / 2; }
__host__ __device__ __forceinline__ int perm32(int rho) { const int n = rho >> 4, i = rho & 15; return 8 * (i >> 2) + 4 * n + (i & 3); }

struct Unit { int pm, pn, sel; };
struct Gemm { const bf16_t* A; const bf16_t* Bt; int M, N, K; const bf16_t* A2; const bf16_t* Bt2; int lda; };

struct StaticOrder {
    int nM, nN, nwg, G, c;
    __host__ __device__ void init(int M, int N, int G_, int c_) { nM = M / BM; nN = N / BM; nwg = nM * nN; G = G_; c = c_; }
    __host__ __device__ bool next(int i, Unit& u) const {
        const long L = (long)i * G + c; if (L >= nwg) return false;
        int wgid = (int)L; { const int q = nwg / NXCD, r = nwg % NXCD, xcd = wgid % NXCD, off = wgid / NXCD; wgid = (xcd < r ? xcd * (q + 1) : r * (q + 1) + (xcd - r) * q) + off; }
        const int nig = WGM * nN, gid = wgid / nig, fm = gid * WGM, gsz = (nM - fm) < WGM ? (nM - fm) : WGM;
        u.pm = fm + ((wgid % nig) % gsz); u.pn = (wgid % nig) / gsz; u.sel = 0; return true;
    }
    __device__ __forceinline__ void a_ready(const Unit&) const {}
    __device__ __forceinline__ void done(const Unit&) const {}
};

__device__ __forceinline__ unsigned cvt_pk_bf16(float lo, float hi) { unsigned r; asm volatile("v_cvt_pk_bf16_f32 %0, %1, %2" : "=v"(r) : "v"(lo), "v"(hi)); return r; }
typedef float f32x2 __attribute__((ext_vector_type(2)));
__device__ __forceinline__ f32x2 gelu_pk(f32x2 v) {
    const f32x2 av = __builtin_elementwise_abs(v), d = av * 0.2316418882f + 1.0f;
    f32x2 t; t.x = __builtin_amdgcn_rcpf(d.x); t.y = __builtin_amdgcn_rcpf(d.y);
    f32x2 q = t * 0.5307027145f + (-0.7265760135f); q = q * t + 0.7107068705f; q = q * t + (-0.142248368f); q = q * t + 0.127414796f; q = q * t;
    const f32x2 s = (v * v) * (-0.72134752044f);
    f32x2 e; e.x = __builtin_amdgcn_exp2f(s.x); e.y = __builtin_amdgcn_exp2f(s.y);
    const f32x2 m = v * (q * e), r = v - m;
    f32x2 o; o.x = v.x < 0.f ? m.x : r.x; o.y = v.y < 0.f ? m.y : r.y; return o;
}

template <int ACT  > struct EpiBf16 {
    static constexpr bool PERM = true, AFTER_DRAIN = false; static_assert(ACT == 0 || ACT == 1, "EpiBf16: ACT is 0 (none) or 1 (gelu_pk)");
    bf16_t* O; int ldc; const float* bias; int split_cols; size_t split_stride; float scale0;
    __device__ __forceinline__ void operator()(const f32x4 (&acc)[2][2][4][2], const Unit& u, int ui, int wr, int wc, int fr, int fq) const {
        const int row0 = u.pm * BM + wr * 64 + fr; int colt = u.pn * BM; bf16_t* base = O;
        float sc = 1.f; if (split_cols) { const int t = colt / split_cols; base += (size_t)t * split_stride; colt -= t * split_cols; if (t == 0) sc = scale0; }
        const int col0 = colt + wc * 32 + 8 * fq, bcol0 = u.pn * BM + wc * 32 + 8 * fq;
        f32x4 bv[2][2];
#pragma unroll
        for (int bj = 0; bj < 2; ++bj)
#pragma unroll
            for (int n = 0; n < 2; ++n) bv[bj][n] = bias ? *(const f32x4*)(bias + bcol0 + bj * HALF + 4 * n) : (f32x4){0.f, 0.f, 0.f, 0.f};
#pragma unroll
        for (int ai = 0; ai < 2; ++ai)
#pragma unroll
            for (int m = 0; m < 4; ++m) { bf16_t* rowp = base + (size_t)(row0 + ai * HALF + m * 16) * ldc + col0;
#pragma unroll
                for (int bj = 0; bj < 2; ++bj) { f32x4 v0 = acc[ai][bj][m][0] + bv[bj][0], v1 = acc[ai][bj][m][1] + bv[bj][1];
                    if (ACT == 1) { f32x2 a = gelu_pk((f32x2){v0[0], v0[1]}), b = gelu_pk((f32x2){v0[2], v0[3]}), c = gelu_pk((f32x2){v1[0], v1[1]}), d = gelu_pk((f32x2){v1[2], v1[3]});
                        v0 = (f32x4){a.x, a.y, b.x, b.y}; v1 = (f32x4){c.x, c.y, d.x, d.y}; }
                    v0 = v0 * sc; v1 = v1 * sc; u32x4 w; w.x = cvt_pk_bf16(v0[0], v0[1]); w.y = cvt_pk_bf16(v0[2], v0[3]); w.z = cvt_pk_bf16(v1[0], v1[1]); w.w = cvt_pk_bf16(v1[2], v1[3]);
                    *(u32x4*)(rowp + bj * HALF) = w; } }
    }
};

template <class T, class = void> struct pg8_has_midk { static constexpr bool value = false; };
template <class T> struct pg8_has_midk<T, decltype((void)T::MIDK)> { static constexpr bool value = T::MIDK; };
template <class Epi, class Sched, bool ALIGN_EPI = false, bool SP2 = false>
__device__ __forceinline__ void gemm_phase(PG8_LAS unsigned char* lds, const Gemm g, const Sched& S, const Epi& E, int tid_in) {
    int tid_ = tid_in; asm volatile("" : "+v"(tid_));
    const int tid = tid_, wid = __builtin_amdgcn_readfirstlane(tid >> 6), lane = tid & 63, wr = wid >> 2, wc = wid & 3, fr = lane & 15, fq = lane >> 4;
    const int K = g.K, nt = K / BK, lda = g.lda ? g.lda : K;
    unsigned voffA[2], voffB[2];
#pragma unroll
    for (int i = 0; i < 2; ++i) { int R, C; stage_rc(tid * 16 + i * 8192, R, C); const int Rb = Epi::PERM ? ((R & ~31) + perm32(R & 31)) : R;
        voffA[i] = (unsigned)(R * lda + C) * 2u; voffB[i] = (unsigned)(Rb * K + C) * 2u; }
    const size_t kstep = (size_t)(BK * 2);
    const size_t hstepA = (size_t)HALF * lda * 2, tstepA = 2 * hstepA;
    const size_t hstep = (size_t)HALF * K * 2;
    const size_t tstep = 2 * hstep;
    const unsigned ldsw = (unsigned)wid * 1024u;
    const int aoff = lds_byte(wr * 64 + fr, fq * 8), boff = lds_byte(wc * 32 + fr, fq * 8);
#define PG8_SA(b, h) (((b) * 2 + (h)) * HTB)
#define PG8_SB(b, h) ((4 + (b) * 2 + (h)) * HTB)
#define PG8_STAGE(bufoff, gbase, voff) do { _Pragma("unroll") for (int _i = 0; _i < 2; ++_i) \
        __builtin_amdgcn_global_load_lds((const unsigned*)((const char*)(gbase) + (voff)[_i]), (PG8_LAS unsigned*)(lds + (bufoff) + ldsw + _i * 8192), 16, 0, 0); } while (0)
#define PG8_LDA(dst, b, h) do { _Pragma("unroll") for (int m = 0; m < 4; ++m) _Pragma("unroll") for (int k = 0; k < 2; ++k) dst[m][k] = *(const PG8_LAS bf16x8*)(lds + PG8_SA(b, h) + aoff + m * 2048 + k * 1024); } while (0)
#define PG8_LDB(dst, b, h) do { _Pragma("unroll") for (int n = 0; n < 2; ++n) _Pragma("unroll") for (int k = 0; k < 2; ++k) dst[n][k] = *(const PG8_LAS bf16x8*)(lds + PG8_SB(b, h) + boff + n * 2048 + k * 1024); } while (0)
#define PG8_MMA(ai, bj, At, Bt) do { __builtin_amdgcn_s_setprio(1); _Pragma("unroll") for (int m = 0; m < 4; ++m) _Pragma("unroll") for (int n = 0; n < 2; ++n) _Pragma("unroll") for (int k = 0; k < 2; ++k) \
        acc[ai][bj][m][n] = __builtin_amdgcn_mfma_f32_16x16x32_bf16(Bt[n][k], At[m][k], acc[ai][bj][m][n], 0, 0, 0); __builtin_amdgcn_s_setprio(0); } while (0)
#define PG8_WAIT_V(n) asm volatile("s_waitcnt vmcnt(" #n ")" ::: "memory")
#define PG8_WAIT_L(n) asm volatile("s_waitcnt lgkmcnt(" #n ")" ::: "memory")
#define PG8_BAR __builtin_amdgcn_s_barrier()
#define PG8_SCHED __builtin_amdgcn_sched_barrier(0)
    Unit cur, nxt; int ui = 0;
    if (!S.next(0, cur)) return;
    f32x4 acc[2][2][4][2];
#pragma unroll
    for (int a = 0; a < 2; ++a)
#pragma unroll
        for (int b = 0; b < 2; ++b)
#pragma unroll
            for (int m = 0; m < 4; ++m)
#pragma unroll
                for (int n = 0; n < 2; ++n) acc[a][b][m][n] = (f32x4){0.f, 0.f, 0.f, 0.f};
    bf16x8 At[4][2], B0[2][2], B1[2][2];
    const char* cA = (const char*)(cur.sel ? g.A2 : g.A) + (size_t)cur.pm * tstepA; const char* cB = (const char*)(cur.sel ? g.Bt2 : g.Bt) + (size_t)cur.pn * tstep;
    S.a_ready(cur);
    if constexpr (SP2) {
        PG8_STAGE(PG8_SB(0, 0), cB, voffB); PG8_STAGE(PG8_SB(0, 1), cB + hstep, voffB); PG8_STAGE(PG8_SA(0, 0), cA, voffA); PG8_STAGE(PG8_SA(0, 1), cA + hstepA, voffA);
        if (wr == 1) PG8_BAR;
        PG8_WAIT_V(2); PG8_BAR;
        PG8_STAGE(PG8_SB(1, 0), cB + kstep, voffB); PG8_STAGE(PG8_SA(1, 0), cA + kstep, voffA); PG8_STAGE(PG8_SB(1, 1), cB + hstep + kstep, voffB);
        PG8_WAIT_V(6); PG8_BAR;
    } else {
        PG8_STAGE(PG8_SB(0, 0), cB, voffB); PG8_STAGE(PG8_SA(0, 0), cA, voffA); PG8_STAGE(PG8_SB(0, 1), cB + hstep, voffB); PG8_STAGE(PG8_SA(0, 1), cA + hstepA, voffA);
        if (wr == 1) PG8_BAR;
        PG8_WAIT_V(4); PG8_BAR;
        PG8_STAGE(PG8_SB(1, 0), cB + kstep, voffB); PG8_STAGE(PG8_SA(1, 0), cA + kstep, voffA); PG8_STAGE(PG8_SB(1, 1), cB + hstep + kstep, voffB);
        PG8_WAIT_V(6); PG8_BAR;
    }
    for (;;) {
        const bool has_next = S.next(ui + 1, nxt);
        const char* nA = has_next ? (const char*)(nxt.sel ? g.A2 : g.A) + (size_t)nxt.pm * tstepA : cA; const char* nB = has_next ? (const char*)(nxt.sel ? g.Bt2 : g.Bt) + (size_t)nxt.pn * tstep : cB;
        for (int t = 0; t < nt; t += 2) {
            if constexpr (pg8_has_midk<Epi>::value) { if (t == (nt >> 1)) E.midk(acc, cur, wr, wc, fr, fq); }
            const bool last = (t == nt - 2);
            const char* a1 = cA + (size_t)(t + 1) * kstep;
            const char* a2 = last ? nA : cA + (size_t)(t + 2) * kstep; const char* b2 = last ? nB : cB + (size_t)(t + 2) * kstep;
            const char* a3 = a2 + kstep; const char* b3 = b2 + kstep;
            if (last && has_next) S.a_ready(nxt);
            if constexpr (SP2) {
            PG8_LDB(B0, 0, 0); PG8_LDB(B1, 0, 1); PG8_SCHED; PG8_LDA(At, 0, 0); PG8_STAGE(PG8_SA(1, 1), a1 + hstepA, voffA);
            PG8_WAIT_V(8); PG8_WAIT_L(0); PG8_BAR; PG8_MMA(0, 0, At, B0); PG8_MMA(0, 1, At, B1); PG8_BAR; PG8_SCHED;
            PG8_LDA(At, 0, 1); PG8_STAGE(PG8_SB(0, 0), b2, voffB); PG8_STAGE(PG8_SB(0, 1), b2 + hstep, voffB); PG8_STAGE(PG8_SA(0, 0), a2, voffA);
            PG8_WAIT_V(8); PG8_WAIT_L(0); PG8_BAR; PG8_MMA(1, 0, At, B0); PG8_MMA(1, 1, At, B1); PG8_BAR; PG8_SCHED;
            PG8_LDB(B0, 1, 0); PG8_LDB(B1, 1, 1); PG8_SCHED; PG8_LDA(At, 1, 0); PG8_STAGE(PG8_SA(0, 1), a2 + hstepA, voffA);
            PG8_WAIT_V(8); PG8_WAIT_L(0); PG8_BAR; PG8_MMA(0, 0, At, B0); PG8_MMA(0, 1, At, B1); PG8_BAR; PG8_SCHED;
            PG8_LDA(At, 1, 1); PG8_STAGE(PG8_SB(1, 0), b3, voffB); PG8_STAGE(PG8_SB(1, 1), b3 + hstep, voffB); PG8_STAGE(PG8_SA(1, 0), a3, voffA);
            PG8_WAIT_V(8); PG8_WAIT_L(0); PG8_BAR; PG8_MMA(1, 0, At, B0); PG8_MMA(1, 1, At, B1); PG8_BAR; PG8_SCHED;
            } else {
            PG8_LDB(B0, 0, 0); PG8_SCHED; PG8_LDA(At, 0, 0); PG8_STAGE(PG8_SA(1, 1), a1 + hstepA, voffA);
            PG8_WAIT_L(8); PG8_BAR; PG8_WAIT_L(0); PG8_MMA(0, 0, At, B0); PG8_BAR; PG8_SCHED;
            PG8_LDB(B1, 0, 1); PG8_STAGE(PG8_SB(0, 0), b2, voffB);
            PG8_BAR; PG8_WAIT_L(0); PG8_MMA(0, 1, At, B1); PG8_BAR;
            PG8_LDA(At, 0, 1); PG8_STAGE(PG8_SA(0, 0), a2, voffA);
            PG8_BAR; PG8_WAIT_L(0); PG8_MMA(1, 0, At, B0); PG8_BAR; PG8_SCHED;
            PG8_STAGE(PG8_SB(0, 1), b2 + hstep, voffB);
            PG8_WAIT_V(6); PG8_BAR; PG8_MMA(1, 1, At, B1); PG8_BAR;
            PG8_LDB(B0, 1, 0); PG8_SCHED; PG8_LDA(At, 1, 0); PG8_STAGE(PG8_SA(0, 1), a2 + hstepA, voffA);
            PG8_WAIT_L(8); PG8_BAR; PG8_WAIT_L(0); PG8_MMA(0, 0, At, B0); PG8_BAR; PG8_SCHED;
            PG8_LDB(B1, 1, 1); PG8_STAGE(PG8_SB(1, 0), b3, voffB);
            PG8_BAR; PG8_WAIT_L(0); PG8_MMA(0, 1, At, B1); PG8_BAR;
            PG8_LDA(At, 1, 1); PG8_STAGE(PG8_SA(1, 0), a3, voffA);
            PG8_BAR; PG8_WAIT_L(0); PG8_MMA(1, 0, At, B0); PG8_BAR; PG8_SCHED;
            PG8_STAGE(PG8_SB(1, 1), b3 + hstep, voffB);
            PG8_WAIT_V(6); PG8_BAR; PG8_MMA(1, 1, At, B1); PG8_BAR;
            }
        }
        if constexpr (ALIGN_EPI) { if (wr == 0) PG8_BAR; }
        if constexpr (!Epi::AFTER_DRAIN) { E(acc, cur, ui, wr, wc, fr, fq); S.done(cur); }
        if (!has_next) break;
#pragma unroll
        for (int a = 0; a < 2; ++a)
#pragma unroll
            for (int b = 0; b < 2; ++b)
#pragma unroll
                for (int m = 0; m < 4; ++m)
#pragma unroll
                    for (int n = 0; n < 2; ++n) acc[a][b][m][n] = (f32x4){0.f, 0.f, 0.f, 0.f};
        cur = nxt; cA = nA; cB = nB; ++ui;
        if constexpr (ALIGN_EPI) { if (wr == 1) PG8_BAR; }
    }
    PG8_WAIT_V(0);
    if constexpr (!ALIGN_EPI) { if (wr == 0) PG8_BAR; }
    PG8_BAR;
    if constexpr (Epi::AFTER_DRAIN) { E.fused(acc, cur, wr, wc, fr, fq, lds, wid, lane); S.done(cur); }
#undef PG8_SA
#undef PG8_SB
#undef PG8_STAGE
#undef PG8_LDA
#undef PG8_LDB
#undef PG8_MMA
#undef PG8_WAIT_V
#undef PG8_WAIT_L
#undef PG8_BAR
#undef PG8_SCHED
}
}
namespace pg8 {
__device__ __forceinline__ float bf_lo(unsigned w) { return __uint_as_float(w << 16); }
__device__ __forceinline__ float bf_hi(unsigned w) { return __uint_as_float(w & 0xffff0000u); }
__device__ __forceinline__ float sigm(float x) { return 1.0f / (1.0f + __expf(-x)); }
typedef unsigned u32x2 __attribute__((ext_vector_type(2)));

template <bool G1>
struct EpiProjT {
    static constexpr bool PERM = true, AFTER_DRAIN = false;
    bf16_t* O; int ldc; const PG8_LAS float* rstd; bf16_t* KV; float* RSQ; bf16_t* RHO; bf16_t* SGB; bf16_t* VT;
    static constexpr int kvtile = 4, sqtile = 9, gtile = 16;
    __device__ __forceinline__ void operator()(const f32x4 (&acc)[2][2][4][2], const Unit& u, int ui, int wr, int wc, int fr, int fq) const {
        const int rt0 = wr * 64 + fr, col0 = u.pn * BM + wc * 32 + 8 * fq;
        const bool sq = G1 && (u.pn == sqtile || u.pn == sqtile + 1);
#pragma unroll
        for (int ai = 0; ai < 2; ++ai)
#pragma unroll
            for (int m = 0; m < 4; ++m) { const int rt = rt0 + ai * HALF + m * 16; const float s = rstd[ui * 256 + rt];
                bf16_t* rowp = O + (size_t)(u.pm * BM + rt) * ldc + col0;
                if constexpr (G1) { if (u.pn == kvtile) rowp = KV + (size_t)(u.pm * BM + rt) * 256 + wc * 32 + 8 * fq; }
                float ss = 0.f;
                if constexpr (G1) { if (u.pn >= gtile) {
                    const f32x4 a0 = acc[ai][0][m][0] * s, a1 = acc[ai][0][m][1] * s, b0 = acc[ai][1][m][0] * s, b1 = acc[ai][1][m][1] * s;
                    float ea[8], eb[8], rh[8], sb[8];
#pragma unroll
                    for (int j = 0; j < 4; ++j) { ea[j] = 1.0f + __expf(-a0[j]); ea[4 + j] = 1.0f + __expf(-a1[j]); eb[j] = 1.0f + __expf(-b0[j]); eb[4 + j] = 1.0f + __expf(-b1[j]); }
#pragma unroll
                    for (int j = 0; j < 8; ++j) { const float ia = __builtin_amdgcn_rcpf(ea[j]); rh[j] = eb[j] * ia; sb[j] = __builtin_amdgcn_rcpf(eb[j]); }
                    const size_t go = (size_t)(u.pm * BM + rt) * 2048 + (u.pn - gtile) * 128 + wc * 32 + 8 * fq;
                    u32x4 wr_, ws_; wr_.x = cvt_pk_bf16(rh[0], rh[1]); wr_.y = cvt_pk_bf16(rh[2], rh[3]); wr_.z = cvt_pk_bf16(rh[4], rh[5]); wr_.w = cvt_pk_bf16(rh[6], rh[7]);
                    ws_.x = cvt_pk_bf16(sb[0], sb[1]); ws_.y = cvt_pk_bf16(sb[2], sb[3]); ws_.z = cvt_pk_bf16(sb[4], sb[5]); ws_.w = cvt_pk_bf16(sb[6], sb[7]);
                    *(u32x4*)(RHO + go) = wr_; *(u32x4*)(SGB + go) = ws_;
                    continue; } }
#pragma unroll
                for (int bj = 0; bj < 2; ++bj) { const f32x4 v0 = acc[ai][bj][m][0] * s, v1 = acc[ai][bj][m][1] * s;
                    ss += (v0[0] * v0[0] + v0[1] * v0[1]) + (v0[2] * v0[2] + v0[3] * v0[3]) + (v1[0] * v1[0] + v1[1] * v1[1]) + (v1[2] * v1[2] + v1[3] * v1[3]);
                    u32x4 w; w.x = cvt_pk_bf16(v0[0], v0[1]); w.y = cvt_pk_bf16(v0[2], v0[3]); w.z = cvt_pk_bf16(v1[0], v1[1]); w.w = cvt_pk_bf16(v1[2], v1[3]);
                    *(u32x4*)(rowp + bj * HALF) = w;
                    if constexpr (G1) { if (bj == 1 && u.pn == kvtile) {
                        const int row = u.pm * BM + rt; bf16_t* vt = VT + ((size_t)(row >> 12) * 128 + wc * 32 + 8 * fq) * 4128 + (row & 4095) + 16;
                        vt[0 * 4128] = (bf16_t)(w.x & 0xffffu); vt[1 * 4128] = (bf16_t)(w.x >> 16); vt[2 * 4128] = (bf16_t)(w.y & 0xffffu); vt[3 * 4128] = (bf16_t)(w.y >> 16);
                        vt[4 * 4128] = (bf16_t)(w.z & 0xffffu); vt[5 * 4128] = (bf16_t)(w.z >> 16); vt[6 * 4128] = (bf16_t)(w.w & 0xffffu); vt[7 * 4128] = (bf16_t)(w.w >> 16); } } }
                if constexpr (G1) if (sq) { ss += __shfl_xor(ss, 16); ss += __shfl_xor(ss, 32); if (fq == 0) RSQ[(size_t)(u.pm * BM + rt) * 8 + (u.pn - sqtile) * 4 + wc] = ss; } }
    }
};
struct EpiPA {
    static constexpr bool PERM = false, AFTER_DRAIN = false;
    float* P; const bf16_t* G; int ldg;
    __device__ __forceinline__ void operator()(const f32x4 (&acc)[2][2][4][2], const Unit& u, int ui, int wr, int wc, int fr, int fq) const {
        const int col0 = u.pn * BM + wc * 32 + 4 * fq;
#pragma unroll
        for (int ai = 0; ai < 2; ++ai)
#pragma unroll
            for (int m = 0; m < 4; ++m) { const int row = u.pm * BM + ai * HALF + wr * 64 + m * 16 + fr;
#pragma unroll
                for (int bj = 0; bj < 2; ++bj)
#pragma unroll
                    for (int n = 0; n < 2; ++n) { const int c = col0 + bj * HALF + n * 16; const u32x2 g = *(const u32x2*)(G + (size_t)row * ldg + c);
                        f32x4 v = acc[ai][bj][m][n]; v[0] *= sigm(bf_lo(g.x)); v[1] *= sigm(bf_hi(g.x)); v[2] *= sigm(bf_lo(g.y)); v[3] *= sigm(bf_hi(g.y));
                        *(f32x4*)(P + (size_t)row * 2048 + c) = v; } }
    }
};
struct EpiMerge {
    static constexpr bool PERM = true, AFTER_DRAIN = false;
    bf16_t* O; const float* P; const bf16_t* G; int ldg;
    __device__ __forceinline__ void operator()(const f32x4 (&acc)[2][2][4][2], const Unit& u, int ui, int wr, int wc, int fr, int fq) const {
        const int col0 = u.pn * BM + wc * 32 + 8 * fq;
#pragma unroll
        for (int ai = 0; ai < 2; ++ai)
#pragma unroll
            for (int m = 0; m < 4; ++m) { const int row = u.pm * BM + ai * HALF + wr * 64 + m * 16 + fr;
#pragma unroll
                for (int bj = 0; bj < 2; ++bj) { const int c = col0 + bj * HALF; const u32x4 g = *(const u32x4*)(G + (size_t)row * ldg + c);
                    const f32x4 p0 = *(const f32x4*)(P + (size_t)row * 2048 + c), p1 = *(const f32x4*)(P + (size_t)row * 2048 + c + 4);
                    f32x4 v0 = acc[ai][bj][m][0], v1 = acc[ai][bj][m][1];
                    v0[0] = p0[0] + sigm(bf_lo(g.x)) * v0[0]; v0[1] = p0[1] + sigm(bf_hi(g.x)) * v0[1]; v0[2] = p0[2] + sigm(bf_lo(g.y)) * v0[2]; v0[3] = p0[3] + sigm(bf_hi(g.y)) * v0[3];
                    v1[0] = p1[0] + sigm(bf_lo(g.z)) * v1[0]; v1[1] = p1[1] + sigm(bf_hi(g.z)) * v1[1]; v1[2] = p1[2] + sigm(bf_lo(g.w)) * v1[2]; v1[3] = p1[3] + sigm(bf_hi(g.w)) * v1[3];
                    u32x4 w; w.x = cvt_pk_bf16(v0[0], v0[1]); w.y = cvt_pk_bf16(v0[2], v0[3]); w.z = cvt_pk_bf16(v1[0], v1[1]); w.w = cvt_pk_bf16(v1[2], v1[3]);
                    *(u32x4*)(O + (size_t)row * 2048 + c) = w; } }
    }
};
struct EpiG4 {
    static constexpr bool PERM = true, AFTER_DRAIN = false;
    bf16_t* O; float* P; const bf16_t* GA; const bf16_t* GB; int ldg;
    __device__ __forceinline__ void operator()(const f32x4 (&acc)[2][2][4][2], const Unit& u, int ui, int wr, int wc, int fr, int fq) const {
        const int col0 = u.pn * BM + wc * 32 + 8 * fq;
        const bf16_t* G = u.sel ? GB : GA;
#pragma unroll
        for (int ai = 0; ai < 2; ++ai)
#pragma unroll
            for (int m = 0; m < 4; ++m) { const int row = u.pm * BM + ai * HALF + wr * 64 + m * 16 + fr;
#pragma unroll
                for (int bj = 0; bj < 2; ++bj) { const int c = col0 + bj * HALF; const u32x4 g = *(const u32x4*)(G + (size_t)row * ldg + c);
                    f32x4 v0 = acc[ai][bj][m][0], v1 = acc[ai][bj][m][1];
                    v0[0] *= sigm(bf_lo(g.x)); v0[1] *= sigm(bf_hi(g.x)); v0[2] *= sigm(bf_lo(g.y)); v0[3] *= sigm(bf_hi(g.y));
                    v1[0] *= sigm(bf_lo(g.z)); v1[1] *= sigm(bf_hi(g.z)); v1[2] *= sigm(bf_lo(g.w)); v1[3] *= sigm(bf_hi(g.w));
                    float* pp = P + (size_t)row * 2048 + c;
                    if (u.sel == 0) { *(f32x4*)pp = v0; *(f32x4*)(pp + 4) = v1; }
                    else { v0 += *(const f32x4*)pp; v1 += *(const f32x4*)(pp + 4);
                        u32x4 w; w.x = cvt_pk_bf16(v0[0], v0[1]); w.y = cvt_pk_bf16(v0[2], v0[3]); w.z = cvt_pk_bf16(v1[0], v1[1]); w.w = cvt_pk_bf16(v1[2], v1[3]);
                        *(u32x4*)(O + (size_t)row * 2048 + c) = w; } } }
    }
};
struct EpiG4m {
    static constexpr bool PERM = true, AFTER_DRAIN = false, MIDK = true;
    bf16_t* O; const bf16_t* RHO; const bf16_t* SGB;
    __device__ __forceinline__ void scale(f32x4 (&acc)[2][2][4][2], const bf16_t* T, const Unit& u, int wr, int wc, int fr, int fq) const {
        const int col0 = u.pn * BM + wc * 32 + 8 * fq;
        u32x4 gv[2][4][2];
#pragma unroll
        for (int ai = 0; ai < 2; ++ai)
#pragma unroll
            for (int m = 0; m < 4; ++m)
#pragma unroll
                for (int bj = 0; bj < 2; ++bj) gv[ai][m][bj] = *(const u32x4*)(T + (size_t)(u.pm * BM + ai * HALF + wr * 64 + m * 16 + fr) * 2048 + col0 + bj * HALF);
        __builtin_amdgcn_sched_barrier(0);
#pragma unroll
        for (int ai = 0; ai < 2; ++ai)
#pragma unroll
            for (int m = 0; m < 4; ++m)
#pragma unroll
                for (int bj = 0; bj < 2; ++bj) { const u32x4 g = gv[ai][m][bj]; f32x4& v0 = acc[ai][bj][m][0]; f32x4& v1 = acc[ai][bj][m][1];
                    v0[0] *= bf_lo(g.x); v0[1] *= bf_hi(g.x); v0[2] *= bf_lo(g.y); v0[3] *= bf_hi(g.y); v1[0] *= bf_lo(g.z); v1[1] *= bf_hi(g.z); v1[2] *= bf_lo(g.w); v1[3] *= bf_hi(g.w); }
    }
    __device__ __forceinline__ void midk(f32x4 (&acc)[2][2][4][2], const Unit& u, int wr, int wc, int fr, int fq) const {
        asm volatile("" : "+v"(fr), "+v"(fq));
        scale(acc, RHO, u, wr, wc, fr, fq);
    }
    __device__ __forceinline__ void operator()(const f32x4 (&acc_)[2][2][4][2], const Unit& u, int ui, int wr, int wc, int fr, int fq) const {
        f32x4 acc[2][2][4][2];
#pragma unroll
        for (int a = 0; a < 2; ++a)
#pragma unroll
            for (int b = 0; b < 2; ++b)
#pragma unroll
                for (int m = 0; m < 4; ++m)
#pragma unroll
                    for (int n = 0; n < 2; ++n) acc[a][b][m][n] = acc_[a][b][m][n];
        scale(acc, SGB, u, wr, wc, fr, fq);
        const int col0 = u.pn * BM + wc * 32 + 8 * fq;
#pragma unroll
        for (int ai = 0; ai < 2; ++ai)
#pragma unroll
            for (int m = 0; m < 4; ++m) { const int row = u.pm * BM + ai * HALF + wr * 64 + m * 16 + fr;
#pragma unroll
                for (int bj = 0; bj < 2; ++bj) { const f32x4 v0 = acc[ai][bj][m][0], v1 = acc[ai][bj][m][1];
                    u32x4 w; w.x = cvt_pk_bf16(v0[0], v0[1]); w.y = cvt_pk_bf16(v0[2], v0[3]); w.z = cvt_pk_bf16(v1[0], v1[1]); w.w = cvt_pk_bf16(v1[2], v1[3]);
                    *(u32x4*)(O + (size_t)row * 2048 + col0 + bj * HALF) = w; } }
    }
};
struct DualOrder : StaticOrder {
    __host__ __device__ bool next(int i, Unit& u) const { if (!StaticOrder::next(i >> 1, u)) return false; u.sel = i & 1; return true; }
};
struct EpiRes {
    static constexpr bool PERM = false, AFTER_DRAIN = false;
    bf16_t* HB; float* RS;
    __device__ __forceinline__ void operator()(const f32x4 (&acc)[2][2][4][2], const Unit& u, int ui, int wr, int wc, int fr, int fq) const {
        const int col0 = u.pn * BM + wc * 32 + 4 * fq;
        u32x2 ho[2][4][2][2];
#pragma unroll
        for (int ai = 0; ai < 2; ++ai)
#pragma unroll
            for (int m = 0; m < 4; ++m) { const int row = u.pm * BM + ai * HALF + wr * 64 + m * 16 + fr;
#pragma unroll
                for (int bj = 0; bj < 2; ++bj)
#pragma unroll
                    for (int n = 0; n < 2; ++n) ho[ai][m][bj][n] = *(const u32x2*)(HB + (size_t)row * 2048 + col0 + bj * HALF + n * 16); }
        __builtin_amdgcn_sched_barrier(0);
#pragma unroll
        for (int ai = 0; ai < 2; ++ai)
#pragma unroll
            for (int m = 0; m < 4; ++m) { const int row = u.pm * BM + ai * HALF + wr * 64 + m * 16 + fr; float ss = 0.f;
#pragma unroll
                for (int bj = 0; bj < 2; ++bj)
#pragma unroll
                    for (int n = 0; n < 2; ++n) { const size_t off = (size_t)row * 2048 + col0 + bj * HALF + n * 16;
                        const u32x2 h0 = ho[ai][m][bj][n];
                        f32x4 hv = {bf_lo(h0.x), bf_hi(h0.x), bf_lo(h0.y), bf_hi(h0.y)}; hv += acc[ai][bj][m][n];
                        u32x2 w; w.x = cvt_pk_bf16(hv[0], hv[1]); w.y = cvt_pk_bf16(hv[2], hv[3]); *(u32x2*)(HB + off) = w;
                        ss += (hv[0] * hv[0] + hv[1] * hv[1]) + (hv[2] * hv[2] + hv[3] * hv[3]); }
                ss += __shfl_xor(ss, 16); ss += __shfl_xor(ss, 32);
                if (fq == 0) RS[(size_t)row * 32 + u.pn * 4 + wc] = ss; }
    }
};
}

#define GAS __attribute__((address_space(1)))
#define LAS __attribute__((address_space(3)))
typedef unsigned short bf16;
typedef unsigned v4u __attribute__((ext_vector_type(4)));
typedef float f32x4 __attribute__((ext_vector_type(4)));
typedef short bf16x8 __attribute__((ext_vector_type(8)));
typedef GAS unsigned gu32;
typedef GAS unsigned long long gu64;
#define RLX_AGENT __ATOMIC_RELAXED, __HIP_MEMORY_SCOPE_AGENT
#define LDS_WAIT() asm volatile("s_waitcnt lgkmcnt(0)" ::: "memory")
#define VM_WAIT() asm volatile("s_waitcnt vmcnt(0)" ::: "memory")
__device__ __forceinline__ unsigned long long rt() { return __builtin_amdgcn_s_memrealtime(); }
__device__ __forceinline__ unsigned f2bf(float f) { unsigned u = __builtin_bit_cast(unsigned, f); return (u + 0x7fffu + ((u >> 16) & 1u)) >> 16; }
__device__ __forceinline__ unsigned pk2(float lo, float hi) { return f2bf(lo) | (f2bf(hi) << 16); }

#define XB_TMO      128
#define XB_XCNT(j)  (256  + 64 * (j))
#define XB_XSUB(j)  (1280 + 64 * (j))
#define XB_XGEN(j)  (2304 + 64 * (j))
#define XB_TOP      3328
#define XB_TOPGEN   3392
#define XCD_BAR_WORDS 3456
#define XB_SPIN_CAP (1u << 18)

__device__ __forceinline__ unsigned xb_ld(unsigned* p)              { return __hip_atomic_load(p, __ATOMIC_RELAXED, __HIP_MEMORY_SCOPE_AGENT); }
__device__ __forceinline__ unsigned xb_add(unsigned* p, unsigned v) { return __hip_atomic_fetch_add(p, v, __ATOMIC_RELAXED, __HIP_MEMORY_SCOPE_AGENT); }
__device__ __forceinline__ unsigned xb_xcc_id() { return (unsigned)__builtin_amdgcn_s_getreg((3 << 11) | 20) & 0xFu; }
#define XB_SPIN(cond, bar) do { unsigned _sp = 0; while (cond) { __builtin_amdgcn_s_sleep(1); \
    if ((++_sp & 255u) == 0u) { if (xb_ld(&(bar)[XB_TMO])) break; if (_sp > XB_SPIN_CAP) { atomicAdd(&(bar)[XB_TMO], 1u); break; } } } } while (0)

struct XcdBarrier {
    unsigned* bar; unsigned x;
    volatile LAS unsigned* st;
};

__device__ __forceinline__ XcdBarrier xcd_barrier_post(unsigned* bar, volatile LAS unsigned* st) {
    XcdBarrier b; b.bar = bar; b.x = xb_xcc_id(); b.st = st;
    if (threadIdx.x == 0) (void)xb_add(&bar[XB_XCNT(b.x)], 1u);
    return b;
}
__device__ __forceinline__ void xcd_barrier_complete(unsigned* bar, unsigned x, unsigned& nloc, unsigned& nx) {
    const unsigned G = gridDim.x * gridDim.y * gridDim.z;
    unsigned sum, cnt, mine, sp = 0u;
    for (;;) {
        sum = 0u; cnt = 0u; mine = 0u;
#pragma unroll
        for (unsigned j = 0; j < 16; ++j) { const unsigned c = xb_ld(&bar[XB_XCNT(j)]); sum += c; cnt += (c > 0u) ? 1u : 0u; mine = (j == x) ? c : mine; }
        if (sum == G) break;
        __builtin_amdgcn_s_sleep(1);
        if ((++sp & 255u) == 0u) { if (xb_ld(&bar[XB_TMO])) break; if (sp > XB_SPIN_CAP) { atomicAdd(&bar[XB_TMO], 1u); break; } }
    }
    nloc = mine > 0u ? mine : 1u; nx = cnt > 0u ? cnt : 1u;
}

__device__ __forceinline__ void xcd_barrier(const XcdBarrier& b, bool thread0) {
    asm volatile("s_waitcnt vmcnt(0)" ::: "memory");
    __syncthreads();
    if (thread0) {
        unsigned* bar = b.bar;
        __builtin_amdgcn_s_waitcnt(0);
        unsigned nloc = b.st[0], nx = b.st[1];
        if (nloc == 0u) { xcd_barrier_complete(bar, b.x, nloc, nx); b.st[0] = nloc; b.st[1] = nx; }
        const unsigned old = xb_add(&bar[XB_XSUB(b.x)], 1u);
        const unsigned gen = old / nloc;
        if (old + 1u == (gen + 1u) * nloc) {
            __builtin_amdgcn_fence(__ATOMIC_RELEASE, "agent");
            asm volatile("s_waitcnt vmcnt(0)" ::: "memory");
            const unsigned og = xb_add(&bar[XB_TOP], 1u);
            const unsigned tg = og / nx;
            if (og + 1u == (tg + 1u) * nx) xb_add(&bar[XB_TOPGEN], 1u);
            else XB_SPIN(xb_ld(&bar[XB_TOPGEN]) == tg, bar);
            __builtin_amdgcn_fence(__ATOMIC_ACQUIRE, "agent");
            xb_add(&bar[XB_XGEN(b.x)], 1u);
            asm volatile("s_waitcnt vmcnt(0)" ::: "memory");
        } else {
            XB_SPIN(xb_ld(&bar[XB_XGEN(b.x)]) == gen, bar);
            __builtin_amdgcn_fence(__ATOMIC_ACQUIRE, "agent");
            asm volatile("s_waitcnt vmcnt(0)" ::: "memory");
        }
    }
    __syncthreads();
}
#ifndef MK_PROBE
#define MK_PROBE (-1)
#endif
#ifndef MK_PROBE_BLOCK
#define MK_PROBE_BLOCK 0
#endif
#ifndef MK_PROBE_SCALE
#define MK_PROBE_SCALE 2e-6f
#endif
#define PROBE_T0() unsigned pt0_ = 0; if (MK_PROBE >= 0) { pt0_ = (unsigned)__builtin_amdgcn_readfirstlane((int)(unsigned)__builtin_amdgcn_s_memtime()); asm volatile("s_waitcnt lgkmcnt(0)" ::: "memory"); }
#define PROBE_T1(id) do { if (MK_PROBE == (id)) { const unsigned pt1_ = (unsigned)__builtin_amdgcn_readfirstlane((int)(unsigned)__builtin_amdgcn_s_memtime()); asm volatile("s_waitcnt lgkmcnt(0)" ::: "memory"); \
    if (C.bid == MK_PROBE_BLOCK && C.wave == 0 && C.lane == 0) { volatile LAS unsigned* pw_ = (volatile LAS unsigned*)(C.lds + MISC_OFF + 64); pw_[0] = pw_[0] + (unsigned)(pt1_ - pt0_); } } } while (0)
constexpr int NWAVES = 8;
constexpr int NLAYER = 4, DM = 2048, NBATCH = 2, SEQ = 4096, NMETA = 16, LTOK = SEQ + NMETA, NTOK = NBATCH * LTOK;
constexpr int MP = 8448;
constexpr int NP1 = 8448;
constexpr int NC_IN = 8264;
constexpr int PC_QA = 0, PC_KA = 1024, PC_VA = 1152, PC_ZA = 1280, PC_CQ = 2304, PC_CKV = 2816, PC_ZB = 3072, PC_GA = 4096, PC_GB = 6144, PC_KIDX = 8192, PC_WIDX = 8256;
constexpr int NQ2 = 4608;
constexpr int TOPK = 256;
constexpr int YLD = 2048;
constexpr float RMS_EPS = 1e-6f;

__device__ __forceinline__ int rowof(int b, int t) { return t < NMETA ? 8192 + b * NMETA + t : b * SEQ + (t - NMETA); }
__device__ __forceinline__ int t5_bucket(int d) {
    const int n = d < 0 ? 0 : d;
    if (n < 16) return n;
    return 16 + (n >= 19) + (n >= 21) + (n >= 24) + (n >= 27) + (n >= 31) + (n >= 35) + (n >= 40) + (n >= 46) + (n >= 52) + (n >= 59) + (n >= 67) + (n >= 77) + (n >= 87) + (n >= 99) + (n >= 113);
}
__device__ __forceinline__ float bf2f(bf16 v) { return __uint_as_float((unsigned)v << 16); }
__device__ __forceinline__ float sigmoidf_(float x) { return 1.0f / (1.0f + __expf(-x)); }
__device__ __forceinline__ float siluf_(float x) { return x / (1.0f + __expf(-x)); }
__device__ __forceinline__ float wave_sum(float v) {
#pragma unroll
    for (int o = 1; o < 64; o <<= 1) v += __shfl_xor(v, o);
    return v;
}
__device__ __forceinline__ float wave_max(float v) {
#pragma unroll
    for (int o = 1; o < 64; o <<= 1) v = fmaxf(v, __shfl_xor(v, o));
    return v;
}
__device__ __forceinline__ int wave_sum_i(int v) {
#pragma unroll
    for (int o = 1; o < 64; o <<= 1) v += __shfl_xor(v, o);
    return v;
}

constexpr size_t MiB = 1u << 20;
constexpr size_t WS_CTL = 0, CTL_ZERO_BYTES = 1 * MiB;
constexpr size_t SZ_W1 = (size_t)NLAYER * NP1 * DM * 2, SZ_W2 = (size_t)NLAYER * NQ2 * 512 * 2, SZ_WA = (size_t)NLAYER * DM * 1024 * 2, SZ_WO = (size_t)NLAYER * DM * DM * 2;
constexpr size_t al(size_t x) { return (x + 4095) / 4096 * 4096; }
constexpr size_t WS_W1 = 1 * MiB, WS_W2 = WS_W1 + al(SZ_W1), WS_WA = WS_W2 + al(SZ_W2), WS_WB = WS_WA + 1024 * 2, WS_WO = WS_WA + al(2 * SZ_WA);
constexpr size_t SZ_WUV = (size_t)NLAYER * 16 * 64 * 256 * 2;
constexpr size_t WS_WUV = WS_WO + al(SZ_WO);
constexpr size_t WS_VT = WS_WUV + al(SZ_WUV);
constexpr size_t WS_KV = WS_VT + al((size_t)2 * 128 * 4128 * 2), WS_KIDX = WS_KV + al((size_t)MP * 256 * 2);
constexpr size_t WS_H = WS_KIDX + al((size_t)MP * 64 * 2), WS_HB = WS_H + al((size_t)MP * DM * 4), WS_RS = WS_HB + al((size_t)MP * DM * 2);
constexpr size_t WS_RS2 = WS_RS + al((size_t)MP * 32 * 4);
constexpr size_t WS_RSQ = WS_RS2 + al((size_t)32 * 64 * 4), WS_RSQ2 = WS_RSQ + al((size_t)MP * 8 * 4);
constexpr size_t WS_PROJ = WS_RSQ2 + al((size_t)32 * 16 * 4), WS_CQN = WS_PROJ + al((size_t)MP * NP1 * 2), WS_CKVN = WS_CQN + al((size_t)MP * 512 * 2);
constexpr size_t WS_Q2 = WS_CKVN + al((size_t)MP * 256 * 2), WS_OLAT = WS_Q2 + al((size_t)MP * NQ2 * 2), WS_YA = WS_OLAT + al((size_t)256 * 3 * 16 * 8 * 64 * 8 * 2);
constexpr size_t WS_YB = WS_YA + 1024 * 2, WS_PA = WS_YA + al((size_t)MP * 2048 * 2),
 WS_MG = WS_PA + al((size_t)MP * DM * 4), WS_RHO = WS_MG + al((size_t)MP * DM * 2), WS_SGB = WS_RHO + al((size_t)MP * DM * 2), WS_W1K = WS_SGB + al((size_t)MP * DM * 2), WS_END = WS_W1K + al((size_t)NLAYER * 32 * 3 * 4 * 512 * 2);
constexpr int CW_TMO = 0, CW_CODE = 1, CW_BAR = 4096, CW_DSAQ = 16384, CW_SWAQ = 20480;

constexpr int LDSCTL_OFF = 0, MISC_OFF = LDSCTL_OFF + 320;
constexpr int RSTD_OFF = 512;
constexpr int RING_OFF = 8192, RING_BYTES = 131072;
constexpr int LDS_BYTES = 163840;
static_assert(RSTD_OFF + 5 * 256 * 4 <= RING_OFF, "LDS map");

struct Args {
    const float* x; const float* meta; const float* bias_table; const float* norm_g; const float* w_in; const float* q_norm_g; const float* kv_norm_g; const float* w_qb; const float* w_iq;
    const float* w_uk; const float* w_uv; const float* sinks; const float* w_proj_a; const float* w_proj_b; const float* w_out; const float* final_g;
    float* out; unsigned char* ws; int ph_lo, ph_hi;
};

__device__ __forceinline__ unsigned pkh(float lo, float hi) { typedef float f2_t __attribute__((ext_vector_type(2))); typedef __bf16 b2_t __attribute__((ext_vector_type(2))); f2_t v = {lo, hi}; b2_t b = __builtin_convertvector(v, b2_t); return __builtin_bit_cast(unsigned, b); }
struct XDesc { const float* W; const float* scale; bf16* out; int ldw, k0, c0, nvalid, K; };
__device__ __forceinline__ void xpose_load(const XDesc& d, float (&v)[32], int lane) {
    asm volatile("" : "+v"(lane));
    const int c = lane & 31, cc = (c < d.nvalid) ? c : 0; const float* p = d.W + (size_t)(d.k0 + (lane >> 5)) * d.ldw + d.c0 + cc;
    const float keep = (c < d.nvalid) ? 1.f : 0.f;
#pragma unroll
    for (int i = 0; i < 32; ++i) v[i] = p[(size_t)(2 * i) * d.ldw];
#pragma unroll
    for (int i = 0; i < 32; ++i) v[i] *= keep;
    if (d.scale) {
#pragma unroll
        for (int i = 0; i < 32; ++i) v[i] *= d.scale[d.k0 + 2 * i + (lane >> 5)];
    }
}
__device__ __forceinline__ void xpose_store(const XDesc& d, const float (&v)[32], LAS float* scr, int lane) {
    asm volatile("" : "+v"(lane));
    const int c = lane & 31;
#pragma unroll
    for (int i = 0; i < 32; ++i) scr[(2 * i + (lane >> 5)) * 33 + c] = v[i];
    LDS_WAIT(); asm volatile("" ::: "memory");
    const int cc = lane & 7;
#pragma unroll
    for (int j = 0; j < 4; ++j) { const int n = (lane >> 3) + 8 * j; const LAS float* s = scr + (8 * cc) * 33 + n;
        v4u o; o.x = pkh(s[0 * 33], s[1 * 33]); o.y = pkh(s[2 * 33], s[3 * 33]); o.z = pkh(s[4 * 33], s[5 * 33]); o.w = pkh(s[6 * 33], s[7 * 33]);
        *(GAS v4u*)(d.out + (size_t)n * d.K + d.k0 + 8 * cc) = o; }
    LDS_WAIT(); asm volatile("" ::: "memory");
}
__device__ __forceinline__ void fold_split(const float (&x)[8], bf16x8& hi, bf16x8& lo) {
    unsigned hw[4], lw[4];
#pragma unroll
    for (int j = 0; j < 4; ++j) { hw[j] = pkh(x[2 * j], x[2 * j + 1]);
        const float r0 = x[2 * j] - __uint_as_float(hw[j] << 16), r1 = x[2 * j + 1] - __uint_as_float(hw[j] & 0xffff0000u); lw[j] = pkh(r0, r1); }
    const v4u h4 = {hw[0], hw[1], hw[2], hw[3]}, l4 = {lw[0], lw[1], lw[2], lw[3]};
    hi = __builtin_bit_cast(bf16x8, h4); lo = __builtin_bit_cast(bf16x8, l4);
}
__device__ __forceinline__ void fold_item(const float* __restrict__ wqb, const float* __restrict__ wuk, const float* __restrict__ gq, bf16* W2l, int h, int kb, int rb, LAS float* scr, int lane) {
    asm volatile("" : "+v"(lane));
    (void)scr;
    const int n = lane & 31, hh = lane >> 5;
    f32x4 av[2][4][2]; float bvv[4][8]; f32x4 gv[2][4];
#pragma unroll
    for (int mt = 0; mt < 2; ++mt)
#pragma unroll
        for (int s = 0; s < 4; ++s) { const float* p = wqb + (size_t)(kb * 64 + mt * 32 + n) * 1024 + h * 64 + 16 * s + 8 * hh; av[mt][s][0] = *(const f32x4*)p; av[mt][s][1] = *(const f32x4*)(p + 4); }
#pragma unroll
    for (int s = 0; s < 4; ++s)
#pragma unroll
        for (int j = 0; j < 8; ++j) bvv[s][j] = wuk[((size_t)h * 64 + 16 * s + 8 * hh + j) * 256 + rb * 32 + n];
#pragma unroll
    for (int mt = 0; mt < 2; ++mt)
#pragma unroll
        for (int q = 0; q < 4; ++q) gv[mt][q] = *(const f32x4*)(gq + kb * 64 + mt * 32 + 8 * q + 4 * hh);
    typedef float f32x16_ __attribute__((ext_vector_type(16)));
    f32x16_ acc[2] = {};
#pragma unroll
    for (int s = 0; s < 4; ++s) { bf16x8 bh, bl; fold_split(bvv[s], bh, bl);
#pragma unroll
        for (int mt = 0; mt < 2; ++mt) { const float x[8] = {av[mt][s][0][0], av[mt][s][0][1], av[mt][s][0][2], av[mt][s][0][3], av[mt][s][1][0], av[mt][s][1][1], av[mt][s][1][2], av[mt][s][1][3]};
            bf16x8 ah, al; fold_split(x, ah, al);
            acc[mt] = __builtin_amdgcn_mfma_f32_32x32x16_bf16(al, bh, acc[mt], 0, 0, 0);
            acc[mt] = __builtin_amdgcn_mfma_f32_32x32x16_bf16(ah, bl, acc[mt], 0, 0, 0);
            acc[mt] = __builtin_amdgcn_mfma_f32_32x32x16_bf16(ah, bh, acc[mt], 0, 0, 0); } }
    bf16* out = W2l + (size_t)(h * 256 + rb * 32 + n) * 512 + kb * 64 + 4 * hh;
#pragma unroll
    for (int mt = 0; mt < 2; ++mt)
#pragma unroll
        for (int q = 0; q < 4; ++q) { const f32x4 g = gv[mt][q]; pg8::u32x2 o;
            o.x = pkh(acc[mt][4 * q] * g[0], acc[mt][4 * q + 1] * g[1]); o.y = pkh(acc[mt][4 * q + 2] * g[2], acc[mt][4 * q + 3] * g[3]);
            *(pg8::u32x2*)(out + mt * 32 + 8 * q) = o; }
}

typedef const __attribute__((address_space(4))) Args KArgs;
__device__ __forceinline__ KArgs* kargs() { size_t z = 0; asm volatile("" : "+s"(z)); return (KArgs*)((const __attribute__((address_space(4))) unsigned char*)__builtin_amdgcn_kernarg_segment_ptr() + z); }
struct Ctx {
    LAS unsigned char* lds; int tid, lane, wave, G, gw, NGW, bid;
};
#if defined(__HIP_DEVICE_COMPILE__)
#define ASSUME_GLOBAL(p) do { __builtin_assume(!__builtin_amdgcn_is_shared((const void*)(p))); __builtin_assume(!__builtin_amdgcn_is_private((const void*)(p))); } while (0)
#else
#define ASSUME_GLOBAL(p) do { } while (0)
#endif
__device__ __forceinline__ unsigned char* launder(unsigned char* p) { size_t z = 0; asm volatile("" : "+s"(z)); return p + z; }
__device__ __forceinline__ const float* launderf(const float* p) { size_t z = 0; asm volatile("" : "+s"(z)); return p + z; }
struct Bufs {
    bf16 *W1K, *W1, *W2, *WA, *WB, *WO, *WUV, *VT, *KV, *KIDX, *RHO, *SGB, *HB, *PROJ, *CQN, *CKVN, *Q2, *OLAT, *YA, *YB, *MG; float *H, *RS, *RS2, *RSQ, *RSQ2, *PA;
    __device__ __forceinline__ explicit Bufs(unsigned char* ws0) {
        unsigned char* ws = launder(ws0);
        W1K = (bf16*)(ws + WS_W1K); W1 = (bf16*)(ws + WS_W1); W2 = (bf16*)(ws + WS_W2); WA = (bf16*)(ws + WS_WA); WB = (bf16*)(ws + WS_WB); WO = (bf16*)(ws + WS_WO); WUV = (bf16*)(ws + WS_WUV); VT = (bf16*)(ws + WS_VT); KV = (bf16*)(ws + WS_KV); KIDX = (bf16*)(ws + WS_KIDX); RHO = (bf16*)(ws + WS_RHO); SGB = (bf16*)(ws + WS_SGB);
        H = (float*)(ws + WS_H); HB = (bf16*)(ws + WS_HB); RS = (float*)(ws + WS_RS); RS2 = (float*)(ws + WS_RS2); RSQ = (float*)(ws + WS_RSQ); RSQ2 = (float*)(ws + WS_RSQ2); PROJ = (bf16*)(ws + WS_PROJ); CQN = (bf16*)(ws + WS_CQN); CKVN = (bf16*)(ws + WS_CKVN);
        Q2 = (bf16*)(ws + WS_Q2); OLAT = (bf16*)(ws + WS_OLAT); YA = (bf16*)(ws + WS_YA); YB = (bf16*)(ws + WS_YB); PA = (float*)(ws + WS_PA); MG = (bf16*)(ws + WS_MG);
    }
};

__device__ __forceinline__ void p0_prologue(const Ctx& C) {
    const Bufs B(kargs()->ws);
    const KArgs& A = *kargs();
    LAS float* scr = (LAS float*)(C.lds + RING_OFF + C.wave * 16384);
    constexpr int I_T1 = (DM / 64) * (NP1 / 32), I_T2 = (512 / 64) * (512 / 32), I_T3 = (1024 / 64) * (DM / 32), I_T5 = (DM / 64) * (DM / 32), I_F = 16 * 8 * 8, I_UV = 16 * 8;
    constexpr int I_X = I_T1 + I_T2 + 2 * I_T3 + I_T5, NX = NLAYER * I_X;
    auto decode = [&](int it) -> XDesc {
        const int l = it / I_X; int r = it % I_X; XDesc d;
        if (r < I_T1) { const int nblk = NP1 / 32, kb = r / nblk, n0 = (r % nblk) * 32; int c0, nvalid = 32;
            if (n0 < 4096) c0 = n0; else if (n0 < 8192) { const int tt = (n0 - 4096) >> 8, wi = (n0 - 4096) & 255; c0 = (wi < 128 ? 4168 : 6216 - 128) + 128 * tt + wi; }
            else { c0 = n0 - 8192 + 4096; nvalid = (8264 - n0) < 0 ? 0 : ((8264 - n0) > 32 ? 32 : (8264 - n0)); }
            d = XDesc{A.w_in + (size_t)l * DM * NC_IN, A.norm_g + l * DM, B.W1 + ((size_t)l * NP1 + n0) * DM, NC_IN, kb * 64, c0, nvalid, DM}; return d; }
        r -= I_T1;
        if (r < I_T2) { const int nblk = 512 / 32, kb = r / nblk, nb = r % nblk;
            d = XDesc{A.w_iq + (size_t)l * 512 * 512, A.q_norm_g + l * 512, B.W2 + ((size_t)l * NQ2 + 4096 + nb * 32) * 512, 512, kb * 64, nb * 32, 32, 512}; return d; }
        r -= I_T2;
        if (r < 2 * I_T3) { const bool second = r >= I_T3; if (second) r -= I_T3; const int nblk = DM / 32, kb = r / nblk, nb = r % nblk;
            d = XDesc{(second ? A.w_proj_b : A.w_proj_a) + (size_t)l * 1024 * DM, nullptr, (second ? B.WB : B.WA) + ((size_t)l * DM + nb * 32) * 2048, DM, kb * 64, nb * 32, 32, 2048}; return d; }
        r -= 2 * I_T3;
        { const int nblk = DM / 32, kb = r / nblk, nb = r % nblk;
            d = XDesc{A.w_out + (size_t)l * DM * DM, nullptr, B.WO + ((size_t)l * DM + nb * 32) * DM, DM, kb * 64, nb * 32, 32, DM}; return d; }
    };
    const int split = C.gw + 3 * (C.wave & 7) * C.NGW;
#pragma unroll 1
    for (int seg = 0; seg < 2; ++seg) {
    const int it0 = (seg == 0) ? C.gw : split, lim = (seg == 0) ? (split < NX ? split : NX) : NX;
    {
        int it = it0;
        if (it < lim) {
            XDesc dA = decode(it), dB = dA, dC = dA; float vA[32], vB[32], vC[32];
            xpose_load(dA, vA, C.lane);
            if (it + C.NGW < lim) { dB = decode(it + C.NGW); xpose_load(dB, vB, C.lane); }
#define PRO_STEP(dc_, vc_, dn_, vn_) { if (it + 2 * C.NGW < lim) { dn_ = decode(it + 2 * C.NGW); xpose_load(dn_, vn_, C.lane); } xpose_store(dc_, vc_, scr, C.lane); it += C.NGW; if (it >= lim) break; }
            for (;;) {
                PRO_STEP(dA, vA, dC, vC)
                PRO_STEP(dB, vB, dA, vA)
                PRO_STEP(dC, vC, dB, vB)
            }
#undef PRO_STEP
        }
    }
    if (seg == 0) {
    for (int it = C.NGW - 1 - C.gw; it < NLAYER * I_UV; it += C.NGW) {
        const int l = it / I_UV, r = it % I_UV, h = r / 8, s = r % 8;
        const float* wsrc = A.w_uv + ((size_t)l * 16 + h) * 256 * 64; const int gg = C.lane >> 4, cc = C.lane & 15;
#pragma unroll
        for (int nt = 0; nt < 4; ++nt) { const float* p = wsrc + (size_t)(32 * s + 8 * gg) * 64 + 16 * nt + cc;
            v4u o; o.x = pkh(p[0 * 64], p[1 * 64]); o.y = pkh(p[2 * 64], p[3 * 64]); o.z = pkh(p[4 * 64], p[5 * 64]); o.w = pkh(p[6 * 64], p[7 * 64]);
            *(GAS v4u*)(B.WUV + ((((size_t)l * 16 + h) * 8 + s) * 4 + nt) * 512 + C.lane * 8) = o; }
    }
    for (int it = C.NGW - 1 - 512 - C.gw; it >= 0 && it < NLAYER * 96; it += C.NGW) {
        const int l = it / 96, r = it % 96, gk = r / 3, nt = r % 3, n = C.lane & 31, hh = C.lane >> 5, col = nt * 32 + n;
        const float* wsrc = A.w_in + (size_t)l * DM * NC_IN + 4096 + (col < 72 ? col : 0); const float* gsrc = A.norm_g + l * DM; const float keep = col < 72 ? 1.f : 0.f;
#pragma unroll
        for (int s = 0; s < 4; ++s) { const int k0 = gk * 64 + s * 16 + hh * 8; float x[8];
#pragma unroll
            for (int e = 0; e < 8; ++e) x[e] = wsrc[(size_t)(k0 + e) * NC_IN] * gsrc[k0 + e] * keep;
            v4u o; o.x = pkh(x[0], x[1]); o.y = pkh(x[2], x[3]); o.z = pkh(x[4], x[5]); o.w = pkh(x[6], x[7]);
            *(GAS v4u*)(B.W1K + ((((size_t)l * 32 + gk) * 3 + nt) * 4 + s) * 512 + C.lane * 8) = o; }
    }
    for (int it = C.gw; it < NLAYER * I_F; it += C.NGW) {
        const int l = it / I_F, r = it % I_F, h = r / 64, kb = (r / 8) % 8, rb = r % 8;
        fold_item(A.w_qb + (size_t)l * 512 * 1024, A.w_uk + (size_t)l * 16 * 64 * 256, A.q_norm_g + l * 512, B.W2 + (size_t)l * NQ2 * 512, h, kb, rb, scr, C.lane);
    }
    for (int m0 = C.gw; m0 < MP; m0 += 3 * C.NGW) {
        f32x4 vv[3][8];
#pragma unroll
        for (int r = 0; r < 3; ++r) { const int m = m0 + r * C.NGW;
            const float* src = A.x;
            if (m < 8192) src = A.x + (size_t)m * DM; else if (m < 8224) src = A.meta + (size_t)((m - 8192) % NMETA) * DM;
#pragma unroll
            for (int j = 0; j < 8; ++j) vv[r][j] = *(const f32x4*)(src + j * 256 + C.lane * 4); }
        __builtin_amdgcn_sched_barrier(0);
#pragma unroll
        for (int r = 0; r < 3; ++r) { const int m = m0 + r * C.NGW;
            if (m < MP) { const bool keep = m < 8224; float ss = 0.f;
#pragma unroll
                for (int j = 0; j < 8; ++j) { const f32x4 v = keep ? vv[r][j] : (f32x4){0.f, 0.f, 0.f, 0.f};
                    pg8::u32x2 w; w.x = pkh(v[0], v[1]); w.y = pkh(v[2], v[3]); *(pg8::u32x2*)(B.HB + (size_t)m * DM + j * 256 + C.lane * 4) = w;
                    ss += (v[0] * v[0] + v[1] * v[1]) + (v[2] * v[2] + v[3] * v[3]); }
                ss = wave_sum(ss);
                if (C.lane < 32) B.RS[(size_t)m * 32 + C.lane] = (C.lane == 0) ? ss : 0.f;
                if (m >= 8192 && m < 8224) B.RS2[(size_t)(m - 8192) * 64 + C.lane] = (C.lane == 0) ? ss : 0.f;
                if (m >= NTOK) {
#pragma unroll
                    for (int j = 0; j < 2; ++j) { *(v4u*)(B.YA + (size_t)m * YLD + j * 512 + C.lane * 8) = (v4u){0u, 0u, 0u, 0u}; *(v4u*)(B.YB + (size_t)m * YLD + j * 512 + C.lane * 8) = (v4u){0u, 0u, 0u, 0u}; }
                } } }
    }
    }
    }
    if (C.gw < 2) { bf16* kp = B.KIDX + (size_t)(C.gw * 129 + 128) * 2048;
#pragma unroll
        for (int i = 0; i < 2; ++i) { const int q = C.lane + 64 * i, s = q >> 5, hh = (q >> 4) & 1, n = 16 + (q & 15); *(v4u*)(kp + s * 512 + (hh * 32 + n) * 8) = (v4u){0u, 0u, 0u, 0u}; } }
}

template <int NP4>
__device__ __forceinline__ void rstd_table(const Ctx& C, const pg8::StaticOrder& S, const float* __restrict__ rs, float inv_dim) {
    LAS float* tbl = (LAS float*)(C.lds + RSTD_OFF);
    const int hf = C.wave >> 2, rr = C.tid & 255;
    pg8::Unit u0, u1, u2;
    const int i0 = hf, i1 = 2 + hf, i2 = 4 + hf;
    const bool v0 = S.next(i0, u0), v1 = S.next(i1, u1), v2 = (i2 < 5) && S.next(i2, u2);
    f32x4 x0[NP4], x1[NP4];
    { const f32x4* p0 = (const f32x4*)(rs + (size_t)((v0 ? u0.pm : 0) * 256 + rr) * (NP4 * 4)); const f32x4* p1 = (const f32x4*)(rs + (size_t)((v1 ? u1.pm : 0) * 256 + rr) * (NP4 * 4));
#pragma unroll
      for (int j = 0; j < NP4; ++j) { x0[j] = p0[j]; x1[j] = p1[j]; } }
    { float s0 = 0.f, s1 = 0.f;
#pragma unroll
      for (int j = 0; j < NP4; ++j) { s0 += (x0[j][0] + x0[j][1]) + (x0[j][2] + x0[j][3]); s1 += (x1[j][0] + x1[j][1]) + (x1[j][2] + x1[j][3]); }
      if (v0) tbl[i0 * 256 + rr] = rsqrtf(s0 * inv_dim + RMS_EPS);
      if (v1) tbl[i1 * 256 + rr] = rsqrtf(s1 * inv_dim + RMS_EPS); }
    if (v2) { const f32x4* p = (const f32x4*)(rs + (size_t)(u2.pm * 256 + rr) * (NP4 * 4)); float s = 0.f;
#pragma unroll
        for (int j = 0; j < NP4; ++j) { const f32x4 v = p[j]; s += (v[0] + v[1]) + (v[2] + v[3]); }
        tbl[i2 * 256 + rr] = rsqrtf(s * inv_dim + RMS_EPS); }
    __syncthreads();
}

__device__ __forceinline__ void norm_tail(const Ctx& C, int l) {
    const Bufs B(kargs()->ws);
    const KArgs& A = *kargs();
    const int gw2 = (C.G == 256) ? C.gw - 64 * NWAVES : C.gw, ngw2 = (C.G == 256) ? C.NGW - 64 * NWAVES : C.NGW;
    if (gw2 < 0) return;
    {
        const f32x4 g = *(const f32x4*)(A.kv_norm_g + l * 256 + C.lane * 4);
        for (int m0 = gw2; m0 < NTOK; m0 += 6 * ngw2) {
            pg8::u32x2 wv[6];
#pragma unroll
            for (int j = 0; j < 6; ++j) { const int m = m0 + j * ngw2; wv[j] = *(const pg8::u32x2*)(B.PROJ + (size_t)(m < NTOK ? m : m0) * NP1 + PC_CKV + C.lane * 4); }
#pragma unroll
            for (int j = 0; j < 6; ++j) { const int m = m0 + j * ngw2; const pg8::u32x2 w = wv[j];
                float v[4] = {pg8::bf_lo(w.x), pg8::bf_hi(w.x), pg8::bf_lo(w.y), pg8::bf_hi(w.y)};
                float ss = (v[0] * v[0] + v[1] * v[1]) + (v[2] * v[2] + v[3] * v[3]);
                ss = wave_sum(ss); const float r = rsqrtf(ss * (1.0f / 256.0f) + RMS_EPS);
                pg8::u32x2 o; o.x = pkh(v[0] * r * g[0], v[1] * r * g[1]); o.y = pkh(v[2] * r * g[2], v[3] * r * g[3]);
                if (m < NTOK) *(pg8::u32x2*)(B.CKVN + (size_t)m * 256 + C.lane * 4) = o; }
        }
    }
}

__device__ __forceinline__ unsigned f2key(float f) { const unsigned u = __float_as_uint(f); return (u & 0x80000000u) ? ~u : (u | 0x80000000u); }

__device__ __forceinline__ void final_phase(const Ctx& C) {
    const Bufs B(kargs()->ws);
    const KArgs& A = *kargs();
    for (int m0 = C.gw; m0 < 8192; m0 += 4 * C.NGW) {
        float sv[4]; pg8::u32x2 hv[4][8];
#pragma unroll
        for (int r = 0; r < 4; ++r) { const int m = m0 + r * C.NGW, mc = m < 8192 ? m : m0;
            sv[r] = (C.lane < 32) ? B.RS[(size_t)mc * 32 + C.lane] : 0.f;
#pragma unroll
            for (int j = 0; j < 8; ++j) hv[r][j] = *(const pg8::u32x2*)(B.HB + (size_t)mc * DM + j * 256 + C.lane * 4); }
        __builtin_amdgcn_sched_barrier(0);
#pragma unroll
        for (int r = 0; r < 4; ++r) { const int m = m0 + r * C.NGW;
            const float s = wave_sum(sv[r]);
            const float rs = rsqrtf(s * (1.0f / DM) + RMS_EPS);
            if (m < 8192) {
#pragma unroll
                for (int j = 0; j < 8; ++j) { const pg8::u32x2 hw = hv[r][j]; const f32x4 v = {pg8::bf_lo(hw.x), pg8::bf_hi(hw.x), pg8::bf_lo(hw.y), pg8::bf_hi(hw.y)}; const f32x4 g = *(const f32x4*)(A.final_g + j * 256 + C.lane * 4);
                    *(f32x4*)(A.out + (size_t)m * DM + j * 256 + C.lane * 4) = v * rs * g; } } }
    }
#if defined(MK_PROBE)
    if (MK_PROBE >= 0 && C.gw == 0) { VM_WAIT(); if (C.lane == 0) { float* o0 = A.out; o0[0] += (float)__hip_atomic_load((gu32*)(A.ws + WS_CTL) + 3, RLX_AGENT) * MK_PROBE_SCALE; } }
#endif
}


struct SkProj {
    bf16* P; bf16* KV; bf16* KIDX; int cb; const LAS float* tbl; int kr0; bf16* VT;
    __device__ __forceinline__ float operator()(int rloc, int c, float v) const { const int ac = cb + c; const bf16 o = (bf16)f2bf(v * tbl[rloc]);
        if (ac >= 1024 && ac < 1280) { KV[(size_t)rloc * 256 + ac - 1024] = o;
            if (ac >= 1152 && kr0 >= 8192) { const int mm = kr0 + rloc - 8192; VT[((size_t)(mm >> 4) * 128 + ac - 1152) * 4128 + (mm & 15)] = o; } }
        else if (ac >= 8192 && ac < 8256) { const int m = kr0 + rloc, bb = m < 8192 ? (m >> 12) : ((m - 8192) >> 4), pos = m < 8192 ? (m & 4095) + NMETA : ((m - 8192) & 15), k = ac - 8192;
            KIDX[((size_t)(bb * 129 + (pos >> 5)) * 4 + (k >> 4)) * 512 + (((k >> 3) & 1) * 32 + (pos & 31)) * 8 + (k & 7)] = o; }
        else P[(size_t)rloc * NP1 + ac] = o;
        return v * tbl[rloc]; } };
struct SkQ2 { bf16* O; const LAS float* tbl; __device__ __forceinline__ float operator()(int rloc, int c, float v) const { O[(size_t)rloc * NQ2 + c] = (bf16)f2bf(v * tbl[rloc]); return 0.f; } };
struct SkMerge2 { static constexpr bool SPLIT = true; bf16* O; const bf16* G; int c0;
    __device__ __forceinline__ float operator()(int, int, float) const { return 0.f; }
    __device__ __forceinline__ float split(int rloc, int c, float va, float vb) const { const int cg = c0 + c; const bf16* gp = G + (size_t)rloc * NP1 + 256 * (cg >> 7) + (cg & 127);
        O[(size_t)rloc * DM + c] = (bf16)f2bf(sigmoidf_(bf2f(gp[0])) * va + sigmoidf_(bf2f(gp[128])) * vb); return 0.f; } };
struct SkPA { float* P; const bf16* G; int c0; __device__ __forceinline__ float operator()(int rloc, int c, float v) const { const int cg = c0 + c; P[(size_t)rloc * DM + c] = sigmoidf_(bf2f(G[(size_t)rloc * NP1 + 256 * (cg >> 7) + (cg & 127)])) * v; return 0.f; } };
struct SkMerge { bf16* O; const float* P; const bf16* G; int c0; __device__ __forceinline__ float operator()(int rloc, int c, float v) const { const int cg = c0 + c; O[(size_t)rloc * DM + c] = (bf16)f2bf(P[(size_t)rloc * DM + c] + sigmoidf_(bf2f(G[(size_t)rloc * NP1 + 256 * (cg >> 7) + (cg & 127) + 128])) * v); return 0.f; } };
struct SkRes { bf16* HB; __device__ __forceinline__ float operator()(int rloc, int c, float v) const { const float h = bf2f(HB[(size_t)rloc * DM + c]) + v; HB[(size_t)rloc * DM + c] = (bf16)f2bf(h); return h; } };
constexpr int MR = 8192;
typedef float f32x16 __attribute__((ext_vector_type(16)));
__device__ __forceinline__ void sk_glds16(const void* gsrc, unsigned lds_dst) { unsigned keep;
    asm volatile("s_mov_b32 %0, m0\n\ts_mov_b32 m0, %2\n\ts_nop 0\n\tglobal_load_lds_dwordx4 %1, off\n\ts_mov_b32 m0, %0" : "=&s"(keep) : "v"(gsrc), "s"(lds_dst) : "memory"); }
template <class F, class = void> struct sk_has_split { static constexpr bool value = false; };
template <class F> struct sk_has_split<F, decltype((void)F::SPLIT)> { static constexpr bool value = F::SPLIT; };
template <int NT, int GPI, class F>
__device__ __forceinline__ void skinny_unit(const Ctx& C, const bf16* __restrict__ A, int lda, const bf16* __restrict__ Bt, int ldb, int K, float* ss_out  , int ss_ld, int ss_col0, const F& epi) {
    const int lane = C.lane, w = C.wave, r32 = lane & 31, hh = lane >> 5;
    f32x16 acc[NT];
#pragma unroll
    for (int nt = 0; nt < NT; ++nt) acc[nt] = (f32x16){};
    const int kper = K >> 3, ngroups = kper >> 6;
    const unsigned stg = (unsigned)__builtin_amdgcn_readfirstlane((unsigned)(uintptr_t)(C.lds + RING_OFF) + (unsigned)w * 16384u);
    LAS unsigned char* stp = C.lds + RING_OFF + w * 16384;
    const int prow = lane >> 3, pch = lane & 7;
    const int foff = r32 * 128;
    const int fsw = (r32 >> 1) & 7;
    constexpr int GI = (4 / (1 + NT)) < GPI ? (4 / (1 + NT)) : GPI;
    if constexpr (NT == 3 && GPI == 2) {
        const size_t kb0 = (size_t)w * kper * 2;
#pragma unroll
        for (int g = 0; g < 4; ++g)
#pragma unroll
            for (int p = 0; p < 4; ++p) { const int row = 8 * p + prow; const int lg = pch ^ ((row >> 1) & 7);
                sk_glds16((const unsigned char*)A + (size_t)row * lda * 2 + kb0 + g * 128 + lg * 16, stg + g * 4096 + p * 1024); }
        size_t zo = 0; asm volatile("" : "+s"(zo));
        const bf16* bp = Bt + zo + (size_t)(4 * w) * 12 * 512 + lane * 8;
        bf16x8 b0[3][4], b1[3][4];
#define SK_LOADB(dst_, g_) do { _Pragma("unroll") for (int nt = 0; nt < 3; ++nt) _Pragma("unroll") for (int s = 0; s < 4; ++s) dst_[nt][s] = *(const bf16x8*)(bp + (((g_) * 3 + nt) * 4 + s) * 512); } while (0)
#define SK_MMA(src_, g_) do { bf16x8 a[4]; _Pragma("unroll") for (int s = 0; s < 4; ++s) a[s] = *(const LAS bf16x8*)(stp + (g_) * 4096 + foff + (((2 * s + hh) ^ fsw) << 4)); \
        _Pragma("unroll") for (int s = 0; s < 4; ++s) _Pragma("unroll") for (int nt = 0; nt < 3; ++nt) acc[nt] = __builtin_amdgcn_mfma_f32_32x32x16_bf16(a[s], src_[nt][s], acc[nt], 0, 0, 0); } while (0)
        SK_LOADB(b0, 0); SK_LOADB(b1, 1);
        asm volatile("s_waitcnt vmcnt(0)" ::: "memory");
        __builtin_amdgcn_sched_barrier(0);
        SK_MMA(b0, 0);
        __builtin_amdgcn_sched_barrier(0);
        SK_LOADB(b0, 2);
        __builtin_amdgcn_sched_barrier(0);
        SK_MMA(b1, 1);
        __builtin_amdgcn_sched_barrier(0);
        SK_LOADB(b1, 3);
        __builtin_amdgcn_sched_barrier(0);
        SK_MMA(b0, 2);
        SK_MMA(b1, 3);
#undef SK_LOADB
#undef SK_MMA
        LDS_WAIT(); asm volatile("" ::: "memory");
    } else
#pragma unroll 1
    for (int g0 = 0; g0 < ngroups; g0 += GI) {
#pragma unroll
        for (int gi = 0; gi < GI; ++gi) {
            const size_t kbyte = ((size_t)w * kper + (size_t)(g0 + gi) * 64) * 2; const unsigned sg = stg + gi * (1 + NT) * 4096;
#pragma unroll
            for (int p = 0; p < 4; ++p) { const int row = 8 * p + prow; const int lg = pch ^ ((row >> 1) & 7);
                sk_glds16((const unsigned char*)A + (size_t)row * lda * 2 + kbyte + lg * 16, sg + p * 1024); }
#pragma unroll
            for (int nt = 0; nt < NT; ++nt)
#pragma unroll
                for (int p = 0; p < 4; ++p) { const int row = 8 * p + prow; const int lg = pch ^ ((row >> 1) & 7);
                    sk_glds16((const unsigned char*)Bt + (size_t)(nt * 32 + row) * ldb * 2 + kbyte + lg * 16, sg + 4096 * (1 + nt) + p * 1024); }
        }
        asm volatile("s_waitcnt vmcnt(0)" ::: "memory");
#pragma unroll
        for (int gi = 0; gi < GI; ++gi) {
            LAS unsigned char* sp = stp + gi * (1 + NT) * 4096;
            bf16x8 a[4], bv[NT][4];
#pragma unroll
            for (int s = 0; s < 4; ++s) { const int o = foff + (((2 * s + hh) ^ fsw) << 4); a[s] = *(const LAS bf16x8*)(sp + o);
#pragma unroll
                for (int nt = 0; nt < NT; ++nt) bv[nt][s] = *(const LAS bf16x8*)(sp + 4096 * (1 + nt) + o); }
            __builtin_amdgcn_sched_barrier(0);
#pragma unroll
            for (int s = 0; s < 4; ++s)
#pragma unroll
                for (int nt = 0; nt < NT; ++nt) acc[nt] = __builtin_amdgcn_mfma_f32_32x32x16_bf16(a[s], bv[nt][s], acc[nt], 0, 0, 0);
        }
        LDS_WAIT(); asm volatile("" ::: "memory");
    }
    LDS_WAIT(); __syncthreads();
    LAS float* part = (LAS float*)(C.lds + RING_OFF);
#pragma unroll
    for (int nt = 0; nt < NT; ++nt)
#pragma unroll
        for (int i = 0; i < 16; ++i) part[(w * NT * 16 + nt * 16 + i) * 64 + lane] = acc[nt][i];
    LDS_WAIT(); __syncthreads();
    int lane_e = lane; asm volatile("" : "+v"(lane_e));
    const int r32e = lane_e & 31, hhe = lane_e >> 5;
#pragma unroll
    for (int j = 0; j < 2 * NT; ++j) { const int e = (w + 8 * j) * 64 + lane;
        const int nti = w + 8 * j, nt = nti >> 4, i = nti & 15;
        float v = 0.f, vhi = 0.f;
#pragma unroll
        for (int ww = 0; ww < 4; ++ww) v += part[ww * NT * 1024 + e];
#pragma unroll
        for (int ww = 4; ww < 8; ++ww) vhi += part[ww * NT * 1024 + e];
        const int rloc = (i & 3) + 8 * (i >> 2) + 4 * hhe, c = nt * 32 + r32e;
        float sv;
        if constexpr (sk_has_split<F>::value) sv = epi.split(rloc, c, v, vhi); else sv = epi(rloc, c, v + vhi);
        if (ss_out != nullptr) { sv = sv * sv;
#pragma unroll
            for (int o = 1; o < 32; o <<= 1) sv += __shfl_xor(sv, o);
            if (r32e == 0) ss_out[(size_t)rloc * ss_ld + ss_col0 + nt] = sv; }
        __builtin_amdgcn_sched_barrier(0);
    }
    LDS_WAIT(); __syncthreads();
}
__device__ __forceinline__ void skinny_rstd(const Ctx& C, const float* __restrict__ rs, int np, float inv_dim, LAS float* tbl) {
    if (C.tid < 32) { float s = 0.f; const f32x4* p = (const f32x4*)(rs + (size_t)C.tid * np);
        for (int j = 0; j < np / 4; ++j) { const f32x4 v = p[j]; s += (v[0] + v[1]) + (v[2] + v[3]); }
        tbl[C.tid] = rsqrtf(s * inv_dim + RMS_EPS); }
    LDS_WAIT(); __syncthreads();
}

typedef short s16x4 __attribute__((ext_vector_type(4)));
typedef unsigned short u16x4 __attribute__((ext_vector_type(4)));
constexpr int DS_ISC = RING_OFF, DS_ISC_WORDS = 4128, DS_ISC_STRIDE = DS_ISC_WORDS * 4;
constexpr int DS_SEL = DS_ISC + 8 * DS_ISC_STRIDE;
constexpr int DS_SELR = DS_SEL + 8 * 512;
constexpr int DS_BIAS = DS_SELR + 8 * 512;
constexpr int DS_QROW = DS_BIAS + 8192;
constexpr int DS_END = DS_QROW + 256;
constexpr size_t OL_BLOCK = (size_t)3 * 16 * 8 * 64 * 8;
static_assert(DS_END <= LDS_BYTES, "DSA LDS map");

__device__ __forceinline__ void glds16(const void* gsrc, unsigned lds_dst) { unsigned keep;
    asm volatile("s_mov_b32 %0, m0\n\ts_mov_b32 m0, %2\n\ts_nop 0\n\tglobal_load_lds_dwordx4 %1, off\n\ts_mov_b32 m0, %0" : "=&s"(keep) : "v"(gsrc), "s"(lds_dst) : "memory"); }
__device__ __forceinline__ float relu1(float x) { const int i = __float_as_int(x); return __int_as_float(i > 0 ? i : 0); }
__device__ __forceinline__ void glds16o(const void* base, unsigned voff, unsigned lds_dst) { unsigned keep;
    asm volatile("s_mov_b32 %0, m0\n\ts_mov_b32 m0, %3\n\ts_nop 0\n\tglobal_load_lds_dwordx4 %1, %2\n\ts_mov_b32 m0, %0" : "=&s"(keep) : "v"(voff), "s"(base), "s"(lds_dst) : "memory"); }
__device__ __forceinline__ s16x4 tr_read(LAS unsigned char* p) { typedef short v4i16_t __attribute__((ext_vector_type(4))); return __builtin_bit_cast(s16x4, __builtin_amdgcn_ds_read_tr16_b64_v4i16((LAS v4i16_t*)p)); }
__device__ __forceinline__ unsigned cvtpk(float lo, float hi) { typedef float f2_t __attribute__((ext_vector_type(2))); typedef __bf16 b2_t __attribute__((ext_vector_type(2))); f2_t v = {lo, hi}; b2_t b = __builtin_convertvector(v, b2_t); return __builtin_bit_cast(unsigned, b); }

#define DSA_LOCALS() const int w = C.wave; LAS unsigned* ISC = (LAS unsigned*)(C.lds + DS_ISC); LAS unsigned short* sel = (LAS unsigned short*)(C.lds + DS_SEL) + w * 256; const LAS float* biasl = (const LAS float*)(C.lds + DS_BIAS); (void)ISC; (void)sel; (void)biasl
#define RELANE() do { asm volatile("" : "+v"(lane)); asm volatile("" : "+s"(t0), "+s"(b)); } while (0)
__device__ __forceinline__ void dsa_step1(const Ctx& C, const Bufs& B, int b, int t0) {
    int lane = C.lane; RELANE(); DSA_LOCALS();
    PROBE_T0();
    {
        const int r32 = lane & 31, hh = lane >> 5;
        bf16x8 qa[2][4]; float wq[2][2][8];
        const int qi = 2 * ((r32 >> 2) & 1) + (r32 >> 4), hA = (r32 & 3) + 4 * ((r32 >> 3) & 1);
#pragma unroll
        for (int g = 0; g < 2; ++g) { const int row = rowof(b, t0 + 4 * g + qi);
#pragma unroll
            for (int s = 0; s < 4; ++s) qa[g][s] = *(const bf16x8*)(B.Q2 + (size_t)row * NQ2 + 4096 + hA * 64 + 16 * s + 8 * hh);
#pragma unroll
            for (int j = 0; j < 2; ++j) { const int rw = rowof(b, t0 + 4 * g + 2 * hh + j); const v4u ww = *(const v4u*)(B.PROJ + (size_t)rw * NP1 + PC_WIDX);
                const float sc = 0.35355339059327373f * 0.125f;
                wq[g][j][0] = pg8::bf_lo(ww.x) * sc; wq[g][j][1] = pg8::bf_hi(ww.x) * sc; wq[g][j][2] = pg8::bf_lo(ww.y) * sc; wq[g][j][3] = pg8::bf_hi(ww.y) * sc;
                wq[g][j][4] = pg8::bf_lo(ww.z) * sc; wq[g][j][5] = pg8::bf_hi(ww.z) * sc; wq[g][j][6] = pg8::bf_lo(ww.w) * sc; wq[g][j][7] = pg8::bf_hi(ww.w) * sc; } }
        PROBE_T1(40);
        const int nkeys = t0 + 8, nkt = (nkeys + 31) >> 5;
        bf16x8 kA[4], kB[4];
#define IDX_LOAD(dst, kt_) do { const bf16* kp_ = B.KIDX + (size_t)(b * 129 + (kt_)) * 2048 + 8 * lane; \
        asm volatile("global_load_dwordx4 %0, %4, off\n\tglobal_load_dwordx4 %1, %4, off offset:1024\n\tglobal_load_dwordx4 %2, %4, off offset:2048\n\tglobal_load_dwordx4 %3, %4, off offset:3072" \
                     : "=&v"(dst[0]), "=&v"(dst[1]), "=&v"(dst[2]), "=&v"(dst[3]) : "v"(kp_) : "memory"); } while (0)
#define IDX_WAIT(cur) asm volatile("s_waitcnt vmcnt(12)" : "+v"(cur[0]), "+v"(cur[1]), "+v"(cur[2]), "+v"(cur[3]) :: "memory")
#define IDX_TILE(src, kt_) do { const int key_ = (kt_) * 32 + r32; \
        _Pragma("unroll") for (int g = 0; g < 2; ++g) { f32x16 acc = {}; \
            _Pragma("unroll") for (int s = 0; s < 4; ++s) acc = __builtin_amdgcn_mfma_f32_32x32x16_bf16(qa[g][s], src[s], acc, 0, 0, 0); \
            _Pragma("unroll") for (int j = 0; j < 2; ++j) { pg8::f32x2 i2 = {0.f, 0.f};     \
                _Pragma("unroll") for (int h = 0; h < 8; h += 2) { const pg8::f32x2 r2 = {relu1(acc[8 * j + h]), relu1(acc[8 * j + h + 1])}, w2 = {wq[g][j][h], wq[g][j][h + 1]}; i2 = __builtin_elementwise_fma(r2, w2, i2); } \
                const float isc = i2[0] + i2[1]; \
                ISC[(4 * g + 2 * hh + j) * DS_ISC_WORDS + key_] = f2key(isc); } } } while (0)
        bf16x8 kC[4], kD[4];
        int kt = w;
        const int ktl = nkt - 1;
        if (kt < nkt) {
            __builtin_amdgcn_s_waitcnt(0x0F70);
            IDX_LOAD(kA, kt); IDX_LOAD(kB, (kt + 8 < nkt ? kt + 8 : ktl)); IDX_LOAD(kC, (kt + 16 < nkt ? kt + 16 : ktl));
#define IDX_STEP(cur, nxt) { IDX_LOAD(nxt, (kt + 24 < nkt ? kt + 24 : ktl)); IDX_WAIT(cur); __builtin_amdgcn_sched_barrier(0); IDX_TILE(cur, kt); __builtin_amdgcn_sched_barrier(0); kt += 8; if (kt >= nkt) break; }
#pragma unroll 1
            for (;;) {
                IDX_STEP(kA, kD)
                IDX_STEP(kB, kA)
                IDX_STEP(kC, kB)
                IDX_STEP(kD, kC)
            }
#undef IDX_STEP
            asm volatile("s_waitcnt vmcnt(0)" : "+v"(kA[0]), "+v"(kA[1]), "+v"(kA[2]), "+v"(kA[3]), "+v"(kB[0]), "+v"(kB[1]), "+v"(kB[2]), "+v"(kB[3]) :: "memory");
            asm volatile("" : "+v"(kC[0]), "+v"(kC[1]), "+v"(kC[2]), "+v"(kC[3]), "+v"(kD[0]), "+v"(kD[1]), "+v"(kD[2]), "+v"(kD[3]) :: "memory");
        }
#undef IDX_WAIT
#undef IDX_LOAD
#undef IDX_TILE
        PROBE_T1(41);
    }
}
#define DSA_DPP(v_, ctrl_, rmask_, ident_) __builtin_amdgcn_update_dpp((ident_), (v_), (ctrl_), (rmask_), 0xf, false)
__device__ __forceinline__ unsigned wave_umax_dpp(unsigned v) { unsigned t;
    t = (unsigned)DSA_DPP((int)v, 0x111, 0xf, 0); v = t > v ? t : v; t = (unsigned)DSA_DPP((int)v, 0x112, 0xf, 0); v = t > v ? t : v; t = (unsigned)DSA_DPP((int)v, 0x114, 0xf, 0); v = t > v ? t : v; t = (unsigned)DSA_DPP((int)v, 0x118, 0xf, 0); v = t > v ? t : v;
    t = (unsigned)DSA_DPP((int)v, 0x142, 0xa, 0); v = t > v ? t : v; t = (unsigned)DSA_DPP((int)v, 0x143, 0xc, 0); v = t > v ? t : v;
    return (unsigned)__builtin_amdgcn_readlane((int)v, 63); }
__device__ __forceinline__ unsigned wave_umin_dpp(unsigned v) { return ~wave_umax_dpp(~v); }
__device__ __forceinline__ float wave_fadd_dpp(float v) {
    v += __int_as_float(DSA_DPP(__float_as_int(v), 0x111, 0xf, 0)); v += __int_as_float(DSA_DPP(__float_as_int(v), 0x112, 0xf, 0)); v += __int_as_float(DSA_DPP(__float_as_int(v), 0x114, 0xf, 0)); v += __int_as_float(DSA_DPP(__float_as_int(v), 0x118, 0xf, 0));
    v += __int_as_float(DSA_DPP(__float_as_int(v), 0x142, 0xa, 0)); v += __int_as_float(DSA_DPP(__float_as_int(v), 0x143, 0xc, 0));
    return __int_as_float(__builtin_amdgcn_readlane(__float_as_int(v), 63)); }
__device__ __forceinline__ float xmax16(float x) { const auto r = __builtin_amdgcn_permlane16_swap(__float_as_uint(x), __float_as_uint(x), false, false); return fmaxf(__uint_as_float(r[0]), __uint_as_float(r[1])); }
__device__ __forceinline__ float xmax32(float x) { const auto r = __builtin_amdgcn_permlane32_swap(__float_as_uint(x), __float_as_uint(x), false, false); return fmaxf(__uint_as_float(r[0]), __uint_as_float(r[1])); }
__device__ __forceinline__ float xadd16(float x) { const auto r = __builtin_amdgcn_permlane16_swap(__float_as_uint(x), __float_as_uint(x), false, false); return __uint_as_float(r[0]) + __uint_as_float(r[1]); }
__device__ __forceinline__ float xadd32(float x) { const auto r = __builtin_amdgcn_permlane32_swap(__float_as_uint(x), __float_as_uint(x), false, false); return __uint_as_float(r[0]) + __uint_as_float(r[1]); }
__device__ __forceinline__ int dsa_step2(const Ctx& C, int b, int t0) {
    int lane = C.lane; RELANE(); DSA_LOCALS();
    const int t = t0 + w, n = t + 1;
    int cnt;
    if (n <= TOPK) { for (int j = lane; j < n; j += 64) sel[j] = (unsigned short)j; cnt = n; }
    else {
        const LAS unsigned* myrow = ISC + w * DS_ISC_WORDS;
        const int nI = (n + 255) >> 8;
        unsigned v[68];
#pragma unroll
        for (int i = 0; i < 17; ++i) { const pg8::u32x4 x = *(const LAS pg8::u32x4*)(myrow + 256 * i + 4 * lane);
#pragma unroll
            for (int e = 0; e < 4; ++e) v[4 * i + e] = (256 * i + 4 * lane + e <= t) ? x[e] : 0u; }
        unsigned T = 0u; bool exact = false;
#define DSA_COUNT(res, cand_) do { int c_ = 0; const unsigned t_ = (cand_); \
        _Pragma("unroll") for (int i = 0; i < 17; ++i) { if (i < nI) { unsigned long long m0_, m1_, m2_, m3_; \
            asm volatile("v_cmp_ge_u32_e64 %1, %5, %9\n\tv_cmp_ge_u32_e64 %2, %6, %9\n\tv_cmp_ge_u32_e64 %3, %7, %9\n\tv_cmp_ge_u32_e64 %4, %8, %9\n\t" \
                         "v_addc_co_u32_e64 %0, %1, 0, %0, %1\n\tv_addc_co_u32_e64 %0, %2, 0, %0, %2\n\tv_addc_co_u32_e64 %0, %3, 0, %0, %3\n\tv_addc_co_u32_e64 %0, %4, 0, %0, %4" \
                         : "+v"(c_), "=&s"(m0_), "=&s"(m1_), "=&s"(m2_), "=&s"(m3_) : "v"(v[4 * i]), "v"(v[4 * i + 1]), "v"(v[4 * i + 2]), "v"(v[4 * i + 3]), "v"(t_)); } } \
        int tot_ = 0; _Pragma("unroll") for (int bt = 0; bt < 7; ++bt) tot_ += __popcll(__ballot((c_ >> bt) & 1)) << bt; res = tot_; } while (0)
        {
            unsigned kmax = 0u, kmin = 0xfffffffeu;
#pragma unroll
            for (int i = 0; i < 17; ++i) { if (i < nI) {
#pragma unroll
                for (int e = 0; e < 4; e += 2) { const unsigned x0 = v[4 * i + e], x1 = v[4 * i + e + 1]; const unsigned mx = x0 > x1 ? x0 : x1; kmax = mx > kmax ? mx : kmax;
                    const unsigned y0 = x0 - 1u, y1 = x1 - 1u, mn = y0 < y1 ? y0 : y1; kmin = mn < kmin ? mn : kmin; } } }
            kmin += 1u;
            kmax = wave_umax_dpp(kmax); kmin = wave_umin_dpp(kmin);
#define DSA_K2F(k_) __uint_as_float(((k_) & 0x80000000u) ? ((k_) & 0x7fffffffu) : ~(k_))
            float lo = DSA_K2F(kmin), hi = DSA_K2F(kmax), flo = (float)(n - TOPK), fhi = (float)(1 - TOPK); int side = 0;
            float x0, dens;
            { float s1 = 0.f, s2 = 0.f;
#pragma unroll
              for (int e = 0; e < 4; ++e) { const float f = DSA_K2F(v[e]); s1 += f; s2 = fmaf(f, f, s2); }
              s1 = wave_fadd_dpp(s1); s2 = wave_fadd_dpp(s2);
              const float mu = s1 * (1.0f / 256.0f), var = fmaxf(s2 * (1.0f / 256.0f) - mu * mu, 1e-30f), sd = sqrtf(var);
              const float q = fmaxf(1.0f - (float)TOPK / (float)n, 0.03f), r = q - 0.5f, t2 = r * r;
              const float zn = (((((-3.969683028665376e+01f * t2 + 2.209460984245205e+02f) * t2 - 2.759285104469687e+02f) * t2 + 1.383577518672690e+02f) * t2 - 3.066479806614716e+01f) * t2 + 2.506628277459239e+00f) * r;
              const float zd = ((((-5.447609879822406e+01f * t2 + 1.615858368580409e+02f) * t2 - 1.556989798598866e+02f) * t2 + 6.680131188771972e+01f) * t2 - 1.328068155288572e+01f) * t2 + 1.0f;
              const float z = zn / zd;
              x0 = mu + z * sd; dens = (float)n * __expf(-0.5f * z * z) * 0.3989422804f / sd; }
            float xl = 0.f; int cl = TOPK;
#pragma unroll 1
            for (int it = 0; it < 22 && !exact; ++it) {
                float x = (lo * fhi - hi * flo) / (fhi - flo);
                if (it == 0) x = x0; else if (it == 1) x = xl + 1.5f * (float)(cl - TOPK) / dens;
                if (!(x > lo && x < hi)) x = (it < 2) ? (lo * fhi - hi * flo) / (fhi - flo) : x;
                if (!(x > lo && x < hi)) x = 0.5f * (lo + hi);
                if (!(x > lo && x < hi)) break;
                const unsigned cand = f2key(x); int c;
                DSA_COUNT(c, cand);
                xl = x; cl = c;
                if (c == TOPK) { T = cand; exact = true; }
                else if (c > TOPK) { lo = x; flo = (float)(c - TOPK); if (side == 1) fhi *= 0.5f; side = 1; }
                else { hi = x; fhi = (float)(c - TOPK); if (side == -1) flo *= 0.5f; side = -1; }
            }
#undef DSA_K2F
        }
        if (!exact) {
            T = 0u;
#pragma unroll 1
            for (int bit = 31; bit >= 0; --bit) {
                const unsigned cand = T | (1u << bit); int c;
                DSA_COUNT(c, cand);
                if (c >= TOPK) { T = cand; if (c == TOPK) { exact = true; break; } }
            }
            if (!exact) { int c; DSA_COUNT(c, T); exact = (c == TOPK); }
        }
#undef DSA_COUNT
        int base = 0;
#pragma unroll
        for (int k = 0; k < 68; ++k) { const bool p = exact ? (v[k] >= T) : (v[k] > T); const unsigned long long m = __ballot(p);
            const int pos = (int)__builtin_amdgcn_mbcnt_hi((unsigned)(m >> 32), __builtin_amdgcn_mbcnt_lo((unsigned)m, (unsigned)base));
            if (p) sel[pos] = (unsigned short)(256 * (k >> 2) + 4 * lane + (k & 3));
            base += __popcll(m); }
        if (!exact) {
            int last = -1;
            while (base < TOPK) { int mi = 0x7fffffff;
#pragma unroll
                for (int k = 0; k < 68; ++k) { const int idx = 256 * (k >> 2) + 4 * lane + (k & 3); if (v[k] == T && idx > last && idx < mi) mi = idx; }
#pragma unroll
                for (int o = 1; o < 64; o <<= 1) { const int oth = __shfl_xor(mi, o); mi = oth < mi ? oth : mi; }
                if (lane == 0) sel[base] = (unsigned short)mi;
                last = mi; ++base; }
        }
        cnt = TOPK;
    }
    { LDS_WAIT(); asm volatile("" ::: "memory");
      LAS unsigned short* selr = (LAS unsigned short*)(C.lds + DS_SELR) + w * 256;
      const u16x4 p4 = *(const LAS u16x4*)(sel + 4 * lane); u16x4 r4;
#pragma unroll
      for (int e = 0; e < 4; ++e) { const int pos = (int)p4[e]; r4[e] = (unsigned short)((4 * lane + e < cnt) ? rowof(b, pos) : 0); }
      *(LAS u16x4*)(selr + 4 * lane) = r4; }
    return cnt;
}
__device__ __forceinline__ void dsa_step3(const Ctx& C, const Bufs& B, int b, int t0, int cnt, int qslot) {
    int lane = C.lane; RELANE(); DSA_LOCALS(); const int t = t0 + w;
    {
        const int g = lane >> 4, c16 = lane & 15, rowq = rowof(b, t);
        bf16x8 qf[8];
#pragma unroll
        for (int s = 0; s < 8; ++s) qf[s] = *(const bf16x8*)(B.Q2 + (size_t)rowq * NQ2 + c16 * 256 + 32 * s + 8 * g);
        f32x4 O[16];
#pragma unroll
        for (int rt = 0; rt < 16; ++rt) O[rt] = (f32x4){0.f, 0.f, 0.f, 0.f};
        float m_ref = 0.f, lsum = 0.f;
        const int buf0 = DS_ISC + w * DS_ISC_STRIDE;
        const int npairs = (cnt + 31) >> 5;
        const int swz = (c16 & 7) << 1;
        const int trow = 4 * g + (c16 >> 2), tswz = (trow & 7) << 1, tp = c16 & 3;
        const int arow = (c16 & 7) * 1024 + (c16 >> 3) * 512, trowo = (trow & 7) * 1024 + (trow >> 3) * 512;
        const unsigned ldsb = (unsigned)(uintptr_t)(C.lds + buf0);
        const LAS unsigned short* selr = (const LAS unsigned short*)(C.lds + DS_SELR) + w * 256; const unsigned l4 = (unsigned)(lane & 31) << 4;
#define DSA_GATHER(c_) do { const unsigned bo_ = (unsigned)__builtin_amdgcn_readfirstlane(ldsb + ((c_) & 1) * 8192); \
        const pg8::u32x4 sp_ = *(const LAS pg8::u32x4*)(selr + 16 * (c_) + 8 * (lane >> 5)); const unsigned spw_[4] = {sp_.x, sp_.y, sp_.z, sp_.w}; \
        _Pragma("unroll") for (int p = 0; p < 8; ++p) { const unsigned row_ = (p & 1) ? (spw_[p >> 1] >> 16) : (spw_[p >> 1] & 0xffffu); \
            glds16o(B.CKVN, ((row_ << 9) | l4) ^ (unsigned)(p << 5), bo_ + p * 1024); } } while (0)
        DSA_GATHER(0); DSA_GATHER(1);
#pragma unroll 1
        for (int kp = 0; kp < npairs; ++kp) {
            asm volatile("s_waitcnt vmcnt(0)" ::: "memory");
            bf16x8 a0[8], a1[8]; s16x4 v0[16], v1[16];
#pragma unroll
            for (int s = 0; s < 8; ++s) { const int off = arow + (((4 * s + g) ^ swz) << 4); a0[s] = *(const LAS bf16x8*)(C.lds + buf0 + off); a1[s] = *(const LAS bf16x8*)(C.lds + buf0 + 8192 + off); }
            const u16x4 p0 = *(const LAS u16x4*)(sel + 32 * kp + 4 * g), p1 = *(const LAS u16x4*)(sel + 32 * kp + 16 + 4 * g);
            __builtin_amdgcn_sched_barrier(0);
            f32x4 s0 = {0.f, 0.f, 0.f, 0.f}, s1 = {0.f, 0.f, 0.f, 0.f};
#pragma unroll
            for (int s = 0; s < 8; ++s) { s0 = __builtin_amdgcn_mfma_f32_16x16x32_bf16(a0[s], qf[s], s0, 0, 0, 0); s1 = __builtin_amdgcn_mfma_f32_16x16x32_bf16(a1[s], qf[s], s1, 0, 0, 0); }
            __builtin_amdgcn_sched_barrier(0);
#pragma unroll
            for (int rt = 0; rt < 16; ++rt) { const int off = trowo + (((2 * rt + (tp >> 1)) ^ tswz) << 4) + 8 * (tp & 1); v0[rt] = tr_read(C.lds + buf0 + off); v1[rt] = tr_read(C.lds + buf0 + 8192 + off); }
            __builtin_amdgcn_sched_barrier(0);
            LDS_WAIT(); asm volatile("" ::: "memory");
            if (kp + 1 < npairs) { DSA_GATHER(2 * kp + 2); DSA_GATHER(2 * kp + 3); }
            __builtin_amdgcn_sched_barrier(0);
            float x0[4], x1[4]; float mloc = -INFINITY;
#pragma unroll
            for (int i = 0; i < 4; ++i) { const int j0 = 32 * kp + 4 * g + i, j1 = j0 + 16; int d0 = t - (int)p0[i], d1 = t - (int)p1[i]; d0 = d0 < 0 ? 0 : (d0 > 127 ? 127 : d0); d1 = d1 < 0 ? 0 : (d1 > 127 ? 127 : d1);
                const float b0 = biasl[d0 * 16 + c16], b1 = biasl[d1 * 16 + c16];
                const float y0 = 0.125f * s0[i] + b0, y1 = 0.125f * s1[i] + b1;
                x0[i] = (j0 < cnt) ? y0 : -INFINITY; x1[i] = (j1 < cnt) ? y1 : -INFINITY;
                mloc = fmaxf(mloc, fmaxf(x0[i], x1[i])); }
            mloc = xmax32(xmax16(mloc));
            if (kp == 0) m_ref = mloc;
            else if (__any(mloc > m_ref + 8.0f)) { const float mn = fmaxf(m_ref, mloc), al = __expf(m_ref - mn);
#pragma unroll
                for (int rt = 0; rt < 16; ++rt) O[rt] *= al;
                lsum *= al; m_ref = mn; }
            float pe0[4], pe1[4];
#pragma unroll
            for (int i = 0; i < 4; ++i) { pe0[i] = __expf(x0[i] - m_ref); pe1[i] = __expf(x1[i] - m_ref); lsum += pe0[i] + pe1[i]; }
            pg8::u32x4 pw; pw.x = cvtpk(pe0[0], pe0[1]); pw.y = cvtpk(pe0[2], pe0[3]); pw.z = cvtpk(pe1[0], pe1[1]); pw.w = cvtpk(pe1[2], pe1[3]);
            const bf16x8 pf = __builtin_bit_cast(bf16x8, pw);
#pragma unroll
            for (int rt = 0; rt < 16; ++rt) { const bf16x8 af = {v0[rt][0], v0[rt][1], v0[rt][2], v0[rt][3], v1[rt][0], v1[rt][1], v1[rt][2], v1[rt][3]};
                O[rt] = __builtin_amdgcn_mfma_f32_16x16x32_bf16(af, pf, O[rt], 0, 0, 0); }
            LDS_WAIT(); asm volatile("" ::: "memory");
        }
#undef DSA_GATHER
        lsum = xadd32(xadd16(lsum));
        const float inv = 1.0f / lsum;
#pragma unroll
        for (int rt = 0; rt < 16; ++rt) { const f32x4 o = O[rt] * inv; pg8::u32x2 wv; wv.x = cvtpk(o[0], o[1]); wv.y = cvtpk(o[2], o[3]);
            const int s_ = rt >> 1, gp = 2 * (rt & 1) + (g >> 1), jo = 4 * (g & 1);
            *(pg8::u32x2*)(B.OLAT + (size_t)C.bid * OL_BLOCK + ((((size_t)(qslot >> 4) * 16 + c16) * 8 + s_) * 64 + gp * 16 + (qslot & 15)) * 8 + jo) = wv; }
    }
}
__device__ __forceinline__ void dsa_wuv(const Ctx& C, const Bufs& B, int l, int nq) {
    const int lane = C.lane, w = C.wave, g = lane >> 4, c16 = lane & 15;
    const LAS int* qrow = (const LAS int*)(C.lds + DS_QROW);
    const int nmt = (nq + 15) >> 4;
#pragma unroll 1
    for (int hq = 0; hq < 2; ++hq) { const int h = 2 * w + hq;
        f32x4 Dv[3][4];
#pragma unroll
        for (int mt = 0; mt < 3; ++mt)
#pragma unroll
            for (int nt = 0; nt < 4; ++nt) Dv[mt][nt] = (f32x4){0.f, 0.f, 0.f, 0.f};
        const bf16* wb = B.WUV + (((size_t)l * 16 + h) * 32) * 512 + lane * 8;
        const bf16* ab = B.OLAT + (size_t)C.bid * OL_BLOCK + ((size_t)h * 8) * 512 + lane * 8;
        v4u zw[3][2];
        { const int slot = lane >> 2, d0 = (lane & 3) * 16;
#pragma unroll
          for (int mt = 0; mt < 3; ++mt) { const int q = mt * 16 + slot; const int row = qrow[q < nq ? q : 0];
#pragma unroll
              for (int hf = 0; hf < 2; ++hf) zw[mt][hf] = *(const v4u*)(B.PROJ + (size_t)row * NP1 + PC_ZB + h * 64 + d0 + 8 * hf); } }
        bf16x8 bw[4][4], aw[4][3];
#define WUV_LOAD(set_, s_) do { _Pragma("unroll") for (int nt = 0; nt < 4; ++nt) bw[set_][nt] = *(const bf16x8*)(wb + ((s_) * 4 + nt) * 512); \
        _Pragma("unroll") for (int mt = 0; mt < 3; ++mt) { aw[set_][mt] = *(const bf16x8*)(ab + ((size_t)mt * 16 * 8 + (s_)) * 512);     } } while (0)
#define WUV_MMA(set_) do { _Pragma("unroll") for (int mt = 0; mt < 3; ++mt) _Pragma("unroll") for (int nt = 0; nt < 4; ++nt) Dv[mt][nt] = __builtin_amdgcn_mfma_f32_16x16x32_bf16(aw[set_][mt], bw[set_][nt], Dv[mt][nt], 0, 0, 0); } while (0)
        WUV_LOAD(0, 0); WUV_LOAD(1, 1); WUV_LOAD(2, 2); WUV_LOAD(3, 3);
#pragma unroll
        for (int s = 0; s < 8; ++s) {
            __builtin_amdgcn_sched_barrier(0);
            WUV_MMA(s & 3);
            __builtin_amdgcn_sched_barrier(0);
            if (s + 4 < 8) WUV_LOAD(s & 3, s + 4);
        }
        __builtin_amdgcn_sched_barrier(0);
#undef WUV_LOAD
#undef WUV_MMA
        LAS float* stg = (LAS float*)(C.lds + RING_OFF + w * 4608);
#pragma unroll
        for (int mt = 0; mt < 3; ++mt) { if (mt < nmt) {
#pragma unroll
            for (int nt = 0; nt < 4; ++nt)
#pragma unroll
                for (int i = 0; i < 4; ++i) stg[(4 * g + i) * 68 + 16 * nt + c16] = Dv[mt][nt][i];
            LDS_WAIT(); asm volatile("" ::: "memory");
            const int slot = lane >> 2, q = mt * 16 + slot, d0 = (lane & 3) * 16;
            if (q < nq) { const int row = qrow[q]; const v4u zw_[2] = {zw[mt][0], zw[mt][1]};
                bf16* op = B.YB + (size_t)row * YLD + h * 64 + d0;
#pragma unroll
                for (int hf = 0; hf < 2; ++hf) { const v4u zw = zw_[hf];
                    const f32x4 xa = *(const LAS f32x4*)(stg + slot * 68 + d0 + 8 * hf), xb = *(const LAS f32x4*)(stg + slot * 68 + d0 + 8 * hf + 4);
                    v4u o; o.x = pk2(xa[0] * siluf_(pg8::bf_lo(zw.x)), xa[1] * siluf_(pg8::bf_hi(zw.x))); o.y = pk2(xa[2] * siluf_(pg8::bf_lo(zw.y)), xa[3] * siluf_(pg8::bf_hi(zw.y)));
                    o.z = pk2(xb[0] * siluf_(pg8::bf_lo(zw.z)), xb[1] * siluf_(pg8::bf_hi(zw.z))); o.w = pk2(xb[2] * siluf_(pg8::bf_lo(zw.w)), xb[3] * siluf_(pg8::bf_hi(zw.w)));
                    *(v4u*)(op + 8 * hf) = o; } }
            LDS_WAIT(); asm volatile("" ::: "memory"); } }
    }
}
#ifndef MK_DSUB
#define MK_DSUB 0
#endif
__device__ __forceinline__ void dsa_unit(const Ctx& C, const Bufs& B, int l, int b, int t0, int uidx) {
    { PROBE_T0(); for (int rep = 0; rep < ((MK_DSUB & 1) ? 2 : 1); ++rep) { dsa_step1(C, B, b, t0); LDS_WAIT(); PROBE_T1(10); __syncthreads(); } PROBE_T1(0); }
    int cnt = 0;
    { PROBE_T0(); for (int rep = 0; rep < ((MK_DSUB & 2) ? 2 : 1); ++rep) { cnt = dsa_step2(C, b, t0); LDS_WAIT(); asm volatile("" ::: "memory"); } PROBE_T1(1); }
    if (C.lane == 0) ((LAS int*)(C.lds + DS_QROW))[uidx * 8 + C.wave] = rowof(b, t0 + C.wave);
    { PROBE_T0(); for (int rep = 0; rep < ((MK_DSUB & 4) ? 2 : 1); ++rep) { dsa_step3(C, B, b, t0, cnt, uidx * 8 + C.wave); } PROBE_T1(2); }
}
#undef RELANE
#undef DSA_LOCALS

__device__ __forceinline__ void dsa_phase(const Ctx& C, int l) {
    const Bufs B(kargs()->ws);
    const KArgs& A = *kargs();
    for (int i = C.tid; i < 128 * 16; i += NWAVES * 64) { const int dd = i >> 4, h = i & 15; ((LAS float*)(C.lds + DS_BIAS))[i] = A.bias_table[t5_bucket(dd) * 32 + 16 + h]; }
    __syncthreads();
    gu32* qctr = (gu32*)(A.ws + WS_CTL) + CW_DSAQ + l * 128;
    LAS int* qslot = (LAS int*)(C.lds + DS_QROW) + 56;
    int nu = 0, myb = C.bid & 1; bool other = false;
    int s_next = 0;
#define DSA_GRAB_ISSUE() do { if (C.tid == 0) s_next = (int)__hip_atomic_fetch_add(qctr + myb * 64, 1u, __ATOMIC_RELAXED, __HIP_MEMORY_SCOPE_AGENT); } while (0)
#define DSA_GRAB_FINISH() do { if (C.tid == 0) { int s_ = s_next; \
        if (s_ >= 514 && !other) { s_ = (int)__hip_atomic_fetch_add(qctr + (myb ^ 1) * 64, 1u, __ATOMIC_RELAXED, __HIP_MEMORY_SCOPE_AGENT); s_ = s_ < 514 ? s_ + 1024 : -1; } \
        else if (s_ >= 514) s_ = -1; \
        qslot[0] = s_; } } while (0)
    DSA_GRAB_ISSUE(); DSA_GRAB_FINISH();
    LDS_WAIT(); __syncthreads();
    for (;;) {
        int s = qslot[0];
        const bool done = s < 0;
        if ((done && nu > 0) || nu == 6) {
            VM_WAIT(); LDS_WAIT(); __syncthreads(); { PROBE_T0(); dsa_wuv(C, B, l, nu * 8); PROBE_T1(3); } __syncthreads(); nu = 0; }
        if (done) break;
        int b = myb;
        if (s >= 1024) { s -= 1024; if (!other) { other = true; myb ^= 1; } b = myb; }
        DSA_GRAB_ISSUE();
        dsa_unit(C, B, l, b, 8 * (513 - s), nu); ++nu;
        DSA_GRAB_FINISH();
        { PROBE_T0(); LDS_WAIT(); __syncthreads(); PROBE_T1(7); }
    }
#undef DSA_GRAB_ISSUE
#undef DSA_GRAB_FINISH
    __syncthreads();
}

constexpr int VT_PITCH = 4128;
constexpr int SW_BIAS = RING_OFF;
constexpr int SW_WS = SW_BIAS + 8192;
constexpr int SW_STG = SW_WS + 1024;

constexpr int SW_Q = SW_STG, SW_WAVE = 16384, SW_SLOT = 4096;
__device__ __forceinline__ void swa_item(const Ctx& C, const Bufs& B, const float* __restrict__ sinks, int b, int head, int p0, bool meta) {
    const int lane = C.lane, r32 = lane & 31, hh = lane >> 5, g = head >> 3;
    const LAS float* biasl = (const LAS float*)(C.lds + SW_BIAS);
    LAS float* wsf = (LAS float*)(C.lds + SW_WS) + C.wave * 32;
    LAS unsigned char* wl = C.lds + SW_Q + C.wave * SW_WAVE;
    const unsigned wlb = (unsigned)__builtin_amdgcn_readfirstlane((unsigned)(uintptr_t)(C.lds + SW_Q) + (unsigned)C.wave * SW_WAVE);
    const int tq = p0 + r32;
    const int ntile = meta ? 1 : 6;
    PROBE_T0();
    const int prow = lane >> 3, pch = lane & 7, vrow = lane >> 2, vch = lane & 3;
#define SW_DMA_K(kt_, slot_) do { const int k0_ = ((kt_) == 0) ? 0 : p0 - 128 + 32 * ((kt_) - 1); \
        _Pragma("unroll") for (int p = 0; p < 4; ++p) { const int r_ = 8 * p + prow; int kp_ = k0_ + r_; kp_ = kp_ < 0 ? 0 : kp_; \
            glds16o(B.KV, (unsigned)rowof(b, kp_) * 512u + (unsigned)(g * 128 + ((pch ^ ((r_ >> 1) & 7)) << 4)), wlb + 4096u + (unsigned)(slot_) * SW_SLOT + p * 1024); } } while (0)
#define SW_DMA_V(kt_, slot_) do { const int k0_ = ((kt_) == 0) ? 0 : p0 - 128 + 32 * ((kt_) - 1); \
        _Pragma("unroll") for (int p = 0; p < 4; ++p) { const int r_ = 16 * p + vrow; int ks_ = k0_ + 8 * (vch ^ ((r_ >> 2) & 3)); ks_ = ks_ < 0 ? 0 : ks_; \
            glds16o(B.VT, (unsigned)((b * 128 + g * 64 + r_) * VT_PITCH + ks_) * 2u, wlb + 4096u + (unsigned)(slot_) * SW_SLOT + p * 1024); } } while (0)
    {
#pragma unroll
        for (int p = 0; p < 4; ++p) { const int r_ = 8 * p + prow; int tqq = p0 + r_; if (meta) tqq = tqq < NMETA ? tqq : NMETA - 1;
            glds16o(B.PROJ, ((unsigned)rowof(b, tqq) * (unsigned)NP1 + (unsigned)(PC_QA + head * 64)) * 2u + (unsigned)((pch ^ ((r_ >> 1) & 7)) << 4), wlb + p * 1024); }
    }
    SW_DMA_K(0, 0);
    if (!meta) { SW_DMA_K(1, 1); SW_DMA_K(2, 2); }
    const int foff = r32 * 128, fsw = (r32 >> 1) & 7;
    bf16x8 qf[4];
    if (meta) asm volatile("s_waitcnt vmcnt(0)" ::: "memory"); else asm volatile("s_waitcnt vmcnt(8)" ::: "memory");
#pragma unroll
    for (int s = 0; s < 4; ++s) qf[s] = *(const LAS bf16x8*)(wl + foff + (((2 * s + hh) ^ fsw) << 4));
    f32x16 S[6];
#pragma unroll
    for (int kt = 0; kt < 6; ++kt) {
        if (kt < ntile) {
            if (meta || kt >= 4) { if (kt == 4) asm volatile("s_waitcnt vmcnt(4)" ::: "memory"); else asm volatile("s_waitcnt vmcnt(0)" ::: "memory"); }
            else asm volatile("s_waitcnt vmcnt(8)" ::: "memory");
            bf16x8 kf[4];
#pragma unroll
            for (int s = 0; s < 4; ++s) kf[s] = *(const LAS bf16x8*)(wl + 4096 + (kt % 3) * SW_SLOT + foff + (((2 * s + hh) ^ fsw) << 4));
            __builtin_amdgcn_sched_barrier(0);
            f32x16 acc = {};
#pragma unroll
            for (int s = 0; s < 4; ++s) acc = __builtin_amdgcn_mfma_f32_32x32x16_bf16(kf[s], qf[s], acc, 0, 0, 0);
            S[kt] = acc;
            LDS_WAIT(); asm volatile("" ::: "memory");
            if (kt + 3 < ntile) SW_DMA_K(kt + 3, kt % 3);
        } else S[kt] = (f32x16){-INFINITY, -INFINITY, -INFINITY, -INFINITY, -INFINITY, -INFINITY, -INFINITY, -INFINITY, -INFINITY, -INFINITY, -INFINITY, -INFINITY, -INFINITY, -INFINITY, -INFINITY, -INFINITY};
    }
    PROBE_T1(50);
    SW_DMA_V(0, 0);
    if (!meta) { SW_DMA_V(1, 1); SW_DMA_V(2, 2); }
#pragma unroll
    for (int kt = 0; kt < 6; ++kt) {
        if (kt < ntile) {
            const int k0 = (kt == 0) ? 0 : p0 - 128 + 32 * (kt - 1);
            float bz[16];
#pragma unroll
            for (int i = 0; i < 16; ++i) { const int kp = k0 + (i & 3) + 8 * (i >> 2) + 4 * hh; int d = tq - kp; d = d < 0 ? 0 : (d > 127 ? 127 : d); bz[i] = biasl[head * 128 + d]; }
#pragma unroll
            for (int i = 0; i < 16; ++i) { const int kp = k0 + (i & 3) + 8 * (i >> 2) + 4 * hh; const int d = tq - kp;
                const bool ok = (kt == 0) ? (kp < NMETA && d >= 0) : (kp >= NMETA && d >= 0 && d < 128);
                const float x = 0.125f * S[kt][i] + bz[i];
                S[kt][i] = ok ? x : -INFINITY; }
        }
    }
    const float sink = sinks[head];
    float mx = sink;
#pragma unroll
    for (int kt = 0; kt < 6; ++kt)
#pragma unroll
        for (int i = 0; i < 16; ++i) mx = fmaxf(mx, S[kt][i]);
    mx = fmaxf(mx, __shfl_xor(mx, 32));
    float sum = 0.f;
#pragma unroll
    for (int kt = 0; kt < 6; ++kt)
#pragma unroll
        for (int i = 0; i < 16; ++i) { const float p = __expf(S[kt][i] - mx); S[kt][i] = p; sum += p; }
    sum += __shfl_xor(sum, 32);
    sum += __expf(sink - mx);
    if (hh == 0) wsf[r32] = sum;
    PROBE_T1(51);
    f32x16 O0 = {}, O1 = {};
#pragma unroll
    for (int kt = 0; kt < 6; ++kt) {
        if (kt < ntile) {
            if (meta || kt >= 4) { if (kt == 4) asm volatile("s_waitcnt vmcnt(4)" ::: "memory"); else asm volatile("s_waitcnt vmcnt(0)" ::: "memory"); }
            else asm volatile("s_waitcnt vmcnt(8)" ::: "memory");
            pg8::u32x2 vl[2][2], vh[2][2];
#pragma unroll
            for (int s2 = 0; s2 < 2; ++s2)
#pragma unroll
                for (int dt = 0; dt < 2; ++dt) { const int r_ = 32 * dt + r32; const LAS unsigned char* vp = wl + 4096 + (kt % 3) * SW_SLOT + r_ * 64 + 8 * hh; const int sw_ = (r_ >> 2) & 3;
                    vl[s2][dt] = *(const LAS pg8::u32x2*)(vp + (((2 * s2) ^ sw_) << 4)); vh[s2][dt] = *(const LAS pg8::u32x2*)(vp + (((2 * s2 + 1) ^ sw_) << 4)); }
            __builtin_amdgcn_sched_barrier(0);
#pragma unroll
            for (int s2 = 0; s2 < 2; ++s2) {
                pg8::u32x4 pw; pw.x = cvtpk(S[kt][8 * s2 + 0], S[kt][8 * s2 + 1]); pw.y = cvtpk(S[kt][8 * s2 + 2], S[kt][8 * s2 + 3]); pw.z = cvtpk(S[kt][8 * s2 + 4], S[kt][8 * s2 + 5]); pw.w = cvtpk(S[kt][8 * s2 + 6], S[kt][8 * s2 + 7]);
                const bf16x8 pf = __builtin_bit_cast(bf16x8, pw);
#pragma unroll
                for (int dt = 0; dt < 2; ++dt) { const pg8::u32x4 vw = {vl[s2][dt].x, vl[s2][dt].y, vh[s2][dt].x, vh[s2][dt].y}; const bf16x8 vf = __builtin_bit_cast(bf16x8, vw);
                    if (dt == 0) O0 = __builtin_amdgcn_mfma_f32_32x32x16_bf16(pf, vf, O0, 0, 0, 0); else O1 = __builtin_amdgcn_mfma_f32_32x32x16_bf16(pf, vf, O1, 0, 0, 0); }
            }
            LDS_WAIT(); asm volatile("" ::: "memory");
            if (kt + 3 < ntile) SW_DMA_V(kt + 3, kt % 3);
            __builtin_amdgcn_sched_barrier(0);
        }
    }
#undef SW_DMA_K
#undef SW_DMA_V
    PROBE_T1(52);
    LDS_WAIT(); asm volatile("" ::: "memory");
    LAS float* stg = (LAS float*)(wl + 4096);
#pragma unroll
    for (int i = 0; i < 16; ++i) { const int q = (i & 3) + 8 * (i >> 2) + 4 * hh; stg[q * 68 + r32] = O0[i]; stg[q * 68 + 32 + r32] = O1[i]; }
    LDS_WAIT(); asm volatile("" ::: "memory");
    { const int q = lane >> 1, d0 = (lane & 1) * 32, t = p0 + q;
      if (!meta || t < NMETA) { const int row = rowof(b, t); const float inv = 1.0f / wsf[q];
          const bf16* zp = B.PROJ + (size_t)row * NP1 + PC_ZA + head * 64 + d0; bf16* op = B.YA + (size_t)row * YLD + head * 64 + d0;
#pragma unroll
          for (int hf = 0; hf < 4; ++hf) { const v4u zw = *(const v4u*)(zp + 8 * hf);
              const f32x4 xa = *(const LAS f32x4*)(stg + q * 68 + d0 + 8 * hf) * inv, xb = *(const LAS f32x4*)(stg + q * 68 + d0 + 8 * hf + 4) * inv;
              v4u o; o.x = pk2(xa[0] * siluf_(pg8::bf_lo(zw.x)), xa[1] * siluf_(pg8::bf_hi(zw.x))); o.y = pk2(xa[2] * siluf_(pg8::bf_lo(zw.y)), xa[3] * siluf_(pg8::bf_hi(zw.y)));
              o.z = pk2(xb[0] * siluf_(pg8::bf_lo(zw.z)), xb[1] * siluf_(pg8::bf_hi(zw.z))); o.w = pk2(xb[2] * siluf_(pg8::bf_lo(zw.w)), xb[3] * siluf_(pg8::bf_hi(zw.w)));
              *(v4u*)(op + 8 * hf) = o; } } }
    LDS_WAIT(); asm volatile("" ::: "memory");
}

__device__ __forceinline__ void swa_phase(const Ctx& C, int l) {
    const Bufs B(kargs()->ws);
    const KArgs& A = *kargs();
    __syncthreads();
    for (int i = C.tid; i < 128 * 16; i += NWAVES * 64) { const int h = i >> 7, d = i & 127; ((LAS float*)(C.lds + SW_BIAS))[i] = A.bias_table[t5_bucket(d) * 32 + h]; }
    __syncthreads();
    const float* sinks = A.sinks + l * 16;
    gu32* qctr = (gu32*)(A.ws + WS_CTL) + CW_SWAQ + l * 64;
    LAS int* qslot = (LAS int*)(C.lds + SW_WS) + 8 * 32;
    for (;;) {
        if (C.tid == 0) qslot[0] = (int)__hip_atomic_fetch_add(qctr, 8u, __ATOMIC_RELAXED, __HIP_MEMORY_SCOPE_AGENT);
        LDS_WAIT(); __syncthreads();
        const int base = qslot[0];
        __syncthreads();
        if (base >= 4096 + 32) break;
        const int it = base + C.wave;
        if (it < 4096) { const int blk = it & 127, head = (it >> 7) & 15, b = it >> 11; swa_item(C, B, sinks, b, head, NMETA + 32 * blk, false); }
        else if (it < 4096 + 32) { const int r = it - 4096, head = r & 15, b = r >> 4; swa_item(C, B, sinks, b, head, 0, true); }
    }
    __syncthreads();
}


constexpr int PH_PER_LAYER = 5, N_PHASES = 1 + NLAYER * PH_PER_LAYER + 1;
#ifndef MK_DUP
#define MK_DUP 0
#endif
#ifndef MK_NAIVE_SWA
#define MK_NAIVE_SWA 0
#endif
#ifndef MK_NAIVE_DSA
#define MK_NAIVE_DSA 0
#endif
#ifndef MK_ONE_LAUNCH
#define MK_ONE_LAUNCH 1
#endif

__device__ __forceinline__ int lane_id_fresh() { int l; asm volatile("v_mbcnt_lo_u32_b32 %0, -1, 0\n\tv_mbcnt_hi_u32_b32 %0, -1, %0" : "=v"(l)); return l; }
__global__ void __launch_bounds__(NWAVES * 64, 2) fwd_kernel(Args args) {
    extern __shared__ __attribute__((aligned(16))) unsigned char lds[];
    Ctx C;
    C.lds = (LAS unsigned char*)lds; C.tid = threadIdx.x; C.lane = C.tid & 63; C.wave = __builtin_amdgcn_readfirstlane(C.tid >> 6);
    const int wave0 = C.wave;
    C.G = gridDim.x; C.bid = blockIdx.x; C.gw = blockIdx.x * NWAVES + C.wave; C.NGW = C.G * NWAVES;
    unsigned char* ws = args.ws;
    gu32* ctl = (gu32*)(ws + WS_CTL);
    for (int u = C.tid; u < RING_OFF / 4; u += NWAVES * 64) ((LAS unsigned*)(C.lds + LDSCTL_OFF))[u] = 0u;
    __syncthreads();
    volatile LAS unsigned* MISC = (volatile LAS unsigned*)(C.lds + MISC_OFF);
    XcdBarrier bar; bar.bar = (unsigned*)(ctl + CW_BAR); bar.x = 0; bar.st = nullptr;
    const int lo = args.ph_lo, hi = args.ph_hi;
    const bool one = (hi - lo) > 1;
    if (one) bar = xcd_barrier_post((unsigned*)(ctl + CW_BAR), MISC + 8);
#define IN(k) (lo <= (k) && (k) < hi)
#define PHASE_BEGIN() do { int l_ = lane_id_fresh(); int b_ = blockIdx.x; asm volatile("" : "+s"(b_)); \
    int w_ = wave0; asm volatile("" : "+s"(w_)); C.wave = w_; C.lane = l_; C.tid = w_ * 64 + l_; C.bid = b_; C.gw = b_ * NWAVES + w_; } while (0)
#define SEAM(k) do { if (IN((k) + 1)) { PROBE_T0(); XcdBarrier b2_ = bar; b2_.bar = (unsigned*)launder((unsigned char*)bar.bar);     \
    xcd_barrier(b2_, C.wave == 0 && lane_id_fresh() == 0); PROBE_T1(29); PROBE_T1(60 + ((k) == 0 ? 5 : ((k) - 1) % PH_PER_LAYER)); if (MK_DUP & 256) xcd_barrier(b2_, C.wave == 0 && lane_id_fresh() == 0); } } while (0)
    LAS unsigned char* ring = C.lds + RING_OFF;

    if (IN(0)) { PROBE_T0(); PHASE_BEGIN(); p0_prologue(C); PROBE_T1(20); if (MK_DUP & 128) { PHASE_BEGIN(); p0_prologue(C); } SEAM(0); }
    for (int l = 0; l < NLAYER; ++l) {
        const int p = 1 + l * PH_PER_LAYER;
        if (IN(p)) {
            PHASE_BEGIN(); const Bufs B(kargs()->ws);
            const bf16* W1l = B.W1 + (size_t)l * NP1 * DM;
            pg8::Gemm g{B.HB, W1l, MR, 8192, DM}; pg8::StaticOrder S; S.init(MR, 8192, C.G, C.bid);
            rstd_table<8>(C, S, B.RS, 1.0f / DM);
            pg8::EpiProjT<true> E{B.PROJ, NP1, (const LAS float*)(C.lds + RSTD_OFF), B.KV, B.RSQ, B.RHO, B.SGB, B.VT};
            { PROBE_T0(); pg8::gemm_phase<pg8::EpiProjT<true>, pg8::StaticOrder, true, true>(ring, g, S, E, C.tid); PROBE_T1(21); }
            PHASE_BEGIN();
            LAS float* tbl = (LAS float*)(C.lds + RSTD_OFF);
            PROBE_T0();
            const int nside = (C.G == 256) ? 256 + 256 : 256 + 259;
            for (int u = C.bid; u < nside; u += C.G) {
                if (u < 256) { const int row0 = 32 * u; skinny_rstd(C, B.RS + (size_t)row0 * 32, 32, 1.0f / DM, tbl);
                    skinny_unit<3, 2>(C, B.HB + (size_t)row0 * DM, DM, B.W1K + (size_t)l * 32 * 3 * 4 * 512, DM, DM, nullptr, 0, 0, SkProj{B.PROJ + (size_t)row0 * NP1, B.KV + (size_t)row0 * 256, B.KIDX, 8192, tbl, row0, B.VT}); }
                else { const int gc = u - 256; skinny_rstd(C, B.RS2, 64, 1.0f / DM, tbl);
                    const SkProj E2{B.PROJ + (size_t)MR * NP1, B.KV + (size_t)MR * 256, B.KIDX, gc * 32, tbl, MR, B.VT};
                    const bool sqc = gc >= 72 && gc < 88;
                    skinny_unit<1, 4>(C, B.HB + (size_t)MR * DM, DM, W1l + (size_t)gc * 32 * DM, DM, DM, sqc ? B.RSQ2 : nullptr, 16, gc - 72, E2); }
            }
            PROBE_T1(22);
            SEAM(p);
        }
        if (IN(p + 1)) {
            PHASE_BEGIN(); const Bufs B(kargs()->ws);
            const bf16* W2l = B.W2 + (size_t)l * NQ2 * 512;
            pg8::Gemm g{B.PROJ + PC_CQ, W2l, MR, NQ2, 512, nullptr, nullptr, NP1}; pg8::StaticOrder S; S.init(MR, NQ2, C.G, C.bid);
            rstd_table<2>(C, S, B.RSQ, 1.0f / 512.0f);
            pg8::EpiProjT<false> E{B.Q2, NQ2, (const LAS float*)(C.lds + RSTD_OFF), nullptr, nullptr, nullptr, nullptr, nullptr};
            PROBE_T0();
            pg8::gemm_phase<pg8::EpiProjT<false>, pg8::StaticOrder, true, true>(ring, g, S, E, C.tid);
            PHASE_BEGIN();
            { LAS float* tbl = (LAS float*)(C.lds + RSTD_OFF);
              const int sb = (C.G == 256) ? C.bid - 64 : C.bid;
              for (int u = sb; u >= 0 && u < 48; u += C.G) { skinny_rstd(C, B.RSQ2, 16, 1.0f / 512.0f, tbl);
                skinny_unit<3, 1>(C, B.PROJ + (size_t)MR * NP1 + PC_CQ, NP1, W2l + (size_t)u * 96 * 512, 512, 512, nullptr, 0, 0, SkQ2{B.Q2 + (size_t)MR * NQ2 + u * 96, tbl}); }
              if (C.G == 256 && sb >= 48 && sb < 51) { const int gc = 256 + sb - 48; const bf16* W1l = B.W1 + (size_t)l * NP1 * DM;
                skinny_rstd(C, B.RS2, 64, 1.0f / DM, tbl);
                skinny_unit<1, 4>(C, B.HB + (size_t)MR * DM, DM, W1l + (size_t)gc * 32 * DM, DM, DM, nullptr, 16, 0, SkProj{B.PROJ + (size_t)MR * NP1, B.KV + (size_t)MR * 256, B.KIDX, gc * 32, tbl, MR, B.VT}); } }
            PHASE_BEGIN(); norm_tail(C, l);
            PROBE_T1(24);
            SEAM(p + 1);
        }
        if (IN(p + 2)) {
            { PROBE_T0(); PHASE_BEGIN(); dsa_phase(C, l); PROBE_T1(4); }
            if (MK_DUP & 16) { PHASE_BEGIN(); dsa_phase(C, l); }
            { PROBE_T0(); PHASE_BEGIN(); swa_phase(C, l); PROBE_T1(5); }
            SEAM(p + 2);
        }
        if (IN(p + 3)) {
            PHASE_BEGIN(); const Bufs B(kargs()->ws);
            const bf16* WABl = B.WA + (size_t)l * DM * 2048;
            pg8::Gemm g{B.YA, WABl, MR, DM, 2048, nullptr, nullptr, 0}; pg8::StaticOrder S; S.init(MR, DM, C.G, C.bid);
            pg8::EpiG4m E{B.MG, B.RHO, B.SGB};
            PROBE_T0();
            pg8::gemm_phase<pg8::EpiG4m, pg8::StaticOrder, true, true>(ring, g, S, E, C.tid);
            PROBE_T1(35);
            PHASE_BEGIN();
            for (int u = C.bid; u < 64; u += C.G) {
                skinny_unit<1, 2>(C, B.YA + (size_t)MR * YLD, YLD, WABl + (size_t)u * 32 * 2048, 2048, 2048, nullptr, 0, 0, SkMerge2{B.MG + (size_t)MR * DM + u * 32, B.PROJ + (size_t)MR * NP1 + 4096, u * 32}); }
            PROBE_T1(25);
            SEAM(p + 3);
        }
        if (MK_PROBE >= 0 && l == NLAYER - 1 && C.bid == MK_PROBE_BLOCK && C.wave == 0 && C.lane == 0) __hip_atomic_store((gu32*)(kargs()->ws + WS_CTL) + 3, ((volatile LAS unsigned*)(C.lds + MISC_OFF + 64))[0], RLX_AGENT);
        if (IN(p + 4)) {
            PHASE_BEGIN(); const Bufs B(kargs()->ws);
            const bf16* WOl = B.WO + (size_t)l * DM * DM;
            pg8::Gemm g{B.MG, WOl, MR, DM, DM}; pg8::StaticOrder S; S.init(MR, DM, C.G, C.bid);
            pg8::EpiRes E{B.HB, B.RS};
            PROBE_T0();
            pg8::gemm_phase<pg8::EpiRes, pg8::StaticOrder, true, true>(ring, g, S, E, C.tid);
            PROBE_T1(37);
            PHASE_BEGIN();
            for (int u = C.bid; u < 64; u += C.G) skinny_unit<1, 4>(C, B.MG + (size_t)MR * DM, DM, WOl + (size_t)u * 32 * DM, DM, DM, B.RS2, 64, u, SkRes{B.HB + (size_t)MR * DM + u * 32});
            PROBE_T1(27);
            SEAM(p + 4);
        }
    }
    if (IN(N_PHASES - 1)) { PHASE_BEGIN(); final_phase(C); }
#undef IN
#undef SEAM
}

extern "C" void kernel_launch(void* const* d_in, const int* in_sizes, int n_in, void* d_out, int out_size, void* d_ws, size_t ws_size, hipStream_t stream) {
    static int grid = 0;
    if (grid == 0) {
        if (n_in != 16 || ws_size < WS_END) { fprintf(stderr, "kernel_launch: unexpected inputs (n_in %d, ws %zu, need %zu)\n", n_in, ws_size, (size_t)WS_END); grid = -1; return; }
        int dev = 0, cus = 0;
        if (hipGetDevice(&dev) != hipSuccess || hipDeviceGetAttribute(&cus, hipDeviceAttributeMultiprocessorCount, dev) != hipSuccess) { grid = -1; return; }
        if (hipFuncSetAttribute((const void*)fwd_kernel, hipFuncAttributeMaxDynamicSharedMemorySize, LDS_BYTES) != hipSuccess) { fprintf(stderr, "kernel_launch: hipFuncSetAttribute failed\n"); grid = -1; return; }
        int per_cu = 0;
        if (hipOccupancyMaxActiveBlocksPerMultiprocessor(&per_cu, (const void*)fwd_kernel, NWAVES * 64, LDS_BYTES) != hipSuccess || per_cu < 1) fprintf(stderr, "kernel_launch: occupancy query says %d\n", per_cu);
        (void)hipGetLastError();
        grid = cus;
    }
    if (grid < 0) return;
    if (hipMemsetAsync((char*)d_ws + WS_CTL, 0, CTL_ZERO_BYTES, stream) != hipSuccess) return;
    Args a{};
    a.x = (const float*)d_in[0]; a.meta = (const float*)d_in[1]; a.bias_table = (const float*)d_in[2]; a.norm_g = (const float*)d_in[3]; a.w_in = (const float*)d_in[4];
    a.q_norm_g = (const float*)d_in[5]; a.kv_norm_g = (const float*)d_in[6]; a.w_qb = (const float*)d_in[7]; a.w_iq = (const float*)d_in[8]; a.w_uk = (const float*)d_in[9];
    a.w_uv = (const float*)d_in[10]; a.sinks = (const float*)d_in[11]; a.w_proj_a = (const float*)d_in[12]; a.w_proj_b = (const float*)d_in[13]; a.w_out = (const float*)d_in[14];
    a.final_g = (const float*)d_in[15]; a.out = (float*)d_out; a.ws = (unsigned char*)d_ws;
#if MK_ONE_LAUNCH
    a.ph_lo = 0; a.ph_hi = N_PHASES;
    hipLaunchKernelGGL(fwd_kernel, dim3(grid), dim3(NWAVES * 64), LDS_BYTES, stream, a);
#else
    for (int p = 0; p < N_PHASES; ++p) { a.ph_lo = p; a.ph_hi = p + 1; hipLaunchKernelGGL(fwd_kernel, dim3(grid), dim3(NWAVES * 64), LDS_BYTES, stream, a); }
#endif
}
```
